# Optimizing an MI355X kernel written in HIP

```python
import functools
import jax, jax.numpy as jnp
from jax import lax
import numpy as np


D_MODEL = 1024
BATCH = 8
SEQ = 2048
DEPTH = 1
DEC_BATCH = 32
DEC_SEQ = 1
PAST_LEN = 8192
PAGE_SIZE = 128

ATT_W = D_MODEL // 2
HEAD_DIM = 64
ATT_H = ATT_W // HEAD_DIM
IDX_H = 16
IDX_D = 64
IDX_W_SCALE = (IDX_H ** -0.5) * (IDX_D ** -0.5)
TOPK_MAX = 256
Q_BLOCK = 128
RW_W = D_MODEL - ATT_W
RW_N = 64
RW_H = RW_W // RW_N
W_LORA = 64
A_LORA = 64
G_LORA = 128
GN_EPS = 64e-5
MIX_W = ATT_W + RW_W
ATT_COLS = 3 * ATT_W + IDX_H * IDX_D + IDX_D + IDX_H
RW_COLS = 3 * RW_W + W_LORA + A_LORA + G_LORA
IN_COLS = ATT_COLS + RW_COLS
FFN_DIM = ((8 * D_MODEL + 3 * 256 - 1) // (3 * 256)) * 256
RMS_EPS = 1e-6

kernel_name = 'hymba_dsa_rwkv7_adaln_step'


def rms_norm(x, g=None, eps=RMS_EPS):
    xf = x.astype(jnp.float32)
    y = xf * lax.rsqrt(jnp.mean(xf * xf, axis=-1, keepdims=True) + eps)
    if g is not None:
        y = y * g.astype(jnp.float32)
    return y.astype(x.dtype)


def gather_rows(src, idx):
    return jax.vmap(lambda s, i: s[i])(src, idx)


def indexer_scores(qi, ki, wi):
    dots = jnp.einsum('bqhd,bld->bqhl', qi.astype(jnp.float32), ki.astype(jnp.float32))
    return jnp.einsum('bqhl,bqh->bql', jax.nn.relu(dots), wi.astype(jnp.float32))


def attend_selected(q, kg, vg, valid):
    s = jnp.einsum('bqhd,bqkhd->bqhk', q.astype(jnp.float32), kg.astype(jnp.float32)) * (HEAD_DIM ** -0.5)
    s = jnp.where(valid[:, :, None, :], s, -jnp.inf)
    p = jax.nn.softmax(s, axis=-1)
    o = jnp.einsum('bqhk,bqkhd->bqhd', p, vg.astype(jnp.float32))
    return o.astype(q.dtype)


def prompt_attention(q, k, v, qi, ki, wi):
    B, T = q.shape[:2]
    n_sel = min(TOPK_MAX, T // 4)
    nb = T // Q_BLOCK

    def blocks(z):
        return jnp.moveaxis(z.reshape((B, nb, Q_BLOCK) + z.shape[2:]), 1, 0)

    def one_block(args):
        qb, qib, wib, t0 = args
        tpos = t0 + jnp.arange(Q_BLOCK)
        score = indexer_scores(qib, ki, wib)
        allowed = jnp.arange(T)[None, :] <= tpos[:, None]
        score = jnp.where(allowed[None], score, -jnp.inf)
        _, idx = lax.top_k(score, n_sel)
        valid = idx <= tpos[None, :, None]
        return attend_selected(qb, gather_rows(k, idx), gather_rows(v, idx), valid)

    out = lax.map(one_block, (blocks(q), blocks(qi), blocks(wi), jnp.arange(nb, dtype=jnp.int32) * Q_BLOCK))
    return jnp.moveaxis(out, 0, 1).reshape(B, T, ATT_H, HEAD_DIM)


def sample_attention(q, k_new, v_new, qi, ki_new, wi, cache_k, cache_v, cache_ik, page_table):
    B, T = q.shape[:2]
    past = page_table.shape[1] * PAGE_SIZE
    L = past + T
    n_sel = min(TOPK_MAX, L // 4)
    past_ik = cache_ik[page_table].reshape(B, past, IDX_D)
    ki_all = jnp.concatenate([past_ik.astype(ki_new.dtype), ki_new], axis=1)
    tpos = past + jnp.arange(T)
    score = indexer_scores(qi, ki_all, wi)
    allowed = jnp.arange(L)[None, :] <= tpos[:, None]
    score = jnp.where(allowed[None], score, -jnp.inf)
    _, idx = lax.top_k(score, n_sel)
    valid = idx <= tpos[None, :, None]
    is_past = idx < past
    pidx = jnp.minimum(idx, past - 1)
    page = jnp.take_along_axis(page_table, (pidx // PAGE_SIZE).reshape(B, -1), axis=1).reshape(idx.shape)
    row = page * PAGE_SIZE + pidx % PAGE_SIZE
    nidx = jnp.clip(idx - past, 0, T - 1)

    def pick(pool, new):
        flat = pool.reshape((-1,) + pool.shape[2:])
        return jnp.where(is_past[..., None, None], flat[row].astype(new.dtype), gather_rows(new, nidx))

    return attend_selected(q, pick(cache_k, k_new), pick(cache_v, v_new), valid)


def wkv7_step(S, inp):
    r, w, k, v, kk, a = inp
    sa = jnp.einsum('bhij,bhj->bhi', S, -kk)
    S = S * w[:, :, None, :] + sa[..., None] * (kk * a)[:, :, None, :] + v[..., None] * k[:, :, None, :]
    return S, jnp.einsum('bhij,bhj->bhi', S, r)


def rwkv7_mix(pr, prev_row, s0, lp):
    B, T, _ = pr.shape
    prev = jnp.concatenate([prev_row[:, None, :].astype(pr.dtype), pr[:, :-1]], axis=1)
    xm = pr + (prev - pr) * lp['rw_mu']
    p0 = 3 * RW_W
    r = xm[..., :RW_W]
    k = xm[..., RW_W:2 * RW_W]
    v = xm[..., 2 * RW_W:p0]
    wd = xm[..., p0:p0 + W_LORA]
    ad = xm[..., p0 + W_LORA:p0 + W_LORA + A_LORA]
    gd = xm[..., p0 + W_LORA + A_LORA:]
    w_log = -jax.nn.softplus(-(lp['rw_w0'] + jnp.tanh(wd) @ lp['rw_w2'])) - 0.5
    a = jax.nn.sigmoid(lp['rw_a0'] + ad @ lp['rw_a2'])
    g = jax.nn.sigmoid(gd) @ lp['rw_g2']

    def heads(z):
        return z.astype(jnp.float32).reshape(B, T, RW_H, RW_N)

    kk = heads(k * lp['rw_k_k'])
    kk = kk * lax.rsqrt(jnp.maximum(jnp.sum(kk * kk, axis=-1, keepdims=True), 1e-24))
    k = k * (1 + (a - 1) * lp['rw_k_a'])
    rh, kh, vh, ah = heads(r), heads(k), heads(v), heads(a)
    decay = jnp.exp(-jnp.exp(heads(w_log)))
    xs = tuple(jnp.moveaxis(z, 1, 0) for z in (rh, decay, kh, vh, kk, ah))
    s_fin, ys = lax.scan(wkv7_step, s0.astype(jnp.float32), xs)
    y = jnp.moveaxis(ys, 0, 1)
    mu = jnp.mean(y, axis=-1, keepdims=True)
    var = jnp.mean((y - mu) ** 2, axis=-1, keepdims=True)
    yn = ((y - mu) * lax.rsqrt(var + GN_EPS)).reshape(B, T, RW_W) * lp['rw_ln_w'].astype(jnp.float32) + lp['rw_ln_b'].astype(jnp.float32)
    bonus = (jnp.sum(rh * kh * lp['rw_r_k'].astype(jnp.float32), axis=-1, keepdims=True) * vh).reshape(B, T, RW_W)
    out = ((yn + bonus) * g.astype(jnp.float32)).astype(pr.dtype)
    return out, s_fin, pr[:, -1]


def decoder_layer(x, c, attn_fn, prev_row, s0, lp):
    B, T, _ = x.shape
    mod = (jax.nn.silu(c) @ lp['w_ada'] + lp['b_ada'])[:, None, :]
    shift1, scale1, gate1, shift2, scale2, gate2 = jnp.split(mod, 6, axis=-1)
    h = rms_norm(x, lp['norm1_g']) * (1 + scale1) + shift1
    proj = h @ lp['w_in']
    pa, pr = proj[..., :ATT_COLS], proj[..., ATT_COLS:]
    o1, o2, o3 = ATT_W, 2 * ATT_W, 3 * ATT_W
    o4 = o3 + IDX_H * IDX_D
    o5 = o4 + IDX_D
    q = rms_norm(pa[..., :o1].reshape(B, T, ATT_H, HEAD_DIM), lp['q_norm_g'])
    k = rms_norm(pa[..., o1:o2].reshape(B, T, ATT_H, HEAD_DIM), lp['k_norm_g'])
    v = pa[..., o2:o3].reshape(B, T, ATT_H, HEAD_DIM)
    qi = pa[..., o3:o4].reshape(B, T, IDX_H, IDX_D)
    ki = rms_norm(pa[..., o4:o5])
    wi = pa[..., o5:ATT_COLS] * IDX_W_SCALE
    att = attn_fn(q, k, v, qi, ki, wi).reshape(B, T, ATT_W)
    rw, s_fin, last_row = rwkv7_mix(pr, prev_row, s0, lp)
    x = x + gate1 * (jnp.concatenate([att, rw], axis=-1) @ lp['w_out'])
    h2 = rms_norm(x, lp['norm2_g']) * (1 + scale2) + shift2
    ffn = (jax.nn.silu(h2 @ lp['w_ffn_gate']) * (h2 @ lp['w_ffn_up'])) @ lp['w_ffn_down']
    x = x + gate2 * ffn
    return x, (k, v, ki, s_fin, last_row)


def setup_inputs(seed: int = 0) -> dict:
    key = jax.random.key(seed)
    ks = iter(jax.random.split(key, 48))
    nrm = lambda shape, s=1.0: jax.random.normal(next(ks), shape, jnp.float32) * s
    n_pages = PAST_LEN // PAGE_SIZE
    n_used = DEC_BATCH * n_pages
    n_pool = n_used + max(1, n_used // 4)
    page_table = jax.random.permutation(next(ks), n_pool)[:n_used].reshape(DEC_BATCH, n_pages).astype(jnp.int32)
    return {
        'x_prompt': nrm((BATCH, SEQ, D_MODEL)),
        'x_sample': nrm((DEC_BATCH, DEC_SEQ, D_MODEL)),
        'cache_k': nrm((DEPTH, n_pool, PAGE_SIZE, ATT_H, HEAD_DIM)),
        'cache_v': nrm((DEPTH, n_pool, PAGE_SIZE, ATT_H, HEAD_DIM)),
        'cache_idx_k': nrm((DEPTH, n_pool, PAGE_SIZE, IDX_D)),
        'state_wkv': nrm((DEPTH, DEC_BATCH, RW_H, RW_N, RW_N), 0.3),
        'state_shift': nrm((DEPTH, DEC_BATCH, RW_COLS)),
        'page_table': page_table,
        'c_prompt': nrm((BATCH, D_MODEL)),
        'c_sample': nrm((DEC_BATCH, D_MODEL)),
        'norm1_g': 1.0 + nrm((DEPTH, D_MODEL), 0.05),
        'norm2_g': 1.0 + nrm((DEPTH, D_MODEL), 0.05),
        'w_ada': nrm((DEPTH, D_MODEL, 6 * D_MODEL), 0.3 * D_MODEL ** -0.5),
        'b_ada': nrm((DEPTH, 6 * D_MODEL), 0.02),
        'w_in': nrm((DEPTH, D_MODEL, IN_COLS), D_MODEL ** -0.5),
        'q_norm_g': 1.0 + nrm((DEPTH, HEAD_DIM), 0.05),
        'k_norm_g': 1.0 + nrm((DEPTH, HEAD_DIM), 0.05),
        'rw_mu': jax.random.uniform(next(ks), (DEPTH, RW_COLS), jnp.float32),
        'rw_w0': nrm((DEPTH, RW_W), 0.5),
        'rw_w2': nrm((DEPTH, W_LORA, RW_W), 0.5 * W_LORA ** -0.5),
        'rw_a0': nrm((DEPTH, RW_W), 0.1),
        'rw_a2': nrm((DEPTH, A_LORA, RW_W), 0.5 * A_LORA ** -0.5),
        'rw_g2': nrm((DEPTH, G_LORA, RW_W), G_LORA ** -0.5),
        'rw_k_k': 0.85 + nrm((DEPTH, RW_W), 0.05),
        'rw_k_a': 1.0 + nrm((DEPTH, RW_W), 0.05),
        'rw_r_k': nrm((DEPTH, RW_H, RW_N), 0.1),
        'rw_ln_w': 1.0 + nrm((DEPTH, RW_W), 0.05),
        'rw_ln_b': nrm((DEPTH, RW_W), 0.02),
        'w_out': nrm((DEPTH, MIX_W, D_MODEL), MIX_W ** -0.5),
        'w_ffn_gate': nrm((DEPTH, D_MODEL, FFN_DIM), D_MODEL ** -0.5),
        'w_ffn_up': nrm((DEPTH, D_MODEL, FFN_DIM), D_MODEL ** -0.5),
        'w_ffn_down': nrm((DEPTH, FFN_DIM, D_MODEL), FFN_DIM ** -0.5),
    }


def reference(x_prompt, x_sample, cache_k, cache_v, cache_idx_k, state_wkv, state_shift, page_table,
              c_prompt, c_sample, norm1_g, norm2_g, w_ada, b_ada, w_in, q_norm_g, k_norm_g,
              rw_mu, rw_w0, rw_w2, rw_a0, rw_a2, rw_g2, rw_k_k, rw_k_a, rw_r_k, rw_ln_w, rw_ln_b,
              w_out, w_ffn_gate, w_ffn_up, w_ffn_down):
    y_p, y_s = x_prompt, x_sample
    Bp = x_prompt.shape[0]
    kp, vp, ikp, wkvp, shp = [], [], [], [], []
    ksm, vsm, iks, wkvs, shs = [], [], [], [], []
    for l in range(DEPTH):
        lp = {
            'norm1_g': norm1_g[l], 'norm2_g': norm2_g[l], 'w_ada': w_ada[l], 'b_ada': b_ada[l],
            'w_in': w_in[l], 'q_norm_g': q_norm_g[l], 'k_norm_g': k_norm_g[l],
            'rw_mu': rw_mu[l], 'rw_w0': rw_w0[l], 'rw_w2': rw_w2[l], 'rw_a0': rw_a0[l], 'rw_a2': rw_a2[l],
            'rw_g2': rw_g2[l], 'rw_k_k': rw_k_k[l], 'rw_k_a': rw_k_a[l], 'rw_r_k': rw_r_k[l],
            'rw_ln_w': rw_ln_w[l], 'rw_ln_b': rw_ln_b[l], 'w_out': w_out[l],
            'w_ffn_gate': w_ffn_gate[l], 'w_ffn_up': w_ffn_up[l], 'w_ffn_down': w_ffn_down[l],
        }
        prev0 = jnp.zeros((Bp, RW_COLS), x_prompt.dtype)
        s00 = jnp.zeros((Bp, RW_H, RW_N, RW_N), jnp.float32)
        y_p, st_p = decoder_layer(y_p, c_prompt, prompt_attention, prev0, s00, lp)
        samp_attn = functools.partial(sample_attention, cache_k=cache_k[l], cache_v=cache_v[l],
                                      cache_ik=cache_idx_k[l], page_table=page_table)
        y_s, st_s = decoder_layer(y_s, c_sample, samp_attn, state_shift[l], state_wkv[l], lp)
        kp.append(st_p[0]); vp.append(st_p[1]); ikp.append(st_p[2]); wkvp.append(st_p[3]); shp.append(st_p[4])
        ksm.append(st_s[0]); vsm.append(st_s[1]); iks.append(st_s[2]); wkvs.append(st_s[3]); shs.append(st_s[4])
    return (y_p, y_s,
            jnp.stack(kp), jnp.stack(vp), jnp.stack(ikp), jnp.stack(wkvp), jnp.stack(shp),
            jnp.stack(ksm), jnp.stack(vsm), jnp.stack(iks), jnp.stack(wkvs), jnp.stack(shs))
```

```cpp
#include <hip/hip_runtime.h>
#include <cstdio>
#include <cstdint>
#include <cmath>
#define LAS __attribute__((address_space(3)))
namespace pg8 {
#define PG8_LAS __attribute__((address_space(3)))
typedef unsigned short bf16_t;
typedef short bf16x8 __attribute__((ext_vector_type(8)));
typedef float f32x4 __attribute__((ext_vector_type(4)));
typedef unsigned u32x4 __attribute__((ext_vector_type(4)));
constexpr int BM = 256, BK = 64, HALF = 128, HTB = HALF * BK * 2  , STAGE_BYTES = 8 * HTB, NXCD = 8, WGM = 8;

__host__ __device__ __forceinline__ int lds_byte(int r, int c) { const int st = (r >> 4) * 2 + (c >> 5), rr = r & 15, cc = c & 31, ob = rr * 64 + cc * 2; return st * 1024 + (ob ^ (((ob >> 9) & 1) << 5)); }
__host__ __device__ __forceinline__ void stage_rc(int b, int& R, int& C) { const int st = b / 1024, sb = b % 1024, swz = sb ^ (((sb >> 9) & 1) << 5); R = (st >> 1) * 16 + swz / 64; C = (st & 1) * 32 + (swz % 64) / 2; }
__host__ __device__ __forceinline__ int perm32(int rho) { const int n = rho >> 4, i = rho & 15; return 8 * (i >> 2) + 4 * n + (i & 3); }

struct Unit { int pm, pn; };
struct Gemm { const bf16_t* A; const bf16_t* Bt; int M, N, K; };

struct StaticOrder {
    int nM, nN, nwg, G, c;
    __host__ __device__ void init(int M, int N, int G_, int c_) { nM = M / BM; nN = N / BM; nwg = nM * nN; G = G_; c = c_; }
    __host__ __device__ bool next(int i, Unit& u) const {
        const long L = (long)i * G + c; if (L >= nwg) return false;
        int wgid = (int)L; { const int q = nwg / NXCD, r = nwg % NXCD, xcd = wgid % NXCD, off = wgid / NXCD; wgid = (xcd < r ? xcd * (q + 1) : r * (q + 1) + (xcd - r) * q) + off; }
        const int nig = WGM * nN, gid = wgid / nig, fm = gid * WGM, gsz = (nM - fm) < WGM ? (nM - fm) : WGM;
        u.pm = fm + ((wgid % nig) % gsz); u.pn = (wgid % nig) / gsz; return true;
    }
    __device__ __forceinline__ void a_ready(const Unit&) const {}
    __device__ __forceinline__ void done(const Unit&) const {}
};

__device__ __forceinline__ unsigned cvt_pk_bf16(float lo, float hi) { unsigned r; asm volatile("v_cvt_pk_bf16_f32 %0, %1, %2" : "=v"(r) : "v"(lo), "v"(hi)); return r; }
typedef float f32x2 __attribute__((ext_vector_type(2)));
__device__ __forceinline__ f32x2 gelu_pk(f32x2 v) {
    const f32x2 av = __builtin_elementwise_abs(v), d = av * 0.2316418882f + 1.0f;
    f32x2 t; t.x = __builtin_amdgcn_rcpf(d.x); t.y = __builtin_amdgcn_rcpf(d.y);
    f32x2 q = t * 0.5307027145f + (-0.7265760135f); q = q * t + 0.7107068705f; q = q * t + (-0.142248368f); q = q * t + 0.127414796f; q = q * t;
    const f32x2 s = (v * v) * (-0.72134752044f);
    f32x2 e; e.x = __builtin_amdgcn_exp2f(s.x); e.y = __builtin_amdgcn_exp2f(s.y);
    const f32x2 m = v * (q * e), r = v - m;
    f32x2 o; o.x = v.x < 0.f ? m.x : r.x; o.y = v.y < 0.f ? m.y : r.y; return o;
}

template <int ACT  > struct EpiBf16 {
    static constexpr bool PERM = true, AFTER_DRAIN = false; static_assert(ACT == 0 || ACT == 1, "EpiBf16: ACT is 0 (none) or 1 (gelu_pk)");
    bf16_t* O; int ldc; const float* bias; int split_cols; size_t split_stride; float scale0;
    __device__ __forceinline__ void operator()(const f32x4 (&acc)[2][2][4][2], const Unit& u, int wr, int wc, int fr, int fq) const {
        const int row0 = u.pm * BM + wr * 64 + fr; int colt = u.pn * BM; bf16_t* base = O;
        float sc = 1.f; if (split_cols) { const int t = colt / split_cols; base += (size_t)t * split_stride; colt -= t * split_cols; if (t == 0) sc = scale0; }
        const int col0 = colt + wc * 32 + 8 * fq, bcol0 = u.pn * BM + wc * 32 + 8 * fq;
        f32x4 bv[2][2];
#pragma unroll
        for (int bj = 0; bj < 2; ++bj)
#pragma unroll
            for (int n = 0; n < 2; ++n) bv[bj][n] = bias ? *(const f32x4*)(bias + bcol0 + bj * HALF + 4 * n) : (f32x4){0.f, 0.f, 0.f, 0.f};
#pragma unroll
        for (int ai = 0; ai < 2; ++ai)
#pragma unroll
            for (int m = 0; m < 4; ++m) { bf16_t* rowp = base + (size_t)(row0 + ai * HALF + m * 16) * ldc + col0;
#pragma unroll
                for (int bj = 0; bj < 2; ++bj) { f32x4 v0 = acc[ai][bj][m][0] + bv[bj][0], v1 = acc[ai][bj][m][1] + bv[bj][1];
                    if (ACT == 1) { f32x2 a = gelu_pk((f32x2){v0[0], v0[1]}), b = gelu_pk((f32x2){v0[2], v0[3]}), c = gelu_pk((f32x2){v1[0], v1[1]}), d = gelu_pk((f32x2){v1[2], v1[3]});
                        v0 = (f32x4){a.x, a.y, b.x, b.y}; v1 = (f32x4){c.x, c.y, d.x, d.y}; }
                    v0 = v0 * sc; v1 = v1 * sc; u32x4 w; w.x = cvt_pk_bf16(v0[0], v0[1]); w.y = cvt_pk_bf16(v0[2], v0[3]); w.z = cvt_pk_bf16(v1[0], v1[1]); w.w = cvt_pk_bf16(v1[2], v1[3]);
                    *(u32x4*)(rowp + bj * HALF) = w; } }
    }
};


template <class Epi, class Sched, bool ALIGN_EPI = false, bool SP2 = false>
__device__ __forceinline__ void gemm_phase(PG8_LAS unsigned char* lds, const Gemm g, const Sched& S, const Epi& E) {
    const int tid = threadIdx.x, wid = __builtin_amdgcn_readfirstlane(tid >> 6), lane = tid & 63, wr = wid >> 2, wc = wid & 3, fr = lane & 15, fq = lane >> 4;
    const int K = g.K, nt = K / BK;
    unsigned voffA[2], voffB[2];
#pragma unroll
    for (int i = 0; i < 2; ++i) { int R, C; stage_rc(tid * 16 + i * 8192, R, C); const int Rb = Epi::PERM ? ((R & ~31) + perm32(R & 31)) : R;
        voffA[i] = (unsigned)(R * K + C) * 2u; voffB[i] = (unsigned)(Rb * K + C) * 2u; }
    const size_t kstep = (size_t)(BK * 2);
    const size_t hstep = (size_t)HALF * K * 2;
    const size_t tstep = 2 * hstep;
    const unsigned ldsw = (unsigned)wid * 1024u;
    const int aoff = lds_byte(wr * 64 + fr, fq * 8), boff = lds_byte(wc * 32 + fr, fq * 8);
#define PG8_SA(b, h) (((b) * 2 + (h)) * HTB)
#define PG8_SB(b, h) ((4 + (b) * 2 + (h)) * HTB)
#define PG8_STAGE(bufoff, gbase, voff) do { _Pragma("unroll") for (int _i = 0; _i < 2; ++_i) \
        __builtin_amdgcn_global_load_lds((const unsigned*)((const char*)(gbase) + (voff)[_i]), (PG8_LAS unsigned*)(lds + (bufoff) + ldsw + _i * 8192), 16, 0, 0); } while (0)
#define PG8_LDA(dst, b, h) do { _Pragma("unroll") for (int m = 0; m < 4; ++m) _Pragma("unroll") for (int k = 0; k < 2; ++k) dst[m][k] = *(const PG8_LAS bf16x8*)(lds + PG8_SA(b, h) + aoff + m * 2048 + k * 1024); } while (0)
#define PG8_LDB(dst, b, h) do { _Pragma("unroll") for (int n = 0; n < 2; ++n) _Pragma("unroll") for (int k = 0; k < 2; ++k) dst[n][k] = *(const PG8_LAS bf16x8*)(lds + PG8_SB(b, h) + boff + n * 2048 + k * 1024); } while (0)
#define PG8_MMA(ai, bj, At, Bt) do { __builtin_amdgcn_s_setprio(1); _Pragma("unroll") for (int m = 0; m < 4; ++m) _Pragma("unroll") for (int n = 0; n < 2; ++n) _Pragma("unroll") for (int k = 0; k < 2; ++k) \
        acc[ai][bj][m][n] = __builtin_amdgcn_mfma_f32_16x16x32_bf16(Bt[n][k], At[m][k], acc[ai][bj][m][n], 0, 0, 0); __builtin_amdgcn_s_setprio(0); } while (0)
#define PG8_WAIT_V(n) asm volatile("s_waitcnt vmcnt(" #n ")" ::: "memory")
#define PG8_WAIT_L(n) asm volatile("s_waitcnt lgkmcnt(" #n ")" ::: "memory")
#define PG8_BAR __builtin_amdgcn_s_barrier()
#define PG8_SCHED __builtin_amdgcn_sched_barrier(0)
    Unit cur, nxt; int ui = 0;
    if (!S.next(0, cur)) return;
    f32x4 acc[2][2][4][2];
#pragma unroll
    for (int a = 0; a < 2; ++a)
#pragma unroll
        for (int b = 0; b < 2; ++b)
#pragma unroll
            for (int m = 0; m < 4; ++m)
#pragma unroll
                for (int n = 0; n < 2; ++n) acc[a][b][m][n] = (f32x4){0.f, 0.f, 0.f, 0.f};
    bf16x8 At[4][2], B0[2][2], B1[2][2];
    const char* cA = (const char*)g.A + (size_t)cur.pm * tstep; const char* cB = (const char*)g.Bt + (size_t)cur.pn * tstep;
    S.a_ready(cur);
    if constexpr (SP2) {
        PG8_STAGE(PG8_SB(0, 0), cB, voffB); PG8_STAGE(PG8_SB(0, 1), cB + hstep, voffB); PG8_STAGE(PG8_SA(0, 0), cA, voffA); PG8_STAGE(PG8_SA(0, 1), cA + hstep, voffA);
        if (wr == 1) PG8_BAR;
        PG8_WAIT_V(2); PG8_BAR;
        PG8_STAGE(PG8_SB(1, 0), cB + kstep, voffB); PG8_STAGE(PG8_SA(1, 0), cA + kstep, voffA); PG8_STAGE(PG8_SB(1, 1), cB + hstep + kstep, voffB);
        PG8_WAIT_V(6); PG8_BAR;
    } else {
        PG8_STAGE(PG8_SB(0, 0), cB, voffB); PG8_STAGE(PG8_SA(0, 0), cA, voffA); PG8_STAGE(PG8_SB(0, 1), cB + hstep, voffB); PG8_STAGE(PG8_SA(0, 1), cA + hstep, voffA);
        if (wr == 1) PG8_BAR;
        PG8_WAIT_V(4); PG8_BAR;
        PG8_STAGE(PG8_SB(1, 0), cB + kstep, voffB); PG8_STAGE(PG8_SA(1, 0), cA + kstep, voffA); PG8_STAGE(PG8_SB(1, 1), cB + hstep + kstep, voffB);
        PG8_WAIT_V(6); PG8_BAR;
    }
    for (;;) {
        const bool has_next = S.next(ui + 1, nxt);
        const char* nA = has_next ? (const char*)g.A + (size_t)nxt.pm * tstep : cA; const char* nB = has_next ? (const char*)g.Bt + (size_t)nxt.pn * tstep : cB;
        for (int t = 0; t < nt; t += 2) {
            const bool last = (t == nt - 2);
            const char* a1 = cA + (size_t)(t + 1) * kstep;
            const char* a2 = last ? nA : cA + (size_t)(t + 2) * kstep; const char* b2 = last ? nB : cB + (size_t)(t + 2) * kstep;
            const char* a3 = a2 + kstep; const char* b3 = b2 + kstep;
            if (last && has_next) S.a_ready(nxt);
            if constexpr (SP2) {
            PG8_LDB(B0, 0, 0); PG8_LDB(B1, 0, 1); PG8_SCHED; PG8_LDA(At, 0, 0); PG8_STAGE(PG8_SA(1, 1), a1 + hstep, voffA);
            PG8_WAIT_V(8); PG8_WAIT_L(0); PG8_BAR; PG8_MMA(0, 0, At, B0); PG8_MMA(0, 1, At, B1); PG8_BAR; PG8_SCHED;
            PG8_LDA(At, 0, 1); PG8_STAGE(PG8_SB(0, 0), b2, voffB); PG8_STAGE(PG8_SB(0, 1), b2 + hstep, voffB); PG8_STAGE(PG8_SA(0, 0), a2, voffA);
            PG8_WAIT_V(8); PG8_WAIT_L(0); PG8_BAR; PG8_MMA(1, 0, At, B0); PG8_MMA(1, 1, At, B1); PG8_BAR; PG8_SCHED;
            PG8_LDB(B0, 1, 0); PG8_LDB(B1, 1, 1); PG8_SCHED; PG8_LDA(At, 1, 0); PG8_STAGE(PG8_SA(0, 1), a2 + hstep, voffA);
            PG8_WAIT_V(8); PG8_WAIT_L(0); PG8_BAR; PG8_MMA(0, 0, At, B0); PG8_MMA(0, 1, At, B1); PG8_BAR; PG8_SCHED;
            PG8_LDA(At, 1, 1); PG8_STAGE(PG8_SB(1, 0), b3, voffB); PG8_STAGE(PG8_SB(1, 1), b3 + hstep, voffB); PG8_STAGE(PG8_SA(1, 0), a3, voffA);
            PG8_WAIT_V(8); PG8_WAIT_L(0); PG8_BAR; PG8_MMA(1, 0, At, B0); PG8_MMA(1, 1, At, B1); PG8_BAR; PG8_SCHED;
            } else {
            PG8_LDB(B0, 0, 0); PG8_SCHED; PG8_LDA(At, 0, 0); PG8_STAGE(PG8_SA(1, 1), a1 + hstep, voffA);
            PG8_WAIT_L(8); PG8_BAR; PG8_WAIT_L(0); PG8_MMA(0, 0, At, B0); PG8_BAR; PG8_SCHED;
            PG8_LDB(B1, 0, 1); PG8_STAGE(PG8_SB(0, 0), b2, voffB);
            PG8_BAR; PG8_WAIT_L(0); PG8_MMA(0, 1, At, B1); PG8_BAR;
            PG8_LDA(At, 0, 1); PG8_STAGE(PG8_SA(0, 0), a2, voffA);
            PG8_BAR; PG8_WAIT_L(0); PG8_MMA(1, 0, At, B0); PG8_BAR; PG8_SCHED;
            PG8_STAGE(PG8_SB(0, 1), b2 + hstep, voffB);
            PG8_WAIT_V(6); PG8_BAR; PG8_MMA(1, 1, At, B1); PG8_BAR;
            PG8_LDB(B0, 1, 0); PG8_SCHED; PG8_LDA(At, 1, 0); PG8_STAGE(PG8_SA(0, 1), a2 + hstep, voffA);
            PG8_WAIT_L(8); PG8_BAR; PG8_WAIT_L(0); PG8_MMA(0, 0, At, B0); PG8_BAR; PG8_SCHED;
            PG8_LDB(B1, 1, 1); PG8_STAGE(PG8_SB(1, 0), b3, voffB);
            PG8_BAR; PG8_WAIT_L(0); PG8_MMA(0, 1, At, B1); PG8_BAR;
            PG8_LDA(At, 1, 1); PG8_STAGE(PG8_SA(1, 0), a3, voffA);
            PG8_BAR; PG8_WAIT_L(0); PG8_MMA(1, 0, At, B0); PG8_BAR; PG8_SCHED;
            PG8_STAGE(PG8_SB(1, 1), b3 + hstep, voffB);
            PG8_WAIT_V(6); PG8_BAR; PG8_MMA(1, 1, At, B1); PG8_BAR;
            }
        }
        if constexpr (ALIGN_EPI) { if (wr == 0) PG8_BAR; }
        if constexpr (!Epi::AFTER_DRAIN) { E(acc, cur, wr, wc, fr, fq); S.done(cur); }
        if (!has_next) break;
#pragma unroll
        for (int a = 0; a < 2; ++a)
#pragma unroll
            for (int b = 0; b < 2; ++b)
#pragma unroll
                for (int m = 0; m < 4; ++m)
#pragma unroll
                    for (int n = 0; n < 2; ++n) acc[a][b][m][n] = (f32x4){0.f, 0.f, 0.f, 0.f};
        cur = nxt; cA = nA; cB = nB; ++ui;
        if constexpr (ALIGN_EPI) { if (wr == 1) PG8_BAR; }
    }
    PG8_WAIT_V(0);
    if constexpr (!ALIGN_EPI) { if (wr == 0) PG8_BAR; }
    PG8_BAR;
    if constexpr (Epi::AFTER_DRAIN) { E.fused(acc, cur, wr, wc, fr, fq, lds, wid, lane); S.done(cur); }
#undef PG8_SA
#undef PG8_SB
#undef PG8_STAGE
#undef PG8_LDA
#undef PG8_LDB
#undef PG8_MMA
#undef PG8_WAIT_V
#undef PG8_WAIT_L
#undef PG8_BAR
#undef PG8_SCHED
}
}
#define XB_TMO      128
#define XB_XCNT(j)  (256  + 64 * (j))
#define XB_XSUB(j)  (1280 + 64 * (j))
#define XB_XGEN(j)  (2304 + 64 * (j))
#define XB_TOP      3328
#define XB_TOPGEN   3392
#define XCD_BAR_WORDS 3456
#define XB_SPIN_CAP (1u << 18)

__device__ __forceinline__ unsigned xb_ld(unsigned* p)              { return __hip_atomic_load(p, __ATOMIC_RELAXED, __HIP_MEMORY_SCOPE_AGENT); }
__device__ __forceinline__ unsigned xb_add(unsigned* p, unsigned v) { return __hip_atomic_fetch_add(p, v, __ATOMIC_RELAXED, __HIP_MEMORY_SCOPE_AGENT); }
__device__ __forceinline__ unsigned xb_xcc_id() { return (unsigned)__builtin_amdgcn_s_getreg((3 << 11) | 20) & 0xFu; }
#define XB_SPIN(cond, bar) do { unsigned _sp = 0; while (cond) { __builtin_amdgcn_s_sleep(1); \
    if ((++_sp & 255u) == 0u) { if (xb_ld(&(bar)[XB_TMO])) break; if (_sp > XB_SPIN_CAP) { atomicAdd(&(bar)[XB_TMO], 1u); break; } } } } while (0)

struct XcdBarrier {
    unsigned* bar; unsigned x;
    volatile LAS unsigned* st;
};

__device__ __forceinline__ XcdBarrier xcd_barrier_post(unsigned* bar, volatile LAS unsigned* st) {
    XcdBarrier b; b.bar = bar; b.x = xb_xcc_id(); b.st = st;
    if (threadIdx.x == 0) (void)xb_add(&bar[XB_XCNT(b.x)], 1u);
    return b;
}
__device__ __forceinline__ void xcd_barrier_complete(unsigned* bar, unsigned x, unsigned& nloc, unsigned& nx) {
    const unsigned G = gridDim.x * gridDim.y * gridDim.z;
    unsigned sum, cnt, mine, sp = 0u;
    for (;;) {
        sum = 0u; cnt = 0u; mine = 0u;
#pragma unroll
        for (unsigned j = 0; j < 16; ++j) { const unsigned c = xb_ld(&bar[XB_XCNT(j)]); sum += c; cnt += (c > 0u) ? 1u : 0u; mine = (j == x) ? c : mine; }
        if (sum == G) break;
        __builtin_amdgcn_s_sleep(1);
        if ((++sp & 255u) == 0u) { if (xb_ld(&bar[XB_TMO])) break; if (sp > XB_SPIN_CAP) { atomicAdd(&bar[XB_TMO], 1u); break; } }
    }
    nloc = mine > 0u ? mine : 1u; nx = cnt > 0u ? cnt : 1u;
}

__device__ __forceinline__ void xcd_barrier(const XcdBarrier& b) {
    asm volatile("s_waitcnt vmcnt(0)" ::: "memory");
    __syncthreads();
    if (threadIdx.x == 0) {
        unsigned* bar = b.bar;
        __builtin_amdgcn_s_waitcnt(0);
        unsigned nloc = b.st[0], nx = b.st[1];
        if (nloc == 0u) { xcd_barrier_complete(bar, b.x, nloc, nx); b.st[0] = nloc; b.st[1] = nx; }
        const unsigned old = xb_add(&bar[XB_XSUB(b.x)], 1u);
        const unsigned gen = old / nloc;
        if (old + 1u == (gen + 1u) * nloc) {
            __builtin_amdgcn_fence(__ATOMIC_RELEASE, "agent");
            asm volatile("s_waitcnt vmcnt(0)" ::: "memory");
            const unsigned og = xb_add(&bar[XB_TOP], 1u);
            const unsigned tg = og / nx;
            if (og + 1u == (tg + 1u) * nx) xb_add(&bar[XB_TOPGEN], 1u);
            else XB_SPIN(xb_ld(&bar[XB_TOPGEN]) == tg, bar);
            __builtin_amdgcn_fence(__ATOMIC_ACQUIRE, "agent");
            xb_add(&bar[XB_XGEN(b.x)], 1u);
            asm volatile("s_waitcnt vmcnt(0)" ::: "memory");
        } else {
            XB_SPIN(xb_ld(&bar[XB_XGEN(b.x)]) == gen, bar);
            __builtin_amdgcn_fence(__ATOMIC_ACQUIRE, "agent");
            asm volatile("s_waitcnt vmcnt(0)" ::: "memory");
        }
    }
    __syncthreads();
}
#define GAS __attribute__((address_space(1)))
#ifndef LAS
#define LAS __attribute__((address_space(3)))
#endif
typedef unsigned short bf16;
typedef unsigned v4u __attribute__((ext_vector_type(4)));
typedef float f32x4 __attribute__((ext_vector_type(4)));
#define LDS_WAIT() asm volatile("s_waitcnt lgkmcnt(0)" ::: "memory")
#define VM_WAIT() asm volatile("s_waitcnt vmcnt(0)" ::: "memory")

constexpr int D = 1024, NB = 8, T = 2048, MP = NB * T, NSMP = 32, MT = MP + NSMP, MPAD = 16640;
constexpr int ATT_W = 512, AH = 8, IH = 16, IDD = 64, TOPK = 256;
constexpr int RW_W = 512, RH = 8, RN = 64;
constexpr int RW_COLS = 1792, IN_COLS = 4432, NIN = 4608;
constexpr int FFN = 2816, NGU = 2 * FFN;
constexpr int NPAGES = 64, PAGE = 128, PAST = 8192, LS = PAST + 1, SCS_LD = 8704;
constexpr int O_Q = 0, O_K = 512, O_V = 1024, O_QI = 1536, O_KI = 2560, O_WI = 2624, O_RW = 2640;
constexpr float IDX_W_SCALE = 0.03125f;
constexpr float RMS_EPS = 1e-6f, GN_EPS = 64e-5f;
constexpr int MODW = 6 * D;

constexpr size_t OUT_Y = 0, OUT_YS = OUT_Y + (size_t)MP * D, OUT_KP = OUT_YS + (size_t)NSMP * D, OUT_VP = OUT_KP + (size_t)MP * ATT_W,
                 OUT_IKP = OUT_VP + (size_t)MP * ATT_W, OUT_WKVP = OUT_IKP + (size_t)MP * IDD, OUT_SHP = OUT_WKVP + (size_t)NB * RH * RN * RN,
                 OUT_KS = OUT_SHP + (size_t)NB * RW_COLS, OUT_VS = OUT_KS + (size_t)NSMP * ATT_W, OUT_IKS = OUT_VS + (size_t)NSMP * ATT_W,
                 OUT_WKVS = OUT_IKS + (size_t)NSMP * IDD, OUT_SHS = OUT_WKVS + (size_t)NSMP * RH * RN * RN, OUT_END = OUT_SHS + (size_t)NSMP * RW_COLS;
static_assert(OUT_END == 36052992, "output size");

constexpr size_t MiB = 1u << 20;
constexpr size_t WS_CTL = 0, CTL_ZERO_BYTES = 1 * MiB;
constexpr size_t WS_MOD = 1 * MiB;
constexpr size_t WS_WIN = 2 * MiB;
constexpr size_t WS_WOUT = 12 * MiB;
constexpr size_t WS_WGU = 14 * MiB;
constexpr size_t WS_WDN = 26 * MiB;
constexpr size_t WS_A1 = 32 * MiB;
constexpr size_t WS_A2 = 66 * MiB;
constexpr size_t WS_MIX = 100 * MiB;
constexpr size_t WS_HB = 134 * MiB;
constexpr size_t WS_X1 = 224 * MiB;
constexpr size_t WS_PROJ = 290 * MiB;
constexpr size_t WS_RAW = 584 * MiB;
constexpr size_t WS_RAW2 = 650 * MiB;
constexpr size_t WS_QN = 1008 * MiB;
constexpr size_t WS_RWA = 1042 * MiB, RWA_STRIDE = 33 * MiB;
constexpr size_t WS_Y = 1273 * MiB;
constexpr size_t WS_SC = 1306 * MiB;
constexpr size_t WS_SCS = 1434 * MiB;
constexpr size_t WS_MASK = 1436 * MiB;
constexpr size_t WS_SLIST = 1440 * MiB;
constexpr size_t WS_END = 1441 * MiB;
constexpr int CW_BAR = 4096;

constexpr int NWAVES = 8, NTHREADS = 512;
constexpr int LDS_BYTES = 147456, MISC_OFF = 131072 + 320;

__device__ __forceinline__ unsigned f2bf(float f) { unsigned u = __builtin_bit_cast(unsigned, f); return (u + 0x7fffu + ((u >> 16) & 1u)) >> 16; }
__device__ __forceinline__ unsigned pk2(float lo, float hi) { return f2bf(lo) | (f2bf(hi) << 16); }
__device__ __forceinline__ float wave_sum(float v) {
#pragma unroll
    for (int o = 1; o < 64; o <<= 1) v += __shfl_xor(v, o);
    return v;
}
__device__ __forceinline__ float wave_max(float v) {
#pragma unroll
    for (int o = 1; o < 64; o <<= 1) v = fmaxf(v, __shfl_xor(v, o));
    return v;
}
__device__ __forceinline__ int wave_sum_i(int v) {
#pragma unroll
    for (int o = 1; o < 64; o <<= 1) v += __shfl_xor(v, o);
    return v;
}
__device__ __forceinline__ float sigmoidf_(float x) { return 1.f / (1.f + expf(-x)); }
__device__ __forceinline__ unsigned sortable(float f) { const unsigned u = __builtin_bit_cast(unsigned, f); return (u & 0x80000000u) ? ~u : (u | 0x80000000u); }
__device__ __forceinline__ unsigned long long lanemask_lt(int lane) { return (1ull << lane) - 1ull; }
__device__ __forceinline__ float rdlane(float v, int l) { return __builtin_bit_cast(float, __builtin_amdgcn_readlane(__builtin_bit_cast(int, v), l)); }

struct Args { const float* in[32]; float* out; unsigned char* ws; int ph_lo, ph_hi; };

struct Ctx {
    LAS unsigned char* lds;
    int tid, lane, wave, G, gw, ngw;
    const float* in[32]; float* out; unsigned char* ws;
};
__device__ __forceinline__ const float* x_row(const Ctx& C, int m) { return m < MP ? C.in[0] + (size_t)m * D : C.in[1] + (size_t)(m - MP) * D; }
__device__ __forceinline__ int mod_row(int m) { return m < MP ? (m >> 11) : NB + (m - MP); }

struct EpiRawF32 {
    static constexpr bool PERM = false, AFTER_DRAIN = false;
    float* O; int ldc;
    __device__ __forceinline__ void operator()(const pg8::f32x4 (&acc)[2][2][4][2], const pg8::Unit& u, int wr, int wc, int fr, int fq) const {
        const int row0 = u.pm * 256 + wr * 64 + fr, col0 = u.pn * 256 + wc * 32 + 4 * fq;
#pragma unroll
        for (int ai = 0; ai < 2; ++ai)
#pragma unroll
            for (int m = 0; m < 4; ++m) { float* rowp = O + (size_t)(row0 + ai * 128 + m * 16) * ldc + col0;
#pragma unroll
                for (int bj = 0; bj < 2; ++bj)
#pragma unroll
                    for (int n = 0; n < 2; ++n) *(pg8::f32x4*)(rowp + bj * 128 + n * 16) = acc[ai][bj][m][n]; }
    }
};

__device__ __forceinline__ void p0_mod(const Ctx& C) {
    LAS float* sc = (LAS float*)C.lds;
    const float* cp = C.in[8]; const float* cs = C.in[9]; const float* wada = C.in[12]; const float* bada = C.in[13];
    float* MOD = (float*)(C.ws + WS_MOD);
    const int cl = C.tid & 31, kc = C.tid >> 5;
    for (int u = blockIdx.x; u < MODW / 32; u += C.G) {
        const int c0 = 32 * u;
        float acc[40];
#pragma unroll
        for (int r = 0; r < 40; ++r) acc[r] = 0.f;
        for (int hh = 0; hh < 2; ++hh) {
            __syncthreads();
            for (int i = C.tid; i < 40 * 512; i += NTHREADS) { const int r = i >> 9, kk = i & 511; const float v = (r < NB) ? cp[r * D + 512 * hh + kk] : cs[(r - NB) * D + 512 * hh + kk]; sc[i] = v / (1.f + expf(-v)); }
            __syncthreads();
            const int kb = 512 * hh + 32 * kc;
            for (int k4 = 0; k4 < 8; ++k4) {
                const float* wp = wada + (size_t)(kb + 4 * k4) * MODW + c0 + cl;
                const float w0 = wp[0], w1 = wp[MODW], w2 = wp[2 * MODW], w3 = wp[3 * MODW];
#pragma unroll
                for (int r = 0; r < 40; ++r) { const f32x4 s = *(const LAS f32x4*)(sc + r * 512 + 32 * kc + 4 * k4); acc[r] += s.x * w0 + s.y * w1 + s.z * w2 + s.w * w3; }
            }
        }
        __syncthreads();
#pragma unroll
        for (int r = 0; r < 40; ++r) sc[(kc * 40 + r) * 32 + cl] = acc[r];
        __syncthreads();
        for (int i = C.tid; i < 40 * 32; i += NTHREADS) { const int r = i >> 5, c = i & 31; float s = 0.f;
            for (int k = 0; k < 16; ++k) s += sc[(k * 40 + r) * 32 + c];
            MOD[r * MODW + c0 + c] = s + bada[c0 + c]; }
    }
    __syncthreads();
}
__device__ __forceinline__ void transpose_item(const float* W, int K, int N, int NP, bf16* WT, int row_off, LAS float* scr, int item, int lane) {
    const int nblk = NP / 32, kb = item / nblk, nb = item % nblk, k0 = 64 * kb, n0 = 32 * nb;
    const int nsrc = n0 + (lane & 31);
#pragma unroll 8
    for (int i = 0; i < 32; ++i) { const int kk = 2 * i + (lane >> 5); scr[kk * 33 + (lane & 31)] = (nsrc < N) ? W[(size_t)(k0 + kk) * N + nsrc] : 0.f; }
    LDS_WAIT(); asm volatile("" ::: "memory");
    const int c = lane & 7;
#pragma unroll
    for (int j = 0; j < 4; ++j) { const int n = (lane >> 3) + 8 * j; const LAS float* s = scr + (8 * c) * 33 + n;
        v4u o; o.x = pk2(s[0 * 33], s[1 * 33]); o.y = pk2(s[2 * 33], s[3 * 33]); o.z = pk2(s[4 * 33], s[5 * 33]); o.w = pk2(s[6 * 33], s[7 * 33]);
        *(GAS v4u*)(WT + (size_t)(row_off + n0 + n) * K + k0 + 8 * c) = o; }
    LDS_WAIT(); asm volatile("" ::: "memory");
}
__device__ __forceinline__ void p0_weights(const Ctx& C) {
    LAS float* scr = (LAS float*)(C.lds + C.wave * 16384);
    constexpr int I_IN = (D / 64) * (NIN / 32), I_OUT = (D / 64) * (D / 32), I_G = (D / 64) * (FFN / 32), I_DN = (FFN / 64) * (D / 32);
    constexpr int NITEMS = I_IN + I_OUT + 2 * I_G + I_DN;
    bf16* WIN = (bf16*)(C.ws + WS_WIN); bf16* WOUT = (bf16*)(C.ws + WS_WOUT); bf16* WGU = (bf16*)(C.ws + WS_WGU); bf16* WDN = (bf16*)(C.ws + WS_WDN);
    for (int it = C.gw; it < NITEMS; it += C.ngw) {
        int r = it;
        if (r < I_IN) { transpose_item(C.in[14], D, IN_COLS, NIN, WIN, 0, scr, r, C.lane); continue; } r -= I_IN;
        if (r < I_OUT) { transpose_item(C.in[28], D, D, D, WOUT, 0, scr, r, C.lane); continue; } r -= I_OUT;
        if (r < I_G) { transpose_item(C.in[29], D, FFN, FFN, WGU, 0, scr, r, C.lane); continue; } r -= I_G;
        if (r < I_G) { transpose_item(C.in[30], D, FFN, FFN, WGU, FFN, scr, r, C.lane); continue; } r -= I_G;
        transpose_item(C.in[31], FFN, D, D, WDN, 0, scr, r, C.lane);
    }
}
__device__ __forceinline__ void norm_mod_row(const Ctx& C, int m, const float* xr, const float* g, const float* shift, const float* scale, bf16* orow) {
    const GAS f32x4* xp = (const GAS f32x4*)xr + C.lane;
    f32x4 v[4]; float s = 0.f;
#pragma unroll
    for (int j = 0; j < 4; ++j) { v[j] = xp[64 * j]; s += (v[j].x * v[j].x + v[j].y * v[j].y) + (v[j].z * v[j].z + v[j].w * v[j].w); }
    const float rstd = 1.f / sqrtf(wave_sum(s) * (1.f / D) + RMS_EPS);
    GAS unsigned long long* o8 = (GAS unsigned long long*)orow + C.lane;
#pragma unroll
    for (int j = 0; j < 4; ++j) { const int c = 4 * (C.lane + 64 * j);
        const f32x4 gg = *(const f32x4*)(g + c), sh = *(const f32x4*)(shift + c), sc = *(const f32x4*)(scale + c);
        const f32x4 h = v[j] * rstd * gg * (1.f + sc) + sh;
        o8[64 * j] = (unsigned long long)pk2(h.x, h.y) | ((unsigned long long)pk2(h.z, h.w) << 32); }
}
__device__ __forceinline__ void p1_norm1(const Ctx& C) {
    bf16* A1 = (bf16*)(C.ws + WS_A1); const float* MOD = (const float*)(C.ws + WS_MOD);
    for (int m = C.gw; m < MPAD; m += C.ngw) {
        bf16* orow = A1 + (size_t)m * D;
        if (m >= MT) { GAS unsigned long long* o8 = (GAS unsigned long long*)orow + C.lane;
#pragma unroll
            for (int j = 0; j < 4; ++j) o8[64 * j] = 0ull;
            continue; }
        const float* md = MOD + mod_row(m) * MODW;
        norm_mod_row(C, m, x_row(C, m), C.in[10], md, md + D, orow);
    }
}
__device__ __forceinline__ void p3_post(const Ctx& C) {
    const float* PROJ = (const float*)(C.ws + WS_PROJ); float* QN = (float*)(C.ws + WS_QN);
    const int lane = C.lane;
    const float qg = C.in[15][lane], kg = C.in[16][lane];
    for (int m = C.gw; m < MT; m += C.ngw) {
        const float* p = PROJ + (size_t)m * NIN;
        const bool smp = m >= MP; const int j = m - MP;
        float* ko = C.out + (smp ? OUT_KS + (size_t)j * ATT_W : OUT_KP + (size_t)m * ATT_W);
        float* vo = C.out + (smp ? OUT_VS + (size_t)j * ATT_W : OUT_VP + (size_t)m * ATT_W);
        float* io = C.out + (smp ? OUT_IKS + (size_t)j * IDD : OUT_IKP + (size_t)m * IDD);
        float* qn = QN + (size_t)m * ATT_W;
        for (int h = 0; h < AH; ++h) {
            const float q = p[O_Q + h * 64 + lane], k = p[O_K + h * 64 + lane];
            const float sq = wave_sum(q * q), sk = wave_sum(k * k);
            qn[h * 64 + lane] = q * (1.f / sqrtf(sq * (1.f / 64.f) + RMS_EPS)) * qg;
            ko[h * 64 + lane] = k * (1.f / sqrtf(sk * (1.f / 64.f) + RMS_EPS)) * kg;
            vo[h * 64 + lane] = p[O_V + h * 64 + lane];
        }
        const float ki = p[O_KI + lane];
        io[lane] = ki * (1.f / sqrtf(wave_sum(ki * ki) * (1.f / 64.f) + RMS_EPS));
        if (smp || (m & (T - 1)) == T - 1) {
            float* so = C.out + (smp ? OUT_SHS + (size_t)j * RW_COLS : OUT_SHP + (size_t)(m >> 11) * RW_COLS);
            for (int i = 0; i < RW_COLS / 64; ++i) so[i * 64 + lane] = p[O_RW + i * 64 + lane];
        }
    }
}
__device__ __forceinline__ void p3_rwprep(const Ctx& C) {
    const float* PROJ = (const float*)(C.ws + WS_PROJ);
    float* Rr = (float*)(C.ws + WS_RWA), *Wd = (float*)(C.ws + WS_RWA + RWA_STRIDE), *Kp = (float*)(C.ws + WS_RWA + 2 * RWA_STRIDE), *Vv = (float*)(C.ws + WS_RWA + 3 * RWA_STRIDE),
          *KK = (float*)(C.ws + WS_RWA + 4 * RWA_STRIDE), *Bb = (float*)(C.ws + WS_RWA + 5 * RWA_STRIDE), *Gg = (float*)(C.ws + WS_RWA + 6 * RWA_STRIDE);
    const float* mu = C.in[17]; const float* w0 = C.in[18]; const float* w2 = C.in[19]; const float* a0 = C.in[20]; const float* a2 = C.in[21]; const float* g2 = C.in[22];
    const float* k_k = C.in[23]; const float* k_a = C.in[24];
    LAS float* lw = (LAS float*)(C.lds + C.wave * 1024);
    const int lane = C.lane;
    for (int m = C.gw; m < MT; m += C.ngw) {
        const float* p = PROJ + (size_t)m * NIN + O_RW;
        const bool smp = m >= MP; const int j = m - MP; const int t = m & (T - 1);
        const float* pv = smp ? C.in[6] + (size_t)j * RW_COLS : (t == 0 ? nullptr : p - NIN);
#define XM(c) ({ const int c_ = (c); const float cur_ = p[c_]; const float prv_ = pv ? pv[c_] : 0.f; cur_ + (prv_ - cur_) * mu[c_]; })
        lw[lane] = tanhf(XM(1536 + lane)); lw[64 + lane] = XM(1600 + lane); lw[128 + lane] = sigmoidf_(XM(1664 + lane)); lw[192 + lane] = sigmoidf_(XM(1728 + lane));
        LDS_WAIT(); asm volatile("" ::: "memory");
        for (int h = 0; h < RH; ++h) {
            const int c = h * 64 + lane;
            float aw = w0[c], aa = a0[c], ag = 0.f;
            for (int jj = 0; jj < 64; ++jj) { aw += lw[jj] * w2[jj * RW_W + c]; aa += lw[64 + jj] * a2[jj * RW_W + c]; }
            for (int jj = 0; jj < 128; ++jj) ag += lw[128 + jj] * g2[jj * RW_W + c];
            const float decay = expf(-0.6065306597126334f * sigmoidf_(aw));
            const float a = sigmoidf_(aa);
            const float r = XM(c), k = XM(512 + c), v = XM(1024 + c);
            float kk = k * k_k[c]; const float nrm = wave_sum(kk * kk); kk *= 1.f / sqrtf(fmaxf(nrm, 1e-24f));
            const float kp = k * (1.f + (a - 1.f) * k_a[c]);
            const size_t o = (size_t)m * RW_W + c;
            Rr[o] = r; Wd[o] = decay; Kp[o] = kp; Vv[o] = v; KK[o] = kk; Bb[o] = kk * a; Gg[o] = ag;
        }
#undef XM
        LDS_WAIT(); asm volatile("" ::: "memory");
    }
}
__device__ __forceinline__ float idx_score(const float (&kr)[64], const LAS float* ql, const LAS float* wl) {
    float score = 0.f;
    for (int h = 0; h < IH; ++h) {
        float d = 0.f;
#pragma unroll
        for (int dd = 0; dd < 64; dd += 4) { const f32x4 qv = *(const LAS f32x4*)(ql + h * 64 + dd); d += qv.x * kr[dd] + qv.y * kr[dd + 1] + qv.z * kr[dd + 2] + qv.w * kr[dd + 3]; }
        score += wl[h] * fmaxf(d, 0.f);
    }
    return score;
}
__device__ __forceinline__ void p4_indexer(const Ctx& C) {
    const float* PROJ = (const float*)(C.ws + WS_PROJ); float* SC = (float*)(C.ws + WS_SC); float* SCS = (float*)(C.ws + WS_SCS);
    LAS float* ql = (LAS float*)C.lds;
    LAS float* wl = ql + 16 * 1024;
    const int lane = C.lane;
    for (int u = blockIdx.x; u < NB * 128 * 4; u += C.G) {
        const int b = u >> 9, tq = (u >> 2) & 127, scn = u & 3, t0 = tq * 16;
        if (scn * 512 > t0 + 15) continue;
        __syncthreads();
        for (int i = C.tid; i < 16 * 1024; i += NTHREADS) { const int q = i >> 10, e = i & 1023; ql[i] = PROJ[(size_t)(b * T + t0 + q) * NIN + O_QI + e]; }
        if (C.tid < 256) { const int q = C.tid >> 4, h = C.tid & 15; wl[C.tid] = PROJ[(size_t)(b * T + t0 + q) * NIN + O_WI + h] * IDX_W_SCALE; }
        __syncthreads();
        const int s = scn * 512 + C.wave * 64 + lane;
        if (scn * 512 + C.wave * 64 <= t0 + 15) {
            float kr[64];
            const f32x4* kp = (const f32x4*)(C.out + OUT_IKP + (size_t)(b * T + s) * IDD);
#pragma unroll
            for (int i = 0; i < 16; ++i) { const f32x4 v = kp[i]; kr[4 * i] = v.x; kr[4 * i + 1] = v.y; kr[4 * i + 2] = v.z; kr[4 * i + 3] = v.w; }
            for (int q = 0; q < 16; ++q) {
                const float score = idx_score(kr, ql + q * 1024, wl + q * 16);
                const int t = t0 + q;
                if (s <= t) SC[((size_t)b * T + t) * T + s] = score;
            }
        }
    }
    __syncthreads();
    const int* pt = (const int*)C.in[7];
    LAS float* qw = (LAS float*)(C.lds + C.wave * 8192); LAS float* ww = qw + 1024;
    for (int wu = C.gw; wu < NSMP * 129; wu += C.ngw) {
        const int j = wu / 129, kb = wu % 129;
        const float* pq = PROJ + (size_t)(MP + j) * NIN;
        for (int i = 0; i < 16; ++i) qw[i * 64 + lane] = pq[O_QI + i * 64 + lane];
        if (lane < 16) ww[lane] = pq[O_WI + lane] * IDX_W_SCALE;
        LDS_WAIT(); asm volatile("" ::: "memory");
        const int s = kb * 64 + lane;
        const float* krow = nullptr;
        if (s < PAST) krow = C.in[4] + ((size_t)pt[j * NPAGES + (s >> 7)] * PAGE + (s & 127)) * IDD;
        else if (s == PAST) krow = C.out + OUT_IKS + (size_t)j * IDD;
        float score = -INFINITY;
        if (krow) { float kr[64]; const f32x4* kp = (const f32x4*)krow;
#pragma unroll
            for (int i = 0; i < 16; ++i) { const f32x4 v = kp[i]; kr[4 * i] = v.x; kr[4 * i + 1] = v.y; kr[4 * i + 2] = v.z; kr[4 * i + 3] = v.w; }
            score = idx_score(kr, qw, ww); }
        SCS[(size_t)j * SCS_LD + s] = score;
        LDS_WAIT(); asm volatile("" ::: "memory");
    }
}
__device__ __forceinline__ void p4_scan(const Ctx& C) {
    const float* Rr = (const float*)(C.ws + WS_RWA), *Wd = (const float*)(C.ws + WS_RWA + RWA_STRIDE), *Kp = (const float*)(C.ws + WS_RWA + 2 * RWA_STRIDE), *Vv = (const float*)(C.ws + WS_RWA + 3 * RWA_STRIDE),
          *KK = (const float*)(C.ws + WS_RWA + 4 * RWA_STRIDE), *Bb = (const float*)(C.ws + WS_RWA + 5 * RWA_STRIDE);
    float* Y = (float*)(C.ws + WS_Y);
    const int lane = C.lane;
    for (int u = C.gw; u < NB * RH + NSMP * RH; u += C.ngw) {
        const bool smp = u >= NB * RH; const int seq = smp ? (u - NB * RH) / RH : u / RH, h = u % RH;
        const int nsteps = smp ? 1 : T; const size_t base = smp ? (size_t)(MP + seq) : (size_t)seq * T;
        float S[64];
        if (smp) { const f32x4* sp = (const f32x4*)(C.in[5] + (((size_t)seq * RH + h) * RN + lane) * RN);
#pragma unroll
            for (int i = 0; i < 16; ++i) { const f32x4 v = sp[i]; S[4 * i] = v.x; S[4 * i + 1] = v.y; S[4 * i + 2] = v.z; S[4 * i + 3] = v.w; } }
        else {
#pragma unroll
            for (int i = 0; i < 64; ++i) S[i] = 0.f; }
        size_t o = base * RW_W + h * 64 + lane;
        float r = Rr[o], w = Wd[o], k = Kp[o], v = Vv[o], kk = KK[o], bb = Bb[o];
        for (int t = 0; t < nsteps; ++t) {
            float rn = 0.f, wn = 0.f, kn = 0.f, vn = 0.f, kkn = 0.f, bbn = 0.f;
            const size_t on = o + RW_W;
            if (t + 1 < nsteps) { rn = Rr[on]; wn = Wd[on]; kn = Kp[on]; vn = Vv[on]; kkn = KK[on]; bbn = Bb[on]; }
            float sa0 = 0.f, sa1 = 0.f;
#pragma unroll
            for (int jx = 0; jx < 64; jx += 2) { sa0 += S[jx] * rdlane(kk, jx); sa1 += S[jx + 1] * rdlane(kk, jx + 1); }
            const float sa = -(sa0 + sa1);
            float y0 = 0.f, y1 = 0.f;
#pragma unroll
            for (int jx = 0; jx < 64; jx += 2) {
                S[jx] = S[jx] * rdlane(w, jx) + sa * rdlane(bb, jx) + v * rdlane(k, jx); y0 += S[jx] * rdlane(r, jx);
                S[jx + 1] = S[jx + 1] * rdlane(w, jx + 1) + sa * rdlane(bb, jx + 1) + v * rdlane(k, jx + 1); y1 += S[jx + 1] * rdlane(r, jx + 1); }
            Y[o] = y0 + y1;
            o = on; r = rn; w = wn; k = kn; v = vn; kk = kkn; bb = bbn;
        }
        f32x4* so = (f32x4*)(C.out + (smp ? OUT_WKVS : OUT_WKVP) + (((size_t)seq * RH + h) * RN + lane) * RN);
#pragma unroll
        for (int i = 0; i < 16; ++i) so[i] = (f32x4){S[4 * i], S[4 * i + 1], S[4 * i + 2], S[4 * i + 3]};
    }
}
__device__ __forceinline__ void p5_select(const Ctx& C) {
    const float* SC = (const float*)(C.ws + WS_SC); unsigned* MASK = (unsigned*)(C.ws + WS_MASK);
    const int lane = C.lane;
    for (int row = C.gw; row < MP; row += C.ngw) {
        const int t = row & (T - 1); const float* sp = SC + (size_t)row * T;
        unsigned key[32];
#pragma unroll
        for (int j = 0; j < 32; ++j) { const int s = 64 * j + lane; key[j] = (s <= t) ? sortable(sp[s]) : 0u; }
        unsigned Tk = 0u; int need = 0;
        const bool all = (t + 1 <= TOPK);
        if (!all) {
            for (int bit = 31; bit >= 0; --bit) { const unsigned cand = Tk | (1u << bit); int cnt = 0;
#pragma unroll
                for (int j = 0; j < 32; ++j) cnt += __builtin_popcountll(__ballot(key[j] >= cand));
                if (cnt >= TOPK) Tk = cand; }
            int cgt = 0;
#pragma unroll
            for (int j = 0; j < 32; ++j) cgt += __builtin_popcountll(__ballot(key[j] > Tk));
            need = TOPK - cgt;
        }
        int running = 0;
#pragma unroll
        for (int j = 0; j < 32; ++j) {
            const int s = 64 * j + lane; bool take;
            if (all) take = (s <= t);
            else { const bool gt = key[j] > Tk, eq = key[j] == Tk; const unsigned long long eqb = __ballot(eq);
                const int pre = __builtin_popcountll(eqb & lanemask_lt(lane)); take = gt || (eq && (running + pre < need)); running += __builtin_popcountll(eqb); }
            const unsigned long long mb = __ballot(take);
            if (lane == 0) { MASK[(size_t)row * 64 + 2 * j] = (unsigned)mb; MASK[(size_t)row * 64 + 2 * j + 1] = (unsigned)(mb >> 32); }
        }
    }
    const float* SCS = (const float*)(C.ws + WS_SCS); int* SLIST = (int*)(C.ws + WS_SLIST);
    LAS int* sh = (LAS int*)C.lds;
    for (int j = blockIdx.x; j < NSMP; j += C.G) {
        unsigned key[17];
#pragma unroll
        for (int i = 0; i < 17; ++i) { const int s = i * NTHREADS + C.tid; key[i] = (s < LS) ? sortable(SCS[(size_t)j * SCS_LD + s]) : 0u; }
        unsigned Tk = 0u;
        for (int bit = 31; bit >= 0; --bit) { const unsigned cand = Tk | (1u << bit); int c = 0;
#pragma unroll
            for (int i = 0; i < 17; ++i) c += (key[i] >= cand) ? 1 : 0;
            c = wave_sum_i(c);
            __syncthreads(); if (lane == 0) sh[C.wave] = c; __syncthreads();
            int cnt = 0;
#pragma unroll
            for (int w = 0; w < 8; ++w) cnt += sh[w];
            if (cnt >= TOPK) Tk = cand; }
        int cg = 0;
#pragma unroll
        for (int i = 0; i < 17; ++i) cg += (key[i] > Tk) ? 1 : 0;
        cg = wave_sum_i(cg);
        __syncthreads(); if (lane == 0) sh[C.wave] = cg; __syncthreads();
        int cgt = 0;
#pragma unroll
        for (int w = 0; w < 8; ++w) cgt += sh[w];
        const int need = TOPK - cgt;
        int run_eq = 0, run_sel = 0;
#pragma unroll
        for (int i = 0; i < 17; ++i) {
            const int s = i * NTHREADS + C.tid; const bool gt = key[i] > Tk, eq = key[i] == Tk;
            const unsigned long long eqb = __ballot(eq);
            __syncthreads(); if (lane == 0) sh[C.wave] = __builtin_popcountll(eqb); __syncthreads();
            int eq_before = 0, eq_tot = 0;
#pragma unroll
            for (int w = 0; w < 8; ++w) { const int x = sh[w]; eq_tot += x; if (w < C.wave) eq_before += x; }
            const bool take = gt || (eq && (run_eq + eq_before + __builtin_popcountll(eqb & lanemask_lt(lane)) < need));
            const unsigned long long tb = __ballot(take);
            __syncthreads(); if (lane == 0) sh[8 + C.wave] = __builtin_popcountll(tb); __syncthreads();
            int s_before = 0, s_tot = 0;
#pragma unroll
            for (int w = 0; w < 8; ++w) { const int x = sh[8 + w]; s_tot += x; if (w < C.wave) s_before += x; }
            const int pos = run_sel + s_before + __builtin_popcountll(tb & lanemask_lt(lane));
            if (take && pos < TOPK) SLIST[j * TOPK + pos] = s;
            run_eq += eq_tot; run_sel += s_tot;
        }
    }
    __syncthreads();
}
__device__ __forceinline__ void p5_rwfinal(const Ctx& C) {
    const float* Rr = (const float*)(C.ws + WS_RWA), *Kp = (const float*)(C.ws + WS_RWA + 2 * RWA_STRIDE), *Vv = (const float*)(C.ws + WS_RWA + 3 * RWA_STRIDE), *Gg = (const float*)(C.ws + WS_RWA + 6 * RWA_STRIDE);
    const float* Y = (const float*)(C.ws + WS_Y); bf16* MIX = (bf16*)(C.ws + WS_MIX);
    const float* r_k = C.in[25]; const float* ln_w = C.in[26]; const float* ln_b = C.in[27];
    const int lane = C.lane;
    for (int m = C.gw; m < MT; m += C.ngw) {
        for (int h = 0; h < RH; ++h) {
            const int c = h * 64 + lane; const size_t o = (size_t)m * RW_W + c;
            const float y = Y[o];
            const float mu = wave_sum(y) * (1.f / 64.f); const float dy = y - mu; const float var = wave_sum(dy * dy) * (1.f / 64.f);
            const float yn = dy * (1.f / sqrtf(var + GN_EPS)) * ln_w[c] + ln_b[c];
            const float bonus = wave_sum(Rr[o] * Kp[o] * r_k[c]) * Vv[o];
            MIX[(size_t)m * D + ATT_W + c] = (bf16)f2bf((yn + bonus) * Gg[o]);
        }
    }
}
__device__ __forceinline__ void p6_attn(const Ctx& C) {
    const unsigned* MASK = (const unsigned*)(C.ws + WS_MASK); const int* SLIST = (const int*)(C.ws + WS_SLIST); const float* QN = (const float*)(C.ws + WS_QN);
    bf16* MIX = (bf16*)(C.ws + WS_MIX); const int* pt = (const int*)C.in[7];
    LAS int* list = (LAS int*)C.lds;
    LAS float* pb = (LAS float*)(C.lds + 1024);
    LAS int* cntp = (LAS int*)(C.lds + 1024 + 8192);
    const int lane = C.lane, h = C.wave;
    for (int u = blockIdx.x; u < MT; u += C.G) {
        const bool smp = u >= MP; const int j = u - MP, b = u >> 11;
        __syncthreads();
        if (C.wave == 0) {
            if (!smp) { const unsigned w = MASK[(size_t)u * 64 + lane]; const int c = __builtin_popcount(w);
                int incl = c;
#pragma unroll
                for (int o = 1; o < 64; o <<= 1) { const int x = __shfl_up(incl, o); if (lane >= o) incl += x; }
                int pos = incl - c; unsigned ww = w;
                while (ww) { const int bit = __builtin_ctz(ww); ww &= ww - 1u; list[pos++] = 32 * lane + bit; }
                if (lane == 63) *cntp = incl; }
            else { for (int i = 0; i < 4; ++i) list[i * 64 + lane] = SLIST[j * TOPK + i * 64 + lane]; if (lane == 0) *cntp = TOPK; }
        }
        __syncthreads();
        int cnt = *cntp; if (cnt > TOPK) cnt = TOPK;
        float q[64];
        { const f32x4* qp = (const f32x4*)(QN + (size_t)u * ATT_W + h * 64);
#pragma unroll
          for (int i = 0; i < 16; ++i) { const f32x4 v = qp[i]; q[4 * i] = v.x; q[4 * i + 1] = v.y; q[4 * i + 2] = v.z; q[4 * i + 3] = v.w; } }
        float sc[4]; float mx = -INFINITY;
#pragma unroll
        for (int i = 0; i < 4; ++i) { const int idx = i * 64 + lane; sc[i] = -INFINITY;
            if (idx < cnt) { const int s = list[idx]; const float* kp;
                if (!smp) kp = C.out + OUT_KP + ((size_t)(b * T + s)) * ATT_W + h * 64;
                else if (s < PAST) kp = C.in[2] + ((size_t)pt[j * NPAGES + (s >> 7)] * PAGE + (s & 127)) * ATT_W + h * 64;
                else kp = C.out + OUT_KS + (size_t)j * ATT_W + h * 64;
                float d = 0.f;
#pragma unroll
                for (int e = 0; e < 16; ++e) { const f32x4 kv = ((const f32x4*)kp)[e]; d += q[4 * e] * kv.x + q[4 * e + 1] * kv.y + q[4 * e + 2] * kv.z + q[4 * e + 3] * kv.w; }
                sc[i] = d * 0.125f; }
            mx = fmaxf(mx, sc[i]); }
        mx = wave_max(mx); float l = 0.f;
#pragma unroll
        for (int i = 0; i < 4; ++i) { const int idx = i * 64 + lane; const float p = (idx < cnt) ? expf(sc[i] - mx) : 0.f; pb[h * 256 + idx] = p; l += p; }
        l = wave_sum(l);
        LDS_WAIT(); asm volatile("" ::: "memory");
        float o = 0.f;
        for (int kx = 0; kx < cnt; ++kx) { const int s = list[kx]; const float* vp;
            if (!smp) vp = C.out + OUT_VP + ((size_t)(b * T + s)) * ATT_W + h * 64;
            else if (s < PAST) vp = C.in[3] + ((size_t)pt[j * NPAGES + (s >> 7)] * PAGE + (s & 127)) * ATT_W + h * 64;
            else vp = C.out + OUT_VS + (size_t)j * ATT_W + h * 64;
            o += pb[h * 256 + kx] * vp[lane]; }
        MIX[(size_t)u * D + h * 64 + lane] = (bf16)f2bf(o / l);
    }
    __syncthreads();
}
__device__ __forceinline__ void p8_res_norm2(const Ctx& C) {
    const float* RAW = (const float*)(C.ws + WS_RAW); float* X1 = (float*)(C.ws + WS_X1); bf16* A2 = (bf16*)(C.ws + WS_A2); const float* MOD = (const float*)(C.ws + WS_MOD);
    for (int m = C.gw; m < MPAD; m += C.ngw) {
        bf16* orow = A2 + (size_t)m * D;
        if (m >= MT) { GAS unsigned long long* o8 = (GAS unsigned long long*)orow + C.lane;
#pragma unroll
            for (int j = 0; j < 4; ++j) o8[64 * j] = 0ull;
            continue; }
        const float* md = MOD + mod_row(m) * MODW; const float* xr = x_row(C, m);
        float* x1 = X1 + (size_t)m * D;
#pragma unroll
        for (int j = 0; j < 4; ++j) { const int c = 4 * (C.lane + 64 * j);
            const f32x4 xv = *(const f32x4*)(xr + c), rv = *(const f32x4*)(RAW + (size_t)m * D + c), g1 = *(const f32x4*)(md + 2 * D + c);
            *(f32x4*)(x1 + c) = xv + g1 * rv; }
        VM_WAIT(); asm volatile("" ::: "memory");
        norm_mod_row(C, m, x1, C.in[11], md + 3 * D, md + 4 * D, orow);
    }
}
__device__ __forceinline__ void p10_swiglu(const Ctx& C) {
    const float* RAW2 = (const float*)(C.ws + WS_RAW2); bf16* HB = (bf16*)(C.ws + WS_HB);
    const size_t total = (size_t)MPAD * (FFN / 4);
    for (size_t i = (size_t)blockIdx.x * NTHREADS + C.tid; i < total; i += (size_t)C.G * NTHREADS) {
        const size_t m = i / (FFN / 4); const int c = (int)(i % (FFN / 4)) * 4;
        const f32x4 g = *(const f32x4*)(RAW2 + m * NGU + c), u = *(const f32x4*)(RAW2 + m * NGU + FFN + c);
        const float h0 = g.x / (1.f + expf(-g.x)) * u.x, h1 = g.y / (1.f + expf(-g.y)) * u.y, h2 = g.z / (1.f + expf(-g.z)) * u.z, h3 = g.w / (1.f + expf(-g.w)) * u.w;
        *(unsigned long long*)(HB + m * FFN + c) = (unsigned long long)pk2(h0, h1) | ((unsigned long long)pk2(h2, h3) << 32);
    }
}
__device__ __forceinline__ void p12_final(const Ctx& C) {
    const float* RAW = (const float*)(C.ws + WS_RAW); const float* X1 = (const float*)(C.ws + WS_X1); const float* MOD = (const float*)(C.ws + WS_MOD);
    for (int m = C.gw; m < MT; m += C.ngw) {
        const float* md = MOD + mod_row(m) * MODW;
        float* yo = C.out + (m < MP ? OUT_Y + (size_t)m * D : OUT_YS + (size_t)(m - MP) * D);
#pragma unroll
        for (int j = 0; j < 4; ++j) { const int c = 4 * (C.lane + 64 * j);
            const f32x4 xv = *(const f32x4*)(X1 + (size_t)m * D + c), rv = *(const f32x4*)(RAW + (size_t)m * D + c), g2 = *(const f32x4*)(md + 5 * D + c);
            *(f32x4*)(yo + c) = xv + g2 * rv; }
    }
}

constexpr int N_PHASES = 13;
__global__ void __launch_bounds__(NTHREADS, 2) fwd(Args args) {
    extern __shared__ __attribute__((aligned(16))) unsigned char lds[];
    Ctx C;
    C.lds = (LAS unsigned char*)lds;
    C.tid = threadIdx.x; C.lane = C.tid & 63; C.wave = __builtin_amdgcn_readfirstlane(C.tid >> 6);
    C.G = gridDim.x; C.gw = blockIdx.x * NWAVES + C.wave; C.ngw = C.G * NWAVES;
#pragma unroll
    for (int i = 0; i < 32; ++i) C.in[i] = args.in[i];
    C.out = args.out; C.ws = args.ws;
    const int lo = args.ph_lo, hi = args.ph_hi;
#define IN(k) (lo <= (k) && (k) < hi)
    if (IN(0)) { p0_mod(C); p0_weights(C); }
    if (IN(1)) { p1_norm1(C); }
    if (IN(2)) {
        pg8::Gemm g{(const pg8::bf16_t*)(C.ws + WS_A1), (const pg8::bf16_t*)(C.ws + WS_WIN), MPAD, NIN, D}; pg8::StaticOrder S; S.init(MPAD, NIN, C.G, (int)blockIdx.x);
        EpiRawF32 E{(float*)(C.ws + WS_PROJ), NIN};
        pg8::gemm_phase<EpiRawF32, pg8::StaticOrder, true, true>(C.lds, g, S, E);
    }
    if (IN(3)) { p3_post(C); p3_rwprep(C); }
    if (IN(4)) { p4_indexer(C); p4_scan(C); }
    if (IN(5)) { p5_select(C); p5_rwfinal(C); }
    if (IN(6)) { p6_attn(C); }
    if (IN(7)) {
        pg8::Gemm g{(const pg8::bf16_t*)(C.ws + WS_MIX), (const pg8::bf16_t*)(C.ws + WS_WOUT), MPAD, D, D}; pg8::StaticOrder S; S.init(MPAD, D, C.G, (int)blockIdx.x);
        EpiRawF32 E{(float*)(C.ws + WS_RAW), D};
        pg8::gemm_phase<EpiRawF32, pg8::StaticOrder, true, true>(C.lds, g, S, E);
    }
    if (IN(8)) { p8_res_norm2(C); }
    if (IN(9)) {
        pg8::Gemm g{(const pg8::bf16_t*)(C.ws + WS_A2), (const pg8::bf16_t*)(C.ws + WS_WGU), MPAD, NGU, D}; pg8::StaticOrder S; S.init(MPAD, NGU, C.G, (int)blockIdx.x);
        EpiRawF32 E{(float*)(C.ws + WS_RAW2), NGU};
        pg8::gemm_phase<EpiRawF32, pg8::StaticOrder, true, true>(C.lds, g, S, E);
    }
    if (IN(10)) { p10_swiglu(C); }
    if (IN(11)) {
        pg8::Gemm g{(const pg8::bf16_t*)(C.ws + WS_HB), (const pg8::bf16_t*)(C.ws + WS_WDN), MPAD, D, FFN}; pg8::StaticOrder S; S.init(MPAD, D, C.G, (int)blockIdx.x);
        EpiRawF32 E{(float*)(C.ws + WS_RAW), D};
        pg8::gemm_phase<EpiRawF32, pg8::StaticOrder, true, true>(C.lds, g, S, E);
    }
    if (IN(12)) { p12_final(C); }
#undef IN
}

extern "C" void kernel_launch(void* const* d_in, const int* in_sizes, int n_in, void* d_out, int out_size, void* d_ws, size_t ws_size, hipStream_t stream) {
    static int grid = 0;
    if (grid == 0) {
        if (n_in != 32 || (size_t)out_size != OUT_END || ws_size < WS_END) { fprintf(stderr, "kernel_launch: unexpected sizes n_in %d out %d ws %zu\n", n_in, out_size, ws_size); grid = -1; return; }
        int dev = 0, cus = 0;
        if (hipGetDevice(&dev) != hipSuccess || hipDeviceGetAttribute(&cus, hipDeviceAttributeMultiprocessorCount, dev) != hipSuccess) { grid = -1; return; }
        if (hipFuncSetAttribute((const void*)fwd, hipFuncAttributeMaxDynamicSharedMemorySize, LDS_BYTES) != hipSuccess) { fprintf(stderr, "kernel_launch: hipFuncSetAttribute failed\n"); grid = -1; return; }
        (void)hipGetLastError();
        grid = cus;
    }
    if (grid < 0) return;
    (void)hipMemsetAsync((char*)d_ws + WS_CTL, 0, CTL_ZERO_BYTES, stream);
    Args a{};
    for (int i = 0; i < 32; ++i) a.in[i] = (const float*)d_in[i];
    a.out = (float*)d_out; a.ws = (unsigned char*)d_ws;
    for (int ph = 0; ph < N_PHASES; ++ph) {
        a.ph_lo = ph; a.ph_hi = ph + 1;
        hipLaunchKernelGGL(fwd, dim3(grid), dim3(NTHREADS), LDS_BYTES, stream, a);
    }
}
```

```cpp
#include <hip/hip_runtime.h>
#include <cstdio>
#include <cstdint>
#include <cmath>
#define LAS __attribute__((address_space(3)))
namespace pg8 {
#define PG8_LAS __attribute__((address_space(3)))
typedef unsigned short bf16_t;
typedef short bf16x8 __attribute__((ext_vector_type(8)));
typedef float f32x4 __attribute__((ext_vector_type(4)));
typedef unsigned u32x4 __attribute__((ext_vector_type(4)));
constexpr int BM = 256, BK = 64, HALF = 128, HTB = HALF * BK * 2  , STAGE_BYTES = 8 * HTB, NXCD = 8, WGM = 8;

__host__ __device__ __forceinline__ int lds_byte(int r, int c) { const int st = (r >> 4) * 2 + (c >> 5), rr = r & 15, cc = c & 31, ob = rr * 64 + cc * 2; return st * 1024 + (ob ^ (((ob >> 9) & 1) << 5)); }
__host__ __device__ __forceinline__ void stage_rc(int b, int& R, int& C) { const int st = b / 1024, sb = b % 1024, swz = sb ^ (((sb >> 9) & 1) << 5); R = (st >> 1) * 16 + swz / 64; C = (st & 1) * 32 + (swz % 64) / 2; }
__host__ __device__ __forceinline__ int perm32(int rho) { const int n = rho >> 4, i = rho & 15; return 8 * (i >> 2) + 4 * n + (i & 3); }

struct Unit { int pm, pn; };
struct Gemm { const bf16_t* A; const bf16_t* Bt; int M, N, K; };

struct StaticOrder {
    int nM, nN, nwg, G, c;
    __host__ __device__ void init(int M, int N, int G_, int c_) { nM = M / BM; nN = N / BM; nwg = nM * nN; G = G_; c = c_; }
    __host__ __device__ bool next(int i, Unit& u) const {
        const long L = (long)i * G + c; if (L >= nwg) return false;
        int wgid = (int)L; { const int q = nwg / NXCD, r = nwg % NXCD, xcd = wgid % NXCD, off = wgid / NXCD; wgid = (xcd < r ? xcd * (q + 1) : r * (q + 1) + (xcd - r) * q) + off; }
        const int nig = WGM * nN, gid = wgid / nig, fm = gid * WGM, gsz = (nM - fm) < WGM ? (nM - fm) : WGM;
        u.pm = fm + ((wgid % nig) % gsz); u.pn = (wgid % nig) / gsz; return true;
    }
    __device__ __forceinline__ void a_ready(const Unit&) const {}
    __device__ __forceinline__ void done(const Unit&) const {}
};

__device__ __forceinline__ unsigned cvt_pk_bf16(float lo, float hi) { unsigned r; asm volatile("v_cvt_pk_bf16_f32 %0, %1, %2" : "=v"(r) : "v"(lo), "v"(hi)); return r; }
typedef float f32x2 __attribute__((ext_vector_type(2)));
__device__ __forceinline__ f32x2 gelu_pk(f32x2 v) {
    const f32x2 av = __builtin_elementwise_abs(v), d = av * 0.2316418882f + 1.0f;
    f32x2 t; t.x = __builtin_amdgcn_rcpf(d.x); t.y = __builtin_amdgcn_rcpf(d.y);
    f32x2 q = t * 0.5307027145f + (-0.7265760135f); q = q * t + 0.7107068705f; q = q * t + (-0.142248368f); q = q * t + 0.127414796f; q = q * t;
    const f32x2 s = (v * v) * (-0.72134752044f);
    f32x2 e; e.x = __builtin_amdgcn_exp2f(s.x); e.y = __builtin_amdgcn_exp2f(s.y);
    const f32x2 m = v * (q * e), r = v - m;
    f32x2 o; o.x = v.x < 0.f ? m.x : r.x; o.y = v.y < 0.f ? m.y : r.y; return o;
}

template <int ACT  > struct EpiBf16 {
    static constexpr bool PERM = true, AFTER_DRAIN = false; static_assert(ACT == 0 || ACT == 1, "EpiBf16: ACT is 0 (none) or 1 (gelu_pk)");
    bf16_t* O; int ldc; const float* bias; int split_cols; size_t split_stride; float scale0;
    __device__ __forceinline__ void operator()(const f32x4 (&acc)[2][2][4][2], const Unit& u, int wr, int wc, int fr, int fq) const {
        const int row0 = u.pm * BM + wr * 64 + fr; int colt = u.pn * BM; bf16_t* base = O;
        float sc = 1.f; if (split_cols) { const int t = colt / split_cols; base += (size_t)t * split_stride; colt -= t * split_cols; if (t == 0) sc = scale0; }
        const int col0 = colt + wc * 32 + 8 * fq, bcol0 = u.pn * BM + wc * 32 + 8 * fq;
        f32x4 bv[2][2];
#pragma unroll
        for (int bj = 0; bj < 2; ++bj)
#pragma unroll
            for (int n = 0; n < 2; ++n) bv[bj][n] = bias ? *(const f32x4*)(bias + bcol0 + bj * HALF + 4 * n) : (f32x4){0.f, 0.f, 0.f, 0.f};
#pragma unroll
        for (int ai = 0; ai < 2; ++ai)
#pragma unroll
            for (int m = 0; m < 4; ++m) { bf16_t* rowp = base + (size_t)(row0 + ai * HALF + m * 16) * ldc + col0;
#pragma unroll
                for (int bj = 0; bj < 2; ++bj) { f32x4 v0 = acc[ai][bj][m][0] + bv[bj][0], v1 = acc[ai][bj][m][1] + bv[bj][1];
                    if (ACT == 1) { f32x2 a = gelu_pk((f32x2){v0[0], v0[1]}), b = gelu_pk((f32x2){v0[2], v0[3]}), c = gelu_pk((f32x2){v1[0], v1[1]}), d = gelu_pk((f32x2){v1[2], v1[3]});
                        v0 = (f32x4){a.x, a.y, b.x, b.y}; v1 = (f32x4){c.x, c.y, d.x, d.y}; }
                    v0 = v0 * sc; v1 = v1 * sc; u32x4 w; w.x = cvt_pk_bf16(v0[0], v0[1]); w.y = cvt_pk_bf16(v0[2], v0[3]); w.z = cvt_pk_bf16(v1[0], v1[1]); w.w = cvt_pk_bf16(v1[2], v1[3]);
                    *(u32x4*)(rowp + bj * HALF) = w; } }
    }
};


template <class Epi, class Sched, bool ALIGN_EPI = false, bool SP2 = false>
__device__ __forceinline__ void gemm_phase(PG8_LAS unsigned char* lds, const Gemm g, const Sched& S, const Epi& E) {
    const int tid = threadIdx.x, wid = __builtin_amdgcn_readfirstlane(tid >> 6), lane = tid & 63, wr = wid >> 2, wc = wid & 3, fr = lane & 15, fq = lane >> 4;
    const int K = g.K, nt = K / BK;
    unsigned voffA[2], voffB[2];
#pragma unroll
    for (int i = 0; i < 2; ++i) { int R, C; stage_rc(tid * 16 + i * 8192, R, C); const int Rb = Epi::PERM ? ((R & ~31) + perm32(R & 31)) : R;
        voffA[i] = (unsigned)(R * K + C) * 2u; voffB[i] = (unsigned)(Rb * K + C) * 2u; }
    const size_t kstep = (size_t)(BK * 2);
    const size_t hstep = (size_t)HALF * K * 2;
    const size_t tstep = 2 * hstep;
    const unsigned ldsw = (unsigned)wid * 1024u;
    const int aoff = lds_byte(wr * 64 + fr, fq * 8), boff = lds_byte(wc * 32 + fr, fq * 8);
#define PG8_SA(b, h) (((b) * 2 + (h)) * HTB)
#define PG8_SB(b, h) ((4 + (b) * 2 + (h)) * HTB)
#define PG8_STAGE(bufoff, gbase, voff) do { _Pragma("unroll") for (int _i = 0; _i < 2; ++_i) \
        __builtin_amdgcn_global_load_lds((const unsigned*)((const char*)(gbase) + (voff)[_i]), (PG8_LAS unsigned*)(lds + (bufoff) + ldsw + _i * 8192), 16, 0, 0); } while (0)
#define PG8_LDA(dst, b, h) do { _Pragma("unroll") for (int m = 0; m < 4; ++m) _Pragma("unroll") for (int k = 0; k < 2; ++k) dst[m][k] = *(const PG8_LAS bf16x8*)(lds + PG8_SA(b, h) + aoff + m * 2048 + k * 1024); } while (0)
#define PG8_LDB(dst, b, h) do { _Pragma("unroll") for (int n = 0; n < 2; ++n) _Pragma("unroll") for (int k = 0; k < 2; ++k) dst[n][k] = *(const PG8_LAS bf16x8*)(lds + PG8_SB(b, h) + boff + n * 2048 + k * 1024); } while (0)
#define PG8_MMA(ai, bj, At, Bt) do { __builtin_amdgcn_s_setprio(1); _Pragma("unroll") for (int m = 0; m < 4; ++m) _Pragma("unroll") for (int n = 0; n < 2; ++n) _Pragma("unroll") for (int k = 0; k < 2; ++k) \
        acc[ai][bj][m][n] = __builtin_amdgcn_mfma_f32_16x16x32_bf16(Bt[n][k], At[m][k], acc[ai][bj][m][n], 0, 0, 0); __builtin_amdgcn_s_setprio(0); } while (0)
#define PG8_WAIT_V(n) asm volatile("s_waitcnt vmcnt(" #n ")" ::: "memory")
#define PG8_WAIT_L(n) asm volatile("s_waitcnt lgkmcnt(" #n ")" ::: "memory")
#define PG8_BAR __builtin_amdgcn_s_barrier()
#define PG8_SCHED __builtin_amdgcn_sched_barrier(0)
    Unit cur, nxt; int ui = 0;
    if (!S.next(0, cur)) return;
    f32x4 acc[2][2][4][2];
#pragma unroll
    for (int a = 0; a < 2; ++a)
#pragma unroll
        for (int b = 0; b < 2; ++b)
#pragma unroll
            for (int m = 0; m < 4; ++m)
#pragma unroll
                for (int n = 0; n < 2; ++n) acc[a][b][m][n] = (f32x4){0.f, 0.f, 0.f, 0.f};
    bf16x8 At[4][2], B0[2][2], B1[2][2];
    const char* cA = (const char*)g.A + (size_t)cur.pm * tstep; const char* cB = (const char*)g.Bt + (size_t)cur.pn * tstep;
    S.a_ready(cur);
    if constexpr (SP2) {
        PG8_STAGE(PG8_SB(0, 0), cB, voffB); PG8_STAGE(PG8_SB(0, 1), cB + hstep, voffB); PG8_STAGE(PG8_SA(0, 0), cA, voffA); PG8_STAGE(PG8_SA(0, 1), cA + hstep, voffA);
        if (wr == 1) PG8_BAR;
        PG8_WAIT_V(2); PG8_BAR;
        PG8_STAGE(PG8_SB(1, 0), cB + kstep, voffB); PG8_STAGE(PG8_SA(1, 0), cA + kstep, voffA); PG8_STAGE(PG8_SB(1, 1), cB + hstep + kstep, voffB);
        PG8_WAIT_V(6); PG8_BAR;
    } else {
        PG8_STAGE(PG8_SB(0, 0), cB, voffB); PG8_STAGE(PG8_SA(0, 0), cA, voffA); PG8_STAGE(PG8_SB(0, 1), cB + hstep, voffB); PG8_STAGE(PG8_SA(0, 1), cA + hstep, voffA);
        if (wr == 1) PG8_BAR;
        PG8_WAIT_V(4); PG8_BAR;
        PG8_STAGE(PG8_SB(1, 0), cB + kstep, voffB); PG8_STAGE(PG8_SA(1, 0), cA + kstep, voffA); PG8_STAGE(PG8_SB(1, 1), cB + hstep + kstep, voffB);
        PG8_WAIT_V(6); PG8_BAR;
    }
    for (;;) {
        const bool has_next = S.next(ui + 1, nxt);
        const char* nA = has_next ? (const char*)g.A + (size_t)nxt.pm * tstep : cA; const char* nB = has_next ? (const char*)g.Bt + (size_t)nxt.pn * tstep : cB;
        for (int t = 0; t < nt; t += 2) {
            const bool last = (t == nt - 2);
            const char* a1 = cA + (size_t)(t + 1) * kstep;
            const char* a2 = last ? nA : cA + (size_t)(t + 2) * kstep; const char* b2 = last ? nB : cB + (size_t)(t + 2) * kstep;
            const char* a3 = a2 + kstep; const char* b3 = b2 + kstep;
            if (last && has_next) S.a_ready(nxt);
            if constexpr (SP2) {
            PG8_LDB(B0, 0, 0); PG8_LDB(B1, 0, 1); PG8_SCHED; PG8_LDA(At, 0, 0); PG8_STAGE(PG8_SA(1, 1), a1 + hstep, voffA);
            PG8_WAIT_V(8); PG8_WAIT_L(0); PG8_BAR; PG8_MMA(0, 0, At, B0); PG8_MMA(0, 1, At, B1); PG8_BAR; PG8_SCHED;
            PG8_LDA(At, 0, 1); PG8_STAGE(PG8_SB(0, 0), b2, voffB); PG8_STAGE(PG8_SB(0, 1), b2 + hstep, voffB); PG8_STAGE(PG8_SA(0, 0), a2, voffA);
            PG8_WAIT_V(8); PG8_WAIT_L(0); PG8_BAR; PG8_MMA(1, 0, At, B0); PG8_MMA(1, 1, At, B1); PG8_BAR; PG8_SCHED;
            PG8_LDB(B0, 1, 0); PG8_LDB(B1, 1, 1); PG8_SCHED; PG8_LDA(At, 1, 0); PG8_STAGE(PG8_SA(0, 1), a2 + hstep, voffA);
            PG8_WAIT_V(8); PG8_WAIT_L(0); PG8_BAR; PG8_MMA(0, 0, At, B0); PG8_MMA(0, 1, At, B1); PG8_BAR; PG8_SCHED;
            PG8_LDA(At, 1, 1); PG8_STAGE(PG8_SB(1, 0), b3, voffB); PG8_STAGE(PG8_SB(1, 1), b3 + hstep, voffB); PG8_STAGE(PG8_SA(1, 0), a3, voffA);
            PG8_WAIT_V(8); PG8_WAIT_L(0); PG8_BAR; PG8_MMA(1, 0, At, B0); PG8_MMA(1, 1, At, B1); PG8_BAR; PG8_SCHED;
            } else {
            PG8_LDB(B0, 0, 0); PG8_SCHED; PG8_LDA(At, 0, 0); PG8_STAGE(PG8_SA(1, 1), a1 + hstep, voffA);
            PG8_WAIT_L(8); PG8_BAR; PG8_WAIT_L(0); PG8_MMA(0, 0, At, B0); PG8_BAR; PG8_SCHED;
            PG8_LDB(B1, 0, 1); PG8_STAGE(PG8_SB(0, 0), b2, voffB);
            PG8_BAR; PG8_WAIT_L(0); PG8_MMA(0, 1, At, B1); PG8_BAR;
            PG8_LDA(At, 0, 1); PG8_STAGE(PG8_SA(0, 0), a2, voffA);
            PG8_BAR; PG8_WAIT_L(0); PG8_MMA(1, 0, At, B0); PG8_BAR; PG8_SCHED;
            PG8_STAGE(PG8_SB(0, 1), b2 + hstep, voffB);
            PG8_WAIT_V(6); PG8_BAR; PG8_MMA(1, 1, At, B1); PG8_BAR;
            PG8_LDB(B0, 1, 0); PG8_SCHED; PG8_LDA(At, 1, 0); PG8_STAGE(PG8_SA(0, 1), a2 + hstep, voffA);
            PG8_WAIT_L(8); PG8_BAR; PG8_WAIT_L(0); PG8_MMA(0, 0, At, B0); PG8_BAR; PG8_SCHED;
            PG8_LDB(B1, 1, 1); PG8_STAGE(PG8_SB(1, 0), b3, voffB);
            PG8_BAR; PG8_WAIT_L(0); PG8_MMA(0, 1, At, B1); PG8_BAR;
            PG8_LDA(At, 1, 1); PG8_STAGE(PG8_SA(1, 0), a3, voffA);
            PG8_BAR; PG8_WAIT_L(0); PG8_MMA(1, 0, At, B0); PG8_BAR; PG8_SCHED;
            PG8_STAGE(PG8_SB(1, 1), b3 + hstep, voffB);
            PG8_WAIT_V(6); PG8_BAR; PG8_MMA(1, 1, At, B1); PG8_BAR;
            }
        }
        if constexpr (ALIGN_EPI) { if (wr == 0) PG8_BAR; }
        if constexpr (!Epi::AFTER_DRAIN) { E(acc, cur, wr, wc, fr, fq); S.done(cur); }
        if (!has_next) break;
#pragma unroll
        for (int a = 0; a < 2; ++a)
#pragma unroll
            for (int b = 0; b < 2; ++b)
#pragma unroll
                for (int m = 0; m < 4; ++m)
#pragma unroll
                    for (int n = 0; n < 2; ++n) acc[a][b][m][n] = (f32x4){0.f, 0.f, 0.f, 0.f};
        cur = nxt; cA = nA; cB = nB; ++ui;
        if constexpr (ALIGN_EPI) { if (wr == 1) PG8_BAR; }
    }
    PG8_WAIT_V(0);
    if constexpr (!ALIGN_EPI) { if (wr == 0) PG8_BAR; }
    PG8_BAR;
    if constexpr (Epi::AFTER_DRAIN) { E.fused(acc, cur, wr, wc, fr, fq, lds, wid, lane); S.done(cur); }
#undef PG8_SA
#undef PG8_SB
#undef PG8_STAGE
#undef PG8_LDA
#undef PG8_LDB
#undef PG8_MMA
#undef PG8_WAIT_V
#undef PG8_WAIT_L
#undef PG8_BAR
#undef PG8_SCHED
}
}
#define XB_TMO      128
#define XB_XCNT(j)  (256  + 64 * (j))
#define XB_XSUB(j)  (1280 + 64 * (j))
#define XB_XGEN(j)  (2304 + 64 * (j))
#define XB_TOP      3328
#define XB_TOPGEN   3392
#define XCD_BAR_WORDS 3456
#define XB_SPIN_CAP (1u << 18)

__device__ __forceinline__ unsigned xb_ld(unsigned* p)              { return __hip_atomic_load(p, __ATOMIC_RELAXED, __HIP_MEMORY_SCOPE_AGENT); }
__device__ __forceinline__ unsigned xb_add(unsigned* p, unsigned v) { return __hip_atomic_fetch_add(p, v, __ATOMIC_RELAXED, __HIP_MEMORY_SCOPE_AGENT); }
__device__ __forceinline__ unsigned xb_xcc_id() { return (unsigned)__builtin_amdgcn_s_getreg((3 << 11) | 20) & 0xFu; }
#define XB_SPIN(cond, bar) do { unsigned _sp = 0; while (cond) { __builtin_amdgcn_s_sleep(1); \
    if ((++_sp & 255u) == 0u) { if (xb_ld(&(bar)[XB_TMO])) break; if (_sp > XB_SPIN_CAP) { atomicAdd(&(bar)[XB_TMO], 1u); break; } } } } while (0)

struct XcdBarrier {
    unsigned* bar; unsigned x;
    volatile LAS unsigned* st;
};

__device__ __forceinline__ XcdBarrier xcd_barrier_post(unsigned* bar, volatile LAS unsigned* st) {
    XcdBarrier b; b.bar = bar; b.x = xb_xcc_id(); b.st = st;
    if (threadIdx.x == 0) (void)xb_add(&bar[XB_XCNT(b.x)], 1u);
    return b;
}
__device__ __forceinline__ void xcd_barrier_complete(unsigned* bar, unsigned x, unsigned& nloc, unsigned& nx) {
    const unsigned G = gridDim.x * gridDim.y * gridDim.z;
    unsigned sum, cnt, mine, sp = 0u;
    for (;;) {
        sum = 0u; cnt = 0u; mine = 0u;
#pragma unroll
        for (unsigned j = 0; j < 16; ++j) { const unsigned c = xb_ld(&bar[XB_XCNT(j)]); sum += c; cnt += (c > 0u) ? 1u : 0u; mine = (j == x) ? c : mine; }
        if (sum == G) break;
        __builtin_amdgcn_s_sleep(1);
        if ((++sp & 255u) == 0u) { if (xb_ld(&bar[XB_TMO])) break; if (sp > XB_SPIN_CAP) { atomicAdd(&bar[XB_TMO], 1u); break; } }
    }
    nloc = mine > 0u ? mine : 1u; nx = cnt > 0u ? cnt : 1u;
}

__device__ __forceinline__ void xcd_barrier(const XcdBarrier& b) {
    asm volatile("s_waitcnt vmcnt(0)" ::: "memory");
    __syncthreads();
    if (threadIdx.x == 0) {
        unsigned* bar = b.bar;
        __builtin_amdgcn_s_waitcnt(0);
        unsigned nloc = b.st[0], nx = b.st[1];
        if (nloc == 0u) { xcd_barrier_complete(bar, b.x, nloc, nx); b.st[0] = nloc; b.st[1] = nx; }
        const unsigned old = xb_add(&bar[XB_XSUB(b.x)], 1u);
        const unsigned gen = old / nloc;
        if (old + 1u == (gen + 1u) * nloc) {
            __builtin_amdgcn_fence(__ATOMIC_RELEASE, "agent");
            asm volatile("s_waitcnt vmcnt(0)" ::: "memory");
            const unsigned og = xb_add(&bar[XB_TOP], 1u);
            const unsigned tg = og / nx;
            if (og + 1u == (tg + 1u) * nx) xb_add(&bar[XB_TOPGEN], 1u);
            else XB_SPIN(xb_ld(&bar[XB_TOPGEN]) == tg, bar);
            __builtin_amdgcn_fence(__ATOMIC_ACQUIRE, "agent");
            xb_add(&bar[XB_XGEN(b.x)], 1u);
            asm volatile("s_waitcnt vmcnt(0)" ::: "memory");
        } else {
            XB_SPIN(xb_ld(&bar[XB_XGEN(b.x)]) == gen, bar);
            __builtin_amdgcn_fence(__ATOMIC_ACQUIRE, "agent");
            asm volatile("s_waitcnt vmcnt(0)" ::: "memory");
        }
    }
    __syncthreads();
}
#define GAS __attribute__((address_space(1)))
#ifndef LAS
#define LAS __attribute__((address_space(3)))
#endif
typedef unsigned short bf16;
typedef unsigned v4u __attribute__((ext_vector_type(4)));
typedef float f32x4 __attribute__((ext_vector_type(4)));
#define LDS_WAIT() asm volatile("s_waitcnt lgkmcnt(0)" ::: "memory")
#define VM_WAIT() asm volatile("s_waitcnt vmcnt(0)" ::: "memory")

constexpr int D = 1024, NB = 8, T = 2048, MP = NB * T, NSMP = 32, MT = MP + NSMP, MPAD = 16640;
constexpr int ATT_W = 512, AH = 8, IH = 16, IDD = 64, TOPK = 256;
constexpr int RW_W = 512, RH = 8, RN = 64;
constexpr int RW_COLS = 1792, IN_COLS = 4432, NIN = 4608;
constexpr int FFN = 2816, NGU = 2 * FFN;
constexpr int NPAGES = 64, PAGE = 128, PAST = 8192, LS = PAST + 1, SCS_LD = 8704;
constexpr int O_Q = 0, O_K = 512, O_V = 1024, O_QI = 1536, O_KI = 2560, O_WI = 2624, O_RW = 2640;
constexpr float IDX_W_SCALE = 0.03125f;
constexpr float RMS_EPS = 1e-6f, GN_EPS = 64e-5f;
constexpr int MODW = 6 * D;

constexpr size_t OUT_Y = 0, OUT_YS = OUT_Y + (size_t)MP * D, OUT_KP = OUT_YS + (size_t)NSMP * D, OUT_VP = OUT_KP + (size_t)MP * ATT_W,
                 OUT_IKP = OUT_VP + (size_t)MP * ATT_W, OUT_WKVP = OUT_IKP + (size_t)MP * IDD, OUT_SHP = OUT_WKVP + (size_t)NB * RH * RN * RN,
                 OUT_KS = OUT_SHP + (size_t)NB * RW_COLS, OUT_VS = OUT_KS + (size_t)NSMP * ATT_W, OUT_IKS = OUT_VS + (size_t)NSMP * ATT_W,
                 OUT_WKVS = OUT_IKS + (size_t)NSMP * IDD, OUT_SHS = OUT_WKVS + (size_t)NSMP * RH * RN * RN, OUT_END = OUT_SHS + (size_t)NSMP * RW_COLS;
static_assert(OUT_END == 36052992, "output size");

constexpr size_t MiB = 1u << 20;
constexpr size_t WS_CTL = 0, CTL_ZERO_BYTES = 1 * MiB;
constexpr size_t WS_MOD = 1 * MiB;
constexpr size_t WS_WIN = 2 * MiB;
constexpr size_t WS_WOUT = 12 * MiB;
constexpr size_t WS_WGU = 14 * MiB;
constexpr size_t WS_WDN = 26 * MiB;
constexpr size_t WS_A1 = 32 * MiB;
constexpr size_t WS_A2 = 66 * MiB;
constexpr size_t WS_MIX = 100 * MiB;
constexpr size_t WS_HB = 134 * MiB;
constexpr size_t WS_X1 = 224 * MiB;
constexpr size_t WS_PROJ = 290 * MiB;
constexpr size_t WS_RAW = 584 * MiB;
constexpr size_t WS_RAW2 = 650 * MiB;
constexpr size_t WS_QN = 1008 * MiB;
constexpr size_t WS_RWA = 1042 * MiB, RWA_STRIDE = 33 * MiB;
constexpr size_t WS_Y = 1273 * MiB;
constexpr size_t WS_SC = 1306 * MiB;
constexpr size_t WS_SCS = 1434 * MiB;
constexpr size_t WS_MASK = 1436 * MiB;
constexpr size_t WS_SLIST = 1440 * MiB;
constexpr size_t WS_END = 1441 * MiB;
constexpr int CW_BAR = 4096;

constexpr int NWAVES = 8, NTHREADS = 512;
constexpr int LDS_BYTES = 147456, MISC_OFF = 131072 + 320;

__device__ __forceinline__ unsigned f2bf(float f) { unsigned u = __builtin_bit_cast(unsigned, f); return (u + 0x7fffu + ((u >> 16) & 1u)) >> 16; }
__device__ __forceinline__ unsigned pk2(float lo, float hi) { return f2bf(lo) | (f2bf(hi) << 16); }
__device__ __forceinline__ float wave_sum(float v) {
#pragma unroll
    for (int o = 1; o < 64; o <<= 1) v += __shfl_xor(v, o);
    return v;
}
__device__ __forceinline__ float wave_max(float v) {
#pragma unroll
    for (int o = 1; o < 64; o <<= 1) v = fmaxf(v, __shfl_xor(v, o));
    return v;
}
__device__ __forceinline__ int wave_sum_i(int v) {
#pragma unroll
    for (int o = 1; o < 64; o <<= 1) v += __shfl_xor(v, o);
    return v;
}
__device__ __forceinline__ float sigmoidf_(float x) { return 1.f / (1.f + expf(-x)); }
__device__ __forceinline__ unsigned sortable(float f) { const unsigned u = __builtin_bit_cast(unsigned, f); return (u & 0x80000000u) ? ~u : (u | 0x80000000u); }
__device__ __forceinline__ unsigned long long lanemask_lt(int lane) { return (1ull << lane) - 1ull; }
__device__ __forceinline__ float rdlane(float v, int l) { return __builtin_bit_cast(float, __builtin_amdgcn_readlane(__builtin_bit_cast(int, v), l)); }

struct Args { const float* in[32]; float* out; unsigned char* ws; int ph_lo, ph_hi; };

struct Ctx {
    LAS unsigned char* lds;
    int tid, lane, wave, G, gw, ngw;
    const float* in[32]; float* out; unsigned char* ws;
};
__device__ __forceinline__ const float* x_row(const Ctx& C, int m) { return m < MP ? C.in[0] + (size_t)m * D : C.in[1] + (size_t)(m - MP) * D; }
__device__ __forceinline__ int mod_row(int m) { return m < MP ? (m >> 11) : NB + (m - MP); }

struct EpiRawF32 {
    static constexpr bool PERM = false, AFTER_DRAIN = false;
    float* O; int ldc;
    __device__ __forceinline__ void operator()(const pg8::f32x4 (&acc)[2][2][4][2], const pg8::Unit& u, int wr, int wc, int fr, int fq) const {
        const int row0 = u.pm * 256 + wr * 64 + fr, col0 = u.pn * 256 + wc * 32 + 4 * fq;
#pragma unroll
        for (int ai = 0; ai < 2; ++ai)
#pragma unroll
            for (int m = 0; m < 4; ++m) { float* rowp = O + (size_t)(row0 + ai * 128 + m * 16) * ldc + col0;
#pragma unroll
                for (int bj = 0; bj < 2; ++bj)
#pragma unroll
                    for (int n = 0; n < 2; ++n) *(pg8::f32x4*)(rowp + bj * 128 + n * 16) = acc[ai][bj][m][n]; }
    }
};

__device__ __forceinline__ void p0_mod(const Ctx& C) {
    LAS float* sc = (LAS float*)C.lds;
    const float* cp = C.in[8]; const float* cs = C.in[9]; const float* wada = C.in[12]; const float* bada = C.in[13];
    float* MOD = (float*)(C.ws + WS_MOD);
    const int cl = C.tid & 31, kc = C.tid >> 5;
    for (int u = blockIdx.x; u < MODW / 32; u += C.G) {
        const int c0 = 32 * u;
        float acc[40];
#pragma unroll
        for (int r = 0; r < 40; ++r) acc[r] = 0.f;
        for (int hh = 0; hh < 2; ++hh) {
            __syncthreads();
            for (int i = C.tid; i < 40 * 512; i += NTHREADS) { const int r = i >> 9, kk = i & 511; const float v = (r < NB) ? cp[r * D + 512 * hh + kk] : cs[(r - NB) * D + 512 * hh + kk]; sc[i] = v / (1.f + expf(-v)); }
            __syncthreads();
            const int kb = 512 * hh + 32 * kc;
            for (int k4 = 0; k4 < 8; ++k4) {
                const float* wp = wada + (size_t)(kb + 4 * k4) * MODW + c0 + cl;
                const float w0 = wp[0], w1 = wp[MODW], w2 = wp[2 * MODW], w3 = wp[3 * MODW];
#pragma unroll
                for (int r = 0; r < 40; ++r) { const f32x4 s = *(const LAS f32x4*)(sc + r * 512 + 32 * kc + 4 * k4); acc[r] += s.x * w0 + s.y * w1 + s.z * w2 + s.w * w3; }
            }
        }
        __syncthreads();
#pragma unroll
        for (int r = 0; r < 40; ++r) sc[(kc * 40 + r) * 32 + cl] = acc[r];
        __syncthreads();
        for (int i = C.tid; i < 40 * 32; i += NTHREADS) { const int r = i >> 5, c = i & 31; float s = 0.f;
            for (int k = 0; k < 16; ++k) s += sc[(k * 40 + r) * 32 + c];
            MOD[r * MODW + c0 + c] = s + bada[c0 + c]; }
    }
    __syncthreads();
}
__device__ __forceinline__ void transpose_item(const float* W, int K, int N, int NP, bf16* WT, int row_off, LAS float* scr, int item, int lane) {
    const int nblk = NP / 32, kb = item / nblk, nb = item % nblk, k0 = 64 * kb, n0 = 32 * nb;
    const int nsrc = n0 + (lane & 31);
#pragma unroll 8
    for (int i = 0; i < 32; ++i) { const int kk = 2 * i + (lane >> 5); scr[kk * 33 + (lane & 31)] = (nsrc < N) ? W[(size_t)(k0 + kk) * N + nsrc] : 0.f; }
    LDS_WAIT(); asm volatile("" ::: "memory");
    const int c = lane & 7;
#pragma unroll
    for (int j = 0; j < 4; ++j) { const int n = (lane >> 3) + 8 * j; const LAS float* s = scr + (8 * c) * 33 + n;
        v4u o; o.x = pk2(s[0 * 33], s[1 * 33]); o.y = pk2(s[2 * 33], s[3 * 33]); o.z = pk2(s[4 * 33], s[5 * 33]); o.w = pk2(s[6 * 33], s[7 * 33]);
        *(GAS v4u*)(WT + (size_t)(row_off + n0 + n) * K + k0 + 8 * c) = o; }
    LDS_WAIT(); asm volatile("" ::: "memory");
}
__device__ __forceinline__ void p0_weights(const Ctx& C) {
    LAS float* scr = (LAS float*)(C.lds + C.wave * 16384);
    constexpr int I_IN = (D / 64) * (NIN / 32), I_OUT = (D / 64) * (D / 32), I_G = (D / 64) * (FFN / 32), I_DN = (FFN / 64) * (D / 32);
    constexpr int NITEMS = I_IN + I_OUT + 2 * I_G + I_DN;
    bf16* WIN = (bf16*)(C.ws + WS_WIN); bf16* WOUT = (bf16*)(C.ws + WS_WOUT); bf16* WGU = (bf16*)(C.ws + WS_WGU); bf16* WDN = (bf16*)(C.ws + WS_WDN);
    for (int it = C.gw; it < NITEMS; it += C.ngw) {
        int r = it;
        if (r < I_IN) { transpose_item(C.in[14], D, IN_COLS, NIN, WIN, 0, scr, r, C.lane); continue; } r -= I_IN;
        if (r < I_OUT) { transpose_item(C.in[28], D, D, D, WOUT, 0, scr, r, C.lane); continue; } r -= I_OUT;
        if (r < I_G) { transpose_item(C.in[29], D, FFN, FFN, WGU, 0, scr, r, C.lane); continue; } r -= I_G;
        if (r < I_G) { transpose_item(C.in[30], D, FFN, FFN, WGU, FFN, scr, r, C.lane); continue; } r -= I_G;
        transpose_item(C.in[31], FFN, D, D, WDN, 0, scr, r, C.lane);
    }
}
__device__ __forceinline__ void norm_mod_row(const Ctx& C, int m, const float* xr, const float* g, const float* shift, const float* scale, bf16* orow) {
    const GAS f32x4* xp = (const GAS f32x4*)xr + C.lane;
    f32x4 v[4]; float s = 0.f;
#pragma unroll
    for (int j = 0; j < 4; ++j) { v[j] = xp[64 * j]; s += (v[j].x * v[j].x + v[j].y * v[j].y) + (v[j].z * v[j].z + v[j].w * v[j].w); }
    const float rstd = 1.f / sqrtf(wave_sum(s) * (1.f / D) + RMS_EPS);
    GAS unsigned long long* o8 = (GAS unsigned long long*)orow + C.lane;
#pragma unroll
    for (int j = 0; j < 4; ++j) { const int c = 4 * (C.lane + 64 * j);
        const f32x4 gg = *(const f32x4*)(g + c), sh = *(const f32x4*)(shift + c), sc = *(const f32x4*)(scale + c);
        const f32x4 h = v[j] * rstd * gg * (1.f + sc) + sh;
        o8[64 * j] = (unsigned long long)pk2(h.x, h.y) | ((unsigned long long)pk2(h.z, h.w) << 32); }
}
__device__ __forceinline__ void p1_norm1(const Ctx& C) {
    bf16* A1 = (bf16*)(C.ws + WS_A1); const float* MOD = (const float*)(C.ws + WS_MOD);
    for (int m = C.gw; m < MPAD; m += C.ngw) {
        bf16* orow = A1 + (size_t)m * D;
        if (m >= MT) { GAS unsigned long long* o8 = (GAS unsigned long long*)orow + C.lane;
#pragma unroll
            for (int j = 0; j < 4; ++j) o8[64 * j] = 0ull;
            continue; }
        const float* md = MOD + mod_row(m) * MODW;
        norm_mod_row(C, m, x_row(C, m), C.in[10], md, md + D, orow);
    }
}
__device__ __forceinline__ void p3_post(const Ctx& C) {
    const float* PROJ = (const float*)(C.ws + WS_PROJ); float* QN = (float*)(C.ws + WS_QN);
    const int lane = C.lane;
    const float qg = C.in[15][lane], kg = C.in[16][lane];
    for (int m = C.gw; m < MT; m += C.ngw) {
        const float* p = PROJ + (size_t)m * NIN;
        const bool smp = m >= MP; const int j = m - MP;
        float* ko = C.out + (smp ? OUT_KS + (size_t)j * ATT_W : OUT_KP + (size_t)m * ATT_W);
        float* vo = C.out + (smp ? OUT_VS + (size_t)j * ATT_W : OUT_VP + (size_t)m * ATT_W);
        float* io = C.out + (smp ? OUT_IKS + (size_t)j * IDD : OUT_IKP + (size_t)m * IDD);
        float* qn = QN + (size_t)m * ATT_W;
        for (int h = 0; h < AH; ++h) {
            const float q = p[O_Q + h * 64 + lane], k = p[O_K + h * 64 + lane];
            const float sq = wave_sum(q * q), sk = wave_sum(k * k);
            qn[h * 64 + lane] = q * (1.f / sqrtf(sq * (1.f / 64.f) + RMS_EPS)) * qg;
            ko[h * 64 + lane] = k * (1.f / sqrtf(sk * (1.f / 64.f) + RMS_EPS)) * kg;
            vo[h * 64 + lane] = p[O_V + h * 64 + lane];
        }
        const float ki = p[O_KI + lane];
        io[lane] = ki * (1.f / sqrtf(wave_sum(ki * ki) * (1.f / 64.f) + RMS_EPS));
        if (smp || (m & (T - 1)) == T - 1) {
            float* so = C.out + (smp ? OUT_SHS + (size_t)j * RW_COLS : OUT_SHP + (size_t)(m >> 11) * RW_COLS);
            for (int i = 0; i < RW_COLS / 64; ++i) so[i * 64 + lane] = p[O_RW + i * 64 + lane];
        }
    }
}
__device__ __forceinline__ void p3_rwprep(const Ctx& C) {
    const float* PROJ = (const float*)(C.ws + WS_PROJ);
    float* Rr = (float*)(C.ws + WS_RWA), *Wd = (float*)(C.ws + WS_RWA + RWA_STRIDE), *Kp = (float*)(C.ws + WS_RWA + 2 * RWA_STRIDE), *Vv = (float*)(C.ws + WS_RWA + 3 * RWA_STRIDE),
          *KK = (float*)(C.ws + WS_RWA + 4 * RWA_STRIDE), *Bb = (float*)(C.ws + WS_RWA + 5 * RWA_STRIDE), *Gg = (float*)(C.ws + WS_RWA + 6 * RWA_STRIDE);
    const float* mu = C.in[17]; const float* w0 = C.in[18]; const float* w2 = C.in[19]; const float* a0 = C.in[20]; const float* a2 = C.in[21]; const float* g2 = C.in[22];
    const float* k_k = C.in[23]; const float* k_a = C.in[24];
    LAS float* lw = (LAS float*)(C.lds + C.wave * 1024);
    const int lane = C.lane;
    for (int m = C.gw; m < MT; m += C.ngw) {
        const float* p = PROJ + (size_t)m * NIN + O_RW;
        const bool smp = m >= MP; const int j = m - MP; const int t = m & (T - 1);
        const float* pv = smp ? C.in[6] + (size_t)j * RW_COLS : (t == 0 ? nullptr : p - NIN);
#define XM(c) ({ const int c_ = (c); const float cur_ = p[c_]; const float prv_ = pv ? pv[c_] : 0.f; cur_ + (prv_ - cur_) * mu[c_]; })
        lw[lane] = tanhf(XM(1536 + lane)); lw[64 + lane] = XM(1600 + lane); lw[128 + lane] = sigmoidf_(XM(1664 + lane)); lw[192 + lane] = sigmoidf_(XM(1728 + lane));
        LDS_WAIT(); asm volatile("" ::: "memory");
        for (int h = 0; h < RH; ++h) {
            const int c = h * 64 + lane;
            float aw = w0[c], aa = a0[c], ag = 0.f;
            for (int jj = 0; jj < 64; ++jj) { aw += lw[jj] * w2[jj * RW_W + c]; aa += lw[64 + jj] * a2[jj * RW_W + c]; }
            for (int jj = 0; jj < 128; ++jj) ag += lw[128 + jj] * g2[jj * RW_W + c];
            const float decay = expf(-0.6065306597126334f * sigmoidf_(aw));
            const float a = sigmoidf_(aa);
            const float r = XM(c), k = XM(512 + c), v = XM(1024 + c);
            float kk = k * k_k[c]; const float nrm = wave_sum(kk * kk); kk *= 1.f / sqrtf(fmaxf(nrm, 1e-24f));
            const float kp = k * (1.f + (a - 1.f) * k_a[c]);
            const size_t o = (size_t)m * RW_W + c;
            Rr[o] = r; Wd[o] = decay; Kp[o] = kp; Vv[o] = v; KK[o] = kk; Bb[o] = kk * a; Gg[o] = ag;
        }
#undef XM
        LDS_WAIT(); asm volatile("" ::: "memory");
    }
}
__device__ __forceinline__ float idx_score(const float (&kr)[64], const LAS float* ql, const LAS float* wl) {
    float score = 0.f;
    for (int h = 0; h < IH; ++h) {
        float d = 0.f;
#pragma unroll
        for (int dd = 0; dd < 64; dd += 4) { const f32x4 qv = *(const LAS f32x4*)(ql + h * 64 + dd); d += qv.x * kr[dd] + qv.y * kr[dd + 1] + qv.z * kr[dd + 2] + qv.w * kr[dd + 3]; }
        score += wl[h] * fmaxf(d, 0.f);
    }
    return score;
}
__device__ __forceinline__ void p4_indexer(const Ctx& C) {
    const float* PROJ = (const float*)(C.ws + WS_PROJ); float* SC = (float*)(C.ws + WS_SC); float* SCS = (float*)(C.ws + WS_SCS);
    LAS float* ql = (LAS float*)C.lds;
    LAS float* wl = ql + 16 * 1024;
    const int lane = C.lane;
    for (int u = blockIdx.x; u < NB * 128 * 4; u += C.G) {
        const int b = u >> 9, tq = (u >> 2) & 127, scn = u & 3, t0 = tq * 16;
        if (scn * 512 > t0 + 15) continue;
        __syncthreads();
        for (int i = C.tid; i < 16 * 1024; i += NTHREADS) { const int q = i >> 10, e = i & 1023; ql[i] = PROJ[(size_t)(b * T + t0 + q) * NIN + O_QI + e]; }
        if (C.tid < 256) { const int q = C.tid >> 4, h = C.tid & 15; wl[C.tid] = PROJ[(size_t)(b * T + t0 + q) * NIN + O_WI + h] * IDX_W_SCALE; }
        __syncthreads();
        const int s = scn * 512 + C.wave * 64 + lane;
        if (scn * 512 + C.wave * 64 <= t0 + 15) {
            float kr[64];
            const f32x4* kp = (const f32x4*)(C.out + OUT_IKP + (size_t)(b * T + s) * IDD);
#pragma unroll
            for (int i = 0; i < 16; ++i) { const f32x4 v = kp[i]; kr[4 * i] = v.x; kr[4 * i + 1] = v.y; kr[4 * i + 2] = v.z; kr[4 * i + 3] = v.w; }
            for (int q = 0; q < 16; ++q) {
                const float score = idx_score(kr, ql + q * 1024, wl + q * 16);
                const int t = t0 + q;
                if (s <= t) SC[((size_t)b * T + t) * T + s] = score;
            }
        }
    }
    __syncthreads();
    const int* pt = (const int*)C.in[7];
    LAS float* qw = (LAS float*)(C.lds + C.wave * 8192); LAS float* ww = qw + 1024;
    for (int wu = C.gw; wu < NSMP * 129; wu += C.ngw) {
        const int j = wu / 129, kb = wu % 129;
        const float* pq = PROJ + (size_t)(MP + j) * NIN;
        for (int i = 0; i < 16; ++i) qw[i * 64 + lane] = pq[O_QI + i * 64 + lane];
        if (lane < 16) ww[lane] = pq[O_WI + lane] * IDX_W_SCALE;
        LDS_WAIT(); asm volatile("" ::: "memory");
        const int s = kb * 64 + lane;
        const float* krow = nullptr;
        if (s < PAST) krow = C.in[4] + ((size_t)pt[j * NPAGES + (s >> 7)] * PAGE + (s & 127)) * IDD;
        else if (s == PAST) krow = C.out + OUT_IKS + (size_t)j * IDD;
        float score = -INFINITY;
        if (krow) { float kr[64]; const f32x4* kp = (const f32x4*)krow;
#pragma unroll
            for (int i = 0; i < 16; ++i) { const f32x4 v = kp[i]; kr[4 * i] = v.x; kr[4 * i + 1] = v.y; kr[4 * i + 2] = v.z; kr[4 * i + 3] = v.w; }
            score = idx_score(kr, qw, ww); }
        SCS[(size_t)j * SCS_LD + s] = score;
        LDS_WAIT(); asm volatile("" ::: "memory");
    }
}
__device__ __forceinline__ void p4_scan(const Ctx& C) {
    const float* Rr = (const float*)(C.ws + WS_RWA), *Wd = (const float*)(C.ws + WS_RWA + RWA_STRIDE), *Kp = (const float*)(C.ws + WS_RWA + 2 * RWA_STRIDE), *Vv = (const float*)(C.ws + WS_RWA + 3 * RWA_STRIDE),
          *KK = (const float*)(C.ws + WS_RWA + 4 * RWA_STRIDE), *Bb = (const float*)(C.ws + WS_RWA + 5 * RWA_STRIDE);
    float* Y = (float*)(C.ws + WS_Y);
    const int lane = C.lane;
    for (int u = C.gw; u < NB * RH + NSMP * RH; u += C.ngw) {
        const bool smp = u >= NB * RH; const int seq = smp ? (u - NB * RH) / RH : u / RH, h = u % RH;
        const int nsteps = smp ? 1 : T; const size_t base = smp ? (size_t)(MP + seq) : (size_t)seq * T;
        float S[64];
        if (smp) { const f32x4* sp = (const f32x4*)(C.in[5] + (((size_t)seq * RH + h) * RN + lane) * RN);
#pragma unroll
            for (int i = 0; i < 16; ++i) { const f32x4 v = sp[i]; S[4 * i] = v.x; S[4 * i + 1] = v.y; S[4 * i + 2] = v.z; S[4 * i + 3] = v.w; } }
        else {
#pragma unroll
            for (int i = 0; i < 64; ++i) S[i] = 0.f; }
        size_t o = base * RW_W + h * 64 + lane;
        float r = Rr[o], w = Wd[o], k = Kp[o], v = Vv[o], kk = KK[o], bb = Bb[o];
        for (int t = 0; t < nsteps; ++t) {
            float rn = 0.f, wn = 0.f, kn = 0.f, vn = 0.f, kkn = 0.f, bbn = 0.f;
            const size_t on = o + RW_W;
            if (t + 1 < nsteps) { rn = Rr[on]; wn = Wd[on]; kn = Kp[on]; vn = Vv[on]; kkn = KK[on]; bbn = Bb[on]; }
            float sa0 = 0.f, sa1 = 0.f;
#pragma unroll
            for (int jx = 0; jx < 64; jx += 2) { sa0 += S[jx] * rdlane(kk, jx); sa1 += S[jx + 1] * rdlane(kk, jx + 1); }
            const float sa = -(sa0 + sa1);
            float y0 = 0.f, y1 = 0.f;
#pragma unroll
            for (int jx = 0; jx < 64; jx += 2) {
                S[jx] = S[jx] * rdlane(w, jx) + sa * rdlane(bb, jx) + v * rdlane(k, jx); y0 += S[jx] * rdlane(r, jx);
                S[jx + 1] = S[jx + 1] * rdlane(w, jx + 1) + sa * rdlane(bb, jx + 1) + v * rdlane(k, jx + 1); y1 += S[jx + 1] * rdlane(r, jx + 1); }
            Y[o] = y0 + y1;
            o = on; r = rn; w = wn; k = kn; v = vn; kk = kkn; bb = bbn;
        }
        f32x4* so = (f32x4*)(C.out + (smp ? OUT_WKVS : OUT_WKVP) + (((size_t)seq * RH + h) * RN + lane) * RN);
#pragma unroll
        for (int i = 0; i < 16; ++i) so[i] = (f32x4){S[4 * i], S[4 * i + 1], S[4 * i + 2], S[4 * i + 3]};
    }
}
__device__ __forceinline__ void p5_select(const Ctx& C) {
    const float* SC = (const float*)(C.ws + WS_SC); unsigned* MASK = (unsigned*)(C.ws + WS_MASK);
    const int lane = C.lane;
    for (int row = C.gw; row < MP; row += C.ngw) {
        const int t = row & (T - 1); const float* sp = SC + (size_t)row * T;
        unsigned key[32];
#pragma unroll
        for (int j = 0; j < 32; ++j) { const int s = 64 * j + lane; key[j] = (s <= t) ? sortable(sp[s]) : 0u; }
        unsigned Tk = 0u; int need = 0;
        const bool all = (t + 1 <= TOPK);
        if (!all) {
            for (int bit = 31; bit >= 0; --bit) { const unsigned cand = Tk | (1u << bit); int cnt = 0;
#pragma unroll
                for (int j = 0; j < 32; ++j) cnt += __builtin_popcountll(__ballot(key[j] >= cand));
                if (cnt >= TOPK) Tk = cand; }
            int cgt = 0;
#pragma unroll
            for (int j = 0; j < 32; ++j) cgt += __builtin_popcountll(__ballot(key[j] > Tk));
            need = TOPK - cgt;
        }
        int running = 0;
#pragma unroll
        for (int j = 0; j < 32; ++j) {
            const int s = 64 * j + lane; bool take;
            if (all) take = (s <= t);
            else { const bool gt = key[j] > Tk, eq = key[j] == Tk; const unsigned long long eqb = __ballot(eq);
                const int pre = __builtin_popcountll(eqb & lanemask_lt(lane)); take = gt || (eq && (running + pre < need)); running += __builtin_popcountll(eqb); }
            const unsigned long long mb = __ballot(take);
            if (lane == 0) { MASK[(size_t)row * 64 + 2 * j] = (unsigned)mb; MASK[(size_t)row * 64 + 2 * j + 1] = (unsigned)(mb >> 32); }
        }
    }
    const float* SCS = (const float*)(C.ws + WS_SCS); int* SLIST = (int*)(C.ws + WS_SLIST);
    LAS int* sh = (LAS int*)C.lds;
    for (int j = blockIdx.x; j < NSMP; j += C.G) {
        unsigned key[17];
#pragma unroll
        for (int i = 0; i < 17; ++i) { const int s = i * NTHREADS + C.tid; key[i] = (s < LS) ? sortable(SCS[(size_t)j * SCS_LD + s]) : 0u; }
        unsigned Tk = 0u;
        for (int bit = 31; bit >= 0; --bit) { const unsigned cand = Tk | (1u << bit); int c = 0;
#pragma unroll
            for (int i = 0; i < 17; ++i) c += (key[i] >= cand) ? 1 : 0;
            c = wave_sum_i(c);
            __syncthreads(); if (lane == 0) sh[C.wave] = c; __syncthreads();
            int cnt = 0;
#pragma unroll
            for (int w = 0; w < 8; ++w) cnt += sh[w];
            if (cnt >= TOPK) Tk = cand; }
        int cg = 0;
#pragma unroll
        for (int i = 0; i < 17; ++i) cg += (key[i] > Tk) ? 1 : 0;
        cg = wave_sum_i(cg);
        __syncthreads(); if (lane == 0) sh[C.wave] = cg; __syncthreads();
        int cgt = 0;
#pragma unroll
        for (int w = 0; w < 8; ++w) cgt += sh[w];
        const int need = TOPK - cgt;
        int run_eq = 0, run_sel = 0;
#pragma unroll
        for (int i = 0; i < 17; ++i) {
            const int s = i * NTHREADS + C.tid; const bool gt = key[i] > Tk, eq = key[i] == Tk;
            const unsigned long long eqb = __ballot(eq);
            __syncthreads(); if (lane == 0) sh[C.wave] = __builtin_popcountll(eqb); __syncthreads();
            int eq_before = 0, eq_tot = 0;
#pragma unroll
            for (int w = 0; w < 8; ++w) { const int x = sh[w]; eq_tot += x; if (w < C.wave) eq_before += x; }
            const bool take = gt || (eq && (run_eq + eq_before + __builtin_popcountll(eqb & lanemask_lt(lane)) < need));
            const unsigned long long tb = __ballot(take);
            __syncthreads(); if (lane == 0) sh[8 + C.wave] = __builtin_popcountll(tb); __syncthreads();
            int s_before = 0, s_tot = 0;
#pragma unroll
            for (int w = 0; w < 8; ++w) { const int x = sh[8 + w]; s_tot += x; if (w < C.wave) s_before += x; }
            const int pos = run_sel + s_before + __builtin_popcountll(tb & lanemask_lt(lane));
            if (take && pos < TOPK) SLIST[j * TOPK + pos] = s;
            run_eq += eq_tot; run_sel += s_tot;
        }
    }
    __syncthreads();
}
__device__ __forceinline__ void p5_rwfinal(const Ctx& C) {
    const float* Rr = (const float*)(C.ws + WS_RWA), *Kp = (const float*)(C.ws + WS_RWA + 2 * RWA_STRIDE), *Vv = (const float*)(C.ws + WS_RWA + 3 * RWA_STRIDE), *Gg = (const float*)(C.ws + WS_RWA + 6 * RWA_STRIDE);
    const float* Y = (const float*)(C.ws + WS_Y); bf16* MIX = (bf16*)(C.ws + WS_MIX);
    const float* r_k = C.in[25]; const float* ln_w = C.in[26]; const float* ln_b = C.in[27];
    const int lane = C.lane;
    for (int m = C.gw; m < MT; m += C.ngw) {
        for (int h = 0; h < RH; ++h) {
            const int c = h * 64 + lane; const size_t o = (size_t)m * RW_W + c;
            const float y = Y[o];
            const float mu = wave_sum(y) * (1.f / 64.f); const float dy = y - mu; const float var = wave_sum(dy * dy) * (1.f / 64.f);
            const float yn = dy * (1.f / sqrtf(var + GN_EPS)) * ln_w[c] + ln_b[c];
            const float bonus = wave_sum(Rr[o] * Kp[o] * r_k[c]) * Vv[o];
            MIX[(size_t)m * D + ATT_W + c] = (bf16)f2bf((yn + bonus) * Gg[o]);
        }
    }
}
__device__ __forceinline__ void p6_attn(const Ctx& C) {
    const unsigned* MASK = (const unsigned*)(C.ws + WS_MASK); const int* SLIST = (const int*)(C.ws + WS_SLIST); const float* QN = (const float*)(C.ws + WS_QN);
    bf16* MIX = (bf16*)(C.ws + WS_MIX); const int* pt = (const int*)C.in[7];
    LAS int* list = (LAS int*)C.lds;
    LAS float* pb = (LAS float*)(C.lds + 1024);
    LAS int* cntp = (LAS int*)(C.lds + 1024 + 8192);
    const int lane = C.lane, h = C.wave;
    for (int u = blockIdx.x; u < MT; u += C.G) {
        const bool smp = u >= MP; const int j = u - MP, b = u >> 11;
        __syncthreads();
        if (C.wave == 0) {
            if (!smp) { const unsigned w = MASK[(size_t)u * 64 + lane]; const int c = __builtin_popcount(w);
                int incl = c;
#pragma unroll
                for (int o = 1; o < 64; o <<= 1) { const int x = __shfl_up(incl, o); if (lane >= o) incl += x; }
                int pos = incl - c; unsigned ww = w;
                while (ww) { const int bit = __builtin_ctz(ww); ww &= ww - 1u; list[pos++] = 32 * lane + bit; }
                if (lane == 63) *cntp = incl; }
            else { for (int i = 0; i < 4; ++i) list[i * 64 + lane] = SLIST[j * TOPK + i * 64 + lane]; if (lane == 0) *cntp = TOPK; }
        }
        __syncthreads();
        int cnt = *cntp; if (cnt > TOPK) cnt = TOPK;
        float q[64];
        { const f32x4* qp = (const f32x4*)(QN + (size_t)u * ATT_W + h * 64);
#pragma unroll
          for (int i = 0; i < 16; ++i) { const f32x4 v = qp[i]; q[4 * i] = v.x; q[4 * i + 1] = v.y; q[4 * i + 2] = v.z; q[4 * i + 3] = v.w; } }
        float sc[4]; float mx = -INFINITY;
#pragma unroll
        for (int i = 0; i < 4; ++i) { const int idx = i * 64 + lane; sc[i] = -INFINITY;
            if (idx < cnt) { const int s = list[idx]; const float* kp;
                if (!smp) kp = C.out + OUT_KP + ((size_t)(b * T + s)) * ATT_W + h * 64;
                else if (s < PAST) kp = C.in[2] + ((size_t)pt[j * NPAGES + (s >> 7)] * PAGE + (s & 127)) * ATT_W + h * 64;
                else kp = C.out + OUT_KS + (size_t)j * ATT_W + h * 64;
                float d = 0.f;
#pragma unroll
                for (int e = 0; e < 16; ++e) { const f32x4 kv = ((const f32x4*)kp)[e]; d += q[4 * e] * kv.x + q[4 * e + 1] * kv.y + q[4 * e + 2] * kv.z + q[4 * e + 3] * kv.w; }
                sc[i] = d * 0.125f; }
            mx = fmaxf(mx, sc[i]); }
        mx = wave_max(mx); float l = 0.f;
#pragma unroll
        for (int i = 0; i < 4; ++i) { const int idx = i * 64 + lane; const float p = (idx < cnt) ? expf(sc[i] - mx) : 0.f; pb[h * 256 + idx] = p; l += p; }
        l = wave_sum(l);
        LDS_WAIT(); asm volatile("" ::: "memory");
        float o = 0.f;
        for (int kx = 0; kx < cnt; ++kx) { const int s = list[kx]; const float* vp;
            if (!smp) vp = C.out + OUT_VP + ((size_t)(b * T + s)) * ATT_W + h * 64;
            else if (s < PAST) vp = C.in[3] + ((size_t)pt[j * NPAGES + (s >> 7)] * PAGE + (s & 127)) * ATT_W + h * 64;
            else vp = C.out + OUT_VS + (size_t)j * ATT_W + h * 64;
            o += pb[h * 256 + kx] * vp[lane]; }
        MIX[(size_t)u * D + h * 64 + lane] = (bf16)f2bf(o / l);
    }
    __syncthreads();
}
__device__ __forceinline__ void p8_res_norm2(const Ctx& C) {
    const float* RAW = (const float*)(C.ws + WS_RAW); float* X1 = (float*)(C.ws + WS_X1); bf16* A2 = (bf16*)(C.ws + WS_A2); const float* MOD = (const float*)(C.ws + WS_MOD);
    for (int m = C.gw; m < MPAD; m += C.ngw) {
        bf16* orow = A2 + (size_t)m * D;
        if (m >= MT) { GAS unsigned long long* o8 = (GAS unsigned long long*)orow + C.lane;
#pragma unroll
            for (int j = 0; j < 4; ++j) o8[64 * j] = 0ull;
            continue; }
        const float* md = MOD + mod_row(m) * MODW; const float* xr = x_row(C, m);
        float* x1 = X1 + (size_t)m * D;
#pragma unroll
        for (int j = 0; j < 4; ++j) { const int c = 4 * (C.lane + 64 * j);
            const f32x4 xv = *(const f32x4*)(xr + c), rv = *(const f32x4*)(RAW + (size_t)m * D + c), g1 = *(const f32x4*)(md + 2 * D + c);
            *(f32x4*)(x1 + c) = xv + g1 * rv; }
        VM_WAIT(); asm volatile("" ::: "memory");
        norm_mod_row(C, m, x1, C.in[11], md + 3 * D, md + 4 * D, orow);
    }
}
__device__ __forceinline__ void p10_swiglu(const Ctx& C) {
    const float* RAW2 = (const float*)(C.ws + WS_RAW2); bf16* HB = (bf16*)(C.ws + WS_HB);
    const size_t total = (size_t)MPAD * (FFN / 4);
    for (size_t i = (size_t)blockIdx.x * NTHREADS + C.tid; i < total; i += (size_t)C.G * NTHREADS) {
        const size_t m = i / (FFN / 4); const int c = (int)(i % (FFN / 4)) * 4;
        const f32x4 g = *(const f32x4*)(RAW2 + m * NGU + c), u = *(const f32x4*)(RAW2 + m * NGU + FFN + c);
        const float h0 = g.x / (1.f + expf(-g.x)) * u.x, h1 = g.y / (1.f + expf(-g.y)) * u.y, h2 = g.z / (1.f + expf(-g.z)) * u.z, h3 = g.w / (1.f + expf(-g.w)) * u.w;
        *(unsigned long long*)(HB + m * FFN + c) = (unsigned long long)pk2(h0, h1) | ((unsigned long long)pk2(h2, h3) << 32);
    }
}
__device__ __forceinline__ void p12_final(const Ctx& C) {
    const float* RAW = (const float*)(C.ws + WS_RAW); const float* X1 = (const float*)(C.ws + WS_X1); const float* MOD = (const float*)(C.ws + WS_MOD);
    for (int m = C.gw; m < MT; m += C.ngw) {
        const float* md = MOD + mod_row(m) * MODW;
        float* yo = C.out + (m < MP ? OUT_Y + (size_t)m * D : OUT_YS + (size_t)(m - MP) * D);
#pragma unroll
        for (int j = 0; j < 4; ++j) { const int c = 4 * (C.lane + 64 * j);
            const f32x4 xv = *(const f32x4*)(X1 + (size_t)m * D + c), rv = *(const f32x4*)(RAW + (size_t)m * D + c), g2 = *(const f32x4*)(md + 5 * D + c);
            *(f32x4*)(yo + c) = xv + g2 * rv; }
    }
}

constexpr int N_PHASES = 13;
__global__ void __launch_bounds__(NTHREADS, 2) fwd(Args args) {
    extern __shared__ __attribute__((aligned(16))) unsigned char lds[];
    Ctx C;
    C.lds = (LAS unsigned char*)lds;
    C.tid = threadIdx.x; C.lane = C.tid & 63; C.wave = __builtin_amdgcn_readfirstlane(C.tid >> 6);
    C.G = gridDim.x; C.gw = blockIdx.x * NWAVES + C.wave; C.ngw = C.G * NWAVES;
#pragma unroll
    for (int i = 0; i < 32; ++i) C.in[i] = args.in[i];
    C.out = args.out; C.ws = args.ws;
    const int lo = args.ph_lo, hi = args.ph_hi;
    volatile LAS unsigned* MISC = (volatile LAS unsigned*)(C.lds + MISC_OFF);
    if (C.tid < 32) MISC[C.tid] = 0u;
    __syncthreads();
    XcdBarrier bar = xcd_barrier_post((unsigned*)(C.ws + WS_CTL) + CW_BAR, MISC + 8);
#define IN(k) (lo <= (k) && (k) < hi)
#define SEAM(k) do { if (IN(k) && IN((k) + 1)) xcd_barrier(bar); } while (0)
    if (IN(0)) { p0_mod(C); p0_weights(C); }
    SEAM(0);
    if (IN(1)) { p1_norm1(C); }
    SEAM(1);
    if (IN(2)) {
        pg8::Gemm g{(const pg8::bf16_t*)(C.ws + WS_A1), (const pg8::bf16_t*)(C.ws + WS_WIN), MPAD, NIN, D}; pg8::StaticOrder S; S.init(MPAD, NIN, C.G, (int)blockIdx.x);
        EpiRawF32 E{(float*)(C.ws + WS_PROJ), NIN};
        pg8::gemm_phase<EpiRawF32, pg8::StaticOrder, true, true>(C.lds, g, S, E);
    }
    SEAM(2);
    if (IN(3)) { p3_post(C); p3_rwprep(C); }
    SEAM(3);
    if (IN(4)) { p4_indexer(C); p4_scan(C); }
    SEAM(4);
    if (IN(5)) { p5_select(C); p5_rwfinal(C); }
    SEAM(5);
    if (IN(6)) { p6_attn(C); }
    SEAM(6);
    if (IN(7)) {
        pg8::Gemm g{(const pg8::bf16_t*)(C.ws + WS_MIX), (const pg8::bf16_t*)(C.ws + WS_WOUT), MPAD, D, D}; pg8::StaticOrder S; S.init(MPAD, D, C.G, (int)blockIdx.x);
        EpiRawF32 E{(float*)(C.ws + WS_RAW), D};
        pg8::gemm_phase<EpiRawF32, pg8::StaticOrder, true, true>(C.lds, g, S, E);
    }
    SEAM(7);
    if (IN(8)) { p8_res_norm2(C); }
    SEAM(8);
    if (IN(9)) {
        pg8::Gemm g{(const pg8::bf16_t*)(C.ws + WS_A2), (const pg8::bf16_t*)(C.ws + WS_WGU), MPAD, NGU, D}; pg8::StaticOrder S; S.init(MPAD, NGU, C.G, (int)blockIdx.x);
        EpiRawF32 E{(float*)(C.ws + WS_RAW2), NGU};
        pg8::gemm_phase<EpiRawF32, pg8::StaticOrder, true, true>(C.lds, g, S, E);
    }
    SEAM(9);
    if (IN(10)) { p10_swiglu(C); }
    SEAM(10);
    if (IN(11)) {
        pg8::Gemm g{(const pg8::bf16_t*)(C.ws + WS_HB), (const pg8::bf16_t*)(C.ws + WS_WDN), MPAD, D, FFN}; pg8::StaticOrder S; S.init(MPAD, D, C.G, (int)blockIdx.x);
        EpiRawF32 E{(float*)(C.ws + WS_RAW), D};
        pg8::gemm_phase<EpiRawF32, pg8::StaticOrder, true, true>(C.lds, g, S, E);
    }
    SEAM(11);
    if (IN(12)) { p12_final(C); }
#undef IN
#undef SEAM
}

extern "C" void kernel_launch(void* const* d_in, const int* in_sizes, int n_in, void* d_out, int out_size, void* d_ws, size_t ws_size, hipStream_t stream) {
    static int grid = 0;
    if (grid == 0) {
        if (n_in != 32 || (size_t)out_size != OUT_END || ws_size < WS_END) { fprintf(stderr, "kernel_launch: unexpected sizes n_in %d out %d ws %zu\n", n_in, out_size, ws_size); grid = -1; return; }
        int dev = 0, cus = 0;
        if (hipGetDevice(&dev) != hipSuccess || hipDeviceGetAttribute(&cus, hipDeviceAttributeMultiprocessorCount, dev) != hipSuccess) { grid = -1; return; }
        if (hipFuncSetAttribute((const void*)fwd, hipFuncAttributeMaxDynamicSharedMemorySize, LDS_BYTES) != hipSuccess) { fprintf(stderr, "kernel_launch: hipFuncSetAttribute failed\n"); grid = -1; return; }
        (void)hipGetLastError();
        grid = cus;
    }
    if (grid < 0) return;
    (void)hipMemsetAsync((char*)d_ws + WS_CTL, 0, CTL_ZERO_BYTES, stream);
    Args a{};
    for (int i = 0; i < 32; ++i) a.in[i] = (const float*)d_in[i];
    a.out = (float*)d_out; a.ws = (unsigned char*)d_ws;
    a.ph_lo = 0; a.ph_hi = N_PHASES;
    hipLaunchKernelGGL(fwd, dim3(grid), dim3(NTHREADS), LDS_BYTES, stream, a);
}
```

```cpp
#include <hip/hip_runtime.h>
#include <cstdio>
#include <cstdint>
#include <cmath>
#include <hip/hip_bf16.h>
#define LAS __attribute__((address_space(3)))
namespace pg8 {
#define PG8_LAS __attribute__((address_space(3)))
typedef unsigned short bf16_t;
typedef short bf16x8 __attribute__((ext_vector_type(8)));
typedef float f32x4 __attribute__((ext_vector_type(4)));
typedef unsigned u32x4 __attribute__((ext_vector_type(4)));
constexpr int BM = 256, BK = 64, HALF = 128, HTB = HALF * BK * 2  , STAGE_BYTES = 8 * HTB, NXCD = 8, WGM = 8;

__host__ __device__ __forceinline__ int lds_byte(int r, int c) { const int st = (r >> 4) * 2 + (c >> 5), rr = r & 15, cc = c & 31, ob = rr * 64 + cc * 2; return st * 1024 + (ob ^ (((ob >> 9) & 1) << 5)); }
__host__ __device__ __forceinline__ void stage_rc(int b, int& R, int& C) { const int st = b / 1024, sb = b % 1024, swz = sb ^ (((sb >> 9) & 1) << 5); R = (st >> 1) * 16 + swz / 64; C = (st & 1) * 32 + (swz % 64) / 2; }
__host__ __device__ __forceinline__ int perm32(int rho) { const int n = rho >> 4, i = rho & 15; return 8 * (i >> 2) + 4 * n + (i & 3); }

struct Unit { int pm, pn; };
struct Gemm { const bf16_t* A; const bf16_t* Bt; int M, N, K; };

struct StaticOrder {
    int nM, nN, nwg, G, c;
    __host__ __device__ void init(int M, int N, int G_, int c_) { nM = M / BM; nN = N / BM; nwg = nM * nN; G = G_; c = c_; }
    __host__ __device__ bool next(int i, Unit& u) const {
        const long L = (long)i * G + c; if (L >= nwg) return false;
        int wgid = (int)L; { const int q = nwg / NXCD, r = nwg % NXCD, xcd = wgid % NXCD, off = wgid / NXCD; wgid = (xcd < r ? xcd * (q + 1) : r * (q + 1) + (xcd - r) * q) + off; }
        const int nig = WGM * nN, gid = wgid / nig, fm = gid * WGM, gsz = (nM - fm) < WGM ? (nM - fm) : WGM;
        u.pm = fm + ((wgid % nig) % gsz); u.pn = (wgid % nig) / gsz; return true;
    }
    __device__ __forceinline__ void a_ready(const Unit&) const {}
    __device__ __forceinline__ void done(const Unit&) const {}
};

__device__ __forceinline__ unsigned cvt_pk_bf16(float lo, float hi) { unsigned r; asm volatile("v_cvt_pk_bf16_f32 %0, %1, %2" : "=v"(r) : "v"(lo), "v"(hi)); return r; }
typedef float f32x2 __attribute__((ext_vector_type(2)));
__device__ __forceinline__ f32x2 gelu_pk(f32x2 v) {
    const f32x2 av = __builtin_elementwise_abs(v), d = av * 0.2316418882f + 1.0f;
    f32x2 t; t.x = __builtin_amdgcn_rcpf(d.x); t.y = __builtin_amdgcn_rcpf(d.y);
    f32x2 q = t * 0.5307027145f + (-0.7265760135f); q = q * t + 0.7107068705f; q = q * t + (-0.142248368f); q = q * t + 0.127414796f; q = q * t;
    const f32x2 s = (v * v) * (-0.72134752044f);
    f32x2 e; e.x = __builtin_amdgcn_exp2f(s.x); e.y = __builtin_amdgcn_exp2f(s.y);
    const f32x2 m = v * (q * e), r = v - m;
    f32x2 o; o.x = v.x < 0.f ? m.x : r.x; o.y = v.y < 0.f ? m.y : r.y; return o;
}

template <int ACT  > struct EpiBf16 {
    static constexpr bool PERM = true, AFTER_DRAIN = false; static_assert(ACT == 0 || ACT == 1, "EpiBf16: ACT is 0 (none) or 1 (gelu_pk)");
    bf16_t* O; int ldc; const float* bias; int split_cols; size_t split_stride; float scale0;
    __device__ __forceinline__ void operator()(const f32x4 (&acc)[2][2][4][2], const Unit& u, int wr, int wc, int fr, int fq) const {
        const int row0 = u.pm * BM + wr * 64 + fr; int colt = u.pn * BM; bf16_t* base = O;
        float sc = 1.f; if (split_cols) { const int t = colt / split_cols; base += (size_t)t * split_stride; colt -= t * split_cols; if (t == 0) sc = scale0; }
        const int col0 = colt + wc * 32 + 8 * fq, bcol0 = u.pn * BM + wc * 32 + 8 * fq;
        f32x4 bv[2][2];
#pragma unroll
        for (int bj = 0; bj < 2; ++bj)
#pragma unroll
            for (int n = 0; n < 2; ++n) bv[bj][n] = bias ? *(const f32x4*)(bias + bcol0 + bj * HALF + 4 * n) : (f32x4){0.f, 0.f, 0.f, 0.f};
#pragma unroll
        for (int ai = 0; ai < 2; ++ai)
#pragma unroll
            for (int m = 0; m < 4; ++m) { bf16_t* rowp = base + (size_t)(row0 + ai * HALF + m * 16) * ldc + col0;
#pragma unroll
                for (int bj = 0; bj < 2; ++bj) { f32x4 v0 = acc[ai][bj][m][0] + bv[bj][0], v1 = acc[ai][bj][m][1] + bv[bj][1];
                    if (ACT == 1) { f32x2 a = gelu_pk((f32x2){v0[0], v0[1]}), b = gelu_pk((f32x2){v0[2], v0[3]}), c = gelu_pk((f32x2){v1[0], v1[1]}), d = gelu_pk((f32x2){v1[2], v1[3]});
                        v0 = (f32x4){a.x, a.y, b.x, b.y}; v1 = (f32x4){c.x, c.y, d.x, d.y}; }
                    v0 = v0 * sc; v1 = v1 * sc; u32x4 w; w.x = cvt_pk_bf16(v0[0], v0[1]); w.y = cvt_pk_bf16(v0[2], v0[3]); w.z = cvt_pk_bf16(v1[0], v1[1]); w.w = cvt_pk_bf16(v1[2], v1[3]);
                    *(u32x4*)(rowp + bj * HALF) = w; } }
    }
};


template <class Epi, class Sched, bool ALIGN_EPI = false, bool SP2 = false>
__device__ __forceinline__ void gemm_phase(PG8_LAS unsigned char* lds, const Gemm g, const Sched& S, const Epi& E) {
    const int tid = threadIdx.x, wid = __builtin_amdgcn_readfirstlane(tid >> 6), lane = tid & 63, wr = wid >> 2, wc = wid & 3, fr = lane & 15, fq = lane >> 4;
    const int K = g.K, nt = K / BK;
    unsigned voffA[2], voffB[2];
#pragma unroll
    for (int i = 0; i < 2; ++i) { int R, C; stage_rc(tid * 16 + i * 8192, R, C); const int Rb = Epi::PERM ? ((R & ~31) + perm32(R & 31)) : R;
        voffA[i] = (unsigned)(R * K + C) * 2u; voffB[i] = (unsigned)(Rb * K + C) * 2u; }
    const size_t kstep = (size_t)(BK * 2);
    const size_t hstep = (size_t)HALF * K * 2;
    const size_t tstep = 2 * hstep;
    const unsigned ldsw = (unsigned)wid * 1024u;
    const int aoff = lds_byte(wr * 64 + fr, fq * 8), boff = lds_byte(wc * 32 + fr, fq * 8);
#define PG8_SA(b, h) (((b) * 2 + (h)) * HTB)
#define PG8_SB(b, h) ((4 + (b) * 2 + (h)) * HTB)
#define PG8_STAGE(bufoff, gbase, voff) do { _Pragma("unroll") for (int _i = 0; _i < 2; ++_i) \
        __builtin_amdgcn_global_load_lds((const unsigned*)((const char*)(gbase) + (voff)[_i]), (PG8_LAS unsigned*)(lds + (bufoff) + ldsw + _i * 8192), 16, 0, 0); } while (0)
#define PG8_LDA(dst, b, h) do { _Pragma("unroll") for (int m = 0; m < 4; ++m) _Pragma("unroll") for (int k = 0; k < 2; ++k) dst[m][k] = *(const PG8_LAS bf16x8*)(lds + PG8_SA(b, h) + aoff + m * 2048 + k * 1024); } while (0)
#define PG8_LDB(dst, b, h) do { _Pragma("unroll") for (int n = 0; n < 2; ++n) _Pragma("unroll") for (int k = 0; k < 2; ++k) dst[n][k] = *(const PG8_LAS bf16x8*)(lds + PG8_SB(b, h) + boff + n * 2048 + k * 1024); } while (0)
#define PG8_MMA(ai, bj, At, Bt) do { __builtin_amdgcn_s_setprio(1); _Pragma("unroll") for (int m = 0; m < 4; ++m) _Pragma("unroll") for (int n = 0; n < 2; ++n) _Pragma("unroll") for (int k = 0; k < 2; ++k) \
        acc[ai][bj][m][n] = __builtin_amdgcn_mfma_f32_16x16x32_bf16(Bt[n][k], At[m][k], acc[ai][bj][m][n], 0, 0, 0); __builtin_amdgcn_s_setprio(0); } while (0)
#define PG8_WAIT_V(n) asm volatile("s_waitcnt vmcnt(" #n ")" ::: "memory")
#define PG8_WAIT_L(n) asm volatile("s_waitcnt lgkmcnt(" #n ")" ::: "memory")
#define PG8_BAR __builtin_amdgcn_s_barrier()
#define PG8_SCHED __builtin_amdgcn_sched_barrier(0)
    Unit cur, nxt; int ui = 0;
    if (!S.next(0, cur)) return;
    f32x4 acc[2][2][4][2];
#pragma unroll
    for (int a = 0; a < 2; ++a)
#pragma unroll
        for (int b = 0; b < 2; ++b)
#pragma unroll
            for (int m = 0; m < 4; ++m)
#pragma unroll
                for (int n = 0; n < 2; ++n) acc[a][b][m][n] = (f32x4){0.f, 0.f, 0.f, 0.f};
    bf16x8 At[4][2], B0[2][2], B1[2][2];
    const char* cA = (const char*)g.A + (size_t)cur.pm * tstep; const char* cB = (const char*)g.Bt + (size_t)cur.pn * tstep;
    S.a_ready(cur);
    if constexpr (SP2) {
        PG8_STAGE(PG8_SB(0, 0), cB, voffB); PG8_STAGE(PG8_SB(0, 1), cB + hstep, voffB); PG8_STAGE(PG8_SA(0, 0), cA, voffA); PG8_STAGE(PG8_SA(0, 1), cA + hstep, voffA);
        if (wr == 1) PG8_BAR;
        PG8_WAIT_V(2); PG8_BAR;
        PG8_STAGE(PG8_SB(1, 0), cB + kstep, voffB); PG8_STAGE(PG8_SA(1, 0), cA + kstep, voffA); PG8_STAGE(PG8_SB(1, 1), cB + hstep + kstep, voffB);
        PG8_WAIT_V(6); PG8_BAR;
    } else {
        PG8_STAGE(PG8_SB(0, 0), cB, voffB); PG8_STAGE(PG8_SA(0, 0), cA, voffA); PG8_STAGE(PG8_SB(0, 1), cB + hstep, voffB); PG8_STAGE(PG8_SA(0, 1), cA + hstep, voffA);
        if (wr == 1) PG8_BAR;
        PG8_WAIT_V(4); PG8_BAR;
        PG8_STAGE(PG8_SB(1, 0), cB + kstep, voffB); PG8_STAGE(PG8_SA(1, 0), cA + kstep, voffA); PG8_STAGE(PG8_SB(1, 1), cB + hstep + kstep, voffB);
        PG8_WAIT_V(6); PG8_BAR;
    }
    for (;;) {
        const bool has_next = S.next(ui + 1, nxt);
        const char* nA = has_next ? (const char*)g.A + (size_t)nxt.pm * tstep : cA; const char* nB = has_next ? (const char*)g.Bt + (size_t)nxt.pn * tstep : cB;
        for (int t = 0; t < nt; t += 2) {
            const bool last = (t == nt - 2);
            const char* a1 = cA + (size_t)(t + 1) * kstep;
            const char* a2 = last ? nA : cA + (size_t)(t + 2) * kstep; const char* b2 = last ? nB : cB + (size_t)(t + 2) * kstep;
            const char* a3 = a2 + kstep; const char* b3 = b2 + kstep;
            if (last && has_next) S.a_ready(nxt);
            if constexpr (SP2) {
            PG8_LDB(B0, 0, 0); PG8_LDB(B1, 0, 1); PG8_SCHED; PG8_LDA(At, 0, 0); PG8_STAGE(PG8_SA(1, 1), a1 + hstep, voffA);
            PG8_WAIT_V(8); PG8_WAIT_L(0); PG8_BAR; PG8_MMA(0, 0, At, B0); PG8_MMA(0, 1, At, B1); PG8_BAR; PG8_SCHED;
            PG8_LDA(At, 0, 1); PG8_STAGE(PG8_SB(0, 0), b2, voffB); PG8_STAGE(PG8_SB(0, 1), b2 + hstep, voffB); PG8_STAGE(PG8_SA(0, 0), a2, voffA);
            PG8_WAIT_V(8); PG8_WAIT_L(0); PG8_BAR; PG8_MMA(1, 0, At, B0); PG8_MMA(1, 1, At, B1); PG8_BAR; PG8_SCHED;
            PG8_LDB(B0, 1, 0); PG8_LDB(B1, 1, 1); PG8_SCHED; PG8_LDA(At, 1, 0); PG8_STAGE(PG8_SA(0, 1), a2 + hstep, voffA);
            PG8_WAIT_V(8); PG8_WAIT_L(0); PG8_BAR; PG8_MMA(0, 0, At, B0); PG8_MMA(0, 1, At, B1); PG8_BAR; PG8_SCHED;
            PG8_LDA(At, 1, 1); PG8_STAGE(PG8_SB(1, 0), b3, voffB); PG8_STAGE(PG8_SB(1, 1), b3 + hstep, voffB); PG8_STAGE(PG8_SA(1, 0), a3, voffA);
            PG8_WAIT_V(8); PG8_WAIT_L(0); PG8_BAR; PG8_MMA(1, 0, At, B0); PG8_MMA(1, 1, At, B1); PG8_BAR; PG8_SCHED;
            } else {
            PG8_LDB(B0, 0, 0); PG8_SCHED; PG8_LDA(At, 0, 0); PG8_STAGE(PG8_SA(1, 1), a1 + hstep, voffA);
            PG8_WAIT_L(8); PG8_BAR; PG8_WAIT_L(0); PG8_MMA(0, 0, At, B0); PG8_BAR; PG8_SCHED;
            PG8_LDB(B1, 0, 1); PG8_STAGE(PG8_SB(0, 0), b2, voffB);
            PG8_BAR; PG8_WAIT_L(0); PG8_MMA(0, 1, At, B1); PG8_BAR;
            PG8_LDA(At, 0, 1); PG8_STAGE(PG8_SA(0, 0), a2, voffA);
            PG8_BAR; PG8_WAIT_L(0); PG8_MMA(1, 0, At, B0); PG8_BAR; PG8_SCHED;
            PG8_STAGE(PG8_SB(0, 1), b2 + hstep, voffB);
            PG8_WAIT_V(6); PG8_BAR; PG8_MMA(1, 1, At, B1); PG8_BAR;
            PG8_LDB(B0, 1, 0); PG8_SCHED; PG8_LDA(At, 1, 0); PG8_STAGE(PG8_SA(0, 1), a2 + hstep, voffA);
            PG8_WAIT_L(8); PG8_BAR; PG8_WAIT_L(0); PG8_MMA(0, 0, At, B0); PG8_BAR; PG8_SCHED;
            PG8_LDB(B1, 1, 1); PG8_STAGE(PG8_SB(1, 0), b3, voffB);
            PG8_BAR; PG8_WAIT_L(0); PG8_MMA(0, 1, At, B1); PG8_BAR;
            PG8_LDA(At, 1, 1); PG8_STAGE(PG8_SA(1, 0), a3, voffA);
            PG8_BAR; PG8_WAIT_L(0); PG8_MMA(1, 0, At, B0); PG8_BAR; PG8_SCHED;
            PG8_STAGE(PG8_SB(1, 1), b3 + hstep, voffB);
            PG8_WAIT_V(6); PG8_BAR; PG8_MMA(1, 1, At, B1); PG8_BAR;
            }
        }
        if constexpr (ALIGN_EPI) { if (wr == 0) PG8_BAR; }
        if constexpr (!Epi::AFTER_DRAIN) { E(acc, cur, wr, wc, fr, fq); S.done(cur); }
        if (!has_next) break;
#pragma unroll
        for (int a = 0; a < 2; ++a)
#pragma unroll
            for (int b = 0; b < 2; ++b)
#pragma unroll
                for (int m = 0; m < 4; ++m)
#pragma unroll
                    for (int n = 0; n < 2; ++n) acc[a][b][m][n] = (f32x4){0.f, 0.f, 0.f, 0.f};
        cur = nxt; cA = nA; cB = nB; ++ui;
        if constexpr (ALIGN_EPI) { if (wr == 1) PG8_BAR; }
    }
    PG8_WAIT_V(0);
    if constexpr (!ALIGN_EPI) { if (wr == 0) PG8_BAR; }
    PG8_BAR;
    if constexpr (Epi::AFTER_DRAIN) { E.fused(acc, cur, wr, wc, fr, fq, lds, wid, lane); S.done(cur); }
#undef PG8_SA
#undef PG8_SB
#undef PG8_STAGE
#undef PG8_LDA
#undef PG8_LDB
#undef PG8_MMA
#undef PG8_WAIT_V
#undef PG8_WAIT_L
#undef PG8_BAR
#undef PG8_SCHED
}
}
namespace attn_body {
using bf16=__hip_bfloat16;
using bf16x8=__attribute__((ext_vector_type(8)))short;
using s16x4=__attribute__((ext_vector_type(4)))short;
using f32x16=__attribute__((ext_vector_type(16)))float;
using u32x4=__attribute__((ext_vector_type(4)))unsigned;
constexpr int BATCH=8,NHEAD=8,SEQ=2048,D=64,DM=NHEAD*D,DMO=1024;
constexpr int NW=8,QBLK=32,QB=QBLK*NW,KVBLK=64,NQB=SEQ/QB;
constexpr int ATTN_PITCH=DM, ATTN_UNIT_ROWS=QB;
__device__ __forceinline__ int crow(int r,int hi){return (r&3)+8*(r>>2)+4*hi;}
#define SBAR() __builtin_amdgcn_sched_barrier(0)
typedef unsigned u32x16 __attribute__((ext_vector_type(16)));
constexpr int NSLOT=3, SLOTB=8192;
constexpr int LDS_K=0, LDS_V=NSLOT*SLOTB, LDS_WS=2*NSLOT*SLOTB, LDS_OST=LDS_WS+NW*64*4, LDS_BYTES=LDS_OST+NW*4096;
constexpr float C2=0.125f*1.4426950408889634f;
__device__ __forceinline__ void glds16(const void*gsrc,unsigned lds_dst){unsigned keep;
  asm volatile("s_mov_b32 %0, m0\n\ts_mov_b32 m0, %2\n\ts_nop 0\n\tglobal_load_lds_dwordx4 %1, off\n\ts_mov_b32 m0, %0":"=&s"(keep):"v"(gsrc),"s"(lds_dst):"memory");}
__device__ __forceinline__ float max3f(float a,float b,float c){float r;asm("v_max3_f32 %0, %1, %2, %3":"=v"(r):"v"(a),"v"(b),"v"(c));return r;}
__device__ __forceinline__ float max2f(float a,float b){float r;asm("v_max_f32_e32 %0, %1, %2":"=v"(r):"v"(a),"v"(b));return r;}
__device__ __forceinline__ float fadd_s(float a,float b){float r;asm("v_add_f32_e32 %0, %1, %2":"=v"(r):"v"(a),"v"(b));return r;}
__device__ __forceinline__ float fsub_s(float a,float b){float r;asm("v_sub_f32_e32 %0, %1, %2":"=v"(r):"v"(a),"v"(b));return r;}
typedef float f32x2_t __attribute__((ext_vector_type(2))); typedef __bf16 bf16x2_t __attribute__((ext_vector_type(2)));
__device__ __forceinline__ unsigned cvtpk_s(float lo,float hi){f32x2_t v={lo,hi};bf16x2_t b=__builtin_convertvector(v,bf16x2_t);return __builtin_bit_cast(unsigned,b);}
#define WAIT_BAR(N) asm volatile("s_waitcnt vmcnt(" #N ") lgkmcnt(0)\n\ts_barrier":::"memory")

__device__ __forceinline__ void qkt(f32x16&p0,f32x16&p1,const char*Kslot,const bf16x8*qr,int r32,int hi){ const f32x16 negm=f32x16{};
  const char*kb=Kslot+hi*1024+r32*16;
  #pragma unroll
  for(int d0=0;d0<4;++d0){
    const bf16x8 b0=*reinterpret_cast<const bf16x8*>(kb+d0*2048);
    const bf16x8 b1=*reinterpret_cast<const bf16x8*>(kb+d0*2048+512);
    if(d0==0){p0=__builtin_amdgcn_mfma_f32_32x32x16_bf16(b0,qr[0],negm,0,0,0);p1=__builtin_amdgcn_mfma_f32_32x32x16_bf16(b1,qr[0],negm,0,0,0);}
    else{p0=__builtin_amdgcn_mfma_f32_32x32x16_bf16(b0,qr[d0],p0,0,0,0);p1=__builtin_amdgcn_mfma_f32_32x32x16_bf16(b1,qr[d0],p1,0,0,0);}}
}
typedef __attribute__((address_space(3))) const char* lds_cptr;
typedef short v4i16_t __attribute__((ext_vector_type(4)));
__device__ __forceinline__ void kload8(bf16x8*kf,lds_cptr kp){
  kf[0]=*(const __attribute__((address_space(3))) bf16x8*)(kp);      kf[1]=*(const __attribute__((address_space(3))) bf16x8*)(kp+512);
  kf[2]=*(const __attribute__((address_space(3))) bf16x8*)(kp+2048); kf[3]=*(const __attribute__((address_space(3))) bf16x8*)(kp+2560);
  kf[4]=*(const __attribute__((address_space(3))) bf16x8*)(kp+4096); kf[5]=*(const __attribute__((address_space(3))) bf16x8*)(kp+4608);
  kf[6]=*(const __attribute__((address_space(3))) bf16x8*)(kp+6144); kf[7]=*(const __attribute__((address_space(3))) bf16x8*)(kp+6656);
}
__device__ __forceinline__ void kload2(bf16x8*kf,lds_cptr kp,int j){ kf[2*j]=*(const __attribute__((address_space(3))) bf16x8*)(kp+j*2048); kf[2*j+1]=*(const __attribute__((address_space(3))) bf16x8*)(kp+j*2048+512); }
__device__ __forceinline__ s16x4 vtr(lds_cptr p){ return __builtin_bit_cast(s16x4,__builtin_amdgcn_ds_read_tr16_b64_v4i16((__attribute__((address_space(3))) v4i16_t*)p)); }
__device__ __forceinline__ float rowmax(const f32x16&p0,const f32x16&p1){
  float a=max3f(p0[0],p0[1],p1[0]),b=max3f(p0[2],p0[3],p1[1]);a=max3f(a,p1[2],p1[3]);
  #pragma unroll
  for(int r=4;r<16;r+=4){a=max3f(a,p0[r],p0[r+1]);b=max3f(b,p0[r+2],p0[r+3]);a=max3f(a,p1[r],p1[r+1]);b=max3f(b,p1[r+2],p1[r+3]);}
  const float m=max2f(a,b);
  auto rr=__builtin_amdgcn_permlane32_swap(__float_as_uint(m),__float_as_uint(m),false,false);
  return max2f(__uint_as_float(rr[0]),__uint_as_float(rr[1]));
}
__device__ __forceinline__ void pv(f32x16*o,int vb,bf16x8 pa0,bf16x8 pa1,bf16x8 pa2,bf16x8 pa3){
  #pragma unroll
  for(int d0=0;d0<2;++d0){s16x4 lo[4],hi[4];
    #pragma unroll
    for(int ks=0;ks<4;++ks){
      asm volatile("ds_read_b64_tr_b16 %0,%1 offset:%c2":"=&v"(lo[ks]):"v"(vb),"i"(d0*4096+ks*1024):"memory");
      asm volatile("ds_read_b64_tr_b16 %0,%1 offset:%c2":"=&v"(hi[ks]):"v"(vb),"i"(d0*4096+ks*1024+512):"memory");}
    asm volatile("s_waitcnt lgkmcnt(0)":::"memory");SBAR();
    #define PK(k) (bf16x8){lo[k][0],lo[k][1],lo[k][2],lo[k][3],hi[k][0],hi[k][1],hi[k][2],hi[k][3]}
    o[d0]=__builtin_amdgcn_mfma_f32_32x32x16_bf16(pa0,PK(0),o[d0],0,0,0);
    o[d0]=__builtin_amdgcn_mfma_f32_32x32x16_bf16(pa1,PK(1),o[d0],0,0,0);
    o[d0]=__builtin_amdgcn_mfma_f32_32x32x16_bf16(pa2,PK(2),o[d0],0,0,0);
    o[d0]=__builtin_amdgcn_mfma_f32_32x32x16_bf16(pa3,PK(3),o[d0],0,0,0);
    #undef PK
  }
}

#ifndef ATTN_STORE16
#define ATTN_STORE16(p,v) (*(u32x4*)(p)=(v))
#endif
template<int THRL> __device__ __forceinline__ void attn_unit(int b,int h,int qb,const bf16*Q,const bf16*__restrict__ K,const bf16*__restrict__ V,bf16*O,const unsigned long long*MT,char*shm){
  const int tid=threadIdx.x,lane=tid&63,r32=lane&31,hi=lane>>5; const int wid=__builtin_amdgcn_readfirstlane(tid>>6);
  const long rowbase=(long)b*SEQ; const int q0=qb*QB;
  const bf16*Qw=Q+(rowbase+q0+wid*QBLK)*DM+h*D;
  const bf16*Kh=K+rowbase*DM+h*D,*Vh=V+rowbase*DM+h*D;
  const unsigned lds0=(unsigned)(uintptr_t)shm;
  float*wsf=(float*)(shm+LDS_WS)+wid*64;
  const bf16*ksrc=Kh+(long)lane*DM+wid*8;
  const bf16*vsrc=Vh+(long)(16*(wid&3)+(lane>>2))*DM+(wid>>2)*32+(lane&3)*8;
  const unsigned kdst=lds0+LDS_K+wid*1024, vdst=lds0+LDS_V+wid*1024;
  #define DMA_K(t,slot) glds16(ksrc+(long)(t)*KVBLK*DM,(unsigned)__builtin_amdgcn_readfirstlane(kdst+(slot)))
  #define DMA_V(t,slot) glds16(vsrc+(long)(t)*KVBLK*DM,(unsigned)__builtin_amdgcn_readfirstlane(vdst+(slot)))
  const int vb0=(int)(lds0+LDS_V)+((lane>>4)&1)*32+(lane&3)*8+(4*hi+((lane&15)>>2))*64;
  const char*Kbase=shm+LDS_K; bf16x8 kf[8];
  const lds_cptr shm3=(lds_cptr)shm; const lds_cptr kp0=shm3+LDS_K+hi*1024+r32*16; const lds_cptr vp0=shm3+LDS_V+((lane>>4)&1)*32+(lane&3)*8+(4*hi+((lane&15)>>2))*64;
  const int NT=(q0+QB)/KVBLK;
  const unsigned long long*mbase=MT+((size_t)((b*(SEQ/32)+qb*NW+wid)*(SEQ/KVBLK)))*32;
  u32x16 mk0,mk1,mk2,mk3; const float NEGV=-INFINITY;
  #define MLOAD(t) do{ const unsigned long long*mp_=mbase+(size_t)(t)*32; \
    asm volatile("s_load_dwordx16 %0, %4, 0x0\n\ts_load_dwordx16 %1, %4, 0x40\n\ts_load_dwordx16 %2, %4, 0x80\n\ts_load_dwordx16 %3, %4, 0xc0":"=&s"(mk0),"=&s"(mk1),"=&s"(mk2),"=&s"(mk3):"s"(mp_):"memory"); }while(0)
  #define MK64(v,i) (((unsigned long long)(v)[2*(i)+1]<<32)|(unsigned long long)(v)[2*(i)])
  #define MAPPLY(P0,P1) do{ asm volatile("s_waitcnt lgkmcnt(0)":"+s"(mk0),"+s"(mk1),"+s"(mk2),"+s"(mk3)::"memory"); \
    _Pragma("unroll") for(int r=0;r<8;++r){ P0[r]=__builtin_amdgcn_inverse_ballot_w64(MK64(mk0,r))?P0[r]:NEGV; P0[r+8]=__builtin_amdgcn_inverse_ballot_w64(MK64(mk1,r))?P0[r+8]:NEGV; \
      P1[r]=__builtin_amdgcn_inverse_ballot_w64(MK64(mk2,r))?P1[r]:NEGV; P1[r+8]=__builtin_amdgcn_inverse_ballot_w64(MK64(mk3,r))?P1[r+8]:NEGV; } }while(0)
  DMA_K(0,0);DMA_V(0,0);DMA_K(1,SLOTB);
  bf16x8 qr[4];
  #pragma unroll
  for(int d0=0;d0<4;++d0)qr[d0]=*reinterpret_cast<const bf16x8*>(&Qw[(long)r32*DM+d0*16+hi*8]);
  float mhat=0.f,l_reg=0.f;f32x16 o[2];o[0]=f32x16{};o[1]=f32x16{};const f32x16 zc=f32x16{};
  bool resc=false;
  #define START(P0,P1) do{ const float rm=rowmax(P0,P1); resc=false; \
    { const float dl=max2f(rm,-30.f); mhat=fadd_s(mhat,dl); \
      _Pragma("unroll") for(int r=0;r<16;++r){P0[r]=fsub_s(P0[r],dl);P1[r]=fsub_s(P1[r],dl);} \
      } \
    _Pragma("unroll") for(int r=0;r<16;++r)P0[r]=__builtin_amdgcn_exp2f(P0[r]); }while(0)
  #define RESC() do{ if(resc){ asm volatile("s_waitcnt lgkmcnt(0)":::"memory"); \
      _Pragma("unroll") for(int d_=0;d_<2;++d_) _Pragma("unroll") for(int r=0;r<16;++r)o[d_][r]*=wsf[crow(r,hi)]; } }while(0)
  f32x16 pA0,pA1,pB0,pB1;
  int sl_prev=0,sl_cur=0,sl_next=SLOTB;
  #define ROT() do{sl_prev=sl_cur;sl_cur=sl_next;sl_next=(sl_next==(NSLOT-1)*SLOTB)?0:sl_next+SLOTB;}while(0)
  DMA_K(2,2*SLOTB);
  WAIT_BAR(3);
  MLOAD(0); qkt(pA0,pA1,Kbase,qr,r32,hi);asm volatile("s_nop 15\n\ts_nop 7":"+v"(pA0),"+v"(pA1));MAPPLY(pA0,pA1);asm volatile("s_nop 1":"+v"(pA0),"+v"(pA1));
  START(pA0,pA1);
  _Pragma("unroll") for(int r=0;r<16;++r)pA1[r]=__builtin_amdgcn_exp2f(pA1[r]);
  WAIT_BAR(0);
  DMA_K(3,0);DMA_V(1,SLOTB);
  ROT();
  kload8(kf,kp0+sl_cur);
  WAIT_BAR(2);
  s16x4 vlo[8],vhi[8]; u32x4 pw0,pw1,pw2,pw3;
  #define PKW(P,B) cvtpk_s(P[B],P[B+1])
  #define PAF(k) __builtin_bit_cast(bf16x8,pw##k)
  #define VFR(i) (bf16x8){vlo[i][0],vlo[i][1],vlo[i][2],vlo[i][3],vhi[i][0],vhi[i][1],vhi[i][2],vhi[i][3]}
  #define PIN(x) asm volatile("":"+v"(x))
  #define MX3(a,b,c) __builtin_fmaxf(__builtin_fmaxf((a),(b)),(c))
  #define GAPA(MF,A0,A1,A2,A3,W0,W1,PW) do{ MF; sacc+=A0; sacc+=A1; sacc+=A2; sacc+=A3; PIN(sacc); W0; W1; PIN(PW); SBAR(); }while(0)
  #define EX(v) __builtin_amdgcn_exp2f(v)
  #define GAPB(MF,X,B) do{ MF; X[B]=EX(X[B]); X[B+1]=EX(X[B+1]); X[B+2]=EX(X[B+2]); X[B+3]=EX(X[B+3]); PIN(X); SBAR(); }while(0)
  #define VRD(i) do{ vlo[i]=vtr(vp_+(((i)>>2)*4096+((i)&3)*1024)); vhi[i]=vtr(vp_+(((i)>>2)*4096+((i)&3)*1024+512)); }while(0)
  #define KRD(G,j) do{ if(G){ kload2(kf,kp0+sl_next,j); SBAR(); } }while(0)
  #define STEP(C0,C1,P0,P1,t,GK,GV,GL) do{ SBAR(); MLOAD(t); \
    const lds_cptr vp_=vp0+sl_prev; \
    VRD(0); SBAR(); float sacc=(P0[0]+P0[1]); \
    GAPA(C0=__builtin_amdgcn_mfma_f32_32x32x16_bf16(kf[0],qr[0],zc,0,0,0), P0[2],P0[3],P0[4],P0[5],     pw0[0]=PKW(P0,0), pw0[1]=PKW(P0,2), pw0); \
    VRD(4); SBAR(); GAPA(C1=__builtin_amdgcn_mfma_f32_32x32x16_bf16(kf[1],qr[0],zc,0,0,0), P0[6],P0[7],P0[8],P0[9],     pw0[2]=PKW(P0,4), pw0[3]=PKW(P0,6), pw0); \
    VRD(1); SBAR(); GAPA(C0=__builtin_amdgcn_mfma_f32_32x32x16_bf16(kf[2],qr[1],C0,0,0,0),   P0[10],P0[11],P0[12],P0[13], pw1[0]=PKW(P0,8), pw1[1]=PKW(P0,10), pw1); \
    VRD(5); SBAR(); GAPA(C1=__builtin_amdgcn_mfma_f32_32x32x16_bf16(kf[3],qr[1],C1,0,0,0),   P0[14],P0[15],P1[0],P1[1],   pw1[2]=PKW(P0,12),pw1[3]=PKW(P0,14), pw1); \
    VRD(2); SBAR(); GAPA(C0=__builtin_amdgcn_mfma_f32_32x32x16_bf16(kf[4],qr[2],C0,0,0,0),   P1[2],P1[3],P1[4],P1[5],     pw2[0]=PKW(P1,0), pw2[1]=PKW(P1,2), pw2); \
    VRD(6); SBAR(); GAPA(C1=__builtin_amdgcn_mfma_f32_32x32x16_bf16(kf[5],qr[2],C1,0,0,0),   P1[6],P1[7],P1[8],P1[9],     pw2[2]=PKW(P1,4), pw2[3]=PKW(P1,6), pw2); \
    VRD(3); SBAR(); GAPA(C0=__builtin_amdgcn_mfma_f32_32x32x16_bf16(kf[6],qr[3],C0,0,0,0),   P1[10],P1[11],P1[12],P1[13], pw3[0]=PKW(P1,8), pw3[1]=PKW(P1,10), pw3); \
    VRD(7); SBAR(); GAPA(C1=__builtin_amdgcn_mfma_f32_32x32x16_bf16(kf[7],qr[3],C1,0,0,0),   P1[14],P1[15],0.f,0.f,       pw3[2]=PKW(P1,12),pw3[3]=PKW(P1,14), pw3); \
    l_reg+=sacc; \
    if(GK){DMA_K((t)+3,sl_cur);} if(GV){DMA_V((t)+1,sl_next);} \
    MAPPLY(C0,C1); \
    { float a=MX3(C0[0],C0[1],C1[0]),b=MX3(C0[2],C0[3],C1[1]); a=MX3(a,C1[2],C1[3]); \
      _Pragma("unroll") for(int r=4;r<16;r+=4){a=MX3(a,C0[r],C0[r+1]);b=MX3(b,C0[r+2],C0[r+3]);a=MX3(a,C1[r],C1[r+1]);b=MX3(b,C1[r+2],C1[r+3]);} \
      float rm=__builtin_fmaxf(a,b); { auto rr=__builtin_amdgcn_permlane32_swap(__float_as_uint(rm),__float_as_uint(rm),false,false); rm=__builtin_fmaxf(__uint_as_float(rr[0]),__uint_as_float(rr[1])); } \
      resc=false; \
      const float rl=rm-mhat; \
      if(__builtin_expect(__any(rl>(float)THRL),0)){ const float dl=__builtin_fmaxf(rl,0.f); mhat+=dl; \
        const float f=__builtin_amdgcn_exp2f(-dl); l_reg*=f; if(hi==0)wsf[r32]=f; resc=true; } \
      _Pragma("unroll") for(int r=0;r<16;++r){C0[r]-=mhat;C1[r]-=mhat;} } \
    SBAR(); \
    GAPB(o[0]=__builtin_amdgcn_mfma_f32_32x32x16_bf16(PAF(0),VFR(0),o[0],0,0,0), C0,0); \
    GAPB(o[1]=__builtin_amdgcn_mfma_f32_32x32x16_bf16(PAF(0),VFR(4),o[1],0,0,0), C0,4); \
    KRD(GL,0); GAPB(o[0]=__builtin_amdgcn_mfma_f32_32x32x16_bf16(PAF(1),VFR(1),o[0],0,0,0), C0,8); \
    KRD(GL,1); GAPB(o[1]=__builtin_amdgcn_mfma_f32_32x32x16_bf16(PAF(1),VFR(5),o[1],0,0,0), C0,12); \
    KRD(GL,2); GAPB(o[0]=__builtin_amdgcn_mfma_f32_32x32x16_bf16(PAF(2),VFR(2),o[0],0,0,0), C1,0); \
    KRD(GL,3); GAPB(o[1]=__builtin_amdgcn_mfma_f32_32x32x16_bf16(PAF(2),VFR(6),o[1],0,0,0), C1,4); \
    GAPB(o[0]=__builtin_amdgcn_mfma_f32_32x32x16_bf16(PAF(3),VFR(3),o[0],0,0,0), C1,8); \
    GAPB(o[1]=__builtin_amdgcn_mfma_f32_32x32x16_bf16(PAF(3),VFR(7),o[1],0,0,0), C1,12); \
    }while(0)
  int t=1;
  for(;t+5<NT;t+=2){
    STEP(pB0,pB1,pA0,pA1,t,true,true,true);     WAIT_BAR(2); RESC(); ROT();
    STEP(pA0,pA1,pB0,pB1,t+1,true,true,true);   WAIT_BAR(2); RESC(); ROT();
  }
  #define ENDW(tt) do{ if((tt)+3<NT){WAIT_BAR(2);} else if((tt)+2<NT){WAIT_BAR(1);} else {WAIT_BAR(0);} }while(0)
  for(;t+1<NT;t+=2){
    STEP(pB0,pB1,pA0,pA1,t,(t+3<NT),(t+1<NT),(t+1<NT));       ENDW(t);   RESC(); ROT();
    STEP(pA0,pA1,pB0,pB1,t+1,(t+4<NT),(t+2<NT),(t+2<NT));     ENDW(t+1); RESC(); ROT();
  }
  STEP(pB0,pB1,pA0,pA1,NT-1,false,false,false); RESC();
  { float sacc=pB0[0]+pB0[1]; _Pragma("unroll") for(int r=2;r<16;++r)sacc+=pB0[r]; _Pragma("unroll") for(int r=0;r<16;++r)sacc+=pB1[r]; l_reg+=sacc;
    pw0=(u32x4){PKW(pB0,0),PKW(pB0,2),PKW(pB0,4),PKW(pB0,6)};pw1=(u32x4){PKW(pB0,8),PKW(pB0,10),PKW(pB0,12),PKW(pB0,14)};pw2=(u32x4){PKW(pB1,0),PKW(pB1,2),PKW(pB1,4),PKW(pB1,6)};pw3=(u32x4){PKW(pB1,8),PKW(pB1,10),PKW(pB1,12),PKW(pB1,14)};
    SBAR(); pv(o,vb0+sl_cur,PAF(0),PAF(1),PAF(2),PAF(3)); }
  #undef PKW
  #undef PAF
  #undef VFR
  #undef PIN
  #undef MX3
  #undef GAPA
  #undef GAPB
  #undef EX
  #undef VRD
  #undef KRD
  #undef STEP
  #undef ENDW
  {auto rr=__builtin_amdgcn_permlane32_swap(__float_as_uint(l_reg),__float_as_uint(l_reg),false,false);l_reg=__uint_as_float(rr[0])+__uint_as_float(rr[1]);}
  if(hi==0)wsf[32+r32]=l_reg;asm volatile("s_waitcnt lgkmcnt(0)":::"memory");
  float rli[16];
  #pragma unroll
  for(int r=0;r<16;++r)rli[r]=__builtin_amdgcn_rcpf(wsf[32+crow(r,hi)]);
  bf16*Ow=O+(rowbase+q0+wid*QBLK)*DMO+h*D;
  { bf16*stg=(bf16*)(shm+LDS_OST)+wid*2048;
    #pragma unroll
    for(int r=0;r<16;++r){const int orow=crow(r,hi);
      #pragma unroll
      for(int d0=0;d0<2;++d0)stg[orow*64+d0*32+r32]=__float2bfloat16(o[d0][r]*rli[r]);}
    asm volatile("s_waitcnt lgkmcnt(0)":::"memory");
    #pragma unroll
    for(int i=0;i<4;++i){const int row=i*8+(lane>>3),ch=lane&7; const u32x4 v=*(const u32x4*)(stg+row*64+ch*8); ATTN_STORE16(Ow+(long)row*DMO+ch*8,v);} }
  asm volatile("s_waitcnt lgkmcnt(0)\n\ts_barrier":::"memory");
  #undef DMA_K
  #undef DMA_V
  #undef MLOAD
  #undef MK64
  #undef MAPPLY
  #undef START
  #undef RESC
  #undef ROT
}
constexpr int ATTN_LDS_BYTES=LDS_BYTES;
struct AttnTensors { const bf16* Q; const bf16* K; const bf16* V; bf16* O; const unsigned long long* MT; };
struct AttnUnit { int bh; int qb; };
struct StaticOrder {
  int vcu;
  __device__ __forceinline__ explicit StaticOrder(int grid,int block):vcu((block%8)*(grid/8)+block/8){}
  __device__ __forceinline__ bool next(int i,AttnUnit&u)const{ if(i>=2)return false; const int s=vcu&3; u.bh=vcu>>2; u.qb=(i==0)?s:7-s; return true; }
  __device__ __forceinline__ void a_ready(const AttnUnit&)const{}
  __device__ __forceinline__ void done(const AttnUnit&)const{}
};
template<class Sched,int THRL=8> __device__ __forceinline__ void attn_phase(char*lds,const AttnTensors&T,const Sched&S){
  AttnUnit u;
  for(int i=0;S.next(i,u);++i){ S.a_ready(u); attn_unit<THRL>(u.bh/NHEAD,u.bh%NHEAD,u.qb,T.Q,T.K,T.V,T.O,T.MT,lds); S.done(u); }
}
#undef SBAR
#undef WAIT_BAR
}
#define XB_TMO      128
#define XB_XCNT(j)  (256  + 64 * (j))
#define XB_XSUB(j)  (1280 + 64 * (j))
#define XB_XGEN(j)  (2304 + 64 * (j))
#define XB_TOP      3328
#define XB_TOPGEN   3392
#define XCD_BAR_WORDS 3456
#define XB_SPIN_CAP (1u << 18)

__device__ __forceinline__ unsigned xb_ld(unsigned* p)              { return __hip_atomic_load(p, __ATOMIC_RELAXED, __HIP_MEMORY_SCOPE_AGENT); }
__device__ __forceinline__ unsigned xb_add(unsigned* p, unsigned v) { return __hip_atomic_fetch_add(p, v, __ATOMIC_RELAXED, __HIP_MEMORY_SCOPE_AGENT); }
__device__ __forceinline__ unsigned xb_xcc_id() { return (unsigned)__builtin_amdgcn_s_getreg((3 << 11) | 20) & 0xFu; }
#define XB_SPIN(cond, bar) do { unsigned _sp = 0; while (cond) { __builtin_amdgcn_s_sleep(1); \
    if ((++_sp & 255u) == 0u) { if (xb_ld(&(bar)[XB_TMO])) break; if (_sp > XB_SPIN_CAP) { atomicAdd(&(bar)[XB_TMO], 1u); break; } } } } while (0)

struct XcdBarrier {
    unsigned* bar; unsigned x;
    volatile LAS unsigned* st;
};

__device__ __forceinline__ XcdBarrier xcd_barrier_post(unsigned* bar, volatile LAS unsigned* st) {
    XcdBarrier b; b.bar = bar; b.x = xb_xcc_id(); b.st = st;
    if (threadIdx.x == 0) (void)xb_add(&bar[XB_XCNT(b.x)], 1u);
    return b;
}
__device__ __forceinline__ void xcd_barrier_complete(unsigned* bar, unsigned x, unsigned& nloc, unsigned& nx) {
    const unsigned G = gridDim.x * gridDim.y * gridDim.z;
    unsigned sum, cnt, mine, sp = 0u;
    for (;;) {
        sum = 0u; cnt = 0u; mine = 0u;
#pragma unroll
        for (unsigned j = 0; j < 16; ++j) { const unsigned c = xb_ld(&bar[XB_XCNT(j)]); sum += c; cnt += (c > 0u) ? 1u : 0u; mine = (j == x) ? c : mine; }
        if (sum == G) break;
        __builtin_amdgcn_s_sleep(1);
        if ((++sp & 255u) == 0u) { if (xb_ld(&bar[XB_TMO])) break; if (sp > XB_SPIN_CAP) { atomicAdd(&bar[XB_TMO], 1u); break; } }
    }
    nloc = mine > 0u ? mine : 1u; nx = cnt > 0u ? cnt : 1u;
}

__device__ __forceinline__ void xcd_barrier(const XcdBarrier& b) {
    asm volatile("s_waitcnt vmcnt(0)" ::: "memory");
    __syncthreads();
    if (threadIdx.x == 0) {
        unsigned* bar = b.bar;
        __builtin_amdgcn_s_waitcnt(0);
        unsigned nloc = b.st[0], nx = b.st[1];
        if (nloc == 0u) { xcd_barrier_complete(bar, b.x, nloc, nx); b.st[0] = nloc; b.st[1] = nx; }
        const unsigned old = xb_add(&bar[XB_XSUB(b.x)], 1u);
        const unsigned gen = old / nloc;
        if (old + 1u == (gen + 1u) * nloc) {
            __builtin_amdgcn_fence(__ATOMIC_RELEASE, "agent");
            asm volatile("s_waitcnt vmcnt(0)" ::: "memory");
            const unsigned og = xb_add(&bar[XB_TOP], 1u);
            const unsigned tg = og / nx;
            if (og + 1u == (tg + 1u) * nx) xb_add(&bar[XB_TOPGEN], 1u);
            else XB_SPIN(xb_ld(&bar[XB_TOPGEN]) == tg, bar);
            __builtin_amdgcn_fence(__ATOMIC_ACQUIRE, "agent");
            xb_add(&bar[XB_XGEN(b.x)], 1u);
            asm volatile("s_waitcnt vmcnt(0)" ::: "memory");
        } else {
            XB_SPIN(xb_ld(&bar[XB_XGEN(b.x)]) == gen, bar);
            __builtin_amdgcn_fence(__ATOMIC_ACQUIRE, "agent");
            asm volatile("s_waitcnt vmcnt(0)" ::: "memory");
        }
    }
    __syncthreads();
}
#define GAS __attribute__((address_space(1)))
#ifndef LAS
#define LAS __attribute__((address_space(3)))
#endif
typedef unsigned short bf16;
typedef unsigned v4u __attribute__((ext_vector_type(4)));
typedef float f32x4 __attribute__((ext_vector_type(4)));
#define LDS_WAIT() asm volatile("s_waitcnt lgkmcnt(0)" ::: "memory")
#define VM_WAIT() asm volatile("s_waitcnt vmcnt(0)" ::: "memory")

constexpr int D = 1024, NB = 8, T = 2048, MP = NB * T, NSMP = 32, MT = MP + NSMP, MPAD = 16640;
constexpr int ATT_W = 512, AH = 8, IH = 16, IDD = 64, TOPK = 256;
constexpr int RW_W = 512, RH = 8, RN = 64;
constexpr int RW_COLS = 1792, IN_COLS = 4432, NIN = 4608;
constexpr int FFN = 2816, NGU = 2 * FFN;
constexpr int NPAGES = 64, PAGE = 128, PAST = 8192, LS = PAST + 1, SCS_LD = 8704;
constexpr int O_Q = 0, O_K = 512, O_V = 1024, O_QI = 1536, O_KI = 2560, O_WI = 2624, O_RW = 2640;
constexpr float IDX_W_SCALE = 0.03125f;
constexpr float RMS_EPS = 1e-6f, GN_EPS = 64e-5f;
constexpr int MODW = 6 * D;

constexpr size_t OUT_Y = 0, OUT_YS = OUT_Y + (size_t)MP * D, OUT_KP = OUT_YS + (size_t)NSMP * D, OUT_VP = OUT_KP + (size_t)MP * ATT_W,
                 OUT_IKP = OUT_VP + (size_t)MP * ATT_W, OUT_WKVP = OUT_IKP + (size_t)MP * IDD, OUT_SHP = OUT_WKVP + (size_t)NB * RH * RN * RN,
                 OUT_KS = OUT_SHP + (size_t)NB * RW_COLS, OUT_VS = OUT_KS + (size_t)NSMP * ATT_W, OUT_IKS = OUT_VS + (size_t)NSMP * ATT_W,
                 OUT_WKVS = OUT_IKS + (size_t)NSMP * IDD, OUT_SHS = OUT_WKVS + (size_t)NSMP * RH * RN * RN, OUT_END = OUT_SHS + (size_t)NSMP * RW_COLS;
static_assert(OUT_END == 36052992, "output size");

constexpr size_t MiB = 1u << 20;
constexpr size_t WS_CTL = 0, CTL_ZERO_BYTES = 1 * MiB;
constexpr size_t WS_MOD = 1 * MiB;
constexpr size_t WS_WIN = 2 * MiB;
constexpr size_t WS_WOUT = 12 * MiB;
constexpr size_t WS_WGU = 14 * MiB;
constexpr size_t WS_WDN = 26 * MiB;
constexpr size_t WS_A1 = 32 * MiB;
constexpr size_t WS_A2 = 66 * MiB;
constexpr size_t WS_MIX = 100 * MiB;
constexpr size_t WS_HB = 134 * MiB;
constexpr size_t WS_X1 = 224 * MiB;
constexpr size_t WS_PROJ = 290 * MiB;
constexpr size_t WS_RAW = 584 * MiB;
constexpr size_t WS_RAW2 = 650 * MiB;
constexpr size_t WS_QN = 1008 * MiB;
constexpr size_t WS_RWA = 1042 * MiB, RWA_STRIDE = 33 * MiB;
constexpr size_t WS_Y = 1273 * MiB;
constexpr size_t WS_SC = 1306 * MiB;
constexpr size_t WS_SCS = 1434 * MiB;
constexpr size_t WS_MASK = 1436 * MiB;
constexpr size_t WS_SLIST = 1440 * MiB;
constexpr size_t WS_QB = 1444 * MiB, WS_KB = 1461 * MiB, WS_VB = 1478 * MiB;
constexpr size_t WS_MASKT = 1495 * MiB;
constexpr size_t WS_QIB = 1500 * MiB;
constexpr size_t WS_KIB = 1536 * MiB;
constexpr size_t WS_WI = 1539 * MiB;
constexpr size_t WS_END = 1541 * MiB;
constexpr int QI_LD = 17 * 64;
constexpr int CW_BAR = 4096;

constexpr int NWAVES = 8, NTHREADS = 512;
constexpr int LDS_BYTES = 147456, MISC_OFF = 131072 + 320;

__device__ __forceinline__ unsigned f2bf(float f) { unsigned u = __builtin_bit_cast(unsigned, f); return (u + 0x7fffu + ((u >> 16) & 1u)) >> 16; }
__device__ __forceinline__ unsigned pk2(float lo, float hi) { return f2bf(lo) | (f2bf(hi) << 16); }
__device__ __forceinline__ float wave_sum(float v) {
#pragma unroll
    for (int o = 1; o < 64; o <<= 1) v += __shfl_xor(v, o);
    return v;
}
__device__ __forceinline__ float wave_max(float v) {
#pragma unroll
    for (int o = 1; o < 64; o <<= 1) v = fmaxf(v, __shfl_xor(v, o));
    return v;
}
__device__ __forceinline__ int wave_sum_i(int v) {
#pragma unroll
    for (int o = 1; o < 64; o <<= 1) v += __shfl_xor(v, o);
    return v;
}
__device__ __forceinline__ float sigmoidf_(float x) { return 1.f / (1.f + expf(-x)); }
__device__ __forceinline__ unsigned sortable(float f) { const unsigned u = __builtin_bit_cast(unsigned, f); return (u & 0x80000000u) ? ~u : (u | 0x80000000u); }
__device__ __forceinline__ unsigned long long lanemask_lt(int lane) { return (1ull << lane) - 1ull; }
__device__ __forceinline__ float rdlane(float v, int l) { return __builtin_bit_cast(float, __builtin_amdgcn_readlane(__builtin_bit_cast(int, v), l)); }

struct Args { const float* in[32]; float* out; unsigned char* ws; int ph_lo, ph_hi; };

struct Ctx {
    LAS unsigned char* lds;
    int tid, lane, wave, G, gw, ngw;
    const float* in[32]; float* out; unsigned char* ws;
};
__device__ __forceinline__ const float* x_row(const Ctx& C, int m) { return m < MP ? C.in[0] + (size_t)m * D : C.in[1] + (size_t)(m - MP) * D; }
__device__ __forceinline__ int mod_row(int m) { return m < MP ? (m >> 11) : NB + (m - MP); }

struct EpiRawF32 {
    static constexpr bool PERM = false, AFTER_DRAIN = false;
    float* O; int ldc;
    __device__ __forceinline__ void operator()(const pg8::f32x4 (&acc)[2][2][4][2], const pg8::Unit& u, int wr, int wc, int fr, int fq) const {
        const int row0 = u.pm * 256 + wr * 64 + fr, col0 = u.pn * 256 + wc * 32 + 4 * fq;
#pragma unroll
        for (int ai = 0; ai < 2; ++ai)
#pragma unroll
            for (int m = 0; m < 4; ++m) { float* rowp = O + (size_t)(row0 + ai * 128 + m * 16) * ldc + col0;
#pragma unroll
                for (int bj = 0; bj < 2; ++bj)
#pragma unroll
                    for (int n = 0; n < 2; ++n) *(pg8::f32x4*)(rowp + bj * 128 + n * 16) = acc[ai][bj][m][n]; }
    }
};

__device__ __forceinline__ void p0_mod(const Ctx& C) {
    LAS float* sc = (LAS float*)C.lds;
    const float* cp = C.in[8]; const float* cs = C.in[9]; const float* wada = C.in[12]; const float* bada = C.in[13];
    float* MOD = (float*)(C.ws + WS_MOD);
    const int cl = C.tid & 31, kc = C.tid >> 5;
    for (int u = blockIdx.x; u < MODW / 32; u += C.G) {
        const int c0 = 32 * u;
        float acc[40];
#pragma unroll
        for (int r = 0; r < 40; ++r) acc[r] = 0.f;
        for (int hh = 0; hh < 2; ++hh) {
            __syncthreads();
            for (int i = C.tid; i < 40 * 512; i += NTHREADS) { const int r = i >> 9, kk = i & 511; const float v = (r < NB) ? cp[r * D + 512 * hh + kk] : cs[(r - NB) * D + 512 * hh + kk]; sc[i] = v / (1.f + expf(-v)); }
            __syncthreads();
            const int kb = 512 * hh + 32 * kc;
            for (int k4 = 0; k4 < 8; ++k4) {
                const float* wp = wada + (size_t)(kb + 4 * k4) * MODW + c0 + cl;
                const float w0 = wp[0], w1 = wp[MODW], w2 = wp[2 * MODW], w3 = wp[3 * MODW];
#pragma unroll
                for (int r = 0; r < 40; ++r) { const f32x4 s = *(const LAS f32x4*)(sc + r * 512 + 32 * kc + 4 * k4); acc[r] += s.x * w0 + s.y * w1 + s.z * w2 + s.w * w3; }
            }
        }
        __syncthreads();
#pragma unroll
        for (int r = 0; r < 40; ++r) sc[(kc * 40 + r) * 32 + cl] = acc[r];
        __syncthreads();
        for (int i = C.tid; i < 40 * 32; i += NTHREADS) { const int r = i >> 5, c = i & 31; float s = 0.f;
            for (int k = 0; k < 16; ++k) s += sc[(k * 40 + r) * 32 + c];
            MOD[r * MODW + c0 + c] = s + bada[c0 + c]; }
    }
    __syncthreads();
}
__device__ __forceinline__ void transpose_item(const float* W, int K, int N, int NP, bf16* WT, int row_off, LAS float* scr, int item, int lane) {
    const int nblk = NP / 32, kb = item / nblk, nb = item % nblk, k0 = 64 * kb, n0 = 32 * nb;
    const int nsrc = n0 + (lane & 31);
#pragma unroll 8
    for (int i = 0; i < 32; ++i) { const int kk = 2 * i + (lane >> 5); scr[kk * 33 + (lane & 31)] = (nsrc < N) ? W[(size_t)(k0 + kk) * N + nsrc] : 0.f; }
    LDS_WAIT(); asm volatile("" ::: "memory");
    const int c = lane & 7;
#pragma unroll
    for (int j = 0; j < 4; ++j) { const int n = (lane >> 3) + 8 * j; const LAS float* s = scr + (8 * c) * 33 + n;
        v4u o; o.x = pk2(s[0 * 33], s[1 * 33]); o.y = pk2(s[2 * 33], s[3 * 33]); o.z = pk2(s[4 * 33], s[5 * 33]); o.w = pk2(s[6 * 33], s[7 * 33]);
        *(GAS v4u*)(WT + (size_t)(row_off + n0 + n) * K + k0 + 8 * c) = o; }
    LDS_WAIT(); asm volatile("" ::: "memory");
}
__device__ __forceinline__ void p0_weights(const Ctx& C) {
    LAS float* scr = (LAS float*)(C.lds + C.wave * 16384);
    constexpr int I_IN = (D / 64) * (NIN / 32), I_OUT = (D / 64) * (D / 32), I_G = (D / 64) * (FFN / 32), I_DN = (FFN / 64) * (D / 32);
    constexpr int NITEMS = I_IN + I_OUT + 2 * I_G + I_DN;
    bf16* WIN = (bf16*)(C.ws + WS_WIN); bf16* WOUT = (bf16*)(C.ws + WS_WOUT); bf16* WGU = (bf16*)(C.ws + WS_WGU); bf16* WDN = (bf16*)(C.ws + WS_WDN);
    for (int it = C.gw; it < NITEMS; it += C.ngw) {
        int r = it;
        if (r < I_IN) { transpose_item(C.in[14], D, IN_COLS, NIN, WIN, 0, scr, r, C.lane); continue; } r -= I_IN;
        if (r < I_OUT) { transpose_item(C.in[28], D, D, D, WOUT, 0, scr, r, C.lane); continue; } r -= I_OUT;
        if (r < I_G) { transpose_item(C.in[29], D, FFN, FFN, WGU, 0, scr, r, C.lane); continue; } r -= I_G;
        if (r < I_G) { transpose_item(C.in[30], D, FFN, FFN, WGU, FFN, scr, r, C.lane); continue; } r -= I_G;
        transpose_item(C.in[31], FFN, D, D, WDN, 0, scr, r, C.lane);
    }
}
__device__ __forceinline__ void norm_mod_row(const Ctx& C, int m, const float* xr, const float* g, const float* shift, const float* scale, bf16* orow) {
    const GAS f32x4* xp = (const GAS f32x4*)xr + C.lane;
    f32x4 v[4]; float s = 0.f;
#pragma unroll
    for (int j = 0; j < 4; ++j) { v[j] = xp[64 * j]; s += (v[j].x * v[j].x + v[j].y * v[j].y) + (v[j].z * v[j].z + v[j].w * v[j].w); }
    const float rstd = 1.f / sqrtf(wave_sum(s) * (1.f / D) + RMS_EPS);
    GAS unsigned long long* o8 = (GAS unsigned long long*)orow + C.lane;
#pragma unroll
    for (int j = 0; j < 4; ++j) { const int c = 4 * (C.lane + 64 * j);
        const f32x4 gg = *(const f32x4*)(g + c), sh = *(const f32x4*)(shift + c), sc = *(const f32x4*)(scale + c);
        const f32x4 h = v[j] * rstd * gg * (1.f + sc) + sh;
        o8[64 * j] = (unsigned long long)pk2(h.x, h.y) | ((unsigned long long)pk2(h.z, h.w) << 32); }
}
__device__ __forceinline__ void p1_norm1(const Ctx& C) {
    bf16* A1 = (bf16*)(C.ws + WS_A1); const float* MOD = (const float*)(C.ws + WS_MOD);
    for (int m = C.gw; m < MPAD; m += C.ngw) {
        bf16* orow = A1 + (size_t)m * D;
        if (m >= MT) { GAS unsigned long long* o8 = (GAS unsigned long long*)orow + C.lane;
#pragma unroll
            for (int j = 0; j < 4; ++j) o8[64 * j] = 0ull;
            continue; }
        const float* md = MOD + mod_row(m) * MODW;
        norm_mod_row(C, m, x_row(C, m), C.in[10], md, md + D, orow);
    }
}
__device__ __forceinline__ void p3_post(const Ctx& C) {
    const float* PROJ = (const float*)(C.ws + WS_PROJ); float* QN = (float*)(C.ws + WS_QN);
    const int lane = C.lane;
    const float qg = C.in[15][lane], kg = C.in[16][lane];
    for (int m = C.gw; m < MT; m += C.ngw) {
        const float* p = PROJ + (size_t)m * NIN;
        const bool smp = m >= MP; const int j = m - MP;
        float* ko = C.out + (smp ? OUT_KS + (size_t)j * ATT_W : OUT_KP + (size_t)m * ATT_W);
        float* vo = C.out + (smp ? OUT_VS + (size_t)j * ATT_W : OUT_VP + (size_t)m * ATT_W);
        float* io = C.out + (smp ? OUT_IKS + (size_t)j * IDD : OUT_IKP + (size_t)m * IDD);
        float* qn = QN + (size_t)m * ATT_W;
        bf16* qb = (bf16*)(C.ws + WS_QB) + (size_t)m * ATT_W; bf16* kb = (bf16*)(C.ws + WS_KB) + (size_t)m * ATT_W; bf16* vb = (bf16*)(C.ws + WS_VB) + (size_t)m * ATT_W;
        for (int h = 0; h < AH; ++h) {
            const float q = p[O_Q + h * 64 + lane], k = p[O_K + h * 64 + lane];
            const float sq = wave_sum(q * q), sk = wave_sum(k * k);
            const float qv = q * (1.f / sqrtf(sq * (1.f / 64.f) + RMS_EPS)) * qg, kv = k * (1.f / sqrtf(sk * (1.f / 64.f) + RMS_EPS)) * kg, vv = p[O_V + h * 64 + lane];
            qn[h * 64 + lane] = qv; ko[h * 64 + lane] = kv; vo[h * 64 + lane] = vv;
            qb[h * 64 + lane] = (bf16)f2bf(qv * attn_body::C2); kb[h * 64 + lane] = (bf16)f2bf(kv); vb[h * 64 + lane] = (bf16)f2bf(vv);
        }
        const float ki = p[O_KI + lane];
        const float kin = ki * (1.f / sqrtf(wave_sum(ki * ki) * (1.f / 64.f) + RMS_EPS));
        io[lane] = kin;
        ((bf16*)(C.ws + WS_KIB))[(size_t)m * IDD + lane] = (bf16)f2bf(kin);
        { bf16* qi = (bf16*)(C.ws + WS_QIB) + (size_t)m * QI_LD; float ql = 0.f;
          for (int h = 0; h < IH; ++h) { const float v = p[O_QI + h * 64 + lane]; qi[h * 64 + lane] = (bf16)f2bf(v); ql += p[O_WI + h] * v; }
          qi[IH * 64 + lane] = (bf16)f2bf(ql);
          if (lane < IH) ((float*)(C.ws + WS_WI))[(size_t)m * IH + lane] = p[O_WI + lane]; }
        if (smp || (m & (T - 1)) == T - 1) {
            float* so = C.out + (smp ? OUT_SHS + (size_t)j * RW_COLS : OUT_SHP + (size_t)(m >> 11) * RW_COLS);
            for (int i = 0; i < RW_COLS / 64; ++i) so[i * 64 + lane] = p[O_RW + i * 64 + lane];
        }
    }
}
__device__ __forceinline__ void p3_rwprep(const Ctx& C) {
    const float* PROJ = (const float*)(C.ws + WS_PROJ);
    float* Rr = (float*)(C.ws + WS_RWA), *Wd = (float*)(C.ws + WS_RWA + RWA_STRIDE), *Kp = (float*)(C.ws + WS_RWA + 2 * RWA_STRIDE), *Vv = (float*)(C.ws + WS_RWA + 3 * RWA_STRIDE),
          *KK = (float*)(C.ws + WS_RWA + 4 * RWA_STRIDE), *Bb = (float*)(C.ws + WS_RWA + 5 * RWA_STRIDE), *Gg = (float*)(C.ws + WS_RWA + 6 * RWA_STRIDE);
    const float* mu = C.in[17]; const float* w0 = C.in[18]; const float* w2 = C.in[19]; const float* a0 = C.in[20]; const float* a2 = C.in[21]; const float* g2 = C.in[22];
    const float* k_k = C.in[23]; const float* k_a = C.in[24];
    LAS float* lw = (LAS float*)(C.lds + C.wave * 1024);
    const int lane = C.lane;
    for (int m = C.gw; m < MT; m += C.ngw) {
        const float* p = PROJ + (size_t)m * NIN + O_RW;
        const bool smp = m >= MP; const int j = m - MP; const int t = m & (T - 1);
        const float* pv = smp ? C.in[6] + (size_t)j * RW_COLS : (t == 0 ? nullptr : p - NIN);
#define XM(c) ({ const int c_ = (c); const float cur_ = p[c_]; const float prv_ = pv ? pv[c_] : 0.f; cur_ + (prv_ - cur_) * mu[c_]; })
        lw[lane] = tanhf(XM(1536 + lane)); lw[64 + lane] = XM(1600 + lane); lw[128 + lane] = sigmoidf_(XM(1664 + lane)); lw[192 + lane] = sigmoidf_(XM(1728 + lane));
        LDS_WAIT(); asm volatile("" ::: "memory");
        for (int h = 0; h < RH; ++h) {
            const int c = h * 64 + lane;
            float aw = w0[c], aa = a0[c], ag = 0.f;
            for (int jj = 0; jj < 64; ++jj) { aw += lw[jj] * w2[jj * RW_W + c]; aa += lw[64 + jj] * a2[jj * RW_W + c]; }
            for (int jj = 0; jj < 128; ++jj) ag += lw[128 + jj] * g2[jj * RW_W + c];
            const float decay = expf(-0.6065306597126334f * sigmoidf_(aw));
            const float a = sigmoidf_(aa);
            const float r = XM(c), k = XM(512 + c), v = XM(1024 + c);
            float kk = k * k_k[c]; const float nrm = wave_sum(kk * kk); kk *= 1.f / sqrtf(fmaxf(nrm, 1e-24f));
            const float kp = k * (1.f + (a - 1.f) * k_a[c]);
            const size_t o = (size_t)m * RW_W + c;
            Rr[o] = r; Wd[o] = decay; Kp[o] = kp; Vv[o] = v; KK[o] = kk; Bb[o] = kk * a; Gg[o] = ag;
        }
#undef XM
        LDS_WAIT(); asm volatile("" ::: "memory");
    }
}
namespace idxsel {
typedef short bf16x8 __attribute__((ext_vector_type(8)));
typedef float f32x16 __attribute__((ext_vector_type(16)));
constexpr int QT_BYTES = 17 * 32 * 128, WT_OFF = QT_BYTES, CNT_OFF = WT_OFF + 32 * 17 * 4;
__device__ __forceinline__ int crow(int r, int hi) { return (r & 3) + 8 * (r >> 2) + 4 * hi; }
__device__ __forceinline__ void unit(const Ctx& C, int b, int qg) {
    const int lane = C.lane, r32 = lane & 31, hi = lane >> 5, wave = C.wave;
    LAS unsigned char* lds = C.lds;
    const bf16* QIb = (const bf16*)(C.ws + WS_QIB); const bf16* KIb = (const bf16*)(C.ws + WS_KIB); const float* WIr = (const float*)(C.ws + WS_WI);
    unsigned long long* MASKT = (unsigned long long*)(C.ws + WS_MASKT);
    LAS float* WT = (LAS float*)(lds + WT_OFF); LAS int* CNT = (LAS int*)(lds + CNT_OFF);
    const size_t row0 = (size_t)b * T + 32 * qg;
    __syncthreads();
    for (int i = C.tid; i < 32 * 136; i += NTHREADS) { const int q = i / 136, hc = i % 136, h = hc >> 3, c = hc & 7;
        const v4u v = *(const v4u*)(QIb + (row0 + q) * QI_LD + hc * 8);
        *(LAS v4u*)(lds + ((h * 32 + q) * 8 + (c ^ (q & 7))) * 16) = v; }
    { const int q = C.tid >> 4, h = C.tid & 15; WT[q * 17 + h] = WIr[(row0 + q) * IH + h]; }
    __syncthreads();
    f32x16 sc[8];
#pragma unroll
    for (int j = 0; j < 8; ++j) sc[j] = f32x16{};
#pragma unroll
    for (int j = 0; j < 8; ++j) {
        const int kt0 = wave + 8 * j;
        asm volatile("" ::: "memory");
        if (kt0 <= qg) {
            bf16x8 ka[4];
            const bf16* kp0 = KIb + ((size_t)b * T + kt0 * 32 + r32) * IDD + 8 * hi;
#pragma unroll
            for (int s4 = 0; s4 < 4; ++s4) ka[s4] = *(const bf16x8*)(kp0 + 16 * s4);
            bf16x8 qf[4];
#pragma unroll
            for (int s4 = 0; s4 < 4; ++s4) qf[s4] = *(const LAS bf16x8*)(lds + ((0 * 32 + r32) * 8 + ((2 * s4 + hi) ^ (r32 & 7))) * 16);
#pragma unroll 1
            for (int h = 0; h < 17; ++h) {
                bf16x8 qn[4];
                const int hn = h < 16 ? h + 1 : 16;
#pragma unroll
                for (int s4 = 0; s4 < 4; ++s4) qn[s4] = *(const LAS bf16x8*)(lds + ((hn * 32 + r32) * 8 + ((2 * s4 + hi) ^ (r32 & 7))) * 16);
                const float w = WT[r32 * 17 + h];
                f32x16 xa = f32x16{};
#pragma unroll
                for (int s4 = 0; s4 < 4; ++s4) xa = __builtin_amdgcn_mfma_f32_32x32x16_bf16(ka[s4], qf[s4], xa, 0, 0, 0);
                if (h < 16) {
#pragma unroll
                    for (int r = 0; r < 16; ++r) sc[j][r] = __builtin_fmaf(__builtin_fabsf(xa[r]), w, sc[j][r]); }
                else {
#pragma unroll
                    for (int r = 0; r < 16; ++r) sc[j][r] += xa[r]; }
#pragma unroll
                for (int s4 = 0; s4 < 4; ++s4) qf[s4] = qn[s4];
            }
        }
    }
    unsigned key[8][16];
#pragma unroll
    for (int j = 0; j < 8; ++j) { const int kt = wave + 8 * j;
#pragma unroll
        for (int r = 0; r < 16; ++r) { const bool valid = (kt < qg) || (kt == qg && crow(r, hi) <= r32); key[j][r] = valid ? sortable(sc[j][r]) : 0u; } }
    unsigned Tk = 1u;
    if (qg >= 8) {
        Tk = 0u; int buf = 0;
        for (int bit = 31; bit >= 0; --bit) {
            const unsigned cand = Tk | (1u << bit); int c = 0;
#pragma unroll
            for (int j = 0; j < 8; ++j) if (wave + 8 * j <= qg) {
#pragma unroll
                for (int r = 0; r < 16; ++r) c += (key[j][r] >= cand) ? 1 : 0; }
            c += __shfl_xor(c, 32);
            if (hi == 0) CNT[(buf * 8 + wave) * 32 + r32] = c;
            __syncthreads();
            int tot = 0;
#pragma unroll
            for (int w = 0; w < 8; ++w) tot += CNT[(buf * 8 + w) * 32 + r32];
            if (tot >= TOPK) Tk = cand;
            buf ^= 1;
        }
    }
#pragma unroll
    for (int j = 0; j < 8; ++j) { const int kt = wave + 8 * j; unsigned long long mine = 0ull;
#pragma unroll
        for (int r = 0; r < 16; ++r) { const unsigned long long W = __ballot(key[j][r] >= Tk); if (lane == r) mine = W; }
        if (lane < 16) MASKT[(((size_t)(b * 64 + qg) * 32 + (kt >> 1)) * 32) + (kt & 1) * 16 + lane] = mine; }
}
__device__ __forceinline__ void phase(const Ctx& C) {
    const int v = (int)((blockIdx.x % 8) * (C.G / 8) + blockIdx.x / 8);
    for (int vv = v; vv < NB * 32; vv += C.G) { const int b = vv >> 5, i = vv & 31; unit(C, b, 63 - i); unit(C, b, i); }
    __syncthreads();
}
}
__device__ __forceinline__ float idx_score(const float (&kr)[64], const LAS float* ql, const LAS float* wl) {
    float score = 0.f;
    for (int h = 0; h < IH; ++h) {
        float d = 0.f;
#pragma unroll
        for (int dd = 0; dd < 64; dd += 4) { const f32x4 qv = *(const LAS f32x4*)(ql + h * 64 + dd); d += qv.x * kr[dd] + qv.y * kr[dd + 1] + qv.z * kr[dd + 2] + qv.w * kr[dd + 3]; }
        score += wl[h] * fmaxf(d, 0.f);
    }
    return score;
}
template <bool PROMPT, bool SAMPLE> __device__ __forceinline__ void p4_indexer(const Ctx& C) {
    const float* PROJ = (const float*)(C.ws + WS_PROJ); float* SC = (float*)(C.ws + WS_SC); float* SCS = (float*)(C.ws + WS_SCS);
    LAS float* ql = (LAS float*)C.lds;
    LAS float* wl = ql + 16 * 1024;
    const int lane = C.lane;
    if (PROMPT) for (int u = blockIdx.x; u < NB * 128 * 4; u += C.G) {
        const int b = u >> 9, tq = (u >> 2) & 127, scn = u & 3, t0 = tq * 16;
        if (scn * 512 > t0 + 15) continue;
        __syncthreads();
        for (int i = C.tid; i < 16 * 1024; i += NTHREADS) { const int q = i >> 10, e = i & 1023; ql[i] = PROJ[(size_t)(b * T + t0 + q) * NIN + O_QI + e]; }
        if (C.tid < 256) { const int q = C.tid >> 4, h = C.tid & 15; wl[C.tid] = PROJ[(size_t)(b * T + t0 + q) * NIN + O_WI + h] * IDX_W_SCALE; }
        __syncthreads();
        const int s = scn * 512 + C.wave * 64 + lane;
        if (scn * 512 + C.wave * 64 <= t0 + 15) {
            float kr[64];
            const f32x4* kp = (const f32x4*)(C.out + OUT_IKP + (size_t)(b * T + s) * IDD);
#pragma unroll
            for (int i = 0; i < 16; ++i) { const f32x4 v = kp[i]; kr[4 * i] = v.x; kr[4 * i + 1] = v.y; kr[4 * i + 2] = v.z; kr[4 * i + 3] = v.w; }
            for (int q = 0; q < 16; ++q) {
                const float score = idx_score(kr, ql + q * 1024, wl + q * 16);
                const int t = t0 + q;
                if (s <= t) SC[((size_t)b * T + t) * T + s] = score;
            }
        }
    }
    __syncthreads();
    const int* pt = (const int*)C.in[7];
    LAS float* qw = (LAS float*)(C.lds + C.wave * 8192); LAS float* ww = qw + 1024;
    if (SAMPLE) for (int wu = C.gw; wu < NSMP * 129; wu += C.ngw) {
        const int j = wu / 129, kb = wu % 129;
        const float* pq = PROJ + (size_t)(MP + j) * NIN;
        for (int i = 0; i < 16; ++i) qw[i * 64 + lane] = pq[O_QI + i * 64 + lane];
        if (lane < 16) ww[lane] = pq[O_WI + lane] * IDX_W_SCALE;
        LDS_WAIT(); asm volatile("" ::: "memory");
        const int s = kb * 64 + lane;
        const float* krow = nullptr;
        if (s < PAST) krow = C.in[4] + ((size_t)pt[j * NPAGES + (s >> 7)] * PAGE + (s & 127)) * IDD;
        else if (s == PAST) krow = C.out + OUT_IKS + (size_t)j * IDD;
        float score = -INFINITY;
        if (krow) { float kr[64]; const f32x4* kp = (const f32x4*)krow;
#pragma unroll
            for (int i = 0; i < 16; ++i) { const f32x4 v = kp[i]; kr[4 * i] = v.x; kr[4 * i + 1] = v.y; kr[4 * i + 2] = v.z; kr[4 * i + 3] = v.w; }
            score = idx_score(kr, qw, ww); }
        SCS[(size_t)j * SCS_LD + s] = score;
        LDS_WAIT(); asm volatile("" ::: "memory");
    }
}
__device__ __forceinline__ void p4_scan(const Ctx& C) {
    const float* Rr = (const float*)(C.ws + WS_RWA), *Wd = (const float*)(C.ws + WS_RWA + RWA_STRIDE), *Kp = (const float*)(C.ws + WS_RWA + 2 * RWA_STRIDE), *Vv = (const float*)(C.ws + WS_RWA + 3 * RWA_STRIDE),
          *KK = (const float*)(C.ws + WS_RWA + 4 * RWA_STRIDE), *Bb = (const float*)(C.ws + WS_RWA + 5 * RWA_STRIDE);
    float* Y = (float*)(C.ws + WS_Y);
    const int lane = C.lane;
    for (int u = C.gw; u < NB * RH + NSMP * RH; u += C.ngw) {
        const bool smp = u >= NB * RH; const int seq = smp ? (u - NB * RH) / RH : u / RH, h = u % RH;
        const int nsteps = smp ? 1 : T; const size_t base = smp ? (size_t)(MP + seq) : (size_t)seq * T;
        float S[64];
        if (smp) { const f32x4* sp = (const f32x4*)(C.in[5] + (((size_t)seq * RH + h) * RN + lane) * RN);
#pragma unroll
            for (int i = 0; i < 16; ++i) { const f32x4 v = sp[i]; S[4 * i] = v.x; S[4 * i + 1] = v.y; S[4 * i + 2] = v.z; S[4 * i + 3] = v.w; } }
        else {
#pragma unroll
            for (int i = 0; i < 64; ++i) S[i] = 0.f; }
        size_t o = base * RW_W + h * 64 + lane;
        float r = Rr[o], w = Wd[o], k = Kp[o], v = Vv[o], kk = KK[o], bb = Bb[o];
        for (int t = 0; t < nsteps; ++t) {
            float rn = 0.f, wn = 0.f, kn = 0.f, vn = 0.f, kkn = 0.f, bbn = 0.f;
            const size_t on = o + RW_W;
            if (t + 1 < nsteps) { rn = Rr[on]; wn = Wd[on]; kn = Kp[on]; vn = Vv[on]; kkn = KK[on]; bbn = Bb[on]; }
            float sa0 = 0.f, sa1 = 0.f;
#pragma unroll
            for (int jx = 0; jx < 64; jx += 2) { sa0 += S[jx] * rdlane(kk, jx); sa1 += S[jx + 1] * rdlane(kk, jx + 1); }
            const float sa = -(sa0 + sa1);
            float y0 = 0.f, y1 = 0.f;
#pragma unroll
            for (int jx = 0; jx < 64; jx += 2) {
                S[jx] = S[jx] * rdlane(w, jx) + sa * rdlane(bb, jx) + v * rdlane(k, jx); y0 += S[jx] * rdlane(r, jx);
                S[jx + 1] = S[jx + 1] * rdlane(w, jx + 1) + sa * rdlane(bb, jx + 1) + v * rdlane(k, jx + 1); y1 += S[jx + 1] * rdlane(r, jx + 1); }
            Y[o] = y0 + y1;
            o = on; r = rn; w = wn; k = kn; v = vn; kk = kkn; bb = bbn;
        }
        f32x4* so = (f32x4*)(C.out + (smp ? OUT_WKVS : OUT_WKVP) + (((size_t)seq * RH + h) * RN + lane) * RN);
#pragma unroll
        for (int i = 0; i < 16; ++i) so[i] = (f32x4){S[4 * i], S[4 * i + 1], S[4 * i + 2], S[4 * i + 3]};
    }
}
template <bool PROMPT, bool SAMPLE> __device__ __forceinline__ void p5_select(const Ctx& C) {
    const float* SC = (const float*)(C.ws + WS_SC); unsigned* MASK = (unsigned*)(C.ws + WS_MASK);
    const int lane = C.lane;
    if (PROMPT) for (int row = C.gw; row < MP; row += C.ngw) {
        const int t = row & (T - 1); const float* sp = SC + (size_t)row * T;
        unsigned key[32];
#pragma unroll
        for (int j = 0; j < 32; ++j) { const int s = 64 * j + lane; key[j] = (s <= t) ? sortable(sp[s]) : 0u; }
        unsigned Tk = 0u; int need = 0;
        const bool all = (t + 1 <= TOPK);
        if (!all) {
            for (int bit = 31; bit >= 0; --bit) { const unsigned cand = Tk | (1u << bit); int cnt = 0;
#pragma unroll
                for (int j = 0; j < 32; ++j) cnt += __builtin_popcountll(__ballot(key[j] >= cand));
                if (cnt >= TOPK) Tk = cand; }
            int cgt = 0;
#pragma unroll
            for (int j = 0; j < 32; ++j) cgt += __builtin_popcountll(__ballot(key[j] > Tk));
            need = TOPK - cgt;
        }
        int running = 0;
#pragma unroll
        for (int j = 0; j < 32; ++j) {
            const int s = 64 * j + lane; bool take;
            if (all) take = (s <= t);
            else { const bool gt = key[j] > Tk, eq = key[j] == Tk; const unsigned long long eqb = __ballot(eq);
                const int pre = __builtin_popcountll(eqb & lanemask_lt(lane)); take = gt || (eq && (running + pre < need)); running += __builtin_popcountll(eqb); }
            const unsigned long long mb = __ballot(take);
            if (lane == 0) { MASK[(size_t)row * 64 + 2 * j] = (unsigned)mb; MASK[(size_t)row * 64 + 2 * j + 1] = (unsigned)(mb >> 32); }
        }
    }
    const float* SCS = (const float*)(C.ws + WS_SCS); int* SLIST = (int*)(C.ws + WS_SLIST);
    LAS int* sh = (LAS int*)C.lds;
    if (SAMPLE) for (int j = blockIdx.x; j < NSMP; j += C.G) {
        unsigned key[17];
#pragma unroll
        for (int i = 0; i < 17; ++i) { const int s = i * NTHREADS + C.tid; key[i] = (s < LS) ? sortable(SCS[(size_t)j * SCS_LD + s]) : 0u; }
        unsigned Tk = 0u;
        for (int bit = 31; bit >= 0; --bit) { const unsigned cand = Tk | (1u << bit); int c = 0;
#pragma unroll
            for (int i = 0; i < 17; ++i) c += (key[i] >= cand) ? 1 : 0;
            c = wave_sum_i(c);
            __syncthreads(); if (lane == 0) sh[C.wave] = c; __syncthreads();
            int cnt = 0;
#pragma unroll
            for (int w = 0; w < 8; ++w) cnt += sh[w];
            if (cnt >= TOPK) Tk = cand; }
        int cg = 0;
#pragma unroll
        for (int i = 0; i < 17; ++i) cg += (key[i] > Tk) ? 1 : 0;
        cg = wave_sum_i(cg);
        __syncthreads(); if (lane == 0) sh[C.wave] = cg; __syncthreads();
        int cgt = 0;
#pragma unroll
        for (int w = 0; w < 8; ++w) cgt += sh[w];
        const int need = TOPK - cgt;
        int run_eq = 0, run_sel = 0;
#pragma unroll
        for (int i = 0; i < 17; ++i) {
            const int s = i * NTHREADS + C.tid; const bool gt = key[i] > Tk, eq = key[i] == Tk;
            const unsigned long long eqb = __ballot(eq);
            __syncthreads(); if (lane == 0) sh[C.wave] = __builtin_popcountll(eqb); __syncthreads();
            int eq_before = 0, eq_tot = 0;
#pragma unroll
            for (int w = 0; w < 8; ++w) { const int x = sh[w]; eq_tot += x; if (w < C.wave) eq_before += x; }
            const bool take = gt || (eq && (run_eq + eq_before + __builtin_popcountll(eqb & lanemask_lt(lane)) < need));
            const unsigned long long tb = __ballot(take);
            __syncthreads(); if (lane == 0) sh[8 + C.wave] = __builtin_popcountll(tb); __syncthreads();
            int s_before = 0, s_tot = 0;
#pragma unroll
            for (int w = 0; w < 8; ++w) { const int x = sh[8 + w]; s_tot += x; if (w < C.wave) s_before += x; }
            const int pos = run_sel + s_before + __builtin_popcountll(tb & lanemask_lt(lane));
            if (take && pos < TOPK) SLIST[j * TOPK + pos] = s;
            run_eq += eq_tot; run_sel += s_tot;
        }
    }
    __syncthreads();
}
__device__ __forceinline__ void p5_rwfinal(const Ctx& C) {
    const float* Rr = (const float*)(C.ws + WS_RWA), *Kp = (const float*)(C.ws + WS_RWA + 2 * RWA_STRIDE), *Vv = (const float*)(C.ws + WS_RWA + 3 * RWA_STRIDE), *Gg = (const float*)(C.ws + WS_RWA + 6 * RWA_STRIDE);
    const float* Y = (const float*)(C.ws + WS_Y); bf16* MIX = (bf16*)(C.ws + WS_MIX);
    const float* r_k = C.in[25]; const float* ln_w = C.in[26]; const float* ln_b = C.in[27];
    const int lane = C.lane;
    for (int m = C.gw; m < MT; m += C.ngw) {
        for (int h = 0; h < RH; ++h) {
            const int c = h * 64 + lane; const size_t o = (size_t)m * RW_W + c;
            const float y = Y[o];
            const float mu = wave_sum(y) * (1.f / 64.f); const float dy = y - mu; const float var = wave_sum(dy * dy) * (1.f / 64.f);
            const float yn = dy * (1.f / sqrtf(var + GN_EPS)) * ln_w[c] + ln_b[c];
            const float bonus = wave_sum(Rr[o] * Kp[o] * r_k[c]) * Vv[o];
            MIX[(size_t)m * D + ATT_W + c] = (bf16)f2bf((yn + bonus) * Gg[o]);
        }
    }
}
__device__ __forceinline__ void p6_masktr(const Ctx& C) {
    const unsigned* MASK = (const unsigned*)(C.ws + WS_MASK); unsigned long long* MASKT = (unsigned long long*)(C.ws + WS_MASKT);
    const int lane = C.lane, q = lane & 31, hi = lane >> 5;
    for (int wu = C.gw; wu < NB * 64 * 32; wu += C.ngw) {
        const int j = wu & 31, qg = (wu >> 5) & 63, b = wu >> 11;
        const size_t row = (size_t)b * T + 32 * qg + q;
        const unsigned w0 = MASK[row * 64 + 2 * j], w1 = MASK[row * 64 + 2 * j + 1];
        unsigned long long mine = 0ull;
#pragma unroll
        for (int r = 0; r < 16; ++r) { const int c = (r & 3) + 8 * (r >> 2) + 4 * hi;
            const unsigned long long W0 = __ballot((w0 >> c) & 1u), W1 = __ballot((w1 >> c) & 1u);
            if (lane == r) mine = W0; if (lane == 16 + r) mine = W1; }
        if (lane < 32) MASKT[((size_t)((b * 64 + qg) * 32 + j)) * 32 + lane] = mine;
    }
}
template <int DIFFK> __device__ __forceinline__ void p6_attn(const Ctx& C, int u_begin, int u_end) {
    const unsigned* MASK = (const unsigned*)(C.ws + WS_MASK); const int* SLIST = (const int*)(C.ws + WS_SLIST); const float* QN = (const float*)(C.ws + WS_QN);
    bf16* MIX = (bf16*)(C.ws + WS_MIX); const int* pt = (const int*)C.in[7];
    LAS int* list = (LAS int*)C.lds;
    LAS float* pb = (LAS float*)(C.lds + 1024);
    LAS int* cntp = (LAS int*)(C.lds + 1024 + 8192);
    const int lane = C.lane, h = C.wave;
    for (int u = u_begin + blockIdx.x; u < u_end; u += C.G) {
        const bool smp = u >= MP; const int j = u - MP, b = u >> 11;
        __syncthreads();
        if (C.wave == 0) {
            if (!smp) { const unsigned w = MASK[(size_t)u * 64 + lane]; const int c = __builtin_popcount(w);
                int incl = c;
#pragma unroll
                for (int o = 1; o < 64; o <<= 1) { const int x = __shfl_up(incl, o); if (lane >= o) incl += x; }
                int pos = incl - c; unsigned ww = w;
                while (ww) { const int bit = __builtin_ctz(ww); ww &= ww - 1u; list[pos++] = 32 * lane + bit; }
                if (lane == 63) *cntp = incl; }
            else { for (int i = 0; i < 4; ++i) list[i * 64 + lane] = SLIST[j * TOPK + i * 64 + lane]; if (lane == 0) *cntp = TOPK; }
        }
        __syncthreads();
        int cnt = *cntp; if (cnt > TOPK) cnt = TOPK;
        float q[64];
        { const f32x4* qp = (const f32x4*)(QN + (size_t)u * ATT_W + h * 64);
#pragma unroll
          for (int i = 0; i < 16; ++i) { const f32x4 v = qp[i]; q[4 * i] = v.x; q[4 * i + 1] = v.y; q[4 * i + 2] = v.z; q[4 * i + 3] = v.w; } }
        float sc[4]; float mx = -INFINITY;
#pragma unroll
        for (int i = 0; i < 4; ++i) { const int idx = i * 64 + lane; sc[i] = -INFINITY;
            if (idx < cnt) { const int s = list[idx]; const float* kp;
                if (!smp) kp = C.out + OUT_KP + ((size_t)(b * T + s)) * ATT_W + h * 64;
                else if (s < PAST) kp = C.in[2] + ((size_t)pt[j * NPAGES + (s >> 7)] * PAGE + (s & 127)) * ATT_W + h * 64;
                else kp = C.out + OUT_KS + (size_t)j * ATT_W + h * 64;
                float d = 0.f;
#pragma unroll
                for (int e = 0; e < 16; ++e) { const f32x4 kv = ((const f32x4*)kp)[e]; d += q[4 * e] * kv.x + q[4 * e + 1] * kv.y + q[4 * e + 2] * kv.z + q[4 * e + 3] * kv.w; }
                sc[i] = d * 0.125f; }
            mx = fmaxf(mx, sc[i]); }
        mx = wave_max(mx); float l = 0.f;
#pragma unroll
        for (int i = 0; i < 4; ++i) { const int idx = i * 64 + lane; const float p = (idx < cnt) ? expf(sc[i] - mx) : 0.f; pb[h * 256 + idx] = p; l += p; }
        l = wave_sum(l);
        LDS_WAIT(); asm volatile("" ::: "memory");
        float o = 0.f;
        for (int kx = 0; kx < cnt; ++kx) { const int s = list[kx]; const float* vp;
            if (!smp) vp = C.out + OUT_VP + ((size_t)(b * T + s)) * ATT_W + h * 64;
            else if (s < PAST) vp = C.in[3] + ((size_t)pt[j * NPAGES + (s >> 7)] * PAGE + (s & 127)) * ATT_W + h * 64;
            else vp = C.out + OUT_VS + (size_t)j * ATT_W + h * 64;
            o += pb[h * 256 + kx] * vp[lane]; }
        if (DIFFK == 0) MIX[(size_t)u * D + h * 64 + lane] = (bf16)f2bf(o / l);
        else { const float a = __builtin_bit_cast(float, (unsigned)MIX[(size_t)u * D + h * 64 + lane] << 16); MIX[(size_t)u * D + h * 64 + lane] = (bf16)f2bf(a + (float)DIFFK * (a - o / l)); }
    }
    __syncthreads();
}
__device__ __forceinline__ void p8_res_norm2(const Ctx& C) {
    const float* RAW = (const float*)(C.ws + WS_RAW); float* X1 = (float*)(C.ws + WS_X1); bf16* A2 = (bf16*)(C.ws + WS_A2); const float* MOD = (const float*)(C.ws + WS_MOD);
    for (int m = C.gw; m < MPAD; m += C.ngw) {
        bf16* orow = A2 + (size_t)m * D;
        if (m >= MT) { GAS unsigned long long* o8 = (GAS unsigned long long*)orow + C.lane;
#pragma unroll
            for (int j = 0; j < 4; ++j) o8[64 * j] = 0ull;
            continue; }
        const float* md = MOD + mod_row(m) * MODW; const float* xr = x_row(C, m);
        float* x1 = X1 + (size_t)m * D;
#pragma unroll
        for (int j = 0; j < 4; ++j) { const int c = 4 * (C.lane + 64 * j);
            const f32x4 xv = *(const f32x4*)(xr + c), rv = *(const f32x4*)(RAW + (size_t)m * D + c), g1 = *(const f32x4*)(md + 2 * D + c);
            *(f32x4*)(x1 + c) = xv + g1 * rv; }
        VM_WAIT(); asm volatile("" ::: "memory");
        norm_mod_row(C, m, x1, C.in[11], md + 3 * D, md + 4 * D, orow);
    }
}
__device__ __forceinline__ void p10_swiglu(const Ctx& C) {
    const float* RAW2 = (const float*)(C.ws + WS_RAW2); bf16* HB = (bf16*)(C.ws + WS_HB);
    const size_t total = (size_t)MPAD * (FFN / 4);
    for (size_t i = (size_t)blockIdx.x * NTHREADS + C.tid; i < total; i += (size_t)C.G * NTHREADS) {
        const size_t m = i / (FFN / 4); const int c = (int)(i % (FFN / 4)) * 4;
        const f32x4 g = *(const f32x4*)(RAW2 + m * NGU + c), u = *(const f32x4*)(RAW2 + m * NGU + FFN + c);
        const float h0 = g.x / (1.f + expf(-g.x)) * u.x, h1 = g.y / (1.f + expf(-g.y)) * u.y, h2 = g.z / (1.f + expf(-g.z)) * u.z, h3 = g.w / (1.f + expf(-g.w)) * u.w;
        *(unsigned long long*)(HB + m * FFN + c) = (unsigned long long)pk2(h0, h1) | ((unsigned long long)pk2(h2, h3) << 32);
    }
}
__device__ __forceinline__ void p12_final(const Ctx& C) {
    const float* RAW = (const float*)(C.ws + WS_RAW); const float* X1 = (const float*)(C.ws + WS_X1); const float* MOD = (const float*)(C.ws + WS_MOD);
    for (int m = C.gw; m < MT; m += C.ngw) {
        const float* md = MOD + mod_row(m) * MODW;
        float* yo = C.out + (m < MP ? OUT_Y + (size_t)m * D : OUT_YS + (size_t)(m - MP) * D);
#pragma unroll
        for (int j = 0; j < 4; ++j) { const int c = 4 * (C.lane + 64 * j);
            const f32x4 xv = *(const f32x4*)(X1 + (size_t)m * D + c), rv = *(const f32x4*)(RAW + (size_t)m * D + c), g2 = *(const f32x4*)(md + 5 * D + c);
            *(f32x4*)(yo + c) = xv + g2 * rv; }
    }
}

constexpr int N_PHASES = 13;
__global__ void __launch_bounds__(NTHREADS, 2) fwd(Args args) {
    extern __shared__ __attribute__((aligned(16))) unsigned char lds[];
    Ctx C;
    C.lds = (LAS unsigned char*)lds;
    C.tid = threadIdx.x; C.lane = C.tid & 63; C.wave = __builtin_amdgcn_readfirstlane(C.tid >> 6);
    C.G = gridDim.x; C.gw = blockIdx.x * NWAVES + C.wave; C.ngw = C.G * NWAVES;
#pragma unroll
    for (int i = 0; i < 32; ++i) C.in[i] = args.in[i];
    C.out = args.out; C.ws = args.ws;
    const int lo = args.ph_lo, hi = args.ph_hi;
    volatile LAS unsigned* MISC = (volatile LAS unsigned*)(C.lds + MISC_OFF);
    if (C.tid < 32) MISC[C.tid] = 0u;
    __syncthreads();
    XcdBarrier bar = xcd_barrier_post((unsigned*)(C.ws + WS_CTL) + CW_BAR, MISC + 8);
#define IN(k) (lo <= (k) && (k) < hi)
#define SEAM(k) do { if (IN(k) && IN((k) + 1)) xcd_barrier(bar); } while (0)
    if (IN(0)) { p0_mod(C); p0_weights(C); }
    SEAM(0);
    if (IN(1)) { p1_norm1(C); }
    SEAM(1);
    if (IN(2)) {
        pg8::Gemm g{(const pg8::bf16_t*)(C.ws + WS_A1), (const pg8::bf16_t*)(C.ws + WS_WIN), MPAD, NIN, D}; pg8::StaticOrder S; S.init(MPAD, NIN, C.G, (int)blockIdx.x);
        EpiRawF32 E{(float*)(C.ws + WS_PROJ), NIN};
        pg8::gemm_phase<EpiRawF32, pg8::StaticOrder, true, true>(C.lds, g, S, E);
    }
    SEAM(2);
    if (IN(3)) { p3_post(C); p3_rwprep(C); }
    SEAM(3);
#ifdef PROBE_SEL
    if (IN(4)) { idxsel::phase(C); p4_indexer<true, true>(C); p4_scan(C); }
    SEAM(4);
    if (IN(5)) { p5_select<true, true>(C); p5_rwfinal(C); }
#else
    if (IN(4)) { idxsel::phase(C); p4_indexer<false, true>(C); p4_scan(C); }
    SEAM(4);
    if (IN(5)) { p5_select<false, true>(C); p5_rwfinal(C); }
#endif
    SEAM(5);
    if (IN(6)) {
        const attn_body::AttnTensors AT{(const attn_body::bf16*)(C.ws + WS_QB), (const attn_body::bf16*)(C.ws + WS_KB), (const attn_body::bf16*)(C.ws + WS_VB), (attn_body::bf16*)(C.ws + WS_MIX), (const unsigned long long*)(C.ws + WS_MASKT)};
        const attn_body::StaticOrder S((int)C.G, (int)blockIdx.x);
        attn_body::attn_phase<attn_body::StaticOrder>((char*)lds, AT, S);
        __syncthreads();
        p6_attn<0>(C, MP, MT);
#ifdef PROBE_SEL
        __syncthreads(); VM_WAIT(); xcd_barrier(bar); p6_attn<PROBE_SEL>(C, 0, MP);
#endif
    }
    SEAM(6);
    if (IN(7)) {
        pg8::Gemm g{(const pg8::bf16_t*)(C.ws + WS_MIX), (const pg8::bf16_t*)(C.ws + WS_WOUT), MPAD, D, D}; pg8::StaticOrder S; S.init(MPAD, D, C.G, (int)blockIdx.x);
        EpiRawF32 E{(float*)(C.ws + WS_RAW), D};
        pg8::gemm_phase<EpiRawF32, pg8::StaticOrder, true, true>(C.lds, g, S, E);
    }
    SEAM(7);
    if (IN(8)) { p8_res_norm2(C); }
    SEAM(8);
    if (IN(9)) {
        pg8::Gemm g{(const pg8::bf16_t*)(C.ws + WS_A2), (const pg8::bf16_t*)(C.ws + WS_WGU), MPAD, NGU, D}; pg8::StaticOrder S; S.init(MPAD, NGU, C.G, (int)blockIdx.x);
        EpiRawF32 E{(float*)(C.ws + WS_RAW2), NGU};
        pg8::gemm_phase<EpiRawF32, pg8::StaticOrder, true, true>(C.lds, g, S, E);
    }
    SEAM(9);
    if (IN(10)) { p10_swiglu(C); }
    SEAM(10);
    if (IN(11)) {
        pg8::Gemm g{(const pg8::bf16_t*)(C.ws + WS_HB), (const pg8::bf16_t*)(C.ws + WS_WDN), MPAD, D, FFN}; pg8::StaticOrder S; S.init(MPAD, D, C.G, (int)blockIdx.x);
        EpiRawF32 E{(float*)(C.ws + WS_RAW), D};
        pg8::gemm_phase<EpiRawF32, pg8::StaticOrder, true, true>(C.lds, g, S, E);
    }
    SEAM(11);
    if (IN(12)) { p12_final(C); }
#undef IN
#undef SEAM
}

extern "C" void kernel_launch(void* const* d_in, const int* in_sizes, int n_in, void* d_out, int out_size, void* d_ws, size_t ws_size, hipStream_t stream) {
    static int grid = 0;
    if (grid == 0) {
        if (n_in != 32 || (size_t)out_size != OUT_END || ws_size < WS_END) { fprintf(stderr, "kernel_launch: unexpected sizes n_in %d out %d ws %zu\n", n_in, out_size, ws_size); grid = -1; return; }
        int dev = 0, cus = 0;
        if (hipGetDevice(&dev) != hipSuccess || hipDeviceGetAttribute(&cus, hipDeviceAttributeMultiprocessorCount, dev) != hipSuccess) { grid = -1; return; }
        if (hipFuncSetAttribute((const void*)fwd, hipFuncAttributeMaxDynamicSharedMemorySize, LDS_BYTES) != hipSuccess) { fprintf(stderr, "kernel_launch: hipFuncSetAttribute failed\n"); grid = -1; return; }
        (void)hipGetLastError();
        grid = cus;
    }
    if (grid < 0) return;
    (void)hipMemsetAsync((char*)d_ws + WS_CTL, 0, CTL_ZERO_BYTES, stream);
    Args a{};
    for (int i = 0; i < 32; ++i) a.in[i] = (const float*)d_in[i];
    a.out = (float*)d_out; a.ws = (unsigned char*)d_ws;
    a.ph_lo = 0; a.ph_hi = N_PHASES;
    hipLaunchKernelGGL(fwd, dim3(grid), dim3(NTHREADS), LDS_BYTES, stream, a);
}
```

```cpp
#include <hip/hip_runtime.h>
#include <cstdio>
#include <cstdint>
#include <cmath>
#include <hip/hip_bf16.h>
#define LAS __attribute__((address_space(3)))
namespace pg8 {
#define PG8_LAS __attribute__((address_space(3)))
typedef unsigned short bf16_t;
typedef short bf16x8 __attribute__((ext_vector_type(8)));
typedef float f32x4 __attribute__((ext_vector_type(4)));
typedef unsigned u32x4 __attribute__((ext_vector_type(4)));
constexpr int BM = 256, BK = 64, HALF = 128, HTB = HALF * BK * 2  , STAGE_BYTES = 8 * HTB, NXCD = 8, WGM = 8;

__host__ __device__ __forceinline__ int lds_byte(int r, int c) { const int st = (r >> 4) * 2 + (c >> 5), rr = r & 15, cc = c & 31, ob = rr * 64 + cc * 2; return st * 1024 + (ob ^ (((ob >> 9) & 1) << 5)); }
__host__ __device__ __forceinline__ void stage_rc(int b, int& R, int& C) { const int st = b / 1024, sb = b % 1024, swz = sb ^ (((sb >> 9) & 1) << 5); R = (st >> 1) * 16 + swz / 64; C = (st & 1) * 32 + (swz % 64) / 2; }
__host__ __device__ __forceinline__ int perm32(int rho) { const int n = rho >> 4, i = rho & 15; return 8 * (i >> 2) + 4 * n + (i & 3); }

struct Unit { int pm, pn; };
struct Gemm { const bf16_t* A; const bf16_t* Bt; int M, N, K; };

struct StaticOrder {
    int nM, nN, nwg, G, c;
    __host__ __device__ void init(int M, int N, int G_, int c_) { nM = M / BM; nN = N / BM; nwg = nM * nN; G = G_; c = c_; }
    __host__ __device__ bool next(int i, Unit& u) const {
        const long L = (long)i * G + c; if (L >= nwg) return false;
        int wgid = (int)L; { const int q = nwg / NXCD, r = nwg % NXCD, xcd = wgid % NXCD, off = wgid / NXCD; wgid = (xcd < r ? xcd * (q + 1) : r * (q + 1) + (xcd - r) * q) + off; }
        const int nig = WGM * nN, gid = wgid / nig, fm = gid * WGM, gsz = (nM - fm) < WGM ? (nM - fm) : WGM;
        u.pm = fm + ((wgid % nig) % gsz); u.pn = (wgid % nig) / gsz; return true;
    }
    __device__ __forceinline__ void a_ready(const Unit&) const {}
    __device__ __forceinline__ void done(const Unit&) const {}
};

__device__ __forceinline__ unsigned cvt_pk_bf16(float lo, float hi) { unsigned r; asm volatile("v_cvt_pk_bf16_f32 %0, %1, %2" : "=v"(r) : "v"(lo), "v"(hi)); return r; }
typedef float f32x2 __attribute__((ext_vector_type(2)));
__device__ __forceinline__ f32x2 gelu_pk(f32x2 v) {
    const f32x2 av = __builtin_elementwise_abs(v), d = av * 0.2316418882f + 1.0f;
    f32x2 t; t.x = __builtin_amdgcn_rcpf(d.x); t.y = __builtin_amdgcn_rcpf(d.y);
    f32x2 q = t * 0.5307027145f + (-0.7265760135f); q = q * t + 0.7107068705f; q = q * t + (-0.142248368f); q = q * t + 0.127414796f; q = q * t;
    const f32x2 s = (v * v) * (-0.72134752044f);
    f32x2 e; e.x = __builtin_amdgcn_exp2f(s.x); e.y = __builtin_amdgcn_exp2f(s.y);
    const f32x2 m = v * (q * e), r = v - m;
    f32x2 o; o.x = v.x < 0.f ? m.x : r.x; o.y = v.y < 0.f ? m.y : r.y; return o;
}

template <int ACT  > struct EpiBf16 {
    static constexpr bool PERM = true, AFTER_DRAIN = false; static_assert(ACT == 0 || ACT == 1, "EpiBf16: ACT is 0 (none) or 1 (gelu_pk)");
    bf16_t* O; int ldc; const float* bias; int split_cols; size_t split_stride; float scale0;
    __device__ __forceinline__ void operator()(const f32x4 (&acc)[2][2][4][2], const Unit& u, int wr, int wc, int fr, int fq) const {
        const int row0 = u.pm * BM + wr * 64 + fr; int colt = u.pn * BM; bf16_t* base = O;
        float sc = 1.f; if (split_cols) { const int t = colt / split_cols; base += (size_t)t * split_stride; colt -= t * split_cols; if (t == 0) sc = scale0; }
        const int col0 = colt + wc * 32 + 8 * fq, bcol0 = u.pn * BM + wc * 32 + 8 * fq;
        f32x4 bv[2][2];
#pragma unroll
        for (int bj = 0; bj < 2; ++bj)
#pragma unroll
            for (int n = 0; n < 2; ++n) bv[bj][n] = bias ? *(const f32x4*)(bias + bcol0 + bj * HALF + 4 * n) : (f32x4){0.f, 0.f, 0.f, 0.f};
#pragma unroll
        for (int ai = 0; ai < 2; ++ai)
#pragma unroll
            for (int m = 0; m < 4; ++m) { bf16_t* rowp = base + (size_t)(row0 + ai * HALF + m * 16) * ldc + col0;
#pragma unroll
                for (int bj = 0; bj < 2; ++bj) { f32x4 v0 = acc[ai][bj][m][0] + bv[bj][0], v1 = acc[ai][bj][m][1] + bv[bj][1];
                    if (ACT == 1) { f32x2 a = gelu_pk((f32x2){v0[0], v0[1]}), b = gelu_pk((f32x2){v0[2], v0[3]}), c = gelu_pk((f32x2){v1[0], v1[1]}), d = gelu_pk((f32x2){v1[2], v1[3]});
                        v0 = (f32x4){a.x, a.y, b.x, b.y}; v1 = (f32x4){c.x, c.y, d.x, d.y}; }
                    v0 = v0 * sc; v1 = v1 * sc; u32x4 w; w.x = cvt_pk_bf16(v0[0], v0[1]); w.y = cvt_pk_bf16(v0[2], v0[3]); w.z = cvt_pk_bf16(v1[0], v1[1]); w.w = cvt_pk_bf16(v1[2], v1[3]);
                    *(u32x4*)(rowp + bj * HALF) = w; } }
    }
};


template <class Epi, class Sched, bool ALIGN_EPI = false, bool SP2 = false>
__device__ __forceinline__ void gemm_phase(PG8_LAS unsigned char* lds, const Gemm g, const Sched& S, const Epi& E) {
    const int tid = threadIdx.x, wid = __builtin_amdgcn_readfirstlane(tid >> 6), lane = tid & 63, wr = wid >> 2, wc = wid & 3, fr = lane & 15, fq = lane >> 4;
    const int K = g.K, nt = K / BK;
    unsigned voffA[2], voffB[2];
#pragma unroll
    for (int i = 0; i < 2; ++i) { int R, C; stage_rc(tid * 16 + i * 8192, R, C); const int Rb = Epi::PERM ? ((R & ~31) + perm32(R & 31)) : R;
        voffA[i] = (unsigned)(R * K + C) * 2u; voffB[i] = (unsigned)(Rb * K + C) * 2u; }
    const size_t kstep = (size_t)(BK * 2);
    const size_t hstep = (size_t)HALF * K * 2;
    const size_t tstep = 2 * hstep;
    const unsigned ldsw = (unsigned)wid * 1024u;
    const int aoff = lds_byte(wr * 64 + fr, fq * 8), boff = lds_byte(wc * 32 + fr, fq * 8);
#define PG8_SA(b, h) (((b) * 2 + (h)) * HTB)
#define PG8_SB(b, h) ((4 + (b) * 2 + (h)) * HTB)
#define PG8_STAGE(bufoff, gbase, voff) do { _Pragma("unroll") for (int _i = 0; _i < 2; ++_i) \
        __builtin_amdgcn_global_load_lds((const unsigned*)((const char*)(gbase) + (voff)[_i]), (PG8_LAS unsigned*)(lds + (bufoff) + ldsw + _i * 8192), 16, 0, 0); } while (0)
#define PG8_LDA(dst, b, h) do { _Pragma("unroll") for (int m = 0; m < 4; ++m) _Pragma("unroll") for (int k = 0; k < 2; ++k) dst[m][k] = *(const PG8_LAS bf16x8*)(lds + PG8_SA(b, h) + aoff + m * 2048 + k * 1024); } while (0)
#define PG8_LDB(dst, b, h) do { _Pragma("unroll") for (int n = 0; n < 2; ++n) _Pragma("unroll") for (int k = 0; k < 2; ++k) dst[n][k] = *(const PG8_LAS bf16x8*)(lds + PG8_SB(b, h) + boff + n * 2048 + k * 1024); } while (0)
#define PG8_MMA(ai, bj, At, Bt) do { __builtin_amdgcn_s_setprio(1); _Pragma("unroll") for (int m = 0; m < 4; ++m) _Pragma("unroll") for (int n = 0; n < 2; ++n) _Pragma("unroll") for (int k = 0; k < 2; ++k) \
        acc[ai][bj][m][n] = __builtin_amdgcn_mfma_f32_16x16x32_bf16(Bt[n][k], At[m][k], acc[ai][bj][m][n], 0, 0, 0); __builtin_amdgcn_s_setprio(0); } while (0)
#define PG8_WAIT_V(n) asm volatile("s_waitcnt vmcnt(" #n ")" ::: "memory")
#define PG8_WAIT_L(n) asm volatile("s_waitcnt lgkmcnt(" #n ")" ::: "memory")
#define PG8_BAR __builtin_amdgcn_s_barrier()
#define PG8_SCHED __builtin_amdgcn_sched_barrier(0)
    Unit cur, nxt; int ui = 0;
    if (!S.next(0, cur)) return;
    f32x4 acc[2][2][4][2];
#pragma unroll
    for (int a = 0; a < 2; ++a)
#pragma unroll
        for (int b = 0; b < 2; ++b)
#pragma unroll
            for (int m = 0; m < 4; ++m)
#pragma unroll
                for (int n = 0; n < 2; ++n) acc[a][b][m][n] = (f32x4){0.f, 0.f, 0.f, 0.f};
    bf16x8 At[4][2], B0[2][2], B1[2][2];
    const char* cA = (const char*)g.A + (size_t)cur.pm * tstep; const char* cB = (const char*)g.Bt + (size_t)cur.pn * tstep;
    S.a_ready(cur);
    if constexpr (SP2) {
        PG8_STAGE(PG8_SB(0, 0), cB, voffB); PG8_STAGE(PG8_SB(0, 1), cB + hstep, voffB); PG8_STAGE(PG8_SA(0, 0), cA, voffA); PG8_STAGE(PG8_SA(0, 1), cA + hstep, voffA);
        if (wr == 1) PG8_BAR;
        PG8_WAIT_V(2); PG8_BAR;
        PG8_STAGE(PG8_SB(1, 0), cB + kstep, voffB); PG8_STAGE(PG8_SA(1, 0), cA + kstep, voffA); PG8_STAGE(PG8_SB(1, 1), cB + hstep + kstep, voffB);
        PG8_WAIT_V(6); PG8_BAR;
    } else {
        PG8_STAGE(PG8_SB(0, 0), cB, voffB); PG8_STAGE(PG8_SA(0, 0), cA, voffA); PG8_STAGE(PG8_SB(0, 1), cB + hstep, voffB); PG8_STAGE(PG8_SA(0, 1), cA + hstep, voffA);
        if (wr == 1) PG8_BAR;
        PG8_WAIT_V(4); PG8_BAR;
        PG8_STAGE(PG8_SB(1, 0), cB + kstep, voffB); PG8_STAGE(PG8_SA(1, 0), cA + kstep, voffA); PG8_STAGE(PG8_SB(1, 1), cB + hstep + kstep, voffB);
        PG8_WAIT_V(6); PG8_BAR;
    }
    for (;;) {
        const bool has_next = S.next(ui + 1, nxt);
        const char* nA = has_next ? (const char*)g.A + (size_t)nxt.pm * tstep : cA; const char* nB = has_next ? (const char*)g.Bt + (size_t)nxt.pn * tstep : cB;
        for (int t = 0; t < nt; t += 2) {
            const bool last = (t == nt - 2);
            const char* a1 = cA + (size_t)(t + 1) * kstep;
            const char* a2 = last ? nA : cA + (size_t)(t + 2) * kstep; const char* b2 = last ? nB : cB + (size_t)(t + 2) * kstep;
            const char* a3 = a2 + kstep; const char* b3 = b2 + kstep;
            if (last && has_next) S.a_ready(nxt);
            if constexpr (SP2) {
            PG8_LDB(B0, 0, 0); PG8_LDB(B1, 0, 1); PG8_SCHED; PG8_LDA(At, 0, 0); PG8_STAGE(PG8_SA(1, 1), a1 + hstep, voffA);
            PG8_WAIT_V(8); PG8_WAIT_L(0); PG8_BAR; PG8_MMA(0, 0, At, B0); PG8_MMA(0, 1, At, B1); PG8_BAR; PG8_SCHED;
            PG8_LDA(At, 0, 1); PG8_STAGE(PG8_SB(0, 0), b2, voffB); PG8_STAGE(PG8_SB(0, 1), b2 + hstep, voffB); PG8_STAGE(PG8_SA(0, 0), a2, voffA);
            PG8_WAIT_V(8); PG8_WAIT_L(0); PG8_BAR; PG8_MMA(1, 0, At, B0); PG8_MMA(1, 1, At, B1); PG8_BAR; PG8_SCHED;
            PG8_LDB(B0, 1, 0); PG8_LDB(B1, 1, 1); PG8_SCHED; PG8_LDA(At, 1, 0); PG8_STAGE(PG8_SA(0, 1), a2 + hstep, voffA);
            PG8_WAIT_V(8); PG8_WAIT_L(0); PG8_BAR; PG8_MMA(0, 0, At, B0); PG8_MMA(0, 1, At, B1); PG8_BAR; PG8_SCHED;
            PG8_LDA(At, 1, 1); PG8_STAGE(PG8_SB(1, 0), b3, voffB); PG8_STAGE(PG8_SB(1, 1), b3 + hstep, voffB); PG8_STAGE(PG8_SA(1, 0), a3, voffA);
            PG8_WAIT_V(8); PG8_WAIT_L(0); PG8_BAR; PG8_MMA(1, 0, At, B0); PG8_MMA(1, 1, At, B1); PG8_BAR; PG8_SCHED;
            } else {
            PG8_LDB(B0, 0, 0); PG8_SCHED; PG8_LDA(At, 0, 0); PG8_STAGE(PG8_SA(1, 1), a1 + hstep, voffA);
            PG8_WAIT_L(8); PG8_BAR; PG8_WAIT_L(0); PG8_MMA(0, 0, At, B0); PG8_BAR; PG8_SCHED;
            PG8_LDB(B1, 0, 1); PG8_STAGE(PG8_SB(0, 0), b2, voffB);
            PG8_BAR; PG8_WAIT_L(0); PG8_MMA(0, 1, At, B1); PG8_BAR;
            PG8_LDA(At, 0, 1); PG8_STAGE(PG8_SA(0, 0), a2, voffA);
            PG8_BAR; PG8_WAIT_L(0); PG8_MMA(1, 0, At, B0); PG8_BAR; PG8_SCHED;
            PG8_STAGE(PG8_SB(0, 1), b2 + hstep, voffB);
            PG8_WAIT_V(6); PG8_BAR; PG8_MMA(1, 1, At, B1); PG8_BAR;
            PG8_LDB(B0, 1, 0); PG8_SCHED; PG8_LDA(At, 1, 0); PG8_STAGE(PG8_SA(0, 1), a2 + hstep, voffA);
            PG8_WAIT_L(8); PG8_BAR; PG8_WAIT_L(0); PG8_MMA(0, 0, At, B0); PG8_BAR; PG8_SCHED;
            PG8_LDB(B1, 1, 1); PG8_STAGE(PG8_SB(1, 0), b3, voffB);
            PG8_BAR; PG8_WAIT_L(0); PG8_MMA(0, 1, At, B1); PG8_BAR;
            PG8_LDA(At, 1, 1); PG8_STAGE(PG8_SA(1, 0), a3, voffA);
            PG8_BAR; PG8_WAIT_L(0); PG8_MMA(1, 0, At, B0); PG8_BAR; PG8_SCHED;
            PG8_STAGE(PG8_SB(1, 1), b3 + hstep, voffB);
            PG8_WAIT_V(6); PG8_BAR; PG8_MMA(1, 1, At, B1); PG8_BAR;
            }
        }
        if constexpr (ALIGN_EPI) { if (wr == 0) PG8_BAR; }
        if constexpr (!Epi::AFTER_DRAIN) { E(acc, cur, wr, wc, fr, fq); S.done(cur); }
        if (!has_next) break;
#pragma unroll
        for (int a = 0; a < 2; ++a)
#pragma unroll
            for (int b = 0; b < 2; ++b)
#pragma unroll
                for (int m = 0; m < 4; ++m)
#pragma unroll
                    for (int n = 0; n < 2; ++n) acc[a][b][m][n] = (f32x4){0.f, 0.f, 0.f, 0.f};
        cur = nxt; cA = nA; cB = nB; ++ui;
        if constexpr (ALIGN_EPI) { if (wr == 1) PG8_BAR; }
    }
    PG8_WAIT_V(0);
    if constexpr (!ALIGN_EPI) { if (wr == 0) PG8_BAR; }
    PG8_BAR;
    if constexpr (Epi::AFTER_DRAIN) { E.fused(acc, cur, wr, wc, fr, fq, lds, wid, lane); S.done(cur); }
#undef PG8_SA
#undef PG8_SB
#undef PG8_STAGE
#undef PG8_LDA
#undef PG8_LDB
#undef PG8_MMA
#undef PG8_WAIT_V
#undef PG8_WAIT_L
#undef PG8_BAR
#undef PG8_SCHED
}
}
namespace attn_body {
using bf16=__hip_bfloat16;
using bf16x8=__attribute__((ext_vector_type(8)))short;
using s16x4=__attribute__((ext_vector_type(4)))short;
using f32x16=__attribute__((ext_vector_type(16)))float;
using u32x4=__attribute__((ext_vector_type(4)))unsigned;
constexpr int BATCH=8,NHEAD=8,SEQ=2048,D=64,DM=NHEAD*D,DMO=1024;
constexpr int NW=8,QBLK=32,QB=QBLK*NW,KVBLK=64,NQB=SEQ/QB;
constexpr int ATTN_PITCH=DM, ATTN_UNIT_ROWS=QB;
__device__ __forceinline__ int crow(int r,int hi){return (r&3)+8*(r>>2)+4*hi;}
#define SBAR() __builtin_amdgcn_sched_barrier(0)
typedef unsigned u32x16 __attribute__((ext_vector_type(16)));
constexpr int NSLOT=3, SLOTB=8192;
constexpr int LDS_K=0, LDS_V=NSLOT*SLOTB, LDS_WS=2*NSLOT*SLOTB, LDS_OST=LDS_WS+NW*64*4, LDS_BYTES=LDS_OST+NW*4096;
constexpr float C2=0.125f*1.4426950408889634f;
__device__ __forceinline__ void glds16(const void*gsrc,unsigned lds_dst){unsigned keep;
  asm volatile("s_mov_b32 %0, m0\n\ts_mov_b32 m0, %2\n\ts_nop 0\n\tglobal_load_lds_dwordx4 %1, off\n\ts_mov_b32 m0, %0":"=&s"(keep):"v"(gsrc),"s"(lds_dst):"memory");}
__device__ __forceinline__ float max3f(float a,float b,float c){float r;asm("v_max3_f32 %0, %1, %2, %3":"=v"(r):"v"(a),"v"(b),"v"(c));return r;}
__device__ __forceinline__ float max2f(float a,float b){float r;asm("v_max_f32_e32 %0, %1, %2":"=v"(r):"v"(a),"v"(b));return r;}
__device__ __forceinline__ float fadd_s(float a,float b){float r;asm("v_add_f32_e32 %0, %1, %2":"=v"(r):"v"(a),"v"(b));return r;}
__device__ __forceinline__ float fsub_s(float a,float b){float r;asm("v_sub_f32_e32 %0, %1, %2":"=v"(r):"v"(a),"v"(b));return r;}
typedef float f32x2_t __attribute__((ext_vector_type(2))); typedef __bf16 bf16x2_t __attribute__((ext_vector_type(2)));
__device__ __forceinline__ unsigned cvtpk_s(float lo,float hi){f32x2_t v={lo,hi};bf16x2_t b=__builtin_convertvector(v,bf16x2_t);return __builtin_bit_cast(unsigned,b);}
#define WAIT_BAR(N) asm volatile("s_waitcnt vmcnt(" #N ") lgkmcnt(0)\n\ts_barrier":::"memory")

__device__ __forceinline__ void qkt(f32x16&p0,f32x16&p1,const char*Kslot,const bf16x8*qr,int r32,int hi){ const f32x16 negm=f32x16{};
  const char*kb=Kslot+hi*1024+r32*16;
  #pragma unroll
  for(int d0=0;d0<4;++d0){
    const bf16x8 b0=*reinterpret_cast<const bf16x8*>(kb+d0*2048);
    const bf16x8 b1=*reinterpret_cast<const bf16x8*>(kb+d0*2048+512);
    if(d0==0){p0=__builtin_amdgcn_mfma_f32_32x32x16_bf16(b0,qr[0],negm,0,0,0);p1=__builtin_amdgcn_mfma_f32_32x32x16_bf16(b1,qr[0],negm,0,0,0);}
    else{p0=__builtin_amdgcn_mfma_f32_32x32x16_bf16(b0,qr[d0],p0,0,0,0);p1=__builtin_amdgcn_mfma_f32_32x32x16_bf16(b1,qr[d0],p1,0,0,0);}}
}
typedef __attribute__((address_space(3))) const char* lds_cptr;
typedef short v4i16_t __attribute__((ext_vector_type(4)));
__device__ __forceinline__ void kload8(bf16x8*kf,lds_cptr kp){
  kf[0]=*(const __attribute__((address_space(3))) bf16x8*)(kp);      kf[1]=*(const __attribute__((address_space(3))) bf16x8*)(kp+512);
  kf[2]=*(const __attribute__((address_space(3))) bf16x8*)(kp+2048); kf[3]=*(const __attribute__((address_space(3))) bf16x8*)(kp+2560);
  kf[4]=*(const __attribute__((address_space(3))) bf16x8*)(kp+4096); kf[5]=*(const __attribute__((address_space(3))) bf16x8*)(kp+4608);
  kf[6]=*(const __attribute__((address_space(3))) bf16x8*)(kp+6144); kf[7]=*(const __attribute__((address_space(3))) bf16x8*)(kp+6656);
}
__device__ __forceinline__ void kload2(bf16x8*kf,lds_cptr kp,int j){ kf[2*j]=*(const __attribute__((address_space(3))) bf16x8*)(kp+j*2048); kf[2*j+1]=*(const __attribute__((address_space(3))) bf16x8*)(kp+j*2048+512); }
__device__ __forceinline__ s16x4 vtr(lds_cptr p){ return __builtin_bit_cast(s16x4,__builtin_amdgcn_ds_read_tr16_b64_v4i16((__attribute__((address_space(3))) v4i16_t*)p)); }
__device__ __forceinline__ float rowmax(const f32x16&p0,const f32x16&p1){
  float a=max3f(p0[0],p0[1],p1[0]),b=max3f(p0[2],p0[3],p1[1]);a=max3f(a,p1[2],p1[3]);
  #pragma unroll
  for(int r=4;r<16;r+=4){a=max3f(a,p0[r],p0[r+1]);b=max3f(b,p0[r+2],p0[r+3]);a=max3f(a,p1[r],p1[r+1]);b=max3f(b,p1[r+2],p1[r+3]);}
  const float m=max2f(a,b);
  auto rr=__builtin_amdgcn_permlane32_swap(__float_as_uint(m),__float_as_uint(m),false,false);
  return max2f(__uint_as_float(rr[0]),__uint_as_float(rr[1]));
}
__device__ __forceinline__ void pv(f32x16*o,int vb,bf16x8 pa0,bf16x8 pa1,bf16x8 pa2,bf16x8 pa3){
  #pragma unroll
  for(int d0=0;d0<2;++d0){s16x4 lo[4],hi[4];
    #pragma unroll
    for(int ks=0;ks<4;++ks){
      asm volatile("ds_read_b64_tr_b16 %0,%1 offset:%c2":"=&v"(lo[ks]):"v"(vb),"i"(d0*4096+ks*1024):"memory");
      asm volatile("ds_read_b64_tr_b16 %0,%1 offset:%c2":"=&v"(hi[ks]):"v"(vb),"i"(d0*4096+ks*1024+512):"memory");}
    asm volatile("s_waitcnt lgkmcnt(0)":::"memory");SBAR();
    #define PK(k) (bf16x8){lo[k][0],lo[k][1],lo[k][2],lo[k][3],hi[k][0],hi[k][1],hi[k][2],hi[k][3]}
    o[d0]=__builtin_amdgcn_mfma_f32_32x32x16_bf16(pa0,PK(0),o[d0],0,0,0);
    o[d0]=__builtin_amdgcn_mfma_f32_32x32x16_bf16(pa1,PK(1),o[d0],0,0,0);
    o[d0]=__builtin_amdgcn_mfma_f32_32x32x16_bf16(pa2,PK(2),o[d0],0,0,0);
    o[d0]=__builtin_amdgcn_mfma_f32_32x32x16_bf16(pa3,PK(3),o[d0],0,0,0);
    #undef PK
  }
}

#ifndef ATTN_STORE16
#define ATTN_STORE16(p,v) (*(u32x4*)(p)=(v))
#endif
template<int THRL> __device__ __forceinline__ void attn_unit(int b,int h,int qb,const bf16*Q,const bf16*__restrict__ K,const bf16*__restrict__ V,bf16*O,const unsigned long long*MT,char*shm){
  const int tid=threadIdx.x,lane=tid&63,r32=lane&31,hi=lane>>5; const int wid=__builtin_amdgcn_readfirstlane(tid>>6);
  const long rowbase=(long)b*SEQ; const int q0=qb*QB;
  const bf16*Qw=Q+(rowbase+q0+wid*QBLK)*DM+h*D;
  const bf16*Kh=K+rowbase*DM+h*D,*Vh=V+rowbase*DM+h*D;
  const unsigned lds0=(unsigned)(uintptr_t)shm;
  float*wsf=(float*)(shm+LDS_WS)+wid*64;
  const bf16*ksrc=Kh+(long)lane*DM+wid*8;
  const bf16*vsrc=Vh+(long)(16*(wid&3)+(lane>>2))*DM+(wid>>2)*32+(lane&3)*8;
  const unsigned kdst=lds0+LDS_K+wid*1024, vdst=lds0+LDS_V+wid*1024;
  #define DMA_K(t,slot) glds16(ksrc+(long)(t)*KVBLK*DM,(unsigned)__builtin_amdgcn_readfirstlane(kdst+(slot)))
  #define DMA_V(t,slot) glds16(vsrc+(long)(t)*KVBLK*DM,(unsigned)__builtin_amdgcn_readfirstlane(vdst+(slot)))
  const int vb0=(int)(lds0+LDS_V)+((lane>>4)&1)*32+(lane&3)*8+(4*hi+((lane&15)>>2))*64;
  const char*Kbase=shm+LDS_K; bf16x8 kf[8];
  const lds_cptr shm3=(lds_cptr)shm; const lds_cptr kp0=shm3+LDS_K+hi*1024+r32*16; const lds_cptr vp0=shm3+LDS_V+((lane>>4)&1)*32+(lane&3)*8+(4*hi+((lane&15)>>2))*64;
  const int NT=(q0+QB)/KVBLK;
  const unsigned long long*mbase=MT+((size_t)((b*(SEQ/32)+qb*NW+wid)*(SEQ/KVBLK)))*32;
  u32x16 mk0,mk1,mk2,mk3; const float NEGV=-INFINITY;
  #define MLOAD(t) do{ const unsigned long long*mp_=mbase+(size_t)(t)*32; \
    asm volatile("s_load_dwordx16 %0, %4, 0x0\n\ts_load_dwordx16 %1, %4, 0x40\n\ts_load_dwordx16 %2, %4, 0x80\n\ts_load_dwordx16 %3, %4, 0xc0":"=&s"(mk0),"=&s"(mk1),"=&s"(mk2),"=&s"(mk3):"s"(mp_):"memory"); }while(0)
  #define MK64(v,i) (((unsigned long long)(v)[2*(i)+1]<<32)|(unsigned long long)(v)[2*(i)])
  #define MAPPLY(P0,P1) do{ asm volatile("s_waitcnt lgkmcnt(0)":"+s"(mk0),"+s"(mk1),"+s"(mk2),"+s"(mk3)::"memory"); \
    _Pragma("unroll") for(int r=0;r<8;++r){ P0[r]=__builtin_amdgcn_inverse_ballot_w64(MK64(mk0,r))?P0[r]:NEGV; P0[r+8]=__builtin_amdgcn_inverse_ballot_w64(MK64(mk1,r))?P0[r+8]:NEGV; \
      P1[r]=__builtin_amdgcn_inverse_ballot_w64(MK64(mk2,r))?P1[r]:NEGV; P1[r+8]=__builtin_amdgcn_inverse_ballot_w64(MK64(mk3,r))?P1[r+8]:NEGV; } }while(0)
  DMA_K(0,0);DMA_V(0,0);DMA_K(1,SLOTB);
  bf16x8 qr[4];
  #pragma unroll
  for(int d0=0;d0<4;++d0)qr[d0]=*reinterpret_cast<const bf16x8*>(&Qw[(long)r32*DM+d0*16+hi*8]);
  float mhat=0.f,l_reg=0.f;f32x16 o[2];o[0]=f32x16{};o[1]=f32x16{};const f32x16 zc=f32x16{};
  bool resc=false;
  #define START(P0,P1) do{ const float rm=rowmax(P0,P1); resc=false; \
    { const float dl=max2f(rm,-30.f); mhat=fadd_s(mhat,dl); \
      _Pragma("unroll") for(int r=0;r<16;++r){P0[r]=fsub_s(P0[r],dl);P1[r]=fsub_s(P1[r],dl);} \
      } \
    _Pragma("unroll") for(int r=0;r<16;++r)P0[r]=__builtin_amdgcn_exp2f(P0[r]); }while(0)
  #define RESC() do{ if(resc){ asm volatile("s_waitcnt lgkmcnt(0)":::"memory"); \
      _Pragma("unroll") for(int d_=0;d_<2;++d_) _Pragma("unroll") for(int r=0;r<16;++r)o[d_][r]*=wsf[crow(r,hi)]; } }while(0)
  f32x16 pA0,pA1,pB0,pB1;
  int sl_prev=0,sl_cur=0,sl_next=SLOTB;
  #define ROT() do{sl_prev=sl_cur;sl_cur=sl_next;sl_next=(sl_next==(NSLOT-1)*SLOTB)?0:sl_next+SLOTB;}while(0)
  DMA_K(2,2*SLOTB);
  WAIT_BAR(3);
  MLOAD(0); qkt(pA0,pA1,Kbase,qr,r32,hi);asm volatile("s_nop 15\n\ts_nop 7":"+v"(pA0),"+v"(pA1));MAPPLY(pA0,pA1);asm volatile("s_nop 1":"+v"(pA0),"+v"(pA1));
  START(pA0,pA1);
  _Pragma("unroll") for(int r=0;r<16;++r)pA1[r]=__builtin_amdgcn_exp2f(pA1[r]);
  WAIT_BAR(0);
  DMA_K(3,0);DMA_V(1,SLOTB);
  ROT();
  kload8(kf,kp0+sl_cur);
  WAIT_BAR(2);
  s16x4 vlo[8],vhi[8]; u32x4 pw0,pw1,pw2,pw3;
  #define PKW(P,B) cvtpk_s(P[B],P[B+1])
  #define PAF(k) __builtin_bit_cast(bf16x8,pw##k)
  #define VFR(i) (bf16x8){vlo[i][0],vlo[i][1],vlo[i][2],vlo[i][3],vhi[i][0],vhi[i][1],vhi[i][2],vhi[i][3]}
  #define PIN(x) asm volatile("":"+v"(x))
  #define MX3(a,b,c) __builtin_fmaxf(__builtin_fmaxf((a),(b)),(c))
  #define GAPA(MF,A0,A1,A2,A3,W0,W1,PW) do{ MF; sacc+=A0; sacc+=A1; sacc+=A2; sacc+=A3; PIN(sacc); W0; W1; PIN(PW); SBAR(); }while(0)
  #define EX(v) __builtin_amdgcn_exp2f(v)
  #define GAPB(MF,X,B) do{ MF; X[B]=EX(X[B]); X[B+1]=EX(X[B+1]); X[B+2]=EX(X[B+2]); X[B+3]=EX(X[B+3]); PIN(X); SBAR(); }while(0)
  #define VRD(i) do{ vlo[i]=vtr(vp_+(((i)>>2)*4096+((i)&3)*1024)); vhi[i]=vtr(vp_+(((i)>>2)*4096+((i)&3)*1024+512)); }while(0)
  #define KRD(G,j) do{ if(G){ kload2(kf,kp0+sl_next,j); SBAR(); } }while(0)
  #define STEP(C0,C1,P0,P1,t,GK,GV,GL) do{ SBAR(); MLOAD(t); \
    const lds_cptr vp_=vp0+sl_prev; \
    VRD(0); SBAR(); float sacc=(P0[0]+P0[1]); \
    GAPA(C0=__builtin_amdgcn_mfma_f32_32x32x16_bf16(kf[0],qr[0],zc,0,0,0), P0[2],P0[3],P0[4],P0[5],     pw0[0]=PKW(P0,0), pw0[1]=PKW(P0,2), pw0); \
    VRD(4); SBAR(); GAPA(C1=__builtin_amdgcn_mfma_f32_32x32x16_bf16(kf[1],qr[0],zc,0,0,0), P0[6],P0[7],P0[8],P0[9],     pw0[2]=PKW(P0,4), pw0[3]=PKW(P0,6), pw0); \
    VRD(1); SBAR(); GAPA(C0=__builtin_amdgcn_mfma_f32_32x32x16_bf16(kf[2],qr[1],C0,0,0,0),   P0[10],P0[11],P0[12],P0[13], pw1[0]=PKW(P0,8), pw1[1]=PKW(P0,10), pw1); \
    VRD(5); SBAR(); GAPA(C1=__builtin_amdgcn_mfma_f32_32x32x16_bf16(kf[3],qr[1],C1,0,0,0),   P0[14],P0[15],P1[0],P1[1],   pw1[2]=PKW(P0,12),pw1[3]=PKW(P0,14), pw1); \
    VRD(2); SBAR(); GAPA(C0=__builtin_amdgcn_mfma_f32_32x32x16_bf16(kf[4],qr[2],C0,0,0,0),   P1[2],P1[3],P1[4],P1[5],     pw2[0]=PKW(P1,0), pw2[1]=PKW(P1,2), pw2); \
    VRD(6); SBAR(); GAPA(C1=__builtin_amdgcn_mfma_f32_32x32x16_bf16(kf[5],qr[2],C1,0,0,0),   P1[6],P1[7],P1[8],P1[9],     pw2[2]=PKW(P1,4), pw2[3]=PKW(P1,6), pw2); \
    VRD(3); SBAR(); GAPA(C0=__builtin_amdgcn_mfma_f32_32x32x16_bf16(kf[6],qr[3],C0,0,0,0),   P1[10],P1[11],P1[12],P1[13], pw3[0]=PKW(P1,8), pw3[1]=PKW(P1,10), pw3); \
    VRD(7); SBAR(); GAPA(C1=__builtin_amdgcn_mfma_f32_32x32x16_bf16(kf[7],qr[3],C1,0,0,0),   P1[14],P1[15],0.f,0.f,       pw3[2]=PKW(P1,12),pw3[3]=PKW(P1,14), pw3); \
    l_reg+=sacc; \
    if(GK){DMA_K((t)+3,sl_cur);} if(GV){DMA_V((t)+1,sl_next);} \
    MAPPLY(C0,C1); \
    { float a=MX3(C0[0],C0[1],C1[0]),b=MX3(C0[2],C0[3],C1[1]); a=MX3(a,C1[2],C1[3]); \
      _Pragma("unroll") for(int r=4;r<16;r+=4){a=MX3(a,C0[r],C0[r+1]);b=MX3(b,C0[r+2],C0[r+3]);a=MX3(a,C1[r],C1[r+1]);b=MX3(b,C1[r+2],C1[r+3]);} \
      float rm=__builtin_fmaxf(a,b); { auto rr=__builtin_amdgcn_permlane32_swap(__float_as_uint(rm),__float_as_uint(rm),false,false); rm=__builtin_fmaxf(__uint_as_float(rr[0]),__uint_as_float(rr[1])); } \
      resc=false; \
      const float rl=rm-mhat; \
      if(__builtin_expect(__any(rl>(float)THRL),0)){ const float dl=__builtin_fmaxf(rl,0.f); mhat+=dl; \
        const float f=__builtin_amdgcn_exp2f(-dl); l_reg*=f; if(hi==0)wsf[r32]=f; resc=true; } \
      _Pragma("unroll") for(int r=0;r<16;++r){C0[r]-=mhat;C1[r]-=mhat;} } \
    SBAR(); \
    GAPB(o[0]=__builtin_amdgcn_mfma_f32_32x32x16_bf16(PAF(0),VFR(0),o[0],0,0,0), C0,0); \
    GAPB(o[1]=__builtin_amdgcn_mfma_f32_32x32x16_bf16(PAF(0),VFR(4),o[1],0,0,0), C0,4); \
    KRD(GL,0); GAPB(o[0]=__builtin_amdgcn_mfma_f32_32x32x16_bf16(PAF(1),VFR(1),o[0],0,0,0), C0,8); \
    KRD(GL,1); GAPB(o[1]=__builtin_amdgcn_mfma_f32_32x32x16_bf16(PAF(1),VFR(5),o[1],0,0,0), C0,12); \
    KRD(GL,2); GAPB(o[0]=__builtin_amdgcn_mfma_f32_32x32x16_bf16(PAF(2),VFR(2),o[0],0,0,0), C1,0); \
    KRD(GL,3); GAPB(o[1]=__builtin_amdgcn_mfma_f32_32x32x16_bf16(PAF(2),VFR(6),o[1],0,0,0), C1,4); \
    GAPB(o[0]=__builtin_amdgcn_mfma_f32_32x32x16_bf16(PAF(3),VFR(3),o[0],0,0,0), C1,8); \
    GAPB(o[1]=__builtin_amdgcn_mfma_f32_32x32x16_bf16(PAF(3),VFR(7),o[1],0,0,0), C1,12); \
    }while(0)
  int t=1;
  for(;t+5<NT;t+=2){
    STEP(pB0,pB1,pA0,pA1,t,true,true,true);     WAIT_BAR(2); RESC(); ROT();
    STEP(pA0,pA1,pB0,pB1,t+1,true,true,true);   WAIT_BAR(2); RESC(); ROT();
  }
  #define ENDW(tt) do{ if((tt)+3<NT){WAIT_BAR(2);} else if((tt)+2<NT){WAIT_BAR(1);} else {WAIT_BAR(0);} }while(0)
  for(;t+1<NT;t+=2){
    STEP(pB0,pB1,pA0,pA1,t,(t+3<NT),(t+1<NT),(t+1<NT));       ENDW(t);   RESC(); ROT();
    STEP(pA0,pA1,pB0,pB1,t+1,(t+4<NT),(t+2<NT),(t+2<NT));     ENDW(t+1); RESC(); ROT();
  }
  STEP(pB0,pB1,pA0,pA1,NT-1,false,false,false); RESC();
  { float sacc=pB0[0]+pB0[1]; _Pragma("unroll") for(int r=2;r<16;++r)sacc+=pB0[r]; _Pragma("unroll") for(int r=0;r<16;++r)sacc+=pB1[r]; l_reg+=sacc;
    pw0=(u32x4){PKW(pB0,0),PKW(pB0,2),PKW(pB0,4),PKW(pB0,6)};pw1=(u32x4){PKW(pB0,8),PKW(pB0,10),PKW(pB0,12),PKW(pB0,14)};pw2=(u32x4){PKW(pB1,0),PKW(pB1,2),PKW(pB1,4),PKW(pB1,6)};pw3=(u32x4){PKW(pB1,8),PKW(pB1,10),PKW(pB1,12),PKW(pB1,14)};
    SBAR(); pv(o,vb0+sl_cur,PAF(0),PAF(1),PAF(2),PAF(3)); }
  #undef PKW
  #undef PAF
  #undef VFR
  #undef PIN
  #undef MX3
  #undef GAPA
  #undef GAPB
  #undef EX
  #undef VRD
  #undef KRD
  #undef STEP
  #undef ENDW
  {auto rr=__builtin_amdgcn_permlane32_swap(__float_as_uint(l_reg),__float_as_uint(l_reg),false,false);l_reg=__uint_as_float(rr[0])+__uint_as_float(rr[1]);}
  if(hi==0)wsf[32+r32]=l_reg;asm volatile("s_waitcnt lgkmcnt(0)":::"memory");
  float rli[16];
  #pragma unroll
  for(int r=0;r<16;++r)rli[r]=__builtin_amdgcn_rcpf(wsf[32+crow(r,hi)]);
  bf16*Ow=O+(rowbase+q0+wid*QBLK)*DMO+h*D;
  { bf16*stg=(bf16*)(shm+LDS_OST)+wid*2048;
    #pragma unroll
    for(int r=0;r<16;++r){const int orow=crow(r,hi);
      #pragma unroll
      for(int d0=0;d0<2;++d0)stg[orow*64+d0*32+r32]=__float2bfloat16(o[d0][r]*rli[r]);}
    asm volatile("s_waitcnt lgkmcnt(0)":::"memory");
    #pragma unroll
    for(int i=0;i<4;++i){const int row=i*8+(lane>>3),ch=lane&7; const u32x4 v=*(const u32x4*)(stg+row*64+ch*8); ATTN_STORE16(Ow+(long)row*DMO+ch*8,v);} }
  asm volatile("s_waitcnt lgkmcnt(0)\n\ts_barrier":::"memory");
  #undef DMA_K
  #undef DMA_V
  #undef MLOAD
  #undef MK64
  #undef MAPPLY
  #undef START
  #undef RESC
  #undef ROT
}
constexpr int ATTN_LDS_BYTES=LDS_BYTES;
struct AttnTensors { const bf16* Q; const bf16* K; const bf16* V; bf16* O; const unsigned long long* MT; };
struct AttnUnit { int bh; int qb; };
struct StaticOrder {
  int vcu;
  __device__ __forceinline__ explicit StaticOrder(int grid,int block):vcu((block%8)*(grid/8)+block/8){}
  __device__ __forceinline__ bool next(int i,AttnUnit&u)const{ if(i>=2)return false; const int s=vcu&3; u.bh=vcu>>2; u.qb=(i==0)?s:7-s; return true; }
  __device__ __forceinline__ void a_ready(const AttnUnit&)const{}
  __device__ __forceinline__ void done(const AttnUnit&)const{}
};
template<class Sched,int THRL=8> __device__ __forceinline__ void attn_phase(char*lds,const AttnTensors&T,const Sched&S){
  AttnUnit u;
  for(int i=0;S.next(i,u);++i){ S.a_ready(u); attn_unit<THRL>(u.bh/NHEAD,u.bh%NHEAD,u.qb,T.Q,T.K,T.V,T.O,T.MT,lds); S.done(u); }
}
#undef SBAR
#undef WAIT_BAR
}
#define XB_TMO      128
#define XB_XCNT(j)  (256  + 64 * (j))
#define XB_XSUB(j)  (1280 + 64 * (j))
#define XB_XGEN(j)  (2304 + 64 * (j))
#define XB_TOP      3328
#define XB_TOPGEN   3392
#define XCD_BAR_WORDS 3456
#define XB_SPIN_CAP (1u << 18)

__device__ __forceinline__ unsigned xb_ld(unsigned* p)              { return __hip_atomic_load(p, __ATOMIC_RELAXED, __HIP_MEMORY_SCOPE_AGENT); }
__device__ __forceinline__ unsigned xb_add(unsigned* p, unsigned v) { return __hip_atomic_fetch_add(p, v, __ATOMIC_RELAXED, __HIP_MEMORY_SCOPE_AGENT); }
__device__ __forceinline__ unsigned xb_xcc_id() { return (unsigned)__builtin_amdgcn_s_getreg((3 << 11) | 20) & 0xFu; }
#define XB_SPIN(cond, bar) do { unsigned _sp = 0; while (cond) { __builtin_amdgcn_s_sleep(1); \
    if ((++_sp & 255u) == 0u) { if (xb_ld(&(bar)[XB_TMO])) break; if (_sp > XB_SPIN_CAP) { atomicAdd(&(bar)[XB_TMO], 1u); break; } } } } while (0)

struct XcdBarrier {
    unsigned* bar; unsigned x;
    volatile LAS unsigned* st;
};

__device__ __forceinline__ XcdBarrier xcd_barrier_post(unsigned* bar, volatile LAS unsigned* st) {
    XcdBarrier b; b.bar = bar; b.x = xb_xcc_id(); b.st = st;
    if (threadIdx.x == 0) (void)xb_add(&bar[XB_XCNT(b.x)], 1u);
    return b;
}
__device__ __forceinline__ void xcd_barrier_complete(unsigned* bar, unsigned x, unsigned& nloc, unsigned& nx) {
    const unsigned G = gridDim.x * gridDim.y * gridDim.z;
    unsigned sum, cnt, mine, sp = 0u;
    for (;;) {
        sum = 0u; cnt = 0u; mine = 0u;
#pragma unroll
        for (unsigned j = 0; j < 16; ++j) { const unsigned c = xb_ld(&bar[XB_XCNT(j)]); sum += c; cnt += (c > 0u) ? 1u : 0u; mine = (j == x) ? c : mine; }
        if (sum == G) break;
        __builtin_amdgcn_s_sleep(1);
        if ((++sp & 255u) == 0u) { if (xb_ld(&bar[XB_TMO])) break; if (sp > XB_SPIN_CAP) { atomicAdd(&bar[XB_TMO], 1u); break; } }
    }
    nloc = mine > 0u ? mine : 1u; nx = cnt > 0u ? cnt : 1u;
}

__device__ __forceinline__ void xcd_barrier(const XcdBarrier& b) {
    asm volatile("s_waitcnt vmcnt(0)" ::: "memory");
    __syncthreads();
    if (threadIdx.x == 0) {
        unsigned* bar = b.bar;
        __builtin_amdgcn_s_waitcnt(0);
        unsigned nloc = b.st[0], nx = b.st[1];
        if (nloc == 0u) { xcd_barrier_complete(bar, b.x, nloc, nx); b.st[0] = nloc; b.st[1] = nx; }
        const unsigned old = xb_add(&bar[XB_XSUB(b.x)], 1u);
        const unsigned gen = old / nloc;
        if (old + 1u == (gen + 1u) * nloc) {
            __builtin_amdgcn_fence(__ATOMIC_RELEASE, "agent");
            asm volatile("s_waitcnt vmcnt(0)" ::: "memory");
            const unsigned og = xb_add(&bar[XB_TOP], 1u);
            const unsigned tg = og / nx;
            if (og + 1u == (tg + 1u) * nx) xb_add(&bar[XB_TOPGEN], 1u);
            else XB_SPIN(xb_ld(&bar[XB_TOPGEN]) == tg, bar);
            __builtin_amdgcn_fence(__ATOMIC_ACQUIRE, "agent");
            xb_add(&bar[XB_XGEN(b.x)], 1u);
            asm volatile("s_waitcnt vmcnt(0)" ::: "memory");
        } else {
            XB_SPIN(xb_ld(&bar[XB_XGEN(b.x)]) == gen, bar);
            __builtin_amdgcn_fence(__ATOMIC_ACQUIRE, "agent");
            asm volatile("s_waitcnt vmcnt(0)" ::: "memory");
        }
    }
    __syncthreads();
}
#define GAS __attribute__((address_space(1)))
#ifndef LAS
#define LAS __attribute__((address_space(3)))
#endif
typedef unsigned short bf16;
typedef unsigned v4u __attribute__((ext_vector_type(4)));
typedef float f32x4 __attribute__((ext_vector_type(4)));
#define LDS_WAIT() asm volatile("s_waitcnt lgkmcnt(0)" ::: "memory")
#define VM_WAIT() asm volatile("s_waitcnt vmcnt(0)" ::: "memory")

constexpr int D = 1024, NB = 8, T = 2048, MP = NB * T, NSMP = 32, MT = MP + NSMP, MPAD = 16640;
constexpr int ATT_W = 512, AH = 8, IH = 16, IDD = 64, TOPK = 256;
constexpr int RW_W = 512, RH = 8, RN = 64;
constexpr int RW_COLS = 1792, IN_COLS = 4432, NIN = 4608;
constexpr int FFN = 2816, NGU = 2 * FFN;
constexpr int NPAGES = 64, PAGE = 128, PAST = 8192, LS = PAST + 1, SCS_LD = 8704;
constexpr int O_Q = 0, O_K = 512, O_V = 1024, O_QI = 1536, O_KI = 2560, O_WI = 2624, O_RW = 2640;
constexpr float IDX_W_SCALE = 0.03125f;
constexpr float RMS_EPS = 1e-6f, GN_EPS = 64e-5f;
constexpr int MODW = 6 * D;

constexpr size_t OUT_Y = 0, OUT_YS = OUT_Y + (size_t)MP * D, OUT_KP = OUT_YS + (size_t)NSMP * D, OUT_VP = OUT_KP + (size_t)MP * ATT_W,
                 OUT_IKP = OUT_VP + (size_t)MP * ATT_W, OUT_WKVP = OUT_IKP + (size_t)MP * IDD, OUT_SHP = OUT_WKVP + (size_t)NB * RH * RN * RN,
                 OUT_KS = OUT_SHP + (size_t)NB * RW_COLS, OUT_VS = OUT_KS + (size_t)NSMP * ATT_W, OUT_IKS = OUT_VS + (size_t)NSMP * ATT_W,
                 OUT_WKVS = OUT_IKS + (size_t)NSMP * IDD, OUT_SHS = OUT_WKVS + (size_t)NSMP * RH * RN * RN, OUT_END = OUT_SHS + (size_t)NSMP * RW_COLS;
static_assert(OUT_END == 36052992, "output size");

constexpr size_t MiB = 1u << 20;
constexpr size_t WS_CTL = 0, CTL_ZERO_BYTES = 1 * MiB;
constexpr size_t WS_MOD = 1 * MiB;
constexpr size_t WS_WIN = 2 * MiB;
constexpr size_t WS_WOUT = 12 * MiB;
constexpr size_t WS_WGU = 14 * MiB;
constexpr size_t WS_WDN = 26 * MiB;
constexpr size_t WS_A1 = 32 * MiB;
constexpr size_t WS_A2 = 66 * MiB;
constexpr size_t WS_MIX = 100 * MiB;
constexpr size_t WS_HB = 134 * MiB;
constexpr size_t WS_X1 = 224 * MiB;
constexpr size_t WS_PROJ = 290 * MiB;
constexpr size_t WS_RAW = 584 * MiB;
constexpr size_t WS_RAW2 = 650 * MiB;
constexpr size_t WS_QN = 1008 * MiB;
constexpr size_t WS_RWA = 1042 * MiB, RWA_STRIDE = 33 * MiB;
constexpr size_t WS_Y = 1273 * MiB;
constexpr size_t WS_SC = 1306 * MiB;
constexpr size_t WS_SCS = 1434 * MiB;
constexpr size_t WS_MASK = 1436 * MiB;
constexpr size_t WS_SLIST = 1440 * MiB;
constexpr size_t WS_QB = 1444 * MiB, WS_KB = 1461 * MiB, WS_VB = 1478 * MiB;
constexpr size_t WS_MASKT = 1495 * MiB;
constexpr size_t WS_QIB = 1500 * MiB;
constexpr size_t WS_KIB = 1536 * MiB;
constexpr size_t WS_WI = 1539 * MiB;
constexpr size_t WS_LIN = 1541 * MiB;
constexpr size_t WS_KX = 1550 * MiB;
constexpr size_t WS_W2T = 1583 * MiB, WS_A2T = 1584 * MiB, WS_G2T = 1585 * MiB;
constexpr size_t WS_MF = 1586 * MiB, WS_NT = 1603 * MiB, WS_PF = 1636 * MiB, WS_QP = 1653 * MiB, WS_ZF = 1686 * MiB;
constexpr size_t WS_Y2 = 1703 * MiB;
constexpr size_t WS_END = 1736 * MiB;
constexpr int QI_LD = 17 * 64;
constexpr int CW_BAR = 4096;

constexpr int NWAVES = 8, NTHREADS = 512;
constexpr int LDS_BYTES = 147456, MISC_OFF = 131072 + 320;

__device__ __forceinline__ unsigned f2bf(float f) { unsigned u = __builtin_bit_cast(unsigned, f); return (u + 0x7fffu + ((u >> 16) & 1u)) >> 16; }
__device__ __forceinline__ unsigned pk2(float lo, float hi) { return f2bf(lo) | (f2bf(hi) << 16); }
__device__ __forceinline__ float wave_sum(float v) {
#pragma unroll
    for (int o = 1; o < 64; o <<= 1) v += __shfl_xor(v, o);
    return v;
}
__device__ __forceinline__ float wave_max(float v) {
#pragma unroll
    for (int o = 1; o < 64; o <<= 1) v = fmaxf(v, __shfl_xor(v, o));
    return v;
}
__device__ __forceinline__ int wave_sum_i(int v) {
#pragma unroll
    for (int o = 1; o < 64; o <<= 1) v += __shfl_xor(v, o);
    return v;
}
__device__ __forceinline__ float sigmoidf_(float x) { return 1.f / (1.f + expf(-x)); }
__device__ __forceinline__ unsigned sortable(float f) { const unsigned u = __builtin_bit_cast(unsigned, f); return (u & 0x80000000u) ? ~u : (u | 0x80000000u); }
__device__ __forceinline__ unsigned long long lanemask_lt(int lane) { return (1ull << lane) - 1ull; }
__device__ __forceinline__ float rdlane(float v, int l) { return __builtin_bit_cast(float, __builtin_amdgcn_readlane(__builtin_bit_cast(int, v), l)); }

struct Args { const float* in[32]; float* out; unsigned char* ws; int ph_lo, ph_hi; };

struct Ctx {
    LAS unsigned char* lds;
    int tid, lane, wave, G, gw, ngw;
    const float* const* in; float* out; unsigned char* ws;
};
__device__ __forceinline__ const float* x_row(const Ctx& C, int m) { return m < MP ? C.in[0] + (size_t)m * D : C.in[1] + (size_t)(m - MP) * D; }
__device__ __forceinline__ int mod_row(int m) { return m < MP ? (m >> 11) : NB + (m - MP); }

struct EpiRawF32 {
    static constexpr bool PERM = false, AFTER_DRAIN = false;
    float* O; int ldc;
    __device__ __forceinline__ void operator()(const pg8::f32x4 (&acc)[2][2][4][2], const pg8::Unit& u, int wr, int wc, int fr, int fq) const {
        const int row0 = u.pm * 256 + wr * 64 + fr, col0 = u.pn * 256 + wc * 32 + 4 * fq;
#pragma unroll
        for (int ai = 0; ai < 2; ++ai)
#pragma unroll
            for (int m = 0; m < 4; ++m) { float* rowp = O + (size_t)(row0 + ai * 128 + m * 16) * ldc + col0;
#pragma unroll
                for (int bj = 0; bj < 2; ++bj)
#pragma unroll
                    for (int n = 0; n < 2; ++n) *(pg8::f32x4*)(rowp + bj * 128 + n * 16) = acc[ai][bj][m][n]; }
    }
};

__device__ __forceinline__ void p0_mod(const Ctx& C) {
    LAS float* sc = (LAS float*)C.lds;
    const float* cp = C.in[8]; const float* cs = C.in[9]; const float* wada = C.in[12]; const float* bada = C.in[13];
    float* MOD = (float*)(C.ws + WS_MOD);
    const int cl = C.tid & 31, kc = C.tid >> 5;
    for (int u = blockIdx.x; u < MODW / 32; u += C.G) {
        const int c0 = 32 * u;
        float acc[40];
#pragma unroll
        for (int r = 0; r < 40; ++r) acc[r] = 0.f;
        for (int hh = 0; hh < 2; ++hh) {
            __syncthreads();
            for (int i = C.tid; i < 40 * 512; i += NTHREADS) { const int r = i >> 9, kk = i & 511; const float v = (r < NB) ? cp[r * D + 512 * hh + kk] : cs[(r - NB) * D + 512 * hh + kk]; sc[i] = v / (1.f + expf(-v)); }
            __syncthreads();
            const int kb = 512 * hh + 32 * kc;
            for (int k4 = 0; k4 < 8; ++k4) {
                const float* wp = wada + (size_t)(kb + 4 * k4) * MODW + c0 + cl;
                const float w0 = wp[0], w1 = wp[MODW], w2 = wp[2 * MODW], w3 = wp[3 * MODW];
#pragma unroll
                for (int r = 0; r < 40; ++r) { const f32x4 s = *(const LAS f32x4*)(sc + r * 512 + 32 * kc + 4 * k4); acc[r] += s.x * w0 + s.y * w1 + s.z * w2 + s.w * w3; }
            }
        }
        __syncthreads();
#pragma unroll
        for (int r = 0; r < 40; ++r) sc[(kc * 40 + r) * 32 + cl] = acc[r];
        __syncthreads();
        for (int i = C.tid; i < 40 * 32; i += NTHREADS) { const int r = i >> 5, c = i & 31; float s = 0.f;
            for (int k = 0; k < 16; ++k) s += sc[(k * 40 + r) * 32 + c];
            MOD[r * MODW + c0 + c] = s + bada[c0 + c]; }
    }
    __syncthreads();
}
__device__ __forceinline__ void transpose_item(const float* W, int K, int N, int NP, bf16* WT, int row_off, LAS float* scr, int item, int lane) {
    const int nblk = NP / 32, kb = item / nblk, nb = item % nblk, k0 = 64 * kb, n0 = 32 * nb;
    const int nsrc = n0 + (lane & 31);
#pragma unroll 8
    for (int i = 0; i < 32; ++i) { const int kk = 2 * i + (lane >> 5); scr[kk * 33 + (lane & 31)] = (nsrc < N) ? W[(size_t)(k0 + kk) * N + nsrc] : 0.f; }
    LDS_WAIT(); asm volatile("" ::: "memory");
    const int c = lane & 7;
#pragma unroll
    for (int j = 0; j < 4; ++j) { const int n = (lane >> 3) + 8 * j; const LAS float* s = scr + (8 * c) * 33 + n;
        v4u o; o.x = pk2(s[0 * 33], s[1 * 33]); o.y = pk2(s[2 * 33], s[3 * 33]); o.z = pk2(s[4 * 33], s[5 * 33]); o.w = pk2(s[6 * 33], s[7 * 33]);
        *(GAS v4u*)(WT + (size_t)(row_off + n0 + n) * K + k0 + 8 * c) = o; }
    LDS_WAIT(); asm volatile("" ::: "memory");
}
__device__ __forceinline__ void p0_weights(const Ctx& C) {
    LAS float* scr = (LAS float*)(C.lds + C.wave * 16384);
    constexpr int I_IN = (D / 64) * (NIN / 32), I_OUT = (D / 64) * (D / 32), I_G = (D / 64) * (FFN / 32), I_DN = (FFN / 64) * (D / 32);
    constexpr int I_L = RW_W / 32, NITEMS = I_IN + I_OUT + 2 * I_G + I_DN + 4 * I_L;
    bf16* WIN = (bf16*)(C.ws + WS_WIN); bf16* WOUT = (bf16*)(C.ws + WS_WOUT); bf16* WGU = (bf16*)(C.ws + WS_WGU); bf16* WDN = (bf16*)(C.ws + WS_WDN);
    for (int it = C.gw; it < NITEMS; it += C.ngw) {
        int r = it;
        if (r < I_IN) { transpose_item(C.in[14], D, IN_COLS, NIN, WIN, 0, scr, r, C.lane); continue; } r -= I_IN;
        if (r < I_OUT) { transpose_item(C.in[28], D, D, D, WOUT, 0, scr, r, C.lane); continue; } r -= I_OUT;
        if (r < I_G) { transpose_item(C.in[29], D, FFN, FFN, WGU, 0, scr, r, C.lane); continue; } r -= I_G;
        if (r < I_G) { transpose_item(C.in[30], D, FFN, FFN, WGU, FFN, scr, r, C.lane); continue; } r -= I_G;
        if (r < I_DN) { transpose_item(C.in[31], FFN, D, D, WDN, 0, scr, r, C.lane); continue; } r -= I_DN;
        if (r < I_L) { transpose_item(C.in[19], 64, RW_W, RW_W, (bf16*)(C.ws + WS_W2T), 0, scr, r, C.lane); continue; } r -= I_L;
        if (r < I_L) { transpose_item(C.in[21], 64, RW_W, RW_W, (bf16*)(C.ws + WS_A2T), 0, scr, r, C.lane); continue; } r -= I_L;
        transpose_item(C.in[22], 128, RW_W, RW_W, (bf16*)(C.ws + WS_G2T), 0, scr, r, C.lane);
    }
}
__device__ __forceinline__ void norm_mod_row(const Ctx& C, int m, const float* xr, const float* g, const float* shift, const float* scale, bf16* orow) {
    const GAS f32x4* xp = (const GAS f32x4*)xr + C.lane;
    f32x4 v[4]; float s = 0.f;
#pragma unroll
    for (int j = 0; j < 4; ++j) { v[j] = xp[64 * j]; s += (v[j].x * v[j].x + v[j].y * v[j].y) + (v[j].z * v[j].z + v[j].w * v[j].w); }
    const float rstd = 1.f / sqrtf(wave_sum(s) * (1.f / D) + RMS_EPS);
    GAS unsigned long long* o8 = (GAS unsigned long long*)orow + C.lane;
#pragma unroll
    for (int j = 0; j < 4; ++j) { const int c = 4 * (C.lane + 64 * j);
        const f32x4 gg = *(const f32x4*)(g + c), sh = *(const f32x4*)(shift + c), sc = *(const f32x4*)(scale + c);
        const f32x4 h = v[j] * rstd * gg * (1.f + sc) + sh;
        o8[64 * j] = (unsigned long long)pk2(h.x, h.y) | ((unsigned long long)pk2(h.z, h.w) << 32); }
}
__device__ __forceinline__ void p1_norm1(const Ctx& C) {
    bf16* A1 = (bf16*)(C.ws + WS_A1); const float* MOD = (const float*)(C.ws + WS_MOD);
    for (int m = C.gw; m < MPAD; m += C.ngw) {
        bf16* orow = A1 + (size_t)m * D;
        if (m >= MT) { GAS unsigned long long* o8 = (GAS unsigned long long*)orow + C.lane;
#pragma unroll
            for (int j = 0; j < 4; ++j) o8[64 * j] = 0ull;
            continue; }
        const float* md = MOD + mod_row(m) * MODW;
        norm_mod_row(C, m, x_row(C, m), C.in[10], md, md + D, orow);
    }
}
__device__ __forceinline__ void p3_post(const Ctx& C) {
    const float* PROJ = (const float*)(C.ws + WS_PROJ); float* QN = (float*)(C.ws + WS_QN);
    const int lane = C.lane;
    const float qg = C.in[15][lane], kg = C.in[16][lane];
    for (int m = C.gw; m < MT; m += C.ngw) {
        const float* p = PROJ + (size_t)m * NIN;
        const bool smp = m >= MP; const int j = m - MP;
        float* ko = C.out + (smp ? OUT_KS + (size_t)j * ATT_W : OUT_KP + (size_t)m * ATT_W);
        float* vo = C.out + (smp ? OUT_VS + (size_t)j * ATT_W : OUT_VP + (size_t)m * ATT_W);
        float* io = C.out + (smp ? OUT_IKS + (size_t)j * IDD : OUT_IKP + (size_t)m * IDD);
        float* qn = QN + (size_t)m * ATT_W;
        bf16* qb = (bf16*)(C.ws + WS_QB) + (size_t)m * ATT_W; bf16* kb = (bf16*)(C.ws + WS_KB) + (size_t)m * ATT_W; bf16* vb = (bf16*)(C.ws + WS_VB) + (size_t)m * ATT_W;
        for (int h = 0; h < AH; ++h) {
            const float q = p[O_Q + h * 64 + lane], k = p[O_K + h * 64 + lane];
            const float sq = wave_sum(q * q), sk = wave_sum(k * k);
            const float qv = q * (1.f / sqrtf(sq * (1.f / 64.f) + RMS_EPS)) * qg, kv = k * (1.f / sqrtf(sk * (1.f / 64.f) + RMS_EPS)) * kg, vv = p[O_V + h * 64 + lane];
            qn[h * 64 + lane] = qv; ko[h * 64 + lane] = kv; vo[h * 64 + lane] = vv;
            qb[h * 64 + lane] = (bf16)f2bf(qv * attn_body::C2); kb[h * 64 + lane] = (bf16)f2bf(kv); vb[h * 64 + lane] = (bf16)f2bf(vv);
        }
        const float ki = p[O_KI + lane];
        const float kin = ki * (1.f / sqrtf(wave_sum(ki * ki) * (1.f / 64.f) + RMS_EPS));
        io[lane] = kin;
        ((bf16*)(C.ws + WS_KIB))[(size_t)m * IDD + lane] = (bf16)f2bf(kin);
        { bf16* qi = (bf16*)(C.ws + WS_QIB) + (size_t)m * QI_LD; float ql = 0.f;
          for (int h = 0; h < IH; ++h) { const float v = p[O_QI + h * 64 + lane]; qi[h * 64 + lane] = (bf16)f2bf(v); ql += p[O_WI + h] * v; }
          qi[IH * 64 + lane] = (bf16)f2bf(ql);
          if (lane < IH) ((float*)(C.ws + WS_WI))[(size_t)m * IH + lane] = p[O_WI + lane]; }
        if (smp || (m & (T - 1)) == T - 1) {
            float* so = C.out + (smp ? OUT_SHS + (size_t)j * RW_COLS : OUT_SHP + (size_t)(m >> 11) * RW_COLS);
            for (int i = 0; i < RW_COLS / 64; ++i) so[i * 64 + lane] = p[O_RW + i * 64 + lane];
        }
    }
}
template <bool OLD_ALL> __device__ __forceinline__ void p3_rwprep(const Ctx& C) {
    const float* PROJ = (const float*)(C.ws + WS_PROJ);
    float* Rr = (float*)(C.ws + WS_RWA), *Wd = (float*)(C.ws + WS_RWA + RWA_STRIDE), *Kp = (float*)(C.ws + WS_RWA + 2 * RWA_STRIDE), *Vv = (float*)(C.ws + WS_RWA + 3 * RWA_STRIDE),
          *KK = (float*)(C.ws + WS_RWA + 4 * RWA_STRIDE), *Bb = (float*)(C.ws + WS_RWA + 5 * RWA_STRIDE), *Gg = (float*)(C.ws + WS_RWA + 6 * RWA_STRIDE);
    const float* mu = C.in[17]; const float* w0 = C.in[18]; const float* w2 = C.in[19]; const float* a0 = C.in[20]; const float* a2 = C.in[21]; const float* g2 = C.in[22];
    const float* k_k = C.in[23]; const float* k_a = C.in[24];
    LAS float* lw = (LAS float*)(C.lds + C.wave * 1024);
    const int lane = C.lane;
    for (int m = C.gw; m < MT; m += C.ngw) {
        const float* p = PROJ + (size_t)m * NIN + O_RW;
        const bool smp = m >= MP; const int j = m - MP; const int t = m & (T - 1);
        const float* pv = smp ? C.in[6] + (size_t)j * RW_COLS : (t == 0 ? nullptr : p - NIN);
#define XM(c) ({ const int c_ = (c); const float cur_ = p[c_]; const float prv_ = pv ? pv[c_] : 0.f; cur_ + (prv_ - cur_) * mu[c_]; })
        const float l0 = tanhf(XM(1536 + lane)), l1 = XM(1600 + lane), l2 = sigmoidf_(XM(1664 + lane)), l3 = sigmoidf_(XM(1728 + lane));
        if (!smp) {
            bf16* lin = (bf16*)(C.ws + WS_LIN) + (size_t)m * 256; float* KX = (float*)(C.ws + WS_KX);
            lin[lane] = (bf16)f2bf(l0); lin[64 + lane] = (bf16)f2bf(l1); lin[128 + lane] = (bf16)f2bf(l2); lin[192 + lane] = (bf16)f2bf(l3);
            for (int h = 0; h < RH; ++h) { const int c = h * 64 + lane; const size_t o = (size_t)m * RW_W + c;
                const float r = XM(c), k = XM(512 + c), v = XM(1024 + c);
                float kk = k * k_k[c]; const float nrm = wave_sum(kk * kk); kk *= 1.f / sqrtf(fmaxf(nrm, 1e-24f));
                Rr[o] = r; KX[o] = k; Vv[o] = v; KK[o] = kk; }
            if (!OLD_ALL) continue;
        }
        lw[lane] = l0; lw[64 + lane] = l1; lw[128 + lane] = l2; lw[192 + lane] = l3;
        LDS_WAIT(); asm volatile("" ::: "memory");
        for (int h = 0; h < RH; ++h) {
            const int c = h * 64 + lane;
            float aw = w0[c], aa = a0[c], ag = 0.f;
            for (int jj = 0; jj < 64; ++jj) { aw += lw[jj] * w2[jj * RW_W + c]; aa += lw[64 + jj] * a2[jj * RW_W + c]; }
            for (int jj = 0; jj < 128; ++jj) ag += lw[128 + jj] * g2[jj * RW_W + c];
            const float decay = expf(-0.6065306597126334f * sigmoidf_(aw));
            const float a = sigmoidf_(aa);
            const float r = XM(c), k = XM(512 + c), v = XM(1024 + c);
            float kk = k * k_k[c]; const float nrm = wave_sum(kk * kk); kk *= 1.f / sqrtf(fmaxf(nrm, 1e-24f));
            const float kp = k * (1.f + (a - 1.f) * k_a[c]);
            const size_t o = (size_t)m * RW_W + c;
            Rr[o] = r; Wd[o] = decay; Kp[o] = kp; Vv[o] = v; KK[o] = kk; Bb[o] = kk * a; Gg[o] = ag;
        }
#undef XM
        LDS_WAIT(); asm volatile("" ::: "memory");
    }
}
namespace idxsel {
typedef short bf16x8 __attribute__((ext_vector_type(8)));
typedef float f32x16 __attribute__((ext_vector_type(16)));
constexpr int QT_BYTES = 17 * 32 * 128, WT_OFF = QT_BYTES, CNT_OFF = WT_OFF + 32 * 17 * 4;
__device__ __forceinline__ int crow(int r, int hi) { return (r & 3) + 8 * (r >> 2) + 4 * hi; }
__device__ __forceinline__ void unit(const Ctx& C, int b, int qg) {
    const int lane = C.lane, r32 = lane & 31, hi = lane >> 5, wave = C.wave;
    LAS unsigned char* lds = C.lds;
    const bf16* QIb = (const bf16*)(C.ws + WS_QIB); const bf16* KIb = (const bf16*)(C.ws + WS_KIB); const float* WIr = (const float*)(C.ws + WS_WI);
    unsigned long long* MASKT = (unsigned long long*)(C.ws + WS_MASKT);
    LAS float* WT = (LAS float*)(lds + WT_OFF); LAS int* CNT = (LAS int*)(lds + CNT_OFF);
    const size_t row0 = (size_t)b * T + 32 * qg;
    __syncthreads();
    for (int i = C.tid; i < 32 * 136; i += NTHREADS) { const int q = i / 136, hc = i % 136, h = hc >> 3, c = hc & 7;
        const v4u v = *(const v4u*)(QIb + (row0 + q) * QI_LD + hc * 8);
        *(LAS v4u*)(lds + ((h * 32 + q) * 8 + (c ^ (q & 7))) * 16) = v; }
    { const int q = C.tid >> 4, h = C.tid & 15; WT[q * 17 + h] = WIr[(row0 + q) * IH + h]; }
    __syncthreads();
    f32x16 sc[8];
#pragma unroll
    for (int j = 0; j < 8; ++j) sc[j] = f32x16{};
#pragma unroll
    for (int j = 0; j < 8; ++j) {
        const int kt0 = wave + 8 * j;
        asm volatile("" ::: "memory");
        if (kt0 <= qg) {
            bf16x8 ka[4];
            const bf16* kp0 = KIb + ((size_t)b * T + kt0 * 32 + r32) * IDD + 8 * hi;
#pragma unroll
            for (int s4 = 0; s4 < 4; ++s4) ka[s4] = *(const bf16x8*)(kp0 + 16 * s4);
            bf16x8 qf[4];
#pragma unroll
            for (int s4 = 0; s4 < 4; ++s4) qf[s4] = *(const LAS bf16x8*)(lds + ((0 * 32 + r32) * 8 + ((2 * s4 + hi) ^ (r32 & 7))) * 16);
#pragma unroll 1
            for (int h = 0; h < 17; ++h) {
                bf16x8 qn[4];
                const int hn = h < 16 ? h + 1 : 16;
#pragma unroll
                for (int s4 = 0; s4 < 4; ++s4) qn[s4] = *(const LAS bf16x8*)(lds + ((hn * 32 + r32) * 8 + ((2 * s4 + hi) ^ (r32 & 7))) * 16);
                const float w = WT[r32 * 17 + h];
                f32x16 xa = f32x16{};
#pragma unroll
                for (int s4 = 0; s4 < 4; ++s4) xa = __builtin_amdgcn_mfma_f32_32x32x16_bf16(ka[s4], qf[s4], xa, 0, 0, 0);
                if (h < 16) {
#pragma unroll
                    for (int r = 0; r < 16; ++r) sc[j][r] = __builtin_fmaf(__builtin_fabsf(xa[r]), w, sc[j][r]); }
                else {
#pragma unroll
                    for (int r = 0; r < 16; ++r) sc[j][r] += xa[r]; }
#pragma unroll
                for (int s4 = 0; s4 < 4; ++s4) qf[s4] = qn[s4];
            }
        }
    }
    unsigned key[8][16];
#pragma unroll
    for (int j = 0; j < 8; ++j) { const int kt = wave + 8 * j;
#pragma unroll
        for (int r = 0; r < 16; ++r) { const bool valid = (kt < qg) || (kt == qg && crow(r, hi) <= r32); key[j][r] = valid ? sortable(sc[j][r]) : 0u; } }
    unsigned Tk = 1u;
    if (qg >= 8) {
        Tk = 0u; int buf = 0;
        for (int bit = 31; bit >= 0; --bit) {
            const unsigned cand = Tk | (1u << bit); int c = 0;
#pragma unroll
            for (int j = 0; j < 8; ++j) if (wave + 8 * j <= qg) {
#pragma unroll
                for (int r = 0; r < 16; ++r) c += (key[j][r] >= cand) ? 1 : 0; }
            c += __shfl_xor(c, 32);
            if (hi == 0) CNT[(buf * 8 + wave) * 32 + r32] = c;
            __syncthreads();
            int tot = 0;
#pragma unroll
            for (int w = 0; w < 8; ++w) tot += CNT[(buf * 8 + w) * 32 + r32];
            if (tot >= TOPK) Tk = cand;
            buf ^= 1;
        }
    }
#pragma unroll
    for (int j = 0; j < 8; ++j) { const int kt = wave + 8 * j; unsigned long long mine = 0ull;
#pragma unroll
        for (int r = 0; r < 16; ++r) { const unsigned long long W = __ballot(key[j][r] >= Tk); if (lane == r) mine = W; }
        if (lane < 16) MASKT[(((size_t)(b * 64 + qg) * 32 + (kt >> 1)) * 32) + (kt & 1) * 16 + lane] = mine; }
}
__device__ __forceinline__ void phase(const Ctx& C) {
    const int v = (int)((blockIdx.x % 8) * (C.G / 8) + blockIdx.x / 8);
    for (int vv = v; vv < NB * 32; vv += C.G) { const int b = vv >> 5, i = vv & 31; unit(C, b, 63 - i); unit(C, b, i); }
    __syncthreads();
}
}
__device__ __forceinline__ float idx_score(const float (&kr)[64], const LAS float* ql, const LAS float* wl) {
    float score = 0.f;
    for (int h = 0; h < IH; ++h) {
        float d = 0.f;
#pragma unroll
        for (int dd = 0; dd < 64; dd += 4) { const f32x4 qv = *(const LAS f32x4*)(ql + h * 64 + dd); d += qv.x * kr[dd] + qv.y * kr[dd + 1] + qv.z * kr[dd + 2] + qv.w * kr[dd + 3]; }
        score += wl[h] * fmaxf(d, 0.f);
    }
    return score;
}
template <bool PROMPT, bool SAMPLE> __device__ __forceinline__ void p4_indexer(const Ctx& C) {
    const float* PROJ = (const float*)(C.ws + WS_PROJ); float* SC = (float*)(C.ws + WS_SC); float* SCS = (float*)(C.ws + WS_SCS);
    LAS float* ql = (LAS float*)C.lds;
    LAS float* wl = ql + 16 * 1024;
    const int lane = C.lane;
    if (PROMPT) for (int u = blockIdx.x; u < NB * 128 * 4; u += C.G) {
        const int b = u >> 9, tq = (u >> 2) & 127, scn = u & 3, t0 = tq * 16;
        if (scn * 512 > t0 + 15) continue;
        __syncthreads();
        for (int i = C.tid; i < 16 * 1024; i += NTHREADS) { const int q = i >> 10, e = i & 1023; ql[i] = PROJ[(size_t)(b * T + t0 + q) * NIN + O_QI + e]; }
        if (C.tid < 256) { const int q = C.tid >> 4, h = C.tid & 15; wl[C.tid] = PROJ[(size_t)(b * T + t0 + q) * NIN + O_WI + h] * IDX_W_SCALE; }
        __syncthreads();
        const int s = scn * 512 + C.wave * 64 + lane;
        if (scn * 512 + C.wave * 64 <= t0 + 15) {
            float kr[64];
            const f32x4* kp = (const f32x4*)(C.out + OUT_IKP + (size_t)(b * T + s) * IDD);
#pragma unroll
            for (int i = 0; i < 16; ++i) { const f32x4 v = kp[i]; kr[4 * i] = v.x; kr[4 * i + 1] = v.y; kr[4 * i + 2] = v.z; kr[4 * i + 3] = v.w; }
            for (int q = 0; q < 16; ++q) {
                const float score = idx_score(kr, ql + q * 1024, wl + q * 16);
                const int t = t0 + q;
                if (s <= t) SC[((size_t)b * T + t) * T + s] = score;
            }
        }
    }
    __syncthreads();
    const int* pt = (const int*)C.in[7];
    LAS float* qw = (LAS float*)(C.lds + C.wave * 8192); LAS float* ww = qw + 1024;
    if (SAMPLE) for (int wu = C.gw; wu < NSMP * 129; wu += C.ngw) {
        const int j = wu / 129, kb = wu % 129;
        const float* pq = PROJ + (size_t)(MP + j) * NIN;
        for (int i = 0; i < 16; ++i) qw[i * 64 + lane] = pq[O_QI + i * 64 + lane];
        if (lane < 16) ww[lane] = pq[O_WI + lane] * IDX_W_SCALE;
        LDS_WAIT(); asm volatile("" ::: "memory");
        const int s = kb * 64 + lane;
        const float* krow = nullptr;
        if (s < PAST) krow = C.in[4] + ((size_t)pt[j * NPAGES + (s >> 7)] * PAGE + (s & 127)) * IDD;
        else if (s == PAST) krow = C.out + OUT_IKS + (size_t)j * IDD;
        float score = -INFINITY;
        if (krow) { float kr[64]; const f32x4* kp = (const f32x4*)krow;
#pragma unroll
            for (int i = 0; i < 16; ++i) { const f32x4 v = kp[i]; kr[4 * i] = v.x; kr[4 * i + 1] = v.y; kr[4 * i + 2] = v.z; kr[4 * i + 3] = v.w; }
            score = idx_score(kr, qw, ww); }
        SCS[(size_t)j * SCS_LD + s] = score;
        LDS_WAIT(); asm volatile("" ::: "memory");
    }
}
template <bool PROBE> __device__ __forceinline__ void p4_scan(const Ctx& C, int u_begin) {
    const float* Rr = (const float*)(C.ws + WS_RWA), *Wd = (const float*)(C.ws + WS_RWA + RWA_STRIDE), *Kp = (const float*)(C.ws + WS_RWA + 2 * RWA_STRIDE), *Vv = (const float*)(C.ws + WS_RWA + 3 * RWA_STRIDE),
          *KK = (const float*)(C.ws + WS_RWA + 4 * RWA_STRIDE), *Bb = (const float*)(C.ws + WS_RWA + 5 * RWA_STRIDE);
    float* Y = (float*)(C.ws + (PROBE ? WS_Y2 : WS_Y));
    const int lane = C.lane;
    for (int u = u_begin + C.gw; u < (PROBE ? NB * RH : NB * RH + NSMP * RH); u += C.ngw) {
        const bool smp = u >= NB * RH; const int seq = smp ? (u - NB * RH) / RH : u / RH, h = u % RH;
        const int nsteps = smp ? 1 : T; const size_t base = smp ? (size_t)(MP + seq) : (size_t)seq * T;
        float S[64];
        if (smp) { const f32x4* sp = (const f32x4*)(C.in[5] + (((size_t)seq * RH + h) * RN + lane) * RN);
#pragma unroll
            for (int i = 0; i < 16; ++i) { const f32x4 v = sp[i]; S[4 * i] = v.x; S[4 * i + 1] = v.y; S[4 * i + 2] = v.z; S[4 * i + 3] = v.w; } }
        else {
#pragma unroll
            for (int i = 0; i < 64; ++i) S[i] = 0.f; }
        size_t o = base * RW_W + h * 64 + lane;
        float r = Rr[o], w = Wd[o], k = Kp[o], v = Vv[o], kk = KK[o], bb = Bb[o];
        for (int t = 0; t < nsteps; ++t) {
            float rn = 0.f, wn = 0.f, kn = 0.f, vn = 0.f, kkn = 0.f, bbn = 0.f;
            const size_t on = o + RW_W;
            if (t + 1 < nsteps) { rn = Rr[on]; wn = Wd[on]; kn = Kp[on]; vn = Vv[on]; kkn = KK[on]; bbn = Bb[on]; }
            float sa0 = 0.f, sa1 = 0.f;
#pragma unroll
            for (int jx = 0; jx < 64; jx += 2) { sa0 += S[jx] * rdlane(kk, jx); sa1 += S[jx + 1] * rdlane(kk, jx + 1); }
            const float sa = -(sa0 + sa1);
            float y0 = 0.f, y1 = 0.f;
#pragma unroll
            for (int jx = 0; jx < 64; jx += 2) {
                S[jx] = S[jx] * rdlane(w, jx) + sa * rdlane(bb, jx) + v * rdlane(k, jx); y0 += S[jx] * rdlane(r, jx);
                S[jx + 1] = S[jx + 1] * rdlane(w, jx + 1) + sa * rdlane(bb, jx + 1) + v * rdlane(k, jx + 1); y1 += S[jx + 1] * rdlane(r, jx + 1); }
            Y[o] = y0 + y1;
            o = on; r = rn; w = wn; k = kn; v = vn; kk = kkn; bb = bbn;
        }
        f32x4* so = (f32x4*)(C.out + (smp ? OUT_WKVS : OUT_WKVP) + (((size_t)seq * RH + h) * RN + lane) * RN);
        if (!PROBE)
#pragma unroll
        for (int i = 0; i < 16; ++i) so[i] = (f32x4){S[4 * i], S[4 * i + 1], S[4 * i + 2], S[4 * i + 3]};
    }
}
template <bool PROMPT, bool SAMPLE> __device__ __forceinline__ void p5_select(const Ctx& C) {
    const float* SC = (const float*)(C.ws + WS_SC); unsigned* MASK = (unsigned*)(C.ws + WS_MASK);
    const int lane = C.lane;
    if (PROMPT) for (int row = C.gw; row < MP; row += C.ngw) {
        const int t = row & (T - 1); const float* sp = SC + (size_t)row * T;
        unsigned key[32];
#pragma unroll
        for (int j = 0; j < 32; ++j) { const int s = 64 * j + lane; key[j] = (s <= t) ? sortable(sp[s]) : 0u; }
        unsigned Tk = 0u; int need = 0;
        const bool all = (t + 1 <= TOPK);
        if (!all) {
            for (int bit = 31; bit >= 0; --bit) { const unsigned cand = Tk | (1u << bit); int cnt = 0;
#pragma unroll
                for (int j = 0; j < 32; ++j) cnt += __builtin_popcountll(__ballot(key[j] >= cand));
                if (cnt >= TOPK) Tk = cand; }
            int cgt = 0;
#pragma unroll
            for (int j = 0; j < 32; ++j) cgt += __builtin_popcountll(__ballot(key[j] > Tk));
            need = TOPK - cgt;
        }
        int running = 0;
#pragma unroll
        for (int j = 0; j < 32; ++j) {
            const int s = 64 * j + lane; bool take;
            if (all) take = (s <= t);
            else { const bool gt = key[j] > Tk, eq = key[j] == Tk; const unsigned long long eqb = __ballot(eq);
                const int pre = __builtin_popcountll(eqb & lanemask_lt(lane)); take = gt || (eq && (running + pre < need)); running += __builtin_popcountll(eqb); }
            const unsigned long long mb = __ballot(take);
            if (lane == 0) { MASK[(size_t)row * 64 + 2 * j] = (unsigned)mb; MASK[(size_t)row * 64 + 2 * j + 1] = (unsigned)(mb >> 32); }
        }
    }
    const float* SCS = (const float*)(C.ws + WS_SCS); int* SLIST = (int*)(C.ws + WS_SLIST);
    LAS int* sh = (LAS int*)C.lds;
    if (SAMPLE) for (int j = blockIdx.x; j < NSMP; j += C.G) {
        unsigned key[17];
#pragma unroll
        for (int i = 0; i < 17; ++i) { const int s = i * NTHREADS + C.tid; key[i] = (s < LS) ? sortable(SCS[(size_t)j * SCS_LD + s]) : 0u; }
        unsigned Tk = 0u;
        for (int bit = 31; bit >= 0; --bit) { const unsigned cand = Tk | (1u << bit); int c = 0;
#pragma unroll
            for (int i = 0; i < 17; ++i) c += (key[i] >= cand) ? 1 : 0;
            c = wave_sum_i(c);
            __syncthreads(); if (lane == 0) sh[C.wave] = c; __syncthreads();
            int cnt = 0;
#pragma unroll
            for (int w = 0; w < 8; ++w) cnt += sh[w];
            if (cnt >= TOPK) Tk = cand; }
        int cg = 0;
#pragma unroll
        for (int i = 0; i < 17; ++i) cg += (key[i] > Tk) ? 1 : 0;
        cg = wave_sum_i(cg);
        __syncthreads(); if (lane == 0) sh[C.wave] = cg; __syncthreads();
        int cgt = 0;
#pragma unroll
        for (int w = 0; w < 8; ++w) cgt += sh[w];
        const int need = TOPK - cgt;
        int run_eq = 0, run_sel = 0;
#pragma unroll
        for (int i = 0; i < 17; ++i) {
            const int s = i * NTHREADS + C.tid; const bool gt = key[i] > Tk, eq = key[i] == Tk;
            const unsigned long long eqb = __ballot(eq);
            __syncthreads(); if (lane == 0) sh[C.wave] = __builtin_popcountll(eqb); __syncthreads();
            int eq_before = 0, eq_tot = 0;
#pragma unroll
            for (int w = 0; w < 8; ++w) { const int x = sh[w]; eq_tot += x; if (w < C.wave) eq_before += x; }
            const bool take = gt || (eq && (run_eq + eq_before + __builtin_popcountll(eqb & lanemask_lt(lane)) < need));
            const unsigned long long tb = __ballot(take);
            __syncthreads(); if (lane == 0) sh[8 + C.wave] = __builtin_popcountll(tb); __syncthreads();
            int s_before = 0, s_tot = 0;
#pragma unroll
            for (int w = 0; w < 8; ++w) { const int x = sh[8 + w]; s_tot += x; if (w < C.wave) s_before += x; }
            const int pos = run_sel + s_before + __builtin_popcountll(tb & lanemask_lt(lane));
            if (take && pos < TOPK) SLIST[j * TOPK + pos] = s;
            run_eq += eq_tot; run_sel += s_tot;
        }
    }
    __syncthreads();
}
template <int DIFFK> __device__ __forceinline__ void p5_rwfinal(const Ctx& C) {
    const float* Rr = (const float*)(C.ws + WS_RWA), *Kp = (const float*)(C.ws + WS_RWA + 2 * RWA_STRIDE), *Vv = (const float*)(C.ws + WS_RWA + 3 * RWA_STRIDE), *Gg = (const float*)(C.ws + WS_RWA + 6 * RWA_STRIDE);
    const float* Y = (const float*)(C.ws + WS_Y); bf16* MIX = (bf16*)(C.ws + WS_MIX);
    const float* r_k = C.in[25]; const float* ln_w = C.in[26]; const float* ln_b = C.in[27];
    const int lane = C.lane;
    for (int m = C.gw; m < MT; m += C.ngw) {
        for (int h = 0; h < RH; ++h) {
            const int c = h * 64 + lane; const size_t o = (size_t)m * RW_W + c;
            float y = Y[o];
            if (DIFFK != 0 && m < MP) y += (float)DIFFK * (y - ((const float*)(C.ws + WS_Y2))[o]);
            const float mu = wave_sum(y) * (1.f / 64.f); const float dy = y - mu; const float var = wave_sum(dy * dy) * (1.f / 64.f);
            const float yn = dy * (1.f / sqrtf(var + GN_EPS)) * ln_w[c] + ln_b[c];
            const float bonus = wave_sum(Rr[o] * Kp[o] * r_k[c]) * Vv[o];
            MIX[(size_t)m * D + ATT_W + c] = (bf16)f2bf((yn + bonus) * Gg[o]);
        }
    }
}
__device__ __forceinline__ void p6_masktr(const Ctx& C) {
    const unsigned* MASK = (const unsigned*)(C.ws + WS_MASK); unsigned long long* MASKT = (unsigned long long*)(C.ws + WS_MASKT);
    const int lane = C.lane, q = lane & 31, hi = lane >> 5;
    for (int wu = C.gw; wu < NB * 64 * 32; wu += C.ngw) {
        const int j = wu & 31, qg = (wu >> 5) & 63, b = wu >> 11;
        const size_t row = (size_t)b * T + 32 * qg + q;
        const unsigned w0 = MASK[row * 64 + 2 * j], w1 = MASK[row * 64 + 2 * j + 1];
        unsigned long long mine = 0ull;
#pragma unroll
        for (int r = 0; r < 16; ++r) { const int c = (r & 3) + 8 * (r >> 2) + 4 * hi;
            const unsigned long long W0 = __ballot((w0 >> c) & 1u), W1 = __ballot((w1 >> c) & 1u);
            if (lane == r) mine = W0; if (lane == 16 + r) mine = W1; }
        if (lane < 32) MASKT[((size_t)((b * 64 + qg) * 32 + j)) * 32 + lane] = mine;
    }
}
template <int DIFFK> __device__ __forceinline__ void p6_attn(const Ctx& C, int u_begin, int u_end) {
    const unsigned* MASK = (const unsigned*)(C.ws + WS_MASK); const int* SLIST = (const int*)(C.ws + WS_SLIST); const float* QN = (const float*)(C.ws + WS_QN);
    bf16* MIX = (bf16*)(C.ws + WS_MIX); const int* pt = (const int*)C.in[7];
    LAS int* list = (LAS int*)C.lds;
    LAS float* pb = (LAS float*)(C.lds + 1024);
    LAS int* cntp = (LAS int*)(C.lds + 1024 + 8192);
    const int lane = C.lane, h = C.wave;
    for (int u = u_begin + blockIdx.x; u < u_end; u += C.G) {
        const bool smp = u >= MP; const int j = u - MP, b = u >> 11;
        __syncthreads();
        if (C.wave == 0) {
            if (!smp) { const unsigned w = MASK[(size_t)u * 64 + lane]; const int c = __builtin_popcount(w);
                int incl = c;
#pragma unroll
                for (int o = 1; o < 64; o <<= 1) { const int x = __shfl_up(incl, o); if (lane >= o) incl += x; }
                int pos = incl - c; unsigned ww = w;
                while (ww) { const int bit = __builtin_ctz(ww); ww &= ww - 1u; list[pos++] = 32 * lane + bit; }
                if (lane == 63) *cntp = incl; }
            else { for (int i = 0; i < 4; ++i) list[i * 64 + lane] = SLIST[j * TOPK + i * 64 + lane]; if (lane == 0) *cntp = TOPK; }
        }
        __syncthreads();
        int cnt = *cntp; if (cnt > TOPK) cnt = TOPK;
        float q[64];
        { const f32x4* qp = (const f32x4*)(QN + (size_t)u * ATT_W + h * 64);
#pragma unroll
          for (int i = 0; i < 16; ++i) { const f32x4 v = qp[i]; q[4 * i] = v.x; q[4 * i + 1] = v.y; q[4 * i + 2] = v.z; q[4 * i + 3] = v.w; } }
        float sc[4]; float mx = -INFINITY;
#pragma unroll
        for (int i = 0; i < 4; ++i) { const int idx = i * 64 + lane; sc[i] = -INFINITY;
            if (idx < cnt) { const int s = list[idx]; const float* kp;
                if (!smp) kp = C.out + OUT_KP + ((size_t)(b * T + s)) * ATT_W + h * 64;
                else if (s < PAST) kp = C.in[2] + ((size_t)pt[j * NPAGES + (s >> 7)] * PAGE + (s & 127)) * ATT_W + h * 64;
                else kp = C.out + OUT_KS + (size_t)j * ATT_W + h * 64;
                float d = 0.f;
#pragma unroll
                for (int e = 0; e < 16; ++e) { const f32x4 kv = ((const f32x4*)kp)[e]; d += q[4 * e] * kv.x + q[4 * e + 1] * kv.y + q[4 * e + 2] * kv.z + q[4 * e + 3] * kv.w; }
                sc[i] = d * 0.125f; }
            mx = fmaxf(mx, sc[i]); }
        mx = wave_max(mx); float l = 0.f;
#pragma unroll
        for (int i = 0; i < 4; ++i) { const int idx = i * 64 + lane; const float p = (idx < cnt) ? expf(sc[i] - mx) : 0.f; pb[h * 256 + idx] = p; l += p; }
        l = wave_sum(l);
        LDS_WAIT(); asm volatile("" ::: "memory");
        float o = 0.f;
        for (int kx = 0; kx < cnt; ++kx) { const int s = list[kx]; const float* vp;
            if (!smp) vp = C.out + OUT_VP + ((size_t)(b * T + s)) * ATT_W + h * 64;
            else if (s < PAST) vp = C.in[3] + ((size_t)pt[j * NPAGES + (s >> 7)] * PAGE + (s & 127)) * ATT_W + h * 64;
            else vp = C.out + OUT_VS + (size_t)j * ATT_W + h * 64;
            o += pb[h * 256 + kx] * vp[lane]; }
        if (DIFFK == 0) MIX[(size_t)u * D + h * 64 + lane] = (bf16)f2bf(o / l);
        else { const float a = __builtin_bit_cast(float, (unsigned)MIX[(size_t)u * D + h * 64 + lane] << 16); MIX[(size_t)u * D + h * 64 + lane] = (bf16)f2bf(a + (float)DIFFK * (a - o / l)); }
    }
    __syncthreads();
}
__device__ __forceinline__ void p8_res_norm2(const Ctx& C) {
    const float* RAW = (const float*)(C.ws + WS_RAW); float* X1 = (float*)(C.ws + WS_X1); bf16* A2 = (bf16*)(C.ws + WS_A2); const float* MOD = (const float*)(C.ws + WS_MOD);
    for (int m = C.gw; m < MPAD; m += C.ngw) {
        bf16* orow = A2 + (size_t)m * D;
        if (m >= MT) { GAS unsigned long long* o8 = (GAS unsigned long long*)orow + C.lane;
#pragma unroll
            for (int j = 0; j < 4; ++j) o8[64 * j] = 0ull;
            continue; }
        const float* md = MOD + mod_row(m) * MODW; const float* xr = x_row(C, m);
        float* x1 = X1 + (size_t)m * D;
#pragma unroll
        for (int j = 0; j < 4; ++j) { const int c = 4 * (C.lane + 64 * j);
            const f32x4 xv = *(const f32x4*)(xr + c), rv = *(const f32x4*)(RAW + (size_t)m * D + c), g1 = *(const f32x4*)(md + 2 * D + c);
            *(f32x4*)(x1 + c) = xv + g1 * rv; }
        VM_WAIT(); asm volatile("" ::: "memory");
        norm_mod_row(C, m, x1, C.in[11], md + 3 * D, md + 4 * D, orow);
    }
}
__device__ __forceinline__ void p10_swiglu(const Ctx& C) {
    const float* RAW2 = (const float*)(C.ws + WS_RAW2); bf16* HB = (bf16*)(C.ws + WS_HB);
    const size_t total = (size_t)MPAD * (FFN / 4);
    for (size_t i = (size_t)blockIdx.x * NTHREADS + C.tid; i < total; i += (size_t)C.G * NTHREADS) {
        const size_t m = i / (FFN / 4); const int c = (int)(i % (FFN / 4)) * 4;
        const f32x4 g = *(const f32x4*)(RAW2 + m * NGU + c), u = *(const f32x4*)(RAW2 + m * NGU + FFN + c);
        const float h0 = g.x / (1.f + expf(-g.x)) * u.x, h1 = g.y / (1.f + expf(-g.y)) * u.y, h2 = g.z / (1.f + expf(-g.z)) * u.z, h3 = g.w / (1.f + expf(-g.w)) * u.w;
        *(unsigned long long*)(HB + m * FFN + c) = (unsigned long long)pk2(h0, h1) | ((unsigned long long)pk2(h2, h3) << 32);
    }
}
__device__ __forceinline__ void p12_final(const Ctx& C) {
    const float* RAW = (const float*)(C.ws + WS_RAW); const float* X1 = (const float*)(C.ws + WS_X1); const float* MOD = (const float*)(C.ws + WS_MOD);
    for (int m = C.gw; m < MT; m += C.ngw) {
        const float* md = MOD + mod_row(m) * MODW;
        float* yo = C.out + (m < MP ? OUT_Y + (size_t)m * D : OUT_YS + (size_t)(m - MP) * D);
#pragma unroll
        for (int j = 0; j < 4; ++j) { const int c = 4 * (C.lane + 64 * j);
            const f32x4 xv = *(const f32x4*)(X1 + (size_t)m * D + c), rv = *(const f32x4*)(RAW + (size_t)m * D + c), g2 = *(const f32x4*)(md + 5 * D + c);
            *(f32x4*)(yo + c) = xv + g2 * rv; }
    }
}

namespace rw {
typedef short bf16x8 __attribute__((ext_vector_type(8)));
typedef short s16x4 __attribute__((ext_vector_type(4)));
typedef float f32x16 __attribute__((ext_vector_type(16)));
typedef float f32x4v __attribute__((ext_vector_type(4)));
typedef unsigned u32x2 __attribute__((ext_vector_type(2)));
typedef unsigned u32x4v __attribute__((ext_vector_type(4)));
constexpr int NCH = T / 64;
constexpr int IMG = 16384;
constexpr int A32_OFF = 6 * IMG, TL_OFF = A32_OFF + 16384, WC_OFF = TL_OFF + 16384;
enum { H_AT = 0, H_BT = 1, H_KT = 2, H_RT = 3, H_VT = 4, H_AAK = 5, H_ARB = 6, H_ARK = 7, H_XT = 8, H_TT = 9, H_QT = 10, H_PT = 11 };
__device__ __forceinline__ unsigned off_b(unsigned row, unsigned ch) { return 256u * row + 16u * (ch ^ (((row & 3) << 2) | ((row >> 2) & 3))); }
__device__ __forceinline__ int crow(int r, int hi) { return (r & 3) + 8 * (r >> 2) + 4 * hi; }
__device__ __forceinline__ unsigned cvt2(float lo, float hi) { typedef float f2 __attribute__((ext_vector_type(2))); typedef __bf16 b2 __attribute__((ext_vector_type(2))); f2 v = {lo, hi}; b2 b = __builtin_convertvector(v, b2); return __builtin_bit_cast(unsigned, b); }
__device__ __forceinline__ bf16x8 frag_row(LAS unsigned char* lds, int H, int blk, int s, int lane) {
    return *(const LAS bf16x8*)(lds + (H >> 1) * IMG + off_b(32 * blk + (lane & 31), 8 * (H & 1) + 2 * s + (lane >> 5)));
}
__device__ __forceinline__ bf16x8 frag_tr(LAS unsigned char* lds, int H, int blk, int ks, int lane) {
    const unsigned h = lane >> 5, b2 = (lane >> 4) & 1, q = (lane & 15) >> 2, p = lane & 3, c = 2 * (H & 1) + blk;
    typedef short v4i16_t __attribute__((ext_vector_type(4)));
    LAS unsigned char* base = lds + (H >> 1) * IMG;
    const s16x4 lo = __builtin_bit_cast(s16x4, __builtin_amdgcn_ds_read_tr16_b64_v4i16((LAS v4i16_t*)(base + off_b(16 * ks + 8 * h + q, 4 * c + 2 * b2 + (p >> 1)) + 8 * (p & 1))));
    const s16x4 hi = __builtin_bit_cast(s16x4, __builtin_amdgcn_ds_read_tr16_b64_v4i16((LAS v4i16_t*)(base + off_b(16 * ks + 8 * h + 4 + q, 4 * c + 2 * b2 + (p >> 1)) + 8 * (p & 1))));
    return (bf16x8){lo[0], lo[1], lo[2], lo[3], hi[0], hi[1], hi[2], hi[3]};
}
template <bool ATR, bool BTR> __device__ __forceinline__ f32x16 mm_tile(LAS unsigned char* lds, int HA, int ablk, int HB, int bblk, f32x16 acc, int lane) {
#pragma unroll
    for (int s = 0; s < 4; ++s) {
        const bf16x8 a = ATR ? frag_tr(lds, HA, ablk, s, lane) : frag_row(lds, HA, ablk, s, lane);
        const bf16x8 b = BTR ? frag_tr(lds, HB, bblk, s, lane) : frag_row(lds, HB, bblk, s, lane);
        acc = __builtin_amdgcn_mfma_f32_32x32x16_bf16(a, b, acc, 0, 0, 0);
    }
    return acc;
}
__device__ __forceinline__ void store_tr(LAS unsigned char* lds, int H, int rblk, int cblk, const f32x16& acc, int lane) {
    LAS unsigned char* base = lds + (H >> 1) * IMG; const int hi = lane >> 5, row = 32 * cblk + (lane & 31);
#pragma unroll
    for (int g = 0; g < 4; ++g) { u32x2 w; w.x = cvt2(acc[4 * g], acc[4 * g + 1]); w.y = cvt2(acc[4 * g + 2], acc[4 * g + 3]);
        *(LAS u32x2*)(base + off_b(row, 8 * (H & 1) + 4 * rblk + g) + 8 * hi) = w; }
}
__device__ __forceinline__ u32x4v pack8(const f32x16& a, int s) { u32x4v w; w.x = cvt2(a[8 * s], a[8 * s + 1]); w.y = cvt2(a[8 * s + 2], a[8 * s + 3]); w.z = cvt2(a[8 * s + 4], a[8 * s + 5]); w.w = cvt2(a[8 * s + 6], a[8 * s + 7]); return w; }

struct Bufs { bf16* LIN; bf16* W2T; bf16* A2T; bf16* G2T; float* RX; float* KX; float* VX; float* KKN; float* KP; float* G;
              u32x4v* MF; float* NT; u32x4v* PF; float* QP; u32x4v* ZF; float* Y; };

__device__ __forceinline__ void r1_unit(const Ctx& C, const Bufs& B, int b, int h, int c) {
    LAS unsigned char* lds = C.lds; const int lane = C.lane, wave = C.wave, hi = lane >> 5;
    const size_t row0 = (size_t)b * T + 64 * c; const int ci = (b * RH + h) * NCH + c;
    LAS float* A32 = (LAS float*)(lds + A32_OFF); LAS float* WC = (LAS float*)(lds + WC_OFF);
    typedef float f32x4a __attribute__((ext_vector_type(4)));
    { const int nl = lane & 15, q = lane >> 4;
      if (wave < 4) {
        const int n = 16 * wave + nl, col = h * 64 + n;
        f32x4a aw[4], aa[4];
#pragma unroll
        for (int tt = 0; tt < 4; ++tt) { aw[tt] = (f32x4a){0.f, 0.f, 0.f, 0.f}; aa[tt] = aw[tt]; }
#pragma unroll
        for (int s = 0; s < 2; ++s) {
            const bf16x8 bw = *(const bf16x8*)(B.W2T + (size_t)col * 64 + 32 * s + 8 * q), ba = *(const bf16x8*)(B.A2T + (size_t)col * 64 + 32 * s + 8 * q);
#pragma unroll
            for (int tt = 0; tt < 4; ++tt) { const bf16* lp = B.LIN + (row0 + 16 * tt + nl) * 256 + 32 * s + 8 * q;
                aw[tt] = __builtin_amdgcn_mfma_f32_16x16x32_bf16(*(const bf16x8*)lp, bw, aw[tt], 0, 0, 0);
                aa[tt] = __builtin_amdgcn_mfma_f32_16x16x32_bf16(*(const bf16x8*)(lp + 64), ba, aa[tt], 0, 0, 0); }
        }
        const float w0c = C.in[18][col], a0c = C.in[20][col], kac = C.in[24][col];
        float lw[4][4], av[4][4];
#pragma unroll
        for (int tt = 0; tt < 4; ++tt)
#pragma unroll
            for (int e = 0; e < 4; ++e) { lw[tt][e] = -0.6065306597126334f / (1.f + __expf(-(w0c + aw[tt][e]))); av[tt][e] = 1.f / (1.f + __expf(-(a0c + aa[tt][e]))); }
        float tot[4], L[4][4];
#pragma unroll
        for (int tt = 0; tt < 4; ++tt) { L[tt][0] = lw[tt][0]; L[tt][1] = L[tt][0] + lw[tt][1]; L[tt][2] = L[tt][1] + lw[tt][2]; L[tt][3] = L[tt][2] + lw[tt][3]; tot[tt] = L[tt][3]; }
        float run = 0.f;
#pragma unroll
        for (int tt = 0; tt < 4; ++tt) { float basev = run;
#pragma unroll
            for (int qq = 0; qq < 4; ++qq) { const float o = __shfl(tot[tt], nl + 16 * qq); if (qq < q) basev += o; run += o; }
#pragma unroll
            for (int e = 0; e < 4; ++e) L[tt][e] += basev; }
        if (q == 3) WC[n] = __expf(L[3][3]);
#pragma unroll
        for (int tt = 0; tt < 4; ++tt) {
            asm volatile("" ::: "memory");
            float at[4], bt[4], kt[4], rt[4];
#pragma unroll
            for (int e = 0; e < 4; ++e) { const size_t o = (row0 + 16 * tt + 4 * q + e) * RW_W + col;
                const float rx = B.RX[o], kx = B.KX[o], kkn = B.KKN[o];
                const float kp = kx * (1.f + (av[tt][e] - 1.f) * kac); B.KP[o] = kp;
                const float eL = __expf(L[tt][e]), eLm = __expf(-L[tt][e]), eLex = __expf(L[tt][e] - lw[tt][e]);
                at[e] = -kkn * eLex; bt[e] = kkn * av[tt][e] * eLm; kt[e] = kp * eLm; rt[e] = rx * eL; }
            const unsigned ch = 2 * tt + (q >> 1), bo = 8 * (q & 1);
            u32x2 w;
            w.x = cvt2(at[0], at[1]); w.y = cvt2(at[2], at[3]); *(LAS u32x2*)(lds + 0 * IMG + off_b(n, ch) + bo) = w;
            w.x = cvt2(bt[0], bt[1]); w.y = cvt2(bt[2], bt[3]); *(LAS u32x2*)(lds + 0 * IMG + off_b(n, 8 + ch) + bo) = w;
            w.x = cvt2(kt[0], kt[1]); w.y = cvt2(kt[2], kt[3]); *(LAS u32x2*)(lds + 1 * IMG + off_b(n, ch) + bo) = w;
            w.x = cvt2(rt[0], rt[1]); w.y = cvt2(rt[2], rt[3]); *(LAS u32x2*)(lds + 1 * IMG + off_b(n, 8 + ch) + bo) = w;
        }
      } else {
        const int n = 16 * (wave - 4) + nl, col = h * 64 + n;
        f32x4a ag[4];
#pragma unroll
        for (int tt = 0; tt < 4; ++tt) ag[tt] = (f32x4a){0.f, 0.f, 0.f, 0.f};
#pragma unroll
        for (int s = 0; s < 4; ++s) { const bf16x8 bg = *(const bf16x8*)(B.G2T + (size_t)col * 128 + 32 * s + 8 * q);
#pragma unroll
            for (int tt = 0; tt < 4; ++tt) ag[tt] = __builtin_amdgcn_mfma_f32_16x16x32_bf16(*(const bf16x8*)(B.LIN + (row0 + 16 * tt + nl) * 256 + 128 + 32 * s + 8 * q), bg, ag[tt], 0, 0, 0); }
#pragma unroll
        for (int tt = 0; tt < 4; ++tt) { float vt[4];
#pragma unroll
            for (int e = 0; e < 4; ++e) { const size_t o = (row0 + 16 * tt + 4 * q + e) * RW_W + col; B.G[o] = ag[tt][e]; vt[e] = B.VX[o]; }
            u32x2 w; w.x = cvt2(vt[0], vt[1]); w.y = cvt2(vt[2], vt[3]);
            *(LAS u32x2*)(lds + 2 * IMG + off_b(n, 2 * tt + (q >> 1)) + 8 * (q & 1)) = w; }
      }
    }
    __syncthreads();
#pragma unroll
    for (int k2 = 0; k2 < 2; ++k2) {
        const int id = 2 * wave + k2, prod = id >> 2, tb = (id >> 1) & 1, jb = id & 1;
        f32x16 acc = f32x16{};
        if (prod == 0) acc = mm_tile<true, true>(lds, H_AT, tb, H_BT, jb, acc, lane);
        else if (prod == 1) acc = mm_tile<true, true>(lds, H_AT, tb, H_KT, jb, acc, lane);
        else if (prod == 2) acc = mm_tile<true, true>(lds, H_BT, jb, H_RT, tb, acc, lane);
        else acc = mm_tile<true, true>(lds, H_KT, jb, H_RT, tb, acc, lane);
        if (prod < 2) {
#pragma unroll
            for (int r = 0; r < 16; ++r) { const int t = 32 * tb + crow(r, hi), j = 32 * jb + (lane & 31); if (!(j < t)) acc[r] = 0.f; }
            if (prod == 0) {
#pragma unroll
                for (int r = 0; r < 16; ++r) A32[(32 * tb + crow(r, hi)) * 64 + 32 * jb + (lane & 31)] = acc[r]; }
            else store_tr(lds, H_AAK, tb, jb, acc, lane);
        } else {
#pragma unroll
            for (int r = 0; r < 16; ++r) { const int j = 32 * jb + crow(r, hi), t = 32 * tb + (lane & 31); if (!(j <= t)) acc[r] = 0.f; }
            store_tr(lds, prod == 2 ? H_ARB : H_ARK, jb, tb, acc, lane);
        }
    }
    __syncthreads();
    if (wave == 0) {
        LAS float* TL = (LAS float*)(lds + TL_OFF);
        for (int t = 0; t < 64; ++t) TL[t * 64 + lane] = 0.f;
        for (int t = 0; t < 64; ++t) {
            float s0 = (t == lane) ? 1.f : 0.f, s1 = 0.f;
            for (int j4 = 0; j4 < t; j4 += 4) { const f32x4a a4 = *(const LAS f32x4a*)(A32 + t * 64 + j4);
                s0 += a4[0] * TL[j4 * 64 + lane]; s1 += a4[1] * TL[(j4 + 1) * 64 + lane]; s0 += a4[2] * TL[(j4 + 2) * 64 + lane]; s1 += a4[3] * TL[(j4 + 3) * 64 + lane]; }
            TL[t * 64 + lane] = s0 + s1;
        }
#pragma unroll
        for (int g = 0; g < 8; ++g) { float v[8];
#pragma unroll
            for (int e = 0; e < 8; ++e) v[e] = TL[(8 * g + e) * 64 + lane];
            u32x4v w; w.x = cvt2(v[0], v[1]); w.y = cvt2(v[2], v[3]); w.z = cvt2(v[4], v[5]); w.w = cvt2(v[6], v[7]);
            *(LAS u32x4v*)(lds + (H_TT >> 1) * IMG + off_b(lane, 8 * (H_TT & 1) + g)) = w; }
    } else
    if (wave >= 1 && wave <= 4) {
        const int tb = (wave - 1) >> 1, ib = (wave - 1) & 1;
        f32x16 acc = mm_tile<true, false>(lds, H_AAK, tb, H_VT, ib, f32x16{}, lane);
        store_tr(lds, H_XT, tb, ib, acc, lane);
    }
    __syncthreads();
    { const int tb = (wave >> 1) & 1, cb = wave & 1;
      if (wave < 4) { f32x16 acc = mm_tile<true, false>(lds, H_TT, tb, H_AT, cb, f32x16{}, lane); store_tr(lds, H_PT, tb, cb, acc, lane); }
      else { f32x16 acc = mm_tile<true, false>(lds, H_TT, tb, H_XT, cb, f32x16{}, lane); store_tr(lds, H_QT, tb, cb, acc, lane); } }
    __syncthreads();
#pragma unroll
    for (int k2 = 0; k2 < 2; ++k2) {
        const int id = 2 * wave + k2, prod = id >> 2, rb = (id >> 1) & 1, cb = id & 1;
        f32x16 acc = f32x16{};
        if (prod == 0) {
            acc = mm_tile<false, false>(lds, H_PT, rb, H_BT, cb, acc, lane);
            const float wc = WC[32 * cb + (lane & 31)];
#pragma unroll
            for (int r = 0; r < 16; ++r) { const int n = 32 * rb + crow(r, hi), m = 32 * cb + (lane & 31); acc[r] = (acc[r] + (n == m ? 1.f : 0.f)) * wc; }
            u32x4v* o = B.MF + ((size_t)ci * 8 + (cb * 2 + rb) * 2) * 64 + lane;
            o[0] = pack8(acc, 0); o[64] = pack8(acc, 1);
        } else if (prod == 1) {
            acc = mm_tile<false, false>(lds, H_BT, rb, H_QT, cb, acc, lane);
            acc = mm_tile<false, false>(lds, H_KT, rb, H_VT, cb, acc, lane);
#pragma unroll
            for (int g = 0; g < 4; ++g) { const f32x4a w4 = *(const LAS f32x4a*)(WC + 32 * rb + 8 * g + 4 * hi);
                f32x4a v = {acc[4 * g] * w4[0], acc[4 * g + 1] * w4[1], acc[4 * g + 2] * w4[2], acc[4 * g + 3] * w4[3]};
                *(f32x4a*)(B.NT + (((size_t)ci * 4 + rb * 2 + cb) * 64 + lane) * 16 + 4 * g) = v; }
        } else if (prod == 2) {
            acc = mm_tile<false, false>(lds, H_PT, rb, H_ARB, cb, acc, lane);
#pragma unroll
            for (int s = 0; s < 4; ++s) { bf16x8 idf;
#pragma unroll
                for (int e = 0; e < 8; ++e) idf[e] = (16 * s + 8 * hi + e == 32 * cb + (lane & 31)) ? (short)0x3f80 : (short)0;
                acc = __builtin_amdgcn_mfma_f32_32x32x16_bf16(frag_row(lds, H_RT, rb, s, lane), idf, acc, 0, 0, 0); }
            u32x4v* o = B.PF + ((size_t)ci * 8 + (cb * 2 + rb) * 2) * 64 + lane;
            o[0] = pack8(acc, 0); o[64] = pack8(acc, 1);
        } else {
            acc = mm_tile<false, false>(lds, H_ARB, rb, H_QT, cb, acc, lane);
            acc = mm_tile<false, false>(lds, H_ARK, rb, H_VT, cb, acc, lane);
#pragma unroll
            for (int g = 0; g < 4; ++g) *(f32x4a*)(B.QP + (((size_t)ci * 4 + rb * 2 + cb) * 64 + lane) * 16 + 4 * g) = (f32x4a){acc[4 * g], acc[4 * g + 1], acc[4 * g + 2], acc[4 * g + 3]};
        }
    }
    __syncthreads();
}
__device__ __forceinline__ void r1_phase(const Ctx& C, const Bufs& B) {
    for (int u = blockIdx.x; u < NB * RH * NCH; u += C.G) { const int c = u & (NCH - 1), h = (u >> 5) & 7, b = u >> 8; r1_unit(C, B, b, h, c); }
}
__device__ __forceinline__ void r2_chain(const Ctx& C, const Bufs& B, int k) {
    const int lane = C.lane, hi = lane >> 5, ib = k & 1, bh = k >> 1;
    f32x16 z[2]; z[0] = f32x16{}; z[1] = f32x16{};
    typedef float f32x4a __attribute__((ext_vector_type(4)));
    for (int c = 0; c < NCH; ++c) {
        const size_t ci = (size_t)bh * NCH + c;
        u32x4v bf[2][2];
#pragma unroll
        for (int nb = 0; nb < 2; ++nb)
#pragma unroll
            for (int s = 0; s < 2; ++s) { bf[nb][s] = pack8(z[nb], s); B.ZF[((ci * 2 + ib) * 4 + nb * 2 + s) * 64 + lane] = bf[nb][s]; }
        f32x16 zn[2];
#pragma unroll
        for (int mb = 0; mb < 2; ++mb) {
            const float* np = B.NT + ((ci * 4 + mb * 2 + ib) * 64 + lane) * 16;
#pragma unroll
            for (int g = 0; g < 4; ++g) { const f32x4a v = *(const f32x4a*)(np + 4 * g); zn[mb][4 * g] = v[0]; zn[mb][4 * g + 1] = v[1]; zn[mb][4 * g + 2] = v[2]; zn[mb][4 * g + 3] = v[3]; }
#pragma unroll
            for (int nb = 0; nb < 2; ++nb)
#pragma unroll
                for (int s = 0; s < 2; ++s) { const u32x4v af = B.MF[(ci * 8 + (mb * 2 + nb) * 2 + s) * 64 + lane];
                    zn[mb] = __builtin_amdgcn_mfma_f32_32x32x16_bf16(__builtin_bit_cast(bf16x8, af), __builtin_bit_cast(bf16x8, bf[nb][s]), zn[mb], 0, 0, 0); }
        }
        z[0] = zn[0]; z[1] = zn[1];
    }
    float* so = C.out + OUT_WKVP + ((size_t)bh * RN + 32 * ib + (lane & 31)) * RN;
#pragma unroll
    for (int nb = 0; nb < 2; ++nb)
#pragma unroll
        for (int g = 0; g < 4; ++g) *(f32x4a*)(so + 32 * nb + 8 * g + 4 * hi) = (f32x4a){z[nb][4 * g], z[nb][4 * g + 1], z[nb][4 * g + 2], z[nb][4 * g + 3]};
}
__device__ __forceinline__ void r3_phase(const Ctx& C, const Bufs& B) {
    const int lane = C.lane, hi = lane >> 5;
    typedef float f32x4a __attribute__((ext_vector_type(4)));
    for (int wu = C.gw; wu < NB * RH * NCH * 2; wu += C.ngw) {
        const int tb = wu & 1; const size_t ci = (size_t)(wu >> 1); const int c = (int)(ci & (NCH - 1)), bh = (int)(ci >> 5), h = bh & 7, b = bh >> 3;
        u32x4v pf[2][2];
#pragma unroll
        for (int nb = 0; nb < 2; ++nb)
#pragma unroll
            for (int s = 0; s < 2; ++s) pf[nb][s] = B.PF[(ci * 8 + (tb * 2 + nb) * 2 + s) * 64 + lane];
#pragma unroll
        for (int ib = 0; ib < 2; ++ib) {
            f32x16 y; const float* qp = B.QP + ((ci * 4 + tb * 2 + ib) * 64 + lane) * 16;
#pragma unroll
            for (int g = 0; g < 4; ++g) { const f32x4a v = *(const f32x4a*)(qp + 4 * g); y[4 * g] = v[0]; y[4 * g + 1] = v[1]; y[4 * g + 2] = v[2]; y[4 * g + 3] = v[3]; }
#pragma unroll
            for (int nb = 0; nb < 2; ++nb)
#pragma unroll
                for (int s = 0; s < 2; ++s) { const u32x4v zf = B.ZF[((ci * 2 + ib) * 4 + nb * 2 + s) * 64 + lane];
                    y = __builtin_amdgcn_mfma_f32_32x32x16_bf16(__builtin_bit_cast(bf16x8, pf[nb][s]), __builtin_bit_cast(bf16x8, zf), y, 0, 0, 0); }
            float* yo = B.Y + ((size_t)b * T + 64 * c + 32 * tb) * RW_W + h * 64 + 32 * ib + (lane & 31);
#pragma unroll
            for (int r = 0; r < 16; ++r) yo[(size_t)crow(r, hi) * RW_W] = y[r];
        }
    }
}
}
constexpr int N_PHASES = 14;
__global__ void __launch_bounds__(NTHREADS, 2) fwd(Args args) {
    extern __shared__ __attribute__((aligned(16))) unsigned char lds[];
    Ctx C;
    C.lds = (LAS unsigned char*)lds;
    C.tid = threadIdx.x; C.lane = C.tid & 63; C.wave = __builtin_amdgcn_readfirstlane(C.tid >> 6);
    C.G = gridDim.x; C.gw = blockIdx.x * NWAVES + C.wave; C.ngw = C.G * NWAVES;
    C.in = args.in; C.out = args.out; C.ws = args.ws;
    const int lo = args.ph_lo, hi = args.ph_hi;
    volatile LAS unsigned* MISC = (volatile LAS unsigned*)(C.lds + MISC_OFF);
    if (C.tid < 32) MISC[C.tid] = 0u;
    __syncthreads();
    XcdBarrier bar = xcd_barrier_post((unsigned*)(C.ws + WS_CTL) + CW_BAR, MISC + 8);
#define IN(k) (lo <= (k) && (k) < hi)
#define SEAM(k) do { if (IN(k) && IN((k) + 1)) xcd_barrier(bar); } while (0)
    if (IN(0)) { p0_mod(C); p0_weights(C); }
    SEAM(0);
    if (IN(1)) { p1_norm1(C); }
    SEAM(1);
    if (IN(2)) {
        pg8::Gemm g{(const pg8::bf16_t*)(C.ws + WS_A1), (const pg8::bf16_t*)(C.ws + WS_WIN), MPAD, NIN, D}; pg8::StaticOrder S; S.init(MPAD, NIN, C.G, (int)blockIdx.x);
        EpiRawF32 E{(float*)(C.ws + WS_PROJ), NIN};
        pg8::gemm_phase<EpiRawF32, pg8::StaticOrder, true, true>(C.lds, g, S, E);
    }
    SEAM(2);
    rw::Bufs RB;
    RB.LIN = (bf16*)(C.ws + WS_LIN); RB.W2T = (bf16*)(C.ws + WS_W2T); RB.A2T = (bf16*)(C.ws + WS_A2T); RB.G2T = (bf16*)(C.ws + WS_G2T);
    RB.RX = (float*)(C.ws + WS_RWA); RB.KX = (float*)(C.ws + WS_KX); RB.VX = (float*)(C.ws + WS_RWA + 3 * RWA_STRIDE); RB.KKN = (float*)(C.ws + WS_RWA + 4 * RWA_STRIDE);
    RB.KP = (float*)(C.ws + WS_RWA + 2 * RWA_STRIDE); RB.G = (float*)(C.ws + WS_RWA + 6 * RWA_STRIDE);
    RB.MF = (rw::u32x4v*)(C.ws + WS_MF); RB.NT = (float*)(C.ws + WS_NT); RB.PF = (rw::u32x4v*)(C.ws + WS_PF); RB.QP = (float*)(C.ws + WS_QP); RB.ZF = (rw::u32x4v*)(C.ws + WS_ZF); RB.Y = (float*)(C.ws + WS_Y);
#ifdef PROBE_RW
    if (IN(3)) { p3_post(C); p3_rwprep<true>(C); }
    SEAM(3);
    if (IN(4)) { idxsel::phase(C); rw::r1_phase(C, RB); p4_indexer<false, true>(C); p4_scan<false>(C, NB * RH); p4_scan<true>(C, 0); }
#else
    if (IN(3)) { p3_post(C); p3_rwprep<false>(C); }
    SEAM(3);
    if (IN(4)) { idxsel::phase(C); rw::r1_phase(C, RB); p4_indexer<false, true>(C); p4_scan<false>(C, NB * RH); }
#endif
    SEAM(4);
    if (IN(5)) {
        p5_select<false, true>(C);
        if (C.wave == 0 && blockIdx.x < NB * RH * 2) rw::r2_chain(C, RB, (int)blockIdx.x);
        __syncthreads();
        const attn_body::AttnTensors AT{(const attn_body::bf16*)(C.ws + WS_QB), (const attn_body::bf16*)(C.ws + WS_KB), (const attn_body::bf16*)(C.ws + WS_VB), (attn_body::bf16*)(C.ws + WS_MIX), (const unsigned long long*)(C.ws + WS_MASKT)};
        const attn_body::StaticOrder S((int)C.G, (int)blockIdx.x);
        attn_body::attn_phase<attn_body::StaticOrder>((char*)lds, AT, S);
    }
    SEAM(5);
    if (IN(6)) { p6_attn<0>(C, MP, MT); rw::r3_phase(C, RB); }
    SEAM(6);
#ifdef PROBE_RW
    if (IN(7)) { p5_rwfinal<PROBE_RW>(C); }
#else
    if (IN(7)) { p5_rwfinal<0>(C); }
#endif
    SEAM(7);
    if (IN(8)) {
        pg8::Gemm g{(const pg8::bf16_t*)(C.ws + WS_MIX), (const pg8::bf16_t*)(C.ws + WS_WOUT), MPAD, D, D}; pg8::StaticOrder S; S.init(MPAD, D, C.G, (int)blockIdx.x);
        EpiRawF32 E{(float*)(C.ws + WS_RAW), D};
        pg8::gemm_phase<EpiRawF32, pg8::StaticOrder, true, true>(C.lds, g, S, E);
    }
    SEAM(8);
    if (IN(9)) { p8_res_norm2(C); }
    SEAM(9);
    if (IN(10)) {
        pg8::Gemm g{(const pg8::bf16_t*)(C.ws + WS_A2), (const pg8::bf16_t*)(C.ws + WS_WGU), MPAD, NGU, D}; pg8::StaticOrder S; S.init(MPAD, NGU, C.G, (int)blockIdx.x);
        EpiRawF32 E{(float*)(C.ws + WS_RAW2), NGU};
        pg8::gemm_phase<EpiRawF32, pg8::StaticOrder, true, true>(C.lds, g, S, E);
    }
    SEAM(10);
    if (IN(11)) { p10_swiglu(C); }
    SEAM(11);
    if (IN(12)) {
        pg8::Gemm g{(const pg8::bf16_t*)(C.ws + WS_HB), (const pg8::bf16_t*)(C.ws + WS_WDN), MPAD, D, FFN}; pg8::StaticOrder S; S.init(MPAD, D, C.G, (int)blockIdx.x);
        EpiRawF32 E{(float*)(C.ws + WS_RAW), D};
        pg8::gemm_phase<EpiRawF32, pg8::StaticOrder, true, true>(C.lds, g, S, E);
    }
    SEAM(12);
    if (IN(13)) { p12_final(C); }
#undef IN
#undef SEAM
}

extern "C" void kernel_launch(void* const* d_in, const int* in_sizes, int n_in, void* d_out, int out_size, void* d_ws, size_t ws_size, hipStream_t stream) {
    static int grid = 0;
    if (grid == 0) {
        if (n_in != 32 || (size_t)out_size != OUT_END || ws_size < WS_END) { fprintf(stderr, "kernel_launch: unexpected sizes n_in %d out %d ws %zu\n", n_in, out_size, ws_size); grid = -1; return; }
        int dev = 0, cus = 0;
        if (hipGetDevice(&dev) != hipSuccess || hipDeviceGetAttribute(&cus, hipDeviceAttributeMultiprocessorCount, dev) != hipSuccess) { grid = -1; return; }
        if (hipFuncSetAttribute((const void*)fwd, hipFuncAttributeMaxDynamicSharedMemorySize, LDS_BYTES) != hipSuccess) { fprintf(stderr, "kernel_launch: hipFuncSetAttribute failed\n"); grid = -1; return; }
        (void)hipGetLastError();
        grid = cus;
    }
    if (grid < 0) return;
    (void)hipMemsetAsync((char*)d_ws + WS_CTL, 0, CTL_ZERO_BYTES, stream);
    Args a{};
    for (int i = 0; i < 32; ++i) a.in[i] = (const float*)d_in[i];
    a.out = (float*)d_out; a.ws = (unsigned char*)d_ws;
    a.ph_lo = 0; a.ph_hi = N_PHASES;
    hipLaunchKernelGGL(fwd, dim3(grid), dim3(NTHREADS), LDS_BYTES, stream, a);
}
```

```cpp
#include <hip/hip_runtime.h>
#include <cstdio>
#include <cstdint>
#include <cmath>
#include <hip/hip_bf16.h>
#define LAS __attribute__((address_space(3)))
namespace pg8 {
#define PG8_LAS __attribute__((address_space(3)))
typedef unsigned short bf16_t;
typedef short bf16x8 __attribute__((ext_vector_type(8)));
typedef float f32x4 __attribute__((ext_vector_type(4)));
typedef unsigned u32x4 __attribute__((ext_vector_type(4)));
constexpr int BM = 256, BK = 64, HALF = 128, HTB = HALF * BK * 2  , STAGE_BYTES = 8 * HTB, NXCD = 8, WGM = 8;

__host__ __device__ __forceinline__ int lds_byte(int r, int c) { const int st = (r >> 4) * 2 + (c >> 5), rr = r & 15, cc = c & 31, ob = rr * 64 + cc * 2; return st * 1024 + (ob ^ (((ob >> 9) & 1) << 5)); }
__host__ __device__ __forceinline__ void stage_rc(int b, int& R, int& C) { const int st = b / 1024, sb = b % 1024, swz = sb ^ (((sb >> 9) & 1) << 5); R = (st >> 1) * 16 + swz / 64; C = (st & 1) * 32 + (swz % 64) / 2; }
__host__ __device__ __forceinline__ int perm32(int rho) { const int n = rho >> 4, i = rho & 15; return 8 * (i >> 2) + 4 * n + (i & 3); }

struct Unit { int pm, pn; };
struct Gemm { const bf16_t* A; const bf16_t* Bt; int M, N, K; };

struct StaticOrder {
    int nM, nN, nwg, G, c;
    __host__ __device__ void init(int M, int N, int G_, int c_) { nM = M / BM; nN = N / BM; nwg = nM * nN; G = G_; c = c_; }
    __host__ __device__ bool next(int i, Unit& u) const {
        const long L = (long)i * G + c; if (L >= nwg) return false;
        int wgid = (int)L; { const int q = nwg / NXCD, r = nwg % NXCD, xcd = wgid % NXCD, off = wgid / NXCD; wgid = (xcd < r ? xcd * (q + 1) : r * (q + 1) + (xcd - r) * q) + off; }
        const int nig = WGM * nN, gid = wgid / nig, fm = gid * WGM, gsz = (nM - fm) < WGM ? (nM - fm) : WGM;
        u.pm = fm + ((wgid % nig) % gsz); u.pn = (wgid % nig) / gsz; return true;
    }
    __device__ __forceinline__ void a_ready(const Unit&) const {}
    __device__ __forceinline__ void done(const Unit&) const {}
};

__device__ __forceinline__ unsigned cvt_pk_bf16(float lo, float hi) { unsigned r; asm volatile("v_cvt_pk_bf16_f32 %0, %1, %2" : "=v"(r) : "v"(lo), "v"(hi)); return r; }
typedef float f32x2 __attribute__((ext_vector_type(2)));
__device__ __forceinline__ f32x2 gelu_pk(f32x2 v) {
    const f32x2 av = __builtin_elementwise_abs(v), d = av * 0.2316418882f + 1.0f;
    f32x2 t; t.x = __builtin_amdgcn_rcpf(d.x); t.y = __builtin_amdgcn_rcpf(d.y);
    f32x2 q = t * 0.5307027145f + (-0.7265760135f); q = q * t + 0.7107068705f; q = q * t + (-0.142248368f); q = q * t + 0.127414796f; q = q * t;
    const f32x2 s = (v * v) * (-0.72134752044f);
    f32x2 e; e.x = __builtin_amdgcn_exp2f(s.x); e.y = __builtin_amdgcn_exp2f(s.y);
    const f32x2 m = v * (q * e), r = v - m;
    f32x2 o; o.x = v.x < 0.f ? m.x : r.x; o.y = v.y < 0.f ? m.y : r.y; return o;
}

template <int ACT  > struct EpiBf16 {
    static constexpr bool PERM = true, AFTER_DRAIN = false; static_assert(ACT == 0 || ACT == 1, "EpiBf16: ACT is 0 (none) or 1 (gelu_pk)");
    bf16_t* O; int ldc; const float* bias; int split_cols; size_t split_stride; float scale0;
    __device__ __forceinline__ void operator()(const f32x4 (&acc)[2][2][4][2], const Unit& u, int wr, int wc, int fr, int fq) const {
        const int row0 = u.pm * BM + wr * 64 + fr; int colt = u.pn * BM; bf16_t* base = O;
        float sc = 1.f; if (split_cols) { const int t = colt / split_cols; base += (size_t)t * split_stride; colt -= t * split_cols; if (t == 0) sc = scale0; }
        const int col0 = colt + wc * 32 + 8 * fq, bcol0 = u.pn * BM + wc * 32 + 8 * fq;
        f32x4 bv[2][2];
#pragma unroll
        for (int bj = 0; bj < 2; ++bj)
#pragma unroll
            for (int n = 0; n < 2; ++n) bv[bj][n] = bias ? *(const f32x4*)(bias + bcol0 + bj * HALF + 4 * n) : (f32x4){0.f, 0.f, 0.f, 0.f};
#pragma unroll
        for (int ai = 0; ai < 2; ++ai)
#pragma unroll
            for (int m = 0; m < 4; ++m) { bf16_t* rowp = base + (size_t)(row0 + ai * HALF + m * 16) * ldc + col0;
#pragma unroll
                for (int bj = 0; bj < 2; ++bj) { f32x4 v0 = acc[ai][bj][m][0] + bv[bj][0], v1 = acc[ai][bj][m][1] + bv[bj][1];
                    if (ACT == 1) { f32x2 a = gelu_pk((f32x2){v0[0], v0[1]}), b = gelu_pk((f32x2){v0[2], v0[3]}), c = gelu_pk((f32x2){v1[0], v1[1]}), d = gelu_pk((f32x2){v1[2], v1[3]});
                        v0 = (f32x4){a.x, a.y, b.x, b.y}; v1 = (f32x4){c.x, c.y, d.x, d.y}; }
                    v0 = v0 * sc; v1 = v1 * sc; u32x4 w; w.x = cvt_pk_bf16(v0[0], v0[1]); w.y = cvt_pk_bf16(v0[2], v0[3]); w.z = cvt_pk_bf16(v1[0], v1[1]); w.w = cvt_pk_bf16(v1[2], v1[3]);
                    *(u32x4*)(rowp + bj * HALF) = w; } }
    }
};


template <class Epi, class Sched, bool ALIGN_EPI = false, bool SP2 = false>
__device__ __forceinline__ void gemm_phase(PG8_LAS unsigned char* lds, const Gemm g, const Sched& S, const Epi& E) {
    const int tid = threadIdx.x, wid = __builtin_amdgcn_readfirstlane(tid >> 6), lane = tid & 63, wr = wid >> 2, wc = wid & 3, fr = lane & 15, fq = lane >> 4;
    const int K = g.K, nt = K / BK;
    unsigned voffA[2], voffB[2];
#pragma unroll
    for (int i = 0; i < 2; ++i) { int R, C; stage_rc(tid * 16 + i * 8192, R, C); const int Rb = Epi::PERM ? ((R & ~31) + perm32(R & 31)) : R;
        voffA[i] = (unsigned)(R * K + C) * 2u; voffB[i] = (unsigned)(Rb * K + C) * 2u; }
    const size_t kstep = (size_t)(BK * 2);
    const size_t hstep = (size_t)HALF * K * 2;
    const size_t tstep = 2 * hstep;
    const unsigned ldsw = (unsigned)wid * 1024u;
    const int aoff = lds_byte(wr * 64 + fr, fq * 8), boff = lds_byte(wc * 32 + fr, fq * 8);
#define PG8_SA(b, h) (((b) * 2 + (h)) * HTB)
#define PG8_SB(b, h) ((4 + (b) * 2 + (h)) * HTB)
#define PG8_STAGE(bufoff, gbase, voff) do { _Pragma("unroll") for (int _i = 0; _i < 2; ++_i) \
        __builtin_amdgcn_global_load_lds((const unsigned*)((const char*)(gbase) + (voff)[_i]), (PG8_LAS unsigned*)(lds + (bufoff) + ldsw + _i * 8192), 16, 0, 0); } while (0)
#define PG8_LDA(dst, b, h) do { _Pragma("unroll") for (int m = 0; m < 4; ++m) _Pragma("unroll") for (int k = 0; k < 2; ++k) dst[m][k] = *(const PG8_LAS bf16x8*)(lds + PG8_SA(b, h) + aoff + m * 2048 + k * 1024); } while (0)
#define PG8_LDB(dst, b, h) do { _Pragma("unroll") for (int n = 0; n < 2; ++n) _Pragma("unroll") for (int k = 0; k < 2; ++k) dst[n][k] = *(const PG8_LAS bf16x8*)(lds + PG8_SB(b, h) + boff + n * 2048 + k * 1024); } while (0)
#define PG8_MMA(ai, bj, At, Bt) do { __builtin_amdgcn_s_setprio(1); _Pragma("unroll") for (int m = 0; m < 4; ++m) _Pragma("unroll") for (int n = 0; n < 2; ++n) _Pragma("unroll") for (int k = 0; k < 2; ++k) \
        acc[ai][bj][m][n] = __builtin_amdgcn_mfma_f32_16x16x32_bf16(Bt[n][k], At[m][k], acc[ai][bj][m][n], 0, 0, 0); __builtin_amdgcn_s_setprio(0); } while (0)
#define PG8_WAIT_V(n) asm volatile("s_waitcnt vmcnt(" #n ")" ::: "memory")
#define PG8_WAIT_L(n) asm volatile("s_waitcnt lgkmcnt(" #n ")" ::: "memory")
#define PG8_BAR __builtin_amdgcn_s_barrier()
#define PG8_SCHED __builtin_amdgcn_sched_barrier(0)
    Unit cur, nxt; int ui = 0;
    if (!S.next(0, cur)) return;
    f32x4 acc[2][2][4][2];
#pragma unroll
    for (int a = 0; a < 2; ++a)
#pragma unroll
        for (int b = 0; b < 2; ++b)
#pragma unroll
            for (int m = 0; m < 4; ++m)
#pragma unroll
                for (int n = 0; n < 2; ++n) acc[a][b][m][n] = (f32x4){0.f, 0.f, 0.f, 0.f};
    bf16x8 At[4][2], B0[2][2], B1[2][2];
    const char* cA = (const char*)g.A + (size_t)cur.pm * tstep; const char* cB = (const char*)g.Bt + (size_t)cur.pn * tstep;
    S.a_ready(cur);
    if constexpr (SP2) {
        PG8_STAGE(PG8_SB(0, 0), cB, voffB); PG8_STAGE(PG8_SB(0, 1), cB + hstep, voffB); PG8_STAGE(PG8_SA(0, 0), cA, voffA); PG8_STAGE(PG8_SA(0, 1), cA + hstep, voffA);
        if (wr == 1) PG8_BAR;
        PG8_WAIT_V(2); PG8_BAR;
        PG8_STAGE(PG8_SB(1, 0), cB + kstep, voffB); PG8_STAGE(PG8_SA(1, 0), cA + kstep, voffA); PG8_STAGE(PG8_SB(1, 1), cB + hstep + kstep, voffB);
        PG8_WAIT_V(6); PG8_BAR;
    } else {
        PG8_STAGE(PG8_SB(0, 0), cB, voffB); PG8_STAGE(PG8_SA(0, 0), cA, voffA); PG8_STAGE(PG8_SB(0, 1), cB + hstep, voffB); PG8_STAGE(PG8_SA(0, 1), cA + hstep, voffA);
        if (wr == 1) PG8_BAR;
        PG8_WAIT_V(4); PG8_BAR;
        PG8_STAGE(PG8_SB(1, 0), cB + kstep, voffB); PG8_STAGE(PG8_SA(1, 0), cA + kstep, voffA); PG8_STAGE(PG8_SB(1, 1), cB + hstep + kstep, voffB);
        PG8_WAIT_V(6); PG8_BAR;
    }
    for (;;) {
        const bool has_next = S.next(ui + 1, nxt);
        const char* nA = has_next ? (const char*)g.A + (size_t)nxt.pm * tstep : cA; const char* nB = has_next ? (const char*)g.Bt + (size_t)nxt.pn * tstep : cB;
        for (int t = 0; t < nt; t += 2) {
            const bool last = (t == nt - 2);
            const char* a1 = cA + (size_t)(t + 1) * kstep;
            const char* a2 = last ? nA : cA + (size_t)(t + 2) * kstep; const char* b2 = last ? nB : cB + (size_t)(t + 2) * kstep;
            const char* a3 = a2 + kstep; const char* b3 = b2 + kstep;
            if (last && has_next) S.a_ready(nxt);
            if constexpr (SP2) {
            PG8_LDB(B0, 0, 0); PG8_LDB(B1, 0, 1); PG8_SCHED; PG8_LDA(At, 0, 0); PG8_STAGE(PG8_SA(1, 1), a1 + hstep, voffA);
            PG8_WAIT_V(8); PG8_WAIT_L(0); PG8_BAR; PG8_MMA(0, 0, At, B0); PG8_MMA(0, 1, At, B1); PG8_BAR; PG8_SCHED;
            PG8_LDA(At, 0, 1); PG8_STAGE(PG8_SB(0, 0), b2, voffB); PG8_STAGE(PG8_SB(0, 1), b2 + hstep, voffB); PG8_STAGE(PG8_SA(0, 0), a2, voffA);
            PG8_WAIT_V(8); PG8_WAIT_L(0); PG8_BAR; PG8_MMA(1, 0, At, B0); PG8_MMA(1, 1, At, B1); PG8_BAR; PG8_SCHED;
            PG8_LDB(B0, 1, 0); PG8_LDB(B1, 1, 1); PG8_SCHED; PG8_LDA(At, 1, 0); PG8_STAGE(PG8_SA(0, 1), a2 + hstep, voffA);
            PG8_WAIT_V(8); PG8_WAIT_L(0); PG8_BAR; PG8_MMA(0, 0, At, B0); PG8_MMA(0, 1, At, B1); PG8_BAR; PG8_SCHED;
            PG8_LDA(At, 1, 1); PG8_STAGE(PG8_SB(1, 0), b3, voffB); PG8_STAGE(PG8_SB(1, 1), b3 + hstep, voffB); PG8_STAGE(PG8_SA(1, 0), a3, voffA);
            PG8_WAIT_V(8); PG8_WAIT_L(0); PG8_BAR; PG8_MMA(1, 0, At, B0); PG8_MMA(1, 1, At, B1); PG8_BAR; PG8_SCHED;
            } else {
            PG8_LDB(B0, 0, 0); PG8_SCHED; PG8_LDA(At, 0, 0); PG8_STAGE(PG8_SA(1, 1), a1 + hstep, voffA);
            PG8_WAIT_L(8); PG8_BAR; PG8_WAIT_L(0); PG8_MMA(0, 0, At, B0); PG8_BAR; PG8_SCHED;
            PG8_LDB(B1, 0, 1); PG8_STAGE(PG8_SB(0, 0), b2, voffB);
            PG8_BAR; PG8_WAIT_L(0); PG8_MMA(0, 1, At, B1); PG8_BAR;
            PG8_LDA(At, 0, 1); PG8_STAGE(PG8_SA(0, 0), a2, voffA);
            PG8_BAR; PG8_WAIT_L(0); PG8_MMA(1, 0, At, B0); PG8_BAR; PG8_SCHED;
            PG8_STAGE(PG8_SB(0, 1), b2 + hstep, voffB);
            PG8_WAIT_V(6); PG8_BAR; PG8_MMA(1, 1, At, B1); PG8_BAR;
            PG8_LDB(B0, 1, 0); PG8_SCHED; PG8_LDA(At, 1, 0); PG8_STAGE(PG8_SA(0, 1), a2 + hstep, voffA);
            PG8_WAIT_L(8); PG8_BAR; PG8_WAIT_L(0); PG8_MMA(0, 0, At, B0); PG8_BAR; PG8_SCHED;
            PG8_LDB(B1, 1, 1); PG8_STAGE(PG8_SB(1, 0), b3, voffB);
            PG8_BAR; PG8_WAIT_L(0); PG8_MMA(0, 1, At, B1); PG8_BAR;
            PG8_LDA(At, 1, 1); PG8_STAGE(PG8_SA(1, 0), a3, voffA);
            PG8_BAR; PG8_WAIT_L(0); PG8_MMA(1, 0, At, B0); PG8_BAR; PG8_SCHED;
            PG8_STAGE(PG8_SB(1, 1), b3 + hstep, voffB);
            PG8_WAIT_V(6); PG8_BAR; PG8_MMA(1, 1, At, B1); PG8_BAR;
            }
        }
        if constexpr (ALIGN_EPI) { if (wr == 0) PG8_BAR; }
        if constexpr (!Epi::AFTER_DRAIN) { E(acc, cur, wr, wc, fr, fq); S.done(cur); }
        if (!has_next) break;
#pragma unroll
        for (int a = 0; a < 2; ++a)
#pragma unroll
            for (int b = 0; b < 2; ++b)
#pragma unroll
                for (int m = 0; m < 4; ++m)
#pragma unroll
                    for (int n = 0; n < 2; ++n) acc[a][b][m][n] = (f32x4){0.f, 0.f, 0.f, 0.f};
        cur = nxt; cA = nA; cB = nB; ++ui;
        if constexpr (ALIGN_EPI) { if (wr == 1) PG8_BAR; }
    }
    PG8_WAIT_V(0);
    if constexpr (!ALIGN_EPI) { if (wr == 0) PG8_BAR; }
    PG8_BAR;
    if constexpr (Epi::AFTER_DRAIN) { E.fused(acc, cur, wr, wc, fr, fq, lds, wid, lane); S.done(cur); }
#undef PG8_SA
#undef PG8_SB
#undef PG8_STAGE
#undef PG8_LDA
#undef PG8_LDB
#undef PG8_MMA
#undef PG8_WAIT_V
#undef PG8_WAIT_L
#undef PG8_BAR
#undef PG8_SCHED
}
}
namespace attn_body {
using bf16=__hip_bfloat16;
using bf16x8=__attribute__((ext_vector_type(8)))short;
using s16x4=__attribute__((ext_vector_type(4)))short;
using f32x16=__attribute__((ext_vector_type(16)))float;
using u32x4=__attribute__((ext_vector_type(4)))unsigned;
constexpr int BATCH=8,NHEAD=8,SEQ=2048,D=64,DM=NHEAD*D,DMO=1024;
constexpr int NW=8,QBLK=32,QB=QBLK*NW,KVBLK=64,NQB=SEQ/QB;
constexpr int ATTN_PITCH=DM, ATTN_UNIT_ROWS=QB;
__device__ __forceinline__ int crow(int r,int hi){return (r&3)+8*(r>>2)+4*hi;}
#define SBAR() __builtin_amdgcn_sched_barrier(0)
typedef unsigned u32x16 __attribute__((ext_vector_type(16)));
constexpr int NSLOT=3, SLOTB=8192;
constexpr int LDS_K=0, LDS_V=NSLOT*SLOTB, LDS_WS=2*NSLOT*SLOTB, LDS_OST=LDS_WS+NW*64*4, LDS_BYTES=LDS_OST+NW*4096;
constexpr float C2=0.125f*1.4426950408889634f;
__device__ __forceinline__ void glds16(const void*gsrc,unsigned lds_dst){unsigned keep;
  asm volatile("s_mov_b32 %0, m0\n\ts_mov_b32 m0, %2\n\ts_nop 0\n\tglobal_load_lds_dwordx4 %1, off\n\ts_mov_b32 m0, %0":"=&s"(keep):"v"(gsrc),"s"(lds_dst):"memory");}
__device__ __forceinline__ float max3f(float a,float b,float c){float r;asm("v_max3_f32 %0, %1, %2, %3":"=v"(r):"v"(a),"v"(b),"v"(c));return r;}
__device__ __forceinline__ float max2f(float a,float b){float r;asm("v_max_f32_e32 %0, %1, %2":"=v"(r):"v"(a),"v"(b));return r;}
__device__ __forceinline__ float fadd_s(float a,float b){float r;asm("v_add_f32_e32 %0, %1, %2":"=v"(r):"v"(a),"v"(b));return r;}
__device__ __forceinline__ float fsub_s(float a,float b){float r;asm("v_sub_f32_e32 %0, %1, %2":"=v"(r):"v"(a),"v"(b));return r;}
typedef float f32x2_t __attribute__((ext_vector_type(2))); typedef __bf16 bf16x2_t __attribute__((ext_vector_type(2)));
__device__ __forceinline__ unsigned cvtpk_s(float lo,float hi){f32x2_t v={lo,hi};bf16x2_t b=__builtin_convertvector(v,bf16x2_t);return __builtin_bit_cast(unsigned,b);}
#define WAIT_BAR(N) asm volatile("s_waitcnt vmcnt(" #N ") lgkmcnt(0)\n\ts_barrier":::"memory")

__device__ __forceinline__ void qkt(f32x16&p0,f32x16&p1,const char*Kslot,const bf16x8*qr,int r32,int hi){ const f32x16 negm=f32x16{};
  const char*kb=Kslot+hi*1024+r32*16;
  #pragma unroll
  for(int d0=0;d0<4;++d0){
    const bf16x8 b0=*reinterpret_cast<const bf16x8*>(kb+d0*2048);
    const bf16x8 b1=*reinterpret_cast<const bf16x8*>(kb+d0*2048+512);
    if(d0==0){p0=__builtin_amdgcn_mfma_f32_32x32x16_bf16(b0,qr[0],negm,0,0,0);p1=__builtin_amdgcn_mfma_f32_32x32x16_bf16(b1,qr[0],negm,0,0,0);}
    else{p0=__builtin_amdgcn_mfma_f32_32x32x16_bf16(b0,qr[d0],p0,0,0,0);p1=__builtin_amdgcn_mfma_f32_32x32x16_bf16(b1,qr[d0],p1,0,0,0);}}
}
typedef __attribute__((address_space(3))) const char* lds_cptr;
typedef short v4i16_t __attribute__((ext_vector_type(4)));
__device__ __forceinline__ void kload8(bf16x8*kf,lds_cptr kp){
  kf[0]=*(const __attribute__((address_space(3))) bf16x8*)(kp);      kf[1]=*(const __attribute__((address_space(3))) bf16x8*)(kp+512);
  kf[2]=*(const __attribute__((address_space(3))) bf16x8*)(kp+2048); kf[3]=*(const __attribute__((address_space(3))) bf16x8*)(kp+2560);
  kf[4]=*(const __attribute__((address_space(3))) bf16x8*)(kp+4096); kf[5]=*(const __attribute__((address_space(3))) bf16x8*)(kp+4608);
  kf[6]=*(const __attribute__((address_space(3))) bf16x8*)(kp+6144); kf[7]=*(const __attribute__((address_space(3))) bf16x8*)(kp+6656);
}
__device__ __forceinline__ void kload2(bf16x8*kf,lds_cptr kp,int j){ kf[2*j]=*(const __attribute__((address_space(3))) bf16x8*)(kp+j*2048); kf[2*j+1]=*(const __attribute__((address_space(3))) bf16x8*)(kp+j*2048+512); }
__device__ __forceinline__ s16x4 vtr(lds_cptr p){ return __builtin_bit_cast(s16x4,__builtin_amdgcn_ds_read_tr16_b64_v4i16((__attribute__((address_space(3))) v4i16_t*)p)); }
__device__ __forceinline__ float rowmax(const f32x16&p0,const f32x16&p1){
  float a=max3f(p0[0],p0[1],p1[0]),b=max3f(p0[2],p0[3],p1[1]);a=max3f(a,p1[2],p1[3]);
  #pragma unroll
  for(int r=4;r<16;r+=4){a=max3f(a,p0[r],p0[r+1]);b=max3f(b,p0[r+2],p0[r+3]);a=max3f(a,p1[r],p1[r+1]);b=max3f(b,p1[r+2],p1[r+3]);}
  const float m=max2f(a,b);
  auto rr=__builtin_amdgcn_permlane32_swap(__float_as_uint(m),__float_as_uint(m),false,false);
  return max2f(__uint_as_float(rr[0]),__uint_as_float(rr[1]));
}
__device__ __forceinline__ void pv(f32x16*o,int vb,bf16x8 pa0,bf16x8 pa1,bf16x8 pa2,bf16x8 pa3){
  #pragma unroll
  for(int d0=0;d0<2;++d0){s16x4 lo[4],hi[4];
    #pragma unroll
    for(int ks=0;ks<4;++ks){
      asm volatile("ds_read_b64_tr_b16 %0,%1 offset:%c2":"=&v"(lo[ks]):"v"(vb),"i"(d0*4096+ks*1024):"memory");
      asm volatile("ds_read_b64_tr_b16 %0,%1 offset:%c2":"=&v"(hi[ks]):"v"(vb),"i"(d0*4096+ks*1024+512):"memory");}
    asm volatile("s_waitcnt lgkmcnt(0)":::"memory");SBAR();
    #define PK(k) (bf16x8){lo[k][0],lo[k][1],lo[k][2],lo[k][3],hi[k][0],hi[k][1],hi[k][2],hi[k][3]}
    o[d0]=__builtin_amdgcn_mfma_f32_32x32x16_bf16(pa0,PK(0),o[d0],0,0,0);
    o[d0]=__builtin_amdgcn_mfma_f32_32x32x16_bf16(pa1,PK(1),o[d0],0,0,0);
    o[d0]=__builtin_amdgcn_mfma_f32_32x32x16_bf16(pa2,PK(2),o[d0],0,0,0);
    o[d0]=__builtin_amdgcn_mfma_f32_32x32x16_bf16(pa3,PK(3),o[d0],0,0,0);
    #undef PK
  }
}

#ifndef ATTN_STORE16
#define ATTN_STORE16(p,v) (*(u32x4*)(p)=(v))
#endif
template<int THRL> __device__ __forceinline__ void attn_unit(int b,int h,int qb,const bf16*Q,const bf16*__restrict__ K,const bf16*__restrict__ V,bf16*O,const unsigned long long*MT,char*shm){
  const int tid=threadIdx.x,lane=tid&63,r32=lane&31,hi=lane>>5; const int wid=__builtin_amdgcn_readfirstlane(tid>>6);
  const long rowbase=(long)b*SEQ; const int q0=qb*QB;
  const bf16*Qw=Q+(rowbase+q0+wid*QBLK)*DM+h*D;
  const bf16*Kh=K+rowbase*DM+h*D,*Vh=V+rowbase*DM+h*D;
  const unsigned lds0=(unsigned)(uintptr_t)shm;
  float*wsf=(float*)(shm+LDS_WS)+wid*64;
  const bf16*ksrc=Kh+(long)lane*DM+wid*8;
  const bf16*vsrc=Vh+(long)(16*(wid&3)+(lane>>2))*DM+(wid>>2)*32+(lane&3)*8;
  const unsigned kdst=lds0+LDS_K+wid*1024, vdst=lds0+LDS_V+wid*1024;
  #define DMA_K(t,slot) glds16(ksrc+(long)(t)*KVBLK*DM,(unsigned)__builtin_amdgcn_readfirstlane(kdst+(slot)))
  #define DMA_V(t,slot) glds16(vsrc+(long)(t)*KVBLK*DM,(unsigned)__builtin_amdgcn_readfirstlane(vdst+(slot)))
  const int vb0=(int)(lds0+LDS_V)+((lane>>4)&1)*32+(lane&3)*8+(4*hi+((lane&15)>>2))*64;
  const char*Kbase=shm+LDS_K; bf16x8 kf[8];
  const lds_cptr shm3=(lds_cptr)shm; const lds_cptr kp0=shm3+LDS_K+hi*1024+r32*16; const lds_cptr vp0=shm3+LDS_V+((lane>>4)&1)*32+(lane&3)*8+(4*hi+((lane&15)>>2))*64;
  const int NT=(q0+QB)/KVBLK;
  const unsigned long long*mbase=MT+((size_t)((b*(SEQ/32)+qb*NW+wid)*(SEQ/KVBLK)))*32;
  u32x16 mk0,mk1,mk2,mk3; const float NEGV=-INFINITY;
  #define MLOAD(t) do{ const unsigned long long*mp_=mbase+(size_t)(t)*32; \
    asm volatile("s_load_dwordx16 %0, %4, 0x0\n\ts_load_dwordx16 %1, %4, 0x40\n\ts_load_dwordx16 %2, %4, 0x80\n\ts_load_dwordx16 %3, %4, 0xc0":"=&s"(mk0),"=&s"(mk1),"=&s"(mk2),"=&s"(mk3):"s"(mp_):"memory"); }while(0)
  #define MK64(v,i) (((unsigned long long)(v)[2*(i)+1]<<32)|(unsigned long long)(v)[2*(i)])
  #define MAPPLY(P0,P1) do{ asm volatile("s_waitcnt lgkmcnt(0)":"+s"(mk0),"+s"(mk1),"+s"(mk2),"+s"(mk3)::"memory"); \
    _Pragma("unroll") for(int r=0;r<8;++r){ P0[r]=__builtin_amdgcn_inverse_ballot_w64(MK64(mk0,r))?P0[r]:NEGV; P0[r+8]=__builtin_amdgcn_inverse_ballot_w64(MK64(mk1,r))?P0[r+8]:NEGV; \
      P1[r]=__builtin_amdgcn_inverse_ballot_w64(MK64(mk2,r))?P1[r]:NEGV; P1[r+8]=__builtin_amdgcn_inverse_ballot_w64(MK64(mk3,r))?P1[r+8]:NEGV; } }while(0)
  DMA_K(0,0);DMA_V(0,0);DMA_K(1,SLOTB);
  bf16x8 qr[4];
  #pragma unroll
  for(int d0=0;d0<4;++d0)qr[d0]=*reinterpret_cast<const bf16x8*>(&Qw[(long)r32*DM+d0*16+hi*8]);
  float mhat=0.f,l_reg=0.f;f32x16 o[2];o[0]=f32x16{};o[1]=f32x16{};const f32x16 zc=f32x16{};
  bool resc=false;
  #define START(P0,P1) do{ const float rm=rowmax(P0,P1); resc=false; \
    { const float dl=max2f(rm,-30.f); mhat=fadd_s(mhat,dl); \
      _Pragma("unroll") for(int r=0;r<16;++r){P0[r]=fsub_s(P0[r],dl);P1[r]=fsub_s(P1[r],dl);} \
      } \
    _Pragma("unroll") for(int r=0;r<16;++r)P0[r]=__builtin_amdgcn_exp2f(P0[r]); }while(0)
  #define RESC() do{ if(resc){ asm volatile("s_waitcnt lgkmcnt(0)":::"memory"); \
      _Pragma("unroll") for(int d_=0;d_<2;++d_) _Pragma("unroll") for(int r=0;r<16;++r)o[d_][r]*=wsf[crow(r,hi)]; } }while(0)
  f32x16 pA0,pA1,pB0,pB1;
  int sl_prev=0,sl_cur=0,sl_next=SLOTB;
  #define ROT() do{sl_prev=sl_cur;sl_cur=sl_next;sl_next=(sl_next==(NSLOT-1)*SLOTB)?0:sl_next+SLOTB;}while(0)
  DMA_K(2,2*SLOTB);
  WAIT_BAR(3);
  MLOAD(0); qkt(pA0,pA1,Kbase,qr,r32,hi);asm volatile("s_nop 15\n\ts_nop 7":"+v"(pA0),"+v"(pA1));MAPPLY(pA0,pA1);asm volatile("s_nop 1":"+v"(pA0),"+v"(pA1));
  START(pA0,pA1);
  _Pragma("unroll") for(int r=0;r<16;++r)pA1[r]=__builtin_amdgcn_exp2f(pA1[r]);
  WAIT_BAR(0);
  DMA_K(3,0);DMA_V(1,SLOTB);
  ROT();
  kload8(kf,kp0+sl_cur);
  WAIT_BAR(2);
  s16x4 vlo[8],vhi[8]; u32x4 pw0,pw1,pw2,pw3;
  #define PKW(P,B) cvtpk_s(P[B],P[B+1])
  #define PAF(k) __builtin_bit_cast(bf16x8,pw##k)
  #define VFR(i) (bf16x8){vlo[i][0],vlo[i][1],vlo[i][2],vlo[i][3],vhi[i][0],vhi[i][1],vhi[i][2],vhi[i][3]}
  #define PIN(x) asm volatile("":"+v"(x))
  #define MX3(a,b,c) __builtin_fmaxf(__builtin_fmaxf((a),(b)),(c))
  #define GAPA(MF,A0,A1,A2,A3,W0,W1,PW) do{ MF; sacc+=A0; sacc+=A1; sacc+=A2; sacc+=A3; PIN(sacc); W0; W1; PIN(PW); SBAR(); }while(0)
  #define EX(v) __builtin_amdgcn_exp2f(v)
  #define GAPB(MF,X,B) do{ MF; X[B]=EX(X[B]); X[B+1]=EX(X[B+1]); X[B+2]=EX(X[B+2]); X[B+3]=EX(X[B+3]); PIN(X); SBAR(); }while(0)
  #define VRD(i) do{ vlo[i]=vtr(vp_+(((i)>>2)*4096+((i)&3)*1024)); vhi[i]=vtr(vp_+(((i)>>2)*4096+((i)&3)*1024+512)); }while(0)
  #define KRD(G,j) do{ if(G){ kload2(kf,kp0+sl_next,j); SBAR(); } }while(0)
  #define STEP(C0,C1,P0,P1,t,GK,GV,GL) do{ SBAR(); MLOAD(t); \
    const lds_cptr vp_=vp0+sl_prev; \
    VRD(0); SBAR(); float sacc=(P0[0]+P0[1]); \
    GAPA(C0=__builtin_amdgcn_mfma_f32_32x32x16_bf16(kf[0],qr[0],zc,0,0,0), P0[2],P0[3],P0[4],P0[5],     pw0[0]=PKW(P0,0), pw0[1]=PKW(P0,2), pw0); \
    VRD(4); SBAR(); GAPA(C1=__builtin_amdgcn_mfma_f32_32x32x16_bf16(kf[1],qr[0],zc,0,0,0), P0[6],P0[7],P0[8],P0[9],     pw0[2]=PKW(P0,4), pw0[3]=PKW(P0,6), pw0); \
    VRD(1); SBAR(); GAPA(C0=__builtin_amdgcn_mfma_f32_32x32x16_bf16(kf[2],qr[1],C0,0,0,0),   P0[10],P0[11],P0[12],P0[13], pw1[0]=PKW(P0,8), pw1[1]=PKW(P0,10), pw1); \
    VRD(5); SBAR(); GAPA(C1=__builtin_amdgcn_mfma_f32_32x32x16_bf16(kf[3],qr[1],C1,0,0,0),   P0[14],P0[15],P1[0],P1[1],   pw1[2]=PKW(P0,12),pw1[3]=PKW(P0,14), pw1); \
    VRD(2); SBAR(); GAPA(C0=__builtin_amdgcn_mfma_f32_32x32x16_bf16(kf[4],qr[2],C0,0,0,0),   P1[2],P1[3],P1[4],P1[5],     pw2[0]=PKW(P1,0), pw2[1]=PKW(P1,2), pw2); \
    VRD(6); SBAR(); GAPA(C1=__builtin_amdgcn_mfma_f32_32x32x16_bf16(kf[5],qr[2],C1,0,0,0),   P1[6],P1[7],P1[8],P1[9],     pw2[2]=PKW(P1,4), pw2[3]=PKW(P1,6), pw2); \
    VRD(3); SBAR(); GAPA(C0=__builtin_amdgcn_mfma_f32_32x32x16_bf16(kf[6],qr[3],C0,0,0,0),   P1[10],P1[11],P1[12],P1[13], pw3[0]=PKW(P1,8), pw3[1]=PKW(P1,10), pw3); \
    VRD(7); SBAR(); GAPA(C1=__builtin_amdgcn_mfma_f32_32x32x16_bf16(kf[7],qr[3],C1,0,0,0),   P1[14],P1[15],0.f,0.f,       pw3[2]=PKW(P1,12),pw3[3]=PKW(P1,14), pw3); \
    l_reg+=sacc; \
    if(GK){DMA_K((t)+3,sl_cur);} if(GV){DMA_V((t)+1,sl_next);} \
    MAPPLY(C0,C1); \
    { float a=MX3(C0[0],C0[1],C1[0]),b=MX3(C0[2],C0[3],C1[1]); a=MX3(a,C1[2],C1[3]); \
      _Pragma("unroll") for(int r=4;r<16;r+=4){a=MX3(a,C0[r],C0[r+1]);b=MX3(b,C0[r+2],C0[r+3]);a=MX3(a,C1[r],C1[r+1]);b=MX3(b,C1[r+2],C1[r+3]);} \
      float rm=__builtin_fmaxf(a,b); { auto rr=__builtin_amdgcn_permlane32_swap(__float_as_uint(rm),__float_as_uint(rm),false,false); rm=__builtin_fmaxf(__uint_as_float(rr[0]),__uint_as_float(rr[1])); } \
      resc=false; \
      const float rl=rm-mhat; \
      if(__builtin_expect(__any(rl>(float)THRL),0)){ const float dl=__builtin_fmaxf(rl,0.f); mhat+=dl; \
        const float f=__builtin_amdgcn_exp2f(-dl); l_reg*=f; if(hi==0)wsf[r32]=f; resc=true; } \
      _Pragma("unroll") for(int r=0;r<16;++r){C0[r]-=mhat;C1[r]-=mhat;} } \
    SBAR(); \
    GAPB(o[0]=__builtin_amdgcn_mfma_f32_32x32x16_bf16(PAF(0),VFR(0),o[0],0,0,0), C0,0); \
    GAPB(o[1]=__builtin_amdgcn_mfma_f32_32x32x16_bf16(PAF(0),VFR(4),o[1],0,0,0), C0,4); \
    KRD(GL,0); GAPB(o[0]=__builtin_amdgcn_mfma_f32_32x32x16_bf16(PAF(1),VFR(1),o[0],0,0,0), C0,8); \
    KRD(GL,1); GAPB(o[1]=__builtin_amdgcn_mfma_f32_32x32x16_bf16(PAF(1),VFR(5),o[1],0,0,0), C0,12); \
    KRD(GL,2); GAPB(o[0]=__builtin_amdgcn_mfma_f32_32x32x16_bf16(PAF(2),VFR(2),o[0],0,0,0), C1,0); \
    KRD(GL,3); GAPB(o[1]=__builtin_amdgcn_mfma_f32_32x32x16_bf16(PAF(2),VFR(6),o[1],0,0,0), C1,4); \
    GAPB(o[0]=__builtin_amdgcn_mfma_f32_32x32x16_bf16(PAF(3),VFR(3),o[0],0,0,0), C1,8); \
    GAPB(o[1]=__builtin_amdgcn_mfma_f32_32x32x16_bf16(PAF(3),VFR(7),o[1],0,0,0), C1,12); \
    }while(0)
  int t=1;
  for(;t+5<NT;t+=2){
    STEP(pB0,pB1,pA0,pA1,t,true,true,true);     WAIT_BAR(2); RESC(); ROT();
    STEP(pA0,pA1,pB0,pB1,t+1,true,true,true);   WAIT_BAR(2); RESC(); ROT();
  }
  #define ENDW(tt) do{ if((tt)+3<NT){WAIT_BAR(2);} else if((tt)+2<NT){WAIT_BAR(1);} else {WAIT_BAR(0);} }while(0)
  for(;t+1<NT;t+=2){
    STEP(pB0,pB1,pA0,pA1,t,(t+3<NT),(t+1<NT),(t+1<NT));       ENDW(t);   RESC(); ROT();
    STEP(pA0,pA1,pB0,pB1,t+1,(t+4<NT),(t+2<NT),(t+2<NT));     ENDW(t+1); RESC(); ROT();
  }
  STEP(pB0,pB1,pA0,pA1,NT-1,false,false,false); RESC();
  { float sacc=pB0[0]+pB0[1]; _Pragma("unroll") for(int r=2;r<16;++r)sacc+=pB0[r]; _Pragma("unroll") for(int r=0;r<16;++r)sacc+=pB1[r]; l_reg+=sacc;
    pw0=(u32x4){PKW(pB0,0),PKW(pB0,2),PKW(pB0,4),PKW(pB0,6)};pw1=(u32x4){PKW(pB0,8),PKW(pB0,10),PKW(pB0,12),PKW(pB0,14)};pw2=(u32x4){PKW(pB1,0),PKW(pB1,2),PKW(pB1,4),PKW(pB1,6)};pw3=(u32x4){PKW(pB1,8),PKW(pB1,10),PKW(pB1,12),PKW(pB1,14)};
    SBAR(); pv(o,vb0+sl_cur,PAF(0),PAF(1),PAF(2),PAF(3)); }
  #undef PKW
  #undef PAF
  #undef VFR
  #undef PIN
  #undef MX3
  #undef GAPA
  #undef GAPB
  #undef EX
  #undef VRD
  #undef KRD
  #undef STEP
  #undef ENDW
  {auto rr=__builtin_amdgcn_permlane32_swap(__float_as_uint(l_reg),__float_as_uint(l_reg),false,false);l_reg=__uint_as_float(rr[0])+__uint_as_float(rr[1]);}
  if(hi==0)wsf[32+r32]=l_reg;asm volatile("s_waitcnt lgkmcnt(0)":::"memory");
  float rli[16];
  #pragma unroll
  for(int r=0;r<16;++r)rli[r]=__builtin_amdgcn_rcpf(wsf[32+crow(r,hi)]);
  bf16*Ow=O+(rowbase+q0+wid*QBLK)*DMO+h*D;
  { bf16*stg=(bf16*)(shm+LDS_OST)+wid*2048;
    #pragma unroll
    for(int r=0;r<16;++r){const int orow=crow(r,hi);
      #pragma unroll
      for(int d0=0;d0<2;++d0)stg[orow*64+d0*32+r32]=__float2bfloat16(o[d0][r]*rli[r]);}
    asm volatile("s_waitcnt lgkmcnt(0)":::"memory");
    #pragma unroll
    for(int i=0;i<4;++i){const int row=i*8+(lane>>3),ch=lane&7; const u32x4 v=*(const u32x4*)(stg+row*64+ch*8); ATTN_STORE16(Ow+(long)row*DMO+ch*8,v);} }
  asm volatile("s_waitcnt lgkmcnt(0)\n\ts_barrier":::"memory");
  #undef DMA_K
  #undef DMA_V
  #undef MLOAD
  #undef MK64
  #undef MAPPLY
  #undef START
  #undef RESC
  #undef ROT
}
constexpr int ATTN_LDS_BYTES=LDS_BYTES;
struct AttnTensors { const bf16* Q; const bf16* K; const bf16* V; bf16* O; const unsigned long long* MT; };
struct AttnUnit { int bh; int qb; };
struct StaticOrder {
  int vcu;
  __device__ __forceinline__ explicit StaticOrder(int grid,int block):vcu((block%8)*(grid/8)+block/8){}
  __device__ __forceinline__ bool next(int i,AttnUnit&u)const{ if(i>=2)return false; const int s=vcu&3; u.bh=vcu>>2; u.qb=(i==0)?s:7-s; return true; }
  __device__ __forceinline__ void a_ready(const AttnUnit&)const{}
  __device__ __forceinline__ void done(const AttnUnit&)const{}
};
template<class Sched,int THRL=8> __device__ __forceinline__ void attn_phase(char*lds,const AttnTensors&T,const Sched&S){
  AttnUnit u;
  for(int i=0;S.next(i,u);++i){ S.a_ready(u); attn_unit<THRL>(u.bh/NHEAD,u.bh%NHEAD,u.qb,T.Q,T.K,T.V,T.O,T.MT,lds); S.done(u); }
}
#undef SBAR
#undef WAIT_BAR
}
#define XB_TMO      128
#define XB_XCNT(j)  (256  + 64 * (j))
#define XB_XSUB(j)  (1280 + 64 * (j))
#define XB_XGEN(j)  (2304 + 64 * (j))
#define XB_TOP      3328
#define XB_TOPGEN   3392
#define XCD_BAR_WORDS 3456
#define XB_SPIN_CAP (1u << 18)

__device__ __forceinline__ unsigned xb_ld(unsigned* p)              { return __hip_atomic_load(p, __ATOMIC_RELAXED, __HIP_MEMORY_SCOPE_AGENT); }
__device__ __forceinline__ unsigned xb_add(unsigned* p, unsigned v) { return __hip_atomic_fetch_add(p, v, __ATOMIC_RELAXED, __HIP_MEMORY_SCOPE_AGENT); }
__device__ __forceinline__ unsigned xb_xcc_id() { return (unsigned)__builtin_amdgcn_s_getreg((3 << 11) | 20) & 0xFu; }
#define XB_SPIN(cond, bar) do { unsigned _sp = 0; while (cond) { __builtin_amdgcn_s_sleep(1); \
    if ((++_sp & 255u) == 0u) { if (xb_ld(&(bar)[XB_TMO])) break; if (_sp > XB_SPIN_CAP) { atomicAdd(&(bar)[XB_TMO], 1u); break; } } } } while (0)

struct XcdBarrier {
    unsigned* bar; unsigned x;
    volatile LAS unsigned* st;
};

__device__ __forceinline__ XcdBarrier xcd_barrier_post(unsigned* bar, volatile LAS unsigned* st) {
    XcdBarrier b; b.bar = bar; b.x = xb_xcc_id(); b.st = st;
    if (threadIdx.x == 0) (void)xb_add(&bar[XB_XCNT(b.x)], 1u);
    return b;
}
__device__ __forceinline__ void xcd_barrier_complete(unsigned* bar, unsigned x, unsigned& nloc, unsigned& nx) {
    const unsigned G = gridDim.x * gridDim.y * gridDim.z;
    unsigned sum, cnt, mine, sp = 0u;
    for (;;) {
        sum = 0u; cnt = 0u; mine = 0u;
#pragma unroll
        for (unsigned j = 0; j < 16; ++j) { const unsigned c = xb_ld(&bar[XB_XCNT(j)]); sum += c; cnt += (c > 0u) ? 1u : 0u; mine = (j == x) ? c : mine; }
        if (sum == G) break;
        __builtin_amdgcn_s_sleep(1);
        if ((++sp & 255u) == 0u) { if (xb_ld(&bar[XB_TMO])) break; if (sp > XB_SPIN_CAP) { atomicAdd(&bar[XB_TMO], 1u); break; } }
    }
    nloc = mine > 0u ? mine : 1u; nx = cnt > 0u ? cnt : 1u;
}

__device__ __forceinline__ void xcd_barrier(const XcdBarrier& b) {
    asm volatile("s_waitcnt vmcnt(0)" ::: "memory");
    __syncthreads();
    if (threadIdx.x == 0) {
        unsigned* bar = b.bar;
        __builtin_amdgcn_s_waitcnt(0);
        unsigned nloc = b.st[0], nx = b.st[1];
        if (nloc == 0u) { xcd_barrier_complete(bar, b.x, nloc, nx); b.st[0] = nloc; b.st[1] = nx; }
        const unsigned old = xb_add(&bar[XB_XSUB(b.x)], 1u);
        const unsigned gen = old / nloc;
        if (old + 1u == (gen + 1u) * nloc) {
            __builtin_amdgcn_fence(__ATOMIC_RELEASE, "agent");
            asm volatile("s_waitcnt vmcnt(0)" ::: "memory");
            const unsigned og = xb_add(&bar[XB_TOP], 1u);
            const unsigned tg = og / nx;
            if (og + 1u == (tg + 1u) * nx) xb_add(&bar[XB_TOPGEN], 1u);
            else XB_SPIN(xb_ld(&bar[XB_TOPGEN]) == tg, bar);
            __builtin_amdgcn_fence(__ATOMIC_ACQUIRE, "agent");
            xb_add(&bar[XB_XGEN(b.x)], 1u);
            asm volatile("s_waitcnt vmcnt(0)" ::: "memory");
        } else {
            XB_SPIN(xb_ld(&bar[XB_XGEN(b.x)]) == gen, bar);
            __builtin_amdgcn_fence(__ATOMIC_ACQUIRE, "agent");
            asm volatile("s_waitcnt vmcnt(0)" ::: "memory");
        }
    }
    __syncthreads();
}
#define GAS __attribute__((address_space(1)))
#ifndef LAS
#define LAS __attribute__((address_space(3)))
#endif
typedef unsigned short bf16;
typedef unsigned v4u __attribute__((ext_vector_type(4)));
typedef float f32x4 __attribute__((ext_vector_type(4)));
#define LDS_WAIT() asm volatile("s_waitcnt lgkmcnt(0)" ::: "memory")
#define VM_WAIT() asm volatile("s_waitcnt vmcnt(0)" ::: "memory")

constexpr int D = 1024, NB = 8, T = 2048, MP = NB * T, NSMP = 32, MT = MP + NSMP, MPAD = 16640;
constexpr int ATT_W = 512, AH = 8, IH = 16, IDD = 64, TOPK = 256;
constexpr int RW_W = 512, RH = 8, RN = 64;
constexpr int RW_COLS = 1792, IN_COLS = 4432, NIN = 4608;
constexpr int FFN = 2816, NGU = 2 * FFN;
constexpr int NPAGES = 64, PAGE = 128, PAST = 8192, LS = PAST + 1, SCS_LD = 8704;
constexpr int O_Q = 0, O_K = 512, O_V = 1024, O_QI = 1536, O_KI = 2560, O_WI = 2624, O_RW = 2640;
constexpr float IDX_W_SCALE = 0.03125f;
constexpr float RMS_EPS = 1e-6f, GN_EPS = 64e-5f;
constexpr int MODW = 6 * D;

constexpr size_t OUT_Y = 0, OUT_YS = OUT_Y + (size_t)MP * D, OUT_KP = OUT_YS + (size_t)NSMP * D, OUT_VP = OUT_KP + (size_t)MP * ATT_W,
                 OUT_IKP = OUT_VP + (size_t)MP * ATT_W, OUT_WKVP = OUT_IKP + (size_t)MP * IDD, OUT_SHP = OUT_WKVP + (size_t)NB * RH * RN * RN,
                 OUT_KS = OUT_SHP + (size_t)NB * RW_COLS, OUT_VS = OUT_KS + (size_t)NSMP * ATT_W, OUT_IKS = OUT_VS + (size_t)NSMP * ATT_W,
                 OUT_WKVS = OUT_IKS + (size_t)NSMP * IDD, OUT_SHS = OUT_WKVS + (size_t)NSMP * RH * RN * RN, OUT_END = OUT_SHS + (size_t)NSMP * RW_COLS;
static_assert(OUT_END == 36052992, "output size");

constexpr size_t MiB = 1u << 20;
constexpr size_t WS_CTL = 0, CTL_ZERO_BYTES = 1 * MiB;
constexpr size_t WS_MOD = 1 * MiB;
constexpr size_t WS_WIN = 2 * MiB;
constexpr size_t WS_WOUT = 12 * MiB;
constexpr size_t WS_WGU = 14 * MiB;
constexpr size_t WS_WDN = 26 * MiB;
constexpr size_t WS_A1 = 32 * MiB;
constexpr size_t WS_A2 = 66 * MiB;
constexpr size_t WS_MIX = 100 * MiB;
constexpr size_t WS_HB = 134 * MiB;
constexpr size_t WS_X1 = 224 * MiB;
constexpr size_t WS_PROJ = 290 * MiB;
constexpr size_t WS_RAW = 584 * MiB;
constexpr size_t WS_RAW2 = 650 * MiB;
constexpr size_t WS_QN = 1008 * MiB;
constexpr size_t WS_RWA = 1042 * MiB, RWA_STRIDE = 33 * MiB;
constexpr size_t WS_Y = 1273 * MiB;
constexpr size_t WS_SC = 1306 * MiB;
constexpr size_t WS_SCS = 1434 * MiB;
constexpr size_t WS_MASK = 1436 * MiB;
constexpr size_t WS_SLIST = 1440 * MiB;
constexpr size_t WS_QB = 1444 * MiB, WS_KB = 1461 * MiB, WS_VB = 1478 * MiB;
constexpr size_t WS_MASKT = 1495 * MiB;
constexpr size_t WS_QIB = 1500 * MiB;
constexpr size_t WS_KIB = 1536 * MiB;
constexpr size_t WS_WI = 1539 * MiB;
constexpr size_t WS_LIN = 1541 * MiB;
constexpr size_t WS_KX = 1550 * MiB;
constexpr size_t WS_W2T = 1583 * MiB, WS_A2T = 1584 * MiB, WS_G2T = 1585 * MiB;
constexpr size_t WS_MF = 1586 * MiB, WS_NT = 1603 * MiB, WS_PF = 1636 * MiB, WS_QP = 1653 * MiB, WS_ZF = 1686 * MiB;
constexpr size_t WS_Y2 = 1703 * MiB;
constexpr size_t WS_END = 1736 * MiB;
constexpr int QI_LD = 17 * 64;
constexpr int CW_BAR = 4096;

constexpr int NWAVES = 8, NTHREADS = 512;
constexpr int LDS_BYTES = 147456, MISC_OFF = 131072 + 320;

__device__ __forceinline__ unsigned f2bf(float f) { unsigned u = __builtin_bit_cast(unsigned, f); return (u + 0x7fffu + ((u >> 16) & 1u)) >> 16; }
__device__ __forceinline__ unsigned pk2(float lo, float hi) { return f2bf(lo) | (f2bf(hi) << 16); }
__device__ __forceinline__ float wave_sum(float v) {
#pragma unroll
    for (int o = 1; o < 64; o <<= 1) v += __shfl_xor(v, o);
    return v;
}
__device__ __forceinline__ float wave_max(float v) {
#pragma unroll
    for (int o = 1; o < 64; o <<= 1) v = fmaxf(v, __shfl_xor(v, o));
    return v;
}
__device__ __forceinline__ int wave_sum_i(int v) {
#pragma unroll
    for (int o = 1; o < 64; o <<= 1) v += __shfl_xor(v, o);
    return v;
}
__device__ __forceinline__ float sigmoidf_(float x) { return 1.f / (1.f + expf(-x)); }
__device__ __forceinline__ unsigned sortable(float f) { const unsigned u = __builtin_bit_cast(unsigned, f); return (u & 0x80000000u) ? ~u : (u | 0x80000000u); }
__device__ __forceinline__ unsigned long long lanemask_lt(int lane) { return (1ull << lane) - 1ull; }
__device__ __forceinline__ float rdlane(float v, int l) { return __builtin_bit_cast(float, __builtin_amdgcn_readlane(__builtin_bit_cast(int, v), l)); }

struct Args { const float* in[32]; float* out; unsigned char* ws; int ph_lo, ph_hi; };

struct Ctx {
    LAS unsigned char* lds;
    int tid, lane, wave, G, gw, ngw;
    const float* const* in; float* out; unsigned char* ws;
};
__device__ __forceinline__ const float* x_row(const Ctx& C, int m) { return m < MP ? C.in[0] + (size_t)m * D : C.in[1] + (size_t)(m - MP) * D; }
__device__ __forceinline__ int mod_row(int m) { return m < MP ? (m >> 11) : NB + (m - MP); }

struct EpiRawF32 {
    static constexpr bool PERM = false, AFTER_DRAIN = false;
    float* O; int ldc;
    __device__ __forceinline__ void operator()(const pg8::f32x4 (&acc)[2][2][4][2], const pg8::Unit& u, int wr, int wc, int fr, int fq) const {
        const int row0 = u.pm * 256 + wr * 64 + fr, col0 = u.pn * 256 + wc * 32 + 4 * fq;
#pragma unroll
        for (int ai = 0; ai < 2; ++ai)
#pragma unroll
            for (int m = 0; m < 4; ++m) { float* rowp = O + (size_t)(row0 + ai * 128 + m * 16) * ldc + col0;
#pragma unroll
                for (int bj = 0; bj < 2; ++bj)
#pragma unroll
                    for (int n = 0; n < 2; ++n) *(pg8::f32x4*)(rowp + bj * 128 + n * 16) = acc[ai][bj][m][n]; }
    }
};

struct EpiResGate {
    static constexpr bool PERM = false, AFTER_DRAIN = false;
    const float* base; const float* gate; float* out;
    __device__ __forceinline__ void operator()(const pg8::f32x4 (&acc)[2][2][4][2], const pg8::Unit& u, int wr, int wc, int fr, int fq) const {
        const int row0 = u.pm * 256 + wr * 64 + fr, col0 = u.pn * 256 + wc * 32 + 4 * fq;
        const float* gp = gate + (size_t)((u.pm * 256) >> 11) * MODW + col0;
        pg8::f32x4 gv[2][2];
#pragma unroll
        for (int bj = 0; bj < 2; ++bj)
#pragma unroll
            for (int n = 0; n < 2; ++n) gv[bj][n] = *(const pg8::f32x4*)(gp + bj * 128 + n * 16);
#pragma unroll
        for (int ai = 0; ai < 2; ++ai)
#pragma unroll
            for (int m = 0; m < 4; ++m) { const size_t off = (size_t)(row0 + ai * 128 + m * 16) * D + col0;
#pragma unroll
                for (int bj = 0; bj < 2; ++bj)
#pragma unroll
                    for (int n = 0; n < 2; ++n) { const pg8::f32x4 bv = *(const pg8::f32x4*)(base + off + bj * 128 + n * 16);
                        *(pg8::f32x4*)(out + off + bj * 128 + n * 16) = bv + gv[bj][n] * acc[ai][bj][m][n]; } }
    }
};
struct EpiSwiGLU {
    static constexpr bool PERM = true, AFTER_DRAIN = false;
    bf16* H;
    __device__ __forceinline__ void operator()(const pg8::f32x4 (&acc)[2][2][4][2], const pg8::Unit& u, int wr, int wc, int fr, int fq) const {
        const int row0 = u.pm * 256 + wr * 64 + fr, col0 = u.pn * 128 + wc * 32 + 8 * fq;
#pragma unroll
        for (int ai = 0; ai < 2; ++ai)
#pragma unroll
            for (int m = 0; m < 4; ++m) { float hv[8];
#pragma unroll
                for (int n = 0; n < 2; ++n)
#pragma unroll
                    for (int i = 0; i < 4; ++i) { const float g = acc[ai][0][m][n][i], up = acc[ai][1][m][n][i]; hv[4 * n + i] = g * __builtin_amdgcn_rcpf(1.f + __expf(-g)) * up; }
                pg8::u32x4 w; w.x = pg8::cvt_pk_bf16(hv[0], hv[1]); w.y = pg8::cvt_pk_bf16(hv[2], hv[3]); w.z = pg8::cvt_pk_bf16(hv[4], hv[5]); w.w = pg8::cvt_pk_bf16(hv[6], hv[7]);
                *(pg8::u32x4*)(H + (size_t)(row0 + ai * 128 + m * 16) * FFN + col0) = w; }
    }
};
template <class F> __device__ __forceinline__ void sample_gemm(const Ctx& C, const bf16* A, const bf16* Bt, int K, const F& f) {
    typedef short bf16x8 __attribute__((ext_vector_type(8))); typedef float f32x16 __attribute__((ext_vector_type(16)));
    LAS float* red = (LAS float*)C.lds;
    const int lane = C.lane, hi = lane >> 5, ksteps = K / 16 / NWAVES;
    for (int u = (int)blockIdx.x - 128; u >= 0 && u < D / 32; u += C.G) {
        const int n0 = 32 * u;
        const bf16* ap = A + (size_t)(lane & 31) * K + (size_t)C.wave * ksteps * 16 + 8 * hi; const bf16* bp = Bt + (size_t)(n0 + (lane & 31)) * K + (size_t)C.wave * ksteps * 16 + 8 * hi;
        f32x16 acc = f32x16{};
        for (int ks = 0; ks < ksteps; ++ks) acc = __builtin_amdgcn_mfma_f32_32x32x16_bf16(*(const bf16x8*)(ap + 16 * ks), *(const bf16x8*)(bp + 16 * ks), acc, 0, 0, 0);
        __syncthreads();
#pragma unroll
        for (int r = 0; r < 16; ++r) red[(C.wave * 64 + lane) * 16 + r] = acc[r];
        __syncthreads();
        for (int o = C.tid; o < 1024; o += NTHREADS) { const int ls = o & 63, r = o >> 6; float v = 0.f;
#pragma unroll
            for (int w = 0; w < 8; ++w) v += red[(w * 64 + ls) * 16 + r];
            f((r & 3) + 8 * (r >> 2) + 4 * (ls >> 5), n0 + (ls & 31), v); }
    }
    __syncthreads();
}

__device__ __forceinline__ void p0_mod(const Ctx& C) {
    LAS float* sc = (LAS float*)C.lds;
    const float* cp = C.in[8]; const float* cs = C.in[9]; const float* wada = C.in[12]; const float* bada = C.in[13];
    float* MOD = (float*)(C.ws + WS_MOD);
    const int cl = C.tid & 31, kc = C.tid >> 5;
    for (int u = blockIdx.x; u < MODW / 32; u += C.G) {
        const int c0 = 32 * u;
        float acc[40];
#pragma unroll
        for (int r = 0; r < 40; ++r) acc[r] = 0.f;
        for (int hh = 0; hh < 2; ++hh) {
            __syncthreads();
            for (int i = C.tid; i < 40 * 512; i += NTHREADS) { const int r = i >> 9, kk = i & 511; const float v = (r < NB) ? cp[r * D + 512 * hh + kk] : cs[(r - NB) * D + 512 * hh + kk]; sc[i] = v / (1.f + expf(-v)); }
            __syncthreads();
            const int kb = 512 * hh + 32 * kc;
            for (int k4 = 0; k4 < 8; ++k4) {
                const float* wp = wada + (size_t)(kb + 4 * k4) * MODW + c0 + cl;
                const float w0 = wp[0], w1 = wp[MODW], w2 = wp[2 * MODW], w3 = wp[3 * MODW];
#pragma unroll
                for (int r = 0; r < 40; ++r) { const f32x4 s = *(const LAS f32x4*)(sc + r * 512 + 32 * kc + 4 * k4); acc[r] += s.x * w0 + s.y * w1 + s.z * w2 + s.w * w3; }
            }
        }
        __syncthreads();
#pragma unroll
        for (int r = 0; r < 40; ++r) sc[(kc * 40 + r) * 32 + cl] = acc[r];
        __syncthreads();
        for (int i = C.tid; i < 40 * 32; i += NTHREADS) { const int r = i >> 5, c = i & 31; float s = 0.f;
            for (int k = 0; k < 16; ++k) s += sc[(k * 40 + r) * 32 + c];
            MOD[r * MODW + c0 + c] = s + bada[c0 + c]; }
    }
    __syncthreads();
}
template <int MODE = 0> __device__ __forceinline__ void transpose_item(const float* W, int K, int N, int NP, bf16* WT, int row_off, LAS float* scr, int item, int lane) {
    const int nblk = NP / 32, kb = item / nblk, nb = item % nblk, k0 = 64 * kb, n0 = 32 * nb;
    const int nsrc = n0 + (lane & 31);
#pragma unroll 8
    for (int i = 0; i < 32; ++i) { const int kk = 2 * i + (lane >> 5); scr[kk * 33 + (lane & 31)] = (nsrc < N) ? W[(size_t)(k0 + kk) * N + nsrc] : 0.f; }
    LDS_WAIT(); asm volatile("" ::: "memory");
    const int c = lane & 7;
#pragma unroll
    for (int j = 0; j < 4; ++j) { const int n = (lane >> 3) + 8 * j; const LAS float* s = scr + (8 * c) * 33 + n;
        v4u o; o.x = pk2(s[0 * 33], s[1 * 33]); o.y = pk2(s[2 * 33], s[3 * 33]); o.z = pk2(s[4 * 33], s[5 * 33]); o.w = pk2(s[6 * 33], s[7 * 33]);
        const int nn = n0 + n, drow = MODE == 0 ? row_off + nn : 256 * (nn >> 7) + (nn & 127) + (MODE == 2 ? 128 : 0);
        *(GAS v4u*)(WT + (size_t)drow * K + k0 + 8 * c) = o; }
    LDS_WAIT(); asm volatile("" ::: "memory");
}
__device__ __forceinline__ void p0_weights(const Ctx& C) {
    LAS float* scr = (LAS float*)(C.lds + C.wave * 16384);
    constexpr int I_IN = (D / 64) * (NIN / 32), I_OUT = (D / 64) * (D / 32), I_G = (D / 64) * (FFN / 32), I_DN = (FFN / 64) * (D / 32);
    constexpr int I_L = RW_W / 32, NITEMS = I_IN + I_OUT + 2 * I_G + I_DN + 4 * I_L;
    bf16* WIN = (bf16*)(C.ws + WS_WIN); bf16* WOUT = (bf16*)(C.ws + WS_WOUT); bf16* WGU = (bf16*)(C.ws + WS_WGU); bf16* WDN = (bf16*)(C.ws + WS_WDN);
    for (int it = C.gw; it < NITEMS; it += C.ngw) {
        int r = it;
        if (r < I_IN) { transpose_item(C.in[14], D, IN_COLS, NIN, WIN, 0, scr, r, C.lane); continue; } r -= I_IN;
        if (r < I_OUT) { transpose_item(C.in[28], D, D, D, WOUT, 0, scr, r, C.lane); continue; } r -= I_OUT;
        if (r < I_G) { transpose_item<1>(C.in[29], D, FFN, FFN, WGU, 0, scr, r, C.lane); continue; } r -= I_G;
        if (r < I_G) { transpose_item<2>(C.in[30], D, FFN, FFN, WGU, 0, scr, r, C.lane); continue; } r -= I_G;
        if (r < I_DN) { transpose_item(C.in[31], FFN, D, D, WDN, 0, scr, r, C.lane); continue; } r -= I_DN;
        if (r < I_L) { transpose_item(C.in[19], 64, RW_W, RW_W, (bf16*)(C.ws + WS_W2T), 0, scr, r, C.lane); continue; } r -= I_L;
        if (r < I_L) { transpose_item(C.in[21], 64, RW_W, RW_W, (bf16*)(C.ws + WS_A2T), 0, scr, r, C.lane); continue; } r -= I_L;
        transpose_item(C.in[22], 128, RW_W, RW_W, (bf16*)(C.ws + WS_G2T), 0, scr, r, C.lane);
    }
}
__device__ __forceinline__ void norm_mod_row(const Ctx& C, int m, const float* xr, const float* g, const float* shift, const float* scale, bf16* orow) {
    const GAS f32x4* xp = (const GAS f32x4*)xr + C.lane;
    f32x4 v[4]; float s = 0.f;
#pragma unroll
    for (int j = 0; j < 4; ++j) { v[j] = xp[64 * j]; s += (v[j].x * v[j].x + v[j].y * v[j].y) + (v[j].z * v[j].z + v[j].w * v[j].w); }
    const float rstd = 1.f / sqrtf(wave_sum(s) * (1.f / D) + RMS_EPS);
    GAS unsigned long long* o8 = (GAS unsigned long long*)orow + C.lane;
#pragma unroll
    for (int j = 0; j < 4; ++j) { const int c = 4 * (C.lane + 64 * j);
        const f32x4 gg = *(const f32x4*)(g + c), sh = *(const f32x4*)(shift + c), sc = *(const f32x4*)(scale + c);
        const f32x4 h = v[j] * rstd * gg * (1.f + sc) + sh;
        o8[64 * j] = (unsigned long long)pk2(h.x, h.y) | ((unsigned long long)pk2(h.z, h.w) << 32); }
}
__device__ __forceinline__ void p1_norm1(const Ctx& C) {
    bf16* A1 = (bf16*)(C.ws + WS_A1); const float* MOD = (const float*)(C.ws + WS_MOD);
    for (int m = C.gw; m < MPAD; m += C.ngw) {
        bf16* orow = A1 + (size_t)m * D;
        if (m >= MT) { GAS unsigned long long* o8 = (GAS unsigned long long*)orow + C.lane;
#pragma unroll
            for (int j = 0; j < 4; ++j) o8[64 * j] = 0ull;
            continue; }
        const float* md = MOD + mod_row(m) * MODW;
        norm_mod_row(C, m, x_row(C, m), C.in[10], md, md + D, orow);
    }
}
__device__ __forceinline__ void p3_post(const Ctx& C) {
    const float* PROJ = (const float*)(C.ws + WS_PROJ); float* QN = (float*)(C.ws + WS_QN);
    const int lane = C.lane;
    const float qg = C.in[15][lane], kg = C.in[16][lane];
    for (int m = C.gw; m < MT; m += C.ngw) {
        const float* p = PROJ + (size_t)m * NIN;
        const bool smp = m >= MP; const int j = m - MP;
        float* ko = C.out + (smp ? OUT_KS + (size_t)j * ATT_W : OUT_KP + (size_t)m * ATT_W);
        float* vo = C.out + (smp ? OUT_VS + (size_t)j * ATT_W : OUT_VP + (size_t)m * ATT_W);
        float* io = C.out + (smp ? OUT_IKS + (size_t)j * IDD : OUT_IKP + (size_t)m * IDD);
        float* qn = QN + (size_t)m * ATT_W;
        bf16* qb = (bf16*)(C.ws + WS_QB) + (size_t)m * ATT_W; bf16* kb = (bf16*)(C.ws + WS_KB) + (size_t)m * ATT_W; bf16* vb = (bf16*)(C.ws + WS_VB) + (size_t)m * ATT_W;
        for (int h = 0; h < AH; ++h) {
            const float q = p[O_Q + h * 64 + lane], k = p[O_K + h * 64 + lane];
            const float sq = wave_sum(q * q), sk = wave_sum(k * k);
            const float qv = q * (1.f / sqrtf(sq * (1.f / 64.f) + RMS_EPS)) * qg, kv = k * (1.f / sqrtf(sk * (1.f / 64.f) + RMS_EPS)) * kg, vv = p[O_V + h * 64 + lane];
            qn[h * 64 + lane] = qv; ko[h * 64 + lane] = kv; vo[h * 64 + lane] = vv;
            qb[h * 64 + lane] = (bf16)f2bf(qv * attn_body::C2); kb[h * 64 + lane] = (bf16)f2bf(kv); vb[h * 64 + lane] = (bf16)f2bf(vv);
        }
        const float ki = p[O_KI + lane];
        const float kin = ki * (1.f / sqrtf(wave_sum(ki * ki) * (1.f / 64.f) + RMS_EPS));
        io[lane] = kin;
        ((bf16*)(C.ws + WS_KIB))[(size_t)m * IDD + lane] = (bf16)f2bf(kin);
        { bf16* qi = (bf16*)(C.ws + WS_QIB) + (size_t)m * QI_LD; float ql = 0.f;
          for (int h = 0; h < IH; ++h) { const float v = p[O_QI + h * 64 + lane]; qi[h * 64 + lane] = (bf16)f2bf(v); ql += p[O_WI + h] * v; }
          qi[IH * 64 + lane] = (bf16)f2bf(ql);
          if (lane < IH) ((float*)(C.ws + WS_WI))[(size_t)m * IH + lane] = p[O_WI + lane]; }
        if (smp || (m & (T - 1)) == T - 1) {
            float* so = C.out + (smp ? OUT_SHS + (size_t)j * RW_COLS : OUT_SHP + (size_t)(m >> 11) * RW_COLS);
            for (int i = 0; i < RW_COLS / 64; ++i) so[i * 64 + lane] = p[O_RW + i * 64 + lane];
        }
    }
}
template <bool OLD_ALL> __device__ __forceinline__ void p3_rwprep(const Ctx& C) {
    const float* PROJ = (const float*)(C.ws + WS_PROJ);
    float* Rr = (float*)(C.ws + WS_RWA), *Wd = (float*)(C.ws + WS_RWA + RWA_STRIDE), *Kp = (float*)(C.ws + WS_RWA + 2 * RWA_STRIDE), *Vv = (float*)(C.ws + WS_RWA + 3 * RWA_STRIDE),
          *KK = (float*)(C.ws + WS_RWA + 4 * RWA_STRIDE), *Bb = (float*)(C.ws + WS_RWA + 5 * RWA_STRIDE), *Gg = (float*)(C.ws + WS_RWA + 6 * RWA_STRIDE);
    const float* mu = C.in[17]; const float* w0 = C.in[18]; const float* w2 = C.in[19]; const float* a0 = C.in[20]; const float* a2 = C.in[21]; const float* g2 = C.in[22];
    const float* k_k = C.in[23]; const float* k_a = C.in[24];
    LAS float* lw = (LAS float*)(C.lds + C.wave * 1024);
    const int lane = C.lane;
    for (int m = C.gw; m < MT; m += C.ngw) {
        const float* p = PROJ + (size_t)m * NIN + O_RW;
        const bool smp = m >= MP; const int j = m - MP; const int t = m & (T - 1);
        const float* pv = smp ? C.in[6] + (size_t)j * RW_COLS : (t == 0 ? nullptr : p - NIN);
#define XM(c) ({ const int c_ = (c); const float cur_ = p[c_]; const float prv_ = pv ? pv[c_] : 0.f; cur_ + (prv_ - cur_) * mu[c_]; })
        const float l0 = tanhf(XM(1536 + lane)), l1 = XM(1600 + lane), l2 = sigmoidf_(XM(1664 + lane)), l3 = sigmoidf_(XM(1728 + lane));
        if (!smp) {
            bf16* lin = (bf16*)(C.ws + WS_LIN) + (size_t)m * 256; float* KX = (float*)(C.ws + WS_KX);
            lin[lane] = (bf16)f2bf(l0); lin[64 + lane] = (bf16)f2bf(l1); lin[128 + lane] = (bf16)f2bf(l2); lin[192 + lane] = (bf16)f2bf(l3);
            for (int h = 0; h < RH; ++h) { const int c = h * 64 + lane; const size_t o = (size_t)m * RW_W + c;
                const float r = XM(c), k = XM(512 + c), v = XM(1024 + c);
                float kk = k * k_k[c]; const float nrm = wave_sum(kk * kk); kk *= 1.f / sqrtf(fmaxf(nrm, 1e-24f));
                Rr[o] = r; KX[o] = k; Vv[o] = v; KK[o] = kk; }
            if (!OLD_ALL) continue;
        }
        lw[lane] = l0; lw[64 + lane] = l1; lw[128 + lane] = l2; lw[192 + lane] = l3;
        LDS_WAIT(); asm volatile("" ::: "memory");
        for (int h = 0; h < RH; ++h) {
            const int c = h * 64 + lane;
            float aw = w0[c], aa = a0[c], ag = 0.f;
            for (int jj = 0; jj < 64; ++jj) { aw += lw[jj] * w2[jj * RW_W + c]; aa += lw[64 + jj] * a2[jj * RW_W + c]; }
            for (int jj = 0; jj < 128; ++jj) ag += lw[128 + jj] * g2[jj * RW_W + c];
            const float decay = expf(-0.6065306597126334f * sigmoidf_(aw));
            const float a = sigmoidf_(aa);
            const float r = XM(c), k = XM(512 + c), v = XM(1024 + c);
            float kk = k * k_k[c]; const float nrm = wave_sum(kk * kk); kk *= 1.f / sqrtf(fmaxf(nrm, 1e-24f));
            const float kp = k * (1.f + (a - 1.f) * k_a[c]);
            const size_t o = (size_t)m * RW_W + c;
            Rr[o] = r; Wd[o] = decay; Kp[o] = kp; Vv[o] = v; KK[o] = kk; Bb[o] = kk * a; Gg[o] = ag;
        }
#undef XM
        LDS_WAIT(); asm volatile("" ::: "memory");
    }
}
namespace idxsel {
typedef short bf16x8 __attribute__((ext_vector_type(8)));
typedef float f32x16 __attribute__((ext_vector_type(16)));
constexpr int QT_BYTES = 17 * 32 * 128, WT_OFF = QT_BYTES, CNT_OFF = WT_OFF + 32 * 17 * 4;
__device__ __forceinline__ int crow(int r, int hi) { return (r & 3) + 8 * (r >> 2) + 4 * hi; }
__device__ __forceinline__ void unit(const Ctx& C, int b, int qg) {
    const int lane = C.lane, r32 = lane & 31, hi = lane >> 5, wave = C.wave;
    LAS unsigned char* lds = C.lds;
    const bf16* QIb = (const bf16*)(C.ws + WS_QIB); const bf16* KIb = (const bf16*)(C.ws + WS_KIB); const float* WIr = (const float*)(C.ws + WS_WI);
    unsigned long long* MASKT = (unsigned long long*)(C.ws + WS_MASKT);
    LAS float* WT = (LAS float*)(lds + WT_OFF); LAS int* CNT = (LAS int*)(lds + CNT_OFF);
    const size_t row0 = (size_t)b * T + 32 * qg;
    __syncthreads();
    for (int i = C.tid; i < 32 * 136; i += NTHREADS) { const int q = i / 136, hc = i % 136, h = hc >> 3, c = hc & 7;
        const v4u v = *(const v4u*)(QIb + (row0 + q) * QI_LD + hc * 8);
        *(LAS v4u*)(lds + ((h * 32 + q) * 8 + (c ^ (q & 7))) * 16) = v; }
    { const int q = C.tid >> 4, h = C.tid & 15; WT[q * 17 + h] = WIr[(row0 + q) * IH + h]; }
    __syncthreads();
    f32x16 sc[8];
#pragma unroll
    for (int j = 0; j < 8; ++j) sc[j] = f32x16{};
#pragma unroll
    for (int j = 0; j < 8; ++j) {
        const int kt0 = wave + 8 * j;
        asm volatile("" ::: "memory");
        if (kt0 <= qg) {
            bf16x8 ka[4];
            const bf16* kp0 = KIb + ((size_t)b * T + kt0 * 32 + r32) * IDD + 8 * hi;
#pragma unroll
            for (int s4 = 0; s4 < 4; ++s4) ka[s4] = *(const bf16x8*)(kp0 + 16 * s4);
            bf16x8 qf[4];
#pragma unroll
            for (int s4 = 0; s4 < 4; ++s4) qf[s4] = *(const LAS bf16x8*)(lds + ((0 * 32 + r32) * 8 + ((2 * s4 + hi) ^ (r32 & 7))) * 16);
#pragma unroll 1
            for (int h = 0; h < 17; ++h) {
                bf16x8 qn[4];
                const int hn = h < 16 ? h + 1 : 16;
#pragma unroll
                for (int s4 = 0; s4 < 4; ++s4) qn[s4] = *(const LAS bf16x8*)(lds + ((hn * 32 + r32) * 8 + ((2 * s4 + hi) ^ (r32 & 7))) * 16);
                const float w = WT[r32 * 17 + h];
                f32x16 xa = f32x16{};
#pragma unroll
                for (int s4 = 0; s4 < 4; ++s4) xa = __builtin_amdgcn_mfma_f32_32x32x16_bf16(ka[s4], qf[s4], xa, 0, 0, 0);
                if (h < 16) {
#pragma unroll
                    for (int r = 0; r < 16; ++r) sc[j][r] = __builtin_fmaf(__builtin_fabsf(xa[r]), w, sc[j][r]); }
                else {
#pragma unroll
                    for (int r = 0; r < 16; ++r) sc[j][r] += xa[r]; }
#pragma unroll
                for (int s4 = 0; s4 < 4; ++s4) qf[s4] = qn[s4];
            }
        }
    }
    unsigned key[8][16];
#pragma unroll
    for (int j = 0; j < 8; ++j) { const int kt = wave + 8 * j;
#pragma unroll
        for (int r = 0; r < 16; ++r) { const bool valid = (kt < qg) || (kt == qg && crow(r, hi) <= r32); key[j][r] = valid ? sortable(sc[j][r]) : 0u; } }
    unsigned Tk = 1u;
    if (qg >= 8) {
        Tk = 0u; int buf = 0;
        for (int bit = 31; bit >= 0; --bit) {
            const unsigned cand = Tk | (1u << bit); int c = 0;
#pragma unroll
            for (int j = 0; j < 8; ++j) if (wave + 8 * j <= qg) {
#pragma unroll
                for (int r = 0; r < 16; ++r) c += (key[j][r] >= cand) ? 1 : 0; }
            c += __shfl_xor(c, 32);
            if (hi == 0) CNT[(buf * 8 + wave) * 32 + r32] = c;
            __syncthreads();
            int tot = 0;
#pragma unroll
            for (int w = 0; w < 8; ++w) tot += CNT[(buf * 8 + w) * 32 + r32];
            if (tot >= TOPK) Tk = cand;
            buf ^= 1;
        }
    }
#pragma unroll
    for (int j = 0; j < 8; ++j) { const int kt = wave + 8 * j; unsigned long long mine = 0ull;
#pragma unroll
        for (int r = 0; r < 16; ++r) { const unsigned long long W = __ballot(key[j][r] >= Tk); if (lane == r) mine = W; }
        if (lane < 16) MASKT[(((size_t)(b * 64 + qg) * 32 + (kt >> 1)) * 32) + (kt & 1) * 16 + lane] = mine; }
}
__device__ __forceinline__ void phase(const Ctx& C) {
    const int v = (int)((blockIdx.x % 8) * (C.G / 8) + blockIdx.x / 8);
    for (int vv = v; vv < NB * 32; vv += C.G) { const int b = vv >> 5, i = vv & 31; unit(C, b, 63 - i); unit(C, b, i); }
    __syncthreads();
}
}
__device__ __forceinline__ float idx_score(const float (&kr)[64], const LAS float* ql, const LAS float* wl) {
    float score = 0.f;
    for (int h = 0; h < IH; ++h) {
        float d = 0.f;
#pragma unroll
        for (int dd = 0; dd < 64; dd += 4) { const f32x4 qv = *(const LAS f32x4*)(ql + h * 64 + dd); d += qv.x * kr[dd] + qv.y * kr[dd + 1] + qv.z * kr[dd + 2] + qv.w * kr[dd + 3]; }
        score += wl[h] * fmaxf(d, 0.f);
    }
    return score;
}
template <bool PROMPT, bool SAMPLE> __device__ __forceinline__ void p4_indexer(const Ctx& C) {
    const float* PROJ = (const float*)(C.ws + WS_PROJ); float* SC = (float*)(C.ws + WS_SC); float* SCS = (float*)(C.ws + WS_SCS);
    LAS float* ql = (LAS float*)C.lds;
    LAS float* wl = ql + 16 * 1024;
    const int lane = C.lane;
    if (PROMPT) for (int u = blockIdx.x; u < NB * 128 * 4; u += C.G) {
        const int b = u >> 9, tq = (u >> 2) & 127, scn = u & 3, t0 = tq * 16;
        if (scn * 512 > t0 + 15) continue;
        __syncthreads();
        for (int i = C.tid; i < 16 * 1024; i += NTHREADS) { const int q = i >> 10, e = i & 1023; ql[i] = PROJ[(size_t)(b * T + t0 + q) * NIN + O_QI + e]; }
        if (C.tid < 256) { const int q = C.tid >> 4, h = C.tid & 15; wl[C.tid] = PROJ[(size_t)(b * T + t0 + q) * NIN + O_WI + h] * IDX_W_SCALE; }
        __syncthreads();
        const int s = scn * 512 + C.wave * 64 + lane;
        if (scn * 512 + C.wave * 64 <= t0 + 15) {
            float kr[64];
            const f32x4* kp = (const f32x4*)(C.out + OUT_IKP + (size_t)(b * T + s) * IDD);
#pragma unroll
            for (int i = 0; i < 16; ++i) { const f32x4 v = kp[i]; kr[4 * i] = v.x; kr[4 * i + 1] = v.y; kr[4 * i + 2] = v.z; kr[4 * i + 3] = v.w; }
            for (int q = 0; q < 16; ++q) {
                const float score = idx_score(kr, ql + q * 1024, wl + q * 16);
                const int t = t0 + q;
                if (s <= t) SC[((size_t)b * T + t) * T + s] = score;
            }
        }
    }
    __syncthreads();
    const int* pt = (const int*)C.in[7];
    LAS float* qw = (LAS float*)(C.lds + C.wave * 8192); LAS float* ww = qw + 1024;
    if (SAMPLE) for (int wu = C.gw; wu < NSMP * 129; wu += C.ngw) {
        const int j = wu / 129, kb = wu % 129;
        const float* pq = PROJ + (size_t)(MP + j) * NIN;
        for (int i = 0; i < 16; ++i) qw[i * 64 + lane] = pq[O_QI + i * 64 + lane];
        if (lane < 16) ww[lane] = pq[O_WI + lane] * IDX_W_SCALE;
        LDS_WAIT(); asm volatile("" ::: "memory");
        const int s = kb * 64 + lane;
        const float* krow = nullptr;
        if (s < PAST) krow = C.in[4] + ((size_t)pt[j * NPAGES + (s >> 7)] * PAGE + (s & 127)) * IDD;
        else if (s == PAST) krow = C.out + OUT_IKS + (size_t)j * IDD;
        float score = -INFINITY;
        if (krow) { float kr[64]; const f32x4* kp = (const f32x4*)krow;
#pragma unroll
            for (int i = 0; i < 16; ++i) { const f32x4 v = kp[i]; kr[4 * i] = v.x; kr[4 * i + 1] = v.y; kr[4 * i + 2] = v.z; kr[4 * i + 3] = v.w; }
            score = idx_score(kr, qw, ww); }
        SCS[(size_t)j * SCS_LD + s] = score;
        LDS_WAIT(); asm volatile("" ::: "memory");
    }
}
template <bool PROBE> __device__ __forceinline__ void p4_scan(const Ctx& C, int u_begin) {
    const float* Rr = (const float*)(C.ws + WS_RWA), *Wd = (const float*)(C.ws + WS_RWA + RWA_STRIDE), *Kp = (const float*)(C.ws + WS_RWA + 2 * RWA_STRIDE), *Vv = (const float*)(C.ws + WS_RWA + 3 * RWA_STRIDE),
          *KK = (const float*)(C.ws + WS_RWA + 4 * RWA_STRIDE), *Bb = (const float*)(C.ws + WS_RWA + 5 * RWA_STRIDE);
    float* Y = (float*)(C.ws + (PROBE ? WS_Y2 : WS_Y));
    const int lane = C.lane;
    for (int u = u_begin + C.gw; u < (PROBE ? NB * RH : NB * RH + NSMP * RH); u += C.ngw) {
        const bool smp = u >= NB * RH; const int seq = smp ? (u - NB * RH) / RH : u / RH, h = u % RH;
        const int nsteps = smp ? 1 : T; const size_t base = smp ? (size_t)(MP + seq) : (size_t)seq * T;
        float S[64];
        if (smp) { const f32x4* sp = (const f32x4*)(C.in[5] + (((size_t)seq * RH + h) * RN + lane) * RN);
#pragma unroll
            for (int i = 0; i < 16; ++i) { const f32x4 v = sp[i]; S[4 * i] = v.x; S[4 * i + 1] = v.y; S[4 * i + 2] = v.z; S[4 * i + 3] = v.w; } }
        else {
#pragma unroll
            for (int i = 0; i < 64; ++i) S[i] = 0.f; }
        size_t o = base * RW_W + h * 64 + lane;
        float r = Rr[o], w = Wd[o], k = Kp[o], v = Vv[o], kk = KK[o], bb = Bb[o];
        for (int t = 0; t < nsteps; ++t) {
            float rn = 0.f, wn = 0.f, kn = 0.f, vn = 0.f, kkn = 0.f, bbn = 0.f;
            const size_t on = o + RW_W;
            if (t + 1 < nsteps) { rn = Rr[on]; wn = Wd[on]; kn = Kp[on]; vn = Vv[on]; kkn = KK[on]; bbn = Bb[on]; }
            float sa0 = 0.f, sa1 = 0.f;
#pragma unroll
            for (int jx = 0; jx < 64; jx += 2) { sa0 += S[jx] * rdlane(kk, jx); sa1 += S[jx + 1] * rdlane(kk, jx + 1); }
            const float sa = -(sa0 + sa1);
            float y0 = 0.f, y1 = 0.f;
#pragma unroll
            for (int jx = 0; jx < 64; jx += 2) {
                S[jx] = S[jx] * rdlane(w, jx) + sa * rdlane(bb, jx) + v * rdlane(k, jx); y0 += S[jx] * rdlane(r, jx);
                S[jx + 1] = S[jx + 1] * rdlane(w, jx + 1) + sa * rdlane(bb, jx + 1) + v * rdlane(k, jx + 1); y1 += S[jx + 1] * rdlane(r, jx + 1); }
            Y[o] = y0 + y1;
            o = on; r = rn; w = wn; k = kn; v = vn; kk = kkn; bb = bbn;
        }
        f32x4* so = (f32x4*)(C.out + (smp ? OUT_WKVS : OUT_WKVP) + (((size_t)seq * RH + h) * RN + lane) * RN);
        if (!PROBE)
#pragma unroll
        for (int i = 0; i < 16; ++i) so[i] = (f32x4){S[4 * i], S[4 * i + 1], S[4 * i + 2], S[4 * i + 3]};
    }
}
template <bool PROMPT, bool SAMPLE> __device__ __forceinline__ void p5_select(const Ctx& C) {
    const float* SC = (const float*)(C.ws + WS_SC); unsigned* MASK = (unsigned*)(C.ws + WS_MASK);
    const int lane = C.lane;
    if (PROMPT) for (int row = C.gw; row < MP; row += C.ngw) {
        const int t = row & (T - 1); const float* sp = SC + (size_t)row * T;
        unsigned key[32];
#pragma unroll
        for (int j = 0; j < 32; ++j) { const int s = 64 * j + lane; key[j] = (s <= t) ? sortable(sp[s]) : 0u; }
        unsigned Tk = 0u; int need = 0;
        const bool all = (t + 1 <= TOPK);
        if (!all) {
            for (int bit = 31; bit >= 0; --bit) { const unsigned cand = Tk | (1u << bit); int cnt = 0;
#pragma unroll
                for (int j = 0; j < 32; ++j) cnt += __builtin_popcountll(__ballot(key[j] >= cand));
                if (cnt >= TOPK) Tk = cand; }
            int cgt = 0;
#pragma unroll
            for (int j = 0; j < 32; ++j) cgt += __builtin_popcountll(__ballot(key[j] > Tk));
            need = TOPK - cgt;
        }
        int running = 0;
#pragma unroll
        for (int j = 0; j < 32; ++j) {
            const int s = 64 * j + lane; bool take;
            if (all) take = (s <= t);
            else { const bool gt = key[j] > Tk, eq = key[j] == Tk; const unsigned long long eqb = __ballot(eq);
                const int pre = __builtin_popcountll(eqb & lanemask_lt(lane)); take = gt || (eq && (running + pre < need)); running += __builtin_popcountll(eqb); }
            const unsigned long long mb = __ballot(take);
            if (lane == 0) { MASK[(size_t)row * 64 + 2 * j] = (unsigned)mb; MASK[(size_t)row * 64 + 2 * j + 1] = (unsigned)(mb >> 32); }
        }
    }
    const float* SCS = (const float*)(C.ws + WS_SCS); int* SLIST = (int*)(C.ws + WS_SLIST);
    LAS int* sh = (LAS int*)C.lds;
    if (SAMPLE) for (int j = blockIdx.x; j < NSMP; j += C.G) {
        unsigned key[17];
#pragma unroll
        for (int i = 0; i < 17; ++i) { const int s = i * NTHREADS + C.tid; key[i] = (s < LS) ? sortable(SCS[(size_t)j * SCS_LD + s]) : 0u; }
        unsigned Tk = 0u;
        for (int bit = 31; bit >= 0; --bit) { const unsigned cand = Tk | (1u << bit); int c = 0;
#pragma unroll
            for (int i = 0; i < 17; ++i) c += (key[i] >= cand) ? 1 : 0;
            c = wave_sum_i(c);
            __syncthreads(); if (lane == 0) sh[C.wave] = c; __syncthreads();
            int cnt = 0;
#pragma unroll
            for (int w = 0; w < 8; ++w) cnt += sh[w];
            if (cnt >= TOPK) Tk = cand; }
        int cg = 0;
#pragma unroll
        for (int i = 0; i < 17; ++i) cg += (key[i] > Tk) ? 1 : 0;
        cg = wave_sum_i(cg);
        __syncthreads(); if (lane == 0) sh[C.wave] = cg; __syncthreads();
        int cgt = 0;
#pragma unroll
        for (int w = 0; w < 8; ++w) cgt += sh[w];
        const int need = TOPK - cgt;
        int run_eq = 0, run_sel = 0;
#pragma unroll
        for (int i = 0; i < 17; ++i) {
            const int s = i * NTHREADS + C.tid; const bool gt = key[i] > Tk, eq = key[i] == Tk;
            const unsigned long long eqb = __ballot(eq);
            __syncthreads(); if (lane == 0) sh[C.wave] = __builtin_popcountll(eqb); __syncthreads();
            int eq_before = 0, eq_tot = 0;
#pragma unroll
            for (int w = 0; w < 8; ++w) { const int x = sh[w]; eq_tot += x; if (w < C.wave) eq_before += x; }
            const bool take = gt || (eq && (run_eq + eq_before + __builtin_popcountll(eqb & lanemask_lt(lane)) < need));
            const unsigned long long tb = __ballot(take);
            __syncthreads(); if (lane == 0) sh[8 + C.wave] = __builtin_popcountll(tb); __syncthreads();
            int s_before = 0, s_tot = 0;
#pragma unroll
            for (int w = 0; w < 8; ++w) { const int x = sh[8 + w]; s_tot += x; if (w < C.wave) s_before += x; }
            const int pos = run_sel + s_before + __builtin_popcountll(tb & lanemask_lt(lane));
            if (take && pos < TOPK) SLIST[j * TOPK + pos] = s;
            run_eq += eq_tot; run_sel += s_tot;
        }
    }
    __syncthreads();
}
template <int DIFFK> __device__ __forceinline__ void p5_rwfinal(const Ctx& C) {
    const float* Rr = (const float*)(C.ws + WS_RWA), *Kp = (const float*)(C.ws + WS_RWA + 2 * RWA_STRIDE), *Vv = (const float*)(C.ws + WS_RWA + 3 * RWA_STRIDE), *Gg = (const float*)(C.ws + WS_RWA + 6 * RWA_STRIDE);
    const float* Y = (const float*)(C.ws + WS_Y); bf16* MIX = (bf16*)(C.ws + WS_MIX);
    const float* r_k = C.in[25]; const float* ln_w = C.in[26]; const float* ln_b = C.in[27];
    const int lane = C.lane;
    for (int m = C.gw; m < MT; m += C.ngw) {
        for (int h = 0; h < RH; ++h) {
            const int c = h * 64 + lane; const size_t o = (size_t)m * RW_W + c;
            float y = Y[o];
            if (DIFFK != 0 && m < MP) y += (float)DIFFK * (y - ((const float*)(C.ws + WS_Y2))[o]);
            const float mu = wave_sum(y) * (1.f / 64.f); const float dy = y - mu; const float var = wave_sum(dy * dy) * (1.f / 64.f);
            const float yn = dy * (1.f / sqrtf(var + GN_EPS)) * ln_w[c] + ln_b[c];
            const float bonus = wave_sum(Rr[o] * Kp[o] * r_k[c]) * Vv[o];
            MIX[(size_t)m * D + ATT_W + c] = (bf16)f2bf((yn + bonus) * Gg[o]);
        }
    }
}
__device__ __forceinline__ void p6_masktr(const Ctx& C) {
    const unsigned* MASK = (const unsigned*)(C.ws + WS_MASK); unsigned long long* MASKT = (unsigned long long*)(C.ws + WS_MASKT);
    const int lane = C.lane, q = lane & 31, hi = lane >> 5;
    for (int wu = C.gw; wu < NB * 64 * 32; wu += C.ngw) {
        const int j = wu & 31, qg = (wu >> 5) & 63, b = wu >> 11;
        const size_t row = (size_t)b * T + 32 * qg + q;
        const unsigned w0 = MASK[row * 64 + 2 * j], w1 = MASK[row * 64 + 2 * j + 1];
        unsigned long long mine = 0ull;
#pragma unroll
        for (int r = 0; r < 16; ++r) { const int c = (r & 3) + 8 * (r >> 2) + 4 * hi;
            const unsigned long long W0 = __ballot((w0 >> c) & 1u), W1 = __ballot((w1 >> c) & 1u);
            if (lane == r) mine = W0; if (lane == 16 + r) mine = W1; }
        if (lane < 32) MASKT[((size_t)((b * 64 + qg) * 32 + j)) * 32 + lane] = mine;
    }
}
template <int DIFFK> __device__ __forceinline__ void p6_attn(const Ctx& C, int u_begin, int u_end) {
    const unsigned* MASK = (const unsigned*)(C.ws + WS_MASK); const int* SLIST = (const int*)(C.ws + WS_SLIST); const float* QN = (const float*)(C.ws + WS_QN);
    bf16* MIX = (bf16*)(C.ws + WS_MIX); const int* pt = (const int*)C.in[7];
    LAS int* list = (LAS int*)C.lds;
    LAS float* pb = (LAS float*)(C.lds + 1024);
    LAS int* cntp = (LAS int*)(C.lds + 1024 + 8192);
    const int lane = C.lane, h = C.wave;
    for (int u = u_begin + blockIdx.x; u < u_end; u += C.G) {
        const bool smp = u >= MP; const int j = u - MP, b = u >> 11;
        __syncthreads();
        if (C.wave == 0) {
            if (!smp) { const unsigned w = MASK[(size_t)u * 64 + lane]; const int c = __builtin_popcount(w);
                int incl = c;
#pragma unroll
                for (int o = 1; o < 64; o <<= 1) { const int x = __shfl_up(incl, o); if (lane >= o) incl += x; }
                int pos = incl - c; unsigned ww = w;
                while (ww) { const int bit = __builtin_ctz(ww); ww &= ww - 1u; list[pos++] = 32 * lane + bit; }
                if (lane == 63) *cntp = incl; }
            else { for (int i = 0; i < 4; ++i) list[i * 64 + lane] = SLIST[j * TOPK + i * 64 + lane]; if (lane == 0) *cntp = TOPK; }
        }
        __syncthreads();
        int cnt = *cntp; if (cnt > TOPK) cnt = TOPK;
        float q[64];
        { const f32x4* qp = (const f32x4*)(QN + (size_t)u * ATT_W + h * 64);
#pragma unroll
          for (int i = 0; i < 16; ++i) { const f32x4 v = qp[i]; q[4 * i] = v.x; q[4 * i + 1] = v.y; q[4 * i + 2] = v.z; q[4 * i + 3] = v.w; } }
        float sc[4]; float mx = -INFINITY;
#pragma unroll
        for (int i = 0; i < 4; ++i) { const int idx = i * 64 + lane; sc[i] = -INFINITY;
            if (idx < cnt) { const int s = list[idx]; const float* kp;
                if (!smp) kp = C.out + OUT_KP + ((size_t)(b * T + s)) * ATT_W + h * 64;
                else if (s < PAST) kp = C.in[2] + ((size_t)pt[j * NPAGES + (s >> 7)] * PAGE + (s & 127)) * ATT_W + h * 64;
                else kp = C.out + OUT_KS + (size_t)j * ATT_W + h * 64;
                float d = 0.f;
#pragma unroll
                for (int e = 0; e < 16; ++e) { const f32x4 kv = ((const f32x4*)kp)[e]; d += q[4 * e] * kv.x + q[4 * e + 1] * kv.y + q[4 * e + 2] * kv.z + q[4 * e + 3] * kv.w; }
                sc[i] = d * 0.125f; }
            mx = fmaxf(mx, sc[i]); }
        mx = wave_max(mx); float l = 0.f;
#pragma unroll
        for (int i = 0; i < 4; ++i) { const int idx = i * 64 + lane; const float p = (idx < cnt) ? expf(sc[i] - mx) : 0.f; pb[h * 256 + idx] = p; l += p; }
        l = wave_sum(l);
        LDS_WAIT(); asm volatile("" ::: "memory");
        float o = 0.f;
        for (int kx = 0; kx < cnt; ++kx) { const int s = list[kx]; const float* vp;
            if (!smp) vp = C.out + OUT_VP + ((size_t)(b * T + s)) * ATT_W + h * 64;
            else if (s < PAST) vp = C.in[3] + ((size_t)pt[j * NPAGES + (s >> 7)] * PAGE + (s & 127)) * ATT_W + h * 64;
            else vp = C.out + OUT_VS + (size_t)j * ATT_W + h * 64;
            o += pb[h * 256 + kx] * vp[lane]; }
        if (DIFFK == 0) MIX[(size_t)u * D + h * 64 + lane] = (bf16)f2bf(o / l);
        else { const float a = __builtin_bit_cast(float, (unsigned)MIX[(size_t)u * D + h * 64 + lane] << 16); MIX[(size_t)u * D + h * 64 + lane] = (bf16)f2bf(a + (float)DIFFK * (a - o / l)); }
    }
    __syncthreads();
}
__device__ __forceinline__ void p8_res_norm2(const Ctx& C) {
    const float* X1 = (const float*)(C.ws + WS_X1); bf16* A2 = (bf16*)(C.ws + WS_A2); const float* MOD = (const float*)(C.ws + WS_MOD);
    for (int m = C.gw; m < MPAD; m += C.ngw) {
        bf16* orow = A2 + (size_t)m * D;
        if (m >= MT) { GAS unsigned long long* o8 = (GAS unsigned long long*)orow + C.lane;
#pragma unroll
            for (int j = 0; j < 4; ++j) o8[64 * j] = 0ull;
            continue; }
        const float* md = MOD + mod_row(m) * MODW;
        norm_mod_row(C, m, X1 + (size_t)m * D, C.in[11], md + 3 * D, md + 4 * D, orow);
    }
}
__device__ __forceinline__ void p10_swiglu(const Ctx& C) {
    const float* RAW2 = (const float*)(C.ws + WS_RAW2); bf16* HB = (bf16*)(C.ws + WS_HB);
    const size_t total = (size_t)MPAD * (FFN / 4);
    for (size_t i = (size_t)blockIdx.x * NTHREADS + C.tid; i < total; i += (size_t)C.G * NTHREADS) {
        const size_t m = i / (FFN / 4); const int c = (int)(i % (FFN / 4)) * 4;
        const f32x4 g = *(const f32x4*)(RAW2 + m * NGU + c), u = *(const f32x4*)(RAW2 + m * NGU + FFN + c);
        const float h0 = g.x / (1.f + expf(-g.x)) * u.x, h1 = g.y / (1.f + expf(-g.y)) * u.y, h2 = g.z / (1.f + expf(-g.z)) * u.z, h3 = g.w / (1.f + expf(-g.w)) * u.w;
        *(unsigned long long*)(HB + m * FFN + c) = (unsigned long long)pk2(h0, h1) | ((unsigned long long)pk2(h2, h3) << 32);
    }
}
__device__ __forceinline__ void p12_final(const Ctx& C) {
    const float* RAW = (const float*)(C.ws + WS_RAW); const float* X1 = (const float*)(C.ws + WS_X1); const float* MOD = (const float*)(C.ws + WS_MOD);
    for (int m = C.gw; m < MT; m += C.ngw) {
        const float* md = MOD + mod_row(m) * MODW;
        float* yo = C.out + (m < MP ? OUT_Y + (size_t)m * D : OUT_YS + (size_t)(m - MP) * D);
#pragma unroll
        for (int j = 0; j < 4; ++j) { const int c = 4 * (C.lane + 64 * j);
            const f32x4 xv = *(const f32x4*)(X1 + (size_t)m * D + c), rv = *(const f32x4*)(RAW + (size_t)m * D + c), g2 = *(const f32x4*)(md + 5 * D + c);
            *(f32x4*)(yo + c) = xv + g2 * rv; }
    }
}

namespace rw {
typedef short bf16x8 __attribute__((ext_vector_type(8)));
typedef short s16x4 __attribute__((ext_vector_type(4)));
typedef float f32x16 __attribute__((ext_vector_type(16)));
typedef float f32x4v __attribute__((ext_vector_type(4)));
typedef unsigned u32x2 __attribute__((ext_vector_type(2)));
typedef unsigned u32x4v __attribute__((ext_vector_type(4)));
constexpr int NCH = T / 64;
constexpr int IMG = 16384;
constexpr int A32_OFF = 6 * IMG, TL_OFF = A32_OFF + 16384, WC_OFF = TL_OFF + 16384;
enum { H_AT = 0, H_BT = 1, H_KT = 2, H_RT = 3, H_VT = 4, H_AAK = 5, H_ARB = 6, H_ARK = 7, H_XT = 8, H_TT = 9, H_QT = 10, H_PT = 11 };
__device__ __forceinline__ unsigned off_b(unsigned row, unsigned ch) { return 256u * row + 16u * (ch ^ (((row & 3) << 2) | ((row >> 2) & 3))); }
__device__ __forceinline__ int crow(int r, int hi) { return (r & 3) + 8 * (r >> 2) + 4 * hi; }
__device__ __forceinline__ unsigned cvt2(float lo, float hi) { typedef float f2 __attribute__((ext_vector_type(2))); typedef __bf16 b2 __attribute__((ext_vector_type(2))); f2 v = {lo, hi}; b2 b = __builtin_convertvector(v, b2); return __builtin_bit_cast(unsigned, b); }
__device__ __forceinline__ bf16x8 frag_row(LAS unsigned char* lds, int H, int blk, int s, int lane) {
    return *(const LAS bf16x8*)(lds + (H >> 1) * IMG + off_b(32 * blk + (lane & 31), 8 * (H & 1) + 2 * s + (lane >> 5)));
}
__device__ __forceinline__ bf16x8 frag_tr(LAS unsigned char* lds, int H, int blk, int ks, int lane) {
    const unsigned h = lane >> 5, b2 = (lane >> 4) & 1, q = (lane & 15) >> 2, p = lane & 3, c = 2 * (H & 1) + blk;
    typedef short v4i16_t __attribute__((ext_vector_type(4)));
    LAS unsigned char* base = lds + (H >> 1) * IMG;
    const s16x4 lo = __builtin_bit_cast(s16x4, __builtin_amdgcn_ds_read_tr16_b64_v4i16((LAS v4i16_t*)(base + off_b(16 * ks + 8 * h + q, 4 * c + 2 * b2 + (p >> 1)) + 8 * (p & 1))));
    const s16x4 hi = __builtin_bit_cast(s16x4, __builtin_amdgcn_ds_read_tr16_b64_v4i16((LAS v4i16_t*)(base + off_b(16 * ks + 8 * h + 4 + q, 4 * c + 2 * b2 + (p >> 1)) + 8 * (p & 1))));
    return (bf16x8){lo[0], lo[1], lo[2], lo[3], hi[0], hi[1], hi[2], hi[3]};
}
template <bool ATR, bool BTR> __device__ __forceinline__ f32x16 mm_tile(LAS unsigned char* lds, int HA, int ablk, int HB, int bblk, f32x16 acc, int lane) {
#pragma unroll
    for (int s = 0; s < 4; ++s) {
        const bf16x8 a = ATR ? frag_tr(lds, HA, ablk, s, lane) : frag_row(lds, HA, ablk, s, lane);
        const bf16x8 b = BTR ? frag_tr(lds, HB, bblk, s, lane) : frag_row(lds, HB, bblk, s, lane);
        acc = __builtin_amdgcn_mfma_f32_32x32x16_bf16(a, b, acc, 0, 0, 0);
    }
    return acc;
}
__device__ __forceinline__ void store_tr(LAS unsigned char* lds, int H, int rblk, int cblk, const f32x16& acc, int lane) {
    LAS unsigned char* base = lds + (H >> 1) * IMG; const int hi = lane >> 5, row = 32 * cblk + (lane & 31);
#pragma unroll
    for (int g = 0; g < 4; ++g) { u32x2 w; w.x = cvt2(acc[4 * g], acc[4 * g + 1]); w.y = cvt2(acc[4 * g + 2], acc[4 * g + 3]);
        *(LAS u32x2*)(base + off_b(row, 8 * (H & 1) + 4 * rblk + g) + 8 * hi) = w; }
}
__device__ __forceinline__ u32x4v pack8(const f32x16& a, int s) { u32x4v w; w.x = cvt2(a[8 * s], a[8 * s + 1]); w.y = cvt2(a[8 * s + 2], a[8 * s + 3]); w.z = cvt2(a[8 * s + 4], a[8 * s + 5]); w.w = cvt2(a[8 * s + 6], a[8 * s + 7]); return w; }

struct Bufs { bf16* LIN; bf16* W2T; bf16* A2T; bf16* G2T; float* RX; float* KX; float* VX; float* KKN; float* KP; float* G;
              u32x4v* MF; float* NT; u32x4v* PF; float* QP; u32x4v* ZF; float* Y; };

__device__ __forceinline__ void r1_unit(const Ctx& C, const Bufs& B, int b, int h, int c) {
    LAS unsigned char* lds = C.lds; const int lane = C.lane, wave = C.wave, hi = lane >> 5;
    const size_t row0 = (size_t)b * T + 64 * c; const int ci = (b * RH + h) * NCH + c;
    LAS float* A32 = (LAS float*)(lds + A32_OFF); LAS float* WC = (LAS float*)(lds + WC_OFF);
    typedef float f32x4a __attribute__((ext_vector_type(4)));
    { const int nl = lane & 15, q = lane >> 4;
      if (wave < 4) {
        const int n = 16 * wave + nl, col = h * 64 + n;
        f32x4a aw[4], aa[4];
#pragma unroll
        for (int tt = 0; tt < 4; ++tt) { aw[tt] = (f32x4a){0.f, 0.f, 0.f, 0.f}; aa[tt] = aw[tt]; }
#pragma unroll
        for (int s = 0; s < 2; ++s) {
            const bf16x8 bw = *(const bf16x8*)(B.W2T + (size_t)col * 64 + 32 * s + 8 * q), ba = *(const bf16x8*)(B.A2T + (size_t)col * 64 + 32 * s + 8 * q);
#pragma unroll
            for (int tt = 0; tt < 4; ++tt) { const bf16* lp = B.LIN + (row0 + 16 * tt + nl) * 256 + 32 * s + 8 * q;
                aw[tt] = __builtin_amdgcn_mfma_f32_16x16x32_bf16(*(const bf16x8*)lp, bw, aw[tt], 0, 0, 0);
                aa[tt] = __builtin_amdgcn_mfma_f32_16x16x32_bf16(*(const bf16x8*)(lp + 64), ba, aa[tt], 0, 0, 0); }
        }
        const float w0c = C.in[18][col], a0c = C.in[20][col], kac = C.in[24][col];
        float lw[4][4], av[4][4];
#pragma unroll
        for (int tt = 0; tt < 4; ++tt)
#pragma unroll
            for (int e = 0; e < 4; ++e) { lw[tt][e] = -0.6065306597126334f / (1.f + __expf(-(w0c + aw[tt][e]))); av[tt][e] = 1.f / (1.f + __expf(-(a0c + aa[tt][e]))); }
        float tot[4], L[4][4];
#pragma unroll
        for (int tt = 0; tt < 4; ++tt) { L[tt][0] = lw[tt][0]; L[tt][1] = L[tt][0] + lw[tt][1]; L[tt][2] = L[tt][1] + lw[tt][2]; L[tt][3] = L[tt][2] + lw[tt][3]; tot[tt] = L[tt][3]; }
        float run = 0.f;
#pragma unroll
        for (int tt = 0; tt < 4; ++tt) { float basev = run;
#pragma unroll
            for (int qq = 0; qq < 4; ++qq) { const float o = __shfl(tot[tt], nl + 16 * qq); if (qq < q) basev += o; run += o; }
#pragma unroll
            for (int e = 0; e < 4; ++e) L[tt][e] += basev; }
        if (q == 3) WC[n] = __expf(L[3][3]);
#pragma unroll
        for (int tt = 0; tt < 4; ++tt) {
            asm volatile("" ::: "memory");
            float at[4], bt[4], kt[4], rt[4];
#pragma unroll
            for (int e = 0; e < 4; ++e) { const size_t o = (row0 + 16 * tt + 4 * q + e) * RW_W + col;
                const float rx = B.RX[o], kx = B.KX[o], kkn = B.KKN[o];
                const float kp = kx * (1.f + (av[tt][e] - 1.f) * kac); B.KP[o] = kp;
                const float eL = __expf(L[tt][e]), eLm = __expf(-L[tt][e]), eLex = __expf(L[tt][e] - lw[tt][e]);
                at[e] = -kkn * eLex; bt[e] = kkn * av[tt][e] * eLm; kt[e] = kp * eLm; rt[e] = rx * eL; }
            const unsigned ch = 2 * tt + (q >> 1), bo = 8 * (q & 1);
            u32x2 w;
            w.x = cvt2(at[0], at[1]); w.y = cvt2(at[2], at[3]); *(LAS u32x2*)(lds + 0 * IMG + off_b(n, ch) + bo) = w;
            w.x = cvt2(bt[0], bt[1]); w.y = cvt2(bt[2], bt[3]); *(LAS u32x2*)(lds + 0 * IMG + off_b(n, 8 + ch) + bo) = w;
            w.x = cvt2(kt[0], kt[1]); w.y = cvt2(kt[2], kt[3]); *(LAS u32x2*)(lds + 1 * IMG + off_b(n, ch) + bo) = w;
            w.x = cvt2(rt[0], rt[1]); w.y = cvt2(rt[2], rt[3]); *(LAS u32x2*)(lds + 1 * IMG + off_b(n, 8 + ch) + bo) = w;
        }
      } else {
        const int n = 16 * (wave - 4) + nl, col = h * 64 + n;
        f32x4a ag[4];
#pragma unroll
        for (int tt = 0; tt < 4; ++tt) ag[tt] = (f32x4a){0.f, 0.f, 0.f, 0.f};
#pragma unroll
        for (int s = 0; s < 4; ++s) { const bf16x8 bg = *(const bf16x8*)(B.G2T + (size_t)col * 128 + 32 * s + 8 * q);
#pragma unroll
            for (int tt = 0; tt < 4; ++tt) ag[tt] = __builtin_amdgcn_mfma_f32_16x16x32_bf16(*(const bf16x8*)(B.LIN + (row0 + 16 * tt + nl) * 256 + 128 + 32 * s + 8 * q), bg, ag[tt], 0, 0, 0); }
#pragma unroll
        for (int tt = 0; tt < 4; ++tt) { float vt[4];
#pragma unroll
            for (int e = 0; e < 4; ++e) { const size_t o = (row0 + 16 * tt + 4 * q + e) * RW_W + col; B.G[o] = ag[tt][e]; vt[e] = B.VX[o]; }
            u32x2 w; w.x = cvt2(vt[0], vt[1]); w.y = cvt2(vt[2], vt[3]);
            *(LAS u32x2*)(lds + 2 * IMG + off_b(n, 2 * tt + (q >> 1)) + 8 * (q & 1)) = w; }
      }
    }
    __syncthreads();
#pragma unroll
    for (int k2 = 0; k2 < 2; ++k2) {
        const int id = 2 * wave + k2, prod = id >> 2, tb = (id >> 1) & 1, jb = id & 1;
        f32x16 acc = f32x16{};
        if (prod == 0) acc = mm_tile<true, true>(lds, H_AT, tb, H_BT, jb, acc, lane);
        else if (prod == 1) acc = mm_tile<true, true>(lds, H_AT, tb, H_KT, jb, acc, lane);
        else if (prod == 2) acc = mm_tile<true, true>(lds, H_BT, jb, H_RT, tb, acc, lane);
        else acc = mm_tile<true, true>(lds, H_KT, jb, H_RT, tb, acc, lane);
        if (prod < 2) {
#pragma unroll
            for (int r = 0; r < 16; ++r) { const int t = 32 * tb + crow(r, hi), j = 32 * jb + (lane & 31); if (!(j < t)) acc[r] = 0.f; }
            if (prod == 0) {
#pragma unroll
                for (int r = 0; r < 16; ++r) A32[(32 * tb + crow(r, hi)) * 64 + 32 * jb + (lane & 31)] = acc[r]; }
            else store_tr(lds, H_AAK, tb, jb, acc, lane);
        } else {
#pragma unroll
            for (int r = 0; r < 16; ++r) { const int j = 32 * jb + crow(r, hi), t = 32 * tb + (lane & 31); if (!(j <= t)) acc[r] = 0.f; }
            store_tr(lds, prod == 2 ? H_ARB : H_ARK, jb, tb, acc, lane);
        }
    }
    __syncthreads();
    if (wave == 0) {
        LAS float* TL = (LAS float*)(lds + TL_OFF);
        for (int t = 0; t < 64; ++t) TL[t * 64 + lane] = 0.f;
        for (int t = 0; t < 64; ++t) {
            float s0 = (t == lane) ? 1.f : 0.f, s1 = 0.f;
            for (int j4 = 0; j4 < t; j4 += 4) { const f32x4a a4 = *(const LAS f32x4a*)(A32 + t * 64 + j4);
                s0 += a4[0] * TL[j4 * 64 + lane]; s1 += a4[1] * TL[(j4 + 1) * 64 + lane]; s0 += a4[2] * TL[(j4 + 2) * 64 + lane]; s1 += a4[3] * TL[(j4 + 3) * 64 + lane]; }
            TL[t * 64 + lane] = s0 + s1;
        }
#pragma unroll
        for (int g = 0; g < 8; ++g) { float v[8];
#pragma unroll
            for (int e = 0; e < 8; ++e) v[e] = TL[(8 * g + e) * 64 + lane];
            u32x4v w; w.x = cvt2(v[0], v[1]); w.y = cvt2(v[2], v[3]); w.z = cvt2(v[4], v[5]); w.w = cvt2(v[6], v[7]);
            *(LAS u32x4v*)(lds + (H_TT >> 1) * IMG + off_b(lane, 8 * (H_TT & 1) + g)) = w; }
    } else
    if (wave >= 1 && wave <= 4) {
        const int tb = (wave - 1) >> 1, ib = (wave - 1) & 1;
        f32x16 acc = mm_tile<true, false>(lds, H_AAK, tb, H_VT, ib, f32x16{}, lane);
        store_tr(lds, H_XT, tb, ib, acc, lane);
    }
    __syncthreads();
    { const int tb = (wave >> 1) & 1, cb = wave & 1;
      if (wave < 4) { f32x16 acc = mm_tile<true, false>(lds, H_TT, tb, H_AT, cb, f32x16{}, lane); store_tr(lds, H_PT, tb, cb, acc, lane); }
      else { f32x16 acc = mm_tile<true, false>(lds, H_TT, tb, H_XT, cb, f32x16{}, lane); store_tr(lds, H_QT, tb, cb, acc, lane); } }
    __syncthreads();
#pragma unroll
    for (int k2 = 0; k2 < 2; ++k2) {
        const int id = 2 * wave + k2, prod = id >> 2, rb = (id >> 1) & 1, cb = id & 1;
        f32x16 acc = f32x16{};
        if (prod == 0) {
            acc = mm_tile<false, false>(lds, H_PT, rb, H_BT, cb, acc, lane);
            const float wc = WC[32 * cb + (lane & 31)];
#pragma unroll
            for (int r = 0; r < 16; ++r) { const int n = 32 * rb + crow(r, hi), m = 32 * cb + (lane & 31); acc[r] = (acc[r] + (n == m ? 1.f : 0.f)) * wc; }
            u32x4v* o = B.MF + ((size_t)ci * 8 + (cb * 2 + rb) * 2) * 64 + lane;
            o[0] = pack8(acc, 0); o[64] = pack8(acc, 1);
        } else if (prod == 1) {
            acc = mm_tile<false, false>(lds, H_BT, rb, H_QT, cb, acc, lane);
            acc = mm_tile<false, false>(lds, H_KT, rb, H_VT, cb, acc, lane);
#pragma unroll
            for (int g = 0; g < 4; ++g) { const f32x4a w4 = *(const LAS f32x4a*)(WC + 32 * rb + 8 * g + 4 * hi);
                f32x4a v = {acc[4 * g] * w4[0], acc[4 * g + 1] * w4[1], acc[4 * g + 2] * w4[2], acc[4 * g + 3] * w4[3]};
                *(f32x4a*)(B.NT + (((size_t)ci * 4 + rb * 2 + cb) * 64 + lane) * 16 + 4 * g) = v; }
        } else if (prod == 2) {
            acc = mm_tile<false, false>(lds, H_PT, rb, H_ARB, cb, acc, lane);
#pragma unroll
            for (int s = 0; s < 4; ++s) { bf16x8 idf;
#pragma unroll
                for (int e = 0; e < 8; ++e) idf[e] = (16 * s + 8 * hi + e == 32 * cb + (lane & 31)) ? (short)0x3f80 : (short)0;
                acc = __builtin_amdgcn_mfma_f32_32x32x16_bf16(frag_row(lds, H_RT, rb, s, lane), idf, acc, 0, 0, 0); }
            u32x4v* o = B.PF + ((size_t)ci * 8 + (cb * 2 + rb) * 2) * 64 + lane;
            o[0] = pack8(acc, 0); o[64] = pack8(acc, 1);
        } else {
            acc = mm_tile<false, false>(lds, H_ARB, rb, H_QT, cb, acc, lane);
            acc = mm_tile<false, false>(lds, H_ARK, rb, H_VT, cb, acc, lane);
#pragma unroll
            for (int g = 0; g < 4; ++g) *(f32x4a*)(B.QP + (((size_t)ci * 4 + rb * 2 + cb) * 64 + lane) * 16 + 4 * g) = (f32x4a){acc[4 * g], acc[4 * g + 1], acc[4 * g + 2], acc[4 * g + 3]};
        }
    }
    __syncthreads();
}
__device__ __forceinline__ void r1_phase(const Ctx& C, const Bufs& B) {
    for (int u = blockIdx.x; u < NB * RH * NCH; u += C.G) { const int c = u & (NCH - 1), h = (u >> 5) & 7, b = u >> 8; r1_unit(C, B, b, h, c); }
}
__device__ __forceinline__ void r2_chain(const Ctx& C, const Bufs& B, int k) {
    const int lane = C.lane, hi = lane >> 5, ib = k & 1, bh = k >> 1;
    f32x16 z[2]; z[0] = f32x16{}; z[1] = f32x16{};
    typedef float f32x4a __attribute__((ext_vector_type(4)));
    for (int c = 0; c < NCH; ++c) {
        const size_t ci = (size_t)bh * NCH + c;
        u32x4v bf[2][2];
#pragma unroll
        for (int nb = 0; nb < 2; ++nb)
#pragma unroll
            for (int s = 0; s < 2; ++s) { bf[nb][s] = pack8(z[nb], s); B.ZF[((ci * 2 + ib) * 4 + nb * 2 + s) * 64 + lane] = bf[nb][s]; }
        f32x16 zn[2];
#pragma unroll
        for (int mb = 0; mb < 2; ++mb) {
            const float* np = B.NT + ((ci * 4 + mb * 2 + ib) * 64 + lane) * 16;
#pragma unroll
            for (int g = 0; g < 4; ++g) { const f32x4a v = *(const f32x4a*)(np + 4 * g); zn[mb][4 * g] = v[0]; zn[mb][4 * g + 1] = v[1]; zn[mb][4 * g + 2] = v[2]; zn[mb][4 * g + 3] = v[3]; }
#pragma unroll
            for (int nb = 0; nb < 2; ++nb)
#pragma unroll
                for (int s = 0; s < 2; ++s) { const u32x4v af = B.MF[(ci * 8 + (mb * 2 + nb) * 2 + s) * 64 + lane];
                    zn[mb] = __builtin_amdgcn_mfma_f32_32x32x16_bf16(__builtin_bit_cast(bf16x8, af), __builtin_bit_cast(bf16x8, bf[nb][s]), zn[mb], 0, 0, 0); }
        }
        z[0] = zn[0]; z[1] = zn[1];
    }
    float* so = C.out + OUT_WKVP + ((size_t)bh * RN + 32 * ib + (lane & 31)) * RN;
#pragma unroll
    for (int nb = 0; nb < 2; ++nb)
#pragma unroll
        for (int g = 0; g < 4; ++g) *(f32x4a*)(so + 32 * nb + 8 * g + 4 * hi) = (f32x4a){z[nb][4 * g], z[nb][4 * g + 1], z[nb][4 * g + 2], z[nb][4 * g + 3]};
}
__device__ __forceinline__ void r3_phase(const Ctx& C, const Bufs& B) {
    const int lane = C.lane, hi = lane >> 5;
    typedef float f32x4a __attribute__((ext_vector_type(4)));
    for (int wu = C.gw; wu < NB * RH * NCH * 2; wu += C.ngw) {
        const int tb = wu & 1; const size_t ci = (size_t)(wu >> 1); const int c = (int)(ci & (NCH - 1)), bh = (int)(ci >> 5), h = bh & 7, b = bh >> 3;
        u32x4v pf[2][2];
#pragma unroll
        for (int nb = 0; nb < 2; ++nb)
#pragma unroll
            for (int s = 0; s < 2; ++s) pf[nb][s] = B.PF[(ci * 8 + (tb * 2 + nb) * 2 + s) * 64 + lane];
#pragma unroll
        for (int ib = 0; ib < 2; ++ib) {
            f32x16 y; const float* qp = B.QP + ((ci * 4 + tb * 2 + ib) * 64 + lane) * 16;
#pragma unroll
            for (int g = 0; g < 4; ++g) { const f32x4a v = *(const f32x4a*)(qp + 4 * g); y[4 * g] = v[0]; y[4 * g + 1] = v[1]; y[4 * g + 2] = v[2]; y[4 * g + 3] = v[3]; }
#pragma unroll
            for (int nb = 0; nb < 2; ++nb)
#pragma unroll
                for (int s = 0; s < 2; ++s) { const u32x4v zf = B.ZF[((ci * 2 + ib) * 4 + nb * 2 + s) * 64 + lane];
                    y = __builtin_amdgcn_mfma_f32_32x32x16_bf16(__builtin_bit_cast(bf16x8, pf[nb][s]), __builtin_bit_cast(bf16x8, zf), y, 0, 0, 0); }
            float* yo = B.Y + ((size_t)b * T + 64 * c + 32 * tb) * RW_W + h * 64 + 32 * ib + (lane & 31);
#pragma unroll
            for (int r = 0; r < 16; ++r) yo[(size_t)crow(r, hi) * RW_W] = y[r];
        }
    }
}
}
constexpr int N_PHASES = 12;
__global__ void __launch_bounds__(NTHREADS, 2) fwd(Args args) {
    extern __shared__ __attribute__((aligned(16))) unsigned char lds[];
    Ctx C;
    C.lds = (LAS unsigned char*)lds;
    C.tid = threadIdx.x; C.lane = C.tid & 63; C.wave = __builtin_amdgcn_readfirstlane(C.tid >> 6);
    C.G = gridDim.x; C.gw = blockIdx.x * NWAVES + C.wave; C.ngw = C.G * NWAVES;
    C.in = args.in; C.out = args.out; C.ws = args.ws;
    const int lo = args.ph_lo, hi = args.ph_hi;
    volatile LAS unsigned* MISC = (volatile LAS unsigned*)(C.lds + MISC_OFF);
    if (C.tid < 32) MISC[C.tid] = 0u;
    __syncthreads();
    XcdBarrier bar = xcd_barrier_post((unsigned*)(C.ws + WS_CTL) + CW_BAR, MISC + 8);
#define IN(k) (lo <= (k) && (k) < hi)
#define SEAM(k) do { if (IN(k) && IN((k) + 1)) xcd_barrier(bar); } while (0)
    if (IN(0)) { p0_mod(C); p0_weights(C); }
    SEAM(0);
    if (IN(1)) { p1_norm1(C); }
    SEAM(1);
    if (IN(2)) {
        pg8::Gemm g{(const pg8::bf16_t*)(C.ws + WS_A1), (const pg8::bf16_t*)(C.ws + WS_WIN), MPAD, NIN, D}; pg8::StaticOrder S; S.init(MPAD, NIN, C.G, (int)blockIdx.x);
        EpiRawF32 E{(float*)(C.ws + WS_PROJ), NIN};
        pg8::gemm_phase<EpiRawF32, pg8::StaticOrder, true, true>(C.lds, g, S, E);
    }
    SEAM(2);
    rw::Bufs RB;
    RB.LIN = (bf16*)(C.ws + WS_LIN); RB.W2T = (bf16*)(C.ws + WS_W2T); RB.A2T = (bf16*)(C.ws + WS_A2T); RB.G2T = (bf16*)(C.ws + WS_G2T);
    RB.RX = (float*)(C.ws + WS_RWA); RB.KX = (float*)(C.ws + WS_KX); RB.VX = (float*)(C.ws + WS_RWA + 3 * RWA_STRIDE); RB.KKN = (float*)(C.ws + WS_RWA + 4 * RWA_STRIDE);
    RB.KP = (float*)(C.ws + WS_RWA + 2 * RWA_STRIDE); RB.G = (float*)(C.ws + WS_RWA + 6 * RWA_STRIDE);
    RB.MF = (rw::u32x4v*)(C.ws + WS_MF); RB.NT = (float*)(C.ws + WS_NT); RB.PF = (rw::u32x4v*)(C.ws + WS_PF); RB.QP = (float*)(C.ws + WS_QP); RB.ZF = (rw::u32x4v*)(C.ws + WS_ZF); RB.Y = (float*)(C.ws + WS_Y);
#ifdef PROBE_RW
    if (IN(3)) { p3_post(C); p3_rwprep<true>(C); }
    SEAM(3);
    if (IN(4)) { idxsel::phase(C); rw::r1_phase(C, RB); p4_indexer<false, true>(C); p4_scan<false>(C, NB * RH); p4_scan<true>(C, 0); }
#else
    if (IN(3)) { p3_post(C); p3_rwprep<false>(C); }
    SEAM(3);
    if (IN(4)) { idxsel::phase(C); rw::r1_phase(C, RB); p4_indexer<false, true>(C); p4_scan<false>(C, NB * RH); }
#endif
    SEAM(4);
    if (IN(5)) {
        p5_select<false, true>(C);
        if (C.wave == 0 && blockIdx.x < NB * RH * 2) rw::r2_chain(C, RB, (int)blockIdx.x);
        __syncthreads();
        const attn_body::AttnTensors AT{(const attn_body::bf16*)(C.ws + WS_QB), (const attn_body::bf16*)(C.ws + WS_KB), (const attn_body::bf16*)(C.ws + WS_VB), (attn_body::bf16*)(C.ws + WS_MIX), (const unsigned long long*)(C.ws + WS_MASKT)};
        const attn_body::StaticOrder S((int)C.G, (int)blockIdx.x);
        attn_body::attn_phase<attn_body::StaticOrder>((char*)lds, AT, S);
    }
    SEAM(5);
    if (IN(6)) { p6_attn<0>(C, MP, MT); rw::r3_phase(C, RB); }
    SEAM(6);
#ifdef PROBE_RW
    if (IN(7)) { p5_rwfinal<PROBE_RW>(C); }
#else
    if (IN(7)) { p5_rwfinal<0>(C); }
#endif
    SEAM(7);
    if (IN(8)) {
        pg8::Gemm g{(const pg8::bf16_t*)(C.ws + WS_MIX), (const pg8::bf16_t*)(C.ws + WS_WOUT), MP, D, D}; pg8::StaticOrder S; S.init(MP, D, C.G, (int)blockIdx.x);
        EpiResGate E{C.in[0], (const float*)(C.ws + WS_MOD) + 2 * D, (float*)(C.ws + WS_X1)};
        pg8::gemm_phase<EpiResGate, pg8::StaticOrder, true, true>(C.lds, g, S, E);
        const float* xs = C.in[1]; const float* g1 = (const float*)(C.ws + WS_MOD) + (size_t)NB * MODW + 2 * D; float* x1s = (float*)(C.ws + WS_X1) + (size_t)MP * D;
        sample_gemm(C, (const bf16*)(C.ws + WS_MIX) + (size_t)MP * D, (const bf16*)(C.ws + WS_WOUT), D, [&](int row, int col, float v) { x1s[row * D + col] = xs[row * D + col] + g1[(size_t)row * MODW + col] * v; });
    }
    SEAM(8);
    if (IN(9)) { p8_res_norm2(C); }
    SEAM(9);
    if (IN(10)) {
        pg8::Gemm g{(const pg8::bf16_t*)(C.ws + WS_A2), (const pg8::bf16_t*)(C.ws + WS_WGU), MPAD, NGU, D}; pg8::StaticOrder S; S.init(MPAD, NGU, C.G, (int)blockIdx.x);
        EpiSwiGLU E{(bf16*)(C.ws + WS_HB)};
        pg8::gemm_phase<EpiSwiGLU, pg8::StaticOrder, true, true>(C.lds, g, S, E);
    }
    SEAM(10);
    if (IN(11)) {
        pg8::Gemm g{(const pg8::bf16_t*)(C.ws + WS_HB), (const pg8::bf16_t*)(C.ws + WS_WDN), MP, D, FFN}; pg8::StaticOrder S; S.init(MP, D, C.G, (int)blockIdx.x);
        EpiResGate E{(const float*)(C.ws + WS_X1), (const float*)(C.ws + WS_MOD) + 5 * D, C.out + OUT_Y};
        pg8::gemm_phase<EpiResGate, pg8::StaticOrder, true, true>(C.lds, g, S, E);
        const float* x1s = (const float*)(C.ws + WS_X1) + (size_t)MP * D; const float* g2 = (const float*)(C.ws + WS_MOD) + (size_t)NB * MODW + 5 * D; float* ys = C.out + OUT_YS;
        sample_gemm(C, (const bf16*)(C.ws + WS_HB) + (size_t)MP * FFN, (const bf16*)(C.ws + WS_WDN), FFN, [&](int row, int col, float v) { ys[row * D + col] = x1s[row * D + col] + g2[(size_t)row * MODW + col] * v; });
    }
#undef IN
#undef SEAM
}

extern "C" void kernel_launch(void* const* d_in, const int* in_sizes, int n_in, void* d_out, int out_size, void* d_ws, size_t ws_size, hipStream_t stream) {
    static int grid = 0;
    if (grid == 0) {
        if (n_in != 32 || (size_t)out_size != OUT_END || ws_size < WS_END) { fprintf(stderr, "kernel_launch: unexpected sizes n_in %d out %d ws %zu\n", n_in, out_size, ws_size); grid = -1; return; }
        int dev = 0, cus = 0;
        if (hipGetDevice(&dev) != hipSuccess || hipDeviceGetAttribute(&cus, hipDeviceAttributeMultiprocessorCount, dev) != hipSuccess) { grid = -1; return; }
        if (hipFuncSetAttribute((const void*)fwd, hipFuncAttributeMaxDynamicSharedMemorySize, LDS_BYTES) != hipSuccess) { fprintf(stderr, "kernel_launch: hipFuncSetAttribute failed\n"); grid = -1; return; }
        (void)hipGetLastError();
        grid = cus;
    }
    if (grid < 0) return;
    (void)hipMemsetAsync((char*)d_ws + WS_CTL, 0, CTL_ZERO_BYTES, stream);
    Args a{};
    for (int i = 0; i < 32; ++i) a.in[i] = (const float*)d_in[i];
    a.out = (float*)d_out; a.ws = (unsigned char*)d_ws;
    a.ph_lo = 0; a.ph_hi = N_PHASES;
    hipLaunchKernelGGL(fwd, dim3(grid), dim3(NTHREADS), LDS_BYTES, stream, a);
}
```

```cpp
#include <hip/hip_runtime.h>
#include <cstdio>
#include <cstdint>
#include <cmath>
#include <hip/hip_bf16.h>
#define LAS __attribute__((address_space(3)))
namespace pg8 {
#define PG8_LAS __attribute__((address_space(3)))
typedef unsigned short bf16_t;
typedef short bf16x8 __attribute__((ext_vector_type(8)));
typedef float f32x4 __attribute__((ext_vector_type(4)));
typedef unsigned u32x4 __attribute__((ext_vector_type(4)));
constexpr int BM = 256, BK = 64, HALF = 128, HTB = HALF * BK * 2  , STAGE_BYTES = 8 * HTB, NXCD = 8, WGM = 8;

__host__ __device__ __forceinline__ int lds_byte(int r, int c) { const int st = (r >> 4) * 2 + (c >> 5), rr = r & 15, cc = c & 31, ob = rr * 64 + cc * 2; return st * 1024 + (ob ^ (((ob >> 9) & 1) << 5)); }
__host__ __device__ __forceinline__ void stage_rc(int b, int& R, int& C) { const int st = b / 1024, sb = b % 1024, swz = sb ^ (((sb >> 9) & 1) << 5); R = (st >> 1) * 16 + swz / 64; C = (st & 1) * 32 + (swz % 64) / 2; }
__host__ __device__ __forceinline__ int perm32(int rho) { const int n = rho >> 4, i = rho & 15; return 8 * (i >> 2) + 4 * n + (i & 3); }

struct Unit { int pm, pn; };
struct Gemm { const bf16_t* A; const bf16_t* Bt; int M, N, K; };

struct StaticOrder {
    int nM, nN, nwg, G, c;
    __host__ __device__ void init(int M, int N, int G_, int c_) { nM = M / BM; nN = N / BM; nwg = nM * nN; G = G_; c = c_; }
    __host__ __device__ bool next(int i, Unit& u) const {
        const long L = (long)i * G + c; if (L >= nwg) return false;
        int wgid = (int)L; { const int q = nwg / NXCD, r = nwg % NXCD, xcd = wgid % NXCD, off = wgid / NXCD; wgid = (xcd < r ? xcd * (q + 1) : r * (q + 1) + (xcd - r) * q) + off; }
        const int nig = WGM * nN, gid = wgid / nig, fm = gid * WGM, gsz = (nM - fm) < WGM ? (nM - fm) : WGM;
        u.pm = fm + ((wgid % nig) % gsz); u.pn = (wgid % nig) / gsz; return true;
    }
    __device__ __forceinline__ void a_ready(const Unit&) const {}
    __device__ __forceinline__ void done(const Unit&) const {}
};

__device__ __forceinline__ unsigned cvt_pk_bf16(float lo, float hi) { unsigned r; asm volatile("v_cvt_pk_bf16_f32 %0, %1, %2" : "=v"(r) : "v"(lo), "v"(hi)); return r; }
typedef float f32x2 __attribute__((ext_vector_type(2)));
__device__ __forceinline__ f32x2 gelu_pk(f32x2 v) {
    const f32x2 av = __builtin_elementwise_abs(v), d = av * 0.2316418882f + 1.0f;
    f32x2 t; t.x = __builtin_amdgcn_rcpf(d.x); t.y = __builtin_amdgcn_rcpf(d.y);
    f32x2 q = t * 0.5307027145f + (-0.7265760135f); q = q * t + 0.7107068705f; q = q * t + (-0.142248368f); q = q * t + 0.127414796f; q = q * t;
    const f32x2 s = (v * v) * (-0.72134752044f);
    f32x2 e; e.x = __builtin_amdgcn_exp2f(s.x); e.y = __builtin_amdgcn_exp2f(s.y);
    const f32x2 m = v * (q * e), r = v - m;
    f32x2 o; o.x = v.x < 0.f ? m.x : r.x; o.y = v.y < 0.f ? m.y : r.y; return o;
}

template <int ACT  > struct EpiBf16 {
    static constexpr bool PERM = true, AFTER_DRAIN = false; static_assert(ACT == 0 || ACT == 1, "EpiBf16: ACT is 0 (none) or 1 (gelu_pk)");
    bf16_t* O; int ldc; const float* bias; int split_cols; size_t split_stride; float scale0;
    __device__ __forceinline__ void operator()(const f32x4 (&acc)[2][2][4][2], const Unit& u, int wr, int wc, int fr, int fq) const {
        const int row0 = u.pm * BM + wr * 64 + fr; int colt = u.pn * BM; bf16_t* base = O;
        float sc = 1.f; if (split_cols) { const int t = colt / split_cols; base += (size_t)t * split_stride; colt -= t * split_cols; if (t == 0) sc = scale0; }
        const int col0 = colt + wc * 32 + 8 * fq, bcol0 = u.pn * BM + wc * 32 + 8 * fq;
        f32x4 bv[2][2];
#pragma unroll
        for (int bj = 0; bj < 2; ++bj)
#pragma unroll
            for (int n = 0; n < 2; ++n) bv[bj][n] = bias ? *(const f32x4*)(bias + bcol0 + bj * HALF + 4 * n) : (f32x4){0.f, 0.f, 0.f, 0.f};
#pragma unroll
        for (int ai = 0; ai < 2; ++ai)
#pragma unroll
            for (int m = 0; m < 4; ++m) { bf16_t* rowp = base + (size_t)(row0 + ai * HALF + m * 16) * ldc + col0;
#pragma unroll
                for (int bj = 0; bj < 2; ++bj) { f32x4 v0 = acc[ai][bj][m][0] + bv[bj][0], v1 = acc[ai][bj][m][1] + bv[bj][1];
                    if (ACT == 1) { f32x2 a = gelu_pk((f32x2){v0[0], v0[1]}), b = gelu_pk((f32x2){v0[2], v0[3]}), c = gelu_pk((f32x2){v1[0], v1[1]}), d = gelu_pk((f32x2){v1[2], v1[3]});
                        v0 = (f32x4){a.x, a.y, b.x, b.y}; v1 = (f32x4){c.x, c.y, d.x, d.y}; }
                    v0 = v0 * sc; v1 = v1 * sc; u32x4 w; w.x = cvt_pk_bf16(v0[0], v0[1]); w.y = cvt_pk_bf16(v0[2], v0[3]); w.z = cvt_pk_bf16(v1[0], v1[1]); w.w = cvt_pk_bf16(v1[2], v1[3]);
                    *(u32x4*)(rowp + bj * HALF) = w; } }
    }
};


template <class Epi, class Sched, bool ALIGN_EPI = false, bool SP2 = false>
__device__ __forceinline__ void gemm_phase(PG8_LAS unsigned char* lds, const Gemm g, const Sched& S, const Epi& E) {
    const int tid = threadIdx.x, wid = __builtin_amdgcn_readfirstlane(tid >> 6), lane = tid & 63, wr = wid >> 2, wc = wid & 3, fr = lane & 15, fq = lane >> 4;
    const int K = g.K, nt = K / BK;
    unsigned voffA[2], voffB[2];
#pragma unroll
    for (int i = 0; i < 2; ++i) { int R, C; stage_rc(tid * 16 + i * 8192, R, C); const int Rb = Epi::PERM ? ((R & ~31) + perm32(R & 31)) : R;
        voffA[i] = (unsigned)(R * K + C) * 2u; voffB[i] = (unsigned)(Rb * K + C) * 2u; }
    const size_t kstep = (size_t)(BK * 2);
    const size_t hstep = (size_t)HALF * K * 2;
    const size_t tstep = 2 * hstep;
    const unsigned ldsw = (unsigned)wid * 1024u;
    const int aoff = lds_byte(wr * 64 + fr, fq * 8), boff = lds_byte(wc * 32 + fr, fq * 8);
#define PG8_SA(b, h) (((b) * 2 + (h)) * HTB)
#define PG8_SB(b, h) ((4 + (b) * 2 + (h)) * HTB)
#define PG8_STAGE(bufoff, gbase, voff) do { _Pragma("unroll") for (int _i = 0; _i < 2; ++_i) \
        __builtin_amdgcn_global_load_lds((const unsigned*)((const char*)(gbase) + (voff)[_i]), (PG8_LAS unsigned*)(lds + (bufoff) + ldsw + _i * 8192), 16, 0, 0); } while (0)
#define PG8_LDA(dst, b, h) do { _Pragma("unroll") for (int m = 0; m < 4; ++m) _Pragma("unroll") for (int k = 0; k < 2; ++k) dst[m][k] = *(const PG8_LAS bf16x8*)(lds + PG8_SA(b, h) + aoff + m * 2048 + k * 1024); } while (0)
#define PG8_LDB(dst, b, h) do { _Pragma("unroll") for (int n = 0; n < 2; ++n) _Pragma("unroll") for (int k = 0; k < 2; ++k) dst[n][k] = *(const PG8_LAS bf16x8*)(lds + PG8_SB(b, h) + boff + n * 2048 + k * 1024); } while (0)
#define PG8_MMA(ai, bj, At, Bt) do { __builtin_amdgcn_s_setprio(1); _Pragma("unroll") for (int m = 0; m < 4; ++m) _Pragma("unroll") for (int n = 0; n < 2; ++n) _Pragma("unroll") for (int k = 0; k < 2; ++k) \
        acc[ai][bj][m][n] = __builtin_amdgcn_mfma_f32_16x16x32_bf16(Bt[n][k], At[m][k], acc[ai][bj][m][n], 0, 0, 0); __builtin_amdgcn_s_setprio(0); } while (0)
#define PG8_WAIT_V(n) asm volatile("s_waitcnt vmcnt(" #n ")" ::: "memory")
#define PG8_WAIT_L(n) asm volatile("s_waitcnt lgkmcnt(" #n ")" ::: "memory")
#define PG8_BAR __builtin_amdgcn_s_barrier()
#define PG8_SCHED __builtin_amdgcn_sched_barrier(0)
    Unit cur, nxt; int ui = 0;
    if (!S.next(0, cur)) return;
    f32x4 acc[2][2][4][2];
#pragma unroll
    for (int a = 0; a < 2; ++a)
#pragma unroll
        for (int b = 0; b < 2; ++b)
#pragma unroll
            for (int m = 0; m < 4; ++m)
#pragma unroll
                for (int n = 0; n < 2; ++n) acc[a][b][m][n] = (f32x4){0.f, 0.f, 0.f, 0.f};
    bf16x8 At[4][2], B0[2][2], B1[2][2];
    const char* cA = (const char*)g.A + (size_t)cur.pm * tstep; const char* cB = (const char*)g.Bt + (size_t)cur.pn * tstep;
    S.a_ready(cur);
    if constexpr (SP2) {
        PG8_STAGE(PG8_SB(0, 0), cB, voffB); PG8_STAGE(PG8_SB(0, 1), cB + hstep, voffB); PG8_STAGE(PG8_SA(0, 0), cA, voffA); PG8_STAGE(PG8_SA(0, 1), cA + hstep, voffA);
        if (wr == 1) PG8_BAR;
        PG8_WAIT_V(2); PG8_BAR;
        PG8_STAGE(PG8_SB(1, 0), cB + kstep, voffB); PG8_STAGE(PG8_SA(1, 0), cA + kstep, voffA); PG8_STAGE(PG8_SB(1, 1), cB + hstep + kstep, voffB);
        PG8_WAIT_V(6); PG8_BAR;
    } else {
        PG8_STAGE(PG8_SB(0, 0), cB, voffB); PG8_STAGE(PG8_SA(0, 0), cA, voffA); PG8_STAGE(PG8_SB(0, 1), cB + hstep, voffB); PG8_STAGE(PG8_SA(0, 1), cA + hstep, voffA);
        if (wr == 1) PG8_BAR;
        PG8_WAIT_V(4); PG8_BAR;
        PG8_STAGE(PG8_SB(1, 0), cB + kstep, voffB); PG8_STAGE(PG8_SA(1, 0), cA + kstep, voffA); PG8_STAGE(PG8_SB(1, 1), cB + hstep + kstep, voffB);
        PG8_WAIT_V(6); PG8_BAR;
    }
    for (;;) {
        const bool has_next = S.next(ui + 1, nxt);
        const char* nA = has_next ? (const char*)g.A + (size_t)nxt.pm * tstep : cA; const char* nB = has_next ? (const char*)g.Bt + (size_t)nxt.pn * tstep : cB;
        for (int t = 0; t < nt; t += 2) {
            const bool last = (t == nt - 2);
            const char* a1 = cA + (size_t)(t + 1) * kstep;
            const char* a2 = last ? nA : cA + (size_t)(t + 2) * kstep; const char* b2 = last ? nB : cB + (size_t)(t + 2) * kstep;
            const char* a3 = a2 + kstep; const char* b3 = b2 + kstep;
            if (last && has_next) S.a_ready(nxt);
            if constexpr (SP2) {
            PG8_LDB(B0, 0, 0); PG8_LDB(B1, 0, 1); PG8_SCHED; PG8_LDA(At, 0, 0); PG8_STAGE(PG8_SA(1, 1), a1 + hstep, voffA);
            PG8_WAIT_V(8); PG8_WAIT_L(0); PG8_BAR; PG8_MMA(0, 0, At, B0); PG8_MMA(0, 1, At, B1); PG8_BAR; PG8_SCHED;
            PG8_LDA(At, 0, 1); PG8_STAGE(PG8_SB(0, 0), b2, voffB); PG8_STAGE(PG8_SB(0, 1), b2 + hstep, voffB); PG8_STAGE(PG8_SA(0, 0), a2, voffA);
            PG8_WAIT_V(8); PG8_WAIT_L(0); PG8_BAR; PG8_MMA(1, 0, At, B0); PG8_MMA(1, 1, At, B1); PG8_BAR; PG8_SCHED;
            PG8_LDB(B0, 1, 0); PG8_LDB(B1, 1, 1); PG8_SCHED; PG8_LDA(At, 1, 0); PG8_STAGE(PG8_SA(0, 1), a2 + hstep, voffA);
            PG8_WAIT_V(8); PG8_WAIT_L(0); PG8_BAR; PG8_MMA(0, 0, At, B0); PG8_MMA(0, 1, At, B1); PG8_BAR; PG8_SCHED;
            PG8_LDA(At, 1, 1); PG8_STAGE(PG8_SB(1, 0), b3, voffB); PG8_STAGE(PG8_SB(1, 1), b3 + hstep, voffB); PG8_STAGE(PG8_SA(1, 0), a3, voffA);
            PG8_WAIT_V(8); PG8_WAIT_L(0); PG8_BAR; PG8_MMA(1, 0, At, B0); PG8_MMA(1, 1, At, B1); PG8_BAR; PG8_SCHED;
            } else {
            PG8_LDB(B0, 0, 0); PG8_SCHED; PG8_LDA(At, 0, 0); PG8_STAGE(PG8_SA(1, 1), a1 + hstep, voffA);
            PG8_WAIT_L(8); PG8_BAR; PG8_WAIT_L(0); PG8_MMA(0, 0, At, B0); PG8_BAR; PG8_SCHED;
            PG8_LDB(B1, 0, 1); PG8_STAGE(PG8_SB(0, 0), b2, voffB);
            PG8_BAR; PG8_WAIT_L(0); PG8_MMA(0, 1, At, B1); PG8_BAR;
            PG8_LDA(At, 0, 1); PG8_STAGE(PG8_SA(0, 0), a2, voffA);
            PG8_BAR; PG8_WAIT_L(0); PG8_MMA(1, 0, At, B0); PG8_BAR; PG8_SCHED;
            PG8_STAGE(PG8_SB(0, 1), b2 + hstep, voffB);
            PG8_WAIT_V(6); PG8_BAR; PG8_MMA(1, 1, At, B1); PG8_BAR;
            PG8_LDB(B0, 1, 0); PG8_SCHED; PG8_LDA(At, 1, 0); PG8_STAGE(PG8_SA(0, 1), a2 + hstep, voffA);
            PG8_WAIT_L(8); PG8_BAR; PG8_WAIT_L(0); PG8_MMA(0, 0, At, B0); PG8_BAR; PG8_SCHED;
            PG8_LDB(B1, 1, 1); PG8_STAGE(PG8_SB(1, 0), b3, voffB);
            PG8_BAR; PG8_WAIT_L(0); PG8_MMA(0, 1, At, B1); PG8_BAR;
            PG8_LDA(At, 1, 1); PG8_STAGE(PG8_SA(1, 0), a3, voffA);
            PG8_BAR; PG8_WAIT_L(0); PG8_MMA(1, 0, At, B0); PG8_BAR; PG8_SCHED;
            PG8_STAGE(PG8_SB(1, 1), b3 + hstep, voffB);
            PG8_WAIT_V(6); PG8_BAR; PG8_MMA(1, 1, At, B1); PG8_BAR;
            }
        }
        if constexpr (ALIGN_EPI) { if (wr == 0) PG8_BAR; }
        if constexpr (!Epi::AFTER_DRAIN) { E(acc, cur, wr, wc, fr, fq); S.done(cur); }
        if (!has_next) break;
#pragma unroll
        for (int a = 0; a < 2; ++a)
#pragma unroll
            for (int b = 0; b < 2; ++b)
#pragma unroll
                for (int m = 0; m < 4; ++m)
#pragma unroll
                    for (int n = 0; n < 2; ++n) acc[a][b][m][n] = (f32x4){0.f, 0.f, 0.f, 0.f};
        cur = nxt; cA = nA; cB = nB; ++ui;
        if constexpr (ALIGN_EPI) { if (wr == 1) PG8_BAR; }
    }
    PG8_WAIT_V(0);
    if constexpr (!ALIGN_EPI) { if (wr == 0) PG8_BAR; }
    PG8_BAR;
    if constexpr (Epi::AFTER_DRAIN) { E.fused(acc, cur, wr, wc, fr, fq, lds, wid, lane); S.done(cur); }
#undef PG8_SA
#undef PG8_SB
#undef PG8_STAGE
#undef PG8_LDA
#undef PG8_LDB
#undef PG8_MMA
#undef PG8_WAIT_V
#undef PG8_WAIT_L
#undef PG8_BAR
#undef PG8_SCHED
}
}
namespace attn_body {
using bf16=__hip_bfloat16;
using bf16x8=__attribute__((ext_vector_type(8)))short;
using s16x4=__attribute__((ext_vector_type(4)))short;
using f32x16=__attribute__((ext_vector_type(16)))float;
using u32x4=__attribute__((ext_vector_type(4)))unsigned;
constexpr int BATCH=8,NHEAD=8,SEQ=2048,D=64,DM=NHEAD*D,DMO=1024;
constexpr int NW=8,QBLK=32,QB=QBLK*NW,KVBLK=64,NQB=SEQ/QB;
constexpr int ATTN_PITCH=DM, ATTN_UNIT_ROWS=QB;
__device__ __forceinline__ int crow(int r,int hi){return (r&3)+8*(r>>2)+4*hi;}
#define SBAR() __builtin_amdgcn_sched_barrier(0)
typedef unsigned u32x16 __attribute__((ext_vector_type(16)));
constexpr int NSLOT=3, SLOTB=8192;
constexpr int LDS_K=0, LDS_V=NSLOT*SLOTB, LDS_WS=2*NSLOT*SLOTB, LDS_OST=LDS_WS+NW*64*4, LDS_BYTES=LDS_OST+NW*4096;
constexpr float C2=0.125f*1.4426950408889634f;
__device__ __forceinline__ void glds16(const void*gsrc,unsigned lds_dst){unsigned keep;
  asm volatile("s_mov_b32 %0, m0\n\ts_mov_b32 m0, %2\n\ts_nop 0\n\tglobal_load_lds_dwordx4 %1, off\n\ts_mov_b32 m0, %0":"=&s"(keep):"v"(gsrc),"s"(lds_dst):"memory");}
__device__ __forceinline__ float max3f(float a,float b,float c){float r;asm("v_max3_f32 %0, %1, %2, %3":"=v"(r):"v"(a),"v"(b),"v"(c));return r;}
__device__ __forceinline__ float max2f(float a,float b){float r;asm("v_max_f32_e32 %0, %1, %2":"=v"(r):"v"(a),"v"(b));return r;}
__device__ __forceinline__ float fadd_s(float a,float b){float r;asm("v_add_f32_e32 %0, %1, %2":"=v"(r):"v"(a),"v"(b));return r;}
__device__ __forceinline__ float fsub_s(float a,float b){float r;asm("v_sub_f32_e32 %0, %1, %2":"=v"(r):"v"(a),"v"(b));return r;}
typedef float f32x2_t __attribute__((ext_vector_type(2))); typedef __bf16 bf16x2_t __attribute__((ext_vector_type(2)));
__device__ __forceinline__ unsigned cvtpk_s(float lo,float hi){f32x2_t v={lo,hi};bf16x2_t b=__builtin_convertvector(v,bf16x2_t);return __builtin_bit_cast(unsigned,b);}
#define WAIT_BAR(N) asm volatile("s_waitcnt vmcnt(" #N ") lgkmcnt(0)\n\ts_barrier":::"memory")

__device__ __forceinline__ void qkt(f32x16&p0,f32x16&p1,const char*Kslot,const bf16x8*qr,int r32,int hi){ const f32x16 negm=f32x16{};
  const char*kb=Kslot+hi*1024+r32*16;
  #pragma unroll
  for(int d0=0;d0<4;++d0){
    const bf16x8 b0=*reinterpret_cast<const bf16x8*>(kb+d0*2048);
    const bf16x8 b1=*reinterpret_cast<const bf16x8*>(kb+d0*2048+512);
    if(d0==0){p0=__builtin_amdgcn_mfma_f32_32x32x16_bf16(b0,qr[0],negm,0,0,0);p1=__builtin_amdgcn_mfma_f32_32x32x16_bf16(b1,qr[0],negm,0,0,0);}
    else{p0=__builtin_amdgcn_mfma_f32_32x32x16_bf16(b0,qr[d0],p0,0,0,0);p1=__builtin_amdgcn_mfma_f32_32x32x16_bf16(b1,qr[d0],p1,0,0,0);}}
}
typedef __attribute__((address_space(3))) const char* lds_cptr;
typedef short v4i16_t __attribute__((ext_vector_type(4)));
__device__ __forceinline__ void kload8(bf16x8*kf,lds_cptr kp){
  kf[0]=*(const __attribute__((address_space(3))) bf16x8*)(kp);      kf[1]=*(const __attribute__((address_space(3))) bf16x8*)(kp+512);
  kf[2]=*(const __attribute__((address_space(3))) bf16x8*)(kp+2048); kf[3]=*(const __attribute__((address_space(3))) bf16x8*)(kp+2560);
  kf[4]=*(const __attribute__((address_space(3))) bf16x8*)(kp+4096); kf[5]=*(const __attribute__((address_space(3))) bf16x8*)(kp+4608);
  kf[6]=*(const __attribute__((address_space(3))) bf16x8*)(kp+6144); kf[7]=*(const __attribute__((address_space(3))) bf16x8*)(kp+6656);
}
__device__ __forceinline__ void kload2(bf16x8*kf,lds_cptr kp,int j){ kf[2*j]=*(const __attribute__((address_space(3))) bf16x8*)(kp+j*2048); kf[2*j+1]=*(const __attribute__((address_space(3))) bf16x8*)(kp+j*2048+512); }
__device__ __forceinline__ s16x4 vtr(lds_cptr p){ return __builtin_bit_cast(s16x4,__builtin_amdgcn_ds_read_tr16_b64_v4i16((__attribute__((address_space(3))) v4i16_t*)p)); }
__device__ __forceinline__ float rowmax(const f32x16&p0,const f32x16&p1){
  float a=max3f(p0[0],p0[1],p1[0]),b=max3f(p0[2],p0[3],p1[1]);a=max3f(a,p1[2],p1[3]);
  #pragma unroll
  for(int r=4;r<16;r+=4){a=max3f(a,p0[r],p0[r+1]);b=max3f(b,p0[r+2],p0[r+3]);a=max3f(a,p1[r],p1[r+1]);b=max3f(b,p1[r+2],p1[r+3]);}
  const float m=max2f(a,b);
  auto rr=__builtin_amdgcn_permlane32_swap(__float_as_uint(m),__float_as_uint(m),false,false);
  return max2f(__uint_as_float(rr[0]),__uint_as_float(rr[1]));
}
__device__ __forceinline__ void pv(f32x16*o,int vb,bf16x8 pa0,bf16x8 pa1,bf16x8 pa2,bf16x8 pa3){
  #pragma unroll
  for(int d0=0;d0<2;++d0){s16x4 lo[4],hi[4];
    #pragma unroll
    for(int ks=0;ks<4;++ks){
      asm volatile("ds_read_b64_tr_b16 %0,%1 offset:%c2":"=&v"(lo[ks]):"v"(vb),"i"(d0*4096+ks*1024):"memory");
      asm volatile("ds_read_b64_tr_b16 %0,%1 offset:%c2":"=&v"(hi[ks]):"v"(vb),"i"(d0*4096+ks*1024+512):"memory");}
    asm volatile("s_waitcnt lgkmcnt(0)":::"memory");SBAR();
    #define PK(k) (bf16x8){lo[k][0],lo[k][1],lo[k][2],lo[k][3],hi[k][0],hi[k][1],hi[k][2],hi[k][3]}
    o[d0]=__builtin_amdgcn_mfma_f32_32x32x16_bf16(pa0,PK(0),o[d0],0,0,0);
    o[d0]=__builtin_amdgcn_mfma_f32_32x32x16_bf16(pa1,PK(1),o[d0],0,0,0);
    o[d0]=__builtin_amdgcn_mfma_f32_32x32x16_bf16(pa2,PK(2),o[d0],0,0,0);
    o[d0]=__builtin_amdgcn_mfma_f32_32x32x16_bf16(pa3,PK(3),o[d0],0,0,0);
    #undef PK
  }
}

#ifndef ATTN_STORE16
#define ATTN_STORE16(p,v) (*(u32x4*)(p)=(v))
#endif
template<int THRL> __device__ __forceinline__ void attn_unit(int b,int h,int qb,const bf16*Q,const bf16*__restrict__ K,const bf16*__restrict__ V,bf16*O,const unsigned long long*MT,char*shm){
  const int tid=threadIdx.x,lane=tid&63,r32=lane&31,hi=lane>>5; const int wid=__builtin_amdgcn_readfirstlane(tid>>6);
  const long rowbase=(long)b*SEQ; const int q0=qb*QB;
  const bf16*Qw=Q+(rowbase+q0+wid*QBLK)*DM+h*D;
  const bf16*Kh=K+rowbase*DM+h*D,*Vh=V+rowbase*DM+h*D;
  const unsigned lds0=(unsigned)(uintptr_t)shm;
  float*wsf=(float*)(shm+LDS_WS)+wid*64;
  const bf16*ksrc=Kh+(long)lane*DM+wid*8;
  const bf16*vsrc=Vh+(long)(16*(wid&3)+(lane>>2))*DM+(wid>>2)*32+(lane&3)*8;
  const unsigned kdst=lds0+LDS_K+wid*1024, vdst=lds0+LDS_V+wid*1024;
  #define DMA_K(t,slot) glds16(ksrc+(long)(t)*KVBLK*DM,(unsigned)__builtin_amdgcn_readfirstlane(kdst+(slot)))
  #define DMA_V(t,slot) glds16(vsrc+(long)(t)*KVBLK*DM,(unsigned)__builtin_amdgcn_readfirstlane(vdst+(slot)))
  const int vb0=(int)(lds0+LDS_V)+((lane>>4)&1)*32+(lane&3)*8+(4*hi+((lane&15)>>2))*64;
  const char*Kbase=shm+LDS_K; bf16x8 kf[8];
  const lds_cptr shm3=(lds_cptr)shm; const lds_cptr kp0=shm3+LDS_K+hi*1024+r32*16; const lds_cptr vp0=shm3+LDS_V+((lane>>4)&1)*32+(lane&3)*8+(4*hi+((lane&15)>>2))*64;
  const int NT=(q0+QB)/KVBLK;
  const unsigned long long*mbase=MT+((size_t)((b*(SEQ/32)+qb*NW+wid)*(SEQ/KVBLK)))*32;
  u32x16 mk0,mk1,mk2,mk3; const float NEGV=-INFINITY;
  #define MLOAD(t) do{ const unsigned long long*mp_=mbase+(size_t)(t)*32; \
    asm volatile("s_load_dwordx16 %0, %4, 0x0\n\ts_load_dwordx16 %1, %4, 0x40\n\ts_load_dwordx16 %2, %4, 0x80\n\ts_load_dwordx16 %3, %4, 0xc0":"=&s"(mk0),"=&s"(mk1),"=&s"(mk2),"=&s"(mk3):"s"(mp_):"memory"); }while(0)
  #define MK64(v,i) (((unsigned long long)(v)[2*(i)+1]<<32)|(unsigned long long)(v)[2*(i)])
  #define MAPPLY(P0,P1) do{ asm volatile("s_waitcnt lgkmcnt(0)":"+s"(mk0),"+s"(mk1),"+s"(mk2),"+s"(mk3)::"memory"); \
    _Pragma("unroll") for(int r=0;r<8;++r){ P0[r]=__builtin_amdgcn_inverse_ballot_w64(MK64(mk0,r))?P0[r]:NEGV; P0[r+8]=__builtin_amdgcn_inverse_ballot_w64(MK64(mk1,r))?P0[r+8]:NEGV; \
      P1[r]=__builtin_amdgcn_inverse_ballot_w64(MK64(mk2,r))?P1[r]:NEGV; P1[r+8]=__builtin_amdgcn_inverse_ballot_w64(MK64(mk3,r))?P1[r+8]:NEGV; } }while(0)
  DMA_K(0,0);DMA_V(0,0);DMA_K(1,SLOTB);
  bf16x8 qr[4];
  #pragma unroll
  for(int d0=0;d0<4;++d0)qr[d0]=*reinterpret_cast<const bf16x8*>(&Qw[(long)r32*DM+d0*16+hi*8]);
  float mhat=0.f,l_reg=0.f;f32x16 o[2];o[0]=f32x16{};o[1]=f32x16{};const f32x16 zc=f32x16{};
  bool resc=false;
  #define START(P0,P1) do{ const float rm=rowmax(P0,P1); resc=false; \
    { const float dl=max2f(rm,-30.f); mhat=fadd_s(mhat,dl); \
      _Pragma("unroll") for(int r=0;r<16;++r){P0[r]=fsub_s(P0[r],dl);P1[r]=fsub_s(P1[r],dl);} \
      } \
    _Pragma("unroll") for(int r=0;r<16;++r)P0[r]=__builtin_amdgcn_exp2f(P0[r]); }while(0)
  #define RESC() do{ if(resc){ asm volatile("s_waitcnt lgkmcnt(0)":::"memory"); \
      _Pragma("unroll") for(int d_=0;d_<2;++d_) _Pragma("unroll") for(int r=0;r<16;++r)o[d_][r]*=wsf[crow(r,hi)]; } }while(0)
  f32x16 pA0,pA1,pB0,pB1;
  int sl_prev=0,sl_cur=0,sl_next=SLOTB;
  #define ROT() do{sl_prev=sl_cur;sl_cur=sl_next;sl_next=(sl_next==(NSLOT-1)*SLOTB)?0:sl_next+SLOTB;}while(0)
  DMA_K(2,2*SLOTB);
  WAIT_BAR(3);
  MLOAD(0); qkt(pA0,pA1,Kbase,qr,r32,hi);asm volatile("s_nop 15\n\ts_nop 7":"+v"(pA0),"+v"(pA1));MAPPLY(pA0,pA1);asm volatile("s_nop 1":"+v"(pA0),"+v"(pA1));
  START(pA0,pA1);
  _Pragma("unroll") for(int r=0;r<16;++r)pA1[r]=__builtin_amdgcn_exp2f(pA1[r]);
  WAIT_BAR(0);
  DMA_K(3,0);DMA_V(1,SLOTB);
  ROT();
  kload8(kf,kp0+sl_cur);
  WAIT_BAR(2);
  s16x4 vlo[8],vhi[8]; u32x4 pw0,pw1,pw2,pw3;
  #define PKW(P,B) cvtpk_s(P[B],P[B+1])
  #define PAF(k) __builtin_bit_cast(bf16x8,pw##k)
  #define VFR(i) (bf16x8){vlo[i][0],vlo[i][1],vlo[i][2],vlo[i][3],vhi[i][0],vhi[i][1],vhi[i][2],vhi[i][3]}
  #define PIN(x) asm volatile("":"+v"(x))
  #define MX3(a,b,c) __builtin_fmaxf(__builtin_fmaxf((a),(b)),(c))
  #define GAPA(MF,A0,A1,A2,A3,W0,W1,PW) do{ MF; sacc+=A0; sacc+=A1; sacc+=A2; sacc+=A3; PIN(sacc); W0; W1; PIN(PW); SBAR(); }while(0)
  #define EX(v) __builtin_amdgcn_exp2f(v)
  #define GAPB(MF,X,B) do{ MF; X[B]=EX(X[B]); X[B+1]=EX(X[B+1]); X[B+2]=EX(X[B+2]); X[B+3]=EX(X[B+3]); PIN(X); SBAR(); }while(0)
  #define VRD(i) do{ vlo[i]=vtr(vp_+(((i)>>2)*4096+((i)&3)*1024)); vhi[i]=vtr(vp_+(((i)>>2)*4096+((i)&3)*1024+512)); }while(0)
  #define KRD(G,j) do{ if(G){ kload2(kf,kp0+sl_next,j); SBAR(); } }while(0)
  #define STEP(C0,C1,P0,P1,t,GK,GV,GL) do{ SBAR(); MLOAD(t); \
    const lds_cptr vp_=vp0+sl_prev; \
    VRD(0); SBAR(); float sacc=(P0[0]+P0[1]); \
    GAPA(C0=__builtin_amdgcn_mfma_f32_32x32x16_bf16(kf[0],qr[0],zc,0,0,0), P0[2],P0[3],P0[4],P0[5],     pw0[0]=PKW(P0,0), pw0[1]=PKW(P0,2), pw0); \
    VRD(4); SBAR(); GAPA(C1=__builtin_amdgcn_mfma_f32_32x32x16_bf16(kf[1],qr[0],zc,0,0,0), P0[6],P0[7],P0[8],P0[9],     pw0[2]=PKW(P0,4), pw0[3]=PKW(P0,6), pw0); \
    VRD(1); SBAR(); GAPA(C0=__builtin_amdgcn_mfma_f32_32x32x16_bf16(kf[2],qr[1],C0,0,0,0),   P0[10],P0[11],P0[12],P0[13], pw1[0]=PKW(P0,8), pw1[1]=PKW(P0,10), pw1); \
    VRD(5); SBAR(); GAPA(C1=__builtin_amdgcn_mfma_f32_32x32x16_bf16(kf[3],qr[1],C1,0,0,0),   P0[14],P0[15],P1[0],P1[1],   pw1[2]=PKW(P0,12),pw1[3]=PKW(P0,14), pw1); \
    VRD(2); SBAR(); GAPA(C0=__builtin_amdgcn_mfma_f32_32x32x16_bf16(kf[4],qr[2],C0,0,0,0),   P1[2],P1[3],P1[4],P1[5],     pw2[0]=PKW(P1,0), pw2[1]=PKW(P1,2), pw2); \
    VRD(6); SBAR(); GAPA(C1=__builtin_amdgcn_mfma_f32_32x32x16_bf16(kf[5],qr[2],C1,0,0,0),   P1[6],P1[7],P1[8],P1[9],     pw2[2]=PKW(P1,4), pw2[3]=PKW(P1,6), pw2); \
    VRD(3); SBAR(); GAPA(C0=__builtin_amdgcn_mfma_f32_32x32x16_bf16(kf[6],qr[3],C0,0,0,0),   P1[10],P1[11],P1[12],P1[13], pw3[0]=PKW(P1,8), pw3[1]=PKW(P1,10), pw3); \
    VRD(7); SBAR(); GAPA(C1=__builtin_amdgcn_mfma_f32_32x32x16_bf16(kf[7],qr[3],C1,0,0,0),   P1[14],P1[15],0.f,0.f,       pw3[2]=PKW(P1,12),pw3[3]=PKW(P1,14), pw3); \
    l_reg+=sacc; \
    if(GK){DMA_K((t)+3,sl_cur);} if(GV){DMA_V((t)+1,sl_next);} \
    MAPPLY(C0,C1); \
    { float a=MX3(C0[0],C0[1],C1[0]),b=MX3(C0[2],C0[3],C1[1]); a=MX3(a,C1[2],C1[3]); \
      _Pragma("unroll") for(int r=4;r<16;r+=4){a=MX3(a,C0[r],C0[r+1]);b=MX3(b,C0[r+2],C0[r+3]);a=MX3(a,C1[r],C1[r+1]);b=MX3(b,C1[r+2],C1[r+3]);} \
      float rm=__builtin_fmaxf(a,b); { auto rr=__builtin_amdgcn_permlane32_swap(__float_as_uint(rm),__float_as_uint(rm),false,false); rm=__builtin_fmaxf(__uint_as_float(rr[0]),__uint_as_float(rr[1])); } \
      resc=false; \
      const float rl=rm-mhat; \
      if(__builtin_expect(__any(rl>(float)THRL),0)){ const float dl=__builtin_fmaxf(rl,0.f); mhat+=dl; \
        const float f=__builtin_amdgcn_exp2f(-dl); l_reg*=f; if(hi==0)wsf[r32]=f; resc=true; } \
      _Pragma("unroll") for(int r=0;r<16;++r){C0[r]-=mhat;C1[r]-=mhat;} } \
    SBAR(); \
    GAPB(o[0]=__builtin_amdgcn_mfma_f32_32x32x16_bf16(PAF(0),VFR(0),o[0],0,0,0), C0,0); \
    GAPB(o[1]=__builtin_amdgcn_mfma_f32_32x32x16_bf16(PAF(0),VFR(4),o[1],0,0,0), C0,4); \
    KRD(GL,0); GAPB(o[0]=__builtin_amdgcn_mfma_f32_32x32x16_bf16(PAF(1),VFR(1),o[0],0,0,0), C0,8); \
    KRD(GL,1); GAPB(o[1]=__builtin_amdgcn_mfma_f32_32x32x16_bf16(PAF(1),VFR(5),o[1],0,0,0), C0,12); \
    KRD(GL,2); GAPB(o[0]=__builtin_amdgcn_mfma_f32_32x32x16_bf16(PAF(2),VFR(2),o[0],0,0,0), C1,0); \
    KRD(GL,3); GAPB(o[1]=__builtin_amdgcn_mfma_f32_32x32x16_bf16(PAF(2),VFR(6),o[1],0,0,0), C1,4); \
    GAPB(o[0]=__builtin_amdgcn_mfma_f32_32x32x16_bf16(PAF(3),VFR(3),o[0],0,0,0), C1,8); \
    GAPB(o[1]=__builtin_amdgcn_mfma_f32_32x32x16_bf16(PAF(3),VFR(7),o[1],0,0,0), C1,12); \
    }while(0)
  int t=1;
  for(;t+5<NT;t+=2){
    STEP(pB0,pB1,pA0,pA1,t,true,true,true);     WAIT_BAR(2); RESC(); ROT();
    STEP(pA0,pA1,pB0,pB1,t+1,true,true,true);   WAIT_BAR(2); RESC(); ROT();
  }
  #define ENDW(tt) do{ if((tt)+3<NT){WAIT_BAR(2);} else if((tt)+2<NT){WAIT_BAR(1);} else {WAIT_BAR(0);} }while(0)
  for(;t+1<NT;t+=2){
    STEP(pB0,pB1,pA0,pA1,t,(t+3<NT),(t+1<NT),(t+1<NT));       ENDW(t);   RESC(); ROT();
    STEP(pA0,pA1,pB0,pB1,t+1,(t+4<NT),(t+2<NT),(t+2<NT));     ENDW(t+1); RESC(); ROT();
  }
  STEP(pB0,pB1,pA0,pA1,NT-1,false,false,false); RESC();
  { float sacc=pB0[0]+pB0[1]; _Pragma("unroll") for(int r=2;r<16;++r)sacc+=pB0[r]; _Pragma("unroll") for(int r=0;r<16;++r)sacc+=pB1[r]; l_reg+=sacc;
    pw0=(u32x4){PKW(pB0,0),PKW(pB0,2),PKW(pB0,4),PKW(pB0,6)};pw1=(u32x4){PKW(pB0,8),PKW(pB0,10),PKW(pB0,12),PKW(pB0,14)};pw2=(u32x4){PKW(pB1,0),PKW(pB1,2),PKW(pB1,4),PKW(pB1,6)};pw3=(u32x4){PKW(pB1,8),PKW(pB1,10),PKW(pB1,12),PKW(pB1,14)};
    SBAR(); pv(o,vb0+sl_cur,PAF(0),PAF(1),PAF(2),PAF(3)); }
  #undef PKW
  #undef PAF
  #undef VFR
  #undef PIN
  #undef MX3
  #undef GAPA
  #undef GAPB
  #undef EX
  #undef VRD
  #undef KRD
  #undef STEP
  #undef ENDW
  {auto rr=__builtin_amdgcn_permlane32_swap(__float_as_uint(l_reg),__float_as_uint(l_reg),false,false);l_reg=__uint_as_float(rr[0])+__uint_as_float(rr[1]);}
  if(hi==0)wsf[32+r32]=l_reg;asm volatile("s_waitcnt lgkmcnt(0)":::"memory");
  float rli[16];
  #pragma unroll
  for(int r=0;r<16;++r)rli[r]=__builtin_amdgcn_rcpf(wsf[32+crow(r,hi)]);
  bf16*Ow=O+(rowbase+q0+wid*QBLK)*DMO+h*D;
  { bf16*stg=(bf16*)(shm+LDS_OST)+wid*2048;
    #pragma unroll
    for(int r=0;r<16;++r){const int orow=crow(r,hi);
      #pragma unroll
      for(int d0=0;d0<2;++d0)stg[orow*64+d0*32+r32]=__float2bfloat16(o[d0][r]*rli[r]);}
    asm volatile("s_waitcnt lgkmcnt(0)":::"memory");
    #pragma unroll
    for(int i=0;i<4;++i){const int row=i*8+(lane>>3),ch=lane&7; const u32x4 v=*(const u32x4*)(stg+row*64+ch*8); ATTN_STORE16(Ow+(long)row*DMO+ch*8,v);} }
  asm volatile("s_waitcnt lgkmcnt(0)\n\ts_barrier":::"memory");
  #undef DMA_K
  #undef DMA_V
  #undef MLOAD
  #undef MK64
  #undef MAPPLY
  #undef START
  #undef RESC
  #undef ROT
}
constexpr int ATTN_LDS_BYTES=LDS_BYTES;
struct AttnTensors { const bf16* Q; const bf16* K; const bf16* V; bf16* O; const unsigned long long* MT; };
struct AttnUnit { int bh; int qb; };
struct StaticOrder {
  int vcu;
  __device__ __forceinline__ explicit StaticOrder(int grid,int block):vcu((block%8)*(grid/8)+block/8){}
  __device__ __forceinline__ bool next(int i,AttnUnit&u)const{ if(i>=2)return false; const int s=vcu&3; u.bh=vcu>>2; u.qb=(i==0)?s:7-s; return true; }
  __device__ __forceinline__ void a_ready(const AttnUnit&)const{}
  __device__ __forceinline__ void done(const AttnUnit&)const{}
};
template<class Sched,int THRL=8> __device__ __forceinline__ void attn_phase(char*lds,const AttnTensors&T,const Sched&S){
  AttnUnit u;
  for(int i=0;S.next(i,u);++i){ S.a_ready(u); attn_unit<THRL>(u.bh/NHEAD,u.bh%NHEAD,u.qb,T.Q,T.K,T.V,T.O,T.MT,lds); S.done(u); }
}
#undef SBAR
#undef WAIT_BAR
}
#define XB_TMO      128
#define XB_XCNT(j)  (256  + 64 * (j))
#define XB_XSUB(j)  (1280 + 64 * (j))
#define XB_XGEN(j)  (2304 + 64 * (j))
#define XB_TOP      3328
#define XB_TOPGEN   3392
#define XCD_BAR_WORDS 3456
#define XB_SPIN_CAP (1u << 18)

__device__ __forceinline__ unsigned xb_ld(unsigned* p)              { return __hip_atomic_load(p, __ATOMIC_RELAXED, __HIP_MEMORY_SCOPE_AGENT); }
__device__ __forceinline__ unsigned xb_add(unsigned* p, unsigned v) { return __hip_atomic_fetch_add(p, v, __ATOMIC_RELAXED, __HIP_MEMORY_SCOPE_AGENT); }
__device__ __forceinline__ unsigned xb_xcc_id() { return (unsigned)__builtin_amdgcn_s_getreg((3 << 11) | 20) & 0xFu; }
#define XB_SPIN(cond, bar) do { unsigned _sp = 0; while (cond) { __builtin_amdgcn_s_sleep(1); \
    if ((++_sp & 255u) == 0u) { if (xb_ld(&(bar)[XB_TMO])) break; if (_sp > XB_SPIN_CAP) { atomicAdd(&(bar)[XB_TMO], 1u); break; } } } } while (0)

struct XcdBarrier {
    unsigned* bar; unsigned x;
    volatile LAS unsigned* st;
};

__device__ __forceinline__ XcdBarrier xcd_barrier_post(unsigned* bar, volatile LAS unsigned* st) {
    XcdBarrier b; b.bar = bar; b.x = xb_xcc_id(); b.st = st;
    if (threadIdx.x == 0) (void)xb_add(&bar[XB_XCNT(b.x)], 1u);
    return b;
}
__device__ __forceinline__ void xcd_barrier_complete(unsigned* bar, unsigned x, unsigned& nloc, unsigned& nx) {
    const unsigned G = gridDim.x * gridDim.y * gridDim.z;
    unsigned sum, cnt, mine, sp = 0u;
    for (;;) {
        sum = 0u; cnt = 0u; mine = 0u;
#pragma unroll
        for (unsigned j = 0; j < 16; ++j) { const unsigned c = xb_ld(&bar[XB_XCNT(j)]); sum += c; cnt += (c > 0u) ? 1u : 0u; mine = (j == x) ? c : mine; }
        if (sum == G) break;
        __builtin_amdgcn_s_sleep(1);
        if ((++sp & 255u) == 0u) { if (xb_ld(&bar[XB_TMO])) break; if (sp > XB_SPIN_CAP) { atomicAdd(&bar[XB_TMO], 1u); break; } }
    }
    nloc = mine > 0u ? mine : 1u; nx = cnt > 0u ? cnt : 1u;
}

__device__ __forceinline__ void xcd_barrier(const XcdBarrier& b) {
    asm volatile("s_waitcnt vmcnt(0)" ::: "memory");
    __syncthreads();
    if (threadIdx.x == 0) {
        unsigned* bar = b.bar;
        __builtin_amdgcn_s_waitcnt(0);
        unsigned nloc = b.st[0], nx = b.st[1];
        if (nloc == 0u) { xcd_barrier_complete(bar, b.x, nloc, nx); b.st[0] = nloc; b.st[1] = nx; }
        const unsigned old = xb_add(&bar[XB_XSUB(b.x)], 1u);
        const unsigned gen = old / nloc;
        if (old + 1u == (gen + 1u) * nloc) {
            __builtin_amdgcn_fence(__ATOMIC_RELEASE, "agent");
            asm volatile("s_waitcnt vmcnt(0)" ::: "memory");
            const unsigned og = xb_add(&bar[XB_TOP], 1u);
            const unsigned tg = og / nx;
            if (og + 1u == (tg + 1u) * nx) xb_add(&bar[XB_TOPGEN], 1u);
            else XB_SPIN(xb_ld(&bar[XB_TOPGEN]) == tg, bar);
            __builtin_amdgcn_fence(__ATOMIC_ACQUIRE, "agent");
            xb_add(&bar[XB_XGEN(b.x)], 1u);
            asm volatile("s_waitcnt vmcnt(0)" ::: "memory");
        } else {
            XB_SPIN(xb_ld(&bar[XB_XGEN(b.x)]) == gen, bar);
            __builtin_amdgcn_fence(__ATOMIC_ACQUIRE, "agent");
            asm volatile("s_waitcnt vmcnt(0)" ::: "memory");
        }
    }
    __syncthreads();
}
#define GAS __attribute__((address_space(1)))
#ifndef LAS
#define LAS __attribute__((address_space(3)))
#endif
typedef unsigned short bf16;
typedef unsigned v4u __attribute__((ext_vector_type(4)));
typedef float f32x4 __attribute__((ext_vector_type(4)));
#define LDS_WAIT() asm volatile("s_waitcnt lgkmcnt(0)" ::: "memory")
#define VM_WAIT() asm volatile("s_waitcnt vmcnt(0)" ::: "memory")

constexpr int D = 1024, NB = 8, T = 2048, MP = NB * T, NSMP = 32, MT = MP + NSMP, MPAD = 16640;
constexpr int ATT_W = 512, AH = 8, IH = 16, IDD = 64, TOPK = 256;
constexpr int RW_W = 512, RH = 8, RN = 64;
constexpr int RW_COLS = 1792, IN_COLS = 4432, NIN = 4608;
constexpr int FFN = 2816, NGU = 2 * FFN;
constexpr int NPAGES = 64, PAGE = 128, PAST = 8192, LS = PAST + 1, SCS_LD = 8704;
constexpr int O_Q = 0, O_K = 512, O_V = 1024, O_QI = 1536, O_KI = 2560, O_WI = 2624, O_RW = 2640;
constexpr float IDX_W_SCALE = 0.03125f;
constexpr float RMS_EPS = 1e-6f, GN_EPS = 64e-5f;
constexpr int MODW = 6 * D;

constexpr size_t OUT_Y = 0, OUT_YS = OUT_Y + (size_t)MP * D, OUT_KP = OUT_YS + (size_t)NSMP * D, OUT_VP = OUT_KP + (size_t)MP * ATT_W,
                 OUT_IKP = OUT_VP + (size_t)MP * ATT_W, OUT_WKVP = OUT_IKP + (size_t)MP * IDD, OUT_SHP = OUT_WKVP + (size_t)NB * RH * RN * RN,
                 OUT_KS = OUT_SHP + (size_t)NB * RW_COLS, OUT_VS = OUT_KS + (size_t)NSMP * ATT_W, OUT_IKS = OUT_VS + (size_t)NSMP * ATT_W,
                 OUT_WKVS = OUT_IKS + (size_t)NSMP * IDD, OUT_SHS = OUT_WKVS + (size_t)NSMP * RH * RN * RN, OUT_END = OUT_SHS + (size_t)NSMP * RW_COLS;
static_assert(OUT_END == 36052992, "output size");

constexpr size_t MiB = 1u << 20;
constexpr size_t WS_CTL = 0, CTL_ZERO_BYTES = 1 * MiB;
constexpr size_t WS_MOD = 1 * MiB;
constexpr size_t WS_WIN = 2 * MiB;
constexpr size_t WS_WOUT = 12 * MiB;
constexpr size_t WS_WGU = 14 * MiB;
constexpr size_t WS_WDN = 26 * MiB;
constexpr size_t WS_A1 = 32 * MiB;
constexpr size_t WS_A2 = 66 * MiB;
constexpr size_t WS_MIX = 100 * MiB;
constexpr size_t WS_HB = 134 * MiB;
constexpr size_t WS_X1 = 224 * MiB;
constexpr size_t WS_PROJ = 290 * MiB;
constexpr size_t WS_PRW = 290 * MiB;
constexpr size_t WS_RAW = 584 * MiB;
constexpr size_t WS_RAW2 = 650 * MiB;
constexpr size_t WS_QN = 1008 * MiB;
constexpr size_t WS_RWA = 1042 * MiB, RWA_STRIDE = 33 * MiB;
constexpr size_t WS_Y = 1273 * MiB;
constexpr size_t WS_SC = 1306 * MiB;
constexpr size_t WS_SCS = 1434 * MiB;
constexpr size_t WS_MASK = 1436 * MiB;
constexpr size_t WS_SLIST = 1440 * MiB;
constexpr size_t WS_QB = 1444 * MiB, WS_KB = 1461 * MiB, WS_VB = 1478 * MiB;
constexpr size_t WS_MASKT = 1495 * MiB;
constexpr size_t WS_QIB = 1500 * MiB;
constexpr size_t WS_KIB = 1536 * MiB;
constexpr size_t WS_WI = 1539 * MiB;
constexpr size_t WS_LIN = 1541 * MiB;
constexpr size_t WS_KX = 1550 * MiB;
constexpr size_t WS_W2T = 1583 * MiB, WS_A2T = 1584 * MiB, WS_G2T = 1585 * MiB;
constexpr size_t WS_MF = 1586 * MiB, WS_NT = 1603 * MiB, WS_PF = 1636 * MiB, WS_QP = 1653 * MiB, WS_ZF = 1686 * MiB;
constexpr size_t WS_Y2 = 1703 * MiB;
constexpr size_t WS_END = 1736 * MiB;
constexpr int QI_LD = 17 * 64;
constexpr int CW_BAR = 4096;

constexpr int NWAVES = 8, NTHREADS = 512;
constexpr int LDS_BYTES = 147456, MISC_OFF = 131072 + 320;

__device__ __forceinline__ unsigned f2bf(float f) { unsigned u = __builtin_bit_cast(unsigned, f); return (u + 0x7fffu + ((u >> 16) & 1u)) >> 16; }
__device__ __forceinline__ unsigned pk2(float lo, float hi) { return f2bf(lo) | (f2bf(hi) << 16); }
__device__ __forceinline__ float wave_sum(float v) {
#pragma unroll
    for (int o = 1; o < 64; o <<= 1) v += __shfl_xor(v, o);
    return v;
}
__device__ __forceinline__ float wave_max(float v) {
#pragma unroll
    for (int o = 1; o < 64; o <<= 1) v = fmaxf(v, __shfl_xor(v, o));
    return v;
}
__device__ __forceinline__ int wave_sum_i(int v) {
#pragma unroll
    for (int o = 1; o < 64; o <<= 1) v += __shfl_xor(v, o);
    return v;
}
__device__ __forceinline__ float sigmoidf_(float x) { return 1.f / (1.f + expf(-x)); }
__device__ __forceinline__ unsigned sortable(float f) { const unsigned u = __builtin_bit_cast(unsigned, f); return (u & 0x80000000u) ? ~u : (u | 0x80000000u); }
__device__ __forceinline__ unsigned long long lanemask_lt(int lane) { return (1ull << lane) - 1ull; }
__device__ __forceinline__ float rdlane(float v, int l) { return __builtin_bit_cast(float, __builtin_amdgcn_readlane(__builtin_bit_cast(int, v), l)); }

struct Args { const float* in[32]; float* out; unsigned char* ws; int ph_lo, ph_hi; };

struct Ctx {
    LAS unsigned char* lds;
    int tid, lane, wave, G, gw, ngw;
    const float* const* in; float* out; unsigned char* ws;
};
__device__ __forceinline__ const float* x_row(const Ctx& C, int m) { return m < MP ? C.in[0] + (size_t)m * D : C.in[1] + (size_t)(m - MP) * D; }
__device__ __forceinline__ int mod_row(int m) { return m < MP ? (m >> 11) : NB + (m - MP); }

struct EpiRawF32 {
    static constexpr bool PERM = false, AFTER_DRAIN = false;
    float* O; int ldc;
    __device__ __forceinline__ void operator()(const pg8::f32x4 (&acc)[2][2][4][2], const pg8::Unit& u, int wr, int wc, int fr, int fq) const {
        const int row0 = u.pm * 256 + wr * 64 + fr, col0 = u.pn * 256 + wc * 32 + 4 * fq;
#pragma unroll
        for (int ai = 0; ai < 2; ++ai)
#pragma unroll
            for (int m = 0; m < 4; ++m) { float* rowp = O + (size_t)(row0 + ai * 128 + m * 16) * ldc + col0;
#pragma unroll
                for (int bj = 0; bj < 2; ++bj)
#pragma unroll
                    for (int n = 0; n < 2; ++n) *(pg8::f32x4*)(rowp + bj * 128 + n * 16) = acc[ai][bj][m][n]; }
    }
};

struct EpiResGate {
    static constexpr bool PERM = false, AFTER_DRAIN = false;
    const float* base; const float* gate; float* out;
    __device__ __forceinline__ void operator()(const pg8::f32x4 (&acc)[2][2][4][2], const pg8::Unit& u, int wr, int wc, int fr, int fq) const {
        const int row0 = u.pm * 256 + wr * 64 + fr, col0 = u.pn * 256 + wc * 32 + 4 * fq;
        const float* gp = gate + (size_t)((u.pm * 256) >> 11) * MODW + col0;
        pg8::f32x4 gv[2][2];
#pragma unroll
        for (int bj = 0; bj < 2; ++bj)
#pragma unroll
            for (int n = 0; n < 2; ++n) gv[bj][n] = *(const pg8::f32x4*)(gp + bj * 128 + n * 16);
#pragma unroll
        for (int ai = 0; ai < 2; ++ai)
#pragma unroll
            for (int m = 0; m < 4; ++m) { const size_t off = (size_t)(row0 + ai * 128 + m * 16) * D + col0;
#pragma unroll
                for (int bj = 0; bj < 2; ++bj)
#pragma unroll
                    for (int n = 0; n < 2; ++n) { const pg8::f32x4 bv = *(const pg8::f32x4*)(base + off + bj * 128 + n * 16);
                        *(pg8::f32x4*)(out + off + bj * 128 + n * 16) = bv + gv[bj][n] * acc[ai][bj][m][n]; } }
    }
};
struct EpiIn {
    static constexpr bool PERM = true, AFTER_DRAIN = false;
    unsigned char* ws; float* out; const float* qg; const float* kg;
    __device__ __forceinline__ void operator()(const pg8::f32x4 (&acc)[2][2][4][2], const pg8::Unit& u, int wr, int wc, int fr, int fq) const {
        const int pn = u.pn; const bool smp = u.pm == MP / 256;
        bf16* QB = (bf16*)(ws + WS_QB); bf16* KB = (bf16*)(ws + WS_KB); bf16* VB = (bf16*)(ws + WS_VB); bf16* QIb = (bf16*)(ws + WS_QIB); bf16* KIb = (bf16*)(ws + WS_KIB);
        float* QN = (float*)(ws + WS_QN); float* WI = (float*)(ws + WS_WI); float* PRW = (float*)(ws + WS_PRW);
        float gq[2][8];
        if (pn < 4) {
#pragma unroll
            for (int bj = 0; bj < 2; ++bj)
#pragma unroll
                for (int e = 0; e < 8; ++e) gq[bj][e] = (pn < 2 ? qg : kg)[32 * bj + 8 * fq + e] * (pn < 2 ? attn_body::C2 : 1.f);
        }
#pragma unroll
        for (int ai = 0; ai < 2; ++ai)
#pragma unroll
            for (int m = 0; m < 4; ++m) {
                const int r = u.pm * 256 + ai * 128 + wr * 64 + m * 16 + fr; const bool ok = r < MT;
                float v[2][8];
#pragma unroll
                for (int bj = 0; bj < 2; ++bj)
#pragma unroll
                    for (int n = 0; n < 2; ++n)
#pragma unroll
                        for (int i = 0; i < 4; ++i) v[bj][4 * n + i] = acc[ai][bj][m][n][i];
                float rstd = 1.f;
                if (pn < 4 || (pn == 10 && wc == 0)) { float ss = 0.f;
#pragma unroll
                    for (int bj = 0; bj < 2; ++bj)
#pragma unroll
                        for (int e = 0; e < 8; ++e) ss += v[bj][e] * v[bj][e];
                    ss += __shfl_xor(ss, 16); ss += __shfl_xor(ss, 32);
                    rstd = 1.f / sqrtf(ss * (1.f / 64.f) + RMS_EPS); }
                if (!ok) continue;
#pragma unroll
                for (int bj = 0; bj < 2; ++bj) {
                    const int cl = 32 * bj + 8 * fq;
                    float* x = v[bj];
                    if (pn < 2) {
                        const int col = (4 * pn + wc) * 64 + cl; pg8::u32x4 w;
                        w.x = pg8::cvt_pk_bf16(x[0] * rstd * gq[bj][0], x[1] * rstd * gq[bj][1]); w.y = pg8::cvt_pk_bf16(x[2] * rstd * gq[bj][2], x[3] * rstd * gq[bj][3]);
                        w.z = pg8::cvt_pk_bf16(x[4] * rstd * gq[bj][4], x[5] * rstd * gq[bj][5]); w.w = pg8::cvt_pk_bf16(x[6] * rstd * gq[bj][6], x[7] * rstd * gq[bj][7]);
                        *(pg8::u32x4*)(QB + (size_t)r * ATT_W + col) = w;
                        if (smp) { const float ic = 1.f / attn_body::C2; float* qn = QN + (size_t)r * ATT_W + col;
                            *(pg8::f32x4*)qn = (pg8::f32x4){x[0] * rstd * gq[bj][0] * ic, x[1] * rstd * gq[bj][1] * ic, x[2] * rstd * gq[bj][2] * ic, x[3] * rstd * gq[bj][3] * ic};
                            *(pg8::f32x4*)(qn + 4) = (pg8::f32x4){x[4] * rstd * gq[bj][4] * ic, x[5] * rstd * gq[bj][5] * ic, x[6] * rstd * gq[bj][6] * ic, x[7] * rstd * gq[bj][7] * ic}; }
                    } else if (pn < 6) {
                        const bool isk = pn < 4; const int col = (4 * (pn & 1) + wc) * 64 + cl; float y[8];
#pragma unroll
                        for (int e = 0; e < 8; ++e) y[e] = isk ? x[e] * rstd * gq[bj][e] : x[e];
                        float* o = out + (isk ? (smp ? OUT_KS : OUT_KP) : (smp ? OUT_VS : OUT_VP)) + (size_t)(smp ? r - MP : r) * ATT_W + col;
                        *(pg8::f32x4*)o = (pg8::f32x4){y[0], y[1], y[2], y[3]}; *(pg8::f32x4*)(o + 4) = (pg8::f32x4){y[4], y[5], y[6], y[7]};
                        pg8::u32x4 w; w.x = pg8::cvt_pk_bf16(y[0], y[1]); w.y = pg8::cvt_pk_bf16(y[2], y[3]); w.z = pg8::cvt_pk_bf16(y[4], y[5]); w.w = pg8::cvt_pk_bf16(y[6], y[7]);
                        *(pg8::u32x4*)((isk ? KB : VB) + (size_t)r * ATT_W + col) = w;
                    } else if (pn < 10) {
                        const int col = (4 * (pn - 6) + wc) * 64 + cl;
                        pg8::u32x4 w; w.x = pg8::cvt_pk_bf16(x[0], x[1]); w.y = pg8::cvt_pk_bf16(x[2], x[3]); w.z = pg8::cvt_pk_bf16(x[4], x[5]); w.w = pg8::cvt_pk_bf16(x[6], x[7]);
                        *(pg8::u32x4*)(QIb + (size_t)r * QI_LD + col) = w;
                    } else if (pn == 10) {
                        if (wc == 0) {
                            float* o = out + (smp ? OUT_IKS : OUT_IKP) + (size_t)(smp ? r - MP : r) * IDD + cl;
                            *(pg8::f32x4*)o = (pg8::f32x4){x[0] * rstd, x[1] * rstd, x[2] * rstd, x[3] * rstd}; *(pg8::f32x4*)(o + 4) = (pg8::f32x4){x[4] * rstd, x[5] * rstd, x[6] * rstd, x[7] * rstd};
                            pg8::u32x4 w; w.x = pg8::cvt_pk_bf16(x[0] * rstd, x[1] * rstd); w.y = pg8::cvt_pk_bf16(x[2] * rstd, x[3] * rstd); w.z = pg8::cvt_pk_bf16(x[4] * rstd, x[5] * rstd); w.w = pg8::cvt_pk_bf16(x[6] * rstd, x[7] * rstd);
                            *(pg8::u32x4*)(KIb + (size_t)r * IDD + cl) = w;
                        } else if (wc == 1) {
                            if (bj == 0 && fq < 2) { float* o = WI + (size_t)r * IH + 8 * fq; *(pg8::f32x4*)o = (pg8::f32x4){x[0], x[1], x[2], x[3]}; *(pg8::f32x4*)(o + 4) = (pg8::f32x4){x[4], x[5], x[6], x[7]}; }
                        } else {
                            float* o = PRW + (size_t)r * RW_COLS + 1536 + 64 * (wc - 2) + cl;
                            *(pg8::f32x4*)o = (pg8::f32x4){x[0], x[1], x[2], x[3]}; *(pg8::f32x4*)(o + 4) = (pg8::f32x4){x[4], x[5], x[6], x[7]}; }
                    } else if (pn < 17) {
                        float* o = PRW + (size_t)r * RW_COLS + (pn - 11) * 256 + 64 * wc + cl;
                        *(pg8::f32x4*)o = (pg8::f32x4){x[0], x[1], x[2], x[3]}; *(pg8::f32x4*)(o + 4) = (pg8::f32x4){x[4], x[5], x[6], x[7]};
                    } else if (wc < 2) {
                        float* o = PRW + (size_t)r * RW_COLS + 1664 + 64 * wc + cl;
                        *(pg8::f32x4*)o = (pg8::f32x4){x[0], x[1], x[2], x[3]}; *(pg8::f32x4*)(o + 4) = (pg8::f32x4){x[4], x[5], x[6], x[7]}; }
                }
            }
    }
};
struct EpiSwiGLU {
    static constexpr bool PERM = true, AFTER_DRAIN = false;
    bf16* H;
    __device__ __forceinline__ void operator()(const pg8::f32x4 (&acc)[2][2][4][2], const pg8::Unit& u, int wr, int wc, int fr, int fq) const {
        const int row0 = u.pm * 256 + wr * 64 + fr, col0 = u.pn * 128 + wc * 32 + 8 * fq;
#pragma unroll
        for (int ai = 0; ai < 2; ++ai)
#pragma unroll
            for (int m = 0; m < 4; ++m) { float hv[8];
#pragma unroll
                for (int n = 0; n < 2; ++n)
#pragma unroll
                    for (int i = 0; i < 4; ++i) { const float g = acc[ai][0][m][n][i], up = acc[ai][1][m][n][i]; hv[4 * n + i] = g * __builtin_amdgcn_rcpf(1.f + __expf(-g)) * up; }
                pg8::u32x4 w; w.x = pg8::cvt_pk_bf16(hv[0], hv[1]); w.y = pg8::cvt_pk_bf16(hv[2], hv[3]); w.z = pg8::cvt_pk_bf16(hv[4], hv[5]); w.w = pg8::cvt_pk_bf16(hv[6], hv[7]);
                *(pg8::u32x4*)(H + (size_t)(row0 + ai * 128 + m * 16) * FFN + col0) = w; }
    }
};
template <class F> __device__ __forceinline__ void sample_gemm(const Ctx& C, const bf16* A, const bf16* Bt, int K, const F& f) {
    typedef short bf16x8 __attribute__((ext_vector_type(8))); typedef float f32x16 __attribute__((ext_vector_type(16)));
    LAS float* red = (LAS float*)C.lds;
    const int lane = C.lane, hi = lane >> 5, ksteps = K / 16 / NWAVES;
    for (int u = (int)blockIdx.x - 128; u >= 0 && u < D / 32; u += C.G) {
        const int n0 = 32 * u;
        const bf16* ap = A + (size_t)(lane & 31) * K + (size_t)C.wave * ksteps * 16 + 8 * hi; const bf16* bp = Bt + (size_t)(n0 + (lane & 31)) * K + (size_t)C.wave * ksteps * 16 + 8 * hi;
        f32x16 acc = f32x16{};
        for (int ks = 0; ks < ksteps; ++ks) acc = __builtin_amdgcn_mfma_f32_32x32x16_bf16(*(const bf16x8*)(ap + 16 * ks), *(const bf16x8*)(bp + 16 * ks), acc, 0, 0, 0);
        __syncthreads();
#pragma unroll
        for (int r = 0; r < 16; ++r) red[(C.wave * 64 + lane) * 16 + r] = acc[r];
        __syncthreads();
        for (int o = C.tid; o < 1024; o += NTHREADS) { const int ls = o & 63, r = o >> 6; float v = 0.f;
#pragma unroll
            for (int w = 0; w < 8; ++w) v += red[(w * 64 + ls) * 16 + r];
            f((r & 3) + 8 * (r >> 2) + 4 * (ls >> 5), n0 + (ls & 31), v); }
    }
    __syncthreads();
}

__device__ __forceinline__ void p0_mod(const Ctx& C) {
    LAS float* sc = (LAS float*)C.lds;
    const float* cp = C.in[8]; const float* cs = C.in[9]; const float* wada = C.in[12]; const float* bada = C.in[13];
    float* MOD = (float*)(C.ws + WS_MOD);
    const int cl = C.tid & 31, kc = C.tid >> 5;
    for (int u = blockIdx.x; u < MODW / 32; u += C.G) {
        const int c0 = 32 * u;
        float acc[40];
#pragma unroll
        for (int r = 0; r < 40; ++r) acc[r] = 0.f;
        for (int hh = 0; hh < 2; ++hh) {
            __syncthreads();
            for (int i = C.tid; i < 40 * 512; i += NTHREADS) { const int r = i >> 9, kk = i & 511; const float v = (r < NB) ? cp[r * D + 512 * hh + kk] : cs[(r - NB) * D + 512 * hh + kk]; sc[i] = v / (1.f + expf(-v)); }
            __syncthreads();
            const int kb = 512 * hh + 32 * kc;
            for (int k4 = 0; k4 < 8; ++k4) {
                const float* wp = wada + (size_t)(kb + 4 * k4) * MODW + c0 + cl;
                const float w0 = wp[0], w1 = wp[MODW], w2 = wp[2 * MODW], w3 = wp[3 * MODW];
#pragma unroll
                for (int r = 0; r < 40; ++r) { const f32x4 s = *(const LAS f32x4*)(sc + r * 512 + 32 * kc + 4 * k4); acc[r] += s.x * w0 + s.y * w1 + s.z * w2 + s.w * w3; }
            }
        }
        __syncthreads();
#pragma unroll
        for (int r = 0; r < 40; ++r) sc[(kc * 40 + r) * 32 + cl] = acc[r];
        __syncthreads();
        for (int i = C.tid; i < 40 * 32; i += NTHREADS) { const int r = i >> 5, c = i & 31; float s = 0.f;
            for (int k = 0; k < 16; ++k) s += sc[(k * 40 + r) * 32 + c];
            MOD[r * MODW + c0 + c] = s + bada[c0 + c]; }
    }
    __syncthreads();
}
template <int MODE = 0> __device__ __forceinline__ void transpose_item(const float* W, int K, int N, int NP, bf16* WT, int row_off, LAS float* scr, int item, int lane) {
    const int nblk = NP / 32, kb = item / nblk, nb = item % nblk, k0 = 64 * kb, n0 = 32 * nb;
    const int nsrc = n0 + (lane & 31);
#pragma unroll 8
    for (int i = 0; i < 32; ++i) { const int kk = 2 * i + (lane >> 5); scr[kk * 33 + (lane & 31)] = (nsrc < N) ? W[(size_t)(k0 + kk) * N + nsrc] : 0.f; }
    LDS_WAIT(); asm volatile("" ::: "memory");
    const int c = lane & 7;
#pragma unroll
    for (int j = 0; j < 4; ++j) { const int n = (lane >> 3) + 8 * j; const LAS float* s = scr + (8 * c) * 33 + n;
        v4u o; o.x = pk2(s[0 * 33], s[1 * 33]); o.y = pk2(s[2 * 33], s[3 * 33]); o.z = pk2(s[4 * 33], s[5 * 33]); o.w = pk2(s[6 * 33], s[7 * 33]);
        const int nn = n0 + n; int drow;
        if (MODE == 0) drow = row_off + nn;
        else if (MODE == 3) { int tile, L;
            if (nn < 2560) { tile = nn >> 8; L = nn & 255; } else if (nn < 2624) { tile = 10; L = nn - 2560; } else if (nn < 2640) { tile = 10; L = 64 + (nn - 2624); }
            else if (nn < 4176) { tile = 11 + ((nn - 2640) >> 8); L = (nn - 2640) & 255; } else if (nn < 4240) { tile = 10; L = 128 + (nn - 4176); } else if (nn < 4304) { tile = 10; L = 192 + (nn - 4240); }
            else { tile = 17; L = nn - 4304; }
            drow = 256 * tile + 128 * ((L >> 5) & 1) + 32 * (L >> 6) + (L & 31); }
        else drow = 256 * (nn >> 7) + (nn & 127) + (MODE == 2 ? 128 : 0);
        if (MODE != 3 || nn < N) *(GAS v4u*)(WT + (size_t)drow * K + k0 + 8 * c) = o; }
    LDS_WAIT(); asm volatile("" ::: "memory");
}
__device__ __forceinline__ void p0_weights(const Ctx& C) {
    LAS float* scr = (LAS float*)(C.lds + C.wave * 16384);
    constexpr int I_IN = (D / 64) * 139, I_OUT = (D / 64) * (D / 32), I_G = (D / 64) * (FFN / 32), I_DN = (FFN / 64) * (D / 32);
    constexpr int I_L = RW_W / 32, NITEMS = I_IN + I_OUT + 2 * I_G + I_DN + 4 * I_L;
    bf16* WIN = (bf16*)(C.ws + WS_WIN); bf16* WOUT = (bf16*)(C.ws + WS_WOUT); bf16* WGU = (bf16*)(C.ws + WS_WGU); bf16* WDN = (bf16*)(C.ws + WS_WDN);
    for (int it = C.gw; it < NITEMS; it += C.ngw) {
        int r = it;
        if (r < I_IN) { transpose_item<3>(C.in[14], D, IN_COLS, 139 * 32, WIN, 0, scr, r, C.lane); continue; } r -= I_IN;
        if (r < I_OUT) { transpose_item(C.in[28], D, D, D, WOUT, 0, scr, r, C.lane); continue; } r -= I_OUT;
        if (r < I_G) { transpose_item<1>(C.in[29], D, FFN, FFN, WGU, 0, scr, r, C.lane); continue; } r -= I_G;
        if (r < I_G) { transpose_item<2>(C.in[30], D, FFN, FFN, WGU, 0, scr, r, C.lane); continue; } r -= I_G;
        if (r < I_DN) { transpose_item(C.in[31], FFN, D, D, WDN, 0, scr, r, C.lane); continue; } r -= I_DN;
        if (r < I_L) { transpose_item(C.in[19], 64, RW_W, RW_W, (bf16*)(C.ws + WS_W2T), 0, scr, r, C.lane); continue; } r -= I_L;
        if (r < I_L) { transpose_item(C.in[21], 64, RW_W, RW_W, (bf16*)(C.ws + WS_A2T), 0, scr, r, C.lane); continue; } r -= I_L;
        transpose_item(C.in[22], 128, RW_W, RW_W, (bf16*)(C.ws + WS_G2T), 0, scr, r, C.lane);
    }
    for (int i = C.gw; i < 176; i += C.ngw) { const int L = i < 48 ? 80 + i : 128 + (i - 48), tile = i < 48 ? 10 : 17;
        GAS v4u* rowp = (GAS v4u*)(WIN + (size_t)(256 * tile + 128 * ((L >> 5) & 1) + 32 * (L >> 6) + (L & 31)) * D);
        rowp[C.lane] = (v4u){0u, 0u, 0u, 0u}; rowp[64 + C.lane] = (v4u){0u, 0u, 0u, 0u}; }
}
__device__ __forceinline__ void norm_mod_row(const Ctx& C, int m, const float* xr, const float* g, const float* shift, const float* scale, bf16* orow) {
    const GAS f32x4* xp = (const GAS f32x4*)xr + C.lane;
    f32x4 v[4]; float s = 0.f;
#pragma unroll
    for (int j = 0; j < 4; ++j) { v[j] = xp[64 * j]; s += (v[j].x * v[j].x + v[j].y * v[j].y) + (v[j].z * v[j].z + v[j].w * v[j].w); }
    const float rstd = 1.f / sqrtf(wave_sum(s) * (1.f / D) + RMS_EPS);
    GAS unsigned long long* o8 = (GAS unsigned long long*)orow + C.lane;
#pragma unroll
    for (int j = 0; j < 4; ++j) { const int c = 4 * (C.lane + 64 * j);
        const f32x4 gg = *(const f32x4*)(g + c), sh = *(const f32x4*)(shift + c), sc = *(const f32x4*)(scale + c);
        const f32x4 h = v[j] * rstd * gg * (1.f + sc) + sh;
        o8[64 * j] = (unsigned long long)pk2(h.x, h.y) | ((unsigned long long)pk2(h.z, h.w) << 32); }
}
__device__ __forceinline__ void p1_norm1(const Ctx& C) {
    bf16* A1 = (bf16*)(C.ws + WS_A1); const float* MOD = (const float*)(C.ws + WS_MOD);
    for (int m = C.gw; m < MPAD; m += C.ngw) {
        bf16* orow = A1 + (size_t)m * D;
        if (m >= MT) { GAS unsigned long long* o8 = (GAS unsigned long long*)orow + C.lane;
#pragma unroll
            for (int j = 0; j < 4; ++j) o8[64 * j] = 0ull;
            continue; }
        const float* md = MOD + mod_row(m) * MODW;
        norm_mod_row(C, m, x_row(C, m), C.in[10], md, md + D, orow);
    }
}
__device__ __forceinline__ void p3_post(const Ctx& C) {
    const float* PROJ = (const float*)(C.ws + WS_PROJ); float* QN = (float*)(C.ws + WS_QN);
    const int lane = C.lane;
    const float qg = C.in[15][lane], kg = C.in[16][lane];
    for (int m = C.gw; m < MT; m += C.ngw) {
        const float* p = PROJ + (size_t)m * NIN;
        const bool smp = m >= MP; const int j = m - MP;
        float* ko = C.out + (smp ? OUT_KS + (size_t)j * ATT_W : OUT_KP + (size_t)m * ATT_W);
        float* vo = C.out + (smp ? OUT_VS + (size_t)j * ATT_W : OUT_VP + (size_t)m * ATT_W);
        float* io = C.out + (smp ? OUT_IKS + (size_t)j * IDD : OUT_IKP + (size_t)m * IDD);
        float* qn = QN + (size_t)m * ATT_W;
        bf16* qb = (bf16*)(C.ws + WS_QB) + (size_t)m * ATT_W; bf16* kb = (bf16*)(C.ws + WS_KB) + (size_t)m * ATT_W; bf16* vb = (bf16*)(C.ws + WS_VB) + (size_t)m * ATT_W;
        for (int h = 0; h < AH; ++h) {
            const float q = p[O_Q + h * 64 + lane], k = p[O_K + h * 64 + lane];
            const float sq = wave_sum(q * q), sk = wave_sum(k * k);
            const float qv = q * (1.f / sqrtf(sq * (1.f / 64.f) + RMS_EPS)) * qg, kv = k * (1.f / sqrtf(sk * (1.f / 64.f) + RMS_EPS)) * kg, vv = p[O_V + h * 64 + lane];
            qn[h * 64 + lane] = qv; ko[h * 64 + lane] = kv; vo[h * 64 + lane] = vv;
            qb[h * 64 + lane] = (bf16)f2bf(qv * attn_body::C2); kb[h * 64 + lane] = (bf16)f2bf(kv); vb[h * 64 + lane] = (bf16)f2bf(vv);
        }
        const float ki = p[O_KI + lane];
        const float kin = ki * (1.f / sqrtf(wave_sum(ki * ki) * (1.f / 64.f) + RMS_EPS));
        io[lane] = kin;
        ((bf16*)(C.ws + WS_KIB))[(size_t)m * IDD + lane] = (bf16)f2bf(kin);
        { bf16* qi = (bf16*)(C.ws + WS_QIB) + (size_t)m * QI_LD; float ql = 0.f;
          for (int h = 0; h < IH; ++h) { const float v = p[O_QI + h * 64 + lane]; qi[h * 64 + lane] = (bf16)f2bf(v); ql += p[O_WI + h] * v; }
          qi[IH * 64 + lane] = (bf16)f2bf(ql);
          if (lane < IH) ((float*)(C.ws + WS_WI))[(size_t)m * IH + lane] = p[O_WI + lane]; }
        if (smp || (m & (T - 1)) == T - 1) {
            float* so = C.out + (smp ? OUT_SHS + (size_t)j * RW_COLS : OUT_SHP + (size_t)(m >> 11) * RW_COLS);
            for (int i = 0; i < RW_COLS / 64; ++i) so[i * 64 + lane] = p[O_RW + i * 64 + lane];
        }
    }
}
template <bool OLD_ALL> __device__ __forceinline__ void p3_rwprep(const Ctx& C) {
    const float* PRW = (const float*)(C.ws + WS_PRW);
    float* Rr = (float*)(C.ws + WS_RWA), *Wd = (float*)(C.ws + WS_RWA + RWA_STRIDE), *Kp = (float*)(C.ws + WS_RWA + 2 * RWA_STRIDE), *Vv = (float*)(C.ws + WS_RWA + 3 * RWA_STRIDE),
          *KK = (float*)(C.ws + WS_RWA + 4 * RWA_STRIDE), *Bb = (float*)(C.ws + WS_RWA + 5 * RWA_STRIDE), *Gg = (float*)(C.ws + WS_RWA + 6 * RWA_STRIDE);
    const float* mu = C.in[17]; const float* w0 = C.in[18]; const float* w2 = C.in[19]; const float* a0 = C.in[20]; const float* a2 = C.in[21]; const float* g2 = C.in[22];
    const float* k_k = C.in[23]; const float* k_a = C.in[24];
    LAS float* lw = (LAS float*)(C.lds + C.wave * 1024);
    const int lane = C.lane;
    for (int m = C.gw; m < MT; m += C.ngw) {
        const float* p = PRW + (size_t)m * RW_COLS;
        const bool smp = m >= MP; const int j = m - MP; const int t = m & (T - 1);
        const float* pv = smp ? C.in[6] + (size_t)j * RW_COLS : (t == 0 ? nullptr : p - RW_COLS);
        if (smp || t == T - 1) { float* so = C.out + (smp ? OUT_SHS + (size_t)j * RW_COLS : OUT_SHP + (size_t)(m >> 11) * RW_COLS);
            for (int i = 0; i < RW_COLS / 64; ++i) so[i * 64 + lane] = p[i * 64 + lane]; }
#define XM(c) ({ const int c_ = (c); const float cur_ = p[c_]; const float prv_ = pv ? pv[c_] : 0.f; cur_ + (prv_ - cur_) * mu[c_]; })
        const float l0 = tanhf(XM(1536 + lane)), l1 = XM(1600 + lane), l2 = sigmoidf_(XM(1664 + lane)), l3 = sigmoidf_(XM(1728 + lane));
        if (!smp) {
            bf16* lin = (bf16*)(C.ws + WS_LIN) + (size_t)m * 256; float* KX = (float*)(C.ws + WS_KX);
            lin[lane] = (bf16)f2bf(l0); lin[64 + lane] = (bf16)f2bf(l1); lin[128 + lane] = (bf16)f2bf(l2); lin[192 + lane] = (bf16)f2bf(l3);
            for (int h = 0; h < RH; ++h) { const int c = h * 64 + lane; const size_t o = (size_t)m * RW_W + c;
                const float r = XM(c), k = XM(512 + c), v = XM(1024 + c);
                float kk = k * k_k[c]; const float nrm = wave_sum(kk * kk); kk *= 1.f / sqrtf(fmaxf(nrm, 1e-24f));
                Rr[o] = r; KX[o] = k; Vv[o] = v; KK[o] = kk; }
            if (!OLD_ALL) continue;
        }
        lw[lane] = l0; lw[64 + lane] = l1; lw[128 + lane] = l2; lw[192 + lane] = l3;
        LDS_WAIT(); asm volatile("" ::: "memory");
        for (int h = 0; h < RH; ++h) {
            const int c = h * 64 + lane;
            float aw = w0[c], aa = a0[c], ag = 0.f;
            for (int jj = 0; jj < 64; ++jj) { aw += lw[jj] * w2[jj * RW_W + c]; aa += lw[64 + jj] * a2[jj * RW_W + c]; }
            for (int jj = 0; jj < 128; ++jj) ag += lw[128 + jj] * g2[jj * RW_W + c];
            const float decay = expf(-0.6065306597126334f * sigmoidf_(aw));
            const float a = sigmoidf_(aa);
            const float r = XM(c), k = XM(512 + c), v = XM(1024 + c);
            float kk = k * k_k[c]; const float nrm = wave_sum(kk * kk); kk *= 1.f / sqrtf(fmaxf(nrm, 1e-24f));
            const float kp = k * (1.f + (a - 1.f) * k_a[c]);
            const size_t o = (size_t)m * RW_W + c;
            Rr[o] = r; Wd[o] = decay; Kp[o] = kp; Vv[o] = v; KK[o] = kk; Bb[o] = kk * a; Gg[o] = ag;
        }
#undef XM
        LDS_WAIT(); asm volatile("" ::: "memory");
    }
}
namespace idxsel {
typedef short bf16x8 __attribute__((ext_vector_type(8)));
typedef float f32x16 __attribute__((ext_vector_type(16)));
constexpr int QT_BYTES = 17 * 32 * 128, WT_OFF = QT_BYTES, CNT_OFF = WT_OFF + 32 * 17 * 4;
__device__ __forceinline__ int crow(int r, int hi) { return (r & 3) + 8 * (r >> 2) + 4 * hi; }
__device__ __forceinline__ void unit(const Ctx& C, int b, int qg) {
    const int lane = C.lane, r32 = lane & 31, hi = lane >> 5, wave = C.wave;
    LAS unsigned char* lds = C.lds;
    const bf16* QIb = (const bf16*)(C.ws + WS_QIB); const bf16* KIb = (const bf16*)(C.ws + WS_KIB); const float* WIr = (const float*)(C.ws + WS_WI);
    unsigned long long* MASKT = (unsigned long long*)(C.ws + WS_MASKT);
    LAS float* WT = (LAS float*)(lds + WT_OFF); LAS int* CNT = (LAS int*)(lds + CNT_OFF);
    const size_t row0 = (size_t)b * T + 32 * qg;
    __syncthreads();
    for (int i = C.tid; i < 32 * 128; i += NTHREADS) { const int q = i >> 7, hc = i & 127, h = hc >> 3, c = hc & 7;
        const v4u v = *(const v4u*)(QIb + (row0 + q) * QI_LD + hc * 8);
        *(LAS v4u*)(lds + ((h * 32 + q) * 8 + (c ^ (q & 7))) * 16) = v; }
    { const int q = C.tid >> 4, h = C.tid & 15; WT[q * 17 + h] = WIr[(row0 + q) * IH + h]; }
    __syncthreads();
    if (C.tid < 256) {
        const int q = C.tid >> 3, c = C.tid & 7; float a8[8];
#pragma unroll
        for (int e = 0; e < 8; ++e) a8[e] = 0.f;
        for (int h = 0; h < 16; ++h) { const v4u v = *(const LAS v4u*)(lds + ((h * 32 + q) * 8 + (c ^ (q & 7))) * 16); const float w = WT[q * 17 + h];
            a8[0] += w * __builtin_bit_cast(float, v.x << 16); a8[1] += w * __builtin_bit_cast(float, v.x & 0xffff0000u); a8[2] += w * __builtin_bit_cast(float, v.y << 16); a8[3] += w * __builtin_bit_cast(float, v.y & 0xffff0000u);
            a8[4] += w * __builtin_bit_cast(float, v.z << 16); a8[5] += w * __builtin_bit_cast(float, v.z & 0xffff0000u); a8[6] += w * __builtin_bit_cast(float, v.w << 16); a8[7] += w * __builtin_bit_cast(float, v.w & 0xffff0000u); }
        v4u o; o.x = pk2(a8[0], a8[1]); o.y = pk2(a8[2], a8[3]); o.z = pk2(a8[4], a8[5]); o.w = pk2(a8[6], a8[7]);
        *(LAS v4u*)(lds + ((16 * 32 + q) * 8 + (c ^ (q & 7))) * 16) = o; }
    __syncthreads();
    f32x16 sc[8];
#pragma unroll
    for (int j = 0; j < 8; ++j) sc[j] = f32x16{};
#pragma unroll
    for (int j = 0; j < 8; ++j) {
        const int kt0 = wave + 8 * j;
        asm volatile("" ::: "memory");
        if (kt0 <= qg) {
            bf16x8 ka[4];
            const bf16* kp0 = KIb + ((size_t)b * T + kt0 * 32 + r32) * IDD + 8 * hi;
#pragma unroll
            for (int s4 = 0; s4 < 4; ++s4) ka[s4] = *(const bf16x8*)(kp0 + 16 * s4);
            bf16x8 qf[4];
#pragma unroll
            for (int s4 = 0; s4 < 4; ++s4) qf[s4] = *(const LAS bf16x8*)(lds + ((0 * 32 + r32) * 8 + ((2 * s4 + hi) ^ (r32 & 7))) * 16);
#pragma unroll 1
            for (int h = 0; h < 17; ++h) {
                bf16x8 qn[4];
                const int hn = h < 16 ? h + 1 : 16;
#pragma unroll
                for (int s4 = 0; s4 < 4; ++s4) qn[s4] = *(const LAS bf16x8*)(lds + ((hn * 32 + r32) * 8 + ((2 * s4 + hi) ^ (r32 & 7))) * 16);
                const float w = WT[r32 * 17 + h];
                f32x16 xa = f32x16{};
#pragma unroll
                for (int s4 = 0; s4 < 4; ++s4) xa = __builtin_amdgcn_mfma_f32_32x32x16_bf16(ka[s4], qf[s4], xa, 0, 0, 0);
                if (h < 16) {
#pragma unroll
                    for (int r = 0; r < 16; ++r) sc[j][r] = __builtin_fmaf(__builtin_fabsf(xa[r]), w, sc[j][r]); }
                else {
#pragma unroll
                    for (int r = 0; r < 16; ++r) sc[j][r] += xa[r]; }
#pragma unroll
                for (int s4 = 0; s4 < 4; ++s4) qf[s4] = qn[s4];
            }
        }
    }
    unsigned key[8][16];
#pragma unroll
    for (int j = 0; j < 8; ++j) { const int kt = wave + 8 * j;
#pragma unroll
        for (int r = 0; r < 16; ++r) { const bool valid = (kt < qg) || (kt == qg && crow(r, hi) <= r32); key[j][r] = valid ? sortable(sc[j][r]) : 0u; } }
    unsigned Tk = 1u;
    if (qg >= 8) {
        Tk = 0u; int buf = 0;
        for (int bit = 31; bit >= 0; --bit) {
            const unsigned cand = Tk | (1u << bit); int c = 0;
#pragma unroll
            for (int j = 0; j < 8; ++j) if (wave + 8 * j <= qg) {
#pragma unroll
                for (int r = 0; r < 16; ++r) c += (key[j][r] >= cand) ? 1 : 0; }
            c += __shfl_xor(c, 32);
            if (hi == 0) CNT[(buf * 8 + wave) * 32 + r32] = c;
            __syncthreads();
            int tot = 0;
#pragma unroll
            for (int w = 0; w < 8; ++w) tot += CNT[(buf * 8 + w) * 32 + r32];
            if (tot >= TOPK) Tk = cand;
            buf ^= 1;
        }
    }
#pragma unroll
    for (int j = 0; j < 8; ++j) { const int kt = wave + 8 * j; unsigned long long mine = 0ull;
#pragma unroll
        for (int r = 0; r < 16; ++r) { const unsigned long long W = __ballot(key[j][r] >= Tk); if (lane == r) mine = W; }
        if (lane < 16) MASKT[(((size_t)(b * 64 + qg) * 32 + (kt >> 1)) * 32) + (kt & 1) * 16 + lane] = mine; }
}
__device__ __forceinline__ void phase(const Ctx& C) {
    const int v = (int)((blockIdx.x % 8) * (C.G / 8) + blockIdx.x / 8);
    for (int vv = v; vv < NB * 32; vv += C.G) { const int b = vv >> 5, i = vv & 31; unit(C, b, 63 - i); unit(C, b, i); }
    __syncthreads();
}
}
__device__ __forceinline__ float idx_score(const float (&kr)[64], const LAS float* ql, const LAS float* wl) {
    float score = 0.f;
    for (int h = 0; h < IH; ++h) {
        float d = 0.f;
#pragma unroll
        for (int dd = 0; dd < 64; dd += 4) { const f32x4 qv = *(const LAS f32x4*)(ql + h * 64 + dd); d += qv.x * kr[dd] + qv.y * kr[dd + 1] + qv.z * kr[dd + 2] + qv.w * kr[dd + 3]; }
        score += wl[h] * fmaxf(d, 0.f);
    }
    return score;
}
template <bool PROMPT, bool SAMPLE> __device__ __forceinline__ void p4_indexer(const Ctx& C) {
    const float* PROJ = (const float*)(C.ws + WS_PROJ); float* SC = (float*)(C.ws + WS_SC); float* SCS = (float*)(C.ws + WS_SCS);
    LAS float* ql = (LAS float*)C.lds;
    LAS float* wl = ql + 16 * 1024;
    const int lane = C.lane;
    if (PROMPT) for (int u = blockIdx.x; u < NB * 128 * 4; u += C.G) {
        const int b = u >> 9, tq = (u >> 2) & 127, scn = u & 3, t0 = tq * 16;
        if (scn * 512 > t0 + 15) continue;
        __syncthreads();
        for (int i = C.tid; i < 16 * 1024; i += NTHREADS) { const int q = i >> 10, e = i & 1023; ql[i] = PROJ[(size_t)(b * T + t0 + q) * NIN + O_QI + e]; }
        if (C.tid < 256) { const int q = C.tid >> 4, h = C.tid & 15; wl[C.tid] = PROJ[(size_t)(b * T + t0 + q) * NIN + O_WI + h] * IDX_W_SCALE; }
        __syncthreads();
        const int s = scn * 512 + C.wave * 64 + lane;
        if (scn * 512 + C.wave * 64 <= t0 + 15) {
            float kr[64];
            const f32x4* kp = (const f32x4*)(C.out + OUT_IKP + (size_t)(b * T + s) * IDD);
#pragma unroll
            for (int i = 0; i < 16; ++i) { const f32x4 v = kp[i]; kr[4 * i] = v.x; kr[4 * i + 1] = v.y; kr[4 * i + 2] = v.z; kr[4 * i + 3] = v.w; }
            for (int q = 0; q < 16; ++q) {
                const float score = idx_score(kr, ql + q * 1024, wl + q * 16);
                const int t = t0 + q;
                if (s <= t) SC[((size_t)b * T + t) * T + s] = score;
            }
        }
    }
    __syncthreads();
    const int* pt = (const int*)C.in[7];
    LAS float* qw = (LAS float*)(C.lds + C.wave * 8192); LAS float* ww = qw + 1024;
    if (SAMPLE) for (int wu = C.gw; wu < NSMP * 129; wu += C.ngw) {
        const int j = wu / 129, kb = wu % 129;
        const bf16* pq = (const bf16*)(C.ws + WS_QIB) + (size_t)(MP + j) * QI_LD;
        for (int i = 0; i < 16; ++i) qw[i * 64 + lane] = __builtin_bit_cast(float, (unsigned)pq[i * 64 + lane] << 16);
        if (lane < 16) ww[lane] = ((const float*)(C.ws + WS_WI))[(size_t)(MP + j) * IH + lane] * IDX_W_SCALE;
        LDS_WAIT(); asm volatile("" ::: "memory");
        const int s = kb * 64 + lane;
        const float* krow = nullptr;
        if (s < PAST) krow = C.in[4] + ((size_t)pt[j * NPAGES + (s >> 7)] * PAGE + (s & 127)) * IDD;
        else if (s == PAST) krow = C.out + OUT_IKS + (size_t)j * IDD;
        float score = -INFINITY;
        if (krow) { float kr[64]; const f32x4* kp = (const f32x4*)krow;
#pragma unroll
            for (int i = 0; i < 16; ++i) { const f32x4 v = kp[i]; kr[4 * i] = v.x; kr[4 * i + 1] = v.y; kr[4 * i + 2] = v.z; kr[4 * i + 3] = v.w; }
            score = idx_score(kr, qw, ww); }
        SCS[(size_t)j * SCS_LD + s] = score;
        LDS_WAIT(); asm volatile("" ::: "memory");
    }
}
template <bool PROBE> __device__ __forceinline__ void p4_scan(const Ctx& C, int u_begin) {
    const float* Rr = (const float*)(C.ws + WS_RWA), *Wd = (const float*)(C.ws + WS_RWA + RWA_STRIDE), *Kp = (const float*)(C.ws + WS_RWA + 2 * RWA_STRIDE), *Vv = (const float*)(C.ws + WS_RWA + 3 * RWA_STRIDE),
          *KK = (const float*)(C.ws + WS_RWA + 4 * RWA_STRIDE), *Bb = (const float*)(C.ws + WS_RWA + 5 * RWA_STRIDE);
    float* Y = (float*)(C.ws + (PROBE ? WS_Y2 : WS_Y));
    const int lane = C.lane;
    for (int u = u_begin + C.gw; u < (PROBE ? NB * RH : NB * RH + NSMP * RH); u += C.ngw) {
        const bool smp = u >= NB * RH; const int seq = smp ? (u - NB * RH) / RH : u / RH, h = u % RH;
        const int nsteps = smp ? 1 : T; const size_t base = smp ? (size_t)(MP + seq) : (size_t)seq * T;
        float S[64];
        if (smp) { const f32x4* sp = (const f32x4*)(C.in[5] + (((size_t)seq * RH + h) * RN + lane) * RN);
#pragma unroll
            for (int i = 0; i < 16; ++i) { const f32x4 v = sp[i]; S[4 * i] = v.x; S[4 * i + 1] = v.y; S[4 * i + 2] = v.z; S[4 * i + 3] = v.w; } }
        else {
#pragma unroll
            for (int i = 0; i < 64; ++i) S[i] = 0.f; }
        size_t o = base * RW_W + h * 64 + lane;
        float r = Rr[o], w = Wd[o], k = Kp[o], v = Vv[o], kk = KK[o], bb = Bb[o];
        for (int t = 0; t < nsteps; ++t) {
            float rn = 0.f, wn = 0.f, kn = 0.f, vn = 0.f, kkn = 0.f, bbn = 0.f;
            const size_t on = o + RW_W;
            if (t + 1 < nsteps) { rn = Rr[on]; wn = Wd[on]; kn = Kp[on]; vn = Vv[on]; kkn = KK[on]; bbn = Bb[on]; }
            float sa0 = 0.f, sa1 = 0.f;
#pragma unroll
            for (int jx = 0; jx < 64; jx += 2) { sa0 += S[jx] * rdlane(kk, jx); sa1 += S[jx + 1] * rdlane(kk, jx + 1); }
            const float sa = -(sa0 + sa1);
            float y0 = 0.f, y1 = 0.f;
#pragma unroll
            for (int jx = 0; jx < 64; jx += 2) {
                S[jx] = S[jx] * rdlane(w, jx) + sa * rdlane(bb, jx) + v * rdlane(k, jx); y0 += S[jx] * rdlane(r, jx);
                S[jx + 1] = S[jx + 1] * rdlane(w, jx + 1) + sa * rdlane(bb, jx + 1) + v * rdlane(k, jx + 1); y1 += S[jx + 1] * rdlane(r, jx + 1); }
            Y[o] = y0 + y1;
            o = on; r = rn; w = wn; k = kn; v = vn; kk = kkn; bb = bbn;
        }
        f32x4* so = (f32x4*)(C.out + (smp ? OUT_WKVS : OUT_WKVP) + (((size_t)seq * RH + h) * RN + lane) * RN);
        if (!PROBE)
#pragma unroll
        for (int i = 0; i < 16; ++i) so[i] = (f32x4){S[4 * i], S[4 * i + 1], S[4 * i + 2], S[4 * i + 3]};
    }
}
template <bool PROMPT, bool SAMPLE> __device__ __forceinline__ void p5_select(const Ctx& C) {
    const float* SC = (const float*)(C.ws + WS_SC); unsigned* MASK = (unsigned*)(C.ws + WS_MASK);
    const int lane = C.lane;
    if (PROMPT) for (int row = C.gw; row < MP; row += C.ngw) {
        const int t = row & (T - 1); const float* sp = SC + (size_t)row * T;
        unsigned key[32];
#pragma unroll
        for (int j = 0; j < 32; ++j) { const int s = 64 * j + lane; key[j] = (s <= t) ? sortable(sp[s]) : 0u; }
        unsigned Tk = 0u; int need = 0;
        const bool all = (t + 1 <= TOPK);
        if (!all) {
            for (int bit = 31; bit >= 0; --bit) { const unsigned cand = Tk | (1u << bit); int cnt = 0;
#pragma unroll
                for (int j = 0; j < 32; ++j) cnt += __builtin_popcountll(__ballot(key[j] >= cand));
                if (cnt >= TOPK) Tk = cand; }
            int cgt = 0;
#pragma unroll
            for (int j = 0; j < 32; ++j) cgt += __builtin_popcountll(__ballot(key[j] > Tk));
            need = TOPK - cgt;
        }
        int running = 0;
#pragma unroll
        for (int j = 0; j < 32; ++j) {
            const int s = 64 * j + lane; bool take;
            if (all) take = (s <= t);
            else { const bool gt = key[j] > Tk, eq = key[j] == Tk; const unsigned long long eqb = __ballot(eq);
                const int pre = __builtin_popcountll(eqb & lanemask_lt(lane)); take = gt || (eq && (running + pre < need)); running += __builtin_popcountll(eqb); }
            const unsigned long long mb = __ballot(take);
            if (lane == 0) { MASK[(size_t)row * 64 + 2 * j] = (unsigned)mb; MASK[(size_t)row * 64 + 2 * j + 1] = (unsigned)(mb >> 32); }
        }
    }
    const float* SCS = (const float*)(C.ws + WS_SCS); int* SLIST = (int*)(C.ws + WS_SLIST);
    LAS int* sh = (LAS int*)C.lds;
    if (SAMPLE) for (int j = blockIdx.x; j < NSMP; j += C.G) {
        unsigned key[17];
#pragma unroll
        for (int i = 0; i < 17; ++i) { const int s = i * NTHREADS + C.tid; key[i] = (s < LS) ? sortable(SCS[(size_t)j * SCS_LD + s]) : 0u; }
        unsigned Tk = 0u;
        for (int bit = 31; bit >= 0; --bit) { const unsigned cand = Tk | (1u << bit); int c = 0;
#pragma unroll
            for (int i = 0; i < 17; ++i) c += (key[i] >= cand) ? 1 : 0;
            c = wave_sum_i(c);
            __syncthreads(); if (lane == 0) sh[C.wave] = c; __syncthreads();
            int cnt = 0;
#pragma unroll
            for (int w = 0; w < 8; ++w) cnt += sh[w];
            if (cnt >= TOPK) Tk = cand; }
        int cg = 0;
#pragma unroll
        for (int i = 0; i < 17; ++i) cg += (key[i] > Tk) ? 1 : 0;
        cg = wave_sum_i(cg);
        __syncthreads(); if (lane == 0) sh[C.wave] = cg; __syncthreads();
        int cgt = 0;
#pragma unroll
        for (int w = 0; w < 8; ++w) cgt += sh[w];
        const int need = TOPK - cgt;
        int run_eq = 0, run_sel = 0;
#pragma unroll
        for (int i = 0; i < 17; ++i) {
            const int s = i * NTHREADS + C.tid; const bool gt = key[i] > Tk, eq = key[i] == Tk;
            const unsigned long long eqb = __ballot(eq);
            __syncthreads(); if (lane == 0) sh[C.wave] = __builtin_popcountll(eqb); __syncthreads();
            int eq_before = 0, eq_tot = 0;
#pragma unroll
            for (int w = 0; w < 8; ++w) { const int x = sh[w]; eq_tot += x; if (w < C.wave) eq_before += x; }
            const bool take = gt || (eq && (run_eq + eq_before + __builtin_popcountll(eqb & lanemask_lt(lane)) < need));
            const unsigned long long tb = __ballot(take);
            __syncthreads(); if (lane == 0) sh[8 + C.wave] = __builtin_popcountll(tb); __syncthreads();
            int s_before = 0, s_tot = 0;
#pragma unroll
            for (int w = 0; w < 8; ++w) { const int x = sh[8 + w]; s_tot += x; if (w < C.wave) s_before += x; }
            const int pos = run_sel + s_before + __builtin_popcountll(tb & lanemask_lt(lane));
            if (take && pos < TOPK) SLIST[j * TOPK + pos] = s;
            run_eq += eq_tot; run_sel += s_tot;
        }
    }
    __syncthreads();
}
template <int DIFFK> __device__ __forceinline__ void p5_rwfinal(const Ctx& C) {
    const float* Rr = (const float*)(C.ws + WS_RWA), *Kp = (const float*)(C.ws + WS_RWA + 2 * RWA_STRIDE), *Vv = (const float*)(C.ws + WS_RWA + 3 * RWA_STRIDE), *Gg = (const float*)(C.ws + WS_RWA + 6 * RWA_STRIDE);
    const float* Y = (const float*)(C.ws + WS_Y); bf16* MIX = (bf16*)(C.ws + WS_MIX);
    const float* r_k = C.in[25]; const float* ln_w = C.in[26]; const float* ln_b = C.in[27];
    const int lane = C.lane;
    for (int m = C.gw; m < MT; m += C.ngw) {
        for (int h = 0; h < RH; ++h) {
            const int c = h * 64 + lane; const size_t o = (size_t)m * RW_W + c;
            float y = Y[o];
            if (DIFFK != 0 && m < MP) y += (float)DIFFK * (y - ((const float*)(C.ws + WS_Y2))[o]);
            const float mu = wave_sum(y) * (1.f / 64.f); const float dy = y - mu; const float var = wave_sum(dy * dy) * (1.f / 64.f);
            const float yn = dy * (1.f / sqrtf(var + GN_EPS)) * ln_w[c] + ln_b[c];
            const float bonus = wave_sum(Rr[o] * Kp[o] * r_k[c]) * Vv[o];
            MIX[(size_t)m * D + ATT_W + c] = (bf16)f2bf((yn + bonus) * Gg[o]);
        }
    }
}
__device__ __forceinline__ void p6_masktr(const Ctx& C) {
    const unsigned* MASK = (const unsigned*)(C.ws + WS_MASK); unsigned long long* MASKT = (unsigned long long*)(C.ws + WS_MASKT);
    const int lane = C.lane, q = lane & 31, hi = lane >> 5;
    for (int wu = C.gw; wu < NB * 64 * 32; wu += C.ngw) {
        const int j = wu & 31, qg = (wu >> 5) & 63, b = wu >> 11;
        const size_t row = (size_t)b * T + 32 * qg + q;
        const unsigned w0 = MASK[row * 64 + 2 * j], w1 = MASK[row * 64 + 2 * j + 1];
        unsigned long long mine = 0ull;
#pragma unroll
        for (int r = 0; r < 16; ++r) { const int c = (r & 3) + 8 * (r >> 2) + 4 * hi;
            const unsigned long long W0 = __ballot((w0 >> c) & 1u), W1 = __ballot((w1 >> c) & 1u);
            if (lane == r) mine = W0; if (lane == 16 + r) mine = W1; }
        if (lane < 32) MASKT[((size_t)((b * 64 + qg) * 32 + j)) * 32 + lane] = mine;
    }
}
__device__ __forceinline__ void smp_attn(const Ctx& C) {
    const int* SLIST = (const int*)(C.ws + WS_SLIST); const float* QN = (const float*)(C.ws + WS_QN); bf16* MIX = (bf16*)(C.ws + WS_MIX); const int* pt = (const int*)C.in[7];
    LAS int* prow = (LAS int*)C.lds;
    LAS float* pb = (LAS float*)(C.lds + 1024);
    const int lane = C.lane, h = C.wave;
    for (int j = blockIdx.x; j < NSMP; j += C.G) {
        __syncthreads();
        if (C.tid < TOPK) { const int s = SLIST[j * TOPK + C.tid]; prow[C.tid] = (s < PAST) ? pt[j * NPAGES + (s >> 7)] * PAGE + (s & 127) : -1; }
        __syncthreads();
        const float* kn = C.out + OUT_KS + (size_t)j * ATT_W + h * 64; const float* vn = C.out + OUT_VS + (size_t)j * ATT_W + h * 64;
        float q[64];
        { const f32x4* qp = (const f32x4*)(QN + (size_t)(MP + j) * ATT_W + h * 64);
#pragma unroll
          for (int i = 0; i < 16; ++i) { const f32x4 v = qp[i]; q[4 * i] = v.x; q[4 * i + 1] = v.y; q[4 * i + 2] = v.z; q[4 * i + 3] = v.w; } }
        float sc[4]; float mx = -INFINITY;
#pragma unroll
        for (int i = 0; i < 4; ++i) { const int pr = prow[i * 64 + lane]; const float* kp = pr >= 0 ? C.in[2] + (size_t)pr * ATT_W + h * 64 : kn;
            float d = 0.f;
#pragma unroll
            for (int e = 0; e < 16; ++e) { const f32x4 kv = ((const f32x4*)kp)[e]; d += q[4 * e] * kv.x + q[4 * e + 1] * kv.y + q[4 * e + 2] * kv.z + q[4 * e + 3] * kv.w; }
            sc[i] = d * 0.125f; mx = fmaxf(mx, sc[i]); }
        mx = wave_max(mx); float l = 0.f;
#pragma unroll
        for (int i = 0; i < 4; ++i) { const float p = expf(sc[i] - mx); pb[h * 256 + i * 64 + lane] = p; l += p; }
        l = wave_sum(l);
        LDS_WAIT(); asm volatile("" ::: "memory");
        float o = 0.f;
        for (int kx = 0; kx < TOPK; kx += 32) { float vv[32];
#pragma unroll
            for (int e = 0; e < 32; ++e) { const int pr = prow[kx + e]; vv[e] = (pr >= 0 ? C.in[3] + (size_t)pr * ATT_W + h * 64 : vn)[lane]; }
#pragma unroll
            for (int e = 0; e < 32; ++e) o += pb[h * 256 + kx + e] * vv[e]; }
        MIX[(size_t)(MP + j) * D + h * 64 + lane] = (bf16)f2bf(o / l);
    }
    __syncthreads();
}
template <int DIFFK> __device__ __forceinline__ void p6_attn(const Ctx& C, int u_begin, int u_end) {
    const unsigned* MASK = (const unsigned*)(C.ws + WS_MASK); const int* SLIST = (const int*)(C.ws + WS_SLIST); const float* QN = (const float*)(C.ws + WS_QN);
    bf16* MIX = (bf16*)(C.ws + WS_MIX); const int* pt = (const int*)C.in[7];
    LAS int* list = (LAS int*)C.lds;
    LAS float* pb = (LAS float*)(C.lds + 1024);
    LAS int* cntp = (LAS int*)(C.lds + 1024 + 8192);
    const int lane = C.lane, h = C.wave;
    for (int u = u_begin + blockIdx.x; u < u_end; u += C.G) {
        const bool smp = u >= MP; const int j = u - MP, b = u >> 11;
        __syncthreads();
        if (C.wave == 0) {
            if (!smp) { const unsigned w = MASK[(size_t)u * 64 + lane]; const int c = __builtin_popcount(w);
                int incl = c;
#pragma unroll
                for (int o = 1; o < 64; o <<= 1) { const int x = __shfl_up(incl, o); if (lane >= o) incl += x; }
                int pos = incl - c; unsigned ww = w;
                while (ww) { const int bit = __builtin_ctz(ww); ww &= ww - 1u; list[pos++] = 32 * lane + bit; }
                if (lane == 63) *cntp = incl; }
            else { for (int i = 0; i < 4; ++i) list[i * 64 + lane] = SLIST[j * TOPK + i * 64 + lane]; if (lane == 0) *cntp = TOPK; }
        }
        __syncthreads();
        int cnt = *cntp; if (cnt > TOPK) cnt = TOPK;
        float q[64];
        { const f32x4* qp = (const f32x4*)(QN + (size_t)u * ATT_W + h * 64);
#pragma unroll
          for (int i = 0; i < 16; ++i) { const f32x4 v = qp[i]; q[4 * i] = v.x; q[4 * i + 1] = v.y; q[4 * i + 2] = v.z; q[4 * i + 3] = v.w; } }
        float sc[4]; float mx = -INFINITY;
#pragma unroll
        for (int i = 0; i < 4; ++i) { const int idx = i * 64 + lane; sc[i] = -INFINITY;
            if (idx < cnt) { const int s = list[idx]; const float* kp;
                if (!smp) kp = C.out + OUT_KP + ((size_t)(b * T + s)) * ATT_W + h * 64;
                else if (s < PAST) kp = C.in[2] + ((size_t)pt[j * NPAGES + (s >> 7)] * PAGE + (s & 127)) * ATT_W + h * 64;
                else kp = C.out + OUT_KS + (size_t)j * ATT_W + h * 64;
                float d = 0.f;
#pragma unroll
                for (int e = 0; e < 16; ++e) { const f32x4 kv = ((const f32x4*)kp)[e]; d += q[4 * e] * kv.x + q[4 * e + 1] * kv.y + q[4 * e + 2] * kv.z + q[4 * e + 3] * kv.w; }
                sc[i] = d * 0.125f; }
            mx = fmaxf(mx, sc[i]); }
        mx = wave_max(mx); float l = 0.f;
#pragma unroll
        for (int i = 0; i < 4; ++i) { const int idx = i * 64 + lane; const float p = (idx < cnt) ? expf(sc[i] - mx) : 0.f; pb[h * 256 + idx] = p; l += p; }
        l = wave_sum(l);
        LDS_WAIT(); asm volatile("" ::: "memory");
        float o = 0.f;
        for (int kx = 0; kx < cnt; ++kx) { const int s = list[kx]; const float* vp;
            if (!smp) vp = C.out + OUT_VP + ((size_t)(b * T + s)) * ATT_W + h * 64;
            else if (s < PAST) vp = C.in[3] + ((size_t)pt[j * NPAGES + (s >> 7)] * PAGE + (s & 127)) * ATT_W + h * 64;
            else vp = C.out + OUT_VS + (size_t)j * ATT_W + h * 64;
            o += pb[h * 256 + kx] * vp[lane]; }
        if (DIFFK == 0) MIX[(size_t)u * D + h * 64 + lane] = (bf16)f2bf(o / l);
        else { const float a = __builtin_bit_cast(float, (unsigned)MIX[(size_t)u * D + h * 64 + lane] << 16); MIX[(size_t)u * D + h * 64 + lane] = (bf16)f2bf(a + (float)DIFFK * (a - o / l)); }
    }
    __syncthreads();
}
__device__ __forceinline__ void p8_res_norm2(const Ctx& C) {
    const float* X1 = (const float*)(C.ws + WS_X1); bf16* A2 = (bf16*)(C.ws + WS_A2); const float* MOD = (const float*)(C.ws + WS_MOD);
    for (int m = C.gw; m < MPAD; m += C.ngw) {
        bf16* orow = A2 + (size_t)m * D;
        if (m >= MT) { GAS unsigned long long* o8 = (GAS unsigned long long*)orow + C.lane;
#pragma unroll
            for (int j = 0; j < 4; ++j) o8[64 * j] = 0ull;
            continue; }
        const float* md = MOD + mod_row(m) * MODW;
        norm_mod_row(C, m, X1 + (size_t)m * D, C.in[11], md + 3 * D, md + 4 * D, orow);
    }
}
__device__ __forceinline__ void p10_swiglu(const Ctx& C) {
    const float* RAW2 = (const float*)(C.ws + WS_RAW2); bf16* HB = (bf16*)(C.ws + WS_HB);
    const size_t total = (size_t)MPAD * (FFN / 4);
    for (size_t i = (size_t)blockIdx.x * NTHREADS + C.tid; i < total; i += (size_t)C.G * NTHREADS) {
        const size_t m = i / (FFN / 4); const int c = (int)(i % (FFN / 4)) * 4;
        const f32x4 g = *(const f32x4*)(RAW2 + m * NGU + c), u = *(const f32x4*)(RAW2 + m * NGU + FFN + c);
        const float h0 = g.x / (1.f + expf(-g.x)) * u.x, h1 = g.y / (1.f + expf(-g.y)) * u.y, h2 = g.z / (1.f + expf(-g.z)) * u.z, h3 = g.w / (1.f + expf(-g.w)) * u.w;
        *(unsigned long long*)(HB + m * FFN + c) = (unsigned long long)pk2(h0, h1) | ((unsigned long long)pk2(h2, h3) << 32);
    }
}
__device__ __forceinline__ void p12_final(const Ctx& C) {
    const float* RAW = (const float*)(C.ws + WS_RAW); const float* X1 = (const float*)(C.ws + WS_X1); const float* MOD = (const float*)(C.ws + WS_MOD);
    for (int m = C.gw; m < MT; m += C.ngw) {
        const float* md = MOD + mod_row(m) * MODW;
        float* yo = C.out + (m < MP ? OUT_Y + (size_t)m * D : OUT_YS + (size_t)(m - MP) * D);
#pragma unroll
        for (int j = 0; j < 4; ++j) { const int c = 4 * (C.lane + 64 * j);
            const f32x4 xv = *(const f32x4*)(X1 + (size_t)m * D + c), rv = *(const f32x4*)(RAW + (size_t)m * D + c), g2 = *(const f32x4*)(md + 5 * D + c);
            *(f32x4*)(yo + c) = xv + g2 * rv; }
    }
}

namespace rw {
typedef short bf16x8 __attribute__((ext_vector_type(8)));
typedef short s16x4 __attribute__((ext_vector_type(4)));
typedef float f32x16 __attribute__((ext_vector_type(16)));
typedef float f32x4v __attribute__((ext_vector_type(4)));
typedef unsigned u32x2 __attribute__((ext_vector_type(2)));
typedef unsigned u32x4v __attribute__((ext_vector_type(4)));
constexpr int NCH = T / 64;
constexpr int IMG = 16384;
constexpr int A32_OFF = 7 * IMG, WC_OFF = A32_OFF + 16384;
enum { H_AT = 0, H_BT = 1, H_KT = 2, H_RT = 3, H_VT = 4, H_AAK = 5, H_ARB = 6, H_ARK = 7, H_XT = 8, H_TT = 9, H_QT = 10, H_PT = 11, H_N1 = 12, H_N2 = 13 };
__device__ __forceinline__ unsigned off_b(unsigned row, unsigned ch) { return 256u * row + 16u * (ch ^ (((row & 3) << 2) | ((row >> 2) & 3))); }
__device__ __forceinline__ int crow(int r, int hi) { return (r & 3) + 8 * (r >> 2) + 4 * hi; }
__device__ __forceinline__ unsigned cvt2(float lo, float hi) { typedef float f2 __attribute__((ext_vector_type(2))); typedef __bf16 b2 __attribute__((ext_vector_type(2))); f2 v = {lo, hi}; b2 b = __builtin_convertvector(v, b2); return __builtin_bit_cast(unsigned, b); }
__device__ __forceinline__ bf16x8 frag_row(LAS unsigned char* lds, int H, int blk, int s, int lane) {
    return *(const LAS bf16x8*)(lds + (H >> 1) * IMG + off_b(32 * blk + (lane & 31), 8 * (H & 1) + 2 * s + (lane >> 5)));
}
__device__ __forceinline__ bf16x8 frag_tr(LAS unsigned char* lds, int H, int blk, int ks, int lane) {
    const unsigned h = lane >> 5, b2 = (lane >> 4) & 1, q = (lane & 15) >> 2, p = lane & 3, c = 2 * (H & 1) + blk;
    typedef short v4i16_t __attribute__((ext_vector_type(4)));
    LAS unsigned char* base = lds + (H >> 1) * IMG;
    const s16x4 lo = __builtin_bit_cast(s16x4, __builtin_amdgcn_ds_read_tr16_b64_v4i16((LAS v4i16_t*)(base + off_b(16 * ks + 8 * h + q, 4 * c + 2 * b2 + (p >> 1)) + 8 * (p & 1))));
    const s16x4 hi = __builtin_bit_cast(s16x4, __builtin_amdgcn_ds_read_tr16_b64_v4i16((LAS v4i16_t*)(base + off_b(16 * ks + 8 * h + 4 + q, 4 * c + 2 * b2 + (p >> 1)) + 8 * (p & 1))));
    return (bf16x8){lo[0], lo[1], lo[2], lo[3], hi[0], hi[1], hi[2], hi[3]};
}
template <bool ATR, bool BTR> __device__ __forceinline__ f32x16 mm_tile(LAS unsigned char* lds, int HA, int ablk, int HB, int bblk, f32x16 acc, int lane) {
#pragma unroll
    for (int s = 0; s < 4; ++s) {
        const bf16x8 a = ATR ? frag_tr(lds, HA, ablk, s, lane) : frag_row(lds, HA, ablk, s, lane);
        const bf16x8 b = BTR ? frag_tr(lds, HB, bblk, s, lane) : frag_row(lds, HB, bblk, s, lane);
        acc = __builtin_amdgcn_mfma_f32_32x32x16_bf16(a, b, acc, 0, 0, 0);
    }
    return acc;
}
__device__ __forceinline__ void store_tr(LAS unsigned char* lds, int H, int rblk, int cblk, const f32x16& acc, int lane) {
    LAS unsigned char* base = lds + (H >> 1) * IMG; const int hi = lane >> 5, row = 32 * cblk + (lane & 31);
#pragma unroll
    for (int g = 0; g < 4; ++g) { u32x2 w; w.x = cvt2(acc[4 * g], acc[4 * g + 1]); w.y = cvt2(acc[4 * g + 2], acc[4 * g + 3]);
        *(LAS u32x2*)(base + off_b(row, 8 * (H & 1) + 4 * rblk + g) + 8 * hi) = w; }
}
__device__ __forceinline__ u32x4v pack8(const f32x16& a, int s) { u32x4v w; w.x = cvt2(a[8 * s], a[8 * s + 1]); w.y = cvt2(a[8 * s + 2], a[8 * s + 3]); w.z = cvt2(a[8 * s + 4], a[8 * s + 5]); w.w = cvt2(a[8 * s + 6], a[8 * s + 7]); return w; }

struct Bufs { bf16* LIN; bf16* W2T; bf16* A2T; bf16* G2T; float* RX; float* KX; float* VX; float* KKN; float* KP; float* G;
              u32x4v* MF; float* NT; u32x4v* PF; float* QP; u32x4v* ZF; float* Y; };

__device__ __forceinline__ void r1_unit(const Ctx& C, const Bufs& B, int b, int h, int c) {
    LAS unsigned char* lds = C.lds; const int lane0 = C.lane, wave = C.wave;
    const size_t row0 = (size_t)b * T + 64 * c; const int ci = (b * RH + h) * NCH + c;
    LAS float* A32 = (LAS float*)(lds + A32_OFF); LAS float* WC = (LAS float*)(lds + WC_OFF);
    typedef float f32x4a __attribute__((ext_vector_type(4)));
    {
    int lane = lane0; asm volatile("" : "+v"(lane)); const int hi = lane >> 5; (void)hi;
    { const int nl = lane & 15, q = lane >> 4;
      if (wave < 4) {
        const int n = 16 * wave + nl, col = h * 64 + n;
        f32x4a aw[4], aa[4];
#pragma unroll
        for (int tt = 0; tt < 4; ++tt) { aw[tt] = (f32x4a){0.f, 0.f, 0.f, 0.f}; aa[tt] = aw[tt]; }
#pragma unroll
        for (int s = 0; s < 2; ++s) {
            const bf16x8 bw = *(const bf16x8*)(B.W2T + (size_t)col * 64 + 32 * s + 8 * q), ba = *(const bf16x8*)(B.A2T + (size_t)col * 64 + 32 * s + 8 * q);
#pragma unroll
            for (int tt = 0; tt < 4; ++tt) { const bf16* lp = B.LIN + (row0 + 16 * tt + nl) * 256 + 32 * s + 8 * q;
                aw[tt] = __builtin_amdgcn_mfma_f32_16x16x32_bf16(*(const bf16x8*)lp, bw, aw[tt], 0, 0, 0);
                aa[tt] = __builtin_amdgcn_mfma_f32_16x16x32_bf16(*(const bf16x8*)(lp + 64), ba, aa[tt], 0, 0, 0); }
        }
        const float w0c = C.in[18][col], a0c = C.in[20][col], kac = C.in[24][col];
        float lw[4][4], av[4][4];
#pragma unroll
        for (int tt = 0; tt < 4; ++tt)
#pragma unroll
            for (int e = 0; e < 4; ++e) { lw[tt][e] = -0.6065306597126334f / (1.f + __expf(-(w0c + aw[tt][e]))); av[tt][e] = 1.f / (1.f + __expf(-(a0c + aa[tt][e]))); }
        float tot[4], L[4][4];
#pragma unroll
        for (int tt = 0; tt < 4; ++tt) { L[tt][0] = lw[tt][0]; L[tt][1] = L[tt][0] + lw[tt][1]; L[tt][2] = L[tt][1] + lw[tt][2]; L[tt][3] = L[tt][2] + lw[tt][3]; tot[tt] = L[tt][3]; }
        float run = 0.f;
#pragma unroll
        for (int tt = 0; tt < 4; ++tt) { float basev = run;
#pragma unroll
            for (int qq = 0; qq < 4; ++qq) { const float o = __shfl(tot[tt], nl + 16 * qq); if (qq < q) basev += o; run += o; }
#pragma unroll
            for (int e = 0; e < 4; ++e) L[tt][e] += basev; }
        if (q == 3) WC[n] = __expf(L[3][3]);
#pragma unroll
        for (int tt = 0; tt < 4; ++tt) {
            asm volatile("" ::: "memory");
            float at[4], bt[4], kt[4], rt[4];
#pragma unroll
            for (int e = 0; e < 4; ++e) { const size_t o = (row0 + 16 * tt + 4 * q + e) * RW_W + col;
                const float rx = B.RX[o], kx = B.KX[o], kkn = B.KKN[o];
                const float kp = kx * (1.f + (av[tt][e] - 1.f) * kac); B.KP[o] = kp;
                const float eL = __expf(L[tt][e]), eLm = __expf(-L[tt][e]), eLex = __expf(L[tt][e] - lw[tt][e]);
                at[e] = -kkn * eLex; bt[e] = kkn * av[tt][e] * eLm; kt[e] = kp * eLm; rt[e] = rx * eL; }
            const unsigned ch = 2 * tt + (q >> 1), bo = 8 * (q & 1);
            u32x2 w;
            w.x = cvt2(at[0], at[1]); w.y = cvt2(at[2], at[3]); *(LAS u32x2*)(lds + 0 * IMG + off_b(n, ch) + bo) = w;
            w.x = cvt2(bt[0], bt[1]); w.y = cvt2(bt[2], bt[3]); *(LAS u32x2*)(lds + 0 * IMG + off_b(n, 8 + ch) + bo) = w;
            w.x = cvt2(kt[0], kt[1]); w.y = cvt2(kt[2], kt[3]); *(LAS u32x2*)(lds + 1 * IMG + off_b(n, ch) + bo) = w;
            w.x = cvt2(rt[0], rt[1]); w.y = cvt2(rt[2], rt[3]); *(LAS u32x2*)(lds + 1 * IMG + off_b(n, 8 + ch) + bo) = w;
        }
      } else {
        const int n = 16 * (wave - 4) + nl, col = h * 64 + n;
        f32x4a ag[4];
#pragma unroll
        for (int tt = 0; tt < 4; ++tt) ag[tt] = (f32x4a){0.f, 0.f, 0.f, 0.f};
#pragma unroll
        for (int s = 0; s < 4; ++s) { const bf16x8 bg = *(const bf16x8*)(B.G2T + (size_t)col * 128 + 32 * s + 8 * q);
#pragma unroll
            for (int tt = 0; tt < 4; ++tt) ag[tt] = __builtin_amdgcn_mfma_f32_16x16x32_bf16(*(const bf16x8*)(B.LIN + (row0 + 16 * tt + nl) * 256 + 128 + 32 * s + 8 * q), bg, ag[tt], 0, 0, 0); }
#pragma unroll
        for (int tt = 0; tt < 4; ++tt) { float vt[4];
#pragma unroll
            for (int e = 0; e < 4; ++e) { const size_t o = (row0 + 16 * tt + 4 * q + e) * RW_W + col; B.G[o] = ag[tt][e]; vt[e] = B.VX[o]; }
            u32x2 w; w.x = cvt2(vt[0], vt[1]); w.y = cvt2(vt[2], vt[3]);
            *(LAS u32x2*)(lds + 2 * IMG + off_b(n, 2 * tt + (q >> 1)) + 8 * (q & 1)) = w; }
      }
    }
    }
    __syncthreads();
    {
    int lane = lane0; asm volatile("" : "+v"(lane)); const int hi = lane >> 5; (void)hi;
#pragma unroll
    for (int k2 = 0; k2 < 2; ++k2) {
        const int id = 2 * wave + k2, prod = id >> 2, tb = (id >> 1) & 1, jb = id & 1;
        f32x16 acc = f32x16{};
        if (prod == 0) acc = mm_tile<true, true>(lds, H_AT, tb, H_BT, jb, acc, lane);
        else if (prod == 1) acc = mm_tile<true, true>(lds, H_AT, tb, H_KT, jb, acc, lane);
        else if (prod == 2) acc = mm_tile<true, true>(lds, H_BT, jb, H_RT, tb, acc, lane);
        else acc = mm_tile<true, true>(lds, H_KT, jb, H_RT, tb, acc, lane);
        if (prod < 2) {
#pragma unroll
            for (int r = 0; r < 16; ++r) { const int t = 32 * tb + crow(r, hi), j = 32 * jb + (lane & 31); if (!(j < t)) acc[r] = 0.f; }
            if (prod == 0) {
#pragma unroll
                for (int r = 0; r < 16; ++r) A32[(32 * tb + crow(r, hi)) * 64 + 32 * jb + (lane & 31)] = acc[r];
                f32x16 n1 = acc, n2 = acc;
#pragma unroll
                for (int r = 0; r < 16; ++r) { if (!(tb == jb && crow(r, hi) >= 16 && (lane & 31) < 16)) n1[r] = 0.f; if (!(tb == 1 && jb == 0)) n2[r] = 0.f; }
                store_tr(lds, H_N1, tb, jb, n1, lane); store_tr(lds, H_N2, tb, jb, n2, lane); }
            else store_tr(lds, H_AAK, tb, jb, acc, lane);
        } else {
#pragma unroll
            for (int r = 0; r < 16; ++r) { const int j = 32 * jb + crow(r, hi), t = 32 * tb + (lane & 31); if (!(j <= t)) acc[r] = 0.f; }
            store_tr(lds, prod == 2 ? H_ARB : H_ARK, jb, tb, acc, lane);
        }
    }
    }
    __syncthreads();
    {
    int lane = lane0; asm volatile("" : "+v"(lane)); const int hi = lane >> 5; (void)hi;
    if (wave == 0) {
        const int blk = lane >> 4, cc = lane & 15; float Tb[16];
#pragma unroll
        for (int t = 0; t < 16; ++t) { float sacc = (t == cc) ? 1.f : 0.f;
#pragma unroll
            for (int j4 = 0; j4 < t; j4 += 4) { const f32x4a a4 = *(const LAS f32x4a*)(A32 + (16 * blk + t) * 64 + 16 * blk + j4);
                sacc += a4[0] * Tb[j4]; if (j4 + 1 < t) sacc += a4[1] * Tb[j4 + 1]; if (j4 + 2 < t) sacc += a4[2] * Tb[j4 + 2]; if (j4 + 3 < t) sacc += a4[3] * Tb[j4 + 3]; }
            Tb[t] = sacc; }
        u32x4v lo, hi4; lo.x = cvt2(Tb[0], Tb[1]); lo.y = cvt2(Tb[2], Tb[3]); lo.z = cvt2(Tb[4], Tb[5]); lo.w = cvt2(Tb[6], Tb[7]);
        hi4.x = cvt2(Tb[8], Tb[9]); hi4.y = cvt2(Tb[10], Tb[11]); hi4.z = cvt2(Tb[12], Tb[13]); hi4.w = cvt2(Tb[14], Tb[15]);
#pragma unroll
        for (int g = 0; g < 8; ++g) { u32x4v w = (u32x4v){0u, 0u, 0u, 0u}; if (g == 2 * blk) w = lo; if (g == 2 * blk + 1) w = hi4;
            *(LAS u32x4v*)(lds + (H_TT >> 1) * IMG + off_b(lane, 8 * (H_TT & 1) + g)) = w; }
    } else if (wave >= 4) {
        const int tb = (wave - 4) >> 1, ib = (wave - 4) & 1;
        f32x16 acc = mm_tile<true, false>(lds, H_AAK, tb, H_VT, ib, f32x16{}, lane);
        store_tr(lds, H_XT, tb, ib, acc, lane);
    }
    __syncthreads();
    { const int tb = (wave >> 1) & 1, cb = wave & 1;
      if (wave < 4) { f32x16 acc = mm_tile<true, false>(lds, H_N1, tb, H_TT, cb, f32x16{}, lane);
#pragma unroll
          for (int r = 0; r < 16; ++r) if (32 * tb + crow(r, hi) == 32 * cb + (lane & 31)) acc[r] += 1.f;
          store_tr(lds, H_PT, tb, cb, acc, lane); }
      __syncthreads();
      if (wave < 4) { f32x16 acc = mm_tile<true, false>(lds, H_TT, tb, H_PT, cb, f32x16{}, lane); store_tr(lds, H_QT, tb, cb, acc, lane); }
      __syncthreads();
      if (wave < 4) { f32x16 acc = mm_tile<true, false>(lds, H_N2, tb, H_QT, cb, f32x16{}, lane);
#pragma unroll
          for (int r = 0; r < 16; ++r) if (32 * tb + crow(r, hi) == 32 * cb + (lane & 31)) acc[r] += 1.f;
          store_tr(lds, H_PT, tb, cb, acc, lane); }
      __syncthreads();
      if (wave < 4) { f32x16 acc = mm_tile<true, false>(lds, H_QT, tb, H_PT, cb, f32x16{}, lane); store_tr(lds, H_TT, tb, cb, acc, lane); }
    }
    }
    __syncthreads();
    {
    int lane = lane0; asm volatile("" : "+v"(lane)); const int hi = lane >> 5; (void)hi;
    { const int tb = (wave >> 1) & 1, cb = wave & 1;
      if (wave < 4) { f32x16 acc = mm_tile<true, false>(lds, H_TT, tb, H_AT, cb, f32x16{}, lane); store_tr(lds, H_PT, tb, cb, acc, lane); }
      else { f32x16 acc = mm_tile<true, false>(lds, H_TT, tb, H_XT, cb, f32x16{}, lane); store_tr(lds, H_QT, tb, cb, acc, lane); } }
    }
    __syncthreads();
    {
    int lane = lane0; asm volatile("" : "+v"(lane)); const int hi = lane >> 5; (void)hi;
#pragma unroll
    for (int k2 = 0; k2 < 2; ++k2) {
        const int id = 2 * wave + k2, prod = id >> 2, rb = (id >> 1) & 1, cb = id & 1;
        f32x16 acc = f32x16{};
        if (prod == 0) {
            acc = mm_tile<false, false>(lds, H_PT, rb, H_BT, cb, acc, lane);
            const float wc = WC[32 * cb + (lane & 31)];
#pragma unroll
            for (int r = 0; r < 16; ++r) { const int n = 32 * rb + crow(r, hi), m = 32 * cb + (lane & 31); acc[r] = (acc[r] + (n == m ? 1.f : 0.f)) * wc; }
            u32x4v* o = B.MF + ((size_t)ci * 8 + (cb * 2 + rb) * 2) * 64 + lane;
            o[0] = pack8(acc, 0); o[64] = pack8(acc, 1);
        } else if (prod == 1) {
            acc = mm_tile<false, false>(lds, H_BT, rb, H_QT, cb, acc, lane);
            acc = mm_tile<false, false>(lds, H_KT, rb, H_VT, cb, acc, lane);
#pragma unroll
            for (int g = 0; g < 4; ++g) { const f32x4a w4 = *(const LAS f32x4a*)(WC + 32 * rb + 8 * g + 4 * hi);
                f32x4a v = {acc[4 * g] * w4[0], acc[4 * g + 1] * w4[1], acc[4 * g + 2] * w4[2], acc[4 * g + 3] * w4[3]};
                *(f32x4a*)(B.NT + (((size_t)ci * 4 + rb * 2 + cb) * 64 + lane) * 16 + 4 * g) = v; }
        } else if (prod == 2) {
            acc = mm_tile<false, false>(lds, H_PT, rb, H_ARB, cb, acc, lane);
#pragma unroll
            for (int s = 0; s < 4; ++s) { bf16x8 idf;
#pragma unroll
                for (int e = 0; e < 8; ++e) idf[e] = (16 * s + 8 * hi + e == 32 * cb + (lane & 31)) ? (short)0x3f80 : (short)0;
                acc = __builtin_amdgcn_mfma_f32_32x32x16_bf16(frag_row(lds, H_RT, rb, s, lane), idf, acc, 0, 0, 0); }
            u32x4v* o = B.PF + ((size_t)ci * 8 + (cb * 2 + rb) * 2) * 64 + lane;
            o[0] = pack8(acc, 0); o[64] = pack8(acc, 1);
        } else {
            acc = mm_tile<false, false>(lds, H_ARB, rb, H_QT, cb, acc, lane);
            acc = mm_tile<false, false>(lds, H_ARK, rb, H_VT, cb, acc, lane);
#pragma unroll
            for (int g = 0; g < 4; ++g) *(f32x4a*)(B.QP + (((size_t)ci * 4 + rb * 2 + cb) * 64 + lane) * 16 + 4 * g) = (f32x4a){acc[4 * g], acc[4 * g + 1], acc[4 * g + 2], acc[4 * g + 3]};
        }
    }
    }
    __syncthreads();
}
__device__ __forceinline__ void r1_phase(const Ctx& C, const Bufs& B) {
    for (int u = blockIdx.x; u < NB * RH * NCH; u += C.G) { const int c = u & (NCH - 1), h = (u >> 5) & 7, b = u >> 8; r1_unit(C, B, b, h, c); }
}
__device__ __forceinline__ void r2_chain(const Ctx& C, const Bufs& B, int k) {
    const int lane = C.lane, hi = lane >> 5, ib = k & 1, bh = k >> 1;
    f32x16 z[2]; z[0] = f32x16{}; z[1] = f32x16{};
    typedef float f32x4a __attribute__((ext_vector_type(4)));
    for (int c = 0; c < NCH; ++c) {
        const size_t ci = (size_t)bh * NCH + c;
        u32x4v bf[2][2];
#pragma unroll
        for (int nb = 0; nb < 2; ++nb)
#pragma unroll
            for (int s = 0; s < 2; ++s) { bf[nb][s] = pack8(z[nb], s); B.ZF[((ci * 2 + ib) * 4 + nb * 2 + s) * 64 + lane] = bf[nb][s]; }
        f32x16 zn[2];
#pragma unroll
        for (int mb = 0; mb < 2; ++mb) {
            const float* np = B.NT + ((ci * 4 + mb * 2 + ib) * 64 + lane) * 16;
#pragma unroll
            for (int g = 0; g < 4; ++g) { const f32x4a v = *(const f32x4a*)(np + 4 * g); zn[mb][4 * g] = v[0]; zn[mb][4 * g + 1] = v[1]; zn[mb][4 * g + 2] = v[2]; zn[mb][4 * g + 3] = v[3]; }
#pragma unroll
            for (int nb = 0; nb < 2; ++nb)
#pragma unroll
                for (int s = 0; s < 2; ++s) { const u32x4v af = B.MF[(ci * 8 + (mb * 2 + nb) * 2 + s) * 64 + lane];
                    zn[mb] = __builtin_amdgcn_mfma_f32_32x32x16_bf16(__builtin_bit_cast(bf16x8, af), __builtin_bit_cast(bf16x8, bf[nb][s]), zn[mb], 0, 0, 0); }
        }
        z[0] = zn[0]; z[1] = zn[1];
    }
    float* so = C.out + OUT_WKVP + ((size_t)bh * RN + 32 * ib + (lane & 31)) * RN;
#pragma unroll
    for (int nb = 0; nb < 2; ++nb)
#pragma unroll
        for (int g = 0; g < 4; ++g) *(f32x4a*)(so + 32 * nb + 8 * g + 4 * hi) = (f32x4a){z[nb][4 * g], z[nb][4 * g + 1], z[nb][4 * g + 2], z[nb][4 * g + 3]};
}
__device__ __forceinline__ void r3_phase(const Ctx& C, const Bufs& B) {
    const int lane = C.lane, hi = lane >> 5;
    typedef float f32x4a __attribute__((ext_vector_type(4)));
    for (int wu = C.gw; wu < NB * RH * NCH * 2; wu += C.ngw) {
        const int tb = wu & 1; const size_t ci = (size_t)(wu >> 1); const int c = (int)(ci & (NCH - 1)), bh = (int)(ci >> 5), h = bh & 7, b = bh >> 3;
        u32x4v pf[2][2];
#pragma unroll
        for (int nb = 0; nb < 2; ++nb)
#pragma unroll
            for (int s = 0; s < 2; ++s) pf[nb][s] = B.PF[(ci * 8 + (tb * 2 + nb) * 2 + s) * 64 + lane];
#pragma unroll
        for (int ib = 0; ib < 2; ++ib) {
            f32x16 y; const float* qp = B.QP + ((ci * 4 + tb * 2 + ib) * 64 + lane) * 16;
#pragma unroll
            for (int g = 0; g < 4; ++g) { const f32x4a v = *(const f32x4a*)(qp + 4 * g); y[4 * g] = v[0]; y[4 * g + 1] = v[1]; y[4 * g + 2] = v[2]; y[4 * g + 3] = v[3]; }
#pragma unroll
            for (int nb = 0; nb < 2; ++nb)
#pragma unroll
                for (int s = 0; s < 2; ++s) { const u32x4v zf = B.ZF[((ci * 2 + ib) * 4 + nb * 2 + s) * 64 + lane];
                    y = __builtin_amdgcn_mfma_f32_32x32x16_bf16(__builtin_bit_cast(bf16x8, pf[nb][s]), __builtin_bit_cast(bf16x8, zf), y, 0, 0, 0); }
            float* yo = B.Y + ((size_t)b * T + 64 * c + 32 * tb) * RW_W + h * 64 + 32 * ib + (lane & 31);
#pragma unroll
            for (int r = 0; r < 16; ++r) yo[(size_t)crow(r, hi) * RW_W] = y[r];
        }
    }
}
}
constexpr int N_PHASES = 12;
__global__ void __launch_bounds__(NTHREADS, 2) fwd(Args args) {
    extern __shared__ __attribute__((aligned(16))) unsigned char lds[];
    Ctx C;
    C.lds = (LAS unsigned char*)lds;
    C.tid = threadIdx.x; C.lane = C.tid & 63; C.wave = __builtin_amdgcn_readfirstlane(C.tid >> 6);
    C.G = gridDim.x; C.gw = blockIdx.x * NWAVES + C.wave; C.ngw = C.G * NWAVES;
    C.in = args.in; C.out = args.out; C.ws = args.ws;
    const int lo = args.ph_lo, hi = args.ph_hi;
    volatile LAS unsigned* MISC = (volatile LAS unsigned*)(C.lds + MISC_OFF);
    if (C.tid < 32) MISC[C.tid] = 0u;
    __syncthreads();
    XcdBarrier bar = xcd_barrier_post((unsigned*)(C.ws + WS_CTL) + CW_BAR, MISC + 8);
#define IN(k) (lo <= (k) && (k) < hi)
#define SEAM(k) do { if (IN(k) && IN((k) + 1)) xcd_barrier(bar); } while (0)
    if (IN(0)) { p0_mod(C); p0_weights(C); }
    SEAM(0);
    if (IN(1)) { p1_norm1(C); }
    SEAM(1);
    if (IN(2)) {
        pg8::Gemm g{(const pg8::bf16_t*)(C.ws + WS_A1), (const pg8::bf16_t*)(C.ws + WS_WIN), MPAD, NIN, D}; pg8::StaticOrder S; S.init(MPAD, NIN, C.G, (int)blockIdx.x);
        EpiIn E{C.ws, C.out, C.in[15], C.in[16]};
        pg8::gemm_phase<EpiIn, pg8::StaticOrder, true, true>(C.lds, g, S, E);
    }
    SEAM(2);
    rw::Bufs RB;
    RB.LIN = (bf16*)(C.ws + WS_LIN); RB.W2T = (bf16*)(C.ws + WS_W2T); RB.A2T = (bf16*)(C.ws + WS_A2T); RB.G2T = (bf16*)(C.ws + WS_G2T);
    RB.RX = (float*)(C.ws + WS_RWA); RB.KX = (float*)(C.ws + WS_KX); RB.VX = (float*)(C.ws + WS_RWA + 3 * RWA_STRIDE); RB.KKN = (float*)(C.ws + WS_RWA + 4 * RWA_STRIDE);
    RB.KP = (float*)(C.ws + WS_RWA + 2 * RWA_STRIDE); RB.G = (float*)(C.ws + WS_RWA + 6 * RWA_STRIDE);
    RB.MF = (rw::u32x4v*)(C.ws + WS_MF); RB.NT = (float*)(C.ws + WS_NT); RB.PF = (rw::u32x4v*)(C.ws + WS_PF); RB.QP = (float*)(C.ws + WS_QP); RB.ZF = (rw::u32x4v*)(C.ws + WS_ZF); RB.Y = (float*)(C.ws + WS_Y);
#ifdef PROBE_RW
    if (IN(3)) { p3_rwprep<true>(C); }
    SEAM(3);
    if (IN(4)) { idxsel::phase(C); rw::r1_phase(C, RB); p4_indexer<false, true>(C); p4_scan<false>(C, NB * RH); p4_scan<true>(C, 0); }
#else
    if (IN(3)) { p3_rwprep<false>(C); }
    SEAM(3);
    if (IN(4)) { idxsel::phase(C); rw::r1_phase(C, RB); p4_indexer<false, true>(C); p4_scan<false>(C, NB * RH); }
#endif
    SEAM(4);
    if (IN(5)) {
        p5_select<false, true>(C);
        if (C.wave == 0 && blockIdx.x < NB * RH * 2) rw::r2_chain(C, RB, (int)blockIdx.x);
        __syncthreads();
        const attn_body::AttnTensors AT{(const attn_body::bf16*)(C.ws + WS_QB), (const attn_body::bf16*)(C.ws + WS_KB), (const attn_body::bf16*)(C.ws + WS_VB), (attn_body::bf16*)(C.ws + WS_MIX), (const unsigned long long*)(C.ws + WS_MASKT)};
        const attn_body::StaticOrder S((int)C.G, (int)blockIdx.x);
        attn_body::attn_phase<attn_body::StaticOrder>((char*)lds, AT, S);
    }
    SEAM(5);
    if (IN(6)) { smp_attn(C); rw::r3_phase(C, RB); }
    SEAM(6);
#ifdef PROBE_RW
    if (IN(7)) { p5_rwfinal<PROBE_RW>(C); }
#else
    if (IN(7)) { p5_rwfinal<0>(C); }
#endif
    SEAM(7);
    if (IN(8)) {
        pg8::Gemm g{(const pg8::bf16_t*)(C.ws + WS_MIX), (const pg8::bf16_t*)(C.ws + WS_WOUT), MP, D, D}; pg8::StaticOrder S; S.init(MP, D, C.G, (int)blockIdx.x);
        EpiResGate E{C.in[0], (const float*)(C.ws + WS_MOD) + 2 * D, (float*)(C.ws + WS_X1)};
        pg8::gemm_phase<EpiResGate, pg8::StaticOrder, true, true>(C.lds, g, S, E);
        const float* xs = C.in[1]; const float* g1 = (const float*)(C.ws + WS_MOD) + (size_t)NB * MODW + 2 * D; float* x1s = (float*)(C.ws + WS_X1) + (size_t)MP * D;
        sample_gemm(C, (const bf16*)(C.ws + WS_MIX) + (size_t)MP * D, (const bf16*)(C.ws + WS_WOUT), D, [&](int row, int col, float v) { x1s[row * D + col] = xs[row * D + col] + g1[(size_t)row * MODW + col] * v; });
    }
    SEAM(8);
    if (IN(9)) { p8_res_norm2(C); }
    SEAM(9);
    if (IN(10)) {
        pg8::Gemm g{(const pg8::bf16_t*)(C.ws + WS_A2), (const pg8::bf16_t*)(C.ws + WS_WGU), MPAD, NGU, D}; pg8::StaticOrder S; S.init(MPAD, NGU, C.G, (int)blockIdx.x);
        EpiSwiGLU E{(bf16*)(C.ws + WS_HB)};
        pg8::gemm_phase<EpiSwiGLU, pg8::StaticOrder, true, true>(C.lds, g, S, E);
    }
    SEAM(10);
    if (IN(11)) {
        pg8::Gemm g{(const pg8::bf16_t*)(C.ws + WS_HB), (const pg8::bf16_t*)(C.ws + WS_WDN), MP, D, FFN}; pg8::StaticOrder S; S.init(MP, D, C.G, (int)blockIdx.x);
        EpiResGate E{(const float*)(C.ws + WS_X1), (const float*)(C.ws + WS_MOD) + 5 * D, C.out + OUT_Y};
        pg8::gemm_phase<EpiResGate, pg8::StaticOrder, true, true>(C.lds, g, S, E);
        const float* x1s = (const float*)(C.ws + WS_X1) + (size_t)MP * D; const float* g2 = (const float*)(C.ws + WS_MOD) + (size_t)NB * MODW + 5 * D; float* ys = C.out + OUT_YS;
        sample_gemm(C, (const bf16*)(C.ws + WS_HB) + (size_t)MP * FFN, (const bf16*)(C.ws + WS_WDN), FFN, [&](int row, int col, float v) { ys[row * D + col] = x1s[row * D + col] + g2[(size_t)row * MODW + col] * v; });
    }
#undef IN
#undef SEAM
}

extern "C" void kernel_launch(void* const* d_in, const int* in_sizes, int n_in, void* d_out, int out_size, void* d_ws, size_t ws_size, hipStream_t stream) {
    static int grid = 0;
    if (grid == 0) {
        if (n_in != 32 || (size_t)out_size != OUT_END || ws_size < WS_END) { fprintf(stderr, "kernel_launch: unexpected sizes n_in %d out %d ws %zu\n", n_in, out_size, ws_size); grid = -1; return; }
        int dev = 0, cus = 0;
        if (hipGetDevice(&dev) != hipSuccess || hipDeviceGetAttribute(&cus, hipDeviceAttributeMultiprocessorCount, dev) != hipSuccess) { grid = -1; return; }
        if (hipFuncSetAttribute((const void*)fwd, hipFuncAttributeMaxDynamicSharedMemorySize, LDS_BYTES) != hipSuccess) { fprintf(stderr, "kernel_launch: hipFuncSetAttribute failed\n"); grid = -1; return; }
        (void)hipGetLastError();
        grid = cus;
    }
    if (grid < 0) return;
    (void)hipMemsetAsync((char*)d_ws + WS_CTL, 0, CTL_ZERO_BYTES, stream);
    Args a{};
    for (int i = 0; i < 32; ++i) a.in[i] = (const float*)d_in[i];
    a.out = (float*)d_out; a.ws = (unsigned char*)d_ws;
    a.ph_lo = 0; a.ph_hi = N_PHASES;
    hipLaunchKernelGGL(fwd, dim3(grid), dim3(NTHREADS), LDS_BYTES, stream, a);
}
```

```cpp
#include <hip/hip_runtime.h>
#include <cstdio>
#include <cstdint>
#include <cmath>
#include <hip/hip_bf16.h>
#define LAS __attribute__((address_space(3)))
namespace pg8 {
#define PG8_LAS __attribute__((address_space(3)))
typedef unsigned short bf16_t;
typedef short bf16x8 __attribute__((ext_vector_type(8)));
typedef float f32x4 __attribute__((ext_vector_type(4)));
typedef unsigned u32x4 __attribute__((ext_vector_type(4)));
constexpr int BM = 256, BK = 64, HALF = 128, HTB = HALF * BK * 2  , STAGE_BYTES = 8 * HTB, NXCD = 8, WGM = 8;

__host__ __device__ __forceinline__ int lds_byte(int r, int c) { const int st = (r >> 4) * 2 + (c >> 5), rr = r & 15, cc = c & 31, ob = rr * 64 + cc * 2; return st * 1024 + (ob ^ (((ob >> 9) & 1) << 5)); }
__host__ __device__ __forceinline__ void stage_rc(int b, int& R, int& C) { const int st = b / 1024, sb = b % 1024, swz = sb ^ (((sb >> 9) & 1) << 5); R = (st >> 1) * 16 + swz / 64; C = (st & 1) * 32 + (swz % 64) / 2; }
__host__ __device__ __forceinline__ int perm32(int rho) { const int n = rho >> 4, i = rho & 15; return 8 * (i >> 2) + 4 * n + (i & 3); }

struct Unit { int pm, pn; };
struct Gemm { const bf16_t* A; const bf16_t* Bt; int M, N, K; };

struct StaticOrder {
    int nM, nN, nwg, G, c;
    __host__ __device__ void init(int M, int N, int G_, int c_) { nM = M / BM; nN = N / BM; nwg = nM * nN; G = G_; c = c_; }
    __host__ __device__ bool next(int i, Unit& u) const {
        const long L = (long)i * G + c; if (L >= nwg) return false;
        int wgid = (int)L; { const int q = nwg / NXCD, r = nwg % NXCD, xcd = wgid % NXCD, off = wgid / NXCD; wgid = (xcd < r ? xcd * (q + 1) : r * (q + 1) + (xcd - r) * q) + off; }
        const int nig = WGM * nN, gid = wgid / nig, fm = gid * WGM, gsz = (nM - fm) < WGM ? (nM - fm) : WGM;
        u.pm = fm + ((wgid % nig) % gsz); u.pn = (wgid % nig) / gsz; return true;
    }
    __device__ __forceinline__ void a_ready(const Unit&) const {}
    __device__ __forceinline__ void done(const Unit&) const {}
};

__device__ __forceinline__ unsigned cvt_pk_bf16(float lo, float hi) { unsigned r; asm volatile("v_cvt_pk_bf16_f32 %0, %1, %2" : "=v"(r) : "v"(lo), "v"(hi)); return r; }
typedef float f32x2 __attribute__((ext_vector_type(2)));
__device__ __forceinline__ f32x2 gelu_pk(f32x2 v) {
    const f32x2 av = __builtin_elementwise_abs(v), d = av * 0.2316418882f + 1.0f;
    f32x2 t; t.x = __builtin_amdgcn_rcpf(d.x); t.y = __builtin_amdgcn_rcpf(d.y);
    f32x2 q = t * 0.5307027145f + (-0.7265760135f); q = q * t + 0.7107068705f; q = q * t + (-0.142248368f); q = q * t + 0.127414796f; q = q * t;
    const f32x2 s = (v * v) * (-0.72134752044f);
    f32x2 e; e.x = __builtin_amdgcn_exp2f(s.x); e.y = __builtin_amdgcn_exp2f(s.y);
    const f32x2 m = v * (q * e), r = v - m;
    f32x2 o; o.x = v.x < 0.f ? m.x : r.x; o.y = v.y < 0.f ? m.y : r.y; return o;
}

template <int ACT  > struct EpiBf16 {
    static constexpr bool PERM = true, AFTER_DRAIN = false; static_assert(ACT == 0 || ACT == 1, "EpiBf16: ACT is 0 (none) or 1 (gelu_pk)");
    bf16_t* O; int ldc; const float* bias; int split_cols; size_t split_stride; float scale0;
    __device__ __forceinline__ void operator()(const f32x4 (&acc)[2][2][4][2], const Unit& u, int wr, int wc, int fr, int fq) const {
        const int row0 = u.pm * BM + wr * 64 + fr; int colt = u.pn * BM; bf16_t* base = O;
        float sc = 1.f; if (split_cols) { const int t = colt / split_cols; base += (size_t)t * split_stride; colt -= t * split_cols; if (t == 0) sc = scale0; }
        const int col0 = colt + wc * 32 + 8 * fq, bcol0 = u.pn * BM + wc * 32 + 8 * fq;
        f32x4 bv[2][2];
#pragma unroll
        for (int bj = 0; bj < 2; ++bj)
#pragma unroll
            for (int n = 0; n < 2; ++n) bv[bj][n] = bias ? *(const f32x4*)(bias + bcol0 + bj * HALF + 4 * n) : (f32x4){0.f, 0.f, 0.f, 0.f};
#pragma unroll
        for (int ai = 0; ai < 2; ++ai)
#pragma unroll
            for (int m = 0; m < 4; ++m) { bf16_t* rowp = base + (size_t)(row0 + ai * HALF + m * 16) * ldc + col0;
#pragma unroll
                for (int bj = 0; bj < 2; ++bj) { f32x4 v0 = acc[ai][bj][m][0] + bv[bj][0], v1 = acc[ai][bj][m][1] + bv[bj][1];
                    if (ACT == 1) { f32x2 a = gelu_pk((f32x2){v0[0], v0[1]}), b = gelu_pk((f32x2){v0[2], v0[3]}), c = gelu_pk((f32x2){v1[0], v1[1]}), d = gelu_pk((f32x2){v1[2], v1[3]});
                        v0 = (f32x4){a.x, a.y, b.x, b.y}; v1 = (f32x4){c.x, c.y, d.x, d.y}; }
                    v0 = v0 * sc; v1 = v1 * sc; u32x4 w; w.x = cvt_pk_bf16(v0[0], v0[1]); w.y = cvt_pk_bf16(v0[2], v0[3]); w.z = cvt_pk_bf16(v1[0], v1[1]); w.w = cvt_pk_bf16(v1[2], v1[3]);
                    *(u32x4*)(rowp + bj * HALF) = w; } }
    }
};


template <class Epi, class Sched, bool ALIGN_EPI = false, bool SP2 = false>
__device__ __forceinline__ void gemm_phase(PG8_LAS unsigned char* lds, const Gemm g, const Sched& S, const Epi& E) {
    const int tid = threadIdx.x, wid = __builtin_amdgcn_readfirstlane(tid >> 6), lane = tid & 63, wr = wid >> 2, wc = wid & 3, fr = lane & 15, fq = lane >> 4;
    const int K = g.K, nt = K / BK;
    unsigned voffA[2], voffB[2];
#pragma unroll
    for (int i = 0; i < 2; ++i) { int R, C; stage_rc(tid * 16 + i * 8192, R, C); const int Rb = Epi::PERM ? ((R & ~31) + perm32(R & 31)) : R;
        voffA[i] = (unsigned)(R * K + C) * 2u; voffB[i] = (unsigned)(Rb * K + C) * 2u; }
    const size_t kstep = (size_t)(BK * 2);
    const size_t hstep = (size_t)HALF * K * 2;
    const size_t tstep = 2 * hstep;
    const unsigned ldsw = (unsigned)wid * 1024u;
    const int aoff = lds_byte(wr * 64 + fr, fq * 8), boff = lds_byte(wc * 32 + fr, fq * 8);
#define PG8_SA(b, h) (((b) * 2 + (h)) * HTB)
#define PG8_SB(b, h) ((4 + (b) * 2 + (h)) * HTB)
#define PG8_STAGE(bufoff, gbase, voff) do { _Pragma("unroll") for (int _i = 0; _i < 2; ++_i) \
        __builtin_amdgcn_global_load_lds((const unsigned*)((const char*)(gbase) + (voff)[_i]), (PG8_LAS unsigned*)(lds + (bufoff) + ldsw + _i * 8192), 16, 0, 0); } while (0)
#define PG8_LDA(dst, b, h) do { _Pragma("unroll") for (int m = 0; m < 4; ++m) _Pragma("unroll") for (int k = 0; k < 2; ++k) dst[m][k] = *(const PG8_LAS bf16x8*)(lds + PG8_SA(b, h) + aoff + m * 2048 + k * 1024); } while (0)
#define PG8_LDB(dst, b, h) do { _Pragma("unroll") for (int n = 0; n < 2; ++n) _Pragma("unroll") for (int k = 0; k < 2; ++k) dst[n][k] = *(const PG8_LAS bf16x8*)(lds + PG8_SB(b, h) + boff + n * 2048 + k * 1024); } while (0)
#define PG8_MMA(ai, bj, At, Bt) do { __builtin_amdgcn_s_setprio(1); _Pragma("unroll") for (int m = 0; m < 4; ++m) _Pragma("unroll") for (int n = 0; n < 2; ++n) _Pragma("unroll") for (int k = 0; k < 2; ++k) \
        acc[ai][bj][m][n] = __builtin_amdgcn_mfma_f32_16x16x32_bf16(Bt[n][k], At[m][k], acc[ai][bj][m][n], 0, 0, 0); __builtin_amdgcn_s_setprio(0); } while (0)
#define PG8_WAIT_V(n) asm volatile("s_waitcnt vmcnt(" #n ")" ::: "memory")
#define PG8_WAIT_L(n) asm volatile("s_waitcnt lgkmcnt(" #n ")" ::: "memory")
#define PG8_BAR __builtin_amdgcn_s_barrier()
#define PG8_SCHED __builtin_amdgcn_sched_barrier(0)
    Unit cur, nxt; int ui = 0;
    if (!S.next(0, cur)) return;
    f32x4 acc[2][2][4][2];
#pragma unroll
    for (int a = 0; a < 2; ++a)
#pragma unroll
        for (int b = 0; b < 2; ++b)
#pragma unroll
            for (int m = 0; m < 4; ++m)
#pragma unroll
                for (int n = 0; n < 2; ++n) acc[a][b][m][n] = (f32x4){0.f, 0.f, 0.f, 0.f};
    bf16x8 At[4][2], B0[2][2], B1[2][2];
    const char* cA = (const char*)g.A + (size_t)cur.pm * tstep; const char* cB = (const char*)g.Bt + (size_t)cur.pn * tstep;
    S.a_ready(cur);
    if constexpr (SP2) {
        PG8_STAGE(PG8_SB(0, 0), cB, voffB); PG8_STAGE(PG8_SB(0, 1), cB + hstep, voffB); PG8_STAGE(PG8_SA(0, 0), cA, voffA); PG8_STAGE(PG8_SA(0, 1), cA + hstep, voffA);
        if (wr == 1) PG8_BAR;
        PG8_WAIT_V(2); PG8_BAR;
        PG8_STAGE(PG8_SB(1, 0), cB + kstep, voffB); PG8_STAGE(PG8_SA(1, 0), cA + kstep, voffA); PG8_STAGE(PG8_SB(1, 1), cB + hstep + kstep, voffB);
        PG8_WAIT_V(6); PG8_BAR;
    } else {
        PG8_STAGE(PG8_SB(0, 0), cB, voffB); PG8_STAGE(PG8_SA(0, 0), cA, voffA); PG8_STAGE(PG8_SB(0, 1), cB + hstep, voffB); PG8_STAGE(PG8_SA(0, 1), cA + hstep, voffA);
        if (wr == 1) PG8_BAR;
        PG8_WAIT_V(4); PG8_BAR;
        PG8_STAGE(PG8_SB(1, 0), cB + kstep, voffB); PG8_STAGE(PG8_SA(1, 0), cA + kstep, voffA); PG8_STAGE(PG8_SB(1, 1), cB + hstep + kstep, voffB);
        PG8_WAIT_V(6); PG8_BAR;
    }
    for (;;) {
        const bool has_next = S.next(ui + 1, nxt);
        const char* nA = has_next ? (const char*)g.A + (size_t)nxt.pm * tstep : cA; const char* nB = has_next ? (const char*)g.Bt + (size_t)nxt.pn * tstep : cB;
        for (int t = 0; t < nt; t += 2) {
            const bool last = (t == nt - 2);
            const char* a1 = cA + (size_t)(t + 1) * kstep;
            const char* a2 = last ? nA : cA + (size_t)(t + 2) * kstep; const char* b2 = last ? nB : cB + (size_t)(t + 2) * kstep;
            const char* a3 = a2 + kstep; const char* b3 = b2 + kstep;
            if (last && has_next) S.a_ready(nxt);
            if constexpr (SP2) {
            PG8_LDB(B0, 0, 0); PG8_LDB(B1, 0, 1); PG8_SCHED; PG8_LDA(At, 0, 0); PG8_STAGE(PG8_SA(1, 1), a1 + hstep, voffA);
            PG8_WAIT_V(8); PG8_WAIT_L(0); PG8_BAR; PG8_MMA(0, 0, At, B0); PG8_MMA(0, 1, At, B1); PG8_BAR; PG8_SCHED;
            PG8_LDA(At, 0, 1); PG8_STAGE(PG8_SB(0, 0), b2, voffB); PG8_STAGE(PG8_SB(0, 1), b2 + hstep, voffB); PG8_STAGE(PG8_SA(0, 0), a2, voffA);
            PG8_WAIT_V(8); PG8_WAIT_L(0); PG8_BAR; PG8_MMA(1, 0, At, B0); PG8_MMA(1, 1, At, B1); PG8_BAR; PG8_SCHED;
            PG8_LDB(B0, 1, 0); PG8_LDB(B1, 1, 1); PG8_SCHED; PG8_LDA(At, 1, 0); PG8_STAGE(PG8_SA(0, 1), a2 + hstep, voffA);
            PG8_WAIT_V(8); PG8_WAIT_L(0); PG8_BAR; PG8_MMA(0, 0, At, B0); PG8_MMA(0, 1, At, B1); PG8_BAR; PG8_SCHED;
            PG8_LDA(At, 1, 1); PG8_STAGE(PG8_SB(1, 0), b3, voffB); PG8_STAGE(PG8_SB(1, 1), b3 + hstep, voffB); PG8_STAGE(PG8_SA(1, 0), a3, voffA);
            PG8_WAIT_V(8); PG8_WAIT_L(0); PG8_BAR; PG8_MMA(1, 0, At, B0); PG8_MMA(1, 1, At, B1); PG8_BAR; PG8_SCHED;
            } else {
            PG8_LDB(B0, 0, 0); PG8_SCHED; PG8_LDA(At, 0, 0); PG8_STAGE(PG8_SA(1, 1), a1 + hstep, voffA);
            PG8_WAIT_L(8); PG8_BAR; PG8_WAIT_L(0); PG8_MMA(0, 0, At, B0); PG8_BAR; PG8_SCHED;
            PG8_LDB(B1, 0, 1); PG8_STAGE(PG8_SB(0, 0), b2, voffB);
            PG8_BAR; PG8_WAIT_L(0); PG8_MMA(0, 1, At, B1); PG8_BAR;
            PG8_LDA(At, 0, 1); PG8_STAGE(PG8_SA(0, 0), a2, voffA);
            PG8_BAR; PG8_WAIT_L(0); PG8_MMA(1, 0, At, B0); PG8_BAR; PG8_SCHED;
            PG8_STAGE(PG8_SB(0, 1), b2 + hstep, voffB);
            PG8_WAIT_V(6); PG8_BAR; PG8_MMA(1, 1, At, B1); PG8_BAR;
            PG8_LDB(B0, 1, 0); PG8_SCHED; PG8_LDA(At, 1, 0); PG8_STAGE(PG8_SA(0, 1), a2 + hstep, voffA);
            PG8_WAIT_L(8); PG8_BAR; PG8_WAIT_L(0); PG8_MMA(0, 0, At, B0); PG8_BAR; PG8_SCHED;
            PG8_LDB(B1, 1, 1); PG8_STAGE(PG8_SB(1, 0), b3, voffB);
            PG8_BAR; PG8_WAIT_L(0); PG8_MMA(0, 1, At, B1); PG8_BAR;
            PG8_LDA(At, 1, 1); PG8_STAGE(PG8_SA(1, 0), a3, voffA);
            PG8_BAR; PG8_WAIT_L(0); PG8_MMA(1, 0, At, B0); PG8_BAR; PG8_SCHED;
            PG8_STAGE(PG8_SB(1, 1), b3 + hstep, voffB);
            PG8_WAIT_V(6); PG8_BAR; PG8_MMA(1, 1, At, B1); PG8_BAR;
            }
        }
        if constexpr (ALIGN_EPI) { if (wr == 0) PG8_BAR; }
        if constexpr (!Epi::AFTER_DRAIN) { E(acc, cur, wr, wc, fr, fq); S.done(cur); }
        if (!has_next) break;
#pragma unroll
        for (int a = 0; a < 2; ++a)
#pragma unroll
            for (int b = 0; b < 2; ++b)
#pragma unroll
                for (int m = 0; m < 4; ++m)
#pragma unroll
                    for (int n = 0; n < 2; ++n) acc[a][b][m][n] = (f32x4){0.f, 0.f, 0.f, 0.f};
        cur = nxt; cA = nA; cB = nB; ++ui;
        if constexpr (ALIGN_EPI) { if (wr == 1) PG8_BAR; }
    }
    PG8_WAIT_V(0);
    if constexpr (!ALIGN_EPI) { if (wr == 0) PG8_BAR; }
    PG8_BAR;
    if constexpr (Epi::AFTER_DRAIN) { E.fused(acc, cur, wr, wc, fr, fq, lds, wid, lane); S.done(cur); }
#undef PG8_SA
#undef PG8_SB
#undef PG8_STAGE
#undef PG8_LDA
#undef PG8_LDB
#undef PG8_MMA
#undef PG8_WAIT_V
#undef PG8_WAIT_L
#undef PG8_BAR
#undef PG8_SCHED
}
}
namespace attn_body {
using bf16=__hip_bfloat16;
using bf16x8=__attribute__((ext_vector_type(8)))short;
using s16x4=__attribute__((ext_vector_type(4)))short;
using f32x16=__attribute__((ext_vector_type(16)))float;
using u32x4=__attribute__((ext_vector_type(4)))unsigned;
constexpr int BATCH=8,NHEAD=8,SEQ=2048,D=64,DM=NHEAD*D,DMO=1024;
constexpr int NW=8,QBLK=32,QB=QBLK*NW,KVBLK=64,NQB=SEQ/QB;
constexpr int ATTN_PITCH=DM, ATTN_UNIT_ROWS=QB;
__device__ __forceinline__ int crow(int r,int hi){return (r&3)+8*(r>>2)+4*hi;}
#define SBAR() __builtin_amdgcn_sched_barrier(0)
typedef unsigned u32x16 __attribute__((ext_vector_type(16)));
constexpr int NSLOT=3, SLOTB=8192;
constexpr int LDS_K=0, LDS_V=NSLOT*SLOTB, LDS_WS=2*NSLOT*SLOTB, LDS_OST=LDS_WS+NW*64*4, LDS_BYTES=LDS_OST+NW*4096;
constexpr float C2=0.125f*1.4426950408889634f;
__device__ __forceinline__ void glds16(const void*gsrc,unsigned lds_dst){unsigned keep;
  asm volatile("s_mov_b32 %0, m0\n\ts_mov_b32 m0, %2\n\ts_nop 0\n\tglobal_load_lds_dwordx4 %1, off\n\ts_mov_b32 m0, %0":"=&s"(keep):"v"(gsrc),"s"(lds_dst):"memory");}
__device__ __forceinline__ float max3f(float a,float b,float c){float r;asm("v_max3_f32 %0, %1, %2, %3":"=v"(r):"v"(a),"v"(b),"v"(c));return r;}
__device__ __forceinline__ float max2f(float a,float b){float r;asm("v_max_f32_e32 %0, %1, %2":"=v"(r):"v"(a),"v"(b));return r;}
__device__ __forceinline__ float fadd_s(float a,float b){float r;asm("v_add_f32_e32 %0, %1, %2":"=v"(r):"v"(a),"v"(b));return r;}
__device__ __forceinline__ float fsub_s(float a,float b){float r;asm("v_sub_f32_e32 %0, %1, %2":"=v"(r):"v"(a),"v"(b));return r;}
typedef float f32x2_t __attribute__((ext_vector_type(2))); typedef __bf16 bf16x2_t __attribute__((ext_vector_type(2)));
__device__ __forceinline__ unsigned cvtpk_s(float lo,float hi){f32x2_t v={lo,hi};bf16x2_t b=__builtin_convertvector(v,bf16x2_t);return __builtin_bit_cast(unsigned,b);}
#define WAIT_BAR(N) asm volatile("s_waitcnt vmcnt(" #N ") lgkmcnt(0)\n\ts_barrier":::"memory")

__device__ __forceinline__ void qkt(f32x16&p0,f32x16&p1,const char*Kslot,const bf16x8*qr,int r32,int hi){ const f32x16 negm=f32x16{};
  const char*kb=Kslot+hi*1024+r32*16;
  #pragma unroll
  for(int d0=0;d0<4;++d0){
    const bf16x8 b0=*reinterpret_cast<const bf16x8*>(kb+d0*2048);
    const bf16x8 b1=*reinterpret_cast<const bf16x8*>(kb+d0*2048+512);
    if(d0==0){p0=__builtin_amdgcn_mfma_f32_32x32x16_bf16(b0,qr[0],negm,0,0,0);p1=__builtin_amdgcn_mfma_f32_32x32x16_bf16(b1,qr[0],negm,0,0,0);}
    else{p0=__builtin_amdgcn_mfma_f32_32x32x16_bf16(b0,qr[d0],p0,0,0,0);p1=__builtin_amdgcn_mfma_f32_32x32x16_bf16(b1,qr[d0],p1,0,0,0);}}
}
typedef __attribute__((address_space(3))) const char* lds_cptr;
typedef short v4i16_t __attribute__((ext_vector_type(4)));
__device__ __forceinline__ void kload8(bf16x8*kf,lds_cptr kp){
  kf[0]=*(const __attribute__((address_space(3))) bf16x8*)(kp);      kf[1]=*(const __attribute__((address_space(3))) bf16x8*)(kp+512);
  kf[2]=*(const __attribute__((address_space(3))) bf16x8*)(kp+2048); kf[3]=*(const __attribute__((address_space(3))) bf16x8*)(kp+2560);
  kf[4]=*(const __attribute__((address_space(3))) bf16x8*)(kp+4096); kf[5]=*(const __attribute__((address_space(3))) bf16x8*)(kp+4608);
  kf[6]=*(const __attribute__((address_space(3))) bf16x8*)(kp+6144); kf[7]=*(const __attribute__((address_space(3))) bf16x8*)(kp+6656);
}
__device__ __forceinline__ void kload2(bf16x8*kf,lds_cptr kp,int j){ kf[2*j]=*(const __attribute__((address_space(3))) bf16x8*)(kp+j*2048); kf[2*j+1]=*(const __attribute__((address_space(3))) bf16x8*)(kp+j*2048+512); }
__device__ __forceinline__ s16x4 vtr(lds_cptr p){ return __builtin_bit_cast(s16x4,__builtin_amdgcn_ds_read_tr16_b64_v4i16((__attribute__((address_space(3))) v4i16_t*)p)); }
__device__ __forceinline__ float rowmax(const f32x16&p0,const f32x16&p1){
  float a=max3f(p0[0],p0[1],p1[0]),b=max3f(p0[2],p0[3],p1[1]);a=max3f(a,p1[2],p1[3]);
  #pragma unroll
  for(int r=4;r<16;r+=4){a=max3f(a,p0[r],p0[r+1]);b=max3f(b,p0[r+2],p0[r+3]);a=max3f(a,p1[r],p1[r+1]);b=max3f(b,p1[r+2],p1[r+3]);}
  const float m=max2f(a,b);
  auto rr=__builtin_amdgcn_permlane32_swap(__float_as_uint(m),__float_as_uint(m),false,false);
  return max2f(__uint_as_float(rr[0]),__uint_as_float(rr[1]));
}
__device__ __forceinline__ void pv(f32x16*o,int vb,bf16x8 pa0,bf16x8 pa1,bf16x8 pa2,bf16x8 pa3){
  #pragma unroll
  for(int d0=0;d0<2;++d0){s16x4 lo[4],hi[4];
    #pragma unroll
    for(int ks=0;ks<4;++ks){
      asm volatile("ds_read_b64_tr_b16 %0,%1 offset:%c2":"=&v"(lo[ks]):"v"(vb),"i"(d0*4096+ks*1024):"memory");
      asm volatile("ds_read_b64_tr_b16 %0,%1 offset:%c2":"=&v"(hi[ks]):"v"(vb),"i"(d0*4096+ks*1024+512):"memory");}
    asm volatile("s_waitcnt lgkmcnt(0)":::"memory");SBAR();
    #define PK(k) (bf16x8){lo[k][0],lo[k][1],lo[k][2],lo[k][3],hi[k][0],hi[k][1],hi[k][2],hi[k][3]}
    o[d0]=__builtin_amdgcn_mfma_f32_32x32x16_bf16(pa0,PK(0),o[d0],0,0,0);
    o[d0]=__builtin_amdgcn_mfma_f32_32x32x16_bf16(pa1,PK(1),o[d0],0,0,0);
    o[d0]=__builtin_amdgcn_mfma_f32_32x32x16_bf16(pa2,PK(2),o[d0],0,0,0);
    o[d0]=__builtin_amdgcn_mfma_f32_32x32x16_bf16(pa3,PK(3),o[d0],0,0,0);
    #undef PK
  }
}

#ifndef ATTN_STORE16
#define ATTN_STORE16(p,v) (*(u32x4*)(p)=(v))
#endif
template<int THRL> __device__ __forceinline__ void attn_unit(int b,int h,int qb,const bf16*Q,const bf16*__restrict__ K,const bf16*__restrict__ V,bf16*O,const unsigned long long*MT,char*shm){
  const int tid=threadIdx.x,lane=tid&63,r32=lane&31,hi=lane>>5; const int wid=__builtin_amdgcn_readfirstlane(tid>>6);
  const long rowbase=(long)b*SEQ; const int q0=qb*QB;
  const bf16*Qw=Q+(rowbase+q0+wid*QBLK)*DM+h*D;
  const bf16*Kh=K+rowbase*DM+h*D,*Vh=V+rowbase*DM+h*D;
  const unsigned lds0=(unsigned)(uintptr_t)shm;
  float*wsf=(float*)(shm+LDS_WS)+wid*64;
  const bf16*ksrc=Kh+(long)lane*DM+wid*8;
  const bf16*vsrc=Vh+(long)(16*(wid&3)+(lane>>2))*DM+(wid>>2)*32+(lane&3)*8;
  const unsigned kdst=lds0+LDS_K+wid*1024, vdst=lds0+LDS_V+wid*1024;
  #define DMA_K(t,slot) glds16(ksrc+(long)(t)*KVBLK*DM,(unsigned)__builtin_amdgcn_readfirstlane(kdst+(slot)))
  #define DMA_V(t,slot) glds16(vsrc+(long)(t)*KVBLK*DM,(unsigned)__builtin_amdgcn_readfirstlane(vdst+(slot)))
  const int vb0=(int)(lds0+LDS_V)+((lane>>4)&1)*32+(lane&3)*8+(4*hi+((lane&15)>>2))*64;
  const char*Kbase=shm+LDS_K; bf16x8 kf[8];
  const lds_cptr shm3=(lds_cptr)shm; const lds_cptr kp0=shm3+LDS_K+hi*1024+r32*16; const lds_cptr vp0=shm3+LDS_V+((lane>>4)&1)*32+(lane&3)*8+(4*hi+((lane&15)>>2))*64;
  const int NT=(q0+QB)/KVBLK;
  const unsigned long long*mbase=MT+((size_t)((b*(SEQ/32)+qb*NW+wid)*(SEQ/KVBLK)))*32;
  u32x16 mk0,mk1,mk2,mk3; const float NEGV=-INFINITY;
  #define MLOAD(t) do{ const unsigned long long*mp_=mbase+(size_t)(t)*32; \
    asm volatile("s_load_dwordx16 %0, %4, 0x0\n\ts_load_dwordx16 %1, %4, 0x40\n\ts_load_dwordx16 %2, %4, 0x80\n\ts_load_dwordx16 %3, %4, 0xc0":"=&s"(mk0),"=&s"(mk1),"=&s"(mk2),"=&s"(mk3):"s"(mp_):"memory"); }while(0)
  #define MK64(v,i) (((unsigned long long)(v)[2*(i)+1]<<32)|(unsigned long long)(v)[2*(i)])
  #define MAPPLY(P0,P1) do{ asm volatile("s_waitcnt lgkmcnt(0)":"+s"(mk0),"+s"(mk1),"+s"(mk2),"+s"(mk3)::"memory"); \
    _Pragma("unroll") for(int r=0;r<8;++r){ P0[r]=__builtin_amdgcn_inverse_ballot_w64(MK64(mk0,r))?P0[r]:NEGV; P0[r+8]=__builtin_amdgcn_inverse_ballot_w64(MK64(mk1,r))?P0[r+8]:NEGV; \
      P1[r]=__builtin_amdgcn_inverse_ballot_w64(MK64(mk2,r))?P1[r]:NEGV; P1[r+8]=__builtin_amdgcn_inverse_ballot_w64(MK64(mk3,r))?P1[r+8]:NEGV; } }while(0)
  DMA_K(0,0);DMA_V(0,0);DMA_K(1,SLOTB);
  bf16x8 qr[4];
  #pragma unroll
  for(int d0=0;d0<4;++d0)qr[d0]=*reinterpret_cast<const bf16x8*>(&Qw[(long)r32*DM+d0*16+hi*8]);
  float mhat=0.f,l_reg=0.f;f32x16 o[2];o[0]=f32x16{};o[1]=f32x16{};const f32x16 zc=f32x16{};
  bool resc=false;
  #define START(P0,P1) do{ const float rm=rowmax(P0,P1); resc=false; \
    { const float dl=max2f(rm,-30.f); mhat=fadd_s(mhat,dl); \
      _Pragma("unroll") for(int r=0;r<16;++r){P0[r]=fsub_s(P0[r],dl);P1[r]=fsub_s(P1[r],dl);} \
      } \
    _Pragma("unroll") for(int r=0;r<16;++r)P0[r]=__builtin_amdgcn_exp2f(P0[r]); }while(0)
  #define RESC() do{ if(resc){ asm volatile("s_waitcnt lgkmcnt(0)":::"memory"); \
      _Pragma("unroll") for(int d_=0;d_<2;++d_) _Pragma("unroll") for(int r=0;r<16;++r)o[d_][r]*=wsf[crow(r,hi)]; } }while(0)
  f32x16 pA0,pA1,pB0,pB1;
  int sl_prev=0,sl_cur=0,sl_next=SLOTB;
  #define ROT() do{sl_prev=sl_cur;sl_cur=sl_next;sl_next=(sl_next==(NSLOT-1)*SLOTB)?0:sl_next+SLOTB;}while(0)
  DMA_K(2,2*SLOTB);
  WAIT_BAR(3);
  MLOAD(0); qkt(pA0,pA1,Kbase,qr,r32,hi);asm volatile("s_nop 15\n\ts_nop 7":"+v"(pA0),"+v"(pA1));MAPPLY(pA0,pA1);asm volatile("s_nop 1":"+v"(pA0),"+v"(pA1));
  START(pA0,pA1);
  _Pragma("unroll") for(int r=0;r<16;++r)pA1[r]=__builtin_amdgcn_exp2f(pA1[r]);
  WAIT_BAR(0);
  DMA_K(3,0);DMA_V(1,SLOTB);
  ROT();
  kload8(kf,kp0+sl_cur);
  WAIT_BAR(2);
  s16x4 vlo[8],vhi[8]; u32x4 pw0,pw1,pw2,pw3;
  #define PKW(P,B) cvtpk_s(P[B],P[B+1])
  #define PAF(k) __builtin_bit_cast(bf16x8,pw##k)
  #define VFR(i) (bf16x8){vlo[i][0],vlo[i][1],vlo[i][2],vlo[i][3],vhi[i][0],vhi[i][1],vhi[i][2],vhi[i][3]}
  #define PIN(x) asm volatile("":"+v"(x))
  #define MX3(a,b,c) __builtin_fmaxf(__builtin_fmaxf((a),(b)),(c))
  #define GAPA(MF,A0,A1,A2,A3,W0,W1,PW) do{ MF; sacc+=A0; sacc+=A1; sacc+=A2; sacc+=A3; PIN(sacc); W0; W1; PIN(PW); SBAR(); }while(0)
  #define EX(v) __builtin_amdgcn_exp2f(v)
  #define GAPB(MF,X,B) do{ MF; X[B]=EX(X[B]); X[B+1]=EX(X[B+1]); X[B+2]=EX(X[B+2]); X[B+3]=EX(X[B+3]); PIN(X); SBAR(); }while(0)
  #define VRD(i) do{ vlo[i]=vtr(vp_+(((i)>>2)*4096+((i)&3)*1024)); vhi[i]=vtr(vp_+(((i)>>2)*4096+((i)&3)*1024+512)); }while(0)
  #define KRD(G,j) do{ if(G){ kload2(kf,kp0+sl_next,j); SBAR(); } }while(0)
  #define STEP(C0,C1,P0,P1,t,GK,GV,GL) do{ SBAR(); MLOAD(t); \
    const lds_cptr vp_=vp0+sl_prev; \
    VRD(0); SBAR(); float sacc=(P0[0]+P0[1]); \
    GAPA(C0=__builtin_amdgcn_mfma_f32_32x32x16_bf16(kf[0],qr[0],zc,0,0,0), P0[2],P0[3],P0[4],P0[5],     pw0[0]=PKW(P0,0), pw0[1]=PKW(P0,2), pw0); \
    VRD(4); SBAR(); GAPA(C1=__builtin_amdgcn_mfma_f32_32x32x16_bf16(kf[1],qr[0],zc,0,0,0), P0[6],P0[7],P0[8],P0[9],     pw0[2]=PKW(P0,4), pw0[3]=PKW(P0,6), pw0); \
    VRD(1); SBAR(); GAPA(C0=__builtin_amdgcn_mfma_f32_32x32x16_bf16(kf[2],qr[1],C0,0,0,0),   P0[10],P0[11],P0[12],P0[13], pw1[0]=PKW(P0,8), pw1[1]=PKW(P0,10), pw1); \
    VRD(5); SBAR(); GAPA(C1=__builtin_amdgcn_mfma_f32_32x32x16_bf16(kf[3],qr[1],C1,0,0,0),   P0[14],P0[15],P1[0],P1[1],   pw1[2]=PKW(P0,12),pw1[3]=PKW(P0,14), pw1); \
    VRD(2); SBAR(); GAPA(C0=__builtin_amdgcn_mfma_f32_32x32x16_bf16(kf[4],qr[2],C0,0,0,0),   P1[2],P1[3],P1[4],P1[5],     pw2[0]=PKW(P1,0), pw2[1]=PKW(P1,2), pw2); \
    VRD(6); SBAR(); GAPA(C1=__builtin_amdgcn_mfma_f32_32x32x16_bf16(kf[5],qr[2],C1,0,0,0),   P1[6],P1[7],P1[8],P1[9],     pw2[2]=PKW(P1,4), pw2[3]=PKW(P1,6), pw2); \
    VRD(3); SBAR(); GAPA(C0=__builtin_amdgcn_mfma_f32_32x32x16_bf16(kf[6],qr[3],C0,0,0,0),   P1[10],P1[11],P1[12],P1[13], pw3[0]=PKW(P1,8), pw3[1]=PKW(P1,10), pw3); \
    VRD(7); SBAR(); GAPA(C1=__builtin_amdgcn_mfma_f32_32x32x16_bf16(kf[7],qr[3],C1,0,0,0),   P1[14],P1[15],0.f,0.f,       pw3[2]=PKW(P1,12),pw3[3]=PKW(P1,14), pw3); \
    l_reg+=sacc; \
    if(GK){DMA_K((t)+3,sl_cur);} if(GV){DMA_V((t)+1,sl_next);} \
    MAPPLY(C0,C1); \
    { float a=MX3(C0[0],C0[1],C1[0]),b=MX3(C0[2],C0[3],C1[1]); a=MX3(a,C1[2],C1[3]); \
      _Pragma("unroll") for(int r=4;r<16;r+=4){a=MX3(a,C0[r],C0[r+1]);b=MX3(b,C0[r+2],C0[r+3]);a=MX3(a,C1[r],C1[r+1]);b=MX3(b,C1[r+2],C1[r+3]);} \
      float rm=__builtin_fmaxf(a,b); { auto rr=__builtin_amdgcn_permlane32_swap(__float_as_uint(rm),__float_as_uint(rm),false,false); rm=__builtin_fmaxf(__uint_as_float(rr[0]),__uint_as_float(rr[1])); } \
      resc=false; \
      const float rl=rm-mhat; \
      if(__builtin_expect(__any(rl>(float)THRL),0)){ const float dl=__builtin_fmaxf(rl,0.f); mhat+=dl; \
        const float f=__builtin_amdgcn_exp2f(-dl); l_reg*=f; if(hi==0)wsf[r32]=f; resc=true; } \
      _Pragma("unroll") for(int r=0;r<16;++r){C0[r]-=mhat;C1[r]-=mhat;} } \
    SBAR(); \
    GAPB(o[0]=__builtin_amdgcn_mfma_f32_32x32x16_bf16(PAF(0),VFR(0),o[0],0,0,0), C0,0); \
    GAPB(o[1]=__builtin_amdgcn_mfma_f32_32x32x16_bf16(PAF(0),VFR(4),o[1],0,0,0), C0,4); \
    KRD(GL,0); GAPB(o[0]=__builtin_amdgcn_mfma_f32_32x32x16_bf16(PAF(1),VFR(1),o[0],0,0,0), C0,8); \
    KRD(GL,1); GAPB(o[1]=__builtin_amdgcn_mfma_f32_32x32x16_bf16(PAF(1),VFR(5),o[1],0,0,0), C0,12); \
    KRD(GL,2); GAPB(o[0]=__builtin_amdgcn_mfma_f32_32x32x16_bf16(PAF(2),VFR(2),o[0],0,0,0), C1,0); \
    KRD(GL,3); GAPB(o[1]=__builtin_amdgcn_mfma_f32_32x32x16_bf16(PAF(2),VFR(6),o[1],0,0,0), C1,4); \
    GAPB(o[0]=__builtin_amdgcn_mfma_f32_32x32x16_bf16(PAF(3),VFR(3),o[0],0,0,0), C1,8); \
    GAPB(o[1]=__builtin_amdgcn_mfma_f32_32x32x16_bf16(PAF(3),VFR(7),o[1],0,0,0), C1,12); \
    }while(0)
  int t=1;
  for(;t+5<NT;t+=2){
    STEP(pB0,pB1,pA0,pA1,t,true,true,true);     WAIT_BAR(2); RESC(); ROT();
    STEP(pA0,pA1,pB0,pB1,t+1,true,true,true);   WAIT_BAR(2); RESC(); ROT();
  }
  #define ENDW(tt) do{ if((tt)+3<NT){WAIT_BAR(2);} else if((tt)+2<NT){WAIT_BAR(1);} else {WAIT_BAR(0);} }while(0)
  for(;t+1<NT;t+=2){
    STEP(pB0,pB1,pA0,pA1,t,(t+3<NT),(t+1<NT),(t+1<NT));       ENDW(t);   RESC(); ROT();
    STEP(pA0,pA1,pB0,pB1,t+1,(t+4<NT),(t+2<NT),(t+2<NT));     ENDW(t+1); RESC(); ROT();
  }
  STEP(pB0,pB1,pA0,pA1,NT-1,false,false,false); RESC();
  { float sacc=pB0[0]+pB0[1]; _Pragma("unroll") for(int r=2;r<16;++r)sacc+=pB0[r]; _Pragma("unroll") for(int r=0;r<16;++r)sacc+=pB1[r]; l_reg+=sacc;
    pw0=(u32x4){PKW(pB0,0),PKW(pB0,2),PKW(pB0,4),PKW(pB0,6)};pw1=(u32x4){PKW(pB0,8),PKW(pB0,10),PKW(pB0,12),PKW(pB0,14)};pw2=(u32x4){PKW(pB1,0),PKW(pB1,2),PKW(pB1,4),PKW(pB1,6)};pw3=(u32x4){PKW(pB1,8),PKW(pB1,10),PKW(pB1,12),PKW(pB1,14)};
    SBAR(); pv(o,vb0+sl_cur,PAF(0),PAF(1),PAF(2),PAF(3)); }
  #undef PKW
  #undef PAF
  #undef VFR
  #undef PIN
  #undef MX3
  #undef GAPA
  #undef GAPB
  #undef EX
  #undef VRD
  #undef KRD
  #undef STEP
  #undef ENDW
  {auto rr=__builtin_amdgcn_permlane32_swap(__float_as_uint(l_reg),__float_as_uint(l_reg),false,false);l_reg=__uint_as_float(rr[0])+__uint_as_float(rr[1]);}
  if(hi==0)wsf[32+r32]=l_reg;asm volatile("s_waitcnt lgkmcnt(0)":::"memory");
  float rli[16];
  #pragma unroll
  for(int r=0;r<16;++r)rli[r]=__builtin_amdgcn_rcpf(wsf[32+crow(r,hi)]);
  bf16*Ow=O+(rowbase+q0+wid*QBLK)*DMO+h*D;
  { bf16*stg=(bf16*)(shm+LDS_OST)+wid*2048;
    #pragma unroll
    for(int r=0;r<16;++r){const int orow=crow(r,hi);
      #pragma unroll
      for(int d0=0;d0<2;++d0)stg[orow*64+d0*32+r32]=__float2bfloat16(o[d0][r]*rli[r]);}
    asm volatile("s_waitcnt lgkmcnt(0)":::"memory");
    #pragma unroll
    for(int i=0;i<4;++i){const int row=i*8+(lane>>3),ch=lane&7; const u32x4 v=*(const u32x4*)(stg+row*64+ch*8); ATTN_STORE16(Ow+(long)row*DMO+ch*8,v);} }
  asm volatile("s_waitcnt lgkmcnt(0)\n\ts_barrier":::"memory");
  #undef DMA_K
  #undef DMA_V
  #undef MLOAD
  #undef MK64
  #undef MAPPLY
  #undef START
  #undef RESC
  #undef ROT
}
constexpr int ATTN_LDS_BYTES=LDS_BYTES;
struct AttnTensors { const bf16* Q; const bf16* K; const bf16* V; bf16* O; const unsigned long long* MT; };
struct AttnUnit { int bh; int qb; };
struct StaticOrder {
  int vcu;
  __device__ __forceinline__ explicit StaticOrder(int grid,int block):vcu((block%8)*(grid/8)+block/8){}
  __device__ __forceinline__ bool next(int i,AttnUnit&u)const{ if(i>=2)return false; const int s=vcu&3; u.bh=vcu>>2; u.qb=(i==0)?s:7-s; return true; }
  __device__ __forceinline__ void a_ready(const AttnUnit&)const{}
  __device__ __forceinline__ void done(const AttnUnit&)const{}
};
template<class Sched,int THRL=8> __device__ __forceinline__ void attn_phase(char*lds,const AttnTensors&T,const Sched&S){
  AttnUnit u;
  for(int i=0;S.next(i,u);++i){ S.a_ready(u); attn_unit<THRL>(u.bh/NHEAD,u.bh%NHEAD,u.qb,T.Q,T.K,T.V,T.O,T.MT,lds); S.done(u); }
}
#undef SBAR
#undef WAIT_BAR
}
#define XB_TMO      128
#define XB_XCNT(j)  (256  + 64 * (j))
#define XB_XSUB(j)  (1280 + 64 * (j))
#define XB_XGEN(j)  (2304 + 64 * (j))
#define XB_TOP      3328
#define XB_TOPGEN   3392
#define XCD_BAR_WORDS 3456
#define XB_SPIN_CAP (1u << 18)

__device__ __forceinline__ unsigned xb_ld(unsigned* p)              { return __hip_atomic_load(p, __ATOMIC_RELAXED, __HIP_MEMORY_SCOPE_AGENT); }
__device__ __forceinline__ unsigned xb_add(unsigned* p, unsigned v) { return __hip_atomic_fetch_add(p, v, __ATOMIC_RELAXED, __HIP_MEMORY_SCOPE_AGENT); }
__device__ __forceinline__ unsigned xb_xcc_id() { return (unsigned)__builtin_amdgcn_s_getreg((3 << 11) | 20) & 0xFu; }
#define XB_SPIN(cond, bar) do { unsigned _sp = 0; while (cond) { __builtin_amdgcn_s_sleep(1); \
    if ((++_sp & 255u) == 0u) { if (xb_ld(&(bar)[XB_TMO])) break; if (_sp > XB_SPIN_CAP) { atomicAdd(&(bar)[XB_TMO], 1u); break; } } } } while (0)

struct XcdBarrier {
    unsigned* bar; unsigned x;
    volatile LAS unsigned* st;
};

__device__ __forceinline__ XcdBarrier xcd_barrier_post(unsigned* bar, volatile LAS unsigned* st) {
    XcdBarrier b; b.bar = bar; b.x = xb_xcc_id(); b.st = st;
    if (threadIdx.x == 0) (void)xb_add(&bar[XB_XCNT(b.x)], 1u);
    return b;
}
__device__ __forceinline__ void xcd_barrier_complete(unsigned* bar, unsigned x, unsigned& nloc, unsigned& nx) {
    const unsigned G = gridDim.x * gridDim.y * gridDim.z;
    unsigned sum, cnt, mine, sp = 0u;
    for (;;) {
        sum = 0u; cnt = 0u; mine = 0u;
#pragma unroll
        for (unsigned j = 0; j < 16; ++j) { const unsigned c = xb_ld(&bar[XB_XCNT(j)]); sum += c; cnt += (c > 0u) ? 1u : 0u; mine = (j == x) ? c : mine; }
        if (sum == G) break;
        __builtin_amdgcn_s_sleep(1);
        if ((++sp & 255u) == 0u) { if (xb_ld(&bar[XB_TMO])) break; if (sp > XB_SPIN_CAP) { atomicAdd(&bar[XB_TMO], 1u); break; } }
    }
    nloc = mine > 0u ? mine : 1u; nx = cnt > 0u ? cnt : 1u;
}

__device__ __forceinline__ void xcd_barrier(const XcdBarrier& b) {
    asm volatile("s_waitcnt vmcnt(0)" ::: "memory");
    __syncthreads();
    if (threadIdx.x == 0) {
        unsigned* bar = b.bar;
        __builtin_amdgcn_s_waitcnt(0);
        unsigned nloc = b.st[0], nx = b.st[1];
        if (nloc == 0u) { xcd_barrier_complete(bar, b.x, nloc, nx); b.st[0] = nloc; b.st[1] = nx; }
        const unsigned old = xb_add(&bar[XB_XSUB(b.x)], 1u);
        const unsigned gen = old / nloc;
        if (old + 1u == (gen + 1u) * nloc) {
            __builtin_amdgcn_fence(__ATOMIC_RELEASE, "agent");
            asm volatile("s_waitcnt vmcnt(0)" ::: "memory");
            const unsigned og = xb_add(&bar[XB_TOP], 1u);
            const unsigned tg = og / nx;
            if (og + 1u == (tg + 1u) * nx) xb_add(&bar[XB_TOPGEN], 1u);
            else XB_SPIN(xb_ld(&bar[XB_TOPGEN]) == tg, bar);
            __builtin_amdgcn_fence(__ATOMIC_ACQUIRE, "agent");
            xb_add(&bar[XB_XGEN(b.x)], 1u);
            asm volatile("s_waitcnt vmcnt(0)" ::: "memory");
        } else {
            XB_SPIN(xb_ld(&bar[XB_XGEN(b.x)]) == gen, bar);
            __builtin_amdgcn_fence(__ATOMIC_ACQUIRE, "agent");
            asm volatile("s_waitcnt vmcnt(0)" ::: "memory");
        }
    }
    __syncthreads();
}
#define GAS __attribute__((address_space(1)))
#ifndef LAS
#define LAS __attribute__((address_space(3)))
#endif
typedef unsigned short bf16;
typedef unsigned v4u __attribute__((ext_vector_type(4)));
typedef float f32x4 __attribute__((ext_vector_type(4)));
#define LDS_WAIT() asm volatile("s_waitcnt lgkmcnt(0)" ::: "memory")
#define VM_WAIT() asm volatile("s_waitcnt vmcnt(0)" ::: "memory")

constexpr int D = 1024, NB = 8, T = 2048, MP = NB * T, NSMP = 32, MT = MP + NSMP, MPAD = 16640;
constexpr int ATT_W = 512, AH = 8, IH = 16, IDD = 64, TOPK = 256;
constexpr int RW_W = 512, RH = 8, RN = 64;
constexpr int RW_COLS = 1792, IN_COLS = 4432, NIN = 4608;
constexpr int FFN = 2816, NGU = 2 * FFN;
constexpr int NPAGES = 64, PAGE = 128, PAST = 8192, LS = PAST + 1, SCS_LD = 8704;
constexpr int O_Q = 0, O_K = 512, O_V = 1024, O_QI = 1536, O_KI = 2560, O_WI = 2624, O_RW = 2640;
constexpr float IDX_W_SCALE = 0.03125f;
constexpr float RMS_EPS = 1e-6f, GN_EPS = 64e-5f;
constexpr int MODW = 6 * D;

constexpr size_t OUT_Y = 0, OUT_YS = OUT_Y + (size_t)MP * D, OUT_KP = OUT_YS + (size_t)NSMP * D, OUT_VP = OUT_KP + (size_t)MP * ATT_W,
                 OUT_IKP = OUT_VP + (size_t)MP * ATT_W, OUT_WKVP = OUT_IKP + (size_t)MP * IDD, OUT_SHP = OUT_WKVP + (size_t)NB * RH * RN * RN,
                 OUT_KS = OUT_SHP + (size_t)NB * RW_COLS, OUT_VS = OUT_KS + (size_t)NSMP * ATT_W, OUT_IKS = OUT_VS + (size_t)NSMP * ATT_W,
                 OUT_WKVS = OUT_IKS + (size_t)NSMP * IDD, OUT_SHS = OUT_WKVS + (size_t)NSMP * RH * RN * RN, OUT_END = OUT_SHS + (size_t)NSMP * RW_COLS;
static_assert(OUT_END == 36052992, "output size");

constexpr size_t MiB = 1u << 20;
constexpr size_t WS_CTL = 0, CTL_ZERO_BYTES = 1 * MiB;
constexpr size_t WS_MOD = 1 * MiB;
constexpr size_t WS_WIN = 2 * MiB;
constexpr size_t WS_WOUT = 12 * MiB;
constexpr size_t WS_WGU = 14 * MiB;
constexpr size_t WS_WDN = 26 * MiB;
constexpr size_t WS_A1 = 32 * MiB;
constexpr size_t WS_A2 = 66 * MiB;
constexpr size_t WS_MIX = 100 * MiB;
constexpr size_t WS_HB = 134 * MiB;
constexpr size_t WS_X1 = 224 * MiB;
constexpr size_t WS_PROJ = 290 * MiB;
constexpr size_t WS_PRW = 290 * MiB;
constexpr size_t WS_RAW = 584 * MiB;
constexpr size_t WS_RAW2 = 650 * MiB;
constexpr size_t WS_QN = 1008 * MiB;
constexpr size_t WS_RWA = 1042 * MiB, RWA_STRIDE = 33 * MiB;
constexpr size_t WS_Y = 1273 * MiB;
constexpr size_t WS_SC = 1306 * MiB;
constexpr size_t WS_SCS = 1434 * MiB;
constexpr size_t WS_MASK = 1436 * MiB;
constexpr size_t WS_SLIST = 1440 * MiB;
constexpr size_t WS_QB = 1444 * MiB, WS_KB = 1461 * MiB, WS_VB = 1478 * MiB;
constexpr size_t WS_MASKT = 1495 * MiB;
constexpr size_t WS_QIB = 1500 * MiB;
constexpr size_t WS_KIB = 1536 * MiB;
constexpr size_t WS_WI = 1539 * MiB;
constexpr size_t WS_LIN = 1541 * MiB;
constexpr size_t WS_KX = 1550 * MiB;
constexpr size_t WS_W2T = 1583 * MiB, WS_A2T = 1584 * MiB, WS_G2T = 1585 * MiB;
constexpr size_t WS_MF = 1586 * MiB, WS_NT = 1603 * MiB, WS_PF = 1636 * MiB, WS_QP = 1653 * MiB, WS_ZF = 1686 * MiB;
constexpr size_t WS_Y2 = 1703 * MiB;
constexpr size_t WS_END = 1736 * MiB;
constexpr int QI_LD = 17 * 64;
constexpr int CW_BAR = 4096;

constexpr int NWAVES = 8, NTHREADS = 512;
constexpr int LDS_BYTES = 147456, MISC_OFF = 147200;

__device__ __forceinline__ unsigned f2bf(float f) { unsigned u = __builtin_bit_cast(unsigned, f); return (u + 0x7fffu + ((u >> 16) & 1u)) >> 16; }
__device__ __forceinline__ unsigned pk2(float lo, float hi) { return f2bf(lo) | (f2bf(hi) << 16); }
__device__ __forceinline__ float wave_sum(float v) {
#pragma unroll
    for (int o = 1; o < 64; o <<= 1) v += __shfl_xor(v, o);
    return v;
}
__device__ __forceinline__ float wave_max(float v) {
#pragma unroll
    for (int o = 1; o < 64; o <<= 1) v = fmaxf(v, __shfl_xor(v, o));
    return v;
}
__device__ __forceinline__ int wave_sum_i(int v) {
#pragma unroll
    for (int o = 1; o < 64; o <<= 1) v += __shfl_xor(v, o);
    return v;
}
__device__ __forceinline__ float sigmoidf_(float x) { return 1.f / (1.f + expf(-x)); }
__device__ __forceinline__ unsigned sortable(float f) { const unsigned u = __builtin_bit_cast(unsigned, f); return (u & 0x80000000u) ? ~u : (u | 0x80000000u); }
__device__ __forceinline__ unsigned long long lanemask_lt(int lane) { return (1ull << lane) - 1ull; }
__device__ __forceinline__ float rdlane(float v, int l) { return __builtin_bit_cast(float, __builtin_amdgcn_readlane(__builtin_bit_cast(int, v), l)); }

struct Args { const float* in[32]; float* out; unsigned char* ws; int ph_lo, ph_hi; };

struct Ctx {
    LAS unsigned char* lds;
    int tid, lane, wave, G, gw, ngw;
    const float* const* in; float* out; unsigned char* ws;
};
__device__ __forceinline__ const float* x_row(const Ctx& C, int m) { return m < MP ? C.in[0] + (size_t)m * D : C.in[1] + (size_t)(m - MP) * D; }
__device__ __forceinline__ int mod_row(int m) { return m < MP ? (m >> 11) : NB + (m - MP); }

struct EpiRawF32 {
    static constexpr bool PERM = false, AFTER_DRAIN = false;
    float* O; int ldc;
    __device__ __forceinline__ void operator()(const pg8::f32x4 (&acc)[2][2][4][2], const pg8::Unit& u, int wr, int wc, int fr, int fq) const {
        const int row0 = u.pm * 256 + wr * 64 + fr, col0 = u.pn * 256 + wc * 32 + 4 * fq;
#pragma unroll
        for (int ai = 0; ai < 2; ++ai)
#pragma unroll
            for (int m = 0; m < 4; ++m) { float* rowp = O + (size_t)(row0 + ai * 128 + m * 16) * ldc + col0;
#pragma unroll
                for (int bj = 0; bj < 2; ++bj)
#pragma unroll
                    for (int n = 0; n < 2; ++n) *(pg8::f32x4*)(rowp + bj * 128 + n * 16) = acc[ai][bj][m][n]; }
    }
};

struct EpiResGate {
    static constexpr bool PERM = false, AFTER_DRAIN = false;
    const float* base; const float* gate; float* out;
    __device__ __forceinline__ void operator()(const pg8::f32x4 (&acc)[2][2][4][2], const pg8::Unit& u, int wr, int wc, int fr, int fq) const {
        const int row0 = u.pm * 256 + wr * 64 + fr, col0 = u.pn * 256 + wc * 32 + 4 * fq;
        const float* gp = gate + (size_t)((u.pm * 256) >> 11) * MODW + col0;
        pg8::f32x4 gv[2][2];
#pragma unroll
        for (int bj = 0; bj < 2; ++bj)
#pragma unroll
            for (int n = 0; n < 2; ++n) gv[bj][n] = *(const pg8::f32x4*)(gp + bj * 128 + n * 16);
#pragma unroll
        for (int ai = 0; ai < 2; ++ai)
#pragma unroll
            for (int m = 0; m < 4; ++m) { const size_t off = (size_t)(row0 + ai * 128 + m * 16) * D + col0;
#pragma unroll
                for (int bj = 0; bj < 2; ++bj)
#pragma unroll
                    for (int n = 0; n < 2; ++n) { const pg8::f32x4 bv = *(const pg8::f32x4*)(base + off + bj * 128 + n * 16);
                        *(pg8::f32x4*)(out + off + bj * 128 + n * 16) = bv + gv[bj][n] * acc[ai][bj][m][n]; } }
    }
};
struct EpiIn {
    static constexpr bool PERM = true, AFTER_DRAIN = false;
    unsigned char* ws; float* out; const float* qg; const float* kg;
    __device__ __forceinline__ void operator()(const pg8::f32x4 (&acc)[2][2][4][2], const pg8::Unit& u, int wr, int wc, int fr, int fq) const {
        const int pn = u.pn; const bool smp = u.pm == MP / 256;
        bf16* QB = (bf16*)(ws + WS_QB); bf16* KB = (bf16*)(ws + WS_KB); bf16* VB = (bf16*)(ws + WS_VB); bf16* QIb = (bf16*)(ws + WS_QIB); bf16* KIb = (bf16*)(ws + WS_KIB);
        float* QN = (float*)(ws + WS_QN); float* WI = (float*)(ws + WS_WI); float* PRW = (float*)(ws + WS_PRW);
        float gq[2][8];
        if (pn < 4) {
#pragma unroll
            for (int bj = 0; bj < 2; ++bj)
#pragma unroll
                for (int e = 0; e < 8; ++e) gq[bj][e] = (pn < 2 ? qg : kg)[32 * bj + 8 * fq + e] * (pn < 2 ? attn_body::C2 : 1.f);
        }
#pragma unroll
        for (int ai = 0; ai < 2; ++ai)
#pragma unroll
            for (int m = 0; m < 4; ++m) {
                const int r = u.pm * 256 + ai * 128 + wr * 64 + m * 16 + fr; const bool ok = r < MT;
                float v[2][8];
#pragma unroll
                for (int bj = 0; bj < 2; ++bj)
#pragma unroll
                    for (int n = 0; n < 2; ++n)
#pragma unroll
                        for (int i = 0; i < 4; ++i) v[bj][4 * n + i] = acc[ai][bj][m][n][i];
                float rstd = 1.f;
                if (pn < 4 || (pn == 10 && wc == 0)) { float ss = 0.f;
#pragma unroll
                    for (int bj = 0; bj < 2; ++bj)
#pragma unroll
                        for (int e = 0; e < 8; ++e) ss += v[bj][e] * v[bj][e];
                    ss += __shfl_xor(ss, 16); ss += __shfl_xor(ss, 32);
                    rstd = 1.f / sqrtf(ss * (1.f / 64.f) + RMS_EPS); }
                if (!ok) continue;
#pragma unroll
                for (int bj = 0; bj < 2; ++bj) {
                    const int cl = 32 * bj + 8 * fq;
                    float* x = v[bj];
                    if (pn < 2) {
                        const int col = (4 * pn + wc) * 64 + cl; pg8::u32x4 w;
                        w.x = pg8::cvt_pk_bf16(x[0] * rstd * gq[bj][0], x[1] * rstd * gq[bj][1]); w.y = pg8::cvt_pk_bf16(x[2] * rstd * gq[bj][2], x[3] * rstd * gq[bj][3]);
                        w.z = pg8::cvt_pk_bf16(x[4] * rstd * gq[bj][4], x[5] * rstd * gq[bj][5]); w.w = pg8::cvt_pk_bf16(x[6] * rstd * gq[bj][6], x[7] * rstd * gq[bj][7]);
                        *(pg8::u32x4*)(QB + (size_t)r * ATT_W + col) = w;
                        if (smp) { const float ic = 1.f / attn_body::C2; float* qn = QN + (size_t)r * ATT_W + col;
                            *(pg8::f32x4*)qn = (pg8::f32x4){x[0] * rstd * gq[bj][0] * ic, x[1] * rstd * gq[bj][1] * ic, x[2] * rstd * gq[bj][2] * ic, x[3] * rstd * gq[bj][3] * ic};
                            *(pg8::f32x4*)(qn + 4) = (pg8::f32x4){x[4] * rstd * gq[bj][4] * ic, x[5] * rstd * gq[bj][5] * ic, x[6] * rstd * gq[bj][6] * ic, x[7] * rstd * gq[bj][7] * ic}; }
                    } else if (pn < 6) {
                        const bool isk = pn < 4; const int col = (4 * (pn & 1) + wc) * 64 + cl; float y[8];
#pragma unroll
                        for (int e = 0; e < 8; ++e) y[e] = isk ? x[e] * rstd * gq[bj][e] : x[e];
                        float* o = out + (isk ? (smp ? OUT_KS : OUT_KP) : (smp ? OUT_VS : OUT_VP)) + (size_t)(smp ? r - MP : r) * ATT_W + col;
                        *(pg8::f32x4*)o = (pg8::f32x4){y[0], y[1], y[2], y[3]}; *(pg8::f32x4*)(o + 4) = (pg8::f32x4){y[4], y[5], y[6], y[7]};
                        pg8::u32x4 w; w.x = pg8::cvt_pk_bf16(y[0], y[1]); w.y = pg8::cvt_pk_bf16(y[2], y[3]); w.z = pg8::cvt_pk_bf16(y[4], y[5]); w.w = pg8::cvt_pk_bf16(y[6], y[7]);
                        *(pg8::u32x4*)((isk ? KB : VB) + (size_t)r * ATT_W + col) = w;
                    } else if (pn < 10) {
                        const int col = (4 * (pn - 6) + wc) * 64 + cl;
                        pg8::u32x4 w; w.x = pg8::cvt_pk_bf16(x[0], x[1]); w.y = pg8::cvt_pk_bf16(x[2], x[3]); w.z = pg8::cvt_pk_bf16(x[4], x[5]); w.w = pg8::cvt_pk_bf16(x[6], x[7]);
                        *(pg8::u32x4*)(QIb + (size_t)r * QI_LD + col) = w;
                    } else if (pn == 10) {
                        if (wc == 0) {
                            float* o = out + (smp ? OUT_IKS : OUT_IKP) + (size_t)(smp ? r - MP : r) * IDD + cl;
                            *(pg8::f32x4*)o = (pg8::f32x4){x[0] * rstd, x[1] * rstd, x[2] * rstd, x[3] * rstd}; *(pg8::f32x4*)(o + 4) = (pg8::f32x4){x[4] * rstd, x[5] * rstd, x[6] * rstd, x[7] * rstd};
                            pg8::u32x4 w; w.x = pg8::cvt_pk_bf16(x[0] * rstd, x[1] * rstd); w.y = pg8::cvt_pk_bf16(x[2] * rstd, x[3] * rstd); w.z = pg8::cvt_pk_bf16(x[4] * rstd, x[5] * rstd); w.w = pg8::cvt_pk_bf16(x[6] * rstd, x[7] * rstd);
                            *(pg8::u32x4*)(KIb + (size_t)r * IDD + cl) = w;
                        } else if (wc == 1) {
                            if (bj == 0 && fq < 2) { float* o = WI + (size_t)r * IH + 8 * fq; *(pg8::f32x4*)o = (pg8::f32x4){x[0], x[1], x[2], x[3]}; *(pg8::f32x4*)(o + 4) = (pg8::f32x4){x[4], x[5], x[6], x[7]}; }
                        } else {
                            float* o = PRW + (size_t)r * RW_COLS + 1536 + 64 * (wc - 2) + cl;
                            *(pg8::f32x4*)o = (pg8::f32x4){x[0], x[1], x[2], x[3]}; *(pg8::f32x4*)(o + 4) = (pg8::f32x4){x[4], x[5], x[6], x[7]}; }
                    } else if (pn < 17) {
                        float* o = PRW + (size_t)r * RW_COLS + (pn - 11) * 256 + 64 * wc + cl;
                        *(pg8::f32x4*)o = (pg8::f32x4){x[0], x[1], x[2], x[3]}; *(pg8::f32x4*)(o + 4) = (pg8::f32x4){x[4], x[5], x[6], x[7]};
                    } else if (wc < 2) {
                        float* o = PRW + (size_t)r * RW_COLS + 1664 + 64 * wc + cl;
                        *(pg8::f32x4*)o = (pg8::f32x4){x[0], x[1], x[2], x[3]}; *(pg8::f32x4*)(o + 4) = (pg8::f32x4){x[4], x[5], x[6], x[7]}; }
                }
            }
    }
};
struct EpiSwiGLU {
    static constexpr bool PERM = true, AFTER_DRAIN = false;
    bf16* H;
    __device__ __forceinline__ void operator()(const pg8::f32x4 (&acc)[2][2][4][2], const pg8::Unit& u, int wr, int wc, int fr, int fq) const {
        const int row0 = u.pm * 256 + wr * 64 + fr, col0 = u.pn * 128 + wc * 32 + 8 * fq;
#pragma unroll
        for (int ai = 0; ai < 2; ++ai)
#pragma unroll
            for (int m = 0; m < 4; ++m) { float hv[8];
#pragma unroll
                for (int n = 0; n < 2; ++n)
#pragma unroll
                    for (int i = 0; i < 4; ++i) { const float g = acc[ai][0][m][n][i], up = acc[ai][1][m][n][i]; hv[4 * n + i] = g * __builtin_amdgcn_rcpf(1.f + __expf(-g)) * up; }
                pg8::u32x4 w; w.x = pg8::cvt_pk_bf16(hv[0], hv[1]); w.y = pg8::cvt_pk_bf16(hv[2], hv[3]); w.z = pg8::cvt_pk_bf16(hv[4], hv[5]); w.w = pg8::cvt_pk_bf16(hv[6], hv[7]);
                *(pg8::u32x4*)(H + (size_t)(row0 + ai * 128 + m * 16) * FFN + col0) = w; }
    }
};
template <class F> __device__ __forceinline__ void sample_gemm(const Ctx& C, const bf16* A, const bf16* Bt, int K, const F& f) {
    typedef short bf16x8 __attribute__((ext_vector_type(8))); typedef float f32x16 __attribute__((ext_vector_type(16)));
    LAS float* red = (LAS float*)C.lds;
    const int lane = C.lane, hi = lane >> 5, ksteps = K / 16 / NWAVES;
    for (int u = (int)blockIdx.x - 128; u >= 0 && u < D / 32; u += C.G) {
        const int n0 = 32 * u;
        const bf16* ap = A + (size_t)(lane & 31) * K + (size_t)C.wave * ksteps * 16 + 8 * hi; const bf16* bp = Bt + (size_t)(n0 + (lane & 31)) * K + (size_t)C.wave * ksteps * 16 + 8 * hi;
        f32x16 acc = f32x16{};
        for (int ks = 0; ks < ksteps; ++ks) acc = __builtin_amdgcn_mfma_f32_32x32x16_bf16(*(const bf16x8*)(ap + 16 * ks), *(const bf16x8*)(bp + 16 * ks), acc, 0, 0, 0);
        __syncthreads();
#pragma unroll
        for (int r = 0; r < 16; ++r) red[(C.wave * 64 + lane) * 16 + r] = acc[r];
        __syncthreads();
        for (int o = C.tid; o < 1024; o += NTHREADS) { const int ls = o & 63, r = o >> 6; float v = 0.f;
#pragma unroll
            for (int w = 0; w < 8; ++w) v += red[(w * 64 + ls) * 16 + r];
            f((r & 3) + 8 * (r >> 2) + 4 * (ls >> 5), n0 + (ls & 31), v); }
    }
    __syncthreads();
}

__device__ __forceinline__ void p0_mod(const Ctx& C) {
    LAS float* sc = (LAS float*)C.lds;
    const float* cp = C.in[8]; const float* cs = C.in[9]; const float* wada = C.in[12]; const float* bada = C.in[13];
    float* MOD = (float*)(C.ws + WS_MOD);
    const int cl = C.tid & 31, kc = C.tid >> 5;
    for (int u = blockIdx.x; u < MODW / 32; u += C.G) {
        const int c0 = 32 * u;
        float acc[40];
#pragma unroll
        for (int r = 0; r < 40; ++r) acc[r] = 0.f;
        for (int hh = 0; hh < 2; ++hh) {
            __syncthreads();
            for (int i = C.tid; i < 40 * 512; i += NTHREADS) { const int r = i >> 9, kk = i & 511; const float v = (r < NB) ? cp[r * D + 512 * hh + kk] : cs[(r - NB) * D + 512 * hh + kk]; sc[i] = v / (1.f + expf(-v)); }
            __syncthreads();
            const int kb = 512 * hh + 32 * kc;
            for (int k4 = 0; k4 < 8; ++k4) {
                const float* wp = wada + (size_t)(kb + 4 * k4) * MODW + c0 + cl;
                const float w0 = wp[0], w1 = wp[MODW], w2 = wp[2 * MODW], w3 = wp[3 * MODW];
#pragma unroll
                for (int r = 0; r < 40; ++r) { const f32x4 s = *(const LAS f32x4*)(sc + r * 512 + 32 * kc + 4 * k4); acc[r] += s.x * w0 + s.y * w1 + s.z * w2 + s.w * w3; }
            }
        }
        __syncthreads();
#pragma unroll
        for (int r = 0; r < 40; ++r) sc[(kc * 40 + r) * 32 + cl] = acc[r];
        __syncthreads();
        for (int i = C.tid; i < 40 * 32; i += NTHREADS) { const int r = i >> 5, c = i & 31; float s = 0.f;
            for (int k = 0; k < 16; ++k) s += sc[(k * 40 + r) * 32 + c];
            MOD[r * MODW + c0 + c] = s + bada[c0 + c]; }
    }
    __syncthreads();
}
template <int MODE = 0> __device__ __forceinline__ void transpose_item(const float* W, int K, int N, int NP, bf16* WT, int row_off, LAS float* scr, int item, int lane) {
    const int nblk = NP / 32, kb = item / nblk, nb = item % nblk, k0 = 64 * kb, n0 = 32 * nb;
    const int nsrc = n0 + (lane & 31);
#pragma unroll 8
    for (int i = 0; i < 32; ++i) { const int kk = 2 * i + (lane >> 5); scr[kk * 33 + (lane & 31)] = (nsrc < N) ? W[(size_t)(k0 + kk) * N + nsrc] : 0.f; }
    LDS_WAIT(); asm volatile("" ::: "memory");
    const int c = lane & 7;
#pragma unroll
    for (int j = 0; j < 4; ++j) { const int n = (lane >> 3) + 8 * j; const LAS float* s = scr + (8 * c) * 33 + n;
        v4u o; o.x = pk2(s[0 * 33], s[1 * 33]); o.y = pk2(s[2 * 33], s[3 * 33]); o.z = pk2(s[4 * 33], s[5 * 33]); o.w = pk2(s[6 * 33], s[7 * 33]);
        const int nn = n0 + n; int drow;
        if (MODE == 0) drow = row_off + nn;
        else if (MODE == 3) { int tile, L;
            if (nn < 2560) { tile = nn >> 8; L = nn & 255; } else if (nn < 2624) { tile = 10; L = nn - 2560; } else if (nn < 2640) { tile = 10; L = 64 + (nn - 2624); }
            else if (nn < 4176) { tile = 11 + ((nn - 2640) >> 8); L = (nn - 2640) & 255; } else if (nn < 4240) { tile = 10; L = 128 + (nn - 4176); } else if (nn < 4304) { tile = 10; L = 192 + (nn - 4240); }
            else { tile = 17; L = nn - 4304; }
            drow = 256 * tile + 128 * ((L >> 5) & 1) + 32 * (L >> 6) + (L & 31); }
        else drow = 256 * (nn >> 7) + (nn & 127) + (MODE == 2 ? 128 : 0);
        if (MODE != 3 || nn < N) *(GAS v4u*)(WT + (size_t)drow * K + k0 + 8 * c) = o; }
    LDS_WAIT(); asm volatile("" ::: "memory");
}
__device__ __forceinline__ void p0_weights(const Ctx& C) {
    LAS float* scr = (LAS float*)(C.lds + C.wave * 16384);
    constexpr int I_IN = (D / 64) * 139, I_OUT = (D / 64) * (D / 32), I_G = (D / 64) * (FFN / 32), I_DN = (FFN / 64) * (D / 32);
    constexpr int I_L = RW_W / 32, NITEMS = I_IN + I_OUT + 2 * I_G + I_DN + 4 * I_L;
    bf16* WIN = (bf16*)(C.ws + WS_WIN); bf16* WOUT = (bf16*)(C.ws + WS_WOUT); bf16* WGU = (bf16*)(C.ws + WS_WGU); bf16* WDN = (bf16*)(C.ws + WS_WDN);
    for (int it = C.gw; it < NITEMS; it += C.ngw) {
        int r = it;
        if (r < I_IN) { transpose_item<3>(C.in[14], D, IN_COLS, 139 * 32, WIN, 0, scr, r, C.lane); continue; } r -= I_IN;
        if (r < I_OUT) { transpose_item(C.in[28], D, D, D, WOUT, 0, scr, r, C.lane); continue; } r -= I_OUT;
        if (r < I_G) { transpose_item<1>(C.in[29], D, FFN, FFN, WGU, 0, scr, r, C.lane); continue; } r -= I_G;
        if (r < I_G) { transpose_item<2>(C.in[30], D, FFN, FFN, WGU, 0, scr, r, C.lane); continue; } r -= I_G;
        if (r < I_DN) { transpose_item(C.in[31], FFN, D, D, WDN, 0, scr, r, C.lane); continue; } r -= I_DN;
        if (r < I_L) { transpose_item(C.in[19], 64, RW_W, RW_W, (bf16*)(C.ws + WS_W2T), 0, scr, r, C.lane); continue; } r -= I_L;
        if (r < I_L) { transpose_item(C.in[21], 64, RW_W, RW_W, (bf16*)(C.ws + WS_A2T), 0, scr, r, C.lane); continue; } r -= I_L;
        transpose_item(C.in[22], 128, RW_W, RW_W, (bf16*)(C.ws + WS_G2T), 0, scr, r, C.lane);
    }
    for (int i = C.gw; i < 176; i += C.ngw) { const int L = i < 48 ? 80 + i : 128 + (i - 48), tile = i < 48 ? 10 : 17;
        GAS v4u* rowp = (GAS v4u*)(WIN + (size_t)(256 * tile + 128 * ((L >> 5) & 1) + 32 * (L >> 6) + (L & 31)) * D);
        rowp[C.lane] = (v4u){0u, 0u, 0u, 0u}; rowp[64 + C.lane] = (v4u){0u, 0u, 0u, 0u}; }
}
__device__ __forceinline__ void norm_mod_row(const Ctx& C, int m, const float* xr, const float* g, const float* shift, const float* scale, bf16* orow) {
    const GAS f32x4* xp = (const GAS f32x4*)xr + C.lane;
    f32x4 v[4]; float s = 0.f;
#pragma unroll
    for (int j = 0; j < 4; ++j) { v[j] = xp[64 * j]; s += (v[j].x * v[j].x + v[j].y * v[j].y) + (v[j].z * v[j].z + v[j].w * v[j].w); }
    const float rstd = 1.f / sqrtf(wave_sum(s) * (1.f / D) + RMS_EPS);
    GAS unsigned long long* o8 = (GAS unsigned long long*)orow + C.lane;
#pragma unroll
    for (int j = 0; j < 4; ++j) { const int c = 4 * (C.lane + 64 * j);
        const f32x4 gg = *(const f32x4*)(g + c), sh = *(const f32x4*)(shift + c), sc = *(const f32x4*)(scale + c);
        const f32x4 h = v[j] * rstd * gg * (1.f + sc) + sh;
        o8[64 * j] = (unsigned long long)pk2(h.x, h.y) | ((unsigned long long)pk2(h.z, h.w) << 32); }
}
__device__ __forceinline__ void p1_norm1(const Ctx& C) {
    bf16* A1 = (bf16*)(C.ws + WS_A1); const float* MOD = (const float*)(C.ws + WS_MOD);
    for (int m = C.gw; m < MPAD; m += C.ngw) {
        bf16* orow = A1 + (size_t)m * D;
        if (m >= MT) { GAS unsigned long long* o8 = (GAS unsigned long long*)orow + C.lane;
#pragma unroll
            for (int j = 0; j < 4; ++j) o8[64 * j] = 0ull;
            continue; }
        const float* md = MOD + mod_row(m) * MODW;
        norm_mod_row(C, m, x_row(C, m), C.in[10], md, md + D, orow);
    }
}
__device__ __forceinline__ void p3_post(const Ctx& C) {
    const float* PROJ = (const float*)(C.ws + WS_PROJ); float* QN = (float*)(C.ws + WS_QN);
    const int lane = C.lane;
    const float qg = C.in[15][lane], kg = C.in[16][lane];
    for (int m = C.gw; m < MT; m += C.ngw) {
        const float* p = PROJ + (size_t)m * NIN;
        const bool smp = m >= MP; const int j = m - MP;
        float* ko = C.out + (smp ? OUT_KS + (size_t)j * ATT_W : OUT_KP + (size_t)m * ATT_W);
        float* vo = C.out + (smp ? OUT_VS + (size_t)j * ATT_W : OUT_VP + (size_t)m * ATT_W);
        float* io = C.out + (smp ? OUT_IKS + (size_t)j * IDD : OUT_IKP + (size_t)m * IDD);
        float* qn = QN + (size_t)m * ATT_W;
        bf16* qb = (bf16*)(C.ws + WS_QB) + (size_t)m * ATT_W; bf16* kb = (bf16*)(C.ws + WS_KB) + (size_t)m * ATT_W; bf16* vb = (bf16*)(C.ws + WS_VB) + (size_t)m * ATT_W;
        for (int h = 0; h < AH; ++h) {
            const float q = p[O_Q + h * 64 + lane], k = p[O_K + h * 64 + lane];
            const float sq = wave_sum(q * q), sk = wave_sum(k * k);
            const float qv = q * (1.f / sqrtf(sq * (1.f / 64.f) + RMS_EPS)) * qg, kv = k * (1.f / sqrtf(sk * (1.f / 64.f) + RMS_EPS)) * kg, vv = p[O_V + h * 64 + lane];
            qn[h * 64 + lane] = qv; ko[h * 64 + lane] = kv; vo[h * 64 + lane] = vv;
            qb[h * 64 + lane] = (bf16)f2bf(qv * attn_body::C2); kb[h * 64 + lane] = (bf16)f2bf(kv); vb[h * 64 + lane] = (bf16)f2bf(vv);
        }
        const float ki = p[O_KI + lane];
        const float kin = ki * (1.f / sqrtf(wave_sum(ki * ki) * (1.f / 64.f) + RMS_EPS));
        io[lane] = kin;
        ((bf16*)(C.ws + WS_KIB))[(size_t)m * IDD + lane] = (bf16)f2bf(kin);
        { bf16* qi = (bf16*)(C.ws + WS_QIB) + (size_t)m * QI_LD; float ql = 0.f;
          for (int h = 0; h < IH; ++h) { const float v = p[O_QI + h * 64 + lane]; qi[h * 64 + lane] = (bf16)f2bf(v); ql += p[O_WI + h] * v; }
          qi[IH * 64 + lane] = (bf16)f2bf(ql);
          if (lane < IH) ((float*)(C.ws + WS_WI))[(size_t)m * IH + lane] = p[O_WI + lane]; }
        if (smp || (m & (T - 1)) == T - 1) {
            float* so = C.out + (smp ? OUT_SHS + (size_t)j * RW_COLS : OUT_SHP + (size_t)(m >> 11) * RW_COLS);
            for (int i = 0; i < RW_COLS / 64; ++i) so[i * 64 + lane] = p[O_RW + i * 64 + lane];
        }
    }
}
template <bool OLD_ALL> __device__ __forceinline__ void p3_rwprep(const Ctx& C) {
    const float* PRW = (const float*)(C.ws + WS_PRW);
    float* Rr = (float*)(C.ws + WS_RWA), *Wd = (float*)(C.ws + WS_RWA + RWA_STRIDE), *Kp = (float*)(C.ws + WS_RWA + 2 * RWA_STRIDE), *Vv = (float*)(C.ws + WS_RWA + 3 * RWA_STRIDE),
          *KK = (float*)(C.ws + WS_RWA + 4 * RWA_STRIDE), *Bb = (float*)(C.ws + WS_RWA + 5 * RWA_STRIDE), *Gg = (float*)(C.ws + WS_RWA + 6 * RWA_STRIDE);
    const float* mu = C.in[17]; const float* w0 = C.in[18]; const float* w2 = C.in[19]; const float* a0 = C.in[20]; const float* a2 = C.in[21]; const float* g2 = C.in[22];
    const float* k_k = C.in[23]; const float* k_a = C.in[24];
    LAS float* lw = (LAS float*)(C.lds + C.wave * 1024);
    const int lane = C.lane;
    for (int m = C.gw; m < MT; m += C.ngw) {
        const float* p = PRW + (size_t)m * RW_COLS;
        const bool smp = m >= MP; const int j = m - MP; const int t = m & (T - 1);
        const float* pv = smp ? C.in[6] + (size_t)j * RW_COLS : (t == 0 ? nullptr : p - RW_COLS);
        if (smp || t == T - 1) { float* so = C.out + (smp ? OUT_SHS + (size_t)j * RW_COLS : OUT_SHP + (size_t)(m >> 11) * RW_COLS);
            for (int i = 0; i < RW_COLS / 64; ++i) so[i * 64 + lane] = p[i * 64 + lane]; }
#define XM(c) ({ const int c_ = (c); const float cur_ = p[c_]; const float prv_ = pv ? pv[c_] : 0.f; cur_ + (prv_ - cur_) * mu[c_]; })
        const float l0 = tanhf(XM(1536 + lane)), l1 = XM(1600 + lane), l2 = sigmoidf_(XM(1664 + lane)), l3 = sigmoidf_(XM(1728 + lane));
        if (!smp) {
            bf16* lin = (bf16*)(C.ws + WS_LIN) + (size_t)m * 256;
            lin[lane] = (bf16)f2bf(l0); lin[64 + lane] = (bf16)f2bf(l1); lin[128 + lane] = (bf16)f2bf(l2); lin[192 + lane] = (bf16)f2bf(l3);
            if (!OLD_ALL) continue;
        }
        lw[lane] = l0; lw[64 + lane] = l1; lw[128 + lane] = l2; lw[192 + lane] = l3;
        LDS_WAIT(); asm volatile("" ::: "memory");
        for (int h = 0; h < RH; ++h) {
            const int c = h * 64 + lane;
            float aw = w0[c], aa = a0[c], ag = 0.f;
            for (int jj = 0; jj < 64; ++jj) { aw += lw[jj] * w2[jj * RW_W + c]; aa += lw[64 + jj] * a2[jj * RW_W + c]; }
            for (int jj = 0; jj < 128; ++jj) ag += lw[128 + jj] * g2[jj * RW_W + c];
            const float decay = expf(-0.6065306597126334f * sigmoidf_(aw));
            const float a = sigmoidf_(aa);
            const float r = XM(c), k = XM(512 + c), v = XM(1024 + c);
            float kk = k * k_k[c]; const float nrm = wave_sum(kk * kk); kk *= 1.f / sqrtf(fmaxf(nrm, 1e-24f));
            const float kp = k * (1.f + (a - 1.f) * k_a[c]);
            const size_t o = (size_t)m * RW_W + c;
            Rr[o] = r; Wd[o] = decay; Kp[o] = kp; Vv[o] = v; KK[o] = kk; Bb[o] = kk * a; Gg[o] = ag;
        }
#undef XM
        LDS_WAIT(); asm volatile("" ::: "memory");
    }
}
namespace idxsel {
typedef short bf16x8 __attribute__((ext_vector_type(8)));
typedef float f32x16 __attribute__((ext_vector_type(16)));
constexpr int QT_BYTES = 17 * 32 * 128, WT_OFF = QT_BYTES, CNT_OFF = WT_OFF + 32 * 17 * 4;
__device__ __forceinline__ int crow(int r, int hi) { return (r & 3) + 8 * (r >> 2) + 4 * hi; }
__device__ __forceinline__ void unit(const Ctx& C, int b, int qg) {
    const int lane = C.lane, r32 = lane & 31, hi = lane >> 5, wave = C.wave;
    LAS unsigned char* lds = C.lds;
    const bf16* QIb = (const bf16*)(C.ws + WS_QIB); const bf16* KIb = (const bf16*)(C.ws + WS_KIB); const float* WIr = (const float*)(C.ws + WS_WI);
    unsigned long long* MASKT = (unsigned long long*)(C.ws + WS_MASKT);
    LAS float* WT = (LAS float*)(lds + WT_OFF); LAS int* CNT = (LAS int*)(lds + CNT_OFF);
    const size_t row0 = (size_t)b * T + 32 * qg;
    __syncthreads();
    for (int i = C.tid; i < 32 * 128; i += NTHREADS) { const int q = i >> 7, hc = i & 127, h = hc >> 3, c = hc & 7;
        const v4u v = *(const v4u*)(QIb + (row0 + q) * QI_LD + hc * 8);
        *(LAS v4u*)(lds + ((h * 32 + q) * 8 + (c ^ (q & 7))) * 16) = v; }
    { const int q = C.tid >> 4, h = C.tid & 15; WT[q * 17 + h] = WIr[(row0 + q) * IH + h]; }
    __syncthreads();
    if (C.tid < 256) {
        const int q = C.tid >> 3, c = C.tid & 7; float a8[8];
#pragma unroll
        for (int e = 0; e < 8; ++e) a8[e] = 0.f;
        for (int h = 0; h < 16; ++h) { const v4u v = *(const LAS v4u*)(lds + ((h * 32 + q) * 8 + (c ^ (q & 7))) * 16); const float w = WT[q * 17 + h];
            a8[0] += w * __builtin_bit_cast(float, v.x << 16); a8[1] += w * __builtin_bit_cast(float, v.x & 0xffff0000u); a8[2] += w * __builtin_bit_cast(float, v.y << 16); a8[3] += w * __builtin_bit_cast(float, v.y & 0xffff0000u);
            a8[4] += w * __builtin_bit_cast(float, v.z << 16); a8[5] += w * __builtin_bit_cast(float, v.z & 0xffff0000u); a8[6] += w * __builtin_bit_cast(float, v.w << 16); a8[7] += w * __builtin_bit_cast(float, v.w & 0xffff0000u); }
        v4u o; o.x = pk2(a8[0], a8[1]); o.y = pk2(a8[2], a8[3]); o.z = pk2(a8[4], a8[5]); o.w = pk2(a8[6], a8[7]);
        *(LAS v4u*)(lds + ((16 * 32 + q) * 8 + (c ^ (q & 7))) * 16) = o; }
    __syncthreads();
    f32x16 sc[8];
#pragma unroll
    for (int j = 0; j < 8; ++j) sc[j] = f32x16{};
#pragma unroll
    for (int j = 0; j < 8; ++j) {
        const int kt0 = wave + 8 * j;
        asm volatile("" ::: "memory");
        if (kt0 <= qg) {
            bf16x8 ka[4];
            const bf16* kp0 = KIb + ((size_t)b * T + kt0 * 32 + r32) * IDD + 8 * hi;
#pragma unroll
            for (int s4 = 0; s4 < 4; ++s4) ka[s4] = *(const bf16x8*)(kp0 + 16 * s4);
            bf16x8 qf[4];
#pragma unroll
            for (int s4 = 0; s4 < 4; ++s4) qf[s4] = *(const LAS bf16x8*)(lds + ((0 * 32 + r32) * 8 + ((2 * s4 + hi) ^ (r32 & 7))) * 16);
#pragma unroll 1
            for (int h = 0; h < 17; ++h) {
                bf16x8 qn[4];
                const int hn = h < 16 ? h + 1 : 16;
#pragma unroll
                for (int s4 = 0; s4 < 4; ++s4) qn[s4] = *(const LAS bf16x8*)(lds + ((hn * 32 + r32) * 8 + ((2 * s4 + hi) ^ (r32 & 7))) * 16);
                const float w = WT[r32 * 17 + h];
                f32x16 xa = f32x16{};
#pragma unroll
                for (int s4 = 0; s4 < 4; ++s4) xa = __builtin_amdgcn_mfma_f32_32x32x16_bf16(ka[s4], qf[s4], xa, 0, 0, 0);
                if (h < 16) {
#pragma unroll
                    for (int r = 0; r < 16; ++r) sc[j][r] = __builtin_fmaf(__builtin_fabsf(xa[r]), w, sc[j][r]); }
                else {
#pragma unroll
                    for (int r = 0; r < 16; ++r) sc[j][r] += xa[r]; }
#pragma unroll
                for (int s4 = 0; s4 < 4; ++s4) qf[s4] = qn[s4];
            }
        }
    }
    unsigned key[8][16];
#pragma unroll
    for (int j = 0; j < 8; ++j) { const int kt = wave + 8 * j;
#pragma unroll
        for (int r = 0; r < 16; ++r) { const bool valid = (kt < qg) || (kt == qg && crow(r, hi) <= r32); key[j][r] = valid ? sortable(sc[j][r]) : 0u; } }
    unsigned Tk = 1u;
    if (qg >= 8) {
        Tk = 0u; int buf = 0;
        for (int bit = 31; bit >= 0; --bit) {
            const unsigned cand = Tk | (1u << bit); int c = 0;
#pragma unroll
            for (int j = 0; j < 8; ++j) if (wave + 8 * j <= qg) {
#pragma unroll
                for (int r = 0; r < 16; ++r) c += (key[j][r] >= cand) ? 1 : 0; }
            c += __shfl_xor(c, 32);
            if (hi == 0) CNT[(buf * 8 + wave) * 32 + r32] = c;
            __syncthreads();
            int tot = 0;
#pragma unroll
            for (int w = 0; w < 8; ++w) tot += CNT[(buf * 8 + w) * 32 + r32];
            if (tot >= TOPK) Tk = cand;
            buf ^= 1;
        }
    }
#pragma unroll
    for (int j = 0; j < 8; ++j) { const int kt = wave + 8 * j; unsigned long long mine = 0ull;
#pragma unroll
        for (int r = 0; r < 16; ++r) { const unsigned long long W = __ballot(key[j][r] >= Tk); if (lane == r) mine = W; }
        if (lane < 16) MASKT[(((size_t)(b * 64 + qg) * 32 + (kt >> 1)) * 32) + (kt & 1) * 16 + lane] = mine; }
}
__device__ __forceinline__ void phase(const Ctx& C) {
    const int v = (int)((blockIdx.x % 8) * (C.G / 8) + blockIdx.x / 8);
    for (int vv = v; vv < NB * 32; vv += C.G) { const int b = vv >> 5, i = vv & 31; unit(C, b, 63 - i); unit(C, b, i); }
    __syncthreads();
}
}
__device__ __forceinline__ float idx_score(const float (&kr)[64], const LAS float* ql, const LAS float* wl) {
    float score = 0.f;
    for (int h = 0; h < IH; ++h) {
        float d = 0.f;
#pragma unroll
        for (int dd = 0; dd < 64; dd += 4) { const f32x4 qv = *(const LAS f32x4*)(ql + h * 64 + dd); d += qv.x * kr[dd] + qv.y * kr[dd + 1] + qv.z * kr[dd + 2] + qv.w * kr[dd + 3]; }
        score += wl[h] * fmaxf(d, 0.f);
    }
    return score;
}
template <bool PROMPT, bool SAMPLE> __device__ __forceinline__ void p4_indexer(const Ctx& C) {
    const float* PROJ = (const float*)(C.ws + WS_PROJ); float* SC = (float*)(C.ws + WS_SC); float* SCS = (float*)(C.ws + WS_SCS);
    LAS float* ql = (LAS float*)C.lds;
    LAS float* wl = ql + 16 * 1024;
    const int lane = C.lane;
    if (PROMPT) for (int u = blockIdx.x; u < NB * 128 * 4; u += C.G) {
        const int b = u >> 9, tq = (u >> 2) & 127, scn = u & 3, t0 = tq * 16;
        if (scn * 512 > t0 + 15) continue;
        __syncthreads();
        for (int i = C.tid; i < 16 * 1024; i += NTHREADS) { const int q = i >> 10, e = i & 1023; ql[i] = PROJ[(size_t)(b * T + t0 + q) * NIN + O_QI + e]; }
        if (C.tid < 256) { const int q = C.tid >> 4, h = C.tid & 15; wl[C.tid] = PROJ[(size_t)(b * T + t0 + q) * NIN + O_WI + h] * IDX_W_SCALE; }
        __syncthreads();
        const int s = scn * 512 + C.wave * 64 + lane;
        if (scn * 512 + C.wave * 64 <= t0 + 15) {
            float kr[64];
            const f32x4* kp = (const f32x4*)(C.out + OUT_IKP + (size_t)(b * T + s) * IDD);
#pragma unroll
            for (int i = 0; i < 16; ++i) { const f32x4 v = kp[i]; kr[4 * i] = v.x; kr[4 * i + 1] = v.y; kr[4 * i + 2] = v.z; kr[4 * i + 3] = v.w; }
            for (int q = 0; q < 16; ++q) {
                const float score = idx_score(kr, ql + q * 1024, wl + q * 16);
                const int t = t0 + q;
                if (s <= t) SC[((size_t)b * T + t) * T + s] = score;
            }
        }
    }
    __syncthreads();
    const int* pt = (const int*)C.in[7];
    LAS float* qw = (LAS float*)(C.lds + C.wave * 8192); LAS float* ww = qw + 1024;
    if (SAMPLE) for (int wu = C.gw; wu < NSMP * 129; wu += C.ngw) {
        const int j = wu / 129, kb = wu % 129;
        const bf16* pq = (const bf16*)(C.ws + WS_QIB) + (size_t)(MP + j) * QI_LD;
        for (int i = 0; i < 16; ++i) qw[i * 64 + lane] = __builtin_bit_cast(float, (unsigned)pq[i * 64 + lane] << 16);
        if (lane < 16) ww[lane] = ((const float*)(C.ws + WS_WI))[(size_t)(MP + j) * IH + lane] * IDX_W_SCALE;
        LDS_WAIT(); asm volatile("" ::: "memory");
        const int s = kb * 64 + lane;
        const float* krow = nullptr;
        if (s < PAST) krow = C.in[4] + ((size_t)pt[j * NPAGES + (s >> 7)] * PAGE + (s & 127)) * IDD;
        else if (s == PAST) krow = C.out + OUT_IKS + (size_t)j * IDD;
        float score = -INFINITY;
        if (krow) { float kr[64]; const f32x4* kp = (const f32x4*)krow;
#pragma unroll
            for (int i = 0; i < 16; ++i) { const f32x4 v = kp[i]; kr[4 * i] = v.x; kr[4 * i + 1] = v.y; kr[4 * i + 2] = v.z; kr[4 * i + 3] = v.w; }
            score = idx_score(kr, qw, ww); }
        SCS[(size_t)j * SCS_LD + s] = score;
        LDS_WAIT(); asm volatile("" ::: "memory");
    }
}
template <bool PROBE> __device__ __forceinline__ void p4_scan(const Ctx& C, int u_begin) {
    const float* Rr = (const float*)(C.ws + WS_RWA), *Wd = (const float*)(C.ws + WS_RWA + RWA_STRIDE), *Kp = (const float*)(C.ws + WS_RWA + 2 * RWA_STRIDE), *Vv = (const float*)(C.ws + WS_RWA + 3 * RWA_STRIDE),
          *KK = (const float*)(C.ws + WS_RWA + 4 * RWA_STRIDE), *Bb = (const float*)(C.ws + WS_RWA + 5 * RWA_STRIDE);
    float* Y = (float*)(C.ws + (PROBE ? WS_Y2 : WS_Y));
    const int lane = C.lane;
    for (int u = u_begin + C.gw; u < (PROBE ? NB * RH : NB * RH + NSMP * RH); u += C.ngw) {
        const bool smp = u >= NB * RH; const int seq = smp ? (u - NB * RH) / RH : u / RH, h = u % RH;
        const int nsteps = smp ? 1 : T; const size_t base = smp ? (size_t)(MP + seq) : (size_t)seq * T;
        float S[64];
        if (smp) { const f32x4* sp = (const f32x4*)(C.in[5] + (((size_t)seq * RH + h) * RN + lane) * RN);
#pragma unroll
            for (int i = 0; i < 16; ++i) { const f32x4 v = sp[i]; S[4 * i] = v.x; S[4 * i + 1] = v.y; S[4 * i + 2] = v.z; S[4 * i + 3] = v.w; } }
        else {
#pragma unroll
            for (int i = 0; i < 64; ++i) S[i] = 0.f; }
        size_t o = base * RW_W + h * 64 + lane;
        float r = Rr[o], w = Wd[o], k = Kp[o], v = Vv[o], kk = KK[o], bb = Bb[o];
        for (int t = 0; t < nsteps; ++t) {
            float rn = 0.f, wn = 0.f, kn = 0.f, vn = 0.f, kkn = 0.f, bbn = 0.f;
            const size_t on = o + RW_W;
            if (t + 1 < nsteps) { rn = Rr[on]; wn = Wd[on]; kn = Kp[on]; vn = Vv[on]; kkn = KK[on]; bbn = Bb[on]; }
            float sa0 = 0.f, sa1 = 0.f;
#pragma unroll
            for (int jx = 0; jx < 64; jx += 2) { sa0 += S[jx] * rdlane(kk, jx); sa1 += S[jx + 1] * rdlane(kk, jx + 1); }
            const float sa = -(sa0 + sa1);
            float y0 = 0.f, y1 = 0.f;
#pragma unroll
            for (int jx = 0; jx < 64; jx += 2) {
                S[jx] = S[jx] * rdlane(w, jx) + sa * rdlane(bb, jx) + v * rdlane(k, jx); y0 += S[jx] * rdlane(r, jx);
                S[jx + 1] = S[jx + 1] * rdlane(w, jx + 1) + sa * rdlane(bb, jx + 1) + v * rdlane(k, jx + 1); y1 += S[jx + 1] * rdlane(r, jx + 1); }
            Y[o] = y0 + y1;
            o = on; r = rn; w = wn; k = kn; v = vn; kk = kkn; bb = bbn;
        }
        f32x4* so = (f32x4*)(C.out + (smp ? OUT_WKVS : OUT_WKVP) + (((size_t)seq * RH + h) * RN + lane) * RN);
        if (!PROBE)
#pragma unroll
        for (int i = 0; i < 16; ++i) so[i] = (f32x4){S[4 * i], S[4 * i + 1], S[4 * i + 2], S[4 * i + 3]};
    }
}
template <bool PROMPT, bool SAMPLE> __device__ __forceinline__ void p5_select(const Ctx& C) {
    const float* SC = (const float*)(C.ws + WS_SC); unsigned* MASK = (unsigned*)(C.ws + WS_MASK);
    const int lane = C.lane;
    if (PROMPT) for (int row = C.gw; row < MP; row += C.ngw) {
        const int t = row & (T - 1); const float* sp = SC + (size_t)row * T;
        unsigned key[32];
#pragma unroll
        for (int j = 0; j < 32; ++j) { const int s = 64 * j + lane; key[j] = (s <= t) ? sortable(sp[s]) : 0u; }
        unsigned Tk = 0u; int need = 0;
        const bool all = (t + 1 <= TOPK);
        if (!all) {
            for (int bit = 31; bit >= 0; --bit) { const unsigned cand = Tk | (1u << bit); int cnt = 0;
#pragma unroll
                for (int j = 0; j < 32; ++j) cnt += __builtin_popcountll(__ballot(key[j] >= cand));
                if (cnt >= TOPK) Tk = cand; }
            int cgt = 0;
#pragma unroll
            for (int j = 0; j < 32; ++j) cgt += __builtin_popcountll(__ballot(key[j] > Tk));
            need = TOPK - cgt;
        }
        int running = 0;
#pragma unroll
        for (int j = 0; j < 32; ++j) {
            const int s = 64 * j + lane; bool take;
            if (all) take = (s <= t);
            else { const bool gt = key[j] > Tk, eq = key[j] == Tk; const unsigned long long eqb = __ballot(eq);
                const int pre = __builtin_popcountll(eqb & lanemask_lt(lane)); take = gt || (eq && (running + pre < need)); running += __builtin_popcountll(eqb); }
            const unsigned long long mb = __ballot(take);
            if (lane == 0) { MASK[(size_t)row * 64 + 2 * j] = (unsigned)mb; MASK[(size_t)row * 64 + 2 * j + 1] = (unsigned)(mb >> 32); }
        }
    }
    const float* SCS = (const float*)(C.ws + WS_SCS); int* SLIST = (int*)(C.ws + WS_SLIST);
    LAS int* sh = (LAS int*)C.lds;
    if (SAMPLE) for (int j = blockIdx.x; j < NSMP; j += C.G) {
        unsigned key[17];
#pragma unroll
        for (int i = 0; i < 17; ++i) { const int s = i * NTHREADS + C.tid; key[i] = (s < LS) ? sortable(SCS[(size_t)j * SCS_LD + s]) : 0u; }
        unsigned Tk = 0u;
        for (int bit = 31; bit >= 0; --bit) { const unsigned cand = Tk | (1u << bit); int c = 0;
#pragma unroll
            for (int i = 0; i < 17; ++i) c += (key[i] >= cand) ? 1 : 0;
            c = wave_sum_i(c);
            __syncthreads(); if (lane == 0) sh[C.wave] = c; __syncthreads();
            int cnt = 0;
#pragma unroll
            for (int w = 0; w < 8; ++w) cnt += sh[w];
            if (cnt >= TOPK) Tk = cand; }
        int cg = 0;
#pragma unroll
        for (int i = 0; i < 17; ++i) cg += (key[i] > Tk) ? 1 : 0;
        cg = wave_sum_i(cg);
        __syncthreads(); if (lane == 0) sh[C.wave] = cg; __syncthreads();
        int cgt = 0;
#pragma unroll
        for (int w = 0; w < 8; ++w) cgt += sh[w];
        const int need = TOPK - cgt;
        int run_eq = 0, run_sel = 0;
#pragma unroll
        for (int i = 0; i < 17; ++i) {
            const int s = i * NTHREADS + C.tid; const bool gt = key[i] > Tk, eq = key[i] == Tk;
            const unsigned long long eqb = __ballot(eq);
            __syncthreads(); if (lane == 0) sh[C.wave] = __builtin_popcountll(eqb); __syncthreads();
            int eq_before = 0, eq_tot = 0;
#pragma unroll
            for (int w = 0; w < 8; ++w) { const int x = sh[w]; eq_tot += x; if (w < C.wave) eq_before += x; }
            const bool take = gt || (eq && (run_eq + eq_before + __builtin_popcountll(eqb & lanemask_lt(lane)) < need));
            const unsigned long long tb = __ballot(take);
            __syncthreads(); if (lane == 0) sh[8 + C.wave] = __builtin_popcountll(tb); __syncthreads();
            int s_before = 0, s_tot = 0;
#pragma unroll
            for (int w = 0; w < 8; ++w) { const int x = sh[8 + w]; s_tot += x; if (w < C.wave) s_before += x; }
            const int pos = run_sel + s_before + __builtin_popcountll(tb & lanemask_lt(lane));
            if (take && pos < TOPK) SLIST[j * TOPK + pos] = s;
            run_eq += eq_tot; run_sel += s_tot;
        }
    }
    __syncthreads();
}
template <int DIFFK> __device__ __forceinline__ void p5_rwfinal(const Ctx& C, int m_begin) {
    const float* Rr = (const float*)(C.ws + WS_RWA), *Kp = (const float*)(C.ws + WS_RWA + 2 * RWA_STRIDE), *Vv = (const float*)(C.ws + WS_RWA + 3 * RWA_STRIDE), *Gg = (const float*)(C.ws + WS_RWA + 6 * RWA_STRIDE);
    const float* Y = (const float*)(C.ws + WS_Y); bf16* MIX = (bf16*)(C.ws + WS_MIX);
    const float* r_k = C.in[25]; const float* ln_w = C.in[26]; const float* ln_b = C.in[27];
    const int lane = C.lane;
    for (int m = m_begin + C.gw; m < MT; m += C.ngw) {
        for (int h = 0; h < RH; ++h) {
            const int c = h * 64 + lane; const size_t o = (size_t)m * RW_W + c;
            float y = Y[o];
            if (DIFFK != 0 && m < MP) y += (float)DIFFK * (y - ((const float*)(C.ws + WS_Y2))[o]);
            const float mu = wave_sum(y) * (1.f / 64.f); const float dy = y - mu; const float var = wave_sum(dy * dy) * (1.f / 64.f);
            const float yn = dy * (1.f / sqrtf(var + GN_EPS)) * ln_w[c] + ln_b[c];
            const float bonus = wave_sum(Rr[o] * Kp[o] * r_k[c]) * Vv[o];
            MIX[(size_t)m * D + ATT_W + c] = (bf16)f2bf((yn + bonus) * Gg[o]);
        }
    }
}
__device__ __forceinline__ void p6_masktr(const Ctx& C) {
    const unsigned* MASK = (const unsigned*)(C.ws + WS_MASK); unsigned long long* MASKT = (unsigned long long*)(C.ws + WS_MASKT);
    const int lane = C.lane, q = lane & 31, hi = lane >> 5;
    for (int wu = C.gw; wu < NB * 64 * 32; wu += C.ngw) {
        const int j = wu & 31, qg = (wu >> 5) & 63, b = wu >> 11;
        const size_t row = (size_t)b * T + 32 * qg + q;
        const unsigned w0 = MASK[row * 64 + 2 * j], w1 = MASK[row * 64 + 2 * j + 1];
        unsigned long long mine = 0ull;
#pragma unroll
        for (int r = 0; r < 16; ++r) { const int c = (r & 3) + 8 * (r >> 2) + 4 * hi;
            const unsigned long long W0 = __ballot((w0 >> c) & 1u), W1 = __ballot((w1 >> c) & 1u);
            if (lane == r) mine = W0; if (lane == 16 + r) mine = W1; }
        if (lane < 32) MASKT[((size_t)((b * 64 + qg) * 32 + j)) * 32 + lane] = mine;
    }
}
__device__ __forceinline__ void smp_attn(const Ctx& C) {
    const int* SLIST = (const int*)(C.ws + WS_SLIST); const float* QN = (const float*)(C.ws + WS_QN); bf16* MIX = (bf16*)(C.ws + WS_MIX); const int* pt = (const int*)C.in[7];
    LAS int* prow = (LAS int*)C.lds;
    LAS float* pb = (LAS float*)(C.lds + 1024);
    const int lane = C.lane, h = C.wave;
    for (int j = blockIdx.x; j < NSMP; j += C.G) {
        __syncthreads();
        if (C.tid < TOPK) { const int s = SLIST[j * TOPK + C.tid]; prow[C.tid] = (s < PAST) ? pt[j * NPAGES + (s >> 7)] * PAGE + (s & 127) : -1; }
        __syncthreads();
        const float* kn = C.out + OUT_KS + (size_t)j * ATT_W + h * 64; const float* vn = C.out + OUT_VS + (size_t)j * ATT_W + h * 64;
        float q[64];
        { const f32x4* qp = (const f32x4*)(QN + (size_t)(MP + j) * ATT_W + h * 64);
#pragma unroll
          for (int i = 0; i < 16; ++i) { const f32x4 v = qp[i]; q[4 * i] = v.x; q[4 * i + 1] = v.y; q[4 * i + 2] = v.z; q[4 * i + 3] = v.w; } }
        float sc[4]; float mx = -INFINITY;
#pragma unroll
        for (int i = 0; i < 4; ++i) { const int pr = prow[i * 64 + lane]; const float* kp = pr >= 0 ? C.in[2] + (size_t)pr * ATT_W + h * 64 : kn;
            float d = 0.f;
#pragma unroll
            for (int e = 0; e < 16; ++e) { const f32x4 kv = ((const f32x4*)kp)[e]; d += q[4 * e] * kv.x + q[4 * e + 1] * kv.y + q[4 * e + 2] * kv.z + q[4 * e + 3] * kv.w; }
            sc[i] = d * 0.125f; mx = fmaxf(mx, sc[i]); }
        mx = wave_max(mx); float l = 0.f;
#pragma unroll
        for (int i = 0; i < 4; ++i) { const float p = expf(sc[i] - mx); pb[h * 256 + i * 64 + lane] = p; l += p; }
        l = wave_sum(l);
        LDS_WAIT(); asm volatile("" ::: "memory");
        float o = 0.f;
        for (int kx = 0; kx < TOPK; kx += 32) { float vv[32];
#pragma unroll
            for (int e = 0; e < 32; ++e) { const int pr = prow[kx + e]; vv[e] = (pr >= 0 ? C.in[3] + (size_t)pr * ATT_W + h * 64 : vn)[lane]; }
#pragma unroll
            for (int e = 0; e < 32; ++e) o += pb[h * 256 + kx + e] * vv[e]; }
        MIX[(size_t)(MP + j) * D + h * 64 + lane] = (bf16)f2bf(o / l);
    }
    __syncthreads();
}
template <int DIFFK> __device__ __forceinline__ void p6_attn(const Ctx& C, int u_begin, int u_end) {
    const unsigned* MASK = (const unsigned*)(C.ws + WS_MASK); const int* SLIST = (const int*)(C.ws + WS_SLIST); const float* QN = (const float*)(C.ws + WS_QN);
    bf16* MIX = (bf16*)(C.ws + WS_MIX); const int* pt = (const int*)C.in[7];
    LAS int* list = (LAS int*)C.lds;
    LAS float* pb = (LAS float*)(C.lds + 1024);
    LAS int* cntp = (LAS int*)(C.lds + 1024 + 8192);
    const int lane = C.lane, h = C.wave;
    for (int u = u_begin + blockIdx.x; u < u_end; u += C.G) {
        const bool smp = u >= MP; const int j = u - MP, b = u >> 11;
        __syncthreads();
        if (C.wave == 0) {
            if (!smp) { const unsigned w = MASK[(size_t)u * 64 + lane]; const int c = __builtin_popcount(w);
                int incl = c;
#pragma unroll
                for (int o = 1; o < 64; o <<= 1) { const int x = __shfl_up(incl, o); if (lane >= o) incl += x; }
                int pos = incl - c; unsigned ww = w;
                while (ww) { const int bit = __builtin_ctz(ww); ww &= ww - 1u; list[pos++] = 32 * lane + bit; }
                if (lane == 63) *cntp = incl; }
            else { for (int i = 0; i < 4; ++i) list[i * 64 + lane] = SLIST[j * TOPK + i * 64 + lane]; if (lane == 0) *cntp = TOPK; }
        }
        __syncthreads();
        int cnt = *cntp; if (cnt > TOPK) cnt = TOPK;
        float q[64];
        { const f32x4* qp = (const f32x4*)(QN + (size_t)u * ATT_W + h * 64);
#pragma unroll
          for (int i = 0; i < 16; ++i) { const f32x4 v = qp[i]; q[4 * i] = v.x; q[4 * i + 1] = v.y; q[4 * i + 2] = v.z; q[4 * i + 3] = v.w; } }
        float sc[4]; float mx = -INFINITY;
#pragma unroll
        for (int i = 0; i < 4; ++i) { const int idx = i * 64 + lane; sc[i] = -INFINITY;
            if (idx < cnt) { const int s = list[idx]; const float* kp;
                if (!smp) kp = C.out + OUT_KP + ((size_t)(b * T + s)) * ATT_W + h * 64;
                else if (s < PAST) kp = C.in[2] + ((size_t)pt[j * NPAGES + (s >> 7)] * PAGE + (s & 127)) * ATT_W + h * 64;
                else kp = C.out + OUT_KS + (size_t)j * ATT_W + h * 64;
                float d = 0.f;
#pragma unroll
                for (int e = 0; e < 16; ++e) { const f32x4 kv = ((const f32x4*)kp)[e]; d += q[4 * e] * kv.x + q[4 * e + 1] * kv.y + q[4 * e + 2] * kv.z + q[4 * e + 3] * kv.w; }
                sc[i] = d * 0.125f; }
            mx = fmaxf(mx, sc[i]); }
        mx = wave_max(mx); float l = 0.f;
#pragma unroll
        for (int i = 0; i < 4; ++i) { const int idx = i * 64 + lane; const float p = (idx < cnt) ? expf(sc[i] - mx) : 0.f; pb[h * 256 + idx] = p; l += p; }
        l = wave_sum(l);
        LDS_WAIT(); asm volatile("" ::: "memory");
        float o = 0.f;
        for (int kx = 0; kx < cnt; ++kx) { const int s = list[kx]; const float* vp;
            if (!smp) vp = C.out + OUT_VP + ((size_t)(b * T + s)) * ATT_W + h * 64;
            else if (s < PAST) vp = C.in[3] + ((size_t)pt[j * NPAGES + (s >> 7)] * PAGE + (s & 127)) * ATT_W + h * 64;
            else vp = C.out + OUT_VS + (size_t)j * ATT_W + h * 64;
            o += pb[h * 256 + kx] * vp[lane]; }
        if (DIFFK == 0) MIX[(size_t)u * D + h * 64 + lane] = (bf16)f2bf(o / l);
        else { const float a = __builtin_bit_cast(float, (unsigned)MIX[(size_t)u * D + h * 64 + lane] << 16); MIX[(size_t)u * D + h * 64 + lane] = (bf16)f2bf(a + (float)DIFFK * (a - o / l)); }
    }
    __syncthreads();
}
__device__ __forceinline__ void p8_res_norm2(const Ctx& C) {
    const float* X1 = (const float*)(C.ws + WS_X1); bf16* A2 = (bf16*)(C.ws + WS_A2); const float* MOD = (const float*)(C.ws + WS_MOD);
    for (int m = C.gw; m < MPAD; m += C.ngw) {
        bf16* orow = A2 + (size_t)m * D;
        if (m >= MT) { GAS unsigned long long* o8 = (GAS unsigned long long*)orow + C.lane;
#pragma unroll
            for (int j = 0; j < 4; ++j) o8[64 * j] = 0ull;
            continue; }
        const float* md = MOD + mod_row(m) * MODW;
        norm_mod_row(C, m, X1 + (size_t)m * D, C.in[11], md + 3 * D, md + 4 * D, orow);
    }
}
__device__ __forceinline__ void p10_swiglu(const Ctx& C) {
    const float* RAW2 = (const float*)(C.ws + WS_RAW2); bf16* HB = (bf16*)(C.ws + WS_HB);
    const size_t total = (size_t)MPAD * (FFN / 4);
    for (size_t i = (size_t)blockIdx.x * NTHREADS + C.tid; i < total; i += (size_t)C.G * NTHREADS) {
        const size_t m = i / (FFN / 4); const int c = (int)(i % (FFN / 4)) * 4;
        const f32x4 g = *(const f32x4*)(RAW2 + m * NGU + c), u = *(const f32x4*)(RAW2 + m * NGU + FFN + c);
        const float h0 = g.x / (1.f + expf(-g.x)) * u.x, h1 = g.y / (1.f + expf(-g.y)) * u.y, h2 = g.z / (1.f + expf(-g.z)) * u.z, h3 = g.w / (1.f + expf(-g.w)) * u.w;
        *(unsigned long long*)(HB + m * FFN + c) = (unsigned long long)pk2(h0, h1) | ((unsigned long long)pk2(h2, h3) << 32);
    }
}
__device__ __forceinline__ void p12_final(const Ctx& C) {
    const float* RAW = (const float*)(C.ws + WS_RAW); const float* X1 = (const float*)(C.ws + WS_X1); const float* MOD = (const float*)(C.ws + WS_MOD);
    for (int m = C.gw; m < MT; m += C.ngw) {
        const float* md = MOD + mod_row(m) * MODW;
        float* yo = C.out + (m < MP ? OUT_Y + (size_t)m * D : OUT_YS + (size_t)(m - MP) * D);
#pragma unroll
        for (int j = 0; j < 4; ++j) { const int c = 4 * (C.lane + 64 * j);
            const f32x4 xv = *(const f32x4*)(X1 + (size_t)m * D + c), rv = *(const f32x4*)(RAW + (size_t)m * D + c), g2 = *(const f32x4*)(md + 5 * D + c);
            *(f32x4*)(yo + c) = xv + g2 * rv; }
    }
}

namespace rw {
typedef short bf16x8 __attribute__((ext_vector_type(8)));
typedef short s16x4 __attribute__((ext_vector_type(4)));
typedef float f32x16 __attribute__((ext_vector_type(16)));
typedef float f32x4v __attribute__((ext_vector_type(4)));
typedef unsigned u32x2 __attribute__((ext_vector_type(2)));
typedef unsigned u32x4v __attribute__((ext_vector_type(4)));
constexpr int NCH = T / 64;
constexpr int IMG = 16384;
constexpr int A32_OFF = 7 * IMG, WC_OFF = A32_OFF + 16384, RED_OFF = WC_OFF + 256;
enum { H_AT = 0, H_BT = 1, H_KT = 2, H_RT = 3, H_VT = 4, H_AAK = 5, H_ARB = 6, H_ARK = 7, H_XT = 8, H_TT = 9, H_QT = 10, H_PT = 11, H_N1 = 12, H_N2 = 13 };
__device__ __forceinline__ unsigned off_b(unsigned row, unsigned ch) { return 256u * row + 16u * (ch ^ (((row & 3) << 2) | ((row >> 2) & 3))); }
__device__ __forceinline__ int crow(int r, int hi) { return (r & 3) + 8 * (r >> 2) + 4 * hi; }
__device__ __forceinline__ unsigned cvt2(float lo, float hi) { typedef float f2 __attribute__((ext_vector_type(2))); typedef __bf16 b2 __attribute__((ext_vector_type(2))); f2 v = {lo, hi}; b2 b = __builtin_convertvector(v, b2); return __builtin_bit_cast(unsigned, b); }
__device__ __forceinline__ bf16x8 frag_row(LAS unsigned char* lds, int H, int blk, int s, int lane) {
    return *(const LAS bf16x8*)(lds + (H >> 1) * IMG + off_b(32 * blk + (lane & 31), 8 * (H & 1) + 2 * s + (lane >> 5)));
}
__device__ __forceinline__ bf16x8 frag_tr(LAS unsigned char* lds, int H, int blk, int ks, int lane) {
    const unsigned h = lane >> 5, b2 = (lane >> 4) & 1, q = (lane & 15) >> 2, p = lane & 3, c = 2 * (H & 1) + blk;
    typedef short v4i16_t __attribute__((ext_vector_type(4)));
    LAS unsigned char* base = lds + (H >> 1) * IMG;
    const s16x4 lo = __builtin_bit_cast(s16x4, __builtin_amdgcn_ds_read_tr16_b64_v4i16((LAS v4i16_t*)(base + off_b(16 * ks + 8 * h + q, 4 * c + 2 * b2 + (p >> 1)) + 8 * (p & 1))));
    const s16x4 hi = __builtin_bit_cast(s16x4, __builtin_amdgcn_ds_read_tr16_b64_v4i16((LAS v4i16_t*)(base + off_b(16 * ks + 8 * h + 4 + q, 4 * c + 2 * b2 + (p >> 1)) + 8 * (p & 1))));
    return (bf16x8){lo[0], lo[1], lo[2], lo[3], hi[0], hi[1], hi[2], hi[3]};
}
template <bool ATR, bool BTR> __device__ __forceinline__ f32x16 mm_tile(LAS unsigned char* lds, int HA, int ablk, int HB, int bblk, f32x16 acc, int lane) {
#pragma unroll
    for (int s = 0; s < 4; ++s) {
        const bf16x8 a = ATR ? frag_tr(lds, HA, ablk, s, lane) : frag_row(lds, HA, ablk, s, lane);
        const bf16x8 b = BTR ? frag_tr(lds, HB, bblk, s, lane) : frag_row(lds, HB, bblk, s, lane);
        acc = __builtin_amdgcn_mfma_f32_32x32x16_bf16(a, b, acc, 0, 0, 0);
    }
    return acc;
}
__device__ __forceinline__ void store_tr(LAS unsigned char* lds, int H, int rblk, int cblk, const f32x16& acc, int lane) {
    LAS unsigned char* base = lds + (H >> 1) * IMG; const int hi = lane >> 5, row = 32 * cblk + (lane & 31);
#pragma unroll
    for (int g = 0; g < 4; ++g) { u32x2 w; w.x = cvt2(acc[4 * g], acc[4 * g + 1]); w.y = cvt2(acc[4 * g + 2], acc[4 * g + 3]);
        *(LAS u32x2*)(base + off_b(row, 8 * (H & 1) + 4 * rblk + g) + 8 * hi) = w; }
}
__device__ __forceinline__ u32x4v pack8(const f32x16& a, int s) { u32x4v w; w.x = cvt2(a[8 * s], a[8 * s + 1]); w.y = cvt2(a[8 * s + 2], a[8 * s + 3]); w.z = cvt2(a[8 * s + 4], a[8 * s + 5]); w.w = cvt2(a[8 * s + 6], a[8 * s + 7]); return w; }

struct Bufs { bf16* LIN; bf16* W2T; bf16* A2T; bf16* G2T; const float* PRW; bf16* G1; bf16* G2; bf16* MIX;
              u32x4v* MF; float* NT; u32x4v* PF; float* QP; u32x4v* ZF; float* Y; };

__device__ __forceinline__ void r1_unit(const Ctx& C, const Bufs& B, int b, int h, int c) {
    LAS unsigned char* lds = C.lds; const int lane0 = C.lane, wave = C.wave;
    const size_t row0 = (size_t)b * T + 64 * c; const int ci = (b * RH + h) * NCH + c;
    LAS float* A32 = (LAS float*)(lds + A32_OFF); LAS float* WC = (LAS float*)(lds + WC_OFF);
    typedef float f32x4a __attribute__((ext_vector_type(4)));
    {
    int lane = lane0; asm volatile("" : "+v"(lane)); const int hi = lane >> 5; (void)hi;
    { const int nl = lane & 15, q = lane >> 4;
      typedef float f32x2a __attribute__((ext_vector_type(2)));
      LAS f32x2a* RED = (LAS f32x2a*)(lds + RED_OFF);
      const bool first = (c == 0);
      if (wave < 4) {
        const int n = 16 * wave + nl, col = h * 64 + n;
        f32x4a aw[4], aa[4];
#pragma unroll
        for (int tt = 0; tt < 4; ++tt) { aw[tt] = (f32x4a){0.f, 0.f, 0.f, 0.f}; aa[tt] = aw[tt]; }
#pragma unroll
        for (int s = 0; s < 2; ++s) {
            const bf16x8 bw = *(const bf16x8*)(B.W2T + (size_t)col * 64 + 32 * s + 8 * q), ba = *(const bf16x8*)(B.A2T + (size_t)col * 64 + 32 * s + 8 * q);
#pragma unroll
            for (int tt = 0; tt < 4; ++tt) { const bf16* lp = B.LIN + (row0 + 16 * tt + nl) * 256 + 32 * s + 8 * q;
                aw[tt] = __builtin_amdgcn_mfma_f32_16x16x32_bf16(*(const bf16x8*)lp, bw, aw[tt], 0, 0, 0);
                aa[tt] = __builtin_amdgcn_mfma_f32_16x16x32_bf16(*(const bf16x8*)(lp + 64), ba, aa[tt], 0, 0, 0); }
        }
        const float w0c = C.in[18][col], a0c = C.in[20][col], kac = C.in[24][col], kkc = C.in[23][col], rkc = C.in[25][col], mur = C.in[17][col], muk = C.in[17][512 + col];
        float lw[4][4], av[4][4], xr[4][4], kkr[4][4], kpv[4][4];
#pragma unroll
        for (int tt = 0; tt < 4; ++tt) {
            asm volatile("" ::: "memory");
#pragma unroll
            for (int e = 0; e < 4; ++e) { const int t = 16 * tt + 4 * q + e; const float* p = B.PRW + (row0 + t) * RW_COLS + col;
                const bool z = first && t == 0;
                const float rc = p[0], kc = p[512], rp = z ? 0.f : p[-RW_COLS], kq = z ? 0.f : p[512 - RW_COLS];
                const float r_ = rc + (rp - rc) * mur, k_ = kc + (kq - kc) * muk;
                lw[tt][e] = -0.6065306597126334f / (1.f + __expf(-(w0c + aw[tt][e]))); av[tt][e] = 1.f / (1.f + __expf(-(a0c + aa[tt][e])));
                xr[tt][e] = r_; kkr[tt][e] = k_ * kkc; kpv[tt][e] = k_ * (1.f + (av[tt][e] - 1.f) * kac);
                float p1 = kkr[tt][e] * kkr[tt][e], p2 = r_ * kpv[tt][e] * rkc;
#pragma unroll
                for (int o = 1; o < 16; o <<= 1) { p1 += __shfl_xor(p1, o); p2 += __shfl_xor(p2, o); }
                if (nl == 0) RED[wave * 64 + t] = (f32x2a){p1, p2}; }
        }
        __syncthreads();
        float tot[4], L[4][4];
#pragma unroll
        for (int tt = 0; tt < 4; ++tt) { L[tt][0] = lw[tt][0]; L[tt][1] = L[tt][0] + lw[tt][1]; L[tt][2] = L[tt][1] + lw[tt][2]; L[tt][3] = L[tt][2] + lw[tt][3]; tot[tt] = L[tt][3]; }
        float run = 0.f;
#pragma unroll
        for (int tt = 0; tt < 4; ++tt) { float basev = run;
#pragma unroll
            for (int qq = 0; qq < 4; ++qq) { const float o = __shfl(tot[tt], nl + 16 * qq); if (qq < q) basev += o; run += o; }
#pragma unroll
            for (int e = 0; e < 4; ++e) L[tt][e] += basev; }
        if (q == 3) WC[n] = __expf(L[3][3]);
#pragma unroll
        for (int tt = 0; tt < 4; ++tt) {
            float at[4], bt[4], kt[4], rt[4];
#pragma unroll
            for (int e = 0; e < 4; ++e) { const int t = 16 * tt + 4 * q + e;
                const float nrm = RED[t].x + RED[64 + t].x + RED[128 + t].x + RED[192 + t].x;
                const float kkn = kkr[tt][e] * (1.f / sqrtf(fmaxf(nrm, 1e-24f)));
                const float eL = __expf(L[tt][e]), eLm = __expf(-L[tt][e]), eLex = __expf(L[tt][e] - lw[tt][e]);
                at[e] = -kkn * eLex; bt[e] = kkn * av[tt][e] * eLm; kt[e] = kpv[tt][e] * eLm; rt[e] = xr[tt][e] * eL; }
            const unsigned ch = 2 * tt + (q >> 1), bo = 8 * (q & 1);
            u32x2 w;
            w.x = cvt2(at[0], at[1]); w.y = cvt2(at[2], at[3]); *(LAS u32x2*)(lds + 0 * IMG + off_b(n, ch) + bo) = w;
            w.x = cvt2(bt[0], bt[1]); w.y = cvt2(bt[2], bt[3]); *(LAS u32x2*)(lds + 0 * IMG + off_b(n, 8 + ch) + bo) = w;
            w.x = cvt2(kt[0], kt[1]); w.y = cvt2(kt[2], kt[3]); *(LAS u32x2*)(lds + 1 * IMG + off_b(n, ch) + bo) = w;
            w.x = cvt2(rt[0], rt[1]); w.y = cvt2(rt[2], rt[3]); *(LAS u32x2*)(lds + 1 * IMG + off_b(n, 8 + ch) + bo) = w;
        }
      } else {
        const int n = 16 * (wave - 4) + nl, col = h * 64 + n;
        f32x4a ag[4];
#pragma unroll
        for (int tt = 0; tt < 4; ++tt) ag[tt] = (f32x4a){0.f, 0.f, 0.f, 0.f};
#pragma unroll
        for (int s = 0; s < 4; ++s) { const bf16x8 bg = *(const bf16x8*)(B.G2T + (size_t)col * 128 + 32 * s + 8 * q);
#pragma unroll
            for (int tt = 0; tt < 4; ++tt) ag[tt] = __builtin_amdgcn_mfma_f32_16x16x32_bf16(*(const bf16x8*)(B.LIN + (row0 + 16 * tt + nl) * 256 + 128 + 32 * s + 8 * q), bg, ag[tt], 0, 0, 0); }
        const float muv = C.in[17][1024 + col], lnw = C.in[26][col], lnb = C.in[27][col];
        float xv[4][4];
#pragma unroll
        for (int tt = 0; tt < 4; ++tt)
#pragma unroll
            for (int e = 0; e < 4; ++e) { const int t = 16 * tt + 4 * q + e; const float* p = B.PRW + (row0 + t) * RW_COLS + 1024 + col;
                const float vc = p[0], vp = (first && t == 0) ? 0.f : p[-RW_COLS]; xv[tt][e] = vc + (vp - vc) * muv; }
        __syncthreads();
#pragma unroll
        for (int tt = 0; tt < 4; ++tt) {
#pragma unroll
            for (int e = 0; e < 4; ++e) { const int t = 16 * tt + 4 * q + e; const size_t o = (row0 + t) * RW_W + col;
                const float bsc = RED[t].y + RED[64 + t].y + RED[128 + t].y + RED[192 + t].y, g = ag[tt][e];
                B.G1[o] = (bf16)f2bf(lnw * g); B.G2[o] = (bf16)f2bf((lnb + bsc * xv[tt][e]) * g); }
            u32x2 w; w.x = cvt2(xv[tt][0], xv[tt][1]); w.y = cvt2(xv[tt][2], xv[tt][3]);
            *(LAS u32x2*)(lds + 2 * IMG + off_b(n, 2 * tt + (q >> 1)) + 8 * (q & 1)) = w; }
      }
    }
    }
    __syncthreads();
    {
    int lane = lane0; asm volatile("" : "+v"(lane)); const int hi = lane >> 5; (void)hi;
#pragma unroll
    for (int k2 = 0; k2 < 2; ++k2) {
        const int id = 2 * wave + k2, prod = id >> 2, tb = (id >> 1) & 1, jb = id & 1;
        f32x16 acc = f32x16{};
        if (prod == 0) acc = mm_tile<true, true>(lds, H_AT, tb, H_BT, jb, acc, lane);
        else if (prod == 1) acc = mm_tile<true, true>(lds, H_AT, tb, H_KT, jb, acc, lane);
        else if (prod == 2) acc = mm_tile<true, true>(lds, H_BT, jb, H_RT, tb, acc, lane);
        else acc = mm_tile<true, true>(lds, H_KT, jb, H_RT, tb, acc, lane);
        if (prod < 2) {
#pragma unroll
            for (int r = 0; r < 16; ++r) { const int t = 32 * tb + crow(r, hi), j = 32 * jb + (lane & 31); if (!(j < t)) acc[r] = 0.f; }
            if (prod == 0) {
#pragma unroll
                for (int r = 0; r < 16; ++r) A32[(32 * tb + crow(r, hi)) * 64 + 32 * jb + (lane & 31)] = acc[r];
                f32x16 n1 = acc, n2 = acc;
#pragma unroll
                for (int r = 0; r < 16; ++r) { if (!(tb == jb && crow(r, hi) >= 16 && (lane & 31) < 16)) n1[r] = 0.f; if (!(tb == 1 && jb == 0)) n2[r] = 0.f; }
                store_tr(lds, H_N1, tb, jb, n1, lane); store_tr(lds, H_N2, tb, jb, n2, lane); }
            else store_tr(lds, H_AAK, tb, jb, acc, lane);
        } else {
#pragma unroll
            for (int r = 0; r < 16; ++r) { const int j = 32 * jb + crow(r, hi), t = 32 * tb + (lane & 31); if (!(j <= t)) acc[r] = 0.f; }
            store_tr(lds, prod == 2 ? H_ARB : H_ARK, jb, tb, acc, lane);
        }
    }
    }
    __syncthreads();
    {
    int lane = lane0; asm volatile("" : "+v"(lane)); const int hi = lane >> 5; (void)hi;
    if (wave == 0) {
        const int blk = lane >> 4, cc = lane & 15; float Tb[16];
#pragma unroll
        for (int t = 0; t < 16; ++t) { float sacc = (t == cc) ? 1.f : 0.f;
#pragma unroll
            for (int j4 = 0; j4 < t; j4 += 4) { const f32x4a a4 = *(const LAS f32x4a*)(A32 + (16 * blk + t) * 64 + 16 * blk + j4);
                sacc += a4[0] * Tb[j4]; if (j4 + 1 < t) sacc += a4[1] * Tb[j4 + 1]; if (j4 + 2 < t) sacc += a4[2] * Tb[j4 + 2]; if (j4 + 3 < t) sacc += a4[3] * Tb[j4 + 3]; }
            Tb[t] = sacc; }
        u32x4v lo, hi4; lo.x = cvt2(Tb[0], Tb[1]); lo.y = cvt2(Tb[2], Tb[3]); lo.z = cvt2(Tb[4], Tb[5]); lo.w = cvt2(Tb[6], Tb[7]);
        hi4.x = cvt2(Tb[8], Tb[9]); hi4.y = cvt2(Tb[10], Tb[11]); hi4.z = cvt2(Tb[12], Tb[13]); hi4.w = cvt2(Tb[14], Tb[15]);
#pragma unroll
        for (int g = 0; g < 8; ++g) { u32x4v w = (u32x4v){0u, 0u, 0u, 0u}; if (g == 2 * blk) w = lo; if (g == 2 * blk + 1) w = hi4;
            *(LAS u32x4v*)(lds + (H_TT >> 1) * IMG + off_b(lane, 8 * (H_TT & 1) + g)) = w; }
    } else if (wave >= 4) {
        const int tb = (wave - 4) >> 1, ib = (wave - 4) & 1;
        f32x16 acc = mm_tile<true, false>(lds, H_AAK, tb, H_VT, ib, f32x16{}, lane);
        store_tr(lds, H_XT, tb, ib, acc, lane);
    }
    __syncthreads();
    { const int tb = (wave >> 1) & 1, cb = wave & 1;
      if (wave < 4) { f32x16 acc = mm_tile<true, false>(lds, H_N1, tb, H_TT, cb, f32x16{}, lane);
#pragma unroll
          for (int r = 0; r < 16; ++r) if (32 * tb + crow(r, hi) == 32 * cb + (lane & 31)) acc[r] += 1.f;
          store_tr(lds, H_PT, tb, cb, acc, lane); }
      __syncthreads();
      if (wave < 4) { f32x16 acc = mm_tile<true, false>(lds, H_TT, tb, H_PT, cb, f32x16{}, lane); store_tr(lds, H_QT, tb, cb, acc, lane); }
      __syncthreads();
      if (wave < 4) { f32x16 acc = mm_tile<true, false>(lds, H_N2, tb, H_QT, cb, f32x16{}, lane);
#pragma unroll
          for (int r = 0; r < 16; ++r) if (32 * tb + crow(r, hi) == 32 * cb + (lane & 31)) acc[r] += 1.f;
          store_tr(lds, H_PT, tb, cb, acc, lane); }
      __syncthreads();
      if (wave < 4) { f32x16 acc = mm_tile<true, false>(lds, H_QT, tb, H_PT, cb, f32x16{}, lane); store_tr(lds, H_TT, tb, cb, acc, lane); }
    }
    }
    __syncthreads();
    {
    int lane = lane0; asm volatile("" : "+v"(lane)); const int hi = lane >> 5; (void)hi;
    { const int tb = (wave >> 1) & 1, cb = wave & 1;
      if (wave < 4) { f32x16 acc = mm_tile<true, false>(lds, H_TT, tb, H_AT, cb, f32x16{}, lane); store_tr(lds, H_PT, tb, cb, acc, lane); }
      else { f32x16 acc = mm_tile<true, false>(lds, H_TT, tb, H_XT, cb, f32x16{}, lane); store_tr(lds, H_QT, tb, cb, acc, lane); } }
    }
    __syncthreads();
    {
    int lane = lane0; asm volatile("" : "+v"(lane)); const int hi = lane >> 5; (void)hi;
#pragma unroll
    for (int k2 = 0; k2 < 2; ++k2) {
        const int id = 2 * wave + k2, prod = id >> 2, rb = (id >> 1) & 1, cb = id & 1;
        f32x16 acc = f32x16{};
        if (prod == 0) {
            acc = mm_tile<false, false>(lds, H_PT, rb, H_BT, cb, acc, lane);
            const float wc = WC[32 * cb + (lane & 31)];
#pragma unroll
            for (int r = 0; r < 16; ++r) { const int n = 32 * rb + crow(r, hi), m = 32 * cb + (lane & 31); acc[r] = (acc[r] + (n == m ? 1.f : 0.f)) * wc; }
            u32x4v* o = B.MF + ((size_t)ci * 8 + (cb * 2 + rb) * 2) * 64 + lane;
            o[0] = pack8(acc, 0); o[64] = pack8(acc, 1);
        } else if (prod == 1) {
            acc = mm_tile<false, false>(lds, H_BT, rb, H_QT, cb, acc, lane);
            acc = mm_tile<false, false>(lds, H_KT, rb, H_VT, cb, acc, lane);
#pragma unroll
            for (int g = 0; g < 4; ++g) { const f32x4a w4 = *(const LAS f32x4a*)(WC + 32 * rb + 8 * g + 4 * hi);
                f32x4a v = {acc[4 * g] * w4[0], acc[4 * g + 1] * w4[1], acc[4 * g + 2] * w4[2], acc[4 * g + 3] * w4[3]};
                *(f32x4a*)(B.NT + (((size_t)ci * 4 + rb * 2 + cb) * 64 + lane) * 16 + 4 * g) = v; }
        } else if (prod == 2) {
            acc = mm_tile<false, false>(lds, H_PT, rb, H_ARB, cb, acc, lane);
#pragma unroll
            for (int s = 0; s < 4; ++s) { bf16x8 idf;
#pragma unroll
                for (int e = 0; e < 8; ++e) idf[e] = (16 * s + 8 * hi + e == 32 * cb + (lane & 31)) ? (short)0x3f80 : (short)0;
                acc = __builtin_amdgcn_mfma_f32_32x32x16_bf16(frag_row(lds, H_RT, rb, s, lane), idf, acc, 0, 0, 0); }
            u32x4v* o = B.PF + ((size_t)ci * 8 + (cb * 2 + rb) * 2) * 64 + lane;
            o[0] = pack8(acc, 0); o[64] = pack8(acc, 1);
        } else {
            acc = mm_tile<false, false>(lds, H_ARB, rb, H_QT, cb, acc, lane);
            acc = mm_tile<false, false>(lds, H_ARK, rb, H_VT, cb, acc, lane);
#pragma unroll
            for (int g = 0; g < 4; ++g) *(f32x4a*)(B.QP + (((size_t)ci * 4 + rb * 2 + cb) * 64 + lane) * 16 + 4 * g) = (f32x4a){acc[4 * g], acc[4 * g + 1], acc[4 * g + 2], acc[4 * g + 3]};
        }
    }
    }
    __syncthreads();
}
__device__ __forceinline__ void r1_phase(const Ctx& C, const Bufs& B) {
    for (int u = blockIdx.x; u < NB * RH * NCH; u += C.G) { const int c = u & (NCH - 1), h = (u >> 5) & 7, b = u >> 8; r1_unit(C, B, b, h, c); }
}
__device__ __forceinline__ void r2_chain(const Ctx& C, const Bufs& B, int k) {
    const int lane = C.lane, hi = lane >> 5, ib = k & 1, bh = k >> 1;
    f32x16 z[2]; z[0] = f32x16{}; z[1] = f32x16{};
    typedef float f32x4a __attribute__((ext_vector_type(4)));
    for (int c = 0; c < NCH; ++c) {
        const size_t ci = (size_t)bh * NCH + c;
        u32x4v bf[2][2];
#pragma unroll
        for (int nb = 0; nb < 2; ++nb)
#pragma unroll
            for (int s = 0; s < 2; ++s) { bf[nb][s] = pack8(z[nb], s); B.ZF[((ci * 2 + ib) * 4 + nb * 2 + s) * 64 + lane] = bf[nb][s]; }
        f32x16 zn[2];
#pragma unroll
        for (int mb = 0; mb < 2; ++mb) {
            const float* np = B.NT + ((ci * 4 + mb * 2 + ib) * 64 + lane) * 16;
#pragma unroll
            for (int g = 0; g < 4; ++g) { const f32x4a v = *(const f32x4a*)(np + 4 * g); zn[mb][4 * g] = v[0]; zn[mb][4 * g + 1] = v[1]; zn[mb][4 * g + 2] = v[2]; zn[mb][4 * g + 3] = v[3]; }
#pragma unroll
            for (int nb = 0; nb < 2; ++nb)
#pragma unroll
                for (int s = 0; s < 2; ++s) { const u32x4v af = B.MF[(ci * 8 + (mb * 2 + nb) * 2 + s) * 64 + lane];
                    zn[mb] = __builtin_amdgcn_mfma_f32_32x32x16_bf16(__builtin_bit_cast(bf16x8, af), __builtin_bit_cast(bf16x8, bf[nb][s]), zn[mb], 0, 0, 0); }
        }
        z[0] = zn[0]; z[1] = zn[1];
    }
    float* so = C.out + OUT_WKVP + ((size_t)bh * RN + 32 * ib + (lane & 31)) * RN;
#pragma unroll
    for (int nb = 0; nb < 2; ++nb)
#pragma unroll
        for (int g = 0; g < 4; ++g) *(f32x4a*)(so + 32 * nb + 8 * g + 4 * hi) = (f32x4a){z[nb][4 * g], z[nb][4 * g + 1], z[nb][4 * g + 2], z[nb][4 * g + 3]};
}
__device__ __forceinline__ void r3_phase(const Ctx& C, const Bufs& B) {
    const int lane = C.lane, hi = lane >> 5;
    typedef float f32x4a __attribute__((ext_vector_type(4)));
    for (int wu = C.gw; wu < NB * RH * NCH * 2; wu += C.ngw) {
        const int tb = wu & 1; const size_t ci = (size_t)(wu >> 1); const int c = (int)(ci & (NCH - 1)), bh = (int)(ci >> 5), h = bh & 7, b = bh >> 3;
        u32x4v pf[2][2];
#pragma unroll
        for (int nb = 0; nb < 2; ++nb)
#pragma unroll
            for (int s = 0; s < 2; ++s) pf[nb][s] = B.PF[(ci * 8 + (tb * 2 + nb) * 2 + s) * 64 + lane];
        f32x16 y[2];
#pragma unroll
        for (int ib = 0; ib < 2; ++ib) {
            const float* qp = B.QP + ((ci * 4 + tb * 2 + ib) * 64 + lane) * 16;
#pragma unroll
            for (int g = 0; g < 4; ++g) { const f32x4a v = *(const f32x4a*)(qp + 4 * g); y[ib][4 * g] = v[0]; y[ib][4 * g + 1] = v[1]; y[ib][4 * g + 2] = v[2]; y[ib][4 * g + 3] = v[3]; }
#pragma unroll
            for (int nb = 0; nb < 2; ++nb)
#pragma unroll
                for (int s = 0; s < 2; ++s) { const u32x4v zf = B.ZF[((ci * 2 + ib) * 4 + nb * 2 + s) * 64 + lane];
                    y[ib] = __builtin_amdgcn_mfma_f32_32x32x16_bf16(__builtin_bit_cast(bf16x8, pf[nb][s]), __builtin_bit_cast(bf16x8, zf), y[ib], 0, 0, 0); }
        }
        const size_t rowb = (size_t)b * T + 64 * c + 32 * tb;
#pragma unroll
        for (int r = 0; r < 16; ++r) {
            float s1 = y[0][r] + y[1][r], s2 = y[0][r] * y[0][r] + y[1][r] * y[1][r];
#pragma unroll
            for (int o = 1; o < 32; o <<= 1) { s1 += __shfl_xor(s1, o); s2 += __shfl_xor(s2, o); }
            const float mean = s1 * (1.f / 64.f), var = fmaxf(s2 * (1.f / 64.f) - mean * mean, 0.f), rstd = 1.f / sqrtf(var + GN_EPS);
            const size_t row = rowb + crow(r, hi);
#pragma unroll
            for (int ib = 0; ib < 2; ++ib) { const int i = 32 * ib + (lane & 31); const size_t o = row * RW_W + h * 64 + i;
                const float g1 = __builtin_bit_cast(float, (unsigned)B.G1[o] << 16), g2 = __builtin_bit_cast(float, (unsigned)B.G2[o] << 16);
                B.MIX[row * D + ATT_W + h * 64 + i] = (bf16)f2bf((y[ib][r] - mean) * rstd * g1 + g2); }
        }
    }
}
}
constexpr int N_PHASES = 11;
__global__ void __launch_bounds__(NTHREADS, 2) fwd(Args args) {
    extern __shared__ __attribute__((aligned(16))) unsigned char lds[];
    Ctx C;
    C.lds = (LAS unsigned char*)lds;
    C.tid = threadIdx.x; C.lane = C.tid & 63; C.wave = __builtin_amdgcn_readfirstlane(C.tid >> 6);
    C.G = gridDim.x; C.gw = blockIdx.x * NWAVES + C.wave; C.ngw = C.G * NWAVES;
    C.in = args.in; C.out = args.out; C.ws = args.ws;
    const int lo = args.ph_lo, hi = args.ph_hi;
    volatile LAS unsigned* MISC = (volatile LAS unsigned*)(C.lds + MISC_OFF);
    if (C.tid < 32) MISC[C.tid] = 0u;
    __syncthreads();
    XcdBarrier bar = xcd_barrier_post((unsigned*)(C.ws + WS_CTL) + CW_BAR, MISC + 8);
#define IN(k) (lo <= (k) && (k) < hi)
#define SEAM(k) do { if (IN(k) && IN((k) + 1)) xcd_barrier(bar); } while (0)
    if (IN(0)) { p0_mod(C); p0_weights(C); }
    SEAM(0);
    if (IN(1)) { p1_norm1(C); }
    SEAM(1);
    if (IN(2)) {
        pg8::Gemm g{(const pg8::bf16_t*)(C.ws + WS_A1), (const pg8::bf16_t*)(C.ws + WS_WIN), MPAD, NIN, D}; pg8::StaticOrder S; S.init(MPAD, NIN, C.G, (int)blockIdx.x);
        EpiIn E{C.ws, C.out, C.in[15], C.in[16]};
        pg8::gemm_phase<EpiIn, pg8::StaticOrder, true, true>(C.lds, g, S, E);
    }
    SEAM(2);
    rw::Bufs RB;
    RB.LIN = (bf16*)(C.ws + WS_LIN); RB.W2T = (bf16*)(C.ws + WS_W2T); RB.A2T = (bf16*)(C.ws + WS_A2T); RB.G2T = (bf16*)(C.ws + WS_G2T);
    RB.PRW = (const float*)(C.ws + WS_PRW); RB.G1 = (bf16*)(C.ws + WS_RWA); RB.G2 = (bf16*)(C.ws + WS_RWA + RWA_STRIDE); RB.MIX = (bf16*)(C.ws + WS_MIX);
    RB.MF = (rw::u32x4v*)(C.ws + WS_MF); RB.NT = (float*)(C.ws + WS_NT); RB.PF = (rw::u32x4v*)(C.ws + WS_PF); RB.QP = (float*)(C.ws + WS_QP); RB.ZF = (rw::u32x4v*)(C.ws + WS_ZF);
    if (IN(3)) { p3_rwprep<false>(C); }
    SEAM(3);
    if (IN(4)) { idxsel::phase(C); rw::r1_phase(C, RB); p4_indexer<false, true>(C); p4_scan<false>(C, NB * RH); }
    SEAM(4);
    if (IN(5)) {
        p5_select<false, true>(C);
        if (C.wave == 0 && blockIdx.x < NB * RH * 2) rw::r2_chain(C, RB, (int)blockIdx.x);
        __syncthreads();
        const attn_body::AttnTensors AT{(const attn_body::bf16*)(C.ws + WS_QB), (const attn_body::bf16*)(C.ws + WS_KB), (const attn_body::bf16*)(C.ws + WS_VB), (attn_body::bf16*)(C.ws + WS_MIX), (const unsigned long long*)(C.ws + WS_MASKT)};
        const attn_body::StaticOrder S((int)C.G, (int)blockIdx.x);
        attn_body::attn_phase<attn_body::StaticOrder>((char*)lds, AT, S);
    }
    SEAM(5);
    if (IN(6)) { smp_attn(C); rw::r3_phase(C, RB); p5_rwfinal<0>(C, MP); }
    SEAM(6);
    if (IN(7)) {
        pg8::Gemm g{(const pg8::bf16_t*)(C.ws + WS_MIX), (const pg8::bf16_t*)(C.ws + WS_WOUT), MP, D, D}; pg8::StaticOrder S; S.init(MP, D, C.G, (int)blockIdx.x);
        EpiResGate E{C.in[0], (const float*)(C.ws + WS_MOD) + 2 * D, (float*)(C.ws + WS_X1)};
        pg8::gemm_phase<EpiResGate, pg8::StaticOrder, true, true>(C.lds, g, S, E);
        const float* xs = C.in[1]; const float* g1 = (const float*)(C.ws + WS_MOD) + (size_t)NB * MODW + 2 * D; float* x1s = (float*)(C.ws + WS_X1) + (size_t)MP * D;
        sample_gemm(C, (const bf16*)(C.ws + WS_MIX) + (size_t)MP * D, (const bf16*)(C.ws + WS_WOUT), D, [&](int row, int col, float v) { x1s[row * D + col] = xs[row * D + col] + g1[(size_t)row * MODW + col] * v; });
    }
    SEAM(7);
    if (IN(8)) { p8_res_norm2(C); }
    SEAM(8);
    if (IN(9)) {
        pg8::Gemm g{(const pg8::bf16_t*)(C.ws + WS_A2), (const pg8::bf16_t*)(C.ws + WS_WGU), MPAD, NGU, D}; pg8::StaticOrder S; S.init(MPAD, NGU, C.G, (int)blockIdx.x);
        EpiSwiGLU E{(bf16*)(C.ws + WS_HB)};
        pg8::gemm_phase<EpiSwiGLU, pg8::StaticOrder, true, true>(C.lds, g, S, E);
    }
    SEAM(9);
    if (IN(10)) {
        pg8::Gemm g{(const pg8::bf16_t*)(C.ws + WS_HB), (const pg8::bf16_t*)(C.ws + WS_WDN), MP, D, FFN}; pg8::StaticOrder S; S.init(MP, D, C.G, (int)blockIdx.x);
        EpiResGate E{(const float*)(C.ws + WS_X1), (const float*)(C.ws + WS_MOD) + 5 * D, C.out + OUT_Y};
        pg8::gemm_phase<EpiResGate, pg8::StaticOrder, true, true>(C.lds, g, S, E);
        const float* x1s = (const float*)(C.ws + WS_X1) + (size_t)MP * D; const float* g2 = (const float*)(C.ws + WS_MOD) + (size_t)NB * MODW + 5 * D; float* ys = C.out + OUT_YS;
        sample_gemm(C, (const bf16*)(C.ws + WS_HB) + (size_t)MP * FFN, (const bf16*)(C.ws + WS_WDN), FFN, [&](int row, int col, float v) { ys[row * D + col] = x1s[row * D + col] + g2[(size_t)row * MODW + col] * v; });
    }
#undef IN
#undef SEAM
}

extern "C" void kernel_launch(void* const* d_in, const int* in_sizes, int n_in, void* d_out, int out_size, void* d_ws, size_t ws_size, hipStream_t stream) {
    static int grid = 0;
    if (grid == 0) {
        if (n_in != 32 || (size_t)out_size != OUT_END || ws_size < WS_END) { fprintf(stderr, "kernel_launch: unexpected sizes n_in %d out %d ws %zu\n", n_in, out_size, ws_size); grid = -1; return; }
        int dev = 0, cus = 0;
        if (hipGetDevice(&dev) != hipSuccess || hipDeviceGetAttribute(&cus, hipDeviceAttributeMultiprocessorCount, dev) != hipSuccess) { grid = -1; return; }
        if (hipFuncSetAttribute((const void*)fwd, hipFuncAttributeMaxDynamicSharedMemorySize, LDS_BYTES) != hipSuccess) { fprintf(stderr, "kernel_launch: hipFuncSetAttribute failed\n"); grid = -1; return; }
        (void)hipGetLastError();
        grid = cus;
    }
    if (grid < 0) return;
    (void)hipMemsetAsync((char*)d_ws + WS_CTL, 0, CTL_ZERO_BYTES, stream);
    Args a{};
    for (int i = 0; i < 32; ++i) a.in[i] = (const float*)d_in[i];
    a.out = (float*)d_out; a.ws = (unsigned char*)d_ws;
    a.ph_lo = 0; a.ph_hi = N_PHASES;
    hipLaunchKernelGGL(fwd, dim3(grid), dim3(NTHREADS), LDS_BYTES, stream, a);
}
```

```cpp
#include <hip/hip_runtime.h>
#include <cstdio>
#include <cstdint>
#include <cmath>
#include <hip/hip_bf16.h>
#define LAS __attribute__((address_space(3)))
namespace pg8 {
#define PG8_LAS __attribute__((address_space(3)))
typedef unsigned short bf16_t;
typedef short bf16x8 __attribute__((ext_vector_type(8)));
typedef float f32x4 __attribute__((ext_vector_type(4)));
typedef unsigned u32x4 __attribute__((ext_vector_type(4)));
constexpr int BM = 256, BK = 64, HALF = 128, HTB = HALF * BK * 2  , STAGE_BYTES = 8 * HTB, NXCD = 8, WGM = 8;

__host__ __device__ __forceinline__ int lds_byte(int r, int c) { const int st = (r >> 4) * 2 + (c >> 5), rr = r & 15, cc = c & 31, ob = rr * 64 + cc * 2; return st * 1024 + (ob ^ (((ob >> 9) & 1) << 5)); }
__host__ __device__ __forceinline__ void stage_rc(int b, int& R, int& C) { const int st = b / 1024, sb = b % 1024, swz = sb ^ (((sb >> 9) & 1) << 5); R = (st >> 1) * 16 + swz / 64; C = (st & 1) * 32 + (swz % 64) / 2; }
__host__ __device__ __forceinline__ int perm32(int rho) { const int n = rho >> 4, i = rho & 15; return 8 * (i >> 2) + 4 * n + (i & 3); }

struct Unit { int pm, pn; };
struct Gemm { const bf16_t* A; const bf16_t* Bt; int M, N, K; };

struct StaticOrder {
    int nM, nN, nwg, G, c;
    __host__ __device__ void init(int M, int N, int G_, int c_) { nM = M / BM; nN = N / BM; nwg = nM * nN; G = G_; c = c_; }
    __host__ __device__ bool next(int i, Unit& u) const {
        const long L = (long)i * G + c; if (L >= nwg) return false;
        int wgid = (int)L; { const int q = nwg / NXCD, r = nwg % NXCD, xcd = wgid % NXCD, off = wgid / NXCD; wgid = (xcd < r ? xcd * (q + 1) : r * (q + 1) + (xcd - r) * q) + off; }
        const int nig = WGM * nN, gid = wgid / nig, fm = gid * WGM, gsz = (nM - fm) < WGM ? (nM - fm) : WGM;
        u.pm = fm + ((wgid % nig) % gsz); u.pn = (wgid % nig) / gsz; return true;
    }
    __device__ __forceinline__ void a_ready(const Unit&) const {}
    __device__ __forceinline__ void done(const Unit&) const {}
};

__device__ __forceinline__ unsigned cvt_pk_bf16(float lo, float hi) { unsigned r; asm volatile("v_cvt_pk_bf16_f32 %0, %1, %2" : "=v"(r) : "v"(lo), "v"(hi)); return r; }
typedef float f32x2 __attribute__((ext_vector_type(2)));
__device__ __forceinline__ f32x2 gelu_pk(f32x2 v) {
    const f32x2 av = __builtin_elementwise_abs(v), d = av * 0.2316418882f + 1.0f;
    f32x2 t; t.x = __builtin_amdgcn_rcpf(d.x); t.y = __builtin_amdgcn_rcpf(d.y);
    f32x2 q = t * 0.5307027145f + (-0.7265760135f); q = q * t + 0.7107068705f; q = q * t + (-0.142248368f); q = q * t + 0.127414796f; q = q * t;
    const f32x2 s = (v * v) * (-0.72134752044f);
    f32x2 e; e.x = __builtin_amdgcn_exp2f(s.x); e.y = __builtin_amdgcn_exp2f(s.y);
    const f32x2 m = v * (q * e), r = v - m;
    f32x2 o; o.x = v.x < 0.f ? m.x : r.x; o.y = v.y < 0.f ? m.y : r.y; return o;
}

template <int ACT  > struct EpiBf16 {
    static constexpr bool PERM = true, AFTER_DRAIN = false; static_assert(ACT == 0 || ACT == 1, "EpiBf16: ACT is 0 (none) or 1 (gelu_pk)");
    bf16_t* O; int ldc; const float* bias; int split_cols; size_t split_stride; float scale0;
    __device__ __forceinline__ void operator()(const f32x4 (&acc)[2][2][4][2], const Unit& u, int wr, int wc, int fr, int fq) const {
        const int row0 = u.pm * BM + wr * 64 + fr; int colt = u.pn * BM; bf16_t* base = O;
        float sc = 1.f; if (split_cols) { const int t = colt / split_cols; base += (size_t)t * split_stride; colt -= t * split_cols; if (t == 0) sc = scale0; }
        const int col0 = colt + wc * 32 + 8 * fq, bcol0 = u.pn * BM + wc * 32 + 8 * fq;
        f32x4 bv[2][2];
#pragma unroll
        for (int bj = 0; bj < 2; ++bj)
#pragma unroll
            for (int n = 0; n < 2; ++n) bv[bj][n] = bias ? *(const f32x4*)(bias + bcol0 + bj * HALF + 4 * n) : (f32x4){0.f, 0.f, 0.f, 0.f};
#pragma unroll
        for (int ai = 0; ai < 2; ++ai)
#pragma unroll
            for (int m = 0; m < 4; ++m) { bf16_t* rowp = base + (size_t)(row0 + ai * HALF + m * 16) * ldc + col0;
#pragma unroll
                for (int bj = 0; bj < 2; ++bj) { f32x4 v0 = acc[ai][bj][m][0] + bv[bj][0], v1 = acc[ai][bj][m][1] + bv[bj][1];
                    if (ACT == 1) { f32x2 a = gelu_pk((f32x2){v0[0], v0[1]}), b = gelu_pk((f32x2){v0[2], v0[3]}), c = gelu_pk((f32x2){v1[0], v1[1]}), d = gelu_pk((f32x2){v1[2], v1[3]});
                        v0 = (f32x4){a.x, a.y, b.x, b.y}; v1 = (f32x4){c.x, c.y, d.x, d.y}; }
                    v0 = v0 * sc; v1 = v1 * sc; u32x4 w; w.x = cvt_pk_bf16(v0[0], v0[1]); w.y = cvt_pk_bf16(v0[2], v0[3]); w.z = cvt_pk_bf16(v1[0], v1[1]); w.w = cvt_pk_bf16(v1[2], v1[3]);
                    *(u32x4*)(rowp + bj * HALF) = w; } }
    }
};


template <class Epi, class Sched, bool ALIGN_EPI = false, bool SP2 = false>
__device__ __forceinline__ void gemm_phase(PG8_LAS unsigned char* lds, const Gemm g, const Sched& S, const Epi& E) {
    const int tid = threadIdx.x, wid = __builtin_amdgcn_readfirstlane(tid >> 6), lane = tid & 63, wr = wid >> 2, wc = wid & 3, fr = lane & 15, fq = lane >> 4;
    const int K = g.K, nt = K / BK;
    unsigned voffA[2], voffB[2];
#pragma unroll
    for (int i = 0; i < 2; ++i) { int R, C; stage_rc(tid * 16 + i * 8192, R, C); const int Rb = Epi::PERM ? ((R & ~31) + perm32(R & 31)) : R;
        voffA[i] = (unsigned)(R * K + C) * 2u; voffB[i] = (unsigned)(Rb * K + C) * 2u; }
    const size_t kstep = (size_t)(BK * 2);
    const size_t hstep = (size_t)HALF * K * 2;
    const size_t tstep = 2 * hstep;
    const unsigned ldsw = (unsigned)wid * 1024u;
    const int aoff = lds_byte(wr * 64 + fr, fq * 8), boff = lds_byte(wc * 32 + fr, fq * 8);
#define PG8_SA(b, h) (((b) * 2 + (h)) * HTB)
#define PG8_SB(b, h) ((4 + (b) * 2 + (h)) * HTB)
#define PG8_STAGE(bufoff, gbase, voff) do { _Pragma("unroll") for (int _i = 0; _i < 2; ++_i) \
        __builtin_amdgcn_global_load_lds((const unsigned*)((const char*)(gbase) + (voff)[_i]), (PG8_LAS unsigned*)(lds + (bufoff) + ldsw + _i * 8192), 16, 0, 0); } while (0)
#define PG8_LDA(dst, b, h) do { _Pragma("unroll") for (int m = 0; m < 4; ++m) _Pragma("unroll") for (int k = 0; k < 2; ++k) dst[m][k] = *(const PG8_LAS bf16x8*)(lds + PG8_SA(b, h) + aoff + m * 2048 + k * 1024); } while (0)
#define PG8_LDB(dst, b, h) do { _Pragma("unroll") for (int n = 0; n < 2; ++n) _Pragma("unroll") for (int k = 0; k < 2; ++k) dst[n][k] = *(const PG8_LAS bf16x8*)(lds + PG8_SB(b, h) + boff + n * 2048 + k * 1024); } while (0)
#define PG8_MMA(ai, bj, At, Bt) do { __builtin_amdgcn_s_setprio(1); _Pragma("unroll") for (int m = 0; m < 4; ++m) _Pragma("unroll") for (int n = 0; n < 2; ++n) _Pragma("unroll") for (int k = 0; k < 2; ++k) \
        acc[ai][bj][m][n] = __builtin_amdgcn_mfma_f32_16x16x32_bf16(Bt[n][k], At[m][k], acc[ai][bj][m][n], 0, 0, 0); __builtin_amdgcn_s_setprio(0); } while (0)
#define PG8_WAIT_V(n) asm volatile("s_waitcnt vmcnt(" #n ")" ::: "memory")
#define PG8_WAIT_L(n) asm volatile("s_waitcnt lgkmcnt(" #n ")" ::: "memory")
#define PG8_BAR __builtin_amdgcn_s_barrier()
#define PG8_SCHED __builtin_amdgcn_sched_barrier(0)
    Unit cur, nxt; int ui = 0;
    if (!S.next(0, cur)) return;
    f32x4 acc[2][2][4][2];
#pragma unroll
    for (int a = 0; a < 2; ++a)
#pragma unroll
        for (int b = 0; b < 2; ++b)
#pragma unroll
            for (int m = 0; m < 4; ++m)
#pragma unroll
                for (int n = 0; n < 2; ++n) acc[a][b][m][n] = (f32x4){0.f, 0.f, 0.f, 0.f};
    bf16x8 At[4][2], B0[2][2], B1[2][2];
    const char* cA = (const char*)g.A + (size_t)cur.pm * tstep; const char* cB = (const char*)g.Bt + (size_t)cur.pn * tstep;
    S.a_ready(cur);
    if constexpr (SP2) {
        PG8_STAGE(PG8_SB(0, 0), cB, voffB); PG8_STAGE(PG8_SB(0, 1), cB + hstep, voffB); PG8_STAGE(PG8_SA(0, 0), cA, voffA); PG8_STAGE(PG8_SA(0, 1), cA + hstep, voffA);
        if (wr == 1) PG8_BAR;
        PG8_WAIT_V(2); PG8_BAR;
        PG8_STAGE(PG8_SB(1, 0), cB + kstep, voffB); PG8_STAGE(PG8_SA(1, 0), cA + kstep, voffA); PG8_STAGE(PG8_SB(1, 1), cB + hstep + kstep, voffB);
        PG8_WAIT_V(6); PG8_BAR;
    } else {
        PG8_STAGE(PG8_SB(0, 0), cB, voffB); PG8_STAGE(PG8_SA(0, 0), cA, voffA); PG8_STAGE(PG8_SB(0, 1), cB + hstep, voffB); PG8_STAGE(PG8_SA(0, 1), cA + hstep, voffA);
        if (wr == 1) PG8_BAR;
        PG8_WAIT_V(4); PG8_BAR;
        PG8_STAGE(PG8_SB(1, 0), cB + kstep, voffB); PG8_STAGE(PG8_SA(1, 0), cA + kstep, voffA); PG8_STAGE(PG8_SB(1, 1), cB + hstep + kstep, voffB);
        PG8_WAIT_V(6); PG8_BAR;
    }
    for (;;) {
        const bool has_next = S.next(ui + 1, nxt);
        const char* nA = has_next ? (const char*)g.A + (size_t)nxt.pm * tstep : cA; const char* nB = has_next ? (const char*)g.Bt + (size_t)nxt.pn * tstep : cB;
        for (int t = 0; t < nt; t += 2) {
            const bool last = (t == nt - 2);
            const char* a1 = cA + (size_t)(t + 1) * kstep;
            const char* a2 = last ? nA : cA + (size_t)(t + 2) * kstep; const char* b2 = last ? nB : cB + (size_t)(t + 2) * kstep;
            const char* a3 = a2 + kstep; const char* b3 = b2 + kstep;
            if (last && has_next) S.a_ready(nxt);
            if constexpr (SP2) {
            PG8_LDB(B0, 0, 0); PG8_LDB(B1, 0, 1); PG8_SCHED; PG8_LDA(At, 0, 0); PG8_STAGE(PG8_SA(1, 1), a1 + hstep, voffA);
            PG8_WAIT_V(8); PG8_WAIT_L(0); PG8_BAR; PG8_MMA(0, 0, At, B0); PG8_MMA(0, 1, At, B1); PG8_BAR; PG8_SCHED;
            PG8_LDA(At, 0, 1); PG8_STAGE(PG8_SB(0, 0), b2, voffB); PG8_STAGE(PG8_SB(0, 1), b2 + hstep, voffB); PG8_STAGE(PG8_SA(0, 0), a2, voffA);
            PG8_WAIT_V(8); PG8_WAIT_L(0); PG8_BAR; PG8_MMA(1, 0, At, B0); PG8_MMA(1, 1, At, B1); PG8_BAR; PG8_SCHED;
            PG8_LDB(B0, 1, 0); PG8_LDB(B1, 1, 1); PG8_SCHED; PG8_LDA(At, 1, 0); PG8_STAGE(PG8_SA(0, 1), a2 + hstep, voffA);
            PG8_WAIT_V(8); PG8_WAIT_L(0); PG8_BAR; PG8_MMA(0, 0, At, B0); PG8_MMA(0, 1, At, B1); PG8_BAR; PG8_SCHED;
            PG8_LDA(At, 1, 1); PG8_STAGE(PG8_SB(1, 0), b3, voffB); PG8_STAGE(PG8_SB(1, 1), b3 + hstep, voffB); PG8_STAGE(PG8_SA(1, 0), a3, voffA);
            PG8_WAIT_V(8); PG8_WAIT_L(0); PG8_BAR; PG8_MMA(1, 0, At, B0); PG8_MMA(1, 1, At, B1); PG8_BAR; PG8_SCHED;
            } else {
            PG8_LDB(B0, 0, 0); PG8_SCHED; PG8_LDA(At, 0, 0); PG8_STAGE(PG8_SA(1, 1), a1 + hstep, voffA);
            PG8_WAIT_L(8); PG8_BAR; PG8_WAIT_L(0); PG8_MMA(0, 0, At, B0); PG8_BAR; PG8_SCHED;
            PG8_LDB(B1, 0, 1); PG8_STAGE(PG8_SB(0, 0), b2, voffB);
            PG8_BAR; PG8_WAIT_L(0); PG8_MMA(0, 1, At, B1); PG8_BAR;
            PG8_LDA(At, 0, 1); PG8_STAGE(PG8_SA(0, 0), a2, voffA);
            PG8_BAR; PG8_WAIT_L(0); PG8_MMA(1, 0, At, B0); PG8_BAR; PG8_SCHED;
            PG8_STAGE(PG8_SB(0, 1), b2 + hstep, voffB);
            PG8_WAIT_V(6); PG8_BAR; PG8_MMA(1, 1, At, B1); PG8_BAR;
            PG8_LDB(B0, 1, 0); PG8_SCHED; PG8_LDA(At, 1, 0); PG8_STAGE(PG8_SA(0, 1), a2 + hstep, voffA);
            PG8_WAIT_L(8); PG8_BAR; PG8_WAIT_L(0); PG8_MMA(0, 0, At, B0); PG8_BAR; PG8_SCHED;
            PG8_LDB(B1, 1, 1); PG8_STAGE(PG8_SB(1, 0), b3, voffB);
            PG8_BAR; PG8_WAIT_L(0); PG8_MMA(0, 1, At, B1); PG8_BAR;
            PG8_LDA(At, 1, 1); PG8_STAGE(PG8_SA(1, 0), a3, voffA);
            PG8_BAR; PG8_WAIT_L(0); PG8_MMA(1, 0, At, B0); PG8_BAR; PG8_SCHED;
            PG8_STAGE(PG8_SB(1, 1), b3 + hstep, voffB);
            PG8_WAIT_V(6); PG8_BAR; PG8_MMA(1, 1, At, B1); PG8_BAR;
            }
        }
        if constexpr (ALIGN_EPI) { if (wr == 0) PG8_BAR; }
        if constexpr (!Epi::AFTER_DRAIN) { E(acc, cur, wr, wc, fr, fq); S.done(cur); }
        if (!has_next) break;
#pragma unroll
        for (int a = 0; a < 2; ++a)
#pragma unroll
            for (int b = 0; b < 2; ++b)
#pragma unroll
                for (int m = 0; m < 4; ++m)
#pragma unroll
                    for (int n = 0; n < 2; ++n) acc[a][b][m][n] = (f32x4){0.f, 0.f, 0.f, 0.f};
        cur = nxt; cA = nA; cB = nB; ++ui;
        if constexpr (ALIGN_EPI) { if (wr == 1) PG8_BAR; }
    }
    PG8_WAIT_V(0);
    if constexpr (!ALIGN_EPI) { if (wr == 0) PG8_BAR; }
    PG8_BAR;
    if constexpr (Epi::AFTER_DRAIN) { E.fused(acc, cur, wr, wc, fr, fq, lds, wid, lane); S.done(cur); }
#undef PG8_SA
#undef PG8_SB
#undef PG8_STAGE
#undef PG8_LDA
#undef PG8_LDB
#undef PG8_MMA
#undef PG8_WAIT_V
#undef PG8_WAIT_L
#undef PG8_BAR
#undef PG8_SCHED
}
}
namespace attn_body {
using bf16=__hip_bfloat16;
using bf16x8=__attribute__((ext_vector_type(8)))short;
using s16x4=__attribute__((ext_vector_type(4)))short;
using f32x16=__attribute__((ext_vector_type(16)))float;
using u32x4=__attribute__((ext_vector_type(4)))unsigned;
constexpr int BATCH=8,NHEAD=8,SEQ=2048,D=64,DM=NHEAD*D,DMO=1024;
constexpr int NW=8,QBLK=32,QB=QBLK*NW,KVBLK=64,NQB=SEQ/QB;
constexpr int ATTN_PITCH=DM, ATTN_UNIT_ROWS=QB;
__device__ __forceinline__ int crow(int r,int hi){return (r&3)+8*(r>>2)+4*hi;}
#define SBAR() __builtin_amdgcn_sched_barrier(0)
typedef unsigned u32x16 __attribute__((ext_vector_type(16)));
constexpr int NSLOT=3, SLOTB=8192;
constexpr int LDS_K=0, LDS_V=NSLOT*SLOTB, LDS_WS=2*NSLOT*SLOTB, LDS_OST=LDS_WS+NW*64*4, LDS_BYTES=LDS_OST+NW*4096;
constexpr float C2=0.125f*1.4426950408889634f;
__device__ __forceinline__ void glds16(const void*gsrc,unsigned lds_dst){unsigned keep;
  asm volatile("s_mov_b32 %0, m0\n\ts_mov_b32 m0, %2\n\ts_nop 0\n\tglobal_load_lds_dwordx4 %1, off\n\ts_mov_b32 m0, %0":"=&s"(keep):"v"(gsrc),"s"(lds_dst):"memory");}
__device__ __forceinline__ float max3f(float a,float b,float c){float r;asm("v_max3_f32 %0, %1, %2, %3":"=v"(r):"v"(a),"v"(b),"v"(c));return r;}
__device__ __forceinline__ float max2f(float a,float b){float r;asm("v_max_f32_e32 %0, %1, %2":"=v"(r):"v"(a),"v"(b));return r;}
__device__ __forceinline__ float fadd_s(float a,float b){float r;asm("v_add_f32_e32 %0, %1, %2":"=v"(r):"v"(a),"v"(b));return r;}
__device__ __forceinline__ float fsub_s(float a,float b){float r;asm("v_sub_f32_e32 %0, %1, %2":"=v"(r):"v"(a),"v"(b));return r;}
typedef float f32x2_t __attribute__((ext_vector_type(2))); typedef __bf16 bf16x2_t __attribute__((ext_vector_type(2)));
__device__ __forceinline__ unsigned cvtpk_s(float lo,float hi){f32x2_t v={lo,hi};bf16x2_t b=__builtin_convertvector(v,bf16x2_t);return __builtin_bit_cast(unsigned,b);}
#define WAIT_BAR(N) asm volatile("s_waitcnt vmcnt(" #N ") lgkmcnt(0)\n\ts_barrier":::"memory")

__device__ __forceinline__ void qkt(f32x16&p0,f32x16&p1,const char*Kslot,const bf16x8*qr,int r32,int hi){ const f32x16 negm=f32x16{};
  const char*kb=Kslot+hi*1024+r32*16;
  #pragma unroll
  for(int d0=0;d0<4;++d0){
    const bf16x8 b0=*reinterpret_cast<const bf16x8*>(kb+d0*2048);
    const bf16x8 b1=*reinterpret_cast<const bf16x8*>(kb+d0*2048+512);
    if(d0==0){p0=__builtin_amdgcn_mfma_f32_32x32x16_bf16(b0,qr[0],negm,0,0,0);p1=__builtin_amdgcn_mfma_f32_32x32x16_bf16(b1,qr[0],negm,0,0,0);}
    else{p0=__builtin_amdgcn_mfma_f32_32x32x16_bf16(b0,qr[d0],p0,0,0,0);p1=__builtin_amdgcn_mfma_f32_32x32x16_bf16(b1,qr[d0],p1,0,0,0);}}
}
typedef __attribute__((address_space(3))) const char* lds_cptr;
typedef short v4i16_t __attribute__((ext_vector_type(4)));
__device__ __forceinline__ void kload8(bf16x8*kf,lds_cptr kp){
  kf[0]=*(const __attribute__((address_space(3))) bf16x8*)(kp);      kf[1]=*(const __attribute__((address_space(3))) bf16x8*)(kp+512);
  kf[2]=*(const __attribute__((address_space(3))) bf16x8*)(kp+2048); kf[3]=*(const __attribute__((address_space(3))) bf16x8*)(kp+2560);
  kf[4]=*(const __attribute__((address_space(3))) bf16x8*)(kp+4096); kf[5]=*(const __attribute__((address_space(3))) bf16x8*)(kp+4608);
  kf[6]=*(const __attribute__((address_space(3))) bf16x8*)(kp+6144); kf[7]=*(const __attribute__((address_space(3))) bf16x8*)(kp+6656);
}
__device__ __forceinline__ void kload2(bf16x8*kf,lds_cptr kp,int j){ kf[2*j]=*(const __attribute__((address_space(3))) bf16x8*)(kp+j*2048); kf[2*j+1]=*(const __attribute__((address_space(3))) bf16x8*)(kp+j*2048+512); }
__device__ __forceinline__ s16x4 vtr(lds_cptr p){ return __builtin_bit_cast(s16x4,__builtin_amdgcn_ds_read_tr16_b64_v4i16((__attribute__((address_space(3))) v4i16_t*)p)); }
__device__ __forceinline__ float rowmax(const f32x16&p0,const f32x16&p1){
  float a=max3f(p0[0],p0[1],p1[0]),b=max3f(p0[2],p0[3],p1[1]);a=max3f(a,p1[2],p1[3]);
  #pragma unroll
  for(int r=4;r<16;r+=4){a=max3f(a,p0[r],p0[r+1]);b=max3f(b,p0[r+2],p0[r+3]);a=max3f(a,p1[r],p1[r+1]);b=max3f(b,p1[r+2],p1[r+3]);}
  const float m=max2f(a,b);
  auto rr=__builtin_amdgcn_permlane32_swap(__float_as_uint(m),__float_as_uint(m),false,false);
  return max2f(__uint_as_float(rr[0]),__uint_as_float(rr[1]));
}
__device__ __forceinline__ void pv(f32x16*o,int vb,bf16x8 pa0,bf16x8 pa1,bf16x8 pa2,bf16x8 pa3){
  #pragma unroll
  for(int d0=0;d0<2;++d0){s16x4 lo[4],hi[4];
    #pragma unroll
    for(int ks=0;ks<4;++ks){
      asm volatile("ds_read_b64_tr_b16 %0,%1 offset:%c2":"=&v"(lo[ks]):"v"(vb),"i"(d0*4096+ks*1024):"memory");
      asm volatile("ds_read_b64_tr_b16 %0,%1 offset:%c2":"=&v"(hi[ks]):"v"(vb),"i"(d0*4096+ks*1024+512):"memory");}
    asm volatile("s_waitcnt lgkmcnt(0)":::"memory");SBAR();
    #define PK(k) (bf16x8){lo[k][0],lo[k][1],lo[k][2],lo[k][3],hi[k][0],hi[k][1],hi[k][2],hi[k][3]}
    o[d0]=__builtin_amdgcn_mfma_f32_32x32x16_bf16(pa0,PK(0),o[d0],0,0,0);
    o[d0]=__builtin_amdgcn_mfma_f32_32x32x16_bf16(pa1,PK(1),o[d0],0,0,0);
    o[d0]=__builtin_amdgcn_mfma_f32_32x32x16_bf16(pa2,PK(2),o[d0],0,0,0);
    o[d0]=__builtin_amdgcn_mfma_f32_32x32x16_bf16(pa3,PK(3),o[d0],0,0,0);
    #undef PK
  }
}

#ifndef ATTN_STORE16
#define ATTN_STORE16(p,v) (*(u32x4*)(p)=(v))
#endif
template<int THRL> __device__ __forceinline__ void attn_unit(int b,int h,int qb,const bf16*Q,const bf16*__restrict__ K,const bf16*__restrict__ V,bf16*O,const unsigned long long*MT,char*shm){
  const int tid=threadIdx.x,lane=tid&63,r32=lane&31,hi=lane>>5; const int wid=__builtin_amdgcn_readfirstlane(tid>>6);
  const long rowbase=(long)b*SEQ; const int q0=qb*QB;
  const bf16*Qw=Q+(rowbase+q0+wid*QBLK)*DM+h*D;
  const bf16*Kh=K+rowbase*DM+h*D,*Vh=V+rowbase*DM+h*D;
  const unsigned lds0=(unsigned)(uintptr_t)shm;
  float*wsf=(float*)(shm+LDS_WS)+wid*64;
  const bf16*ksrc=Kh+(long)lane*DM+wid*8;
  const bf16*vsrc=Vh+(long)(16*(wid&3)+(lane>>2))*DM+(wid>>2)*32+(lane&3)*8;
  const unsigned kdst=lds0+LDS_K+wid*1024, vdst=lds0+LDS_V+wid*1024;
  #define DMA_K(t,slot) glds16(ksrc+(long)(t)*KVBLK*DM,(unsigned)__builtin_amdgcn_readfirstlane(kdst+(slot)))
  #define DMA_V(t,slot) glds16(vsrc+(long)(t)*KVBLK*DM,(unsigned)__builtin_amdgcn_readfirstlane(vdst+(slot)))
  const int vb0=(int)(lds0+LDS_V)+((lane>>4)&1)*32+(lane&3)*8+(4*hi+((lane&15)>>2))*64;
  const char*Kbase=shm+LDS_K; bf16x8 kf[8];
  const lds_cptr shm3=(lds_cptr)shm; const lds_cptr kp0=shm3+LDS_K+hi*1024+r32*16; const lds_cptr vp0=shm3+LDS_V+((lane>>4)&1)*32+(lane&3)*8+(4*hi+((lane&15)>>2))*64;
  const int NT=(q0+QB)/KVBLK;
  const unsigned long long*mbase=MT+((size_t)((b*(SEQ/32)+qb*NW+wid)*(SEQ/KVBLK)))*32;
  u32x16 mk0,mk1,mk2,mk3; const float NEGV=-INFINITY;
  #define MLOAD(t) do{ const unsigned long long*mp_=mbase+(size_t)(t)*32; \
    asm volatile("s_load_dwordx16 %0, %4, 0x0\n\ts_load_dwordx16 %1, %4, 0x40\n\ts_load_dwordx16 %2, %4, 0x80\n\ts_load_dwordx16 %3, %4, 0xc0":"=&s"(mk0),"=&s"(mk1),"=&s"(mk2),"=&s"(mk3):"s"(mp_):"memory"); }while(0)
  #define MK64(v,i) (((unsigned long long)(v)[2*(i)+1]<<32)|(unsigned long long)(v)[2*(i)])
  #define MAPPLY(P0,P1) do{ asm volatile("s_waitcnt lgkmcnt(0)":"+s"(mk0),"+s"(mk1),"+s"(mk2),"+s"(mk3)::"memory"); \
    _Pragma("unroll") for(int r=0;r<8;++r){ P0[r]=__builtin_amdgcn_inverse_ballot_w64(MK64(mk0,r))?P0[r]:NEGV; P0[r+8]=__builtin_amdgcn_inverse_ballot_w64(MK64(mk1,r))?P0[r+8]:NEGV; \
      P1[r]=__builtin_amdgcn_inverse_ballot_w64(MK64(mk2,r))?P1[r]:NEGV; P1[r+8]=__builtin_amdgcn_inverse_ballot_w64(MK64(mk3,r))?P1[r+8]:NEGV; } }while(0)
  DMA_K(0,0);DMA_V(0,0);DMA_K(1,SLOTB);
  bf16x8 qr[4];
  #pragma unroll
  for(int d0=0;d0<4;++d0)qr[d0]=*reinterpret_cast<const bf16x8*>(&Qw[(long)r32*DM+d0*16+hi*8]);
  float mhat=0.f,l_reg=0.f;f32x16 o[2];o[0]=f32x16{};o[1]=f32x16{};const f32x16 zc=f32x16{};
  bool resc=false;
  #define START(P0,P1) do{ const float rm=rowmax(P0,P1); resc=false; \
    { const float dl=max2f(rm,-30.f); mhat=fadd_s(mhat,dl); \
      _Pragma("unroll") for(int r=0;r<16;++r){P0[r]=fsub_s(P0[r],dl);P1[r]=fsub_s(P1[r],dl);} \
      } \
    _Pragma("unroll") for(int r=0;r<16;++r)P0[r]=__builtin_amdgcn_exp2f(P0[r]); }while(0)
  #define RESC() do{ if(resc){ asm volatile("s_waitcnt lgkmcnt(0)":::"memory"); \
      _Pragma("unroll") for(int d_=0;d_<2;++d_) _Pragma("unroll") for(int r=0;r<16;++r)o[d_][r]*=wsf[crow(r,hi)]; } }while(0)
  f32x16 pA0,pA1,pB0,pB1;
  int sl_prev=0,sl_cur=0,sl_next=SLOTB;
  #define ROT() do{sl_prev=sl_cur;sl_cur=sl_next;sl_next=(sl_next==(NSLOT-1)*SLOTB)?0:sl_next+SLOTB;}while(0)
  DMA_K(2,2*SLOTB);
  WAIT_BAR(3);
  MLOAD(0); qkt(pA0,pA1,Kbase,qr,r32,hi);asm volatile("s_nop 15\n\ts_nop 7":"+v"(pA0),"+v"(pA1));MAPPLY(pA0,pA1);asm volatile("s_nop 1":"+v"(pA0),"+v"(pA1));
  START(pA0,pA1);
  _Pragma("unroll") for(int r=0;r<16;++r)pA1[r]=__builtin_amdgcn_exp2f(pA1[r]);
  WAIT_BAR(0);
  DMA_K(3,0);DMA_V(1,SLOTB);
  ROT();
  kload8(kf,kp0+sl_cur);
  WAIT_BAR(2);
  s16x4 vlo[8],vhi[8]; u32x4 pw0,pw1,pw2,pw3;
  #define PKW(P,B) cvtpk_s(P[B],P[B+1])
  #define PAF(k) __builtin_bit_cast(bf16x8,pw##k)
  #define VFR(i) (bf16x8){vlo[i][0],vlo[i][1],vlo[i][2],vlo[i][3],vhi[i][0],vhi[i][1],vhi[i][2],vhi[i][3]}
  #define PIN(x) asm volatile("":"+v"(x))
  #define MX3(a,b,c) __builtin_fmaxf(__builtin_fmaxf((a),(b)),(c))
  #define GAPA(MF,A0,A1,A2,A3,W0,W1,PW) do{ MF; sacc+=A0; sacc+=A1; sacc+=A2; sacc+=A3; PIN(sacc); W0; W1; PIN(PW); SBAR(); }while(0)
  #define EX(v) __builtin_amdgcn_exp2f(v)
  #define GAPB(MF,X,B) do{ MF; X[B]=EX(X[B]); X[B+1]=EX(X[B+1]); X[B+2]=EX(X[B+2]); X[B+3]=EX(X[B+3]); PIN(X); SBAR(); }while(0)
  #define VRD(i) do{ vlo[i]=vtr(vp_+(((i)>>2)*4096+((i)&3)*1024)); vhi[i]=vtr(vp_+(((i)>>2)*4096+((i)&3)*1024+512)); }while(0)
  #define KRD(G,j) do{ if(G){ kload2(kf,kp0+sl_next,j); SBAR(); } }while(0)
  #define STEP(C0,C1,P0,P1,t,GK,GV,GL) do{ SBAR(); MLOAD(t); \
    const lds_cptr vp_=vp0+sl_prev; \
    VRD(0); SBAR(); float sacc=(P0[0]+P0[1]); \
    GAPA(C0=__builtin_amdgcn_mfma_f32_32x32x16_bf16(kf[0],qr[0],zc,0,0,0), P0[2],P0[3],P0[4],P0[5],     pw0[0]=PKW(P0,0), pw0[1]=PKW(P0,2), pw0); \
    VRD(4); SBAR(); GAPA(C1=__builtin_amdgcn_mfma_f32_32x32x16_bf16(kf[1],qr[0],zc,0,0,0), P0[6],P0[7],P0[8],P0[9],     pw0[2]=PKW(P0,4), pw0[3]=PKW(P0,6), pw0); \
    VRD(1); SBAR(); GAPA(C0=__builtin_amdgcn_mfma_f32_32x32x16_bf16(kf[2],qr[1],C0,0,0,0),   P0[10],P0[11],P0[12],P0[13], pw1[0]=PKW(P0,8), pw1[1]=PKW(P0,10), pw1); \
    VRD(5); SBAR(); GAPA(C1=__builtin_amdgcn_mfma_f32_32x32x16_bf16(kf[3],qr[1],C1,0,0,0),   P0[14],P0[15],P1[0],P1[1],   pw1[2]=PKW(P0,12),pw1[3]=PKW(P0,14), pw1); \
    VRD(2); SBAR(); GAPA(C0=__builtin_amdgcn_mfma_f32_32x32x16_bf16(kf[4],qr[2],C0,0,0,0),   P1[2],P1[3],P1[4],P1[5],     pw2[0]=PKW(P1,0), pw2[1]=PKW(P1,2), pw2); \
    VRD(6); SBAR(); GAPA(C1=__builtin_amdgcn_mfma_f32_32x32x16_bf16(kf[5],qr[2],C1,0,0,0),   P1[6],P1[7],P1[8],P1[9],     pw2[2]=PKW(P1,4), pw2[3]=PKW(P1,6), pw2); \
    VRD(3); SBAR(); GAPA(C0=__builtin_amdgcn_mfma_f32_32x32x16_bf16(kf[6],qr[3],C0,0,0,0),   P1[10],P1[11],P1[12],P1[13], pw3[0]=PKW(P1,8), pw3[1]=PKW(P1,10), pw3); \
    VRD(7); SBAR(); GAPA(C1=__builtin_amdgcn_mfma_f32_32x32x16_bf16(kf[7],qr[3],C1,0,0,0),   P1[14],P1[15],0.f,0.f,       pw3[2]=PKW(P1,12),pw3[3]=PKW(P1,14), pw3); \
    l_reg+=sacc; \
    if(GK){DMA_K((t)+3,sl_cur);} if(GV){DMA_V((t)+1,sl_next);} \
    MAPPLY(C0,C1); \
    { float a=MX3(C0[0],C0[1],C1[0]),b=MX3(C0[2],C0[3],C1[1]); a=MX3(a,C1[2],C1[3]); \
      _Pragma("unroll") for(int r=4;r<16;r+=4){a=MX3(a,C0[r],C0[r+1]);b=MX3(b,C0[r+2],C0[r+3]);a=MX3(a,C1[r],C1[r+1]);b=MX3(b,C1[r+2],C1[r+3]);} \
      float rm=__builtin_fmaxf(a,b); { auto rr=__builtin_amdgcn_permlane32_swap(__float_as_uint(rm),__float_as_uint(rm),false,false); rm=__builtin_fmaxf(__uint_as_float(rr[0]),__uint_as_float(rr[1])); } \
      resc=false; \
      const float rl=rm-mhat; \
      if(__builtin_expect(__any(rl>(float)THRL),0)){ const float dl=__builtin_fmaxf(rl,0.f); mhat+=dl; \
        const float f=__builtin_amdgcn_exp2f(-dl); l_reg*=f; if(hi==0)wsf[r32]=f; resc=true; } \
      _Pragma("unroll") for(int r=0;r<16;++r){C0[r]-=mhat;C1[r]-=mhat;} } \
    SBAR(); \
    GAPB(o[0]=__builtin_amdgcn_mfma_f32_32x32x16_bf16(PAF(0),VFR(0),o[0],0,0,0), C0,0); \
    GAPB(o[1]=__builtin_amdgcn_mfma_f32_32x32x16_bf16(PAF(0),VFR(4),o[1],0,0,0), C0,4); \
    KRD(GL,0); GAPB(o[0]=__builtin_amdgcn_mfma_f32_32x32x16_bf16(PAF(1),VFR(1),o[0],0,0,0), C0,8); \
    KRD(GL,1); GAPB(o[1]=__builtin_amdgcn_mfma_f32_32x32x16_bf16(PAF(1),VFR(5),o[1],0,0,0), C0,12); \
    KRD(GL,2); GAPB(o[0]=__builtin_amdgcn_mfma_f32_32x32x16_bf16(PAF(2),VFR(2),o[0],0,0,0), C1,0); \
    KRD(GL,3); GAPB(o[1]=__builtin_amdgcn_mfma_f32_32x32x16_bf16(PAF(2),VFR(6),o[1],0,0,0), C1,4); \
    GAPB(o[0]=__builtin_amdgcn_mfma_f32_32x32x16_bf16(PAF(3),VFR(3),o[0],0,0,0), C1,8); \
    GAPB(o[1]=__builtin_amdgcn_mfma_f32_32x32x16_bf16(PAF(3),VFR(7),o[1],0,0,0), C1,12); \
    }while(0)
  int t=1;
  for(;t+5<NT;t+=2){
    STEP(pB0,pB1,pA0,pA1,t,true,true,true);     WAIT_BAR(2); RESC(); ROT();
    STEP(pA0,pA1,pB0,pB1,t+1,true,true,true);   WAIT_BAR(2); RESC(); ROT();
  }
  #define ENDW(tt) do{ if((tt)+3<NT){WAIT_BAR(2);} else if((tt)+2<NT){WAIT_BAR(1);} else {WAIT_BAR(0);} }while(0)
  for(;t+1<NT;t+=2){
    STEP(pB0,pB1,pA0,pA1,t,(t+3<NT),(t+1<NT),(t+1<NT));       ENDW(t);   RESC(); ROT();
    STEP(pA0,pA1,pB0,pB1,t+1,(t+4<NT),(t+2<NT),(t+2<NT));     ENDW(t+1); RESC(); ROT();
  }
  STEP(pB0,pB1,pA0,pA1,NT-1,false,false,false); RESC();
  { float sacc=pB0[0]+pB0[1]; _Pragma("unroll") for(int r=2;r<16;++r)sacc+=pB0[r]; _Pragma("unroll") for(int r=0;r<16;++r)sacc+=pB1[r]; l_reg+=sacc;
    pw0=(u32x4){PKW(pB0,0),PKW(pB0,2),PKW(pB0,4),PKW(pB0,6)};pw1=(u32x4){PKW(pB0,8),PKW(pB0,10),PKW(pB0,12),PKW(pB0,14)};pw2=(u32x4){PKW(pB1,0),PKW(pB1,2),PKW(pB1,4),PKW(pB1,6)};pw3=(u32x4){PKW(pB1,8),PKW(pB1,10),PKW(pB1,12),PKW(pB1,14)};
    SBAR(); pv(o,vb0+sl_cur,PAF(0),PAF(1),PAF(2),PAF(3)); }
  #undef PKW
  #undef PAF
  #undef VFR
  #undef PIN
  #undef MX3
  #undef GAPA
  #undef GAPB
  #undef EX
  #undef VRD
  #undef KRD
  #undef STEP
  #undef ENDW
  {auto rr=__builtin_amdgcn_permlane32_swap(__float_as_uint(l_reg),__float_as_uint(l_reg),false,false);l_reg=__uint_as_float(rr[0])+__uint_as_float(rr[1]);}
  if(hi==0)wsf[32+r32]=l_reg;asm volatile("s_waitcnt lgkmcnt(0)":::"memory");
  float rli[16];
  #pragma unroll
  for(int r=0;r<16;++r)rli[r]=__builtin_amdgcn_rcpf(wsf[32+crow(r,hi)]);
  bf16*Ow=O+(rowbase+q0+wid*QBLK)*DMO+h*D;
  { bf16*stg=(bf16*)(shm+LDS_OST)+wid*2048;
    #pragma unroll
    for(int r=0;r<16;++r){const int orow=crow(r,hi);
      #pragma unroll
      for(int d0=0;d0<2;++d0)stg[orow*64+d0*32+r32]=__float2bfloat16(o[d0][r]*rli[r]);}
    asm volatile("s_waitcnt lgkmcnt(0)":::"memory");
    #pragma unroll
    for(int i=0;i<4;++i){const int row=i*8+(lane>>3),ch=lane&7; const u32x4 v=*(const u32x4*)(stg+row*64+ch*8); ATTN_STORE16(Ow+(long)row*DMO+ch*8,v);} }
  asm volatile("s_waitcnt lgkmcnt(0)\n\ts_barrier":::"memory");
  #undef DMA_K
  #undef DMA_V
  #undef MLOAD
  #undef MK64
  #undef MAPPLY
  #undef START
  #undef RESC
  #undef ROT
}
constexpr int ATTN_LDS_BYTES=LDS_BYTES;
struct AttnTensors { const bf16* Q; const bf16* K; const bf16* V; bf16* O; const unsigned long long* MT; };
struct AttnUnit { int bh; int qb; };
struct StaticOrder {
  int vcu;
  __device__ __forceinline__ explicit StaticOrder(int grid,int block):vcu((block%8)*(grid/8)+block/8){}
  __device__ __forceinline__ bool next(int i,AttnUnit&u)const{ if(i>=2)return false; const int s=vcu&3; u.bh=vcu>>2; u.qb=(i==0)?s:7-s; return true; }
  __device__ __forceinline__ void a_ready(const AttnUnit&)const{}
  __device__ __forceinline__ void done(const AttnUnit&)const{}
};
template<class Sched,int THRL=8> __device__ __forceinline__ void attn_phase(char*lds,const AttnTensors&T,const Sched&S){
  AttnUnit u;
  for(int i=0;S.next(i,u);++i){ S.a_ready(u); attn_unit<THRL>(u.bh/NHEAD,u.bh%NHEAD,u.qb,T.Q,T.K,T.V,T.O,T.MT,lds); S.done(u); }
}
#undef SBAR
#undef WAIT_BAR
}
#define XB_TMO      128
#define XB_XCNT(j)  (256  + 64 * (j))
#define XB_XSUB(j)  (1280 + 64 * (j))
#define XB_XGEN(j)  (2304 + 64 * (j))
#define XB_TOP      3328
#define XB_TOPGEN   3392
#define XCD_BAR_WORDS 3456
#define XB_SPIN_CAP (1u << 18)

__device__ __forceinline__ unsigned xb_ld(unsigned* p)              { return __hip_atomic_load(p, __ATOMIC_RELAXED, __HIP_MEMORY_SCOPE_AGENT); }
__device__ __forceinline__ unsigned xb_add(unsigned* p, unsigned v) { return __hip_atomic_fetch_add(p, v, __ATOMIC_RELAXED, __HIP_MEMORY_SCOPE_AGENT); }
__device__ __forceinline__ unsigned xb_xcc_id() { return (unsigned)__builtin_amdgcn_s_getreg((3 << 11) | 20) & 0xFu; }
#define XB_SPIN(cond, bar) do { unsigned _sp = 0; while (cond) { __builtin_amdgcn_s_sleep(1); \
    if ((++_sp & 255u) == 0u) { if (xb_ld(&(bar)[XB_TMO])) break; if (_sp > XB_SPIN_CAP) { atomicAdd(&(bar)[XB_TMO], 1u); break; } } } } while (0)

struct XcdBarrier {
    unsigned* bar; unsigned x;
    volatile LAS unsigned* st;
};

__device__ __forceinline__ XcdBarrier xcd_barrier_post(unsigned* bar, volatile LAS unsigned* st) {
    XcdBarrier b; b.bar = bar; b.x = xb_xcc_id(); b.st = st;
    if (threadIdx.x == 0) (void)xb_add(&bar[XB_XCNT(b.x)], 1u);
    return b;
}
__device__ __forceinline__ void xcd_barrier_complete(unsigned* bar, unsigned x, unsigned& nloc, unsigned& nx) {
    const unsigned G = gridDim.x * gridDim.y * gridDim.z;
    unsigned sum, cnt, mine, sp = 0u;
    for (;;) {
        sum = 0u; cnt = 0u; mine = 0u;
#pragma unroll
        for (unsigned j = 0; j < 16; ++j) { const unsigned c = xb_ld(&bar[XB_XCNT(j)]); sum += c; cnt += (c > 0u) ? 1u : 0u; mine = (j == x) ? c : mine; }
        if (sum == G) break;
        __builtin_amdgcn_s_sleep(1);
        if ((++sp & 255u) == 0u) { if (xb_ld(&bar[XB_TMO])) break; if (sp > XB_SPIN_CAP) { atomicAdd(&bar[XB_TMO], 1u); break; } }
    }
    nloc = mine > 0u ? mine : 1u; nx = cnt > 0u ? cnt : 1u;
}

__device__ __forceinline__ void xcd_barrier(const XcdBarrier& b) {
    asm volatile("s_waitcnt vmcnt(0)" ::: "memory");
    __syncthreads();
    if (threadIdx.x == 0) {
        unsigned* bar = b.bar;
        __builtin_amdgcn_s_waitcnt(0);
        unsigned nloc = b.st[0], nx = b.st[1];
        if (nloc == 0u) { xcd_barrier_complete(bar, b.x, nloc, nx); b.st[0] = nloc; b.st[1] = nx; }
        const unsigned old = xb_add(&bar[XB_XSUB(b.x)], 1u);
        const unsigned gen = old / nloc;
        if (old + 1u == (gen + 1u) * nloc) {
            __builtin_amdgcn_fence(__ATOMIC_RELEASE, "agent");
            asm volatile("s_waitcnt vmcnt(0)" ::: "memory");
            const unsigned og = xb_add(&bar[XB_TOP], 1u);
            const unsigned tg = og / nx;
            if (og + 1u == (tg + 1u) * nx) xb_add(&bar[XB_TOPGEN], 1u);
            else XB_SPIN(xb_ld(&bar[XB_TOPGEN]) == tg, bar);
            __builtin_amdgcn_fence(__ATOMIC_ACQUIRE, "agent");
            xb_add(&bar[XB_XGEN(b.x)], 1u);
            asm volatile("s_waitcnt vmcnt(0)" ::: "memory");
        } else {
            XB_SPIN(xb_ld(&bar[XB_XGEN(b.x)]) == gen, bar);
            __builtin_amdgcn_fence(__ATOMIC_ACQUIRE, "agent");
            asm volatile("s_waitcnt vmcnt(0)" ::: "memory");
        }
    }
    __syncthreads();
}
#define GAS __attribute__((address_space(1)))
#ifndef LAS
#define LAS __attribute__((address_space(3)))
#endif
typedef unsigned short bf16;
typedef unsigned v4u __attribute__((ext_vector_type(4)));
typedef float f32x4 __attribute__((ext_vector_type(4)));
#define LDS_WAIT() asm volatile("s_waitcnt lgkmcnt(0)" ::: "memory")
#define VM_WAIT() asm volatile("s_waitcnt vmcnt(0)" ::: "memory")

constexpr int D = 1024, NB = 8, T = 2048, MP = NB * T, NSMP = 32, MT = MP + NSMP, MPAD = 16640;
constexpr int ATT_W = 512, AH = 8, IH = 16, IDD = 64, TOPK = 256;
constexpr int RW_W = 512, RH = 8, RN = 64;
constexpr int RW_COLS = 1792, IN_COLS = 4432, NIN = 4608;
constexpr int FFN = 2816, NGU = 2 * FFN;
constexpr int NPAGES = 64, PAGE = 128, PAST = 8192, LS = PAST + 1, SCS_LD = 8704;
constexpr int O_Q = 0, O_K = 512, O_V = 1024, O_QI = 1536, O_KI = 2560, O_WI = 2624, O_RW = 2640;
constexpr float IDX_W_SCALE = 0.03125f;
constexpr float RMS_EPS = 1e-6f, GN_EPS = 64e-5f;
constexpr int MODW = 6 * D;

constexpr size_t OUT_Y = 0, OUT_YS = OUT_Y + (size_t)MP * D, OUT_KP = OUT_YS + (size_t)NSMP * D, OUT_VP = OUT_KP + (size_t)MP * ATT_W,
                 OUT_IKP = OUT_VP + (size_t)MP * ATT_W, OUT_WKVP = OUT_IKP + (size_t)MP * IDD, OUT_SHP = OUT_WKVP + (size_t)NB * RH * RN * RN,
                 OUT_KS = OUT_SHP + (size_t)NB * RW_COLS, OUT_VS = OUT_KS + (size_t)NSMP * ATT_W, OUT_IKS = OUT_VS + (size_t)NSMP * ATT_W,
                 OUT_WKVS = OUT_IKS + (size_t)NSMP * IDD, OUT_SHS = OUT_WKVS + (size_t)NSMP * RH * RN * RN, OUT_END = OUT_SHS + (size_t)NSMP * RW_COLS;
static_assert(OUT_END == 36052992, "output size");

constexpr size_t MiB = 1u << 20;
constexpr size_t WS_CTL = 0, CTL_ZERO_BYTES = 1 * MiB;
constexpr size_t WS_MOD = 1 * MiB;
constexpr size_t WS_WIN = 2 * MiB;
constexpr size_t WS_WOUT = 12 * MiB;
constexpr size_t WS_WGU = 14 * MiB;
constexpr size_t WS_WDN = 26 * MiB;
constexpr size_t WS_A1 = 32 * MiB;
constexpr size_t WS_A2 = 66 * MiB;
constexpr size_t WS_MIX = 100 * MiB;
constexpr size_t WS_HB = 134 * MiB;
constexpr size_t WS_X1 = 224 * MiB;
constexpr size_t WS_PROJ = 290 * MiB;
constexpr size_t WS_PRW = 290 * MiB;
constexpr size_t WS_RAW = 584 * MiB;
constexpr size_t WS_RAW2 = 650 * MiB;
constexpr size_t WS_QN = 1008 * MiB;
constexpr size_t WS_RWA = 1042 * MiB, RWA_STRIDE = 33 * MiB;
constexpr size_t WS_Y = 1273 * MiB;
constexpr size_t WS_SC = 1306 * MiB;
constexpr size_t WS_SCS = 1434 * MiB;
constexpr size_t WS_MASK = 1436 * MiB;
constexpr size_t WS_SLIST = 1440 * MiB;
constexpr size_t WS_QB = 1444 * MiB, WS_KB = 1461 * MiB, WS_VB = 1478 * MiB;
constexpr size_t WS_MASKT = 1495 * MiB;
constexpr size_t WS_QIB = 1500 * MiB;
constexpr size_t WS_KIB = 1536 * MiB;
constexpr size_t WS_WI = 1539 * MiB;
constexpr size_t WS_LIN = 1541 * MiB;
constexpr size_t WS_KX = 1550 * MiB;
constexpr size_t WS_W2T = 1583 * MiB, WS_A2T = 1584 * MiB, WS_G2T = 1585 * MiB;
constexpr size_t WS_MF = 1586 * MiB, WS_NT = 1603 * MiB, WS_PF = 1636 * MiB, WS_QP = 1653 * MiB, WS_ZF = 1686 * MiB;
constexpr size_t WS_Y2 = 1703 * MiB;
constexpr size_t WS_END = 1736 * MiB;
constexpr int QI_LD = 17 * 64;
constexpr int CW_BAR = 4096;

constexpr int NWAVES = 8, NTHREADS = 512;
constexpr int LDS_BYTES = 147456, MISC_OFF = 147200;

__device__ __forceinline__ unsigned f2bf(float f) { unsigned u = __builtin_bit_cast(unsigned, f); return (u + 0x7fffu + ((u >> 16) & 1u)) >> 16; }
__device__ __forceinline__ unsigned pk2(float lo, float hi) { return f2bf(lo) | (f2bf(hi) << 16); }
__device__ __forceinline__ float wave_sum(float v) {
#pragma unroll
    for (int o = 1; o < 64; o <<= 1) v += __shfl_xor(v, o);
    return v;
}
__device__ __forceinline__ float wave_max(float v) {
#pragma unroll
    for (int o = 1; o < 64; o <<= 1) v = fmaxf(v, __shfl_xor(v, o));
    return v;
}
__device__ __forceinline__ int wave_sum_i(int v) {
#pragma unroll
    for (int o = 1; o < 64; o <<= 1) v += __shfl_xor(v, o);
    return v;
}
__device__ __forceinline__ float sigmoidf_(float x) { return 1.f / (1.f + expf(-x)); }
__device__ __forceinline__ unsigned sortable(float f) { const unsigned u = __builtin_bit_cast(unsigned, f); return (u & 0x80000000u) ? ~u : (u | 0x80000000u); }
__device__ __forceinline__ unsigned long long lanemask_lt(int lane) { return (1ull << lane) - 1ull; }
__device__ __forceinline__ float rdlane(float v, int l) { return __builtin_bit_cast(float, __builtin_amdgcn_readlane(__builtin_bit_cast(int, v), l)); }

struct Args { const float* in[32]; float* out; unsigned char* ws; int ph_lo, ph_hi; };

struct Ctx {
    LAS unsigned char* lds;
    int tid, lane, wave, G, gw, ngw;
    const float* const* in; float* out; unsigned char* ws;
};
__device__ __forceinline__ const float* x_row(const Ctx& C, int m) { return m < MP ? C.in[0] + (size_t)m * D : C.in[1] + (size_t)(m - MP) * D; }
__device__ __forceinline__ int mod_row(int m) { return m < MP ? (m >> 11) : NB + (m - MP); }

struct EpiRawF32 {
    static constexpr bool PERM = false, AFTER_DRAIN = false;
    float* O; int ldc;
    __device__ __forceinline__ void operator()(const pg8::f32x4 (&acc)[2][2][4][2], const pg8::Unit& u, int wr, int wc, int fr, int fq) const {
        const int row0 = u.pm * 256 + wr * 64 + fr, col0 = u.pn * 256 + wc * 32 + 4 * fq;
#pragma unroll
        for (int ai = 0; ai < 2; ++ai)
#pragma unroll
            for (int m = 0; m < 4; ++m) { float* rowp = O + (size_t)(row0 + ai * 128 + m * 16) * ldc + col0;
#pragma unroll
                for (int bj = 0; bj < 2; ++bj)
#pragma unroll
                    for (int n = 0; n < 2; ++n) *(pg8::f32x4*)(rowp + bj * 128 + n * 16) = acc[ai][bj][m][n]; }
    }
};

struct EpiResGate {
    static constexpr bool PERM = false, AFTER_DRAIN = false;
    const float* base; const float* gate; float* out;
    __device__ __forceinline__ void operator()(const pg8::f32x4 (&acc)[2][2][4][2], const pg8::Unit& u, int wr, int wc, int fr, int fq) const {
        const int row0 = u.pm * 256 + wr * 64 + fr, col0 = u.pn * 256 + wc * 32 + 4 * fq;
        const float* gp = gate + (size_t)((u.pm * 256) >> 11) * MODW + col0;
        pg8::f32x4 gv[2][2];
#pragma unroll
        for (int bj = 0; bj < 2; ++bj)
#pragma unroll
            for (int n = 0; n < 2; ++n) gv[bj][n] = *(const pg8::f32x4*)(gp + bj * 128 + n * 16);
#pragma unroll
        for (int ai = 0; ai < 2; ++ai)
#pragma unroll
            for (int m = 0; m < 4; ++m) { const size_t off = (size_t)(row0 + ai * 128 + m * 16) * D + col0;
#pragma unroll
                for (int bj = 0; bj < 2; ++bj)
#pragma unroll
                    for (int n = 0; n < 2; ++n) { const pg8::f32x4 bv = *(const pg8::f32x4*)(base + off + bj * 128 + n * 16);
                        *(pg8::f32x4*)(out + off + bj * 128 + n * 16) = bv + gv[bj][n] * acc[ai][bj][m][n]; } }
    }
};
struct EpiIn {
    static constexpr bool PERM = true, AFTER_DRAIN = false;
    unsigned char* ws; float* out; const float* qg; const float* kg;
    __device__ __forceinline__ void operator()(const pg8::f32x4 (&acc)[2][2][4][2], const pg8::Unit& u, int wr, int wc, int fr, int fq) const {
        const int pn = u.pn; const bool smp = u.pm == MP / 256;
        bf16* QB = (bf16*)(ws + WS_QB); bf16* KB = (bf16*)(ws + WS_KB); bf16* VB = (bf16*)(ws + WS_VB); bf16* QIb = (bf16*)(ws + WS_QIB); bf16* KIb = (bf16*)(ws + WS_KIB);
        float* QN = (float*)(ws + WS_QN); float* WI = (float*)(ws + WS_WI); float* PRW = (float*)(ws + WS_PRW);
        float gq[2][8];
        if (pn < 4) {
#pragma unroll
            for (int bj = 0; bj < 2; ++bj)
#pragma unroll
                for (int e = 0; e < 8; ++e) gq[bj][e] = (pn < 2 ? qg : kg)[32 * bj + 8 * fq + e] * (pn < 2 ? attn_body::C2 : 1.f);
        }
#pragma unroll
        for (int ai = 0; ai < 2; ++ai)
#pragma unroll
            for (int m = 0; m < 4; ++m) {
                const int r = u.pm * 256 + ai * 128 + wr * 64 + m * 16 + fr; const bool ok = r < MT;
                float v[2][8];
#pragma unroll
                for (int bj = 0; bj < 2; ++bj)
#pragma unroll
                    for (int n = 0; n < 2; ++n)
#pragma unroll
                        for (int i = 0; i < 4; ++i) v[bj][4 * n + i] = acc[ai][bj][m][n][i];
                float rstd = 1.f;
                if (pn < 4 || (pn == 10 && wc == 0)) { float ss = 0.f;
#pragma unroll
                    for (int bj = 0; bj < 2; ++bj)
#pragma unroll
                        for (int e = 0; e < 8; ++e) ss += v[bj][e] * v[bj][e];
                    ss += __shfl_xor(ss, 16); ss += __shfl_xor(ss, 32);
                    rstd = 1.f / sqrtf(ss * (1.f / 64.f) + RMS_EPS); }
                if (!ok) continue;
#pragma unroll
                for (int bj = 0; bj < 2; ++bj) {
                    const int cl = 32 * bj + 8 * fq;
                    float* x = v[bj];
                    if (pn < 2) {
                        const int col = (4 * pn + wc) * 64 + cl; pg8::u32x4 w;
                        w.x = pg8::cvt_pk_bf16(x[0] * rstd * gq[bj][0], x[1] * rstd * gq[bj][1]); w.y = pg8::cvt_pk_bf16(x[2] * rstd * gq[bj][2], x[3] * rstd * gq[bj][3]);
                        w.z = pg8::cvt_pk_bf16(x[4] * rstd * gq[bj][4], x[5] * rstd * gq[bj][5]); w.w = pg8::cvt_pk_bf16(x[6] * rstd * gq[bj][6], x[7] * rstd * gq[bj][7]);
                        *(pg8::u32x4*)(QB + (size_t)r * ATT_W + col) = w;
                        if (smp) { const float ic = 1.f / attn_body::C2; float* qn = QN + (size_t)r * ATT_W + col;
                            *(pg8::f32x4*)qn = (pg8::f32x4){x[0] * rstd * gq[bj][0] * ic, x[1] * rstd * gq[bj][1] * ic, x[2] * rstd * gq[bj][2] * ic, x[3] * rstd * gq[bj][3] * ic};
                            *(pg8::f32x4*)(qn + 4) = (pg8::f32x4){x[4] * rstd * gq[bj][4] * ic, x[5] * rstd * gq[bj][5] * ic, x[6] * rstd * gq[bj][6] * ic, x[7] * rstd * gq[bj][7] * ic}; }
                    } else if (pn < 6) {
                        const bool isk = pn < 4; const int col = (4 * (pn & 1) + wc) * 64 + cl; float y[8];
#pragma unroll
                        for (int e = 0; e < 8; ++e) y[e] = isk ? x[e] * rstd * gq[bj][e] : x[e];
                        float* o = out + (isk ? (smp ? OUT_KS : OUT_KP) : (smp ? OUT_VS : OUT_VP)) + (size_t)(smp ? r - MP : r) * ATT_W + col;
                        *(pg8::f32x4*)o = (pg8::f32x4){y[0], y[1], y[2], y[3]}; *(pg8::f32x4*)(o + 4) = (pg8::f32x4){y[4], y[5], y[6], y[7]};
                        pg8::u32x4 w; w.x = pg8::cvt_pk_bf16(y[0], y[1]); w.y = pg8::cvt_pk_bf16(y[2], y[3]); w.z = pg8::cvt_pk_bf16(y[4], y[5]); w.w = pg8::cvt_pk_bf16(y[6], y[7]);
                        *(pg8::u32x4*)((isk ? KB : VB) + (size_t)r * ATT_W + col) = w;
                    } else if (pn < 10) {
                        const int col = (4 * (pn - 6) + wc) * 64 + cl;
                        pg8::u32x4 w; w.x = pg8::cvt_pk_bf16(x[0], x[1]); w.y = pg8::cvt_pk_bf16(x[2], x[3]); w.z = pg8::cvt_pk_bf16(x[4], x[5]); w.w = pg8::cvt_pk_bf16(x[6], x[7]);
                        *(pg8::u32x4*)(QIb + (size_t)r * QI_LD + col) = w;
                    } else if (pn == 10) {
                        if (wc == 0) {
                            float* o = out + (smp ? OUT_IKS : OUT_IKP) + (size_t)(smp ? r - MP : r) * IDD + cl;
                            *(pg8::f32x4*)o = (pg8::f32x4){x[0] * rstd, x[1] * rstd, x[2] * rstd, x[3] * rstd}; *(pg8::f32x4*)(o + 4) = (pg8::f32x4){x[4] * rstd, x[5] * rstd, x[6] * rstd, x[7] * rstd};
                            pg8::u32x4 w; w.x = pg8::cvt_pk_bf16(x[0] * rstd, x[1] * rstd); w.y = pg8::cvt_pk_bf16(x[2] * rstd, x[3] * rstd); w.z = pg8::cvt_pk_bf16(x[4] * rstd, x[5] * rstd); w.w = pg8::cvt_pk_bf16(x[6] * rstd, x[7] * rstd);
                            *(pg8::u32x4*)(KIb + (size_t)r * IDD + cl) = w;
                        } else if (wc == 1) {
                            if (bj == 0 && fq < 2) { float* o = WI + (size_t)r * IH + 8 * fq; *(pg8::f32x4*)o = (pg8::f32x4){x[0], x[1], x[2], x[3]}; *(pg8::f32x4*)(o + 4) = (pg8::f32x4){x[4], x[5], x[6], x[7]}; }
                        } else {
                            float* o = PRW + (size_t)r * RW_COLS + 1536 + 64 * (wc - 2) + cl;
                            *(pg8::f32x4*)o = (pg8::f32x4){x[0], x[1], x[2], x[3]}; *(pg8::f32x4*)(o + 4) = (pg8::f32x4){x[4], x[5], x[6], x[7]}; }
                    } else if (pn < 17) {
                        float* o = PRW + (size_t)r * RW_COLS + (pn - 11) * 256 + 64 * wc + cl;
                        *(pg8::f32x4*)o = (pg8::f32x4){x[0], x[1], x[2], x[3]}; *(pg8::f32x4*)(o + 4) = (pg8::f32x4){x[4], x[5], x[6], x[7]};
                    } else if (wc < 2) {
                        float* o = PRW + (size_t)r * RW_COLS + 1664 + 64 * wc + cl;
                        *(pg8::f32x4*)o = (pg8::f32x4){x[0], x[1], x[2], x[3]}; *(pg8::f32x4*)(o + 4) = (pg8::f32x4){x[4], x[5], x[6], x[7]}; }
                }
            }
    }
};
struct EpiSwiGLU {
    static constexpr bool PERM = true, AFTER_DRAIN = false;
    bf16* H;
    __device__ __forceinline__ void operator()(const pg8::f32x4 (&acc)[2][2][4][2], const pg8::Unit& u, int wr, int wc, int fr, int fq) const {
        const int row0 = u.pm * 256 + wr * 64 + fr, col0 = u.pn * 128 + wc * 32 + 8 * fq;
#pragma unroll
        for (int ai = 0; ai < 2; ++ai)
#pragma unroll
            for (int m = 0; m < 4; ++m) { float hv[8];
#pragma unroll
                for (int n = 0; n < 2; ++n)
#pragma unroll
                    for (int i = 0; i < 4; ++i) { const float g = acc[ai][0][m][n][i], up = acc[ai][1][m][n][i]; hv[4 * n + i] = g * __builtin_amdgcn_rcpf(1.f + __expf(-g)) * up; }
                pg8::u32x4 w; w.x = pg8::cvt_pk_bf16(hv[0], hv[1]); w.y = pg8::cvt_pk_bf16(hv[2], hv[3]); w.z = pg8::cvt_pk_bf16(hv[4], hv[5]); w.w = pg8::cvt_pk_bf16(hv[6], hv[7]);
                *(pg8::u32x4*)(H + (size_t)(row0 + ai * 128 + m * 16) * FFN + col0) = w; }
    }
};
template <class F> __device__ __forceinline__ void sample_gemm(const Ctx& C, const bf16* A, const bf16* Bt, int K, const F& f) {
    typedef short bf16x8 __attribute__((ext_vector_type(8))); typedef float f32x16 __attribute__((ext_vector_type(16)));
    LAS float* red = (LAS float*)C.lds;
    const int lane = C.lane, hi = lane >> 5, ksteps = K / 16 / NWAVES;
    for (int u = (int)blockIdx.x - 128; u >= 0 && u < D / 32; u += C.G) {
        const int n0 = 32 * u;
        const bf16* ap = A + (size_t)(lane & 31) * K + (size_t)C.wave * ksteps * 16 + 8 * hi; const bf16* bp = Bt + (size_t)(n0 + (lane & 31)) * K + (size_t)C.wave * ksteps * 16 + 8 * hi;
        f32x16 acc = f32x16{};
        for (int ks = 0; ks < ksteps; ++ks) acc = __builtin_amdgcn_mfma_f32_32x32x16_bf16(*(const bf16x8*)(ap + 16 * ks), *(const bf16x8*)(bp + 16 * ks), acc, 0, 0, 0);
        __syncthreads();
#pragma unroll
        for (int r = 0; r < 16; ++r) red[(C.wave * 64 + lane) * 16 + r] = acc[r];
        __syncthreads();
        for (int o = C.tid; o < 1024; o += NTHREADS) { const int ls = o & 63, r = o >> 6; float v = 0.f;
#pragma unroll
            for (int w = 0; w < 8; ++w) v += red[(w * 64 + ls) * 16 + r];
            f((r & 3) + 8 * (r >> 2) + 4 * (ls >> 5), n0 + (ls & 31), v); }
    }
    __syncthreads();
}

__device__ __forceinline__ void p0_mod(const Ctx& C) {
    LAS float* sc = (LAS float*)C.lds;
    const float* cp = C.in[8]; const float* cs = C.in[9]; const float* wada = C.in[12]; const float* bada = C.in[13];
    float* MOD = (float*)(C.ws + WS_MOD);
    const int cl = C.tid & 31, kc = C.tid >> 5;
    for (int u = blockIdx.x; u < MODW / 32; u += C.G) {
        const int c0 = 32 * u;
        float acc[40];
#pragma unroll
        for (int r = 0; r < 40; ++r) acc[r] = 0.f;
        for (int hh = 0; hh < 2; ++hh) {
            __syncthreads();
            for (int i = C.tid; i < 40 * 512; i += NTHREADS) { const int r = i >> 9, kk = i & 511; const float v = (r < NB) ? cp[r * D + 512 * hh + kk] : cs[(r - NB) * D + 512 * hh + kk]; sc[i] = v / (1.f + expf(-v)); }
            __syncthreads();
            const int kb = 512 * hh + 32 * kc;
            for (int k4 = 0; k4 < 8; ++k4) {
                const float* wp = wada + (size_t)(kb + 4 * k4) * MODW + c0 + cl;
                const float w0 = wp[0], w1 = wp[MODW], w2 = wp[2 * MODW], w3 = wp[3 * MODW];
#pragma unroll
                for (int r = 0; r < 40; ++r) { const f32x4 s = *(const LAS f32x4*)(sc + r * 512 + 32 * kc + 4 * k4); acc[r] += s.x * w0 + s.y * w1 + s.z * w2 + s.w * w3; }
            }
        }
        __syncthreads();
#pragma unroll
        for (int r = 0; r < 40; ++r) sc[(kc * 40 + r) * 32 + cl] = acc[r];
        __syncthreads();
        for (int i = C.tid; i < 40 * 32; i += NTHREADS) { const int r = i >> 5, c = i & 31; float s = 0.f;
            for (int k = 0; k < 16; ++k) s += sc[(k * 40 + r) * 32 + c];
            MOD[r * MODW + c0 + c] = s + bada[c0 + c]; }
    }
    __syncthreads();
}
template <int MODE = 0> __device__ __forceinline__ void transpose_item(const float* W, int K, int N, int NP, bf16* WT, int row_off, LAS float* scr, int item, int lane) {
    const int nblk = NP / 32, kb = item / nblk, nb = item % nblk, k0 = 64 * kb, n0 = 32 * nb;
    const int nsrc = n0 + (lane & 31);
#pragma unroll 8
    for (int i = 0; i < 32; ++i) { const int kk = 2 * i + (lane >> 5); scr[kk * 33 + (lane & 31)] = (nsrc < N) ? W[(size_t)(k0 + kk) * N + nsrc] : 0.f; }
    LDS_WAIT(); asm volatile("" ::: "memory");
    const int c = lane & 7;
#pragma unroll
    for (int j = 0; j < 4; ++j) { const int n = (lane >> 3) + 8 * j; const LAS float* s = scr + (8 * c) * 33 + n;
        v4u o; o.x = pk2(s[0 * 33], s[1 * 33]); o.y = pk2(s[2 * 33], s[3 * 33]); o.z = pk2(s[4 * 33], s[5 * 33]); o.w = pk2(s[6 * 33], s[7 * 33]);
        const int nn = n0 + n; int drow;
        if (MODE == 0) drow = row_off + nn;
        else if (MODE == 3) { int tile, L;
            if (nn < 2560) { tile = nn >> 8; L = nn & 255; } else if (nn < 2624) { tile = 10; L = nn - 2560; } else if (nn < 2640) { tile = 10; L = 64 + (nn - 2624); }
            else if (nn < 4176) { tile = 11 + ((nn - 2640) >> 8); L = (nn - 2640) & 255; } else if (nn < 4240) { tile = 10; L = 128 + (nn - 4176); } else if (nn < 4304) { tile = 10; L = 192 + (nn - 4240); }
            else { tile = 17; L = nn - 4304; }
            drow = 256 * tile + 128 * ((L >> 5) & 1) + 32 * (L >> 6) + (L & 31); }
        else drow = 256 * (nn >> 7) + (nn & 127) + (MODE == 2 ? 128 : 0);
        if (MODE != 3 || nn < N) *(GAS v4u*)(WT + (size_t)drow * K + k0 + 8 * c) = o; }
    LDS_WAIT(); asm volatile("" ::: "memory");
}
__device__ __forceinline__ void p0_weights(const Ctx& C) {
    LAS float* scr = (LAS float*)(C.lds + C.wave * 16384);
    constexpr int I_IN = (D / 64) * 139, I_OUT = (D / 64) * (D / 32), I_G = (D / 64) * (FFN / 32), I_DN = (FFN / 64) * (D / 32);
    constexpr int I_L = RW_W / 32, NITEMS = I_IN + I_OUT + 2 * I_G + I_DN + 4 * I_L;
    bf16* WIN = (bf16*)(C.ws + WS_WIN); bf16* WOUT = (bf16*)(C.ws + WS_WOUT); bf16* WGU = (bf16*)(C.ws + WS_WGU); bf16* WDN = (bf16*)(C.ws + WS_WDN);
    for (int it = C.gw; it < NITEMS; it += C.ngw) {
        int r = it;
        if (r < I_IN) { transpose_item<3>(C.in[14], D, IN_COLS, 139 * 32, WIN, 0, scr, r, C.lane); continue; } r -= I_IN;
        if (r < I_OUT) { transpose_item(C.in[28], D, D, D, WOUT, 0, scr, r, C.lane); continue; } r -= I_OUT;
        if (r < I_G) { transpose_item<1>(C.in[29], D, FFN, FFN, WGU, 0, scr, r, C.lane); continue; } r -= I_G;
        if (r < I_G) { transpose_item<2>(C.in[30], D, FFN, FFN, WGU, 0, scr, r, C.lane); continue; } r -= I_G;
        if (r < I_DN) { transpose_item(C.in[31], FFN, D, D, WDN, 0, scr, r, C.lane); continue; } r -= I_DN;
        if (r < I_L) { transpose_item(C.in[19], 64, RW_W, RW_W, (bf16*)(C.ws + WS_W2T), 0, scr, r, C.lane); continue; } r -= I_L;
        if (r < I_L) { transpose_item(C.in[21], 64, RW_W, RW_W, (bf16*)(C.ws + WS_A2T), 0, scr, r, C.lane); continue; } r -= I_L;
        transpose_item(C.in[22], 128, RW_W, RW_W, (bf16*)(C.ws + WS_G2T), 0, scr, r, C.lane);
    }
    for (int i = C.gw; i < 176; i += C.ngw) { const int L = i < 48 ? 80 + i : 128 + (i - 48), tile = i < 48 ? 10 : 17;
        GAS v4u* rowp = (GAS v4u*)(WIN + (size_t)(256 * tile + 128 * ((L >> 5) & 1) + 32 * (L >> 6) + (L & 31)) * D);
        rowp[C.lane] = (v4u){0u, 0u, 0u, 0u}; rowp[64 + C.lane] = (v4u){0u, 0u, 0u, 0u}; }
}
__device__ __forceinline__ void norm_mod_row(const Ctx& C, int m, const float* xr, const float* g, const float* shift, const float* scale, bf16* orow) {
    const GAS f32x4* xp = (const GAS f32x4*)xr + C.lane;
    f32x4 v[4]; float s = 0.f;
#pragma unroll
    for (int j = 0; j < 4; ++j) { v[j] = xp[64 * j]; s += (v[j].x * v[j].x + v[j].y * v[j].y) + (v[j].z * v[j].z + v[j].w * v[j].w); }
    const float rstd = 1.f / sqrtf(wave_sum(s) * (1.f / D) + RMS_EPS);
    GAS unsigned long long* o8 = (GAS unsigned long long*)orow + C.lane;
#pragma unroll
    for (int j = 0; j < 4; ++j) { const int c = 4 * (C.lane + 64 * j);
        const f32x4 gg = *(const f32x4*)(g + c), sh = *(const f32x4*)(shift + c), sc = *(const f32x4*)(scale + c);
        const f32x4 h = v[j] * rstd * gg * (1.f + sc) + sh;
        o8[64 * j] = (unsigned long long)pk2(h.x, h.y) | ((unsigned long long)pk2(h.z, h.w) << 32); }
}
__device__ __forceinline__ void p1_norm1(const Ctx& C) {
    bf16* A1 = (bf16*)(C.ws + WS_A1); const float* MOD = (const float*)(C.ws + WS_MOD);
    for (int m = C.gw; m < MPAD; m += C.ngw) {
        bf16* orow = A1 + (size_t)m * D;
        if (m >= MT) { GAS unsigned long long* o8 = (GAS unsigned long long*)orow + C.lane;
#pragma unroll
            for (int j = 0; j < 4; ++j) o8[64 * j] = 0ull;
            continue; }
        const float* md = MOD + mod_row(m) * MODW;
        norm_mod_row(C, m, x_row(C, m), C.in[10], md, md + D, orow);
    }
}
__device__ __forceinline__ void p3_post(const Ctx& C) {
    const float* PROJ = (const float*)(C.ws + WS_PROJ); float* QN = (float*)(C.ws + WS_QN);
    const int lane = C.lane;
    const float qg = C.in[15][lane], kg = C.in[16][lane];
    for (int m = C.gw; m < MT; m += C.ngw) {
        const float* p = PROJ + (size_t)m * NIN;
        const bool smp = m >= MP; const int j = m - MP;
        float* ko = C.out + (smp ? OUT_KS + (size_t)j * ATT_W : OUT_KP + (size_t)m * ATT_W);
        float* vo = C.out + (smp ? OUT_VS + (size_t)j * ATT_W : OUT_VP + (size_t)m * ATT_W);
        float* io = C.out + (smp ? OUT_IKS + (size_t)j * IDD : OUT_IKP + (size_t)m * IDD);
        float* qn = QN + (size_t)m * ATT_W;
        bf16* qb = (bf16*)(C.ws + WS_QB) + (size_t)m * ATT_W; bf16* kb = (bf16*)(C.ws + WS_KB) + (size_t)m * ATT_W; bf16* vb = (bf16*)(C.ws + WS_VB) + (size_t)m * ATT_W;
        for (int h = 0; h < AH; ++h) {
            const float q = p[O_Q + h * 64 + lane], k = p[O_K + h * 64 + lane];
            const float sq = wave_sum(q * q), sk = wave_sum(k * k);
            const float qv = q * (1.f / sqrtf(sq * (1.f / 64.f) + RMS_EPS)) * qg, kv = k * (1.f / sqrtf(sk * (1.f / 64.f) + RMS_EPS)) * kg, vv = p[O_V + h * 64 + lane];
            qn[h * 64 + lane] = qv; ko[h * 64 + lane] = kv; vo[h * 64 + lane] = vv;
            qb[h * 64 + lane] = (bf16)f2bf(qv * attn_body::C2); kb[h * 64 + lane] = (bf16)f2bf(kv); vb[h * 64 + lane] = (bf16)f2bf(vv);
        }
        const float ki = p[O_KI + lane];
        const float kin = ki * (1.f / sqrtf(wave_sum(ki * ki) * (1.f / 64.f) + RMS_EPS));
        io[lane] = kin;
        ((bf16*)(C.ws + WS_KIB))[(size_t)m * IDD + lane] = (bf16)f2bf(kin);
        { bf16* qi = (bf16*)(C.ws + WS_QIB) + (size_t)m * QI_LD; float ql = 0.f;
          for (int h = 0; h < IH; ++h) { const float v = p[O_QI + h * 64 + lane]; qi[h * 64 + lane] = (bf16)f2bf(v); ql += p[O_WI + h] * v; }
          qi[IH * 64 + lane] = (bf16)f2bf(ql);
          if (lane < IH) ((float*)(C.ws + WS_WI))[(size_t)m * IH + lane] = p[O_WI + lane]; }
        if (smp || (m & (T - 1)) == T - 1) {
            float* so = C.out + (smp ? OUT_SHS + (size_t)j * RW_COLS : OUT_SHP + (size_t)(m >> 11) * RW_COLS);
            for (int i = 0; i < RW_COLS / 64; ++i) so[i * 64 + lane] = p[O_RW + i * 64 + lane];
        }
    }
}
__device__ __forceinline__ void p3_lin(const Ctx& C) {
    const float* PRW = (const float*)(C.ws + WS_PRW); const float* mu = C.in[17];
    const int lane = C.lane;
    for (int m = C.gw; m < MT; m += C.ngw) {
        const float* p = PRW + (size_t)m * RW_COLS;
        const bool smp = m >= MP; const int j = m - MP; const int t = m & (T - 1);
        if (smp || t == T - 1) { float* so = C.out + (smp ? OUT_SHS + (size_t)j * RW_COLS : OUT_SHP + (size_t)(m >> 11) * RW_COLS);
            for (int i = 0; i < RW_COLS / 64; ++i) so[i * 64 + lane] = p[i * 64 + lane]; }
        if (smp) continue;
        float x[4];
#pragma unroll
        for (int i = 0; i < 4; ++i) { const int c = 1536 + 64 * i + lane; const float cur = p[c], prv = t == 0 ? 0.f : p[c - RW_COLS]; x[i] = cur + (prv - cur) * mu[c]; }
        bf16* lin = (bf16*)(C.ws + WS_LIN) + (size_t)m * 256;
        lin[lane] = (bf16)f2bf(tanhf(x[0])); lin[64 + lane] = (bf16)f2bf(x[1]); lin[128 + lane] = (bf16)f2bf(sigmoidf_(x[2])); lin[192 + lane] = (bf16)f2bf(sigmoidf_(x[3]));
    }
}
__device__ __forceinline__ void smp_rwkv(const Ctx& C) {
    const float* PRW = (const float*)(C.ws + WS_PRW); bf16* MIX = (bf16*)(C.ws + WS_MIX);
    const float* mu = C.in[17]; const float* w0 = C.in[18]; const float* w2 = C.in[19]; const float* a0 = C.in[20]; const float* a2 = C.in[21]; const float* g2 = C.in[22];
    const float* k_k = C.in[23]; const float* k_a = C.in[24]; const float* r_k = C.in[25]; const float* ln_w = C.in[26]; const float* ln_b = C.in[27];
    LAS float* lw = (LAS float*)(C.lds + C.wave * 1024);
    const int lane = C.lane;
    for (int wu = C.gw; wu < NSMP * RH; wu += C.ngw) {
        const int j = wu / RH, h = wu % RH, c = h * 64 + lane;
        const float* p = PRW + (size_t)(MP + j) * RW_COLS; const float* pv = C.in[6] + (size_t)j * RW_COLS;
#define XM(cc) ({ const int c_ = (cc); const float cur_ = p[c_]; cur_ + (pv[c_] - cur_) * mu[c_]; })
        lw[lane] = tanhf(XM(1536 + lane)); lw[64 + lane] = XM(1600 + lane); lw[128 + lane] = sigmoidf_(XM(1664 + lane)); lw[192 + lane] = sigmoidf_(XM(1728 + lane));
        LDS_WAIT(); asm volatile("" ::: "memory");
        float aw = w0[c], aa = a0[c], ag = 0.f;
#pragma unroll 8
        for (int jj = 0; jj < 64; ++jj) { aw += lw[jj] * w2[jj * RW_W + c]; aa += lw[64 + jj] * a2[jj * RW_W + c]; }
#pragma unroll 8
        for (int jj = 0; jj < 128; ++jj) ag += lw[128 + jj] * g2[jj * RW_W + c];
        const float w = expf(-0.6065306597126334f * sigmoidf_(aw)), a = sigmoidf_(aa);
        const float r = XM(c), k = XM(512 + c), v = XM(1024 + c);
#undef XM
        float kk = k * k_k[c]; kk *= 1.f / sqrtf(fmaxf(wave_sum(kk * kk), 1e-24f));
        const float kp = k * (1.f + (a - 1.f) * k_a[c]), bb = kk * a;
        float S[64];
        { const f32x4* sp = (const f32x4*)(C.in[5] + (((size_t)j * RH + h) * RN + lane) * RN);
#pragma unroll
          for (int i = 0; i < 16; ++i) { const f32x4 q4 = sp[i]; S[4 * i] = q4.x; S[4 * i + 1] = q4.y; S[4 * i + 2] = q4.z; S[4 * i + 3] = q4.w; } }
        float sa0 = 0.f, sa1 = 0.f;
#pragma unroll
        for (int jx = 0; jx < 64; jx += 2) { sa0 += S[jx] * rdlane(kk, jx); sa1 += S[jx + 1] * rdlane(kk, jx + 1); }
        const float sa = -(sa0 + sa1);
        float y0 = 0.f, y1 = 0.f;
#pragma unroll
        for (int jx = 0; jx < 64; jx += 2) {
            S[jx] = S[jx] * rdlane(w, jx) + sa * rdlane(bb, jx) + v * rdlane(kp, jx); y0 += S[jx] * rdlane(r, jx);
            S[jx + 1] = S[jx + 1] * rdlane(w, jx + 1) + sa * rdlane(bb, jx + 1) + v * rdlane(kp, jx + 1); y1 += S[jx + 1] * rdlane(r, jx + 1); }
        const float y = y0 + y1;
        f32x4* so = (f32x4*)(C.out + OUT_WKVS + (((size_t)j * RH + h) * RN + lane) * RN);
#pragma unroll
        for (int i = 0; i < 16; ++i) so[i] = (f32x4){S[4 * i], S[4 * i + 1], S[4 * i + 2], S[4 * i + 3]};
        const float mean = wave_sum(y) * (1.f / 64.f), dy = y - mean, var = wave_sum(dy * dy) * (1.f / 64.f);
        const float yn = dy * (1.f / sqrtf(var + GN_EPS)) * ln_w[c] + ln_b[c];
        const float bonus = wave_sum(r * kp * r_k[c]) * v;
        MIX[(size_t)(MP + j) * D + ATT_W + c] = (bf16)f2bf((yn + bonus) * ag);
        LDS_WAIT(); asm volatile("" ::: "memory");
    }
}
namespace idxsel {
typedef short bf16x8 __attribute__((ext_vector_type(8)));
typedef float f32x16 __attribute__((ext_vector_type(16)));
constexpr int QT_BYTES = 17 * 32 * 128, WT_OFF = QT_BYTES, CNT_OFF = WT_OFF + 32 * 17 * 4;
__device__ __forceinline__ int crow(int r, int hi) { return (r & 3) + 8 * (r >> 2) + 4 * hi; }
__device__ __forceinline__ void unit(const Ctx& C, int b, int qg) {
    const int lane = C.lane, r32 = lane & 31, hi = lane >> 5, wave = C.wave;
    LAS unsigned char* lds = C.lds;
    const bf16* QIb = (const bf16*)(C.ws + WS_QIB); const bf16* KIb = (const bf16*)(C.ws + WS_KIB); const float* WIr = (const float*)(C.ws + WS_WI);
    unsigned long long* MASKT = (unsigned long long*)(C.ws + WS_MASKT);
    LAS float* WT = (LAS float*)(lds + WT_OFF); LAS int* CNT = (LAS int*)(lds + CNT_OFF);
    const size_t row0 = (size_t)b * T + 32 * qg;
    __syncthreads();
    for (int i = C.tid; i < 32 * 128; i += NTHREADS) { const int q = i >> 7, hc = i & 127, h = hc >> 3, c = hc & 7;
        const v4u v = *(const v4u*)(QIb + (row0 + q) * QI_LD + hc * 8);
        *(LAS v4u*)(lds + ((h * 32 + q) * 8 + (c ^ (q & 7))) * 16) = v; }
    { const int q = C.tid >> 4, h = C.tid & 15; WT[q * 17 + h] = WIr[(row0 + q) * IH + h]; }
    __syncthreads();
    if (C.tid < 256) {
        const int q = C.tid >> 3, c = C.tid & 7; float a8[8];
#pragma unroll
        for (int e = 0; e < 8; ++e) a8[e] = 0.f;
        for (int h = 0; h < 16; ++h) { const v4u v = *(const LAS v4u*)(lds + ((h * 32 + q) * 8 + (c ^ (q & 7))) * 16); const float w = WT[q * 17 + h];
            a8[0] += w * __builtin_bit_cast(float, v.x << 16); a8[1] += w * __builtin_bit_cast(float, v.x & 0xffff0000u); a8[2] += w * __builtin_bit_cast(float, v.y << 16); a8[3] += w * __builtin_bit_cast(float, v.y & 0xffff0000u);
            a8[4] += w * __builtin_bit_cast(float, v.z << 16); a8[5] += w * __builtin_bit_cast(float, v.z & 0xffff0000u); a8[6] += w * __builtin_bit_cast(float, v.w << 16); a8[7] += w * __builtin_bit_cast(float, v.w & 0xffff0000u); }
        v4u o; o.x = pk2(a8[0], a8[1]); o.y = pk2(a8[2], a8[3]); o.z = pk2(a8[4], a8[5]); o.w = pk2(a8[6], a8[7]);
        *(LAS v4u*)(lds + ((16 * 32 + q) * 8 + (c ^ (q & 7))) * 16) = o; }
    __syncthreads();
    f32x16 sc[8];
#pragma unroll
    for (int j = 0; j < 8; ++j) sc[j] = f32x16{};
#pragma unroll
    for (int j = 0; j < 8; ++j) {
        const int kt0 = wave + 8 * j;
        asm volatile("" ::: "memory");
        if (kt0 <= qg) {
            bf16x8 ka[4];
            const bf16* kp0 = KIb + ((size_t)b * T + kt0 * 32 + r32) * IDD + 8 * hi;
#pragma unroll
            for (int s4 = 0; s4 < 4; ++s4) ka[s4] = *(const bf16x8*)(kp0 + 16 * s4);
            bf16x8 qf[4];
#pragma unroll
            for (int s4 = 0; s4 < 4; ++s4) qf[s4] = *(const LAS bf16x8*)(lds + ((0 * 32 + r32) * 8 + ((2 * s4 + hi) ^ (r32 & 7))) * 16);
#pragma unroll 1
            for (int h = 0; h < 17; ++h) {
                bf16x8 qn[4];
                const int hn = h < 16 ? h + 1 : 16;
#pragma unroll
                for (int s4 = 0; s4 < 4; ++s4) qn[s4] = *(const LAS bf16x8*)(lds + ((hn * 32 + r32) * 8 + ((2 * s4 + hi) ^ (r32 & 7))) * 16);
                const float w = WT[r32 * 17 + h];
                f32x16 xa = f32x16{};
#pragma unroll
                for (int s4 = 0; s4 < 4; ++s4) xa = __builtin_amdgcn_mfma_f32_32x32x16_bf16(ka[s4], qf[s4], xa, 0, 0, 0);
                if (h < 16) {
#pragma unroll
                    for (int r = 0; r < 16; ++r) sc[j][r] = __builtin_fmaf(__builtin_fabsf(xa[r]), w, sc[j][r]); }
                else {
#pragma unroll
                    for (int r = 0; r < 16; ++r) sc[j][r] += xa[r]; }
#pragma unroll
                for (int s4 = 0; s4 < 4; ++s4) qf[s4] = qn[s4];
            }
        }
    }
    unsigned key[8][16];
#pragma unroll
    for (int j = 0; j < 8; ++j) { const int kt = wave + 8 * j;
#pragma unroll
        for (int r = 0; r < 16; ++r) { const bool valid = (kt < qg) || (kt == qg && crow(r, hi) <= r32); key[j][r] = valid ? sortable(sc[j][r]) : 0u; } }
    unsigned Tk = 1u;
    if (qg >= 8) {
        Tk = 0u; int buf = 0;
        for (int bit = 31; bit >= 0; --bit) {
            const unsigned cand = Tk | (1u << bit); int c = 0;
#pragma unroll
            for (int j = 0; j < 8; ++j) if (wave + 8 * j <= qg) {
#pragma unroll
                for (int r = 0; r < 16; ++r) c += (key[j][r] >= cand) ? 1 : 0; }
            c += __shfl_xor(c, 32);
            if (hi == 0) CNT[(buf * 8 + wave) * 32 + r32] = c;
            __syncthreads();
            int tot = 0;
#pragma unroll
            for (int w = 0; w < 8; ++w) tot += CNT[(buf * 8 + w) * 32 + r32];
            if (tot >= TOPK) Tk = cand;
            buf ^= 1;
        }
    }
#pragma unroll
    for (int j = 0; j < 8; ++j) { const int kt = wave + 8 * j; unsigned long long mine = 0ull;
#pragma unroll
        for (int r = 0; r < 16; ++r) { const unsigned long long W = __ballot(key[j][r] >= Tk); if (lane == r) mine = W; }
        if (lane < 16) MASKT[(((size_t)(b * 64 + qg) * 32 + (kt >> 1)) * 32) + (kt & 1) * 16 + lane] = mine; }
}
__device__ __forceinline__ void phase(const Ctx& C) {
    const int v = (int)((blockIdx.x % 8) * (C.G / 8) + blockIdx.x / 8);
    for (int vv = v; vv < NB * 32; vv += C.G) { const int b = vv >> 5, i = vv & 31; unit(C, b, 63 - i); unit(C, b, i); }
    __syncthreads();
}
}
__device__ __forceinline__ float idx_score(const float (&kr)[64], const LAS float* ql, const LAS float* wl) {
    float score = 0.f;
    for (int h = 0; h < IH; ++h) {
        float d = 0.f;
#pragma unroll
        for (int dd = 0; dd < 64; dd += 4) { const f32x4 qv = *(const LAS f32x4*)(ql + h * 64 + dd); d += qv.x * kr[dd] + qv.y * kr[dd + 1] + qv.z * kr[dd + 2] + qv.w * kr[dd + 3]; }
        score += wl[h] * fmaxf(d, 0.f);
    }
    return score;
}
template <bool PROMPT, bool SAMPLE> __device__ __forceinline__ void p4_indexer(const Ctx& C) {
    const float* PROJ = (const float*)(C.ws + WS_PROJ); float* SC = (float*)(C.ws + WS_SC); float* SCS = (float*)(C.ws + WS_SCS);
    LAS float* ql = (LAS float*)C.lds;
    LAS float* wl = ql + 16 * 1024;
    const int lane = C.lane;
    if (PROMPT) for (int u = blockIdx.x; u < NB * 128 * 4; u += C.G) {
        const int b = u >> 9, tq = (u >> 2) & 127, scn = u & 3, t0 = tq * 16;
        if (scn * 512 > t0 + 15) continue;
        __syncthreads();
        for (int i = C.tid; i < 16 * 1024; i += NTHREADS) { const int q = i >> 10, e = i & 1023; ql[i] = PROJ[(size_t)(b * T + t0 + q) * NIN + O_QI + e]; }
        if (C.tid < 256) { const int q = C.tid >> 4, h = C.tid & 15; wl[C.tid] = PROJ[(size_t)(b * T + t0 + q) * NIN + O_WI + h] * IDX_W_SCALE; }
        __syncthreads();
        const int s = scn * 512 + C.wave * 64 + lane;
        if (scn * 512 + C.wave * 64 <= t0 + 15) {
            float kr[64];
            const f32x4* kp = (const f32x4*)(C.out + OUT_IKP + (size_t)(b * T + s) * IDD);
#pragma unroll
            for (int i = 0; i < 16; ++i) { const f32x4 v = kp[i]; kr[4 * i] = v.x; kr[4 * i + 1] = v.y; kr[4 * i + 2] = v.z; kr[4 * i + 3] = v.w; }
            for (int q = 0; q < 16; ++q) {
                const float score = idx_score(kr, ql + q * 1024, wl + q * 16);
                const int t = t0 + q;
                if (s <= t) SC[((size_t)b * T + t) * T + s] = score;
            }
        }
    }
    __syncthreads();
    const int* pt = (const int*)C.in[7];
    LAS float* qw = (LAS float*)(C.lds + C.wave * 8192); LAS float* ww = qw + 1024;
    if (SAMPLE) for (int wu = C.gw; wu < NSMP * 129; wu += C.ngw) {
        const int j = wu / 129, kb = wu % 129;
        const bf16* pq = (const bf16*)(C.ws + WS_QIB) + (size_t)(MP + j) * QI_LD;
        for (int i = 0; i < 16; ++i) qw[i * 64 + lane] = __builtin_bit_cast(float, (unsigned)pq[i * 64 + lane] << 16);
        if (lane < 16) ww[lane] = ((const float*)(C.ws + WS_WI))[(size_t)(MP + j) * IH + lane] * IDX_W_SCALE;
        LDS_WAIT(); asm volatile("" ::: "memory");
        const int s = kb * 64 + lane;
        const float* krow = nullptr;
        if (s < PAST) krow = C.in[4] + ((size_t)pt[j * NPAGES + (s >> 7)] * PAGE + (s & 127)) * IDD;
        else if (s == PAST) krow = C.out + OUT_IKS + (size_t)j * IDD;
        float score = -INFINITY;
        if (krow) { float kr[64]; const f32x4* kp = (const f32x4*)krow;
#pragma unroll
            for (int i = 0; i < 16; ++i) { const f32x4 v = kp[i]; kr[4 * i] = v.x; kr[4 * i + 1] = v.y; kr[4 * i + 2] = v.z; kr[4 * i + 3] = v.w; }
            score = idx_score(kr, qw, ww); }
        SCS[(size_t)j * SCS_LD + s] = score;
        LDS_WAIT(); asm volatile("" ::: "memory");
    }
}
template <bool PROBE> __device__ __forceinline__ void p4_scan(const Ctx& C, int u_begin) {
    const float* Rr = (const float*)(C.ws + WS_RWA), *Wd = (const float*)(C.ws + WS_RWA + RWA_STRIDE), *Kp = (const float*)(C.ws + WS_RWA + 2 * RWA_STRIDE), *Vv = (const float*)(C.ws + WS_RWA + 3 * RWA_STRIDE),
          *KK = (const float*)(C.ws + WS_RWA + 4 * RWA_STRIDE), *Bb = (const float*)(C.ws + WS_RWA + 5 * RWA_STRIDE);
    float* Y = (float*)(C.ws + (PROBE ? WS_Y2 : WS_Y));
    const int lane = C.lane;
    for (int u = u_begin + C.gw; u < (PROBE ? NB * RH : NB * RH + NSMP * RH); u += C.ngw) {
        const bool smp = u >= NB * RH; const int seq = smp ? (u - NB * RH) / RH : u / RH, h = u % RH;
        const int nsteps = smp ? 1 : T; const size_t base = smp ? (size_t)(MP + seq) : (size_t)seq * T;
        float S[64];
        if (smp) { const f32x4* sp = (const f32x4*)(C.in[5] + (((size_t)seq * RH + h) * RN + lane) * RN);
#pragma unroll
            for (int i = 0; i < 16; ++i) { const f32x4 v = sp[i]; S[4 * i] = v.x; S[4 * i + 1] = v.y; S[4 * i + 2] = v.z; S[4 * i + 3] = v.w; } }
        else {
#pragma unroll
            for (int i = 0; i < 64; ++i) S[i] = 0.f; }
        size_t o = base * RW_W + h * 64 + lane;
        float r = Rr[o], w = Wd[o], k = Kp[o], v = Vv[o], kk = KK[o], bb = Bb[o];
        for (int t = 0; t < nsteps; ++t) {
            float rn = 0.f, wn = 0.f, kn = 0.f, vn = 0.f, kkn = 0.f, bbn = 0.f;
            const size_t on = o + RW_W;
            if (t + 1 < nsteps) { rn = Rr[on]; wn = Wd[on]; kn = Kp[on]; vn = Vv[on]; kkn = KK[on]; bbn = Bb[on]; }
            float sa0 = 0.f, sa1 = 0.f;
#pragma unroll
            for (int jx = 0; jx < 64; jx += 2) { sa0 += S[jx] * rdlane(kk, jx); sa1 += S[jx + 1] * rdlane(kk, jx + 1); }
            const float sa = -(sa0 + sa1);
            float y0 = 0.f, y1 = 0.f;
#pragma unroll
            for (int jx = 0; jx < 64; jx += 2) {
                S[jx] = S[jx] * rdlane(w, jx) + sa * rdlane(bb, jx) + v * rdlane(k, jx); y0 += S[jx] * rdlane(r, jx);
                S[jx + 1] = S[jx + 1] * rdlane(w, jx + 1) + sa * rdlane(bb, jx + 1) + v * rdlane(k, jx + 1); y1 += S[jx + 1] * rdlane(r, jx + 1); }
            Y[o] = y0 + y1;
            o = on; r = rn; w = wn; k = kn; v = vn; kk = kkn; bb = bbn;
        }
        f32x4* so = (f32x4*)(C.out + (smp ? OUT_WKVS : OUT_WKVP) + (((size_t)seq * RH + h) * RN + lane) * RN);
        if (!PROBE)
#pragma unroll
        for (int i = 0; i < 16; ++i) so[i] = (f32x4){S[4 * i], S[4 * i + 1], S[4 * i + 2], S[4 * i + 3]};
    }
}
template <bool PROMPT, bool SAMPLE> __device__ __forceinline__ void p5_select(const Ctx& C) {
    const float* SC = (const float*)(C.ws + WS_SC); unsigned* MASK = (unsigned*)(C.ws + WS_MASK);
    const int lane = C.lane;
    if (PROMPT) for (int row = C.gw; row < MP; row += C.ngw) {
        const int t = row & (T - 1); const float* sp = SC + (size_t)row * T;
        unsigned key[32];
#pragma unroll
        for (int j = 0; j < 32; ++j) { const int s = 64 * j + lane; key[j] = (s <= t) ? sortable(sp[s]) : 0u; }
        unsigned Tk = 0u; int need = 0;
        const bool all = (t + 1 <= TOPK);
        if (!all) {
            for (int bit = 31; bit >= 0; --bit) { const unsigned cand = Tk | (1u << bit); int cnt = 0;
#pragma unroll
                for (int j = 0; j < 32; ++j) cnt += __builtin_popcountll(__ballot(key[j] >= cand));
                if (cnt >= TOPK) Tk = cand; }
            int cgt = 0;
#pragma unroll
            for (int j = 0; j < 32; ++j) cgt += __builtin_popcountll(__ballot(key[j] > Tk));
            need = TOPK - cgt;
        }
        int running = 0;
#pragma unroll
        for (int j = 0; j < 32; ++j) {
            const int s = 64 * j + lane; bool take;
            if (all) take = (s <= t);
            else { const bool gt = key[j] > Tk, eq = key[j] == Tk; const unsigned long long eqb = __ballot(eq);
                const int pre = __builtin_popcountll(eqb & lanemask_lt(lane)); take = gt || (eq && (running + pre < need)); running += __builtin_popcountll(eqb); }
            const unsigned long long mb = __ballot(take);
            if (lane == 0) { MASK[(size_t)row * 64 + 2 * j] = (unsigned)mb; MASK[(size_t)row * 64 + 2 * j + 1] = (unsigned)(mb >> 32); }
        }
    }
    const float* SCS = (const float*)(C.ws + WS_SCS); int* SLIST = (int*)(C.ws + WS_SLIST);
    LAS int* sh = (LAS int*)C.lds;
    if (SAMPLE) for (int j = (int)blockIdx.x - 128; j >= 0 && j < NSMP; j += C.G) {
        unsigned key[17];
#pragma unroll
        for (int i = 0; i < 17; ++i) { const int s = i * NTHREADS + C.tid; key[i] = (s < LS) ? sortable(SCS[(size_t)j * SCS_LD + s]) : 0u; }
        unsigned Tk = 0u;
        for (int bit = 31; bit >= 0; --bit) { const unsigned cand = Tk | (1u << bit); int c = 0;
#pragma unroll
            for (int i = 0; i < 17; ++i) c += (key[i] >= cand) ? 1 : 0;
            c = wave_sum_i(c);
            __syncthreads(); if (lane == 0) sh[C.wave] = c; __syncthreads();
            int cnt = 0;
#pragma unroll
            for (int w = 0; w < 8; ++w) cnt += sh[w];
            if (cnt >= TOPK) Tk = cand; }
        int cg = 0;
#pragma unroll
        for (int i = 0; i < 17; ++i) cg += (key[i] > Tk) ? 1 : 0;
        cg = wave_sum_i(cg);
        __syncthreads(); if (lane == 0) sh[C.wave] = cg; __syncthreads();
        int cgt = 0;
#pragma unroll
        for (int w = 0; w < 8; ++w) cgt += sh[w];
        const int need = TOPK - cgt;
        int run_eq = 0, run_sel = 0;
#pragma unroll
        for (int i = 0; i < 17; ++i) {
            const int s = i * NTHREADS + C.tid; const bool gt = key[i] > Tk, eq = key[i] == Tk;
            const unsigned long long eqb = __ballot(eq);
            __syncthreads(); if (lane == 0) sh[C.wave] = __builtin_popcountll(eqb); __syncthreads();
            int eq_before = 0, eq_tot = 0;
#pragma unroll
            for (int w = 0; w < 8; ++w) { const int x = sh[w]; eq_tot += x; if (w < C.wave) eq_before += x; }
            const bool take = gt || (eq && (run_eq + eq_before + __builtin_popcountll(eqb & lanemask_lt(lane)) < need));
            const unsigned long long tb = __ballot(take);
            __syncthreads(); if (lane == 0) sh[8 + C.wave] = __builtin_popcountll(tb); __syncthreads();
            int s_before = 0, s_tot = 0;
#pragma unroll
            for (int w = 0; w < 8; ++w) { const int x = sh[8 + w]; s_tot += x; if (w < C.wave) s_before += x; }
            const int pos = run_sel + s_before + __builtin_popcountll(tb & lanemask_lt(lane));
            if (take && pos < TOPK) SLIST[j * TOPK + pos] = s;
            run_eq += eq_tot; run_sel += s_tot;
        }
    }
    __syncthreads();
}
template <int DIFFK> __device__ __forceinline__ void p5_rwfinal(const Ctx& C, int m_begin) {
    const float* Rr = (const float*)(C.ws + WS_RWA), *Kp = (const float*)(C.ws + WS_RWA + 2 * RWA_STRIDE), *Vv = (const float*)(C.ws + WS_RWA + 3 * RWA_STRIDE), *Gg = (const float*)(C.ws + WS_RWA + 6 * RWA_STRIDE);
    const float* Y = (const float*)(C.ws + WS_Y); bf16* MIX = (bf16*)(C.ws + WS_MIX);
    const float* r_k = C.in[25]; const float* ln_w = C.in[26]; const float* ln_b = C.in[27];
    const int lane = C.lane;
    for (int m = m_begin + C.gw; m < MT; m += C.ngw) {
        for (int h = 0; h < RH; ++h) {
            const int c = h * 64 + lane; const size_t o = (size_t)m * RW_W + c;
            float y = Y[o];
            if (DIFFK != 0 && m < MP) y += (float)DIFFK * (y - ((const float*)(C.ws + WS_Y2))[o]);
            const float mu = wave_sum(y) * (1.f / 64.f); const float dy = y - mu; const float var = wave_sum(dy * dy) * (1.f / 64.f);
            const float yn = dy * (1.f / sqrtf(var + GN_EPS)) * ln_w[c] + ln_b[c];
            const float bonus = wave_sum(Rr[o] * Kp[o] * r_k[c]) * Vv[o];
            MIX[(size_t)m * D + ATT_W + c] = (bf16)f2bf((yn + bonus) * Gg[o]);
        }
    }
}
__device__ __forceinline__ void p6_masktr(const Ctx& C) {
    const unsigned* MASK = (const unsigned*)(C.ws + WS_MASK); unsigned long long* MASKT = (unsigned long long*)(C.ws + WS_MASKT);
    const int lane = C.lane, q = lane & 31, hi = lane >> 5;
    for (int wu = C.gw; wu < NB * 64 * 32; wu += C.ngw) {
        const int j = wu & 31, qg = (wu >> 5) & 63, b = wu >> 11;
        const size_t row = (size_t)b * T + 32 * qg + q;
        const unsigned w0 = MASK[row * 64 + 2 * j], w1 = MASK[row * 64 + 2 * j + 1];
        unsigned long long mine = 0ull;
#pragma unroll
        for (int r = 0; r < 16; ++r) { const int c = (r & 3) + 8 * (r >> 2) + 4 * hi;
            const unsigned long long W0 = __ballot((w0 >> c) & 1u), W1 = __ballot((w1 >> c) & 1u);
            if (lane == r) mine = W0; if (lane == 16 + r) mine = W1; }
        if (lane < 32) MASKT[((size_t)((b * 64 + qg) * 32 + j)) * 32 + lane] = mine;
    }
}
__device__ __forceinline__ void smp_attn(const Ctx& C) {
    const int* SLIST = (const int*)(C.ws + WS_SLIST); const float* QN = (const float*)(C.ws + WS_QN); bf16* MIX = (bf16*)(C.ws + WS_MIX); const int* pt = (const int*)C.in[7];
    LAS int* prow = (LAS int*)C.lds;
    LAS float* pb = (LAS float*)(C.lds + 1024);
    const int lane = C.lane, h = C.wave;
    for (int j = blockIdx.x; j < NSMP; j += C.G) {
        __syncthreads();
        if (C.tid < TOPK) { const int s = SLIST[j * TOPK + C.tid]; prow[C.tid] = (s < PAST) ? pt[j * NPAGES + (s >> 7)] * PAGE + (s & 127) : -1; }
        __syncthreads();
        const float* kn = C.out + OUT_KS + (size_t)j * ATT_W + h * 64; const float* vn = C.out + OUT_VS + (size_t)j * ATT_W + h * 64;
        float q[64];
        { const f32x4* qp = (const f32x4*)(QN + (size_t)(MP + j) * ATT_W + h * 64);
#pragma unroll
          for (int i = 0; i < 16; ++i) { const f32x4 v = qp[i]; q[4 * i] = v.x; q[4 * i + 1] = v.y; q[4 * i + 2] = v.z; q[4 * i + 3] = v.w; } }
        float sc[4]; float mx = -INFINITY;
#pragma unroll
        for (int i = 0; i < 4; ++i) { const int pr = prow[i * 64 + lane]; const float* kp = pr >= 0 ? C.in[2] + (size_t)pr * ATT_W + h * 64 : kn;
            float d = 0.f;
#pragma unroll
            for (int e = 0; e < 16; ++e) { const f32x4 kv = ((const f32x4*)kp)[e]; d += q[4 * e] * kv.x + q[4 * e + 1] * kv.y + q[4 * e + 2] * kv.z + q[4 * e + 3] * kv.w; }
            sc[i] = d * 0.125f; mx = fmaxf(mx, sc[i]); }
        mx = wave_max(mx); float l = 0.f;
#pragma unroll
        for (int i = 0; i < 4; ++i) { const float p = expf(sc[i] - mx); pb[h * 256 + i * 64 + lane] = p; l += p; }
        l = wave_sum(l);
        LDS_WAIT(); asm volatile("" ::: "memory");
        float o = 0.f;
        for (int kx = 0; kx < TOPK; kx += 32) { float vv[32];
#pragma unroll
            for (int e = 0; e < 32; ++e) { const int pr = prow[kx + e]; vv[e] = (pr >= 0 ? C.in[3] + (size_t)pr * ATT_W + h * 64 : vn)[lane]; }
#pragma unroll
            for (int e = 0; e < 32; ++e) o += pb[h * 256 + kx + e] * vv[e]; }
        MIX[(size_t)(MP + j) * D + h * 64 + lane] = (bf16)f2bf(o / l);
    }
    __syncthreads();
}
template <int DIFFK> __device__ __forceinline__ void p6_attn(const Ctx& C, int u_begin, int u_end) {
    const unsigned* MASK = (const unsigned*)(C.ws + WS_MASK); const int* SLIST = (const int*)(C.ws + WS_SLIST); const float* QN = (const float*)(C.ws + WS_QN);
    bf16* MIX = (bf16*)(C.ws + WS_MIX); const int* pt = (const int*)C.in[7];
    LAS int* list = (LAS int*)C.lds;
    LAS float* pb = (LAS float*)(C.lds + 1024);
    LAS int* cntp = (LAS int*)(C.lds + 1024 + 8192);
    const int lane = C.lane, h = C.wave;
    for (int u = u_begin + blockIdx.x; u < u_end; u += C.G) {
        const bool smp = u >= MP; const int j = u - MP, b = u >> 11;
        __syncthreads();
        if (C.wave == 0) {
            if (!smp) { const unsigned w = MASK[(size_t)u * 64 + lane]; const int c = __builtin_popcount(w);
                int incl = c;
#pragma unroll
                for (int o = 1; o < 64; o <<= 1) { const int x = __shfl_up(incl, o); if (lane >= o) incl += x; }
                int pos = incl - c; unsigned ww = w;
                while (ww) { const int bit = __builtin_ctz(ww); ww &= ww - 1u; list[pos++] = 32 * lane + bit; }
                if (lane == 63) *cntp = incl; }
            else { for (int i = 0; i < 4; ++i) list[i * 64 + lane] = SLIST[j * TOPK + i * 64 + lane]; if (lane == 0) *cntp = TOPK; }
        }
        __syncthreads();
        int cnt = *cntp; if (cnt > TOPK) cnt = TOPK;
        float q[64];
        { const f32x4* qp = (const f32x4*)(QN + (size_t)u * ATT_W + h * 64);
#pragma unroll
          for (int i = 0; i < 16; ++i) { const f32x4 v = qp[i]; q[4 * i] = v.x; q[4 * i + 1] = v.y; q[4 * i + 2] = v.z; q[4 * i + 3] = v.w; } }
        float sc[4]; float mx = -INFINITY;
#pragma unroll
        for (int i = 0; i < 4; ++i) { const int idx = i * 64 + lane; sc[i] = -INFINITY;
            if (idx < cnt) { const int s = list[idx]; const float* kp;
                if (!smp) kp = C.out + OUT_KP + ((size_t)(b * T + s)) * ATT_W + h * 64;
                else if (s < PAST) kp = C.in[2] + ((size_t)pt[j * NPAGES + (s >> 7)] * PAGE + (s & 127)) * ATT_W + h * 64;
                else kp = C.out + OUT_KS + (size_t)j * ATT_W + h * 64;
                float d = 0.f;
#pragma unroll
                for (int e = 0; e < 16; ++e) { const f32x4 kv = ((const f32x4*)kp)[e]; d += q[4 * e] * kv.x + q[4 * e + 1] * kv.y + q[4 * e + 2] * kv.z + q[4 * e + 3] * kv.w; }
                sc[i] = d * 0.125f; }
            mx = fmaxf(mx, sc[i]); }
        mx = wave_max(mx); float l = 0.f;
#pragma unroll
        for (int i = 0; i < 4; ++i) { const int idx = i * 64 + lane; const float p = (idx < cnt) ? expf(sc[i] - mx) : 0.f; pb[h * 256 + idx] = p; l += p; }
        l = wave_sum(l);
        LDS_WAIT(); asm volatile("" ::: "memory");
        float o = 0.f;
        for (int kx = 0; kx < cnt; ++kx) { const int s = list[kx]; const float* vp;
            if (!smp) vp = C.out + OUT_VP + ((size_t)(b * T + s)) * ATT_W + h * 64;
            else if (s < PAST) vp = C.in[3] + ((size_t)pt[j * NPAGES + (s >> 7)] * PAGE + (s & 127)) * ATT_W + h * 64;
            else vp = C.out + OUT_VS + (size_t)j * ATT_W + h * 64;
            o += pb[h * 256 + kx] * vp[lane]; }
        if (DIFFK == 0) MIX[(size_t)u * D + h * 64 + lane] = (bf16)f2bf(o / l);
        else { const float a = __builtin_bit_cast(float, (unsigned)MIX[(size_t)u * D + h * 64 + lane] << 16); MIX[(size_t)u * D + h * 64 + lane] = (bf16)f2bf(a + (float)DIFFK * (a - o / l)); }
    }
    __syncthreads();
}
__device__ __forceinline__ void p8_res_norm2(const Ctx& C) {
    const float* X1 = (const float*)(C.ws + WS_X1); bf16* A2 = (bf16*)(C.ws + WS_A2); const float* MOD = (const float*)(C.ws + WS_MOD);
    for (int m = C.gw; m < MPAD; m += C.ngw) {
        bf16* orow = A2 + (size_t)m * D;
        if (m >= MT) { GAS unsigned long long* o8 = (GAS unsigned long long*)orow + C.lane;
#pragma unroll
            for (int j = 0; j < 4; ++j) o8[64 * j] = 0ull;
            continue; }
        const float* md = MOD + mod_row(m) * MODW;
        norm_mod_row(C, m, X1 + (size_t)m * D, C.in[11], md + 3 * D, md + 4 * D, orow);
    }
}
__device__ __forceinline__ void p10_swiglu(const Ctx& C) {
    const float* RAW2 = (const float*)(C.ws + WS_RAW2); bf16* HB = (bf16*)(C.ws + WS_HB);
    const size_t total = (size_t)MPAD * (FFN / 4);
    for (size_t i = (size_t)blockIdx.x * NTHREADS + C.tid; i < total; i += (size_t)C.G * NTHREADS) {
        const size_t m = i / (FFN / 4); const int c = (int)(i % (FFN / 4)) * 4;
        const f32x4 g = *(const f32x4*)(RAW2 + m * NGU + c), u = *(const f32x4*)(RAW2 + m * NGU + FFN + c);
        const float h0 = g.x / (1.f + expf(-g.x)) * u.x, h1 = g.y / (1.f + expf(-g.y)) * u.y, h2 = g.z / (1.f + expf(-g.z)) * u.z, h3 = g.w / (1.f + expf(-g.w)) * u.w;
        *(unsigned long long*)(HB + m * FFN + c) = (unsigned long long)pk2(h0, h1) | ((unsigned long long)pk2(h2, h3) << 32);
    }
}
__device__ __forceinline__ void p12_final(const Ctx& C) {
    const float* RAW = (const float*)(C.ws + WS_RAW); const float* X1 = (const float*)(C.ws + WS_X1); const float* MOD = (const float*)(C.ws + WS_MOD);
    for (int m = C.gw; m < MT; m += C.ngw) {
        const float* md = MOD + mod_row(m) * MODW;
        float* yo = C.out + (m < MP ? OUT_Y + (size_t)m * D : OUT_YS + (size_t)(m - MP) * D);
#pragma unroll
        for (int j = 0; j < 4; ++j) { const int c = 4 * (C.lane + 64 * j);
            const f32x4 xv = *(const f32x4*)(X1 + (size_t)m * D + c), rv = *(const f32x4*)(RAW + (size_t)m * D + c), g2 = *(const f32x4*)(md + 5 * D + c);
            *(f32x4*)(yo + c) = xv + g2 * rv; }
    }
}

namespace rw {
typedef short bf16x8 __attribute__((ext_vector_type(8)));
typedef short s16x4 __attribute__((ext_vector_type(4)));
typedef float f32x16 __attribute__((ext_vector_type(16)));
typedef float f32x4v __attribute__((ext_vector_type(4)));
typedef unsigned u32x2 __attribute__((ext_vector_type(2)));
typedef unsigned u32x4v __attribute__((ext_vector_type(4)));
constexpr int NCH = T / 64;
constexpr int IMG = 16384;
constexpr int A32_OFF = 7 * IMG, WC_OFF = A32_OFF + 16384, RED_OFF = WC_OFF + 256;
enum { H_AT = 0, H_BT = 1, H_KT = 2, H_RT = 3, H_VT = 4, H_AAK = 5, H_ARB = 6, H_ARK = 7, H_XT = 8, H_TT = 9, H_QT = 10, H_PT = 11, H_N1 = 12, H_N2 = 13 };
__device__ __forceinline__ unsigned off_b(unsigned row, unsigned ch) { return 256u * row + 16u * (ch ^ (((row & 3) << 2) | ((row >> 2) & 3))); }
__device__ __forceinline__ int crow(int r, int hi) { return (r & 3) + 8 * (r >> 2) + 4 * hi; }
__device__ __forceinline__ unsigned cvt2(float lo, float hi) { typedef float f2 __attribute__((ext_vector_type(2))); typedef __bf16 b2 __attribute__((ext_vector_type(2))); f2 v = {lo, hi}; b2 b = __builtin_convertvector(v, b2); return __builtin_bit_cast(unsigned, b); }
__device__ __forceinline__ bf16x8 frag_row(LAS unsigned char* lds, int H, int blk, int s, int lane) {
    return *(const LAS bf16x8*)(lds + (H >> 1) * IMG + off_b(32 * blk + (lane & 31), 8 * (H & 1) + 2 * s + (lane >> 5)));
}
__device__ __forceinline__ bf16x8 frag_tr(LAS unsigned char* lds, int H, int blk, int ks, int lane) {
    const unsigned h = lane >> 5, b2 = (lane >> 4) & 1, q = (lane & 15) >> 2, p = lane & 3, c = 2 * (H & 1) + blk;
    typedef short v4i16_t __attribute__((ext_vector_type(4)));
    LAS unsigned char* base = lds + (H >> 1) * IMG;
    const s16x4 lo = __builtin_bit_cast(s16x4, __builtin_amdgcn_ds_read_tr16_b64_v4i16((LAS v4i16_t*)(base + off_b(16 * ks + 8 * h + q, 4 * c + 2 * b2 + (p >> 1)) + 8 * (p & 1))));
    const s16x4 hi = __builtin_bit_cast(s16x4, __builtin_amdgcn_ds_read_tr16_b64_v4i16((LAS v4i16_t*)(base + off_b(16 * ks + 8 * h + 4 + q, 4 * c + 2 * b2 + (p >> 1)) + 8 * (p & 1))));
    return (bf16x8){lo[0], lo[1], lo[2], lo[3], hi[0], hi[1], hi[2], hi[3]};
}
template <bool ATR, bool BTR> __device__ __forceinline__ f32x16 mm_tile(LAS unsigned char* lds, int HA, int ablk, int HB, int bblk, f32x16 acc, int lane) {
#pragma unroll
    for (int s = 0; s < 4; ++s) {
        const bf16x8 a = ATR ? frag_tr(lds, HA, ablk, s, lane) : frag_row(lds, HA, ablk, s, lane);
        const bf16x8 b = BTR ? frag_tr(lds, HB, bblk, s, lane) : frag_row(lds, HB, bblk, s, lane);
        acc = __builtin_amdgcn_mfma_f32_32x32x16_bf16(a, b, acc, 0, 0, 0);
    }
    return acc;
}
__device__ __forceinline__ void store_tr(LAS unsigned char* lds, int H, int rblk, int cblk, const f32x16& acc, int lane) {
    LAS unsigned char* base = lds + (H >> 1) * IMG; const int hi = lane >> 5, row = 32 * cblk + (lane & 31);
#pragma unroll
    for (int g = 0; g < 4; ++g) { u32x2 w; w.x = cvt2(acc[4 * g], acc[4 * g + 1]); w.y = cvt2(acc[4 * g + 2], acc[4 * g + 3]);
        *(LAS u32x2*)(base + off_b(row, 8 * (H & 1) + 4 * rblk + g) + 8 * hi) = w; }
}
__device__ __forceinline__ u32x4v pack8(const f32x16& a, int s) { u32x4v w; w.x = cvt2(a[8 * s], a[8 * s + 1]); w.y = cvt2(a[8 * s + 2], a[8 * s + 3]); w.z = cvt2(a[8 * s + 4], a[8 * s + 5]); w.w = cvt2(a[8 * s + 6], a[8 * s + 7]); return w; }

struct Bufs { bf16* LIN; bf16* W2T; bf16* A2T; bf16* G2T; const float* PRW; bf16* G1; bf16* G2; bf16* MIX;
              u32x4v* MF; float* NT; u32x4v* PF; float* QP; u32x4v* ZF; float* Y; };

__device__ __forceinline__ void r1_unit(const Ctx& C, const Bufs& B, int b, int h, int c) {
    LAS unsigned char* lds = C.lds; const int lane0 = C.lane, wave = C.wave;
    const size_t row0 = (size_t)b * T + 64 * c; const int ci = (b * RH + h) * NCH + c;
    LAS float* A32 = (LAS float*)(lds + A32_OFF); LAS float* WC = (LAS float*)(lds + WC_OFF);
    typedef float f32x4a __attribute__((ext_vector_type(4)));
    {
    int lane = lane0; asm volatile("" : "+v"(lane)); const int hi = lane >> 5; (void)hi;
    { const int nl = lane & 15, q = lane >> 4;
      typedef float f32x2a __attribute__((ext_vector_type(2)));
      LAS f32x2a* RED = (LAS f32x2a*)(lds + RED_OFF);
      const bool first = (c == 0);
      if (wave < 4) {
        const int n = 16 * wave + nl, col = h * 64 + n;
        f32x4a aw[4], aa[4];
#pragma unroll
        for (int tt = 0; tt < 4; ++tt) { aw[tt] = (f32x4a){0.f, 0.f, 0.f, 0.f}; aa[tt] = aw[tt]; }
#pragma unroll
        for (int s = 0; s < 2; ++s) {
            const bf16x8 bw = *(const bf16x8*)(B.W2T + (size_t)col * 64 + 32 * s + 8 * q), ba = *(const bf16x8*)(B.A2T + (size_t)col * 64 + 32 * s + 8 * q);
#pragma unroll
            for (int tt = 0; tt < 4; ++tt) { const bf16* lp = B.LIN + (row0 + 16 * tt + nl) * 256 + 32 * s + 8 * q;
                aw[tt] = __builtin_amdgcn_mfma_f32_16x16x32_bf16(*(const bf16x8*)lp, bw, aw[tt], 0, 0, 0);
                aa[tt] = __builtin_amdgcn_mfma_f32_16x16x32_bf16(*(const bf16x8*)(lp + 64), ba, aa[tt], 0, 0, 0); }
        }
        const float w0c = C.in[18][col], a0c = C.in[20][col], kac = C.in[24][col], kkc = C.in[23][col], rkc = C.in[25][col], mur = C.in[17][col], muk = C.in[17][512 + col];
        float lw[4][4], av[4][4], xr[4][4], kkr[4][4], kpv[4][4];
#pragma unroll
        for (int tt = 0; tt < 4; ++tt) {
            asm volatile("" ::: "memory");
#pragma unroll
            for (int e = 0; e < 4; ++e) { const int t = 16 * tt + 4 * q + e; const float* p = B.PRW + (row0 + t) * RW_COLS + col;
                const bool z = first && t == 0;
                const float rc = p[0], kc = p[512], rp = z ? 0.f : p[-RW_COLS], kq = z ? 0.f : p[512 - RW_COLS];
                const float r_ = rc + (rp - rc) * mur, k_ = kc + (kq - kc) * muk;
                lw[tt][e] = -0.6065306597126334f / (1.f + __expf(-(w0c + aw[tt][e]))); av[tt][e] = 1.f / (1.f + __expf(-(a0c + aa[tt][e])));
                xr[tt][e] = r_; kkr[tt][e] = k_ * kkc; kpv[tt][e] = k_ * (1.f + (av[tt][e] - 1.f) * kac);
                float p1 = kkr[tt][e] * kkr[tt][e], p2 = r_ * kpv[tt][e] * rkc;
#pragma unroll
                for (int o = 1; o < 16; o <<= 1) { p1 += __shfl_xor(p1, o); p2 += __shfl_xor(p2, o); }
                if (nl == 0) RED[wave * 64 + t] = (f32x2a){p1, p2}; }
        }
        __syncthreads();
        float tot[4], L[4][4];
#pragma unroll
        for (int tt = 0; tt < 4; ++tt) { L[tt][0] = lw[tt][0]; L[tt][1] = L[tt][0] + lw[tt][1]; L[tt][2] = L[tt][1] + lw[tt][2]; L[tt][3] = L[tt][2] + lw[tt][3]; tot[tt] = L[tt][3]; }
        float run = 0.f;
#pragma unroll
        for (int tt = 0; tt < 4; ++tt) { float basev = run;
#pragma unroll
            for (int qq = 0; qq < 4; ++qq) { const float o = __shfl(tot[tt], nl + 16 * qq); if (qq < q) basev += o; run += o; }
#pragma unroll
            for (int e = 0; e < 4; ++e) L[tt][e] += basev; }
        if (q == 3) WC[n] = __expf(L[3][3]);
#pragma unroll
        for (int tt = 0; tt < 4; ++tt) {
            float at[4], bt[4], kt[4], rt[4];
#pragma unroll
            for (int e = 0; e < 4; ++e) { const int t = 16 * tt + 4 * q + e;
                const float nrm = RED[t].x + RED[64 + t].x + RED[128 + t].x + RED[192 + t].x;
                const float kkn = kkr[tt][e] * (1.f / sqrtf(fmaxf(nrm, 1e-24f)));
                const float eL = __expf(L[tt][e]), eLm = __expf(-L[tt][e]), eLex = __expf(L[tt][e] - lw[tt][e]);
                at[e] = -kkn * eLex; bt[e] = kkn * av[tt][e] * eLm; kt[e] = kpv[tt][e] * eLm; rt[e] = xr[tt][e] * eL; }
            const unsigned ch = 2 * tt + (q >> 1), bo = 8 * (q & 1);
            u32x2 w;
            w.x = cvt2(at[0], at[1]); w.y = cvt2(at[2], at[3]); *(LAS u32x2*)(lds + 0 * IMG + off_b(n, ch) + bo) = w;
            w.x = cvt2(bt[0], bt[1]); w.y = cvt2(bt[2], bt[3]); *(LAS u32x2*)(lds + 0 * IMG + off_b(n, 8 + ch) + bo) = w;
            w.x = cvt2(kt[0], kt[1]); w.y = cvt2(kt[2], kt[3]); *(LAS u32x2*)(lds + 1 * IMG + off_b(n, ch) + bo) = w;
            w.x = cvt2(rt[0], rt[1]); w.y = cvt2(rt[2], rt[3]); *(LAS u32x2*)(lds + 1 * IMG + off_b(n, 8 + ch) + bo) = w;
        }
      } else {
        const int n = 16 * (wave - 4) + nl, col = h * 64 + n;
        f32x4a ag[4];
#pragma unroll
        for (int tt = 0; tt < 4; ++tt) ag[tt] = (f32x4a){0.f, 0.f, 0.f, 0.f};
#pragma unroll
        for (int s = 0; s < 4; ++s) { const bf16x8 bg = *(const bf16x8*)(B.G2T + (size_t)col * 128 + 32 * s + 8 * q);
#pragma unroll
            for (int tt = 0; tt < 4; ++tt) ag[tt] = __builtin_amdgcn_mfma_f32_16x16x32_bf16(*(const bf16x8*)(B.LIN + (row0 + 16 * tt + nl) * 256 + 128 + 32 * s + 8 * q), bg, ag[tt], 0, 0, 0); }
        const float muv = C.in[17][1024 + col], lnw = C.in[26][col], lnb = C.in[27][col];
        float xv[4][4];
#pragma unroll
        for (int tt = 0; tt < 4; ++tt)
#pragma unroll
            for (int e = 0; e < 4; ++e) { const int t = 16 * tt + 4 * q + e; const float* p = B.PRW + (row0 + t) * RW_COLS + 1024 + col;
                const float vc = p[0], vp = (first && t == 0) ? 0.f : p[-RW_COLS]; xv[tt][e] = vc + (vp - vc) * muv; }
        __syncthreads();
#pragma unroll
        for (int tt = 0; tt < 4; ++tt) {
#pragma unroll
            for (int e = 0; e < 4; ++e) { const int t = 16 * tt + 4 * q + e; const size_t o = (row0 + t) * RW_W + col;
                const float bsc = RED[t].y + RED[64 + t].y + RED[128 + t].y + RED[192 + t].y, g = ag[tt][e];
                B.G1[o] = (bf16)f2bf(lnw * g); B.G2[o] = (bf16)f2bf((lnb + bsc * xv[tt][e]) * g); }
            u32x2 w; w.x = cvt2(xv[tt][0], xv[tt][1]); w.y = cvt2(xv[tt][2], xv[tt][3]);
            *(LAS u32x2*)(lds + 2 * IMG + off_b(n, 2 * tt + (q >> 1)) + 8 * (q & 1)) = w; }
      }
    }
    }
    __syncthreads();
    {
    int lane = lane0; asm volatile("" : "+v"(lane)); const int hi = lane >> 5; (void)hi;
#pragma unroll
    for (int k2 = 0; k2 < 2; ++k2) {
        const int id = 2 * wave + k2, prod = id >> 2, tb = (id >> 1) & 1, jb = id & 1;
        f32x16 acc = f32x16{};
        if (prod == 0) acc = mm_tile<true, true>(lds, H_AT, tb, H_BT, jb, acc, lane);
        else if (prod == 1) acc = mm_tile<true, true>(lds, H_AT, tb, H_KT, jb, acc, lane);
        else if (prod == 2) acc = mm_tile<true, true>(lds, H_BT, jb, H_RT, tb, acc, lane);
        else acc = mm_tile<true, true>(lds, H_KT, jb, H_RT, tb, acc, lane);
        if (prod < 2) {
#pragma unroll
            for (int r = 0; r < 16; ++r) { const int t = 32 * tb + crow(r, hi), j = 32 * jb + (lane & 31); if (!(j < t)) acc[r] = 0.f; }
            if (prod == 0) {
#pragma unroll
                for (int r = 0; r < 16; ++r) A32[(32 * tb + crow(r, hi)) * 64 + 32 * jb + (lane & 31)] = acc[r];
                f32x16 n1 = acc, n2 = acc;
#pragma unroll
                for (int r = 0; r < 16; ++r) { if (!(tb == jb && crow(r, hi) >= 16 && (lane & 31) < 16)) n1[r] = 0.f; if (!(tb == 1 && jb == 0)) n2[r] = 0.f; }
                store_tr(lds, H_N1, tb, jb, n1, lane); store_tr(lds, H_N2, tb, jb, n2, lane); }
            else store_tr(lds, H_AAK, tb, jb, acc, lane);
        } else {
#pragma unroll
            for (int r = 0; r < 16; ++r) { const int j = 32 * jb + crow(r, hi), t = 32 * tb + (lane & 31); if (!(j <= t)) acc[r] = 0.f; }
            store_tr(lds, prod == 2 ? H_ARB : H_ARK, jb, tb, acc, lane);
        }
    }
    }
    __syncthreads();
    {
    int lane = lane0; asm volatile("" : "+v"(lane)); const int hi = lane >> 5; (void)hi;
    if (wave == 0) {
        const int blk = lane >> 4, cc = lane & 15; float Tb[16];
#pragma unroll
        for (int t = 0; t < 16; ++t) { float sacc = (t == cc) ? 1.f : 0.f;
#pragma unroll
            for (int j4 = 0; j4 < t; j4 += 4) { const f32x4a a4 = *(const LAS f32x4a*)(A32 + (16 * blk + t) * 64 + 16 * blk + j4);
                sacc += a4[0] * Tb[j4]; if (j4 + 1 < t) sacc += a4[1] * Tb[j4 + 1]; if (j4 + 2 < t) sacc += a4[2] * Tb[j4 + 2]; if (j4 + 3 < t) sacc += a4[3] * Tb[j4 + 3]; }
            Tb[t] = sacc; }
        u32x4v lo, hi4; lo.x = cvt2(Tb[0], Tb[1]); lo.y = cvt2(Tb[2], Tb[3]); lo.z = cvt2(Tb[4], Tb[5]); lo.w = cvt2(Tb[6], Tb[7]);
        hi4.x = cvt2(Tb[8], Tb[9]); hi4.y = cvt2(Tb[10], Tb[11]); hi4.z = cvt2(Tb[12], Tb[13]); hi4.w = cvt2(Tb[14], Tb[15]);
#pragma unroll
        for (int g = 0; g < 8; ++g) { u32x4v w = (u32x4v){0u, 0u, 0u, 0u}; if (g == 2 * blk) w = lo; if (g == 2 * blk + 1) w = hi4;
            *(LAS u32x4v*)(lds + (H_TT >> 1) * IMG + off_b(lane, 8 * (H_TT & 1) + g)) = w; }
    } else if (wave >= 4) {
        const int tb = (wave - 4) >> 1, ib = (wave - 4) & 1;
        f32x16 acc = mm_tile<true, false>(lds, H_AAK, tb, H_VT, ib, f32x16{}, lane);
        store_tr(lds, H_XT, tb, ib, acc, lane);
    }
    __syncthreads();
    { const int tb = (wave >> 1) & 1, cb = wave & 1;
      if (wave < 4) { f32x16 acc = mm_tile<true, false>(lds, H_N1, tb, H_TT, cb, f32x16{}, lane);
#pragma unroll
          for (int r = 0; r < 16; ++r) if (32 * tb + crow(r, hi) == 32 * cb + (lane & 31)) acc[r] += 1.f;
          store_tr(lds, H_PT, tb, cb, acc, lane); }
      __syncthreads();
      if (wave < 4) { f32x16 acc = mm_tile<true, false>(lds, H_TT, tb, H_PT, cb, f32x16{}, lane); store_tr(lds, H_QT, tb, cb, acc, lane); }
      __syncthreads();
      if (wave < 4) { f32x16 acc = mm_tile<true, false>(lds, H_N2, tb, H_QT, cb, f32x16{}, lane);
#pragma unroll
          for (int r = 0; r < 16; ++r) if (32 * tb + crow(r, hi) == 32 * cb + (lane & 31)) acc[r] += 1.f;
          store_tr(lds, H_PT, tb, cb, acc, lane); }
      __syncthreads();
      if (wave < 4) { f32x16 acc = mm_tile<true, false>(lds, H_QT, tb, H_PT, cb, f32x16{}, lane); store_tr(lds, H_TT, tb, cb, acc, lane); }
    }
    }
    __syncthreads();
    {
    int lane = lane0; asm volatile("" : "+v"(lane)); const int hi = lane >> 5; (void)hi;
    { const int tb = (wave >> 1) & 1, cb = wave & 1;
      if (wave < 4) { f32x16 acc = mm_tile<true, false>(lds, H_TT, tb, H_AT, cb, f32x16{}, lane); store_tr(lds, H_PT, tb, cb, acc, lane); }
      else { f32x16 acc = mm_tile<true, false>(lds, H_TT, tb, H_XT, cb, f32x16{}, lane); store_tr(lds, H_QT, tb, cb, acc, lane); } }
    }
    __syncthreads();
    {
    int lane = lane0; asm volatile("" : "+v"(lane)); const int hi = lane >> 5; (void)hi;
#pragma unroll
    for (int k2 = 0; k2 < 2; ++k2) {
        const int id = 2 * wave + k2, prod = id >> 2, rb = (id >> 1) & 1, cb = id & 1;
        f32x16 acc = f32x16{};
        if (prod == 0) {
            acc = mm_tile<false, false>(lds, H_PT, rb, H_BT, cb, acc, lane);
            const float wc = WC[32 * cb + (lane & 31)];
#pragma unroll
            for (int r = 0; r < 16; ++r) { const int n = 32 * rb + crow(r, hi), m = 32 * cb + (lane & 31); acc[r] = (acc[r] + (n == m ? 1.f : 0.f)) * wc; }
            u32x4v* o = B.MF + ((size_t)ci * 8 + (cb * 2 + rb) * 2) * 64 + lane;
            o[0] = pack8(acc, 0); o[64] = pack8(acc, 1);
        } else if (prod == 1) {
            acc = mm_tile<false, false>(lds, H_BT, rb, H_QT, cb, acc, lane);
            acc = mm_tile<false, false>(lds, H_KT, rb, H_VT, cb, acc, lane);
#pragma unroll
            for (int g = 0; g < 4; ++g) { const f32x4a w4 = *(const LAS f32x4a*)(WC + 32 * rb + 8 * g + 4 * hi);
                f32x4a v = {acc[4 * g] * w4[0], acc[4 * g + 1] * w4[1], acc[4 * g + 2] * w4[2], acc[4 * g + 3] * w4[3]};
                *(f32x4a*)(B.NT + (((size_t)ci * 4 + rb * 2 + cb) * 64 + lane) * 16 + 4 * g) = v; }
        } else if (prod == 2) {
            acc = mm_tile<false, false>(lds, H_PT, rb, H_ARB, cb, acc, lane);
#pragma unroll
            for (int s = 0; s < 4; ++s) { bf16x8 idf;
#pragma unroll
                for (int e = 0; e < 8; ++e) idf[e] = (16 * s + 8 * hi + e == 32 * cb + (lane & 31)) ? (short)0x3f80 : (short)0;
                acc = __builtin_amdgcn_mfma_f32_32x32x16_bf16(frag_row(lds, H_RT, rb, s, lane), idf, acc, 0, 0, 0); }
            u32x4v* o = B.PF + ((size_t)ci * 8 + (cb * 2 + rb) * 2) * 64 + lane;
            o[0] = pack8(acc, 0); o[64] = pack8(acc, 1);
        } else {
            acc = mm_tile<false, false>(lds, H_ARB, rb, H_QT, cb, acc, lane);
            acc = mm_tile<false, false>(lds, H_ARK, rb, H_VT, cb, acc, lane);
#pragma unroll
            for (int g = 0; g < 4; ++g) *(f32x4a*)(B.QP + (((size_t)ci * 4 + rb * 2 + cb) * 64 + lane) * 16 + 4 * g) = (f32x4a){acc[4 * g], acc[4 * g + 1], acc[4 * g + 2], acc[4 * g + 3]};
        }
    }
    }
    __syncthreads();
}
__device__ __forceinline__ void r1_phase(const Ctx& C, const Bufs& B) {
    for (int u = blockIdx.x; u < NB * RH * NCH; u += C.G) { const int c = u & (NCH - 1), h = (u >> 5) & 7, b = u >> 8; r1_unit(C, B, b, h, c); }
}
__device__ __forceinline__ void r2_chain(const Ctx& C, const Bufs& B, int k) {
    const int lane = C.lane, hi = lane >> 5, ib = k & 1, bh = k >> 1;
    f32x16 z[2]; z[0] = f32x16{}; z[1] = f32x16{};
    typedef float f32x4a __attribute__((ext_vector_type(4)));
    for (int c = 0; c < NCH; ++c) {
        const size_t ci = (size_t)bh * NCH + c;
        u32x4v bf[2][2];
#pragma unroll
        for (int nb = 0; nb < 2; ++nb)
#pragma unroll
            for (int s = 0; s < 2; ++s) { bf[nb][s] = pack8(z[nb], s); B.ZF[((ci * 2 + ib) * 4 + nb * 2 + s) * 64 + lane] = bf[nb][s]; }
        f32x16 zn[2];
#pragma unroll
        for (int mb = 0; mb < 2; ++mb) {
            const float* np = B.NT + ((ci * 4 + mb * 2 + ib) * 64 + lane) * 16;
#pragma unroll
            for (int g = 0; g < 4; ++g) { const f32x4a v = *(const f32x4a*)(np + 4 * g); zn[mb][4 * g] = v[0]; zn[mb][4 * g + 1] = v[1]; zn[mb][4 * g + 2] = v[2]; zn[mb][4 * g + 3] = v[3]; }
#pragma unroll
            for (int nb = 0; nb < 2; ++nb)
#pragma unroll
                for (int s = 0; s < 2; ++s) { const u32x4v af = B.MF[(ci * 8 + (mb * 2 + nb) * 2 + s) * 64 + lane];
                    zn[mb] = __builtin_amdgcn_mfma_f32_32x32x16_bf16(__builtin_bit_cast(bf16x8, af), __builtin_bit_cast(bf16x8, bf[nb][s]), zn[mb], 0, 0, 0); }
        }
        z[0] = zn[0]; z[1] = zn[1];
    }
    float* so = C.out + OUT_WKVP + ((size_t)bh * RN + 32 * ib + (lane & 31)) * RN;
#pragma unroll
    for (int nb = 0; nb < 2; ++nb)
#pragma unroll
        for (int g = 0; g < 4; ++g) *(f32x4a*)(so + 32 * nb + 8 * g + 4 * hi) = (f32x4a){z[nb][4 * g], z[nb][4 * g + 1], z[nb][4 * g + 2], z[nb][4 * g + 3]};
}
__device__ __forceinline__ void r2_chain_wg(const Ctx& C, const Bufs& B, int k) {
    const int lane = C.lane, hi = lane >> 5, ib = k & 1, bh = k >> 1, wave = C.wave;
    LAS unsigned char* lds = C.lds;
    typedef float f32x4a __attribute__((ext_vector_type(4)));
    auto load_round = [&](int rd) {
        u32x4v tmp[10];
#pragma unroll
        for (int i = 0; i < 10; ++i) { const int pidx = (wave - 1) + 7 * i;
            if (pidx < 64) { const size_t ci = (size_t)bh * NCH + 4 * rd + (pidx >> 4); const int q = pidx & 15;
                tmp[i] = q < 8 ? B.MF[(ci * 8 + q) * 64 + lane] : *(const u32x4v*)(B.NT + ((ci * 4 + ((q - 8) >> 2) * 2 + ib) * 64 + lane) * 16 + 4 * ((q - 8) & 3)); } }
#pragma unroll
        for (int i = 0; i < 10; ++i) { const int pidx = (wave - 1) + 7 * i;
            if (pidx < 64) *(LAS u32x4v*)(lds + (rd & 1) * 65536 + (pidx >> 4) * 16384 + (pidx & 15) * 1024 + lane * 16) = tmp[i]; }
    };
    f32x16 z[2]; z[0] = f32x16{}; z[1] = f32x16{};
    if (wave > 0) load_round(0);
    __syncthreads();
    for (int rd = 0; rd < NCH / 4; ++rd) {
        if (wave > 0) { if (rd + 1 < NCH / 4) load_round(rd + 1); }
        else {
            for (int st = 0; st < 4; ++st) {
                const size_t ci = (size_t)bh * NCH + 4 * rd + st; LAS unsigned char* sl = lds + (rd & 1) * 65536 + st * 16384;
                u32x4v bf[2][2];
#pragma unroll
                for (int nb = 0; nb < 2; ++nb)
#pragma unroll
                    for (int s = 0; s < 2; ++s) { bf[nb][s] = pack8(z[nb], s); B.ZF[((ci * 2 + ib) * 4 + nb * 2 + s) * 64 + lane] = bf[nb][s]; }
                f32x16 zn[2];
#pragma unroll
                for (int mb = 0; mb < 2; ++mb) {
#pragma unroll
                    for (int g = 0; g < 4; ++g) { const f32x4a v = *(const LAS f32x4a*)(sl + (8 + mb * 4 + g) * 1024 + lane * 16); zn[mb][4 * g] = v[0]; zn[mb][4 * g + 1] = v[1]; zn[mb][4 * g + 2] = v[2]; zn[mb][4 * g + 3] = v[3]; }
#pragma unroll
                    for (int nb = 0; nb < 2; ++nb)
#pragma unroll
                        for (int s = 0; s < 2; ++s) { const u32x4v af = *(const LAS u32x4v*)(sl + ((mb * 2 + nb) * 2 + s) * 1024 + lane * 16);
                            zn[mb] = __builtin_amdgcn_mfma_f32_32x32x16_bf16(__builtin_bit_cast(bf16x8, af), __builtin_bit_cast(bf16x8, bf[nb][s]), zn[mb], 0, 0, 0); }
                }
                z[0] = zn[0]; z[1] = zn[1];
            }
        }
        __syncthreads();
    }
    if (wave == 0) {
        float* so = C.out + OUT_WKVP + ((size_t)bh * RN + 32 * ib + (lane & 31)) * RN;
#pragma unroll
        for (int nb = 0; nb < 2; ++nb)
#pragma unroll
            for (int g = 0; g < 4; ++g) *(f32x4a*)(so + 32 * nb + 8 * g + 4 * hi) = (f32x4a){z[nb][4 * g], z[nb][4 * g + 1], z[nb][4 * g + 2], z[nb][4 * g + 3]};
    }
}
__device__ __forceinline__ void r3_phase(const Ctx& C, const Bufs& B) {
    const int lane = C.lane, hi = lane >> 5;
    typedef float f32x4a __attribute__((ext_vector_type(4)));
    for (int wu = C.gw; wu < NB * RH * NCH * 2; wu += C.ngw) {
        const int tb = wu & 1; const size_t ci = (size_t)(wu >> 1); const int c = (int)(ci & (NCH - 1)), bh = (int)(ci >> 5), h = bh & 7, b = bh >> 3;
        u32x4v pf[2][2];
#pragma unroll
        for (int nb = 0; nb < 2; ++nb)
#pragma unroll
            for (int s = 0; s < 2; ++s) pf[nb][s] = B.PF[(ci * 8 + (tb * 2 + nb) * 2 + s) * 64 + lane];
        f32x16 y[2];
#pragma unroll
        for (int ib = 0; ib < 2; ++ib) {
            const float* qp = B.QP + ((ci * 4 + tb * 2 + ib) * 64 + lane) * 16;
#pragma unroll
            for (int g = 0; g < 4; ++g) { const f32x4a v = *(const f32x4a*)(qp + 4 * g); y[ib][4 * g] = v[0]; y[ib][4 * g + 1] = v[1]; y[ib][4 * g + 2] = v[2]; y[ib][4 * g + 3] = v[3]; }
#pragma unroll
            for (int nb = 0; nb < 2; ++nb)
#pragma unroll
                for (int s = 0; s < 2; ++s) { const u32x4v zf = B.ZF[((ci * 2 + ib) * 4 + nb * 2 + s) * 64 + lane];
                    y[ib] = __builtin_amdgcn_mfma_f32_32x32x16_bf16(__builtin_bit_cast(bf16x8, pf[nb][s]), __builtin_bit_cast(bf16x8, zf), y[ib], 0, 0, 0); }
        }
        const size_t rowb = (size_t)b * T + 64 * c + 32 * tb;
#pragma unroll
        for (int r = 0; r < 16; ++r) {
            float s1 = y[0][r] + y[1][r], s2 = y[0][r] * y[0][r] + y[1][r] * y[1][r];
#pragma unroll
            for (int o = 1; o < 32; o <<= 1) { s1 += __shfl_xor(s1, o); s2 += __shfl_xor(s2, o); }
            const float mean = s1 * (1.f / 64.f), var = fmaxf(s2 * (1.f / 64.f) - mean * mean, 0.f), rstd = 1.f / sqrtf(var + GN_EPS);
            const size_t row = rowb + crow(r, hi);
#pragma unroll
            for (int ib = 0; ib < 2; ++ib) { const int i = 32 * ib + (lane & 31); const size_t o = row * RW_W + h * 64 + i;
                const float g1 = __builtin_bit_cast(float, (unsigned)B.G1[o] << 16), g2 = __builtin_bit_cast(float, (unsigned)B.G2[o] << 16);
                B.MIX[row * D + ATT_W + h * 64 + i] = (bf16)f2bf((y[ib][r] - mean) * rstd * g1 + g2); }
        }
    }
}
}
constexpr int N_PHASES = 11;
__global__ void __launch_bounds__(NTHREADS, 2) fwd(Args args) {
    extern __shared__ __attribute__((aligned(16))) unsigned char lds[];
    Ctx C;
    C.lds = (LAS unsigned char*)lds;
    C.tid = threadIdx.x; C.lane = C.tid & 63; C.wave = __builtin_amdgcn_readfirstlane(C.tid >> 6);
    C.G = gridDim.x; C.gw = blockIdx.x * NWAVES + C.wave; C.ngw = C.G * NWAVES;
    C.in = args.in; C.out = args.out; C.ws = args.ws;
    const int lo = args.ph_lo, hi = args.ph_hi;
    volatile LAS unsigned* MISC = (volatile LAS unsigned*)(C.lds + MISC_OFF);
    if (C.tid < 32) MISC[C.tid] = 0u;
    __syncthreads();
    XcdBarrier bar = xcd_barrier_post((unsigned*)(C.ws + WS_CTL) + CW_BAR, MISC + 8);
#define IN(k) (lo <= (k) && (k) < hi)
#define SEAM(k) do { if (IN(k) && IN((k) + 1)) xcd_barrier(bar); } while (0)
    if (IN(0)) { p0_mod(C); p0_weights(C); }
    SEAM(0);
    if (IN(1)) { p1_norm1(C); }
    SEAM(1);
    if (IN(2)) {
        pg8::Gemm g{(const pg8::bf16_t*)(C.ws + WS_A1), (const pg8::bf16_t*)(C.ws + WS_WIN), MPAD, NIN, D}; pg8::StaticOrder S; S.init(MPAD, NIN, C.G, (int)blockIdx.x);
        EpiIn E{C.ws, C.out, C.in[15], C.in[16]};
        pg8::gemm_phase<EpiIn, pg8::StaticOrder, true, true>(C.lds, g, S, E);
    }
    SEAM(2);
    rw::Bufs RB;
    RB.LIN = (bf16*)(C.ws + WS_LIN); RB.W2T = (bf16*)(C.ws + WS_W2T); RB.A2T = (bf16*)(C.ws + WS_A2T); RB.G2T = (bf16*)(C.ws + WS_G2T);
    RB.PRW = (const float*)(C.ws + WS_PRW); RB.G1 = (bf16*)(C.ws + WS_RWA); RB.G2 = (bf16*)(C.ws + WS_RWA + RWA_STRIDE); RB.MIX = (bf16*)(C.ws + WS_MIX);
    RB.MF = (rw::u32x4v*)(C.ws + WS_MF); RB.NT = (float*)(C.ws + WS_NT); RB.PF = (rw::u32x4v*)(C.ws + WS_PF); RB.QP = (float*)(C.ws + WS_QP); RB.ZF = (rw::u32x4v*)(C.ws + WS_ZF);
    if (IN(3)) { p3_lin(C); smp_rwkv(C); }
    SEAM(3);
    if (IN(4)) { idxsel::phase(C); rw::r1_phase(C, RB); p4_indexer<false, true>(C); }
    SEAM(4);
    if (IN(5)) {
        p5_select<false, true>(C);
        if (blockIdx.x < NB * RH * 2) rw::r2_chain_wg(C, RB, (int)blockIdx.x);
        __syncthreads();
        const attn_body::AttnTensors AT{(const attn_body::bf16*)(C.ws + WS_QB), (const attn_body::bf16*)(C.ws + WS_KB), (const attn_body::bf16*)(C.ws + WS_VB), (attn_body::bf16*)(C.ws + WS_MIX), (const unsigned long long*)(C.ws + WS_MASKT)};
        const attn_body::StaticOrder S((int)C.G, (int)blockIdx.x);
        attn_body::attn_phase<attn_body::StaticOrder>((char*)lds, AT, S);
    }
    SEAM(5);
    if (IN(6)) { smp_attn(C); rw::r3_phase(C, RB); }
    SEAM(6);
    if (IN(7)) {
        pg8::Gemm g{(const pg8::bf16_t*)(C.ws + WS_MIX), (const pg8::bf16_t*)(C.ws + WS_WOUT), MP, D, D}; pg8::StaticOrder S; S.init(MP, D, C.G, (int)blockIdx.x);
        EpiResGate E{C.in[0], (const float*)(C.ws + WS_MOD) + 2 * D, (float*)(C.ws + WS_X1)};
        pg8::gemm_phase<EpiResGate, pg8::StaticOrder, true, true>(C.lds, g, S, E);
        const float* xs = C.in[1]; const float* g1 = (const float*)(C.ws + WS_MOD) + (size_t)NB * MODW + 2 * D; float* x1s = (float*)(C.ws + WS_X1) + (size_t)MP * D;
        sample_gemm(C, (const bf16*)(C.ws + WS_MIX) + (size_t)MP * D, (const bf16*)(C.ws + WS_WOUT), D, [&](int row, int col, float v) { x1s[row * D + col] = xs[row * D + col] + g1[(size_t)row * MODW + col] * v; });
    }
    SEAM(7);
    if (IN(8)) { p8_res_norm2(C); }
    SEAM(8);
    if (IN(9)) {
        pg8::Gemm g{(const pg8::bf16_t*)(C.ws + WS_A2), (const pg8::bf16_t*)(C.ws + WS_WGU), MPAD, NGU, D}; pg8::StaticOrder S; S.init(MPAD, NGU, C.G, (int)blockIdx.x);
        EpiSwiGLU E{(bf16*)(C.ws + WS_HB)};
        pg8::gemm_phase<EpiSwiGLU, pg8::StaticOrder, true, true>(C.lds, g, S, E);
    }
    SEAM(9);
    if (IN(10)) {
        pg8::Gemm g{(const pg8::bf16_t*)(C.ws + WS_HB), (const pg8::bf16_t*)(C.ws + WS_WDN), MP, D, FFN}; pg8::StaticOrder S; S.init(MP, D, C.G, (int)blockIdx.x);
        EpiResGate E{(const float*)(C.ws + WS_X1), (const float*)(C.ws + WS_MOD) + 5 * D, C.out + OUT_Y};
        pg8::gemm_phase<EpiResGate, pg8::StaticOrder, true, true>(C.lds, g, S, E);
        const float* x1s = (const float*)(C.ws + WS_X1) + (size_t)MP * D; const float* g2 = (const float*)(C.ws + WS_MOD) + (size_t)NB * MODW + 5 * D; float* ys = C.out + OUT_YS;
        sample_gemm(C, (const bf16*)(C.ws + WS_HB) + (size_t)MP * FFN, (const bf16*)(C.ws + WS_WDN), FFN, [&](int row, int col, float v) { ys[row * D + col] = x1s[row * D + col] + g2[(size_t)row * MODW + col] * v; });
    }
#undef IN
#undef SEAM
}

extern "C" void kernel_launch(void* const* d_in, const int* in_sizes, int n_in, void* d_out, int out_size, void* d_ws, size_t ws_size, hipStream_t stream) {
    static int grid = 0;
    if (grid == 0) {
        if (n_in != 32 || (size_t)out_size != OUT_END || ws_size < WS_END) { fprintf(stderr, "kernel_launch: unexpected sizes n_in %d out %d ws %zu\n", n_in, out_size, ws_size); grid = -1; return; }
        int dev = 0, cus = 0;
        if (hipGetDevice(&dev) != hipSuccess || hipDeviceGetAttribute(&cus, hipDeviceAttributeMultiprocessorCount, dev) != hipSuccess) { grid = -1; return; }
        if (hipFuncSetAttribute((const void*)fwd, hipFuncAttributeMaxDynamicSharedMemorySize, LDS_BYTES) != hipSuccess) { fprintf(stderr, "kernel_launch: hipFuncSetAttribute failed\n"); grid = -1; return; }
        (void)hipGetLastError();
        grid = cus;
    }
    if (grid < 0) return;
    (void)hipMemsetAsync((char*)d_ws + WS_CTL, 0, CTL_ZERO_BYTES, stream);
    Args a{};
    for (int i = 0; i < 32; ++i) a.in[i] = (const float*)d_in[i];
    a.out = (float*)d_out; a.ws = (unsigned char*)d_ws;
    a.ph_lo = 0; a.ph_hi = N_PHASES;
    hipLaunchKernelGGL(fwd, dim3(grid), dim3(NTHREADS), LDS_BYTES, stream, a);
}
```

```cpp
#include <hip/hip_runtime.h>
#include <cstdio>
#include <cstdint>
#include <cmath>
#include <hip/hip_bf16.h>
#define LAS __attribute__((address_space(3)))
namespace pg8 {
#define PG8_LAS __attribute__((address_space(3)))
typedef unsigned short bf16_t;
typedef short bf16x8 __attribute__((ext_vector_type(8)));
typedef float f32x4 __attribute__((ext_vector_type(4)));
typedef unsigned u32x4 __attribute__((ext_vector_type(4)));
constexpr int BM = 256, BK = 64, HALF = 128, HTB = HALF * BK * 2  , STAGE_BYTES = 8 * HTB, NXCD = 8, WGM = 8;

__host__ __device__ __forceinline__ int lds_byte(int r, int c) { const int st = (r >> 4) * 2 + (c >> 5), rr = r & 15, cc = c & 31, ob = rr * 64 + cc * 2; return st * 1024 + (ob ^ (((ob >> 9) & 1) << 5)); }
__host__ __device__ __forceinline__ void stage_rc(int b, int& R, int& C) { const int st = b / 1024, sb = b % 1024, swz = sb ^ (((sb >> 9) & 1) << 5); R = (st >> 1) * 16 + swz / 64; C = (st & 1) * 32 + (swz % 64) / 2; }
__host__ __device__ __forceinline__ int perm32(int rho) { const int n = rho >> 4, i = rho & 15; return 8 * (i >> 2) + 4 * n + (i & 3); }

struct Unit { int pm, pn; };
struct Gemm { const bf16_t* A; const bf16_t* Bt; int M, N, K; };

struct StaticOrder {
    int nM, nN, nwg, G, c;
    __host__ __device__ void init(int M, int N, int G_, int c_) { nM = M / BM; nN = N / BM; nwg = nM * nN; G = G_; c = c_; }
    __host__ __device__ bool next(int i, Unit& u) const {
        const long L = (long)i * G + c; if (L >= nwg) return false;
        int wgid = (int)L; { const int q = nwg / NXCD, r = nwg % NXCD, xcd = wgid % NXCD, off = wgid / NXCD; wgid = (xcd < r ? xcd * (q + 1) : r * (q + 1) + (xcd - r) * q) + off; }
        const int nig = WGM * nN, gid = wgid / nig, fm = gid * WGM, gsz = (nM - fm) < WGM ? (nM - fm) : WGM;
        u.pm = fm + ((wgid % nig) % gsz); u.pn = (wgid % nig) / gsz; return true;
    }
    __device__ __forceinline__ void a_ready(const Unit&) const {}
    __device__ __forceinline__ void done(const Unit&) const {}
};

__device__ __forceinline__ unsigned cvt_pk_bf16(float lo, float hi) { unsigned r; asm volatile("v_cvt_pk_bf16_f32 %0, %1, %2" : "=v"(r) : "v"(lo), "v"(hi)); return r; }
typedef float f32x2 __attribute__((ext_vector_type(2)));
__device__ __forceinline__ f32x2 gelu_pk(f32x2 v) {
    const f32x2 av = __builtin_elementwise_abs(v), d = av * 0.2316418882f + 1.0f;
    f32x2 t; t.x = __builtin_amdgcn_rcpf(d.x); t.y = __builtin_amdgcn_rcpf(d.y);
    f32x2 q = t * 0.5307027145f + (-0.7265760135f); q = q * t + 0.7107068705f; q = q * t + (-0.142248368f); q = q * t + 0.127414796f; q = q * t;
    const f32x2 s = (v * v) * (-0.72134752044f);
    f32x2 e; e.x = __builtin_amdgcn_exp2f(s.x); e.y = __builtin_amdgcn_exp2f(s.y);
    const f32x2 m = v * (q * e), r = v - m;
    f32x2 o; o.x = v.x < 0.f ? m.x : r.x; o.y = v.y < 0.f ? m.y : r.y; return o;
}

template <int ACT  > struct EpiBf16 {
    static constexpr bool PERM = true, AFTER_DRAIN = false; static_assert(ACT == 0 || ACT == 1, "EpiBf16: ACT is 0 (none) or 1 (gelu_pk)");
    bf16_t* O; int ldc; const float* bias; int split_cols; size_t split_stride; float scale0;
    __device__ __forceinline__ void operator()(const f32x4 (&acc)[2][2][4][2], const Unit& u, int wr, int wc, int fr, int fq) const {
        const int row0 = u.pm * BM + wr * 64 + fr; int colt = u.pn * BM; bf16_t* base = O;
        float sc = 1.f; if (split_cols) { const int t = colt / split_cols; base += (size_t)t * split_stride; colt -= t * split_cols; if (t == 0) sc = scale0; }
        const int col0 = colt + wc * 32 + 8 * fq, bcol0 = u.pn * BM + wc * 32 + 8 * fq;
        f32x4 bv[2][2];
#pragma unroll
        for (int bj = 0; bj < 2; ++bj)
#pragma unroll
            for (int n = 0; n < 2; ++n) bv[bj][n] = bias ? *(const f32x4*)(bias + bcol0 + bj * HALF + 4 * n) : (f32x4){0.f, 0.f, 0.f, 0.f};
#pragma unroll
        for (int ai = 0; ai < 2; ++ai)
#pragma unroll
            for (int m = 0; m < 4; ++m) { bf16_t* rowp = base + (size_t)(row0 + ai * HALF + m * 16) * ldc + col0;
#pragma unroll
                for (int bj = 0; bj < 2; ++bj) { f32x4 v0 = acc[ai][bj][m][0] + bv[bj][0], v1 = acc[ai][bj][m][1] + bv[bj][1];
                    if (ACT == 1) { f32x2 a = gelu_pk((f32x2){v0[0], v0[1]}), b = gelu_pk((f32x2){v0[2], v0[3]}), c = gelu_pk((f32x2){v1[0], v1[1]}), d = gelu_pk((f32x2){v1[2], v1[3]});
                        v0 = (f32x4){a.x, a.y, b.x, b.y}; v1 = (f32x4){c.x, c.y, d.x, d.y}; }
                    v0 = v0 * sc; v1 = v1 * sc; u32x4 w; w.x = cvt_pk_bf16(v0[0], v0[1]); w.y = cvt_pk_bf16(v0[2], v0[3]); w.z = cvt_pk_bf16(v1[0], v1[1]); w.w = cvt_pk_bf16(v1[2], v1[3]);
                    *(u32x4*)(rowp + bj * HALF) = w; } }
    }
};


template <class Epi, class Sched, bool ALIGN_EPI = false, bool SP2 = false>
__device__ __forceinline__ void gemm_phase(PG8_LAS unsigned char* lds, const Gemm g, const Sched& S, const Epi& E) {
    const int tid = threadIdx.x, wid = __builtin_amdgcn_readfirstlane(tid >> 6), lane = tid & 63, wr = wid >> 2, wc = wid & 3, fr = lane & 15, fq = lane >> 4;
    const int K = g.K, nt = K / BK;
    unsigned voffA[2], voffB[2];
#pragma unroll
    for (int i = 0; i < 2; ++i) { int R, C; stage_rc(tid * 16 + i * 8192, R, C); const int Rb = Epi::PERM ? ((R & ~31) + perm32(R & 31)) : R;
        voffA[i] = (unsigned)(R * K + C) * 2u; voffB[i] = (unsigned)(Rb * K + C) * 2u; }
    const size_t kstep = (size_t)(BK * 2);
    const size_t hstep = (size_t)HALF * K * 2;
    const size_t tstep = 2 * hstep;
    const unsigned ldsw = (unsigned)wid * 1024u;
    const int aoff = lds_byte(wr * 64 + fr, fq * 8), boff = lds_byte(wc * 32 + fr, fq * 8);
#define PG8_SA(b, h) (((b) * 2 + (h)) * HTB)
#define PG8_SB(b, h) ((4 + (b) * 2 + (h)) * HTB)
#define PG8_STAGE(bufoff, gbase, voff) do { _Pragma("unroll") for (int _i = 0; _i < 2; ++_i) \
        __builtin_amdgcn_global_load_lds((const unsigned*)((const char*)(gbase) + (voff)[_i]), (PG8_LAS unsigned*)(lds + (bufoff) + ldsw + _i * 8192), 16, 0, 0); } while (0)
#define PG8_LDA(dst, b, h) do { _Pragma("unroll") for (int m = 0; m < 4; ++m) _Pragma("unroll") for (int k = 0; k < 2; ++k) dst[m][k] = *(const PG8_LAS bf16x8*)(lds + PG8_SA(b, h) + aoff + m * 2048 + k * 1024); } while (0)
#define PG8_LDB(dst, b, h) do { _Pragma("unroll") for (int n = 0; n < 2; ++n) _Pragma("unroll") for (int k = 0; k < 2; ++k) dst[n][k] = *(const PG8_LAS bf16x8*)(lds + PG8_SB(b, h) + boff + n * 2048 + k * 1024); } while (0)
#define PG8_MMA(ai, bj, At, Bt) do { __builtin_amdgcn_s_setprio(1); _Pragma("unroll") for (int m = 0; m < 4; ++m) _Pragma("unroll") for (int n = 0; n < 2; ++n) _Pragma("unroll") for (int k = 0; k < 2; ++k) \
        acc[ai][bj][m][n] = __builtin_amdgcn_mfma_f32_16x16x32_bf16(Bt[n][k], At[m][k], acc[ai][bj][m][n], 0, 0, 0); __builtin_amdgcn_s_setprio(0); } while (0)
#define PG8_WAIT_V(n) asm volatile("s_waitcnt vmcnt(" #n ")" ::: "memory")
#define PG8_WAIT_L(n) asm volatile("s_waitcnt lgkmcnt(" #n ")" ::: "memory")
#define PG8_BAR __builtin_amdgcn_s_barrier()
#define PG8_SCHED __builtin_amdgcn_sched_barrier(0)
    Unit cur, nxt; int ui = 0;
    if (!S.next(0, cur)) return;
    f32x4 acc[2][2][4][2];
#pragma unroll
    for (int a = 0; a < 2; ++a)
#pragma unroll
        for (int b = 0; b < 2; ++b)
#pragma unroll
            for (int m = 0; m < 4; ++m)
#pragma unroll
                for (int n = 0; n < 2; ++n) acc[a][b][m][n] = (f32x4){0.f, 0.f, 0.f, 0.f};
    bf16x8 At[4][2], B0[2][2], B1[2][2];
    const char* cA = (const char*)g.A + (size_t)cur.pm * tstep; const char* cB = (const char*)g.Bt + (size_t)cur.pn * tstep;
    S.a_ready(cur);
    if constexpr (SP2) {
        PG8_STAGE(PG8_SB(0, 0), cB, voffB); PG8_STAGE(PG8_SB(0, 1), cB + hstep, voffB); PG8_STAGE(PG8_SA(0, 0), cA, voffA); PG8_STAGE(PG8_SA(0, 1), cA + hstep, voffA);
        if (wr == 1) PG8_BAR;
        PG8_WAIT_V(2); PG8_BAR;
        PG8_STAGE(PG8_SB(1, 0), cB + kstep, voffB); PG8_STAGE(PG8_SA(1, 0), cA + kstep, voffA); PG8_STAGE(PG8_SB(1, 1), cB + hstep + kstep, voffB);
        PG8_WAIT_V(6); PG8_BAR;
    } else {
        PG8_STAGE(PG8_SB(0, 0), cB, voffB); PG8_STAGE(PG8_SA(0, 0), cA, voffA); PG8_STAGE(PG8_SB(0, 1), cB + hstep, voffB); PG8_STAGE(PG8_SA(0, 1), cA + hstep, voffA);
        if (wr == 1) PG8_BAR;
        PG8_WAIT_V(4); PG8_BAR;
        PG8_STAGE(PG8_SB(1, 0), cB + kstep, voffB); PG8_STAGE(PG8_SA(1, 0), cA + kstep, voffA); PG8_STAGE(PG8_SB(1, 1), cB + hstep + kstep, voffB);
        PG8_WAIT_V(6); PG8_BAR;
    }
    for (;;) {
        const bool has_next = S.next(ui + 1, nxt);
        const char* nA = has_next ? (const char*)g.A + (size_t)nxt.pm * tstep : cA; const char* nB = has_next ? (const char*)g.Bt + (size_t)nxt.pn * tstep : cB;
        for (int t = 0; t < nt; t += 2) {
            const bool last = (t == nt - 2);
            const char* a1 = cA + (size_t)(t + 1) * kstep;
            const char* a2 = last ? nA : cA + (size_t)(t + 2) * kstep; const char* b2 = last ? nB : cB + (size_t)(t + 2) * kstep;
            const char* a3 = a2 + kstep; const char* b3 = b2 + kstep;
            if (last && has_next) S.a_ready(nxt);
            if constexpr (SP2) {
            PG8_LDB(B0, 0, 0); PG8_LDB(B1, 0, 1); PG8_SCHED; PG8_LDA(At, 0, 0); PG8_STAGE(PG8_SA(1, 1), a1 + hstep, voffA);
            PG8_WAIT_V(8); PG8_WAIT_L(0); PG8_BAR; PG8_MMA(0, 0, At, B0); PG8_MMA(0, 1, At, B1); PG8_BAR; PG8_SCHED;
            PG8_LDA(At, 0, 1); PG8_STAGE(PG8_SB(0, 0), b2, voffB); PG8_STAGE(PG8_SB(0, 1), b2 + hstep, voffB); PG8_STAGE(PG8_SA(0, 0), a2, voffA);
            PG8_WAIT_V(8); PG8_WAIT_L(0); PG8_BAR; PG8_MMA(1, 0, At, B0); PG8_MMA(1, 1, At, B1); PG8_BAR; PG8_SCHED;
            PG8_LDB(B0, 1, 0); PG8_LDB(B1, 1, 1); PG8_SCHED; PG8_LDA(At, 1, 0); PG8_STAGE(PG8_SA(0, 1), a2 + hstep, voffA);
            PG8_WAIT_V(8); PG8_WAIT_L(0); PG8_BAR; PG8_MMA(0, 0, At, B0); PG8_MMA(0, 1, At, B1); PG8_BAR; PG8_SCHED;
            PG8_LDA(At, 1, 1); PG8_STAGE(PG8_SB(1, 0), b3, voffB); PG8_STAGE(PG8_SB(1, 1), b3 + hstep, voffB); PG8_STAGE(PG8_SA(1, 0), a3, voffA);
            PG8_WAIT_V(8); PG8_WAIT_L(0); PG8_BAR; PG8_MMA(1, 0, At, B0); PG8_MMA(1, 1, At, B1); PG8_BAR; PG8_SCHED;
            } else {
            PG8_LDB(B0, 0, 0); PG8_SCHED; PG8_LDA(At, 0, 0); PG8_STAGE(PG8_SA(1, 1), a1 + hstep, voffA);
            PG8_WAIT_L(8); PG8_BAR; PG8_WAIT_L(0); PG8_MMA(0, 0, At, B0); PG8_BAR; PG8_SCHED;
            PG8_LDB(B1, 0, 1); PG8_STAGE(PG8_SB(0, 0), b2, voffB);
            PG8_BAR; PG8_WAIT_L(0); PG8_MMA(0, 1, At, B1); PG8_BAR;
            PG8_LDA(At, 0, 1); PG8_STAGE(PG8_SA(0, 0), a2, voffA);
            PG8_BAR; PG8_WAIT_L(0); PG8_MMA(1, 0, At, B0); PG8_BAR; PG8_SCHED;
            PG8_STAGE(PG8_SB(0, 1), b2 + hstep, voffB);
            PG8_WAIT_V(6); PG8_BAR; PG8_MMA(1, 1, At, B1); PG8_BAR;
            PG8_LDB(B0, 1, 0); PG8_SCHED; PG8_LDA(At, 1, 0); PG8_STAGE(PG8_SA(0, 1), a2 + hstep, voffA);
            PG8_WAIT_L(8); PG8_BAR; PG8_WAIT_L(0); PG8_MMA(0, 0, At, B0); PG8_BAR; PG8_SCHED;
            PG8_LDB(B1, 1, 1); PG8_STAGE(PG8_SB(1, 0), b3, voffB);
            PG8_BAR; PG8_WAIT_L(0); PG8_MMA(0, 1, At, B1); PG8_BAR;
            PG8_LDA(At, 1, 1); PG8_STAGE(PG8_SA(1, 0), a3, voffA);
            PG8_BAR; PG8_WAIT_L(0); PG8_MMA(1, 0, At, B0); PG8_BAR; PG8_SCHED;
            PG8_STAGE(PG8_SB(1, 1), b3 + hstep, voffB);
            PG8_WAIT_V(6); PG8_BAR; PG8_MMA(1, 1, At, B1); PG8_BAR;
            }
        }
        if constexpr (ALIGN_EPI) { if (wr == 0) PG8_BAR; }
        if constexpr (!Epi::AFTER_DRAIN) { E(acc, cur, wr, wc, fr, fq); S.done(cur); }
        if (!has_next) break;
#pragma unroll
        for (int a = 0; a < 2; ++a)
#pragma unroll
            for (int b = 0; b < 2; ++b)
#pragma unroll
                for (int m = 0; m < 4; ++m)
#pragma unroll
                    for (int n = 0; n < 2; ++n) acc[a][b][m][n] = (f32x4){0.f, 0.f, 0.f, 0.f};
        cur = nxt; cA = nA; cB = nB; ++ui;
        if constexpr (ALIGN_EPI) { if (wr == 1) PG8_BAR; }
    }
    PG8_WAIT_V(0);
    if constexpr (!ALIGN_EPI) { if (wr == 0) PG8_BAR; }
    PG8_BAR;
    if constexpr (Epi::AFTER_DRAIN) { E.fused(acc, cur, wr, wc, fr, fq, lds, wid, lane); S.done(cur); }
#undef PG8_SA
#undef PG8_SB
#undef PG8_STAGE
#undef PG8_LDA
#undef PG8_LDB
#undef PG8_MMA
#undef PG8_WAIT_V
#undef PG8_WAIT_L
#undef PG8_BAR
#undef PG8_SCHED
}
}
namespace attn_body {
using bf16=__hip_bfloat16;
using bf16x8=__attribute__((ext_vector_type(8)))short;
using s16x4=__attribute__((ext_vector_type(4)))short;
using f32x16=__attribute__((ext_vector_type(16)))float;
using u32x4=__attribute__((ext_vector_type(4)))unsigned;
constexpr int BATCH=8,NHEAD=8,SEQ=2048,D=64,DM=NHEAD*D,DMO=1024;
constexpr int NW=8,QBLK=32,QB=QBLK*NW,KVBLK=64,NQB=SEQ/QB;
constexpr int ATTN_PITCH=DM, ATTN_UNIT_ROWS=QB;
__device__ __forceinline__ int crow(int r,int hi){return (r&3)+8*(r>>2)+4*hi;}
#define SBAR() __builtin_amdgcn_sched_barrier(0)
typedef unsigned u32x16 __attribute__((ext_vector_type(16)));
constexpr int NSLOT=3, SLOTB=8192;
constexpr int LDS_K=0, LDS_V=NSLOT*SLOTB, LDS_WS=2*NSLOT*SLOTB, LDS_OST=LDS_WS+NW*64*4, LDS_BYTES=LDS_OST+NW*4096;
constexpr float C2=0.125f*1.4426950408889634f;
__device__ __forceinline__ void glds16(const void*gsrc,unsigned lds_dst){unsigned keep;
  asm volatile("s_mov_b32 %0, m0\n\ts_mov_b32 m0, %2\n\ts_nop 0\n\tglobal_load_lds_dwordx4 %1, off\n\ts_mov_b32 m0, %0":"=&s"(keep):"v"(gsrc),"s"(lds_dst):"memory");}
__device__ __forceinline__ float max3f(float a,float b,float c){float r;asm("v_max3_f32 %0, %1, %2, %3":"=v"(r):"v"(a),"v"(b),"v"(c));return r;}
__device__ __forceinline__ float max2f(float a,float b){float r;asm("v_max_f32_e32 %0, %1, %2":"=v"(r):"v"(a),"v"(b));return r;}
__device__ __forceinline__ float fadd_s(float a,float b){float r;asm("v_add_f32_e32 %0, %1, %2":"=v"(r):"v"(a),"v"(b));return r;}
__device__ __forceinline__ float fsub_s(float a,float b){float r;asm("v_sub_f32_e32 %0, %1, %2":"=v"(r):"v"(a),"v"(b));return r;}
typedef float f32x2_t __attribute__((ext_vector_type(2))); typedef __bf16 bf16x2_t __attribute__((ext_vector_type(2)));
__device__ __forceinline__ unsigned cvtpk_s(float lo,float hi){f32x2_t v={lo,hi};bf16x2_t b=__builtin_convertvector(v,bf16x2_t);return __builtin_bit_cast(unsigned,b);}
#define WAIT_BAR(N) asm volatile("s_waitcnt vmcnt(" #N ") lgkmcnt(0)\n\ts_barrier":::"memory")

__device__ __forceinline__ void qkt(f32x16&p0,f32x16&p1,const char*Kslot,const bf16x8*qr,int r32,int hi){ const f32x16 negm=f32x16{};
  const char*kb=Kslot+hi*1024+r32*16;
  #pragma unroll
  for(int d0=0;d0<4;++d0){
    const bf16x8 b0=*reinterpret_cast<const bf16x8*>(kb+d0*2048);
    const bf16x8 b1=*reinterpret_cast<const bf16x8*>(kb+d0*2048+512);
    if(d0==0){p0=__builtin_amdgcn_mfma_f32_32x32x16_bf16(b0,qr[0],negm,0,0,0);p1=__builtin_amdgcn_mfma_f32_32x32x16_bf16(b1,qr[0],negm,0,0,0);}
    else{p0=__builtin_amdgcn_mfma_f32_32x32x16_bf16(b0,qr[d0],p0,0,0,0);p1=__builtin_amdgcn_mfma_f32_32x32x16_bf16(b1,qr[d0],p1,0,0,0);}}
}
typedef __attribute__((address_space(3))) const char* lds_cptr;
typedef short v4i16_t __attribute__((ext_vector_type(4)));
__device__ __forceinline__ void kload8(bf16x8*kf,lds_cptr kp){
  kf[0]=*(const __attribute__((address_space(3))) bf16x8*)(kp);      kf[1]=*(const __attribute__((address_space(3))) bf16x8*)(kp+512);
  kf[2]=*(const __attribute__((address_space(3))) bf16x8*)(kp+2048); kf[3]=*(const __attribute__((address_space(3))) bf16x8*)(kp+2560);
  kf[4]=*(const __attribute__((address_space(3))) bf16x8*)(kp+4096); kf[5]=*(const __attribute__((address_space(3))) bf16x8*)(kp+4608);
  kf[6]=*(const __attribute__((address_space(3))) bf16x8*)(kp+6144); kf[7]=*(const __attribute__((address_space(3))) bf16x8*)(kp+6656);
}
__device__ __forceinline__ void kload2(bf16x8*kf,lds_cptr kp,int j){ kf[2*j]=*(const __attribute__((address_space(3))) bf16x8*)(kp+j*2048); kf[2*j+1]=*(const __attribute__((address_space(3))) bf16x8*)(kp+j*2048+512); }
__device__ __forceinline__ s16x4 vtr(lds_cptr p){ return __builtin_bit_cast(s16x4,__builtin_amdgcn_ds_read_tr16_b64_v4i16((__attribute__((address_space(3))) v4i16_t*)p)); }
__device__ __forceinline__ float rowmax(const f32x16&p0,const f32x16&p1){
  float a=max3f(p0[0],p0[1],p1[0]),b=max3f(p0[2],p0[3],p1[1]);a=max3f(a,p1[2],p1[3]);
  #pragma unroll
  for(int r=4;r<16;r+=4){a=max3f(a,p0[r],p0[r+1]);b=max3f(b,p0[r+2],p0[r+3]);a=max3f(a,p1[r],p1[r+1]);b=max3f(b,p1[r+2],p1[r+3]);}
  const float m=max2f(a,b);
  auto rr=__builtin_amdgcn_permlane32_swap(__float_as_uint(m),__float_as_uint(m),false,false);
  return max2f(__uint_as_float(rr[0]),__uint_as_float(rr[1]));
}
__device__ __forceinline__ void pv(f32x16*o,int vb,bf16x8 pa0,bf16x8 pa1,bf16x8 pa2,bf16x8 pa3){
  #pragma unroll
  for(int d0=0;d0<2;++d0){s16x4 lo[4],hi[4];
    #pragma unroll
    for(int ks=0;ks<4;++ks){
      asm volatile("ds_read_b64_tr_b16 %0,%1 offset:%c2":"=&v"(lo[ks]):"v"(vb),"i"(d0*4096+ks*1024):"memory");
      asm volatile("ds_read_b64_tr_b16 %0,%1 offset:%c2":"=&v"(hi[ks]):"v"(vb),"i"(d0*4096+ks*1024+512):"memory");}
    asm volatile("s_waitcnt lgkmcnt(0)":::"memory");SBAR();
    #define PK(k) (bf16x8){lo[k][0],lo[k][1],lo[k][2],lo[k][3],hi[k][0],hi[k][1],hi[k][2],hi[k][3]}
    o[d0]=__builtin_amdgcn_mfma_f32_32x32x16_bf16(pa0,PK(0),o[d0],0,0,0);
    o[d0]=__builtin_amdgcn_mfma_f32_32x32x16_bf16(pa1,PK(1),o[d0],0,0,0);
    o[d0]=__builtin_amdgcn_mfma_f32_32x32x16_bf16(pa2,PK(2),o[d0],0,0,0);
    o[d0]=__builtin_amdgcn_mfma_f32_32x32x16_bf16(pa3,PK(3),o[d0],0,0,0);
    #undef PK
  }
}

#ifndef ATTN_STORE16
#define ATTN_STORE16(p,v) (*(u32x4*)(p)=(v))
#endif
template<int THRL> __device__ __forceinline__ void attn_unit(int b,int h,int qb,const bf16*Q,const bf16*__restrict__ K,const bf16*__restrict__ V,bf16*O,const unsigned long long*MT,char*shm){
  const int tid=threadIdx.x,lane=tid&63,r32=lane&31,hi=lane>>5; const int wid=__builtin_amdgcn_readfirstlane(tid>>6);
  const long rowbase=(long)b*SEQ; const int q0=qb*QB;
  const bf16*Qw=Q+(rowbase+q0+wid*QBLK)*DM+h*D;
  const bf16*Kh=K+rowbase*DM+h*D,*Vh=V+rowbase*DM+h*D;
  const unsigned lds0=(unsigned)(uintptr_t)shm;
  float*wsf=(float*)(shm+LDS_WS)+wid*64;
  const bf16*ksrc=Kh+(long)lane*DM+wid*8;
  const bf16*vsrc=Vh+(long)(16*(wid&3)+(lane>>2))*DM+(wid>>2)*32+(lane&3)*8;
  const unsigned kdst=lds0+LDS_K+wid*1024, vdst=lds0+LDS_V+wid*1024;
  #define DMA_K(t,slot) glds16(ksrc+(long)(t)*KVBLK*DM,(unsigned)__builtin_amdgcn_readfirstlane(kdst+(slot)))
  #define DMA_V(t,slot) glds16(vsrc+(long)(t)*KVBLK*DM,(unsigned)__builtin_amdgcn_readfirstlane(vdst+(slot)))
  const int vb0=(int)(lds0+LDS_V)+((lane>>4)&1)*32+(lane&3)*8+(4*hi+((lane&15)>>2))*64;
  const char*Kbase=shm+LDS_K; bf16x8 kf[8];
  const lds_cptr shm3=(lds_cptr)shm; const lds_cptr kp0=shm3+LDS_K+hi*1024+r32*16; const lds_cptr vp0=shm3+LDS_V+((lane>>4)&1)*32+(lane&3)*8+(4*hi+((lane&15)>>2))*64;
  const int NT=(q0+QB)/KVBLK;
  const unsigned long long*mbase=MT+((size_t)((b*(SEQ/32)+qb*NW+wid)*(SEQ/KVBLK)))*32;
  u32x16 mk0,mk1,mk2,mk3; const float NEGV=-INFINITY;
  #define MLOAD(t) do{ const unsigned long long*mp_=mbase+(size_t)(t)*32; \
    asm volatile("s_load_dwordx16 %0, %4, 0x0\n\ts_load_dwordx16 %1, %4, 0x40\n\ts_load_dwordx16 %2, %4, 0x80\n\ts_load_dwordx16 %3, %4, 0xc0":"=&s"(mk0),"=&s"(mk1),"=&s"(mk2),"=&s"(mk3):"s"(mp_):"memory"); }while(0)
  #define MK64(v,i) (((unsigned long long)(v)[2*(i)+1]<<32)|(unsigned long long)(v)[2*(i)])
  #define MAPPLY(P0,P1) do{ asm volatile("s_waitcnt lgkmcnt(0)":"+s"(mk0),"+s"(mk1),"+s"(mk2),"+s"(mk3)::"memory"); \
    _Pragma("unroll") for(int r=0;r<8;++r){ P0[r]=__builtin_amdgcn_inverse_ballot_w64(MK64(mk0,r))?P0[r]:NEGV; P0[r+8]=__builtin_amdgcn_inverse_ballot_w64(MK64(mk1,r))?P0[r+8]:NEGV; \
      P1[r]=__builtin_amdgcn_inverse_ballot_w64(MK64(mk2,r))?P1[r]:NEGV; P1[r+8]=__builtin_amdgcn_inverse_ballot_w64(MK64(mk3,r))?P1[r+8]:NEGV; } }while(0)
  DMA_K(0,0);DMA_V(0,0);DMA_K(1,SLOTB);
  bf16x8 qr[4];
  #pragma unroll
  for(int d0=0;d0<4;++d0)qr[d0]=*reinterpret_cast<const bf16x8*>(&Qw[(long)r32*DM+d0*16+hi*8]);
  float mhat=0.f,l_reg=0.f;f32x16 o[2];o[0]=f32x16{};o[1]=f32x16{};const f32x16 zc=f32x16{};
  bool resc=false;
  #define START(P0,P1) do{ const float rm=rowmax(P0,P1); resc=false; \
    { const float dl=max2f(rm,-30.f); mhat=fadd_s(mhat,dl); \
      _Pragma("unroll") for(int r=0;r<16;++r){P0[r]=fsub_s(P0[r],dl);P1[r]=fsub_s(P1[r],dl);} \
      } \
    _Pragma("unroll") for(int r=0;r<16;++r)P0[r]=__builtin_amdgcn_exp2f(P0[r]); }while(0)
  #define RESC() do{ if(resc){ asm volatile("s_waitcnt lgkmcnt(0)":::"memory"); \
      _Pragma("unroll") for(int d_=0;d_<2;++d_) _Pragma("unroll") for(int r=0;r<16;++r)o[d_][r]*=wsf[crow(r,hi)]; } }while(0)
  f32x16 pA0,pA1,pB0,pB1;
  int sl_prev=0,sl_cur=0,sl_next=SLOTB;
  #define ROT() do{sl_prev=sl_cur;sl_cur=sl_next;sl_next=(sl_next==(NSLOT-1)*SLOTB)?0:sl_next+SLOTB;}while(0)
  DMA_K(2,2*SLOTB);
  WAIT_BAR(3);
  MLOAD(0); qkt(pA0,pA1,Kbase,qr,r32,hi);asm volatile("s_nop 15\n\ts_nop 7":"+v"(pA0),"+v"(pA1));MAPPLY(pA0,pA1);asm volatile("s_nop 1":"+v"(pA0),"+v"(pA1));
  START(pA0,pA1);
  _Pragma("unroll") for(int r=0;r<16;++r)pA1[r]=__builtin_amdgcn_exp2f(pA1[r]);
  WAIT_BAR(0);
  DMA_K(3,0);DMA_V(1,SLOTB);
  ROT();
  kload8(kf,kp0+sl_cur);
  WAIT_BAR(2);
  s16x4 vlo[8],vhi[8]; u32x4 pw0,pw1,pw2,pw3;
  #define PKW(P,B) cvtpk_s(P[B],P[B+1])
  #define PAF(k) __builtin_bit_cast(bf16x8,pw##k)
  #define VFR(i) (bf16x8){vlo[i][0],vlo[i][1],vlo[i][2],vlo[i][3],vhi[i][0],vhi[i][1],vhi[i][2],vhi[i][3]}
  #define PIN(x) asm volatile("":"+v"(x))
  #define MX3(a,b,c) __builtin_fmaxf(__builtin_fmaxf((a),(b)),(c))
  #define GAPA(MF,A0,A1,A2,A3,W0,W1,PW) do{ MF; sacc+=A0; sacc+=A1; sacc+=A2; sacc+=A3; PIN(sacc); W0; W1; PIN(PW); SBAR(); }while(0)
  #define EX(v) __builtin_amdgcn_exp2f(v)
  #define GAPB(MF,X,B) do{ MF; X[B]=EX(X[B]); X[B+1]=EX(X[B+1]); X[B+2]=EX(X[B+2]); X[B+3]=EX(X[B+3]); PIN(X); SBAR(); }while(0)
  #define VRD(i) do{ vlo[i]=vtr(vp_+(((i)>>2)*4096+((i)&3)*1024)); vhi[i]=vtr(vp_+(((i)>>2)*4096+((i)&3)*1024+512)); }while(0)
  #define KRD(G,j) do{ if(G){ kload2(kf,kp0+sl_next,j); SBAR(); } }while(0)
  #define STEP(C0,C1,P0,P1,t,GK,GV,GL) do{ SBAR(); MLOAD(t); \
    const lds_cptr vp_=vp0+sl_prev; \
    VRD(0); SBAR(); float sacc=(P0[0]+P0[1]); \
    GAPA(C0=__builtin_amdgcn_mfma_f32_32x32x16_bf16(kf[0],qr[0],zc,0,0,0), P0[2],P0[3],P0[4],P0[5],     pw0[0]=PKW(P0,0), pw0[1]=PKW(P0,2), pw0); \
    VRD(4); SBAR(); GAPA(C1=__builtin_amdgcn_mfma_f32_32x32x16_bf16(kf[1],qr[0],zc,0,0,0), P0[6],P0[7],P0[8],P0[9],     pw0[2]=PKW(P0,4), pw0[3]=PKW(P0,6), pw0); \
    VRD(1); SBAR(); GAPA(C0=__builtin_amdgcn_mfma_f32_32x32x16_bf16(kf[2],qr[1],C0,0,0,0),   P0[10],P0[11],P0[12],P0[13], pw1[0]=PKW(P0,8), pw1[1]=PKW(P0,10), pw1); \
    VRD(5); SBAR(); GAPA(C1=__builtin_amdgcn_mfma_f32_32x32x16_bf16(kf[3],qr[1],C1,0,0,0),   P0[14],P0[15],P1[0],P1[1],   pw1[2]=PKW(P0,12),pw1[3]=PKW(P0,14), pw1); \
    VRD(2); SBAR(); GAPA(C0=__builtin_amdgcn_mfma_f32_32x32x16_bf16(kf[4],qr[2],C0,0,0,0),   P1[2],P1[3],P1[4],P1[5],     pw2[0]=PKW(P1,0), pw2[1]=PKW(P1,2), pw2); \
    VRD(6); SBAR(); GAPA(C1=__builtin_amdgcn_mfma_f32_32x32x16_bf16(kf[5],qr[2],C1,0,0,0),   P1[6],P1[7],P1[8],P1[9],     pw2[2]=PKW(P1,4), pw2[3]=PKW(P1,6), pw2); \
    VRD(3); SBAR(); GAPA(C0=__builtin_amdgcn_mfma_f32_32x32x16_bf16(kf[6],qr[3],C0,0,0,0),   P1[10],P1[11],P1[12],P1[13], pw3[0]=PKW(P1,8), pw3[1]=PKW(P1,10), pw3); \
    VRD(7); SBAR(); GAPA(C1=__builtin_amdgcn_mfma_f32_32x32x16_bf16(kf[7],qr[3],C1,0,0,0),   P1[14],P1[15],0.f,0.f,       pw3[2]=PKW(P1,12),pw3[3]=PKW(P1,14), pw3); \
    l_reg+=sacc; \
    if(GK){DMA_K((t)+3,sl_cur);} if(GV){DMA_V((t)+1,sl_next);} \
    MAPPLY(C0,C1); \
    { float a=MX3(C0[0],C0[1],C1[0]),b=MX3(C0[2],C0[3],C1[1]); a=MX3(a,C1[2],C1[3]); \
      _Pragma("unroll") for(int r=4;r<16;r+=4){a=MX3(a,C0[r],C0[r+1]);b=MX3(b,C0[r+2],C0[r+3]);a=MX3(a,C1[r],C1[r+1]);b=MX3(b,C1[r+2],C1[r+3]);} \
      float rm=__builtin_fmaxf(a,b); { auto rr=__builtin_amdgcn_permlane32_swap(__float_as_uint(rm),__float_as_uint(rm),false,false); rm=__builtin_fmaxf(__uint_as_float(rr[0]),__uint_as_float(rr[1])); } \
      resc=false; \
      const float rl=rm-mhat; \
      if(__builtin_expect(__any(rl>(float)THRL),0)){ const float dl=__builtin_fmaxf(rl,0.f); mhat+=dl; \
        const float f=__builtin_amdgcn_exp2f(-dl); l_reg*=f; if(hi==0)wsf[r32]=f; resc=true; } \
      _Pragma("unroll") for(int r=0;r<16;++r){C0[r]-=mhat;C1[r]-=mhat;} } \
    SBAR(); \
    GAPB(o[0]=__builtin_amdgcn_mfma_f32_32x32x16_bf16(PAF(0),VFR(0),o[0],0,0,0), C0,0); \
    GAPB(o[1]=__builtin_amdgcn_mfma_f32_32x32x16_bf16(PAF(0),VFR(4),o[1],0,0,0), C0,4); \
    KRD(GL,0); GAPB(o[0]=__builtin_amdgcn_mfma_f32_32x32x16_bf16(PAF(1),VFR(1),o[0],0,0,0), C0,8); \
    KRD(GL,1); GAPB(o[1]=__builtin_amdgcn_mfma_f32_32x32x16_bf16(PAF(1),VFR(5),o[1],0,0,0), C0,12); \
    KRD(GL,2); GAPB(o[0]=__builtin_amdgcn_mfma_f32_32x32x16_bf16(PAF(2),VFR(2),o[0],0,0,0), C1,0); \
    KRD(GL,3); GAPB(o[1]=__builtin_amdgcn_mfma_f32_32x32x16_bf16(PAF(2),VFR(6),o[1],0,0,0), C1,4); \
    GAPB(o[0]=__builtin_amdgcn_mfma_f32_32x32x16_bf16(PAF(3),VFR(3),o[0],0,0,0), C1,8); \
    GAPB(o[1]=__builtin_amdgcn_mfma_f32_32x32x16_bf16(PAF(3),VFR(7),o[1],0,0,0), C1,12); \
    }while(0)
  int t=1;
  for(;t+5<NT;t+=2){
    STEP(pB0,pB1,pA0,pA1,t,true,true,true);     WAIT_BAR(2); RESC(); ROT();
    STEP(pA0,pA1,pB0,pB1,t+1,true,true,true);   WAIT_BAR(2); RESC(); ROT();
  }
  #define ENDW(tt) do{ if((tt)+3<NT){WAIT_BAR(2);} else if((tt)+2<NT){WAIT_BAR(1);} else {WAIT_BAR(0);} }while(0)
  for(;t+1<NT;t+=2){
    STEP(pB0,pB1,pA0,pA1,t,(t+3<NT),(t+1<NT),(t+1<NT));       ENDW(t);   RESC(); ROT();
    STEP(pA0,pA1,pB0,pB1,t+1,(t+4<NT),(t+2<NT),(t+2<NT));     ENDW(t+1); RESC(); ROT();
  }
  STEP(pB0,pB1,pA0,pA1,NT-1,false,false,false); RESC();
  { float sacc=pB0[0]+pB0[1]; _Pragma("unroll") for(int r=2;r<16;++r)sacc+=pB0[r]; _Pragma("unroll") for(int r=0;r<16;++r)sacc+=pB1[r]; l_reg+=sacc;
    pw0=(u32x4){PKW(pB0,0),PKW(pB0,2),PKW(pB0,4),PKW(pB0,6)};pw1=(u32x4){PKW(pB0,8),PKW(pB0,10),PKW(pB0,12),PKW(pB0,14)};pw2=(u32x4){PKW(pB1,0),PKW(pB1,2),PKW(pB1,4),PKW(pB1,6)};pw3=(u32x4){PKW(pB1,8),PKW(pB1,10),PKW(pB1,12),PKW(pB1,14)};
    SBAR(); pv(o,vb0+sl_cur,PAF(0),PAF(1),PAF(2),PAF(3)); }
  #undef PKW
  #undef PAF
  #undef VFR
  #undef PIN
  #undef MX3
  #undef GAPA
  #undef GAPB
  #undef EX
  #undef VRD
  #undef KRD
  #undef STEP
  #undef ENDW
  {auto rr=__builtin_amdgcn_permlane32_swap(__float_as_uint(l_reg),__float_as_uint(l_reg),false,false);l_reg=__uint_as_float(rr[0])+__uint_as_float(rr[1]);}
  if(hi==0)wsf[32+r32]=l_reg;asm volatile("s_waitcnt lgkmcnt(0)":::"memory");
  float rli[16];
  #pragma unroll
  for(int r=0;r<16;++r)rli[r]=__builtin_amdgcn_rcpf(wsf[32+crow(r,hi)]);
  bf16*Ow=O+(rowbase+q0+wid*QBLK)*DMO+h*D;
  { bf16*stg=(bf16*)(shm+LDS_OST)+wid*2048;
    #pragma unroll
    for(int r=0;r<16;++r){const int orow=crow(r,hi);
      #pragma unroll
      for(int d0=0;d0<2;++d0)stg[orow*64+d0*32+r32]=__float2bfloat16(o[d0][r]*rli[r]);}
    asm volatile("s_waitcnt lgkmcnt(0)":::"memory");
    #pragma unroll
    for(int i=0;i<4;++i){const int row=i*8+(lane>>3),ch=lane&7; const u32x4 v=*(const u32x4*)(stg+row*64+ch*8); ATTN_STORE16(Ow+(long)row*DMO+ch*8,v);} }
  asm volatile("s_waitcnt lgkmcnt(0)\n\ts_barrier":::"memory");
  #undef DMA_K
  #undef DMA_V
  #undef MLOAD
  #undef MK64
  #undef MAPPLY
  #undef START
  #undef RESC
  #undef ROT
}
constexpr int ATTN_LDS_BYTES=LDS_BYTES;
struct AttnTensors { const bf16* Q; const bf16* K; const bf16* V; bf16* O; const unsigned long long* MT; };
struct AttnUnit { int bh; int qb; };
struct StaticOrder {
  int vcu;
  __device__ __forceinline__ explicit StaticOrder(int grid,int block):vcu((block%8)*(grid/8)+block/8){}
  __device__ __forceinline__ bool next(int i,AttnUnit&u)const{ if(i>=2)return false; const int s=vcu&3; u.bh=vcu>>2; u.qb=(i==0)?s:7-s; return true; }
  __device__ __forceinline__ void a_ready(const AttnUnit&)const{}
  __device__ __forceinline__ void done(const AttnUnit&)const{}
};
template<class Sched,int THRL=8> __device__ __forceinline__ void attn_phase(char*lds,const AttnTensors&T,const Sched&S){
  AttnUnit u;
  for(int i=0;S.next(i,u);++i){ S.a_ready(u); attn_unit<THRL>(u.bh/NHEAD,u.bh%NHEAD,u.qb,T.Q,T.K,T.V,T.O,T.MT,lds); S.done(u); }
}
#undef SBAR
#undef WAIT_BAR
}
#define XB_TMO      128
#define XB_XCNT(j)  (256  + 64 * (j))
#define XB_XSUB(j)  (1280 + 64 * (j))
#define XB_XGEN(j)  (2304 + 64 * (j))
#define XB_TOP      3328
#define XB_TOPGEN   3392
#define XCD_BAR_WORDS 3456
#define XB_SPIN_CAP (1u << 18)

__device__ __forceinline__ unsigned xb_ld(unsigned* p)              { return __hip_atomic_load(p, __ATOMIC_RELAXED, __HIP_MEMORY_SCOPE_AGENT); }
__device__ __forceinline__ unsigned xb_add(unsigned* p, unsigned v) { return __hip_atomic_fetch_add(p, v, __ATOMIC_RELAXED, __HIP_MEMORY_SCOPE_AGENT); }
__device__ __forceinline__ unsigned xb_xcc_id() { return (unsigned)__builtin_amdgcn_s_getreg((3 << 11) | 20) & 0xFu; }
#define XB_SPIN(cond, bar) do { unsigned _sp = 0; while (cond) { __builtin_amdgcn_s_sleep(1); \
    if ((++_sp & 255u) == 0u) { if (xb_ld(&(bar)[XB_TMO])) break; if (_sp > XB_SPIN_CAP) { atomicAdd(&(bar)[XB_TMO], 1u); break; } } } } while (0)

struct XcdBarrier {
    unsigned* bar; unsigned x;
    volatile LAS unsigned* st;
};

__device__ __forceinline__ XcdBarrier xcd_barrier_post(unsigned* bar, volatile LAS unsigned* st) {
    XcdBarrier b; b.bar = bar; b.x = xb_xcc_id(); b.st = st;
    if (threadIdx.x == 0) (void)xb_add(&bar[XB_XCNT(b.x)], 1u);
    return b;
}
__device__ __forceinline__ void xcd_barrier_complete(unsigned* bar, unsigned x, unsigned& nloc, unsigned& nx) {
    const unsigned G = gridDim.x * gridDim.y * gridDim.z;
    unsigned sum, cnt, mine, sp = 0u;
    for (;;) {
        sum = 0u; cnt = 0u; mine = 0u;
#pragma unroll
        for (unsigned j = 0; j < 16; ++j) { const unsigned c = xb_ld(&bar[XB_XCNT(j)]); sum += c; cnt += (c > 0u) ? 1u : 0u; mine = (j == x) ? c : mine; }
        if (sum == G) break;
        __builtin_amdgcn_s_sleep(1);
        if ((++sp & 255u) == 0u) { if (xb_ld(&bar[XB_TMO])) break; if (sp > XB_SPIN_CAP) { atomicAdd(&bar[XB_TMO], 1u); break; } }
    }
    nloc = mine > 0u ? mine : 1u; nx = cnt > 0u ? cnt : 1u;
}

__device__ __forceinline__ void xcd_barrier(const XcdBarrier& b) {
    asm volatile("s_waitcnt vmcnt(0)" ::: "memory");
    __syncthreads();
    if (threadIdx.x == 0) {
        unsigned* bar = b.bar;
        __builtin_amdgcn_s_waitcnt(0);
        unsigned nloc = b.st[0], nx = b.st[1];
        if (nloc == 0u) { xcd_barrier_complete(bar, b.x, nloc, nx); b.st[0] = nloc; b.st[1] = nx; }
        const unsigned old = xb_add(&bar[XB_XSUB(b.x)], 1u);
        const unsigned gen = old / nloc;
        if (old + 1u == (gen + 1u) * nloc) {
            __builtin_amdgcn_fence(__ATOMIC_RELEASE, "agent");
            asm volatile("s_waitcnt vmcnt(0)" ::: "memory");
            const unsigned og = xb_add(&bar[XB_TOP], 1u);
            const unsigned tg = og / nx;
            if (og + 1u == (tg + 1u) * nx) xb_add(&bar[XB_TOPGEN], 1u);
            else XB_SPIN(xb_ld(&bar[XB_TOPGEN]) == tg, bar);
            __builtin_amdgcn_fence(__ATOMIC_ACQUIRE, "agent");
            xb_add(&bar[XB_XGEN(b.x)], 1u);
            asm volatile("s_waitcnt vmcnt(0)" ::: "memory");
        } else {
            XB_SPIN(xb_ld(&bar[XB_XGEN(b.x)]) == gen, bar);
            __builtin_amdgcn_fence(__ATOMIC_ACQUIRE, "agent");
            asm volatile("s_waitcnt vmcnt(0)" ::: "memory");
        }
    }
    __syncthreads();
}
#define GAS __attribute__((address_space(1)))
#ifndef LAS
#define LAS __attribute__((address_space(3)))
#endif
typedef unsigned short bf16;
typedef unsigned v4u __attribute__((ext_vector_type(4)));
typedef float f32x4 __attribute__((ext_vector_type(4)));
#define LDS_WAIT() asm volatile("s_waitcnt lgkmcnt(0)" ::: "memory")
#define VM_WAIT() asm volatile("s_waitcnt vmcnt(0)" ::: "memory")

constexpr int D = 1024, NB = 8, T = 2048, MP = NB * T, NSMP = 32, MT = MP + NSMP, MPAD = 16640;
constexpr int ATT_W = 512, AH = 8, IH = 16, IDD = 64, TOPK = 256;
constexpr int RW_W = 512, RH = 8, RN = 64;
constexpr int RW_COLS = 1792, IN_COLS = 4432, NIN = 4608;
constexpr int FFN = 2816, NGU = 2 * FFN;
constexpr int NPAGES = 64, PAGE = 128, PAST = 8192, LS = PAST + 1, SCS_LD = 8704;
constexpr int O_Q = 0, O_K = 512, O_V = 1024, O_QI = 1536, O_KI = 2560, O_WI = 2624, O_RW = 2640;
constexpr float IDX_W_SCALE = 0.03125f;
constexpr float RMS_EPS = 1e-6f, GN_EPS = 64e-5f;
constexpr int MODW = 6 * D;

constexpr size_t OUT_Y = 0, OUT_YS = OUT_Y + (size_t)MP * D, OUT_KP = OUT_YS + (size_t)NSMP * D, OUT_VP = OUT_KP + (size_t)MP * ATT_W,
                 OUT_IKP = OUT_VP + (size_t)MP * ATT_W, OUT_WKVP = OUT_IKP + (size_t)MP * IDD, OUT_SHP = OUT_WKVP + (size_t)NB * RH * RN * RN,
                 OUT_KS = OUT_SHP + (size_t)NB * RW_COLS, OUT_VS = OUT_KS + (size_t)NSMP * ATT_W, OUT_IKS = OUT_VS + (size_t)NSMP * ATT_W,
                 OUT_WKVS = OUT_IKS + (size_t)NSMP * IDD, OUT_SHS = OUT_WKVS + (size_t)NSMP * RH * RN * RN, OUT_END = OUT_SHS + (size_t)NSMP * RW_COLS;
static_assert(OUT_END == 36052992, "output size");

constexpr size_t MiB = 1u << 20;
constexpr size_t WS_CTL = 0, CTL_ZERO_BYTES = 1 * MiB;
constexpr size_t WS_MOD = 1 * MiB;
constexpr size_t WS_WIN = 2 * MiB;
constexpr size_t WS_WOUT = 12 * MiB;
constexpr size_t WS_WGU = 14 * MiB;
constexpr size_t WS_WDN = 26 * MiB;
constexpr size_t WS_A1 = 32 * MiB;
constexpr size_t WS_A2 = 66 * MiB;
constexpr size_t WS_MIX = 100 * MiB;
constexpr size_t WS_HB = 134 * MiB;
constexpr size_t WS_X1 = 224 * MiB;
constexpr size_t WS_PROJ = 290 * MiB;
constexpr size_t WS_PRW = 290 * MiB;
constexpr size_t WS_RAW = 584 * MiB;
constexpr size_t WS_RAW2 = 650 * MiB;
constexpr size_t WS_QN = 1008 * MiB;
constexpr size_t WS_RWA = 1042 * MiB, RWA_STRIDE = 33 * MiB;
constexpr size_t WS_Y = 1273 * MiB;
constexpr size_t WS_SC = 1306 * MiB;
constexpr size_t WS_SCS = 1434 * MiB;
constexpr size_t WS_MASK = 1436 * MiB;
constexpr size_t WS_SLIST = 1440 * MiB;
constexpr size_t WS_QB = 1444 * MiB, WS_KB = 1461 * MiB, WS_VB = 1478 * MiB;
constexpr size_t WS_MASKT = 1495 * MiB;
constexpr size_t WS_QIB = 1500 * MiB;
constexpr size_t WS_KIB = 1536 * MiB;
constexpr size_t WS_WI = 1539 * MiB;
constexpr size_t WS_LIN = 1541 * MiB;
constexpr size_t WS_KX = 1550 * MiB;
constexpr size_t WS_W2T = 1583 * MiB, WS_A2T = 1584 * MiB, WS_G2T = 1585 * MiB;
constexpr size_t WS_MF = 1586 * MiB, WS_NT = 1603 * MiB, WS_PF = 1636 * MiB, WS_QP = 1653 * MiB, WS_ZF = 1686 * MiB;
constexpr size_t WS_Y2 = 1703 * MiB;
constexpr size_t WS_END = 1736 * MiB;
constexpr int QI_LD = 17 * 64;
constexpr int CW_BAR = 4096;

constexpr int NWAVES = 8, NTHREADS = 512;
constexpr int LDS_BYTES = 147456, MISC_OFF = 147200;

__device__ __forceinline__ unsigned f2bf(float f) { unsigned u = __builtin_bit_cast(unsigned, f); return (u + 0x7fffu + ((u >> 16) & 1u)) >> 16; }
__device__ __forceinline__ unsigned pk2(float lo, float hi) { return f2bf(lo) | (f2bf(hi) << 16); }
__device__ __forceinline__ float wave_sum(float v) {
#pragma unroll
    for (int o = 1; o < 64; o <<= 1) v += __shfl_xor(v, o);
    return v;
}
__device__ __forceinline__ float wave_max(float v) {
#pragma unroll
    for (int o = 1; o < 64; o <<= 1) v = fmaxf(v, __shfl_xor(v, o));
    return v;
}
__device__ __forceinline__ int wave_sum_i(int v) {
#pragma unroll
    for (int o = 1; o < 64; o <<= 1) v += __shfl_xor(v, o);
    return v;
}
__device__ __forceinline__ float sigmoidf_(float x) { return 1.f / (1.f + expf(-x)); }
__device__ __forceinline__ unsigned sortable(float f) { const unsigned u = __builtin_bit_cast(unsigned, f); return (u & 0x80000000u) ? ~u : (u | 0x80000000u); }
__device__ __forceinline__ unsigned long long lanemask_lt(int lane) { return (1ull << lane) - 1ull; }
__device__ __forceinline__ float rdlane(float v, int l) { return __builtin_bit_cast(float, __builtin_amdgcn_readlane(__builtin_bit_cast(int, v), l)); }

struct Args { const float* in[32]; float* out; unsigned char* ws; int ph_lo, ph_hi; };

struct Ctx {
    LAS unsigned char* lds;
    int tid, lane, wave, G, gw, ngw;
    const float* const* in; float* out; unsigned char* ws;
};
__device__ __forceinline__ const float* x_row(const Ctx& C, int m) { return m < MP ? C.in[0] + (size_t)m * D : C.in[1] + (size_t)(m - MP) * D; }
__device__ __forceinline__ int mod_row(int m) { return m < MP ? (m >> 11) : NB + (m - MP); }

struct EpiRawF32 {
    static constexpr bool PERM = false, AFTER_DRAIN = false;
    float* O; int ldc;
    __device__ __forceinline__ void operator()(const pg8::f32x4 (&acc)[2][2][4][2], const pg8::Unit& u, int wr, int wc, int fr, int fq) const {
        const int row0 = u.pm * 256 + wr * 64 + fr, col0 = u.pn * 256 + wc * 32 + 4 * fq;
#pragma unroll
        for (int ai = 0; ai < 2; ++ai)
#pragma unroll
            for (int m = 0; m < 4; ++m) { float* rowp = O + (size_t)(row0 + ai * 128 + m * 16) * ldc + col0;
#pragma unroll
                for (int bj = 0; bj < 2; ++bj)
#pragma unroll
                    for (int n = 0; n < 2; ++n) *(pg8::f32x4*)(rowp + bj * 128 + n * 16) = acc[ai][bj][m][n]; }
    }
};

struct EpiResGate {
    static constexpr bool PERM = false, AFTER_DRAIN = false;
    const float* base; const float* gate; float* out;
    __device__ __forceinline__ void operator()(const pg8::f32x4 (&acc)[2][2][4][2], const pg8::Unit& u, int wr, int wc, int fr, int fq) const {
        const int row0 = u.pm * 256 + wr * 64 + fr, col0 = u.pn * 256 + wc * 32 + 4 * fq;
        const float* gp = gate + (size_t)((u.pm * 256) >> 11) * MODW + col0;
        pg8::f32x4 gv[2][2];
#pragma unroll
        for (int bj = 0; bj < 2; ++bj)
#pragma unroll
            for (int n = 0; n < 2; ++n) gv[bj][n] = *(const pg8::f32x4*)(gp + bj * 128 + n * 16);
#pragma unroll
        for (int ai = 0; ai < 2; ++ai)
#pragma unroll
            for (int m = 0; m < 4; ++m) { const size_t off = (size_t)(row0 + ai * 128 + m * 16) * D + col0;
#pragma unroll
                for (int bj = 0; bj < 2; ++bj)
#pragma unroll
                    for (int n = 0; n < 2; ++n) { const pg8::f32x4 bv = *(const pg8::f32x4*)(base + off + bj * 128 + n * 16);
                        *(pg8::f32x4*)(out + off + bj * 128 + n * 16) = bv + gv[bj][n] * acc[ai][bj][m][n]; } }
    }
};
struct EpiIn {
    static constexpr bool PERM = true, AFTER_DRAIN = false;
    unsigned char* ws; float* out; const float* qg; const float* kg;
    __device__ __forceinline__ void operator()(const pg8::f32x4 (&acc)[2][2][4][2], const pg8::Unit& u, int wr, int wc, int fr, int fq) const {
        const int pn = u.pn; const bool smp = u.pm == MP / 256;
        bf16* QB = (bf16*)(ws + WS_QB); bf16* KB = (bf16*)(ws + WS_KB); bf16* VB = (bf16*)(ws + WS_VB); bf16* QIb = (bf16*)(ws + WS_QIB); bf16* KIb = (bf16*)(ws + WS_KIB);
        float* QN = (float*)(ws + WS_QN); float* WI = (float*)(ws + WS_WI); float* PRW = (float*)(ws + WS_PRW);
        float gq[2][8];
        if (pn < 4) {
#pragma unroll
            for (int bj = 0; bj < 2; ++bj)
#pragma unroll
                for (int e = 0; e < 8; ++e) gq[bj][e] = (pn < 2 ? qg : kg)[32 * bj + 8 * fq + e] * (pn < 2 ? attn_body::C2 : 1.f);
        }
#pragma unroll
        for (int ai = 0; ai < 2; ++ai)
#pragma unroll
            for (int m = 0; m < 4; ++m) {
                const int r = u.pm * 256 + ai * 128 + wr * 64 + m * 16 + fr; const bool ok = r < MT;
                float v[2][8];
#pragma unroll
                for (int bj = 0; bj < 2; ++bj)
#pragma unroll
                    for (int n = 0; n < 2; ++n)
#pragma unroll
                        for (int i = 0; i < 4; ++i) v[bj][4 * n + i] = acc[ai][bj][m][n][i];
                float rstd = 1.f;
                if (pn < 4 || (pn == 10 && wc == 0)) { float ss = 0.f;
#pragma unroll
                    for (int bj = 0; bj < 2; ++bj)
#pragma unroll
                        for (int e = 0; e < 8; ++e) ss += v[bj][e] * v[bj][e];
                    ss += __shfl_xor(ss, 16); ss += __shfl_xor(ss, 32);
                    rstd = 1.f / sqrtf(ss * (1.f / 64.f) + RMS_EPS); }
                if (!ok) continue;
#pragma unroll
                for (int bj = 0; bj < 2; ++bj) {
                    const int cl = 32 * bj + 8 * fq;
                    float* x = v[bj];
                    if (pn < 2) {
                        const int col = (4 * pn + wc) * 64 + cl; pg8::u32x4 w;
                        w.x = pg8::cvt_pk_bf16(x[0] * rstd * gq[bj][0], x[1] * rstd * gq[bj][1]); w.y = pg8::cvt_pk_bf16(x[2] * rstd * gq[bj][2], x[3] * rstd * gq[bj][3]);
                        w.z = pg8::cvt_pk_bf16(x[4] * rstd * gq[bj][4], x[5] * rstd * gq[bj][5]); w.w = pg8::cvt_pk_bf16(x[6] * rstd * gq[bj][6], x[7] * rstd * gq[bj][7]);
                        *(pg8::u32x4*)(QB + (size_t)r * ATT_W + col) = w;
                        if (smp) { const float ic = 1.f / attn_body::C2; float* qn = QN + (size_t)r * ATT_W + col;
                            *(pg8::f32x4*)qn = (pg8::f32x4){x[0] * rstd * gq[bj][0] * ic, x[1] * rstd * gq[bj][1] * ic, x[2] * rstd * gq[bj][2] * ic, x[3] * rstd * gq[bj][3] * ic};
                            *(pg8::f32x4*)(qn + 4) = (pg8::f32x4){x[4] * rstd * gq[bj][4] * ic, x[5] * rstd * gq[bj][5] * ic, x[6] * rstd * gq[bj][6] * ic, x[7] * rstd * gq[bj][7] * ic}; }
                    } else if (pn < 6) {
                        const bool isk = pn < 4; const int col = (4 * (pn & 1) + wc) * 64 + cl; float y[8];
#pragma unroll
                        for (int e = 0; e < 8; ++e) y[e] = isk ? x[e] * rstd * gq[bj][e] : x[e];
                        float* o = out + (isk ? (smp ? OUT_KS : OUT_KP) : (smp ? OUT_VS : OUT_VP)) + (size_t)(smp ? r - MP : r) * ATT_W + col;
                        *(pg8::f32x4*)o = (pg8::f32x4){y[0], y[1], y[2], y[3]}; *(pg8::f32x4*)(o + 4) = (pg8::f32x4){y[4], y[5], y[6], y[7]};
                        pg8::u32x4 w; w.x = pg8::cvt_pk_bf16(y[0], y[1]); w.y = pg8::cvt_pk_bf16(y[2], y[3]); w.z = pg8::cvt_pk_bf16(y[4], y[5]); w.w = pg8::cvt_pk_bf16(y[6], y[7]);
                        *(pg8::u32x4*)((isk ? KB : VB) + (size_t)r * ATT_W + col) = w;
                    } else if (pn < 10) {
                        const int col = (4 * (pn - 6) + wc) * 64 + cl;
                        pg8::u32x4 w; w.x = pg8::cvt_pk_bf16(x[0], x[1]); w.y = pg8::cvt_pk_bf16(x[2], x[3]); w.z = pg8::cvt_pk_bf16(x[4], x[5]); w.w = pg8::cvt_pk_bf16(x[6], x[7]);
                        *(pg8::u32x4*)(QIb + (size_t)r * QI_LD + col) = w;
                    } else if (pn == 10) {
                        if (wc == 0) {
                            float* o = out + (smp ? OUT_IKS : OUT_IKP) + (size_t)(smp ? r - MP : r) * IDD + cl;
                            *(pg8::f32x4*)o = (pg8::f32x4){x[0] * rstd, x[1] * rstd, x[2] * rstd, x[3] * rstd}; *(pg8::f32x4*)(o + 4) = (pg8::f32x4){x[4] * rstd, x[5] * rstd, x[6] * rstd, x[7] * rstd};
                            pg8::u32x4 w; w.x = pg8::cvt_pk_bf16(x[0] * rstd, x[1] * rstd); w.y = pg8::cvt_pk_bf16(x[2] * rstd, x[3] * rstd); w.z = pg8::cvt_pk_bf16(x[4] * rstd, x[5] * rstd); w.w = pg8::cvt_pk_bf16(x[6] * rstd, x[7] * rstd);
                            *(pg8::u32x4*)(KIb + (size_t)r * IDD + cl) = w;
                        } else if (wc == 1) {
                            if (bj == 0 && fq < 2) { float* o = WI + (size_t)r * IH + 8 * fq; *(pg8::f32x4*)o = (pg8::f32x4){x[0], x[1], x[2], x[3]}; *(pg8::f32x4*)(o + 4) = (pg8::f32x4){x[4], x[5], x[6], x[7]}; }
                        } else {
                            float* o = PRW + (size_t)r * RW_COLS + 1536 + 64 * (wc - 2) + cl;
                            *(pg8::f32x4*)o = (pg8::f32x4){x[0], x[1], x[2], x[3]}; *(pg8::f32x4*)(o + 4) = (pg8::f32x4){x[4], x[5], x[6], x[7]}; }
                    } else if (pn < 17) {
                        float* o = PRW + (size_t)r * RW_COLS + (pn - 11) * 256 + 64 * wc + cl;
                        *(pg8::f32x4*)o = (pg8::f32x4){x[0], x[1], x[2], x[3]}; *(pg8::f32x4*)(o + 4) = (pg8::f32x4){x[4], x[5], x[6], x[7]};
                    } else if (wc < 2) {
                        float* o = PRW + (size_t)r * RW_COLS + 1664 + 64 * wc + cl;
                        *(pg8::f32x4*)o = (pg8::f32x4){x[0], x[1], x[2], x[3]}; *(pg8::f32x4*)(o + 4) = (pg8::f32x4){x[4], x[5], x[6], x[7]}; }
                }
            }
    }
};
struct EpiSwiGLU {
    static constexpr bool PERM = true, AFTER_DRAIN = false;
    bf16* H;
    __device__ __forceinline__ void operator()(const pg8::f32x4 (&acc)[2][2][4][2], const pg8::Unit& u, int wr, int wc, int fr, int fq) const {
        const int row0 = u.pm * 256 + wr * 64 + fr, col0 = u.pn * 128 + wc * 32 + 8 * fq;
#pragma unroll
        for (int ai = 0; ai < 2; ++ai)
#pragma unroll
            for (int m = 0; m < 4; ++m) { float hv[8];
#pragma unroll
                for (int n = 0; n < 2; ++n)
#pragma unroll
                    for (int i = 0; i < 4; ++i) { const float g = acc[ai][0][m][n][i], up = acc[ai][1][m][n][i]; hv[4 * n + i] = g * __builtin_amdgcn_rcpf(1.f + __expf(-g)) * up; }
                pg8::u32x4 w; w.x = pg8::cvt_pk_bf16(hv[0], hv[1]); w.y = pg8::cvt_pk_bf16(hv[2], hv[3]); w.z = pg8::cvt_pk_bf16(hv[4], hv[5]); w.w = pg8::cvt_pk_bf16(hv[6], hv[7]);
                *(pg8::u32x4*)(H + (size_t)(row0 + ai * 128 + m * 16) * FFN + col0) = w; }
    }
};
template <class F> __device__ __forceinline__ void sample_gemm(const Ctx& C, const bf16* A, const bf16* Bt, int K, const F& f) {
    typedef short bf16x8 __attribute__((ext_vector_type(8))); typedef float f32x16 __attribute__((ext_vector_type(16)));
    LAS float* red = (LAS float*)C.lds;
    const int lane = C.lane, hi = lane >> 5, ksteps = K / 16 / NWAVES;
    for (int u = (int)blockIdx.x - 128; u >= 0 && u < D / 32; u += C.G) {
        const int n0 = 32 * u;
        const bf16* ap = A + (size_t)(lane & 31) * K + (size_t)C.wave * ksteps * 16 + 8 * hi; const bf16* bp = Bt + (size_t)(n0 + (lane & 31)) * K + (size_t)C.wave * ksteps * 16 + 8 * hi;
        f32x16 acc = f32x16{};
        for (int ks = 0; ks < ksteps; ++ks) acc = __builtin_amdgcn_mfma_f32_32x32x16_bf16(*(const bf16x8*)(ap + 16 * ks), *(const bf16x8*)(bp + 16 * ks), acc, 0, 0, 0);
        __syncthreads();
#pragma unroll
        for (int r = 0; r < 16; ++r) red[(C.wave * 64 + lane) * 16 + r] = acc[r];
        __syncthreads();
        for (int o = C.tid; o < 1024; o += NTHREADS) { const int ls = o & 63, r = o >> 6; float v = 0.f;
#pragma unroll
            for (int w = 0; w < 8; ++w) v += red[(w * 64 + ls) * 16 + r];
            f((r & 3) + 8 * (r >> 2) + 4 * (ls >> 5), n0 + (ls & 31), v); }
    }
    __syncthreads();
}

__device__ __forceinline__ void p0_mod(const Ctx& C) {
    LAS float* sc = (LAS float*)C.lds;
    const float* cp = C.in[8]; const float* cs = C.in[9]; const float* wada = C.in[12]; const float* bada = C.in[13];
    float* MOD = (float*)(C.ws + WS_MOD);
    const int cl = C.tid & 31, kc = C.tid >> 5;
    for (int u = blockIdx.x; u < MODW / 32; u += C.G) {
        const int c0 = 32 * u;
        float acc[40];
#pragma unroll
        for (int r = 0; r < 40; ++r) acc[r] = 0.f;
        for (int hh = 0; hh < 2; ++hh) {
            __syncthreads();
            for (int i = C.tid; i < 40 * 512; i += NTHREADS) { const int r = i >> 9, kk = i & 511; const float v = (r < NB) ? cp[r * D + 512 * hh + kk] : cs[(r - NB) * D + 512 * hh + kk]; sc[i] = v / (1.f + expf(-v)); }
            __syncthreads();
            const int kb = 512 * hh + 32 * kc;
            for (int k4 = 0; k4 < 8; ++k4) {
                const float* wp = wada + (size_t)(kb + 4 * k4) * MODW + c0 + cl;
                const float w0 = wp[0], w1 = wp[MODW], w2 = wp[2 * MODW], w3 = wp[3 * MODW];
#pragma unroll
                for (int r = 0; r < 40; ++r) { const f32x4 s = *(const LAS f32x4*)(sc + r * 512 + 32 * kc + 4 * k4); acc[r] += s.x * w0 + s.y * w1 + s.z * w2 + s.w * w3; }
            }
        }
        __syncthreads();
#pragma unroll
        for (int r = 0; r < 40; ++r) sc[(kc * 40 + r) * 32 + cl] = acc[r];
        __syncthreads();
        for (int i = C.tid; i < 40 * 32; i += NTHREADS) { const int r = i >> 5, c = i & 31; float s = 0.f;
            for (int k = 0; k < 16; ++k) s += sc[(k * 40 + r) * 32 + c];
            MOD[r * MODW + c0 + c] = s + bada[c0 + c]; }
    }
    __syncthreads();
}
template <int MODE = 0> __device__ __forceinline__ void transpose_item(const float* W, int K, int N, int NP, bf16* WT, int row_off, LAS float* scr, int item, int lane) {
    const int nblk = NP / 32, kb = item / nblk, nb = item % nblk, k0 = 64 * kb, n0 = 32 * nb;
    const int nsrc = n0 + (lane & 31);
#pragma unroll 8
    for (int i = 0; i < 32; ++i) { const int kk = 2 * i + (lane >> 5); scr[kk * 33 + (lane & 31)] = (nsrc < N) ? W[(size_t)(k0 + kk) * N + nsrc] : 0.f; }
    LDS_WAIT(); asm volatile("" ::: "memory");
    const int c = lane & 7;
#pragma unroll
    for (int j = 0; j < 4; ++j) { const int n = (lane >> 3) + 8 * j; const LAS float* s = scr + (8 * c) * 33 + n;
        v4u o; o.x = pk2(s[0 * 33], s[1 * 33]); o.y = pk2(s[2 * 33], s[3 * 33]); o.z = pk2(s[4 * 33], s[5 * 33]); o.w = pk2(s[6 * 33], s[7 * 33]);
        const int nn = n0 + n; int drow;
        if (MODE == 0) drow = row_off + nn;
        else if (MODE == 3) { int tile, L;
            if (nn < 2560) { tile = nn >> 8; L = nn & 255; } else if (nn < 2624) { tile = 10; L = nn - 2560; } else if (nn < 2640) { tile = 10; L = 64 + (nn - 2624); }
            else if (nn < 4176) { tile = 11 + ((nn - 2640) >> 8); L = (nn - 2640) & 255; } else if (nn < 4240) { tile = 10; L = 128 + (nn - 4176); } else if (nn < 4304) { tile = 10; L = 192 + (nn - 4240); }
            else { tile = 17; L = nn - 4304; }
            drow = 256 * tile + 128 * ((L >> 5) & 1) + 32 * (L >> 6) + (L & 31); }
        else drow = 256 * (nn >> 7) + (nn & 127) + (MODE == 2 ? 128 : 0);
        if (MODE != 3 || nn < N) *(GAS v4u*)(WT + (size_t)drow * K + k0 + 8 * c) = o; }
    LDS_WAIT(); asm volatile("" ::: "memory");
}
__device__ __forceinline__ void p0_weights(const Ctx& C) {
    LAS float* scr = (LAS float*)(C.lds + C.wave * 16384);
    constexpr int I_IN = (D / 64) * 139, I_OUT = (D / 64) * (D / 32), I_G = (D / 64) * (FFN / 32), I_DN = (FFN / 64) * (D / 32);
    constexpr int I_L = RW_W / 32, NITEMS = I_IN + I_OUT + 2 * I_G + I_DN + 4 * I_L;
    bf16* WIN = (bf16*)(C.ws + WS_WIN); bf16* WOUT = (bf16*)(C.ws + WS_WOUT); bf16* WGU = (bf16*)(C.ws + WS_WGU); bf16* WDN = (bf16*)(C.ws + WS_WDN);
    for (int it = C.gw; it < NITEMS; it += C.ngw) {
        int r = it;
        if (r < I_IN) { transpose_item<3>(C.in[14], D, IN_COLS, 139 * 32, WIN, 0, scr, r, C.lane); continue; } r -= I_IN;
        if (r < I_OUT) { transpose_item(C.in[28], D, D, D, WOUT, 0, scr, r, C.lane); continue; } r -= I_OUT;
        if (r < I_G) { transpose_item<1>(C.in[29], D, FFN, FFN, WGU, 0, scr, r, C.lane); continue; } r -= I_G;
        if (r < I_G) { transpose_item<2>(C.in[30], D, FFN, FFN, WGU, 0, scr, r, C.lane); continue; } r -= I_G;
        if (r < I_DN) { transpose_item(C.in[31], FFN, D, D, WDN, 0, scr, r, C.lane); continue; } r -= I_DN;
        if (r < I_L) { transpose_item(C.in[19], 64, RW_W, RW_W, (bf16*)(C.ws + WS_W2T), 0, scr, r, C.lane); continue; } r -= I_L;
        if (r < I_L) { transpose_item(C.in[21], 64, RW_W, RW_W, (bf16*)(C.ws + WS_A2T), 0, scr, r, C.lane); continue; } r -= I_L;
        transpose_item(C.in[22], 128, RW_W, RW_W, (bf16*)(C.ws + WS_G2T), 0, scr, r, C.lane);
    }
    for (int i = C.gw; i < 176; i += C.ngw) { const int L = i < 48 ? 80 + i : 128 + (i - 48), tile = i < 48 ? 10 : 17;
        GAS v4u* rowp = (GAS v4u*)(WIN + (size_t)(256 * tile + 128 * ((L >> 5) & 1) + 32 * (L >> 6) + (L & 31)) * D);
        rowp[C.lane] = (v4u){0u, 0u, 0u, 0u}; rowp[64 + C.lane] = (v4u){0u, 0u, 0u, 0u}; }
}
__device__ __forceinline__ void norm_mod_row(const Ctx& C, int m, const float* xr, const float* g, const float* shift, const float* scale, bf16* orow) {
    const GAS f32x4* xp = (const GAS f32x4*)xr + C.lane;
    f32x4 v[4]; float s = 0.f;
#pragma unroll
    for (int j = 0; j < 4; ++j) { v[j] = xp[64 * j]; s += (v[j].x * v[j].x + v[j].y * v[j].y) + (v[j].z * v[j].z + v[j].w * v[j].w); }
    const float rstd = 1.f / sqrtf(wave_sum(s) * (1.f / D) + RMS_EPS);
    GAS unsigned long long* o8 = (GAS unsigned long long*)orow + C.lane;
#pragma unroll
    for (int j = 0; j < 4; ++j) { const int c = 4 * (C.lane + 64 * j);
        const f32x4 gg = *(const f32x4*)(g + c), sh = *(const f32x4*)(shift + c), sc = *(const f32x4*)(scale + c);
        const f32x4 h = v[j] * rstd * gg * (1.f + sc) + sh;
        o8[64 * j] = (unsigned long long)pk2(h.x, h.y) | ((unsigned long long)pk2(h.z, h.w) << 32); }
}
__device__ __forceinline__ void p1_norm1(const Ctx& C) {
    bf16* A1 = (bf16*)(C.ws + WS_A1); const float* MOD = (const float*)(C.ws + WS_MOD);
    for (int m = C.gw; m < MPAD; m += C.ngw) {
        bf16* orow = A1 + (size_t)m * D;
        if (m >= MT) { GAS unsigned long long* o8 = (GAS unsigned long long*)orow + C.lane;
#pragma unroll
            for (int j = 0; j < 4; ++j) o8[64 * j] = 0ull;
            continue; }
        const float* md = MOD + mod_row(m) * MODW;
        norm_mod_row(C, m, x_row(C, m), C.in[10], md, md + D, orow);
    }
}
__device__ __forceinline__ void p3_post(const Ctx& C) {
    const float* PROJ = (const float*)(C.ws + WS_PROJ); float* QN = (float*)(C.ws + WS_QN);
    const int lane = C.lane;
    const float qg = C.in[15][lane], kg = C.in[16][lane];
    for (int m = C.gw; m < MT; m += C.ngw) {
        const float* p = PROJ + (size_t)m * NIN;
        const bool smp = m >= MP; const int j = m - MP;
        float* ko = C.out + (smp ? OUT_KS + (size_t)j * ATT_W : OUT_KP + (size_t)m * ATT_W);
        float* vo = C.out + (smp ? OUT_VS + (size_t)j * ATT_W : OUT_VP + (size_t)m * ATT_W);
        float* io = C.out + (smp ? OUT_IKS + (size_t)j * IDD : OUT_IKP + (size_t)m * IDD);
        float* qn = QN + (size_t)m * ATT_W;
        bf16* qb = (bf16*)(C.ws + WS_QB) + (size_t)m * ATT_W; bf16* kb = (bf16*)(C.ws + WS_KB) + (size_t)m * ATT_W; bf16* vb = (bf16*)(C.ws + WS_VB) + (size_t)m * ATT_W;
        for (int h = 0; h < AH; ++h) {
            const float q = p[O_Q + h * 64 + lane], k = p[O_K + h * 64 + lane];
            const float sq = wave_sum(q * q), sk = wave_sum(k * k);
            const float qv = q * (1.f / sqrtf(sq * (1.f / 64.f) + RMS_EPS)) * qg, kv = k * (1.f / sqrtf(sk * (1.f / 64.f) + RMS_EPS)) * kg, vv = p[O_V + h * 64 + lane];
            qn[h * 64 + lane] = qv; ko[h * 64 + lane] = kv; vo[h * 64 + lane] = vv;
            qb[h * 64 + lane] = (bf16)f2bf(qv * attn_body::C2); kb[h * 64 + lane] = (bf16)f2bf(kv); vb[h * 64 + lane] = (bf16)f2bf(vv);
        }
        const float ki = p[O_KI + lane];
        const float kin = ki * (1.f / sqrtf(wave_sum(ki * ki) * (1.f / 64.f) + RMS_EPS));
        io[lane] = kin;
        ((bf16*)(C.ws + WS_KIB))[(size_t)m * IDD + lane] = (bf16)f2bf(kin);
        { bf16* qi = (bf16*)(C.ws + WS_QIB) + (size_t)m * QI_LD; float ql = 0.f;
          for (int h = 0; h < IH; ++h) { const float v = p[O_QI + h * 64 + lane]; qi[h * 64 + lane] = (bf16)f2bf(v); ql += p[O_WI + h] * v; }
          qi[IH * 64 + lane] = (bf16)f2bf(ql);
          if (lane < IH) ((float*)(C.ws + WS_WI))[(size_t)m * IH + lane] = p[O_WI + lane]; }
        if (smp || (m & (T - 1)) == T - 1) {
            float* so = C.out + (smp ? OUT_SHS + (size_t)j * RW_COLS : OUT_SHP + (size_t)(m >> 11) * RW_COLS);
            for (int i = 0; i < RW_COLS / 64; ++i) so[i * 64 + lane] = p[O_RW + i * 64 + lane];
        }
    }
}
__device__ __forceinline__ void p3_lin(const Ctx& C) {
    const float* PRW = (const float*)(C.ws + WS_PRW); const float* mu = C.in[17];
    const int lane = C.lane;
    for (int m = C.gw; m < MT; m += C.ngw) {
        const float* p = PRW + (size_t)m * RW_COLS;
        const bool smp = m >= MP; const int j = m - MP; const int t = m & (T - 1);
        if (smp || t == T - 1) { float* so = C.out + (smp ? OUT_SHS + (size_t)j * RW_COLS : OUT_SHP + (size_t)(m >> 11) * RW_COLS);
            for (int i = 0; i < RW_COLS / 64; ++i) so[i * 64 + lane] = p[i * 64 + lane]; }
        if (smp) continue;
        float x[4];
#pragma unroll
        for (int i = 0; i < 4; ++i) { const int c = 1536 + 64 * i + lane; const float cur = p[c], prv = t == 0 ? 0.f : p[c - RW_COLS]; x[i] = cur + (prv - cur) * mu[c]; }
        bf16* lin = (bf16*)(C.ws + WS_LIN) + (size_t)m * 256;
        lin[lane] = (bf16)f2bf(tanhf(x[0])); lin[64 + lane] = (bf16)f2bf(x[1]); lin[128 + lane] = (bf16)f2bf(sigmoidf_(x[2])); lin[192 + lane] = (bf16)f2bf(sigmoidf_(x[3]));
    }
}
__device__ __forceinline__ void smp_rwkv(const Ctx& C) {
    const float* PRW = (const float*)(C.ws + WS_PRW); bf16* MIX = (bf16*)(C.ws + WS_MIX);
    const float* mu = C.in[17]; const float* w0 = C.in[18]; const float* w2 = C.in[19]; const float* a0 = C.in[20]; const float* a2 = C.in[21]; const float* g2 = C.in[22];
    const float* k_k = C.in[23]; const float* k_a = C.in[24]; const float* r_k = C.in[25]; const float* ln_w = C.in[26]; const float* ln_b = C.in[27];
    LAS float* lw = (LAS float*)(C.lds + C.wave * 1024);
    const int lane = C.lane;
    for (int wu = C.gw; wu < NSMP * RH; wu += C.ngw) {
        const int j = wu / RH, h = wu % RH, c = h * 64 + lane;
        const float* p = PRW + (size_t)(MP + j) * RW_COLS; const float* pv = C.in[6] + (size_t)j * RW_COLS;
#define XM(cc) ({ const int c_ = (cc); const float cur_ = p[c_]; cur_ + (pv[c_] - cur_) * mu[c_]; })
        lw[lane] = tanhf(XM(1536 + lane)); lw[64 + lane] = XM(1600 + lane); lw[128 + lane] = sigmoidf_(XM(1664 + lane)); lw[192 + lane] = sigmoidf_(XM(1728 + lane));
        LDS_WAIT(); asm volatile("" ::: "memory");
        float aw = w0[c], aa = a0[c], ag = 0.f;
#pragma unroll 8
        for (int jj = 0; jj < 64; ++jj) { aw += lw[jj] * w2[jj * RW_W + c]; aa += lw[64 + jj] * a2[jj * RW_W + c]; }
#pragma unroll 8
        for (int jj = 0; jj < 128; ++jj) ag += lw[128 + jj] * g2[jj * RW_W + c];
        const float w = expf(-0.6065306597126334f * sigmoidf_(aw)), a = sigmoidf_(aa);
        const float r = XM(c), k = XM(512 + c), v = XM(1024 + c);
#undef XM
        float kk = k * k_k[c]; kk *= 1.f / sqrtf(fmaxf(wave_sum(kk * kk), 1e-24f));
        const float kp = k * (1.f + (a - 1.f) * k_a[c]), bb = kk * a;
        float S[64];
        { const f32x4* sp = (const f32x4*)(C.in[5] + (((size_t)j * RH + h) * RN + lane) * RN);
#pragma unroll
          for (int i = 0; i < 16; ++i) { const f32x4 q4 = sp[i]; S[4 * i] = q4.x; S[4 * i + 1] = q4.y; S[4 * i + 2] = q4.z; S[4 * i + 3] = q4.w; } }
        float sa0 = 0.f, sa1 = 0.f;
#pragma unroll
        for (int jx = 0; jx < 64; jx += 2) { sa0 += S[jx] * rdlane(kk, jx); sa1 += S[jx + 1] * rdlane(kk, jx + 1); }
        const float sa = -(sa0 + sa1);
        float y0 = 0.f, y1 = 0.f;
#pragma unroll
        for (int jx = 0; jx < 64; jx += 2) {
            S[jx] = S[jx] * rdlane(w, jx) + sa * rdlane(bb, jx) + v * rdlane(kp, jx); y0 += S[jx] * rdlane(r, jx);
            S[jx + 1] = S[jx + 1] * rdlane(w, jx + 1) + sa * rdlane(bb, jx + 1) + v * rdlane(kp, jx + 1); y1 += S[jx + 1] * rdlane(r, jx + 1); }
        const float y = y0 + y1;
        f32x4* so = (f32x4*)(C.out + OUT_WKVS + (((size_t)j * RH + h) * RN + lane) * RN);
#pragma unroll
        for (int i = 0; i < 16; ++i) so[i] = (f32x4){S[4 * i], S[4 * i + 1], S[4 * i + 2], S[4 * i + 3]};
        const float mean = wave_sum(y) * (1.f / 64.f), dy = y - mean, var = wave_sum(dy * dy) * (1.f / 64.f);
        const float yn = dy * (1.f / sqrtf(var + GN_EPS)) * ln_w[c] + ln_b[c];
        const float bonus = wave_sum(r * kp * r_k[c]) * v;
        MIX[(size_t)(MP + j) * D + ATT_W + c] = (bf16)f2bf((yn + bonus) * ag);
        LDS_WAIT(); asm volatile("" ::: "memory");
    }
}
namespace idxsel {
typedef short bf16x8 __attribute__((ext_vector_type(8)));
typedef float f32x16 __attribute__((ext_vector_type(16)));
constexpr int QT_BYTES = 17 * 32 * 128, WT_OFF = QT_BYTES, CNT_OFF = WT_OFF + 32 * 17 * 4;
__device__ __forceinline__ int crow(int r, int hi) { return (r & 3) + 8 * (r >> 2) + 4 * hi; }
__device__ __forceinline__ void unit(const Ctx& C, int b, int qg) {
    const int lane = C.lane, r32 = lane & 31, hi = lane >> 5, wave = C.wave;
    LAS unsigned char* lds = C.lds;
    const bf16* QIb = (const bf16*)(C.ws + WS_QIB); const bf16* KIb = (const bf16*)(C.ws + WS_KIB); const float* WIr = (const float*)(C.ws + WS_WI);
    unsigned long long* MASKT = (unsigned long long*)(C.ws + WS_MASKT);
    LAS float* WT = (LAS float*)(lds + WT_OFF); LAS int* CNT = (LAS int*)(lds + CNT_OFF);
    const size_t row0 = (size_t)b * T + 32 * qg;
    __syncthreads();
    for (int i = C.tid; i < 32 * 128; i += NTHREADS) { const int q = i >> 7, hc = i & 127, h = hc >> 3, c = hc & 7;
        const v4u v = *(const v4u*)(QIb + (row0 + q) * QI_LD + hc * 8);
        *(LAS v4u*)(lds + ((h * 32 + q) * 8 + (c ^ (q & 7))) * 16) = v; }
    { const int q = C.tid >> 4, h = C.tid & 15; WT[q * 17 + h] = WIr[(row0 + q) * IH + h]; }
    __syncthreads();
    if (C.tid < 256) {
        const int q = C.tid >> 3, c = C.tid & 7; float a8[8];
#pragma unroll
        for (int e = 0; e < 8; ++e) a8[e] = 0.f;
        for (int h = 0; h < 16; ++h) { const v4u v = *(const LAS v4u*)(lds + ((h * 32 + q) * 8 + (c ^ (q & 7))) * 16); const float w = WT[q * 17 + h];
            a8[0] += w * __builtin_bit_cast(float, v.x << 16); a8[1] += w * __builtin_bit_cast(float, v.x & 0xffff0000u); a8[2] += w * __builtin_bit_cast(float, v.y << 16); a8[3] += w * __builtin_bit_cast(float, v.y & 0xffff0000u);
            a8[4] += w * __builtin_bit_cast(float, v.z << 16); a8[5] += w * __builtin_bit_cast(float, v.z & 0xffff0000u); a8[6] += w * __builtin_bit_cast(float, v.w << 16); a8[7] += w * __builtin_bit_cast(float, v.w & 0xffff0000u); }
        v4u o; o.x = pk2(a8[0], a8[1]); o.y = pk2(a8[2], a8[3]); o.z = pk2(a8[4], a8[5]); o.w = pk2(a8[6], a8[7]);
        *(LAS v4u*)(lds + ((16 * 32 + q) * 8 + (c ^ (q & 7))) * 16) = o; }
    __syncthreads();
    f32x16 sc[8];
#pragma unroll
    for (int j = 0; j < 8; ++j) sc[j] = f32x16{};
    bf16x8 ka[4];
    { const int kc = wave <= qg ? wave : qg; const bf16* kp0 = KIb + ((size_t)b * T + kc * 32 + r32) * IDD + 8 * hi;
#pragma unroll
      for (int s4 = 0; s4 < 4; ++s4) ka[s4] = *(const bf16x8*)(kp0 + 16 * s4); }
#pragma unroll
    for (int j = 0; j < 8; ++j) {
        const int kt0 = wave + 8 * j;
        asm volatile("" ::: "memory");
        if (kt0 <= qg) {
            bf16x8 kn[4];
            { const int kc = kt0 + 8 <= qg ? kt0 + 8 : qg; const bf16* kp1 = KIb + ((size_t)b * T + kc * 32 + r32) * IDD + 8 * hi;
#pragma unroll
              for (int s4 = 0; s4 < 4; ++s4) kn[s4] = *(const bf16x8*)(kp1 + 16 * s4); }
            bf16x8 qf[4];
#pragma unroll
            for (int s4 = 0; s4 < 4; ++s4) qf[s4] = *(const LAS bf16x8*)(lds + ((0 * 32 + r32) * 8 + ((2 * s4 + hi) ^ (r32 & 7))) * 16);
#pragma unroll 1
            for (int h = 0; h < 17; ++h) {
                bf16x8 qn[4];
                const int hn = h < 16 ? h + 1 : 16;
#pragma unroll
                for (int s4 = 0; s4 < 4; ++s4) qn[s4] = *(const LAS bf16x8*)(lds + ((hn * 32 + r32) * 8 + ((2 * s4 + hi) ^ (r32 & 7))) * 16);
                const float w = WT[r32 * 17 + h];
                f32x16 xa = f32x16{};
#pragma unroll
                for (int s4 = 0; s4 < 4; ++s4) xa = __builtin_amdgcn_mfma_f32_32x32x16_bf16(ka[s4], qf[s4], xa, 0, 0, 0);
                if (h < 16) {
#pragma unroll
                    for (int r = 0; r < 16; ++r) sc[j][r] = __builtin_fmaf(__builtin_fabsf(xa[r]), w, sc[j][r]); }
                else {
#pragma unroll
                    for (int r = 0; r < 16; ++r) sc[j][r] += xa[r]; }
#pragma unroll
                for (int s4 = 0; s4 < 4; ++s4) qf[s4] = qn[s4];
            }
#pragma unroll
            for (int s4 = 0; s4 < 4; ++s4) ka[s4] = kn[s4];
        }
    }
    unsigned key[8][16];
#pragma unroll
    for (int j = 0; j < 8; ++j) { const int kt = wave + 8 * j;
#pragma unroll
        for (int r = 0; r < 16; ++r) { const bool valid = (kt < qg) || (kt == qg && crow(r, hi) <= r32); key[j][r] = valid ? sortable(sc[j][r]) : 0u; } }
    unsigned Tk = 1u;
    if (qg >= 8) {
        Tk = 0u; int buf = 0; bool exact = false;
        for (int bit = 31; bit >= 0; --bit) {
            const unsigned cand = Tk | (1u << bit); int c = 0;
#pragma unroll
            for (int j = 0; j < 8; ++j) if (wave + 8 * j <= qg) {
#pragma unroll
                for (int r = 0; r < 16; ++r) c += (key[j][r] >= cand) ? 1 : 0; }
            c += __shfl_xor(c, 32);
            if (hi == 0) CNT[(buf * 8 + wave) * 32 + r32] = c;
            __syncthreads();
            int tot = 0;
#pragma unroll
            for (int w = 0; w < 8; ++w) tot += CNT[(buf * 8 + w) * 32 + r32];
            if (tot >= TOPK) { Tk = cand; exact = (tot == TOPK); }
            buf ^= 1;
            if (__all(exact)) break;
        }
    }
#pragma unroll
    for (int j = 0; j < 8; ++j) { const int kt = wave + 8 * j; unsigned long long mine = 0ull;
#pragma unroll
        for (int r = 0; r < 16; ++r) { const unsigned long long W = __ballot(key[j][r] >= Tk); if (lane == r) mine = W; }
        if (lane < 16) MASKT[(((size_t)(b * 64 + qg) * 32 + (kt >> 1)) * 32) + (kt & 1) * 16 + lane] = mine; }
}
__device__ __forceinline__ void phase(const Ctx& C) {
    const int v = (int)((blockIdx.x % 8) * (C.G / 8) + blockIdx.x / 8);
    for (int vv = v; vv < NB * 32; vv += C.G) { const int b = vv >> 5, i = vv & 31; unit(C, b, 63 - i); unit(C, b, i); }
    __syncthreads();
}
}
__device__ __forceinline__ float idx_score(const float (&kr)[64], const LAS float* ql, const LAS float* wl) {
    float score = 0.f;
    for (int h = 0; h < IH; ++h) {
        float d = 0.f;
#pragma unroll
        for (int dd = 0; dd < 64; dd += 4) { const f32x4 qv = *(const LAS f32x4*)(ql + h * 64 + dd); d += qv.x * kr[dd] + qv.y * kr[dd + 1] + qv.z * kr[dd + 2] + qv.w * kr[dd + 3]; }
        score += wl[h] * fmaxf(d, 0.f);
    }
    return score;
}
template <bool PROMPT, bool SAMPLE> __device__ __forceinline__ void p4_indexer(const Ctx& C) {
    const float* PROJ = (const float*)(C.ws + WS_PROJ); float* SC = (float*)(C.ws + WS_SC); float* SCS = (float*)(C.ws + WS_SCS);
    LAS float* ql = (LAS float*)C.lds;
    LAS float* wl = ql + 16 * 1024;
    const int lane = C.lane;
    if (PROMPT) for (int u = blockIdx.x; u < NB * 128 * 4; u += C.G) {
        const int b = u >> 9, tq = (u >> 2) & 127, scn = u & 3, t0 = tq * 16;
        if (scn * 512 > t0 + 15) continue;
        __syncthreads();
        for (int i = C.tid; i < 16 * 1024; i += NTHREADS) { const int q = i >> 10, e = i & 1023; ql[i] = PROJ[(size_t)(b * T + t0 + q) * NIN + O_QI + e]; }
        if (C.tid < 256) { const int q = C.tid >> 4, h = C.tid & 15; wl[C.tid] = PROJ[(size_t)(b * T + t0 + q) * NIN + O_WI + h] * IDX_W_SCALE; }
        __syncthreads();
        const int s = scn * 512 + C.wave * 64 + lane;
        if (scn * 512 + C.wave * 64 <= t0 + 15) {
            float kr[64];
            const f32x4* kp = (const f32x4*)(C.out + OUT_IKP + (size_t)(b * T + s) * IDD);
#pragma unroll
            for (int i = 0; i < 16; ++i) { const f32x4 v = kp[i]; kr[4 * i] = v.x; kr[4 * i + 1] = v.y; kr[4 * i + 2] = v.z; kr[4 * i + 3] = v.w; }
            for (int q = 0; q < 16; ++q) {
                const float score = idx_score(kr, ql + q * 1024, wl + q * 16);
                const int t = t0 + q;
                if (s <= t) SC[((size_t)b * T + t) * T + s] = score;
            }
        }
    }
    __syncthreads();
    const int* pt = (const int*)C.in[7];
    LAS float* qw = (LAS float*)(C.lds + C.wave * 8192); LAS float* ww = qw + 1024;
    if (SAMPLE) for (int wu = C.gw; wu < NSMP * 129; wu += C.ngw) {
        const int j = wu / 129, kb = wu % 129;
        const bf16* pq = (const bf16*)(C.ws + WS_QIB) + (size_t)(MP + j) * QI_LD;
        for (int i = 0; i < 16; ++i) qw[i * 64 + lane] = __builtin_bit_cast(float, (unsigned)pq[i * 64 + lane] << 16);
        if (lane < 16) ww[lane] = ((const float*)(C.ws + WS_WI))[(size_t)(MP + j) * IH + lane] * IDX_W_SCALE;
        LDS_WAIT(); asm volatile("" ::: "memory");
        const int s = kb * 64 + lane;
        const float* krow = nullptr;
        if (s < PAST) krow = C.in[4] + ((size_t)pt[j * NPAGES + (s >> 7)] * PAGE + (s & 127)) * IDD;
        else if (s == PAST) krow = C.out + OUT_IKS + (size_t)j * IDD;
        float score = -INFINITY;
        if (krow) { float kr[64]; const f32x4* kp = (const f32x4*)krow;
#pragma unroll
            for (int i = 0; i < 16; ++i) { const f32x4 v = kp[i]; kr[4 * i] = v.x; kr[4 * i + 1] = v.y; kr[4 * i + 2] = v.z; kr[4 * i + 3] = v.w; }
            score = idx_score(kr, qw, ww); }
        SCS[(size_t)j * SCS_LD + s] = score;
        LDS_WAIT(); asm volatile("" ::: "memory");
    }
}
template <bool PROBE> __device__ __forceinline__ void p4_scan(const Ctx& C, int u_begin) {
    const float* Rr = (const float*)(C.ws + WS_RWA), *Wd = (const float*)(C.ws + WS_RWA + RWA_STRIDE), *Kp = (const float*)(C.ws + WS_RWA + 2 * RWA_STRIDE), *Vv = (const float*)(C.ws + WS_RWA + 3 * RWA_STRIDE),
          *KK = (const float*)(C.ws + WS_RWA + 4 * RWA_STRIDE), *Bb = (const float*)(C.ws + WS_RWA + 5 * RWA_STRIDE);
    float* Y = (float*)(C.ws + (PROBE ? WS_Y2 : WS_Y));
    const int lane = C.lane;
    for (int u = u_begin + C.gw; u < (PROBE ? NB * RH : NB * RH + NSMP * RH); u += C.ngw) {
        const bool smp = u >= NB * RH; const int seq = smp ? (u - NB * RH) / RH : u / RH, h = u % RH;
        const int nsteps = smp ? 1 : T; const size_t base = smp ? (size_t)(MP + seq) : (size_t)seq * T;
        float S[64];
        if (smp) { const f32x4* sp = (const f32x4*)(C.in[5] + (((size_t)seq * RH + h) * RN + lane) * RN);
#pragma unroll
            for (int i = 0; i < 16; ++i) { const f32x4 v = sp[i]; S[4 * i] = v.x; S[4 * i + 1] = v.y; S[4 * i + 2] = v.z; S[4 * i + 3] = v.w; } }
        else {
#pragma unroll
            for (int i = 0; i < 64; ++i) S[i] = 0.f; }
        size_t o = base * RW_W + h * 64 + lane;
        float r = Rr[o], w = Wd[o], k = Kp[o], v = Vv[o], kk = KK[o], bb = Bb[o];
        for (int t = 0; t < nsteps; ++t) {
            float rn = 0.f, wn = 0.f, kn = 0.f, vn = 0.f, kkn = 0.f, bbn = 0.f;
            const size_t on = o + RW_W;
            if (t + 1 < nsteps) { rn = Rr[on]; wn = Wd[on]; kn = Kp[on]; vn = Vv[on]; kkn = KK[on]; bbn = Bb[on]; }
            float sa0 = 0.f, sa1 = 0.f;
#pragma unroll
            for (int jx = 0; jx < 64; jx += 2) { sa0 += S[jx] * rdlane(kk, jx); sa1 += S[jx + 1] * rdlane(kk, jx + 1); }
            const float sa = -(sa0 + sa1);
            float y0 = 0.f, y1 = 0.f;
#pragma unroll
            for (int jx = 0; jx < 64; jx += 2) {
                S[jx] = S[jx] * rdlane(w, jx) + sa * rdlane(bb, jx) + v * rdlane(k, jx); y0 += S[jx] * rdlane(r, jx);
                S[jx + 1] = S[jx + 1] * rdlane(w, jx + 1) + sa * rdlane(bb, jx + 1) + v * rdlane(k, jx + 1); y1 += S[jx + 1] * rdlane(r, jx + 1); }
            Y[o] = y0 + y1;
            o = on; r = rn; w = wn; k = kn; v = vn; kk = kkn; bb = bbn;
        }
        f32x4* so = (f32x4*)(C.out + (smp ? OUT_WKVS : OUT_WKVP) + (((size_t)seq * RH + h) * RN + lane) * RN);
        if (!PROBE)
#pragma unroll
        for (int i = 0; i < 16; ++i) so[i] = (f32x4){S[4 * i], S[4 * i + 1], S[4 * i + 2], S[4 * i + 3]};
    }
}
template <bool PROMPT, bool SAMPLE> __device__ __forceinline__ void p5_select(const Ctx& C) {
    const float* SC = (const float*)(C.ws + WS_SC); unsigned* MASK = (unsigned*)(C.ws + WS_MASK);
    const int lane = C.lane;
    if (PROMPT) for (int row = C.gw; row < MP; row += C.ngw) {
        const int t = row & (T - 1); const float* sp = SC + (size_t)row * T;
        unsigned key[32];
#pragma unroll
        for (int j = 0; j < 32; ++j) { const int s = 64 * j + lane; key[j] = (s <= t) ? sortable(sp[s]) : 0u; }
        unsigned Tk = 0u; int need = 0;
        const bool all = (t + 1 <= TOPK);
        if (!all) {
            for (int bit = 31; bit >= 0; --bit) { const unsigned cand = Tk | (1u << bit); int cnt = 0;
#pragma unroll
                for (int j = 0; j < 32; ++j) cnt += __builtin_popcountll(__ballot(key[j] >= cand));
                if (cnt >= TOPK) Tk = cand; }
            int cgt = 0;
#pragma unroll
            for (int j = 0; j < 32; ++j) cgt += __builtin_popcountll(__ballot(key[j] > Tk));
            need = TOPK - cgt;
        }
        int running = 0;
#pragma unroll
        for (int j = 0; j < 32; ++j) {
            const int s = 64 * j + lane; bool take;
            if (all) take = (s <= t);
            else { const bool gt = key[j] > Tk, eq = key[j] == Tk; const unsigned long long eqb = __ballot(eq);
                const int pre = __builtin_popcountll(eqb & lanemask_lt(lane)); take = gt || (eq && (running + pre < need)); running += __builtin_popcountll(eqb); }
            const unsigned long long mb = __ballot(take);
            if (lane == 0) { MASK[(size_t)row * 64 + 2 * j] = (unsigned)mb; MASK[(size_t)row * 64 + 2 * j + 1] = (unsigned)(mb >> 32); }
        }
    }
    const float* SCS = (const float*)(C.ws + WS_SCS); int* SLIST = (int*)(C.ws + WS_SLIST);
    LAS int* sh = (LAS int*)C.lds;
    if (SAMPLE) for (int j = (int)blockIdx.x - 128; j >= 0 && j < NSMP; j += C.G) {
        unsigned key[17];
#pragma unroll
        for (int i = 0; i < 17; ++i) { const int s = i * NTHREADS + C.tid; key[i] = (s < LS) ? sortable(SCS[(size_t)j * SCS_LD + s]) : 0u; }
        unsigned Tk = 0u;
        for (int bit = 31; bit >= 0; --bit) { const unsigned cand = Tk | (1u << bit); int c = 0;
#pragma unroll
            for (int i = 0; i < 17; ++i) c += (key[i] >= cand) ? 1 : 0;
            c = wave_sum_i(c);
            __syncthreads(); if (lane == 0) sh[C.wave] = c; __syncthreads();
            int cnt = 0;
#pragma unroll
            for (int w = 0; w < 8; ++w) cnt += sh[w];
            if (cnt >= TOPK) Tk = cand; }
        int cg = 0;
#pragma unroll
        for (int i = 0; i < 17; ++i) cg += (key[i] > Tk) ? 1 : 0;
        cg = wave_sum_i(cg);
        __syncthreads(); if (lane == 0) sh[C.wave] = cg; __syncthreads();
        int cgt = 0;
#pragma unroll
        for (int w = 0; w < 8; ++w) cgt += sh[w];
        const int need = TOPK - cgt;
        int run_eq = 0, run_sel = 0;
#pragma unroll
        for (int i = 0; i < 17; ++i) {
            const int s = i * NTHREADS + C.tid; const bool gt = key[i] > Tk, eq = key[i] == Tk;
            const unsigned long long eqb = __ballot(eq);
            __syncthreads(); if (lane == 0) sh[C.wave] = __builtin_popcountll(eqb); __syncthreads();
            int eq_before = 0, eq_tot = 0;
#pragma unroll
            for (int w = 0; w < 8; ++w) { const int x = sh[w]; eq_tot += x; if (w < C.wave) eq_before += x; }
            const bool take = gt || (eq && (run_eq + eq_before + __builtin_popcountll(eqb & lanemask_lt(lane)) < need));
            const unsigned long long tb = __ballot(take);
            __syncthreads(); if (lane == 0) sh[8 + C.wave] = __builtin_popcountll(tb); __syncthreads();
            int s_before = 0, s_tot = 0;
#pragma unroll
            for (int w = 0; w < 8; ++w) { const int x = sh[8 + w]; s_tot += x; if (w < C.wave) s_before += x; }
            const int pos = run_sel + s_before + __builtin_popcountll(tb & lanemask_lt(lane));
            if (take && pos < TOPK) SLIST[j * TOPK + pos] = s;
            run_eq += eq_tot; run_sel += s_tot;
        }
    }
    __syncthreads();
}
template <int DIFFK> __device__ __forceinline__ void p5_rwfinal(const Ctx& C, int m_begin) {
    const float* Rr = (const float*)(C.ws + WS_RWA), *Kp = (const float*)(C.ws + WS_RWA + 2 * RWA_STRIDE), *Vv = (const float*)(C.ws + WS_RWA + 3 * RWA_STRIDE), *Gg = (const float*)(C.ws + WS_RWA + 6 * RWA_STRIDE);
    const float* Y = (const float*)(C.ws + WS_Y); bf16* MIX = (bf16*)(C.ws + WS_MIX);
    const float* r_k = C.in[25]; const float* ln_w = C.in[26]; const float* ln_b = C.in[27];
    const int lane = C.lane;
    for (int m = m_begin + C.gw; m < MT; m += C.ngw) {
        for (int h = 0; h < RH; ++h) {
            const int c = h * 64 + lane; const size_t o = (size_t)m * RW_W + c;
            float y = Y[o];
            if (DIFFK != 0 && m < MP) y += (float)DIFFK * (y - ((const float*)(C.ws + WS_Y2))[o]);
            const float mu = wave_sum(y) * (1.f / 64.f); const float dy = y - mu; const float var = wave_sum(dy * dy) * (1.f / 64.f);
            const float yn = dy * (1.f / sqrtf(var + GN_EPS)) * ln_w[c] + ln_b[c];
            const float bonus = wave_sum(Rr[o] * Kp[o] * r_k[c]) * Vv[o];
            MIX[(size_t)m * D + ATT_W + c] = (bf16)f2bf((yn + bonus) * Gg[o]);
        }
    }
}
__device__ __forceinline__ void p6_masktr(const Ctx& C) {
    const unsigned* MASK = (const unsigned*)(C.ws + WS_MASK); unsigned long long* MASKT = (unsigned long long*)(C.ws + WS_MASKT);
    const int lane = C.lane, q = lane & 31, hi = lane >> 5;
    for (int wu = C.gw; wu < NB * 64 * 32; wu += C.ngw) {
        const int j = wu & 31, qg = (wu >> 5) & 63, b = wu >> 11;
        const size_t row = (size_t)b * T + 32 * qg + q;
        const unsigned w0 = MASK[row * 64 + 2 * j], w1 = MASK[row * 64 + 2 * j + 1];
        unsigned long long mine = 0ull;
#pragma unroll
        for (int r = 0; r < 16; ++r) { const int c = (r & 3) + 8 * (r >> 2) + 4 * hi;
            const unsigned long long W0 = __ballot((w0 >> c) & 1u), W1 = __ballot((w1 >> c) & 1u);
            if (lane == r) mine = W0; if (lane == 16 + r) mine = W1; }
        if (lane < 32) MASKT[((size_t)((b * 64 + qg) * 32 + j)) * 32 + lane] = mine;
    }
}
__device__ __forceinline__ void smp_attn(const Ctx& C) {
    const int* SLIST = (const int*)(C.ws + WS_SLIST); const float* QN = (const float*)(C.ws + WS_QN); bf16* MIX = (bf16*)(C.ws + WS_MIX); const int* pt = (const int*)C.in[7];
    LAS int* prow = (LAS int*)C.lds;
    LAS float* pb = (LAS float*)(C.lds + 1024);
    const int lane = C.lane, h = C.wave;
    for (int j = blockIdx.x; j < NSMP; j += C.G) {
        __syncthreads();
        if (C.tid < TOPK) { const int s = SLIST[j * TOPK + C.tid]; prow[C.tid] = (s < PAST) ? pt[j * NPAGES + (s >> 7)] * PAGE + (s & 127) : -1; }
        __syncthreads();
        const float* kn = C.out + OUT_KS + (size_t)j * ATT_W + h * 64; const float* vn = C.out + OUT_VS + (size_t)j * ATT_W + h * 64;
        float q[64];
        { const f32x4* qp = (const f32x4*)(QN + (size_t)(MP + j) * ATT_W + h * 64);
#pragma unroll
          for (int i = 0; i < 16; ++i) { const f32x4 v = qp[i]; q[4 * i] = v.x; q[4 * i + 1] = v.y; q[4 * i + 2] = v.z; q[4 * i + 3] = v.w; } }
        float sc[4]; float mx = -INFINITY;
#pragma unroll
        for (int i = 0; i < 4; ++i) { const int pr = prow[i * 64 + lane]; const float* kp = pr >= 0 ? C.in[2] + (size_t)pr * ATT_W + h * 64 : kn;
            float d = 0.f;
#pragma unroll
            for (int e = 0; e < 16; ++e) { const f32x4 kv = ((const f32x4*)kp)[e]; d += q[4 * e] * kv.x + q[4 * e + 1] * kv.y + q[4 * e + 2] * kv.z + q[4 * e + 3] * kv.w; }
            sc[i] = d * 0.125f; mx = fmaxf(mx, sc[i]); }
        mx = wave_max(mx); float l = 0.f;
#pragma unroll
        for (int i = 0; i < 4; ++i) { const float p = expf(sc[i] - mx); pb[h * 256 + i * 64 + lane] = p; l += p; }
        l = wave_sum(l);
        LDS_WAIT(); asm volatile("" ::: "memory");
        float o = 0.f;
        for (int kx = 0; kx < TOPK; kx += 32) { float vv[32];
#pragma unroll
            for (int e = 0; e < 32; ++e) { const int pr = prow[kx + e]; vv[e] = (pr >= 0 ? C.in[3] + (size_t)pr * ATT_W + h * 64 : vn)[lane]; }
#pragma unroll
            for (int e = 0; e < 32; ++e) o += pb[h * 256 + kx + e] * vv[e]; }
        MIX[(size_t)(MP + j) * D + h * 64 + lane] = (bf16)f2bf(o / l);
    }
    __syncthreads();
}
template <int DIFFK> __device__ __forceinline__ void p6_attn(const Ctx& C, int u_begin, int u_end) {
    const unsigned* MASK = (const unsigned*)(C.ws + WS_MASK); const int* SLIST = (const int*)(C.ws + WS_SLIST); const float* QN = (const float*)(C.ws + WS_QN);
    bf16* MIX = (bf16*)(C.ws + WS_MIX); const int* pt = (const int*)C.in[7];
    LAS int* list = (LAS int*)C.lds;
    LAS float* pb = (LAS float*)(C.lds + 1024);
    LAS int* cntp = (LAS int*)(C.lds + 1024 + 8192);
    const int lane = C.lane, h = C.wave;
    for (int u = u_begin + blockIdx.x; u < u_end; u += C.G) {
        const bool smp = u >= MP; const int j = u - MP, b = u >> 11;
        __syncthreads();
        if (C.wave == 0) {
            if (!smp) { const unsigned w = MASK[(size_t)u * 64 + lane]; const int c = __builtin_popcount(w);
                int incl = c;
#pragma unroll
                for (int o = 1; o < 64; o <<= 1) { const int x = __shfl_up(incl, o); if (lane >= o) incl += x; }
                int pos = incl - c; unsigned ww = w;
                while (ww) { const int bit = __builtin_ctz(ww); ww &= ww - 1u; list[pos++] = 32 * lane + bit; }
                if (lane == 63) *cntp = incl; }
            else { for (int i = 0; i < 4; ++i) list[i * 64 + lane] = SLIST[j * TOPK + i * 64 + lane]; if (lane == 0) *cntp = TOPK; }
        }
        __syncthreads();
        int cnt = *cntp; if (cnt > TOPK) cnt = TOPK;
        float q[64];
        { const f32x4* qp = (const f32x4*)(QN + (size_t)u * ATT_W + h * 64);
#pragma unroll
          for (int i = 0; i < 16; ++i) { const f32x4 v = qp[i]; q[4 * i] = v.x; q[4 * i + 1] = v.y; q[4 * i + 2] = v.z; q[4 * i + 3] = v.w; } }
        float sc[4]; float mx = -INFINITY;
#pragma unroll
        for (int i = 0; i < 4; ++i) { const int idx = i * 64 + lane; sc[i] = -INFINITY;
            if (idx < cnt) { const int s = list[idx]; const float* kp;
                if (!smp) kp = C.out + OUT_KP + ((size_t)(b * T + s)) * ATT_W + h * 64;
                else if (s < PAST) kp = C.in[2] + ((size_t)pt[j * NPAGES + (s >> 7)] * PAGE + (s & 127)) * ATT_W + h * 64;
                else kp = C.out + OUT_KS + (size_t)j * ATT_W + h * 64;
                float d = 0.f;
#pragma unroll
                for (int e = 0; e < 16; ++e) { const f32x4 kv = ((const f32x4*)kp)[e]; d += q[4 * e] * kv.x + q[4 * e + 1] * kv.y + q[4 * e + 2] * kv.z + q[4 * e + 3] * kv.w; }
                sc[i] = d * 0.125f; }
            mx = fmaxf(mx, sc[i]); }
        mx = wave_max(mx); float l = 0.f;
#pragma unroll
        for (int i = 0; i < 4; ++i) { const int idx = i * 64 + lane; const float p = (idx < cnt) ? expf(sc[i] - mx) : 0.f; pb[h * 256 + idx] = p; l += p; }
        l = wave_sum(l);
        LDS_WAIT(); asm volatile("" ::: "memory");
        float o = 0.f;
        for (int kx = 0; kx < cnt; ++kx) { const int s = list[kx]; const float* vp;
            if (!smp) vp = C.out + OUT_VP + ((size_t)(b * T + s)) * ATT_W + h * 64;
            else if (s < PAST) vp = C.in[3] + ((size_t)pt[j * NPAGES + (s >> 7)] * PAGE + (s & 127)) * ATT_W + h * 64;
            else vp = C.out + OUT_VS + (size_t)j * ATT_W + h * 64;
            o += pb[h * 256 + kx] * vp[lane]; }
        if (DIFFK == 0) MIX[(size_t)u * D + h * 64 + lane] = (bf16)f2bf(o / l);
        else { const float a = __builtin_bit_cast(float, (unsigned)MIX[(size_t)u * D + h * 64 + lane] << 16); MIX[(size_t)u * D + h * 64 + lane] = (bf16)f2bf(a + (float)DIFFK * (a - o / l)); }
    }
    __syncthreads();
}
__device__ __forceinline__ void p8_res_norm2(const Ctx& C) {
    const float* X1 = (const float*)(C.ws + WS_X1); bf16* A2 = (bf16*)(C.ws + WS_A2); const float* MOD = (const float*)(C.ws + WS_MOD);
    for (int m = C.gw; m < MPAD; m += C.ngw) {
        bf16* orow = A2 + (size_t)m * D;
        if (m >= MT) { GAS unsigned long long* o8 = (GAS unsigned long long*)orow + C.lane;
#pragma unroll
            for (int j = 0; j < 4; ++j) o8[64 * j] = 0ull;
            continue; }
        const float* md = MOD + mod_row(m) * MODW;
        norm_mod_row(C, m, X1 + (size_t)m * D, C.in[11], md + 3 * D, md + 4 * D, orow);
    }
}
__device__ __forceinline__ void p10_swiglu(const Ctx& C) {
    const float* RAW2 = (const float*)(C.ws + WS_RAW2); bf16* HB = (bf16*)(C.ws + WS_HB);
    const size_t total = (size_t)MPAD * (FFN / 4);
    for (size_t i = (size_t)blockIdx.x * NTHREADS + C.tid; i < total; i += (size_t)C.G * NTHREADS) {
        const size_t m = i / (FFN / 4); const int c = (int)(i % (FFN / 4)) * 4;
        const f32x4 g = *(const f32x4*)(RAW2 + m * NGU + c), u = *(const f32x4*)(RAW2 + m * NGU + FFN + c);
        const float h0 = g.x / (1.f + expf(-g.x)) * u.x, h1 = g.y / (1.f + expf(-g.y)) * u.y, h2 = g.z / (1.f + expf(-g.z)) * u.z, h3 = g.w / (1.f + expf(-g.w)) * u.w;
        *(unsigned long long*)(HB + m * FFN + c) = (unsigned long long)pk2(h0, h1) | ((unsigned long long)pk2(h2, h3) << 32);
    }
}
__device__ __forceinline__ void p12_final(const Ctx& C) {
    const float* RAW = (const float*)(C.ws + WS_RAW); const float* X1 = (const float*)(C.ws + WS_X1); const float* MOD = (const float*)(C.ws + WS_MOD);
    for (int m = C.gw; m < MT; m += C.ngw) {
        const float* md = MOD + mod_row(m) * MODW;
        float* yo = C.out + (m < MP ? OUT_Y + (size_t)m * D : OUT_YS + (size_t)(m - MP) * D);
#pragma unroll
        for (int j = 0; j < 4; ++j) { const int c = 4 * (C.lane + 64 * j);
            const f32x4 xv = *(const f32x4*)(X1 + (size_t)m * D + c), rv = *(const f32x4*)(RAW + (size_t)m * D + c), g2 = *(const f32x4*)(md + 5 * D + c);
            *(f32x4*)(yo + c) = xv + g2 * rv; }
    }
}

namespace rw {
typedef short bf16x8 __attribute__((ext_vector_type(8)));
typedef short s16x4 __attribute__((ext_vector_type(4)));
typedef float f32x16 __attribute__((ext_vector_type(16)));
typedef float f32x4v __attribute__((ext_vector_type(4)));
typedef unsigned u32x2 __attribute__((ext_vector_type(2)));
typedef unsigned u32x4v __attribute__((ext_vector_type(4)));
constexpr int NCH = T / 64;
constexpr int IMG = 16384;
constexpr int A32_OFF = 7 * IMG, WC_OFF = A32_OFF + 16384, RED_OFF = WC_OFF + 256;
enum { H_AT = 0, H_BT = 1, H_KT = 2, H_RT = 3, H_VT = 4, H_AAK = 5, H_ARB = 6, H_ARK = 7, H_XT = 8, H_TT = 9, H_QT = 10, H_PT = 11, H_N1 = 12, H_N2 = 13 };
__device__ __forceinline__ unsigned off_b(unsigned row, unsigned ch) { return 256u * row + 16u * (ch ^ (((row & 3) << 2) | ((row >> 2) & 3))); }
__device__ __forceinline__ int crow(int r, int hi) { return (r & 3) + 8 * (r >> 2) + 4 * hi; }
__device__ __forceinline__ unsigned cvt2(float lo, float hi) { typedef float f2 __attribute__((ext_vector_type(2))); typedef __bf16 b2 __attribute__((ext_vector_type(2))); f2 v = {lo, hi}; b2 b = __builtin_convertvector(v, b2); return __builtin_bit_cast(unsigned, b); }
__device__ __forceinline__ bf16x8 frag_row(LAS unsigned char* lds, int H, int blk, int s, int lane) {
    return *(const LAS bf16x8*)(lds + (H >> 1) * IMG + off_b(32 * blk + (lane & 31), 8 * (H & 1) + 2 * s + (lane >> 5)));
}
__device__ __forceinline__ bf16x8 frag_tr(LAS unsigned char* lds, int H, int blk, int ks, int lane) {
    const unsigned h = lane >> 5, b2 = (lane >> 4) & 1, q = (lane & 15) >> 2, p = lane & 3, c = 2 * (H & 1) + blk;
    typedef short v4i16_t __attribute__((ext_vector_type(4)));
    LAS unsigned char* base = lds + (H >> 1) * IMG;
    const s16x4 lo = __builtin_bit_cast(s16x4, __builtin_amdgcn_ds_read_tr16_b64_v4i16((LAS v4i16_t*)(base + off_b(16 * ks + 8 * h + q, 4 * c + 2 * b2 + (p >> 1)) + 8 * (p & 1))));
    const s16x4 hi = __builtin_bit_cast(s16x4, __builtin_amdgcn_ds_read_tr16_b64_v4i16((LAS v4i16_t*)(base + off_b(16 * ks + 8 * h + 4 + q, 4 * c + 2 * b2 + (p >> 1)) + 8 * (p & 1))));
    return (bf16x8){lo[0], lo[1], lo[2], lo[3], hi[0], hi[1], hi[2], hi[3]};
}
template <bool ATR, bool BTR> __device__ __forceinline__ f32x16 mm_tile(LAS unsigned char* lds, int HA, int ablk, int HB, int bblk, f32x16 acc, int lane) {
#pragma unroll
    for (int s = 0; s < 4; ++s) {
        const bf16x8 a = ATR ? frag_tr(lds, HA, ablk, s, lane) : frag_row(lds, HA, ablk, s, lane);
        const bf16x8 b = BTR ? frag_tr(lds, HB, bblk, s, lane) : frag_row(lds, HB, bblk, s, lane);
        acc = __builtin_amdgcn_mfma_f32_32x32x16_bf16(a, b, acc, 0, 0, 0);
    }
    return acc;
}
__device__ __forceinline__ void store_tr(LAS unsigned char* lds, int H, int rblk, int cblk, const f32x16& acc, int lane) {
    LAS unsigned char* base = lds + (H >> 1) * IMG; const int hi = lane >> 5, row = 32 * cblk + (lane & 31);
#pragma unroll
    for (int g = 0; g < 4; ++g) { u32x2 w; w.x = cvt2(acc[4 * g], acc[4 * g + 1]); w.y = cvt2(acc[4 * g + 2], acc[4 * g + 3]);
        *(LAS u32x2*)(base + off_b(row, 8 * (H & 1) + 4 * rblk + g) + 8 * hi) = w; }
}
__device__ __forceinline__ float row16_sum(float x) {
    x += __builtin_bit_cast(float, __builtin_amdgcn_update_dpp(0, __builtin_bit_cast(int, x), 0xB1, 0xF, 0xF, true));
    x += __builtin_bit_cast(float, __builtin_amdgcn_update_dpp(0, __builtin_bit_cast(int, x), 0x4E, 0xF, 0xF, true));
    x += __builtin_bit_cast(float, __builtin_amdgcn_update_dpp(0, __builtin_bit_cast(int, x), 0x141, 0xF, 0xF, true));
    x += __builtin_bit_cast(float, __builtin_amdgcn_update_dpp(0, __builtin_bit_cast(int, x), 0x140, 0xF, 0xF, true));
    return x;
}
__device__ __forceinline__ u32x4v pack8(const f32x16& a, int s) { u32x4v w; w.x = cvt2(a[8 * s], a[8 * s + 1]); w.y = cvt2(a[8 * s + 2], a[8 * s + 3]); w.z = cvt2(a[8 * s + 4], a[8 * s + 5]); w.w = cvt2(a[8 * s + 6], a[8 * s + 7]); return w; }

struct Bufs { bf16* LIN; bf16* W2T; bf16* A2T; bf16* G2T; const float* PRW; bf16* G1; bf16* G2; bf16* MIX;
              u32x4v* MF; float* NT; u32x4v* PF; float* QP; u32x4v* ZF; float* Y; };

__device__ __forceinline__ void r1_unit(const Ctx& C, const Bufs& B, int b, int h, int c) {
    LAS unsigned char* lds = C.lds; const int lane0 = C.lane, wave = C.wave;
    const size_t row0 = (size_t)b * T + 64 * c; const int ci = (b * RH + h) * NCH + c;
    LAS float* A32 = (LAS float*)(lds + A32_OFF); LAS float* WC = (LAS float*)(lds + WC_OFF);
    typedef float f32x4a __attribute__((ext_vector_type(4)));
    {
    int lane = lane0; asm volatile("" : "+v"(lane)); const int hi = lane >> 5; (void)hi;
    { const int nl = lane & 15, q = lane >> 4;
      typedef float f32x2a __attribute__((ext_vector_type(2)));
      LAS f32x2a* RED = (LAS f32x2a*)(lds + RED_OFF);
      const bool first = (c == 0);
      if (wave < 4) {
        const int n = 16 * wave + nl, col = h * 64 + n;
        f32x4a aw[4], aa[4];
#pragma unroll
        for (int tt = 0; tt < 4; ++tt) { aw[tt] = (f32x4a){0.f, 0.f, 0.f, 0.f}; aa[tt] = aw[tt]; }
#pragma unroll
        for (int s = 0; s < 2; ++s) {
            const bf16x8 bw = *(const bf16x8*)(B.W2T + (size_t)col * 64 + 32 * s + 8 * q), ba = *(const bf16x8*)(B.A2T + (size_t)col * 64 + 32 * s + 8 * q);
#pragma unroll
            for (int tt = 0; tt < 4; ++tt) { const bf16* lp = B.LIN + (row0 + 16 * tt + nl) * 256 + 32 * s + 8 * q;
                aw[tt] = __builtin_amdgcn_mfma_f32_16x16x32_bf16(*(const bf16x8*)lp, bw, aw[tt], 0, 0, 0);
                aa[tt] = __builtin_amdgcn_mfma_f32_16x16x32_bf16(*(const bf16x8*)(lp + 64), ba, aa[tt], 0, 0, 0); }
        }
        const float w0c = C.in[18][col], a0c = C.in[20][col], kac = C.in[24][col], kkc = C.in[23][col], rkc = C.in[25][col], mur = C.in[17][col], muk = C.in[17][512 + col];
        float lw[4][4], av[4][4], xr[4][4], kkr[4][4], kpv[4][4];
#pragma unroll
        for (int tt = 0; tt < 4; ++tt) {
            asm volatile("" ::: "memory");
            const int t0 = 16 * tt + 4 * q; const float* p = B.PRW + (row0 + t0) * RW_COLS + col;
            const bool z = first && t0 == 0;
            float rr[5], kr5[5];
            rr[0] = z ? 0.f : p[-RW_COLS]; kr5[0] = z ? 0.f : p[512 - RW_COLS];
#pragma unroll
            for (int e = 0; e < 4; ++e) { rr[e + 1] = p[e * RW_COLS]; kr5[e + 1] = p[512 + e * RW_COLS]; }
#pragma unroll
            for (int e = 0; e < 4; ++e) { const int t = t0 + e;
                const float r_ = rr[e + 1] + (rr[e] - rr[e + 1]) * mur, k_ = kr5[e + 1] + (kr5[e] - kr5[e + 1]) * muk;
                lw[tt][e] = -0.6065306597126334f / (1.f + __expf(-(w0c + aw[tt][e]))); av[tt][e] = 1.f / (1.f + __expf(-(a0c + aa[tt][e])));
                xr[tt][e] = r_; kkr[tt][e] = k_ * kkc; kpv[tt][e] = k_ * (1.f + (av[tt][e] - 1.f) * kac);
                const float p1 = row16_sum(kkr[tt][e] * kkr[tt][e]), p2 = row16_sum(r_ * kpv[tt][e] * rkc);
                if (nl == 0) RED[wave * 64 + t] = (f32x2a){p1, p2}; }
        }
        __syncthreads();
        float tot[4], L[4][4];
#pragma unroll
        for (int tt = 0; tt < 4; ++tt) { L[tt][0] = lw[tt][0]; L[tt][1] = L[tt][0] + lw[tt][1]; L[tt][2] = L[tt][1] + lw[tt][2]; L[tt][3] = L[tt][2] + lw[tt][3]; tot[tt] = L[tt][3]; }
        float run = 0.f;
#pragma unroll
        for (int tt = 0; tt < 4; ++tt) { float basev = run;
#pragma unroll
            for (int qq = 0; qq < 4; ++qq) { const float o = __shfl(tot[tt], nl + 16 * qq); if (qq < q) basev += o; run += o; }
#pragma unroll
            for (int e = 0; e < 4; ++e) L[tt][e] += basev; }
        if (q == 3) WC[n] = __expf(L[3][3]);
#pragma unroll
        for (int tt = 0; tt < 4; ++tt) {
            float at[4], bt[4], kt[4], rt[4];
#pragma unroll
            for (int e = 0; e < 4; ++e) { const int t = 16 * tt + 4 * q + e;
                const float nrm = RED[t].x + RED[64 + t].x + RED[128 + t].x + RED[192 + t].x;
                const float kkn = kkr[tt][e] * (1.f / sqrtf(fmaxf(nrm, 1e-24f)));
                const float eL = __expf(L[tt][e]), eLm = __expf(-L[tt][e]), eLex = __expf(L[tt][e] - lw[tt][e]);
                at[e] = -kkn * eLex; bt[e] = kkn * av[tt][e] * eLm; kt[e] = kpv[tt][e] * eLm; rt[e] = xr[tt][e] * eL; }
            const unsigned ch = 2 * tt + (q >> 1), bo = 8 * (q & 1);
            u32x2 w;
            w.x = cvt2(at[0], at[1]); w.y = cvt2(at[2], at[3]); *(LAS u32x2*)(lds + 0 * IMG + off_b(n, ch) + bo) = w;
            w.x = cvt2(bt[0], bt[1]); w.y = cvt2(bt[2], bt[3]); *(LAS u32x2*)(lds + 0 * IMG + off_b(n, 8 + ch) + bo) = w;
            w.x = cvt2(kt[0], kt[1]); w.y = cvt2(kt[2], kt[3]); *(LAS u32x2*)(lds + 1 * IMG + off_b(n, ch) + bo) = w;
            w.x = cvt2(rt[0], rt[1]); w.y = cvt2(rt[2], rt[3]); *(LAS u32x2*)(lds + 1 * IMG + off_b(n, 8 + ch) + bo) = w;
        }
      } else {
        const int n = 16 * (wave - 4) + nl, col = h * 64 + n;
        f32x4a ag[4];
#pragma unroll
        for (int tt = 0; tt < 4; ++tt) ag[tt] = (f32x4a){0.f, 0.f, 0.f, 0.f};
#pragma unroll
        for (int s = 0; s < 4; ++s) { const bf16x8 bg = *(const bf16x8*)(B.G2T + (size_t)col * 128 + 32 * s + 8 * q);
#pragma unroll
            for (int tt = 0; tt < 4; ++tt) ag[tt] = __builtin_amdgcn_mfma_f32_16x16x32_bf16(*(const bf16x8*)(B.LIN + (row0 + 16 * tt + nl) * 256 + 128 + 32 * s + 8 * q), bg, ag[tt], 0, 0, 0); }
        const float muv = C.in[17][1024 + col], lnw = C.in[26][col], lnb = C.in[27][col];
        float xv[4][4];
#pragma unroll
        for (int tt = 0; tt < 4; ++tt) { const int t0 = 16 * tt + 4 * q; const float* p = B.PRW + (row0 + t0) * RW_COLS + 1024 + col;
            float vr[5]; vr[0] = (first && t0 == 0) ? 0.f : p[-RW_COLS];
#pragma unroll
            for (int e = 0; e < 4; ++e) vr[e + 1] = p[e * RW_COLS];
#pragma unroll
            for (int e = 0; e < 4; ++e) xv[tt][e] = vr[e + 1] + (vr[e] - vr[e + 1]) * muv; }
        __syncthreads();
#pragma unroll
        for (int tt = 0; tt < 4; ++tt) {
            float g1v[4], g2v[4];
#pragma unroll
            for (int e = 0; e < 4; ++e) { const int t = 16 * tt + 4 * q + e;
                const float bsc = RED[t].y + RED[64 + t].y + RED[128 + t].y + RED[192 + t].y, g = ag[tt][e];
                g1v[e] = lnw * g; g2v[e] = (lnb + bsc * xv[tt][e]) * g; }
            { u32x2 w; const size_t o = ((size_t)ci * 64 + n) * 64 + 16 * tt + 4 * q;
              w.x = cvt2(g1v[0], g1v[1]); w.y = cvt2(g1v[2], g1v[3]); *(u32x2*)(B.G1 + o) = w;
              w.x = cvt2(g2v[0], g2v[1]); w.y = cvt2(g2v[2], g2v[3]); *(u32x2*)(B.G2 + o) = w; }
            u32x2 w; w.x = cvt2(xv[tt][0], xv[tt][1]); w.y = cvt2(xv[tt][2], xv[tt][3]);
            *(LAS u32x2*)(lds + 2 * IMG + off_b(n, 2 * tt + (q >> 1)) + 8 * (q & 1)) = w; }
      }
    }
    }
    __syncthreads();
    {
    int lane = lane0; asm volatile("" : "+v"(lane)); const int hi = lane >> 5; (void)hi;
#pragma unroll
    for (int k2 = 0; k2 < 2; ++k2) {
        const int id = 2 * wave + k2, prod = id >> 2, tb = (id >> 1) & 1, jb = id & 1;
        f32x16 acc = f32x16{};
        if (prod == 0) acc = mm_tile<true, true>(lds, H_AT, tb, H_BT, jb, acc, lane);
        else if (prod == 1) acc = mm_tile<true, true>(lds, H_AT, tb, H_KT, jb, acc, lane);
        else if (prod == 2) acc = mm_tile<true, true>(lds, H_BT, jb, H_RT, tb, acc, lane);
        else acc = mm_tile<true, true>(lds, H_KT, jb, H_RT, tb, acc, lane);
        if (prod < 2) {
#pragma unroll
            for (int r = 0; r < 16; ++r) { const int t = 32 * tb + crow(r, hi), j = 32 * jb + (lane & 31); if (!(j < t)) acc[r] = 0.f; }
            if (prod == 0) {
#pragma unroll
                for (int r = 0; r < 16; ++r) A32[(32 * tb + crow(r, hi)) * 64 + 32 * jb + (lane & 31)] = acc[r];
                f32x16 n1 = acc, n2 = acc;
#pragma unroll
                for (int r = 0; r < 16; ++r) { if (!(tb == jb && crow(r, hi) >= 16 && (lane & 31) < 16)) n1[r] = 0.f; if (!(tb == 1 && jb == 0)) n2[r] = 0.f; }
                store_tr(lds, H_N1, tb, jb, n1, lane); store_tr(lds, H_N2, tb, jb, n2, lane); }
            else store_tr(lds, H_AAK, tb, jb, acc, lane);
        } else {
#pragma unroll
            for (int r = 0; r < 16; ++r) { const int j = 32 * jb + crow(r, hi), t = 32 * tb + (lane & 31); if (!(j <= t)) acc[r] = 0.f; }
            store_tr(lds, prod == 2 ? H_ARB : H_ARK, jb, tb, acc, lane);
        }
    }
    }
    __syncthreads();
    {
    int lane = lane0; asm volatile("" : "+v"(lane)); const int hi = lane >> 5; (void)hi;
    if (wave == 0) {
        const int blk = lane >> 4, cc = lane & 15; float Tb[16];
#pragma unroll
        for (int t = 0; t < 16; ++t) { float sacc = (t == cc) ? 1.f : 0.f;
#pragma unroll
            for (int j4 = 0; j4 < t; j4 += 4) { const f32x4a a4 = *(const LAS f32x4a*)(A32 + (16 * blk + t) * 64 + 16 * blk + j4);
                sacc += a4[0] * Tb[j4]; if (j4 + 1 < t) sacc += a4[1] * Tb[j4 + 1]; if (j4 + 2 < t) sacc += a4[2] * Tb[j4 + 2]; if (j4 + 3 < t) sacc += a4[3] * Tb[j4 + 3]; }
            Tb[t] = sacc; }
        u32x4v lo, hi4; lo.x = cvt2(Tb[0], Tb[1]); lo.y = cvt2(Tb[2], Tb[3]); lo.z = cvt2(Tb[4], Tb[5]); lo.w = cvt2(Tb[6], Tb[7]);
        hi4.x = cvt2(Tb[8], Tb[9]); hi4.y = cvt2(Tb[10], Tb[11]); hi4.z = cvt2(Tb[12], Tb[13]); hi4.w = cvt2(Tb[14], Tb[15]);
#pragma unroll
        for (int g = 0; g < 8; ++g) { u32x4v w = (u32x4v){0u, 0u, 0u, 0u}; if (g == 2 * blk) w = lo; if (g == 2 * blk + 1) w = hi4;
            *(LAS u32x4v*)(lds + (H_TT >> 1) * IMG + off_b(lane, 8 * (H_TT & 1) + g)) = w; }
    } else if (wave >= 4) {
        const int tb = (wave - 4) >> 1, ib = (wave - 4) & 1;
        f32x16 acc = mm_tile<true, false>(lds, H_AAK, tb, H_VT, ib, f32x16{}, lane);
        store_tr(lds, H_XT, tb, ib, acc, lane);
    }
    __syncthreads();
    { const int tb = (wave >> 1) & 1, cb = wave & 1;
      if (wave < 4) { f32x16 acc = mm_tile<true, false>(lds, H_N1, tb, H_TT, cb, f32x16{}, lane);
#pragma unroll
          for (int r = 0; r < 16; ++r) if (32 * tb + crow(r, hi) == 32 * cb + (lane & 31)) acc[r] += 1.f;
          store_tr(lds, H_PT, tb, cb, acc, lane); }
      __syncthreads();
      if (wave < 4) { f32x16 acc = mm_tile<true, false>(lds, H_TT, tb, H_PT, cb, f32x16{}, lane); store_tr(lds, H_QT, tb, cb, acc, lane); }
      __syncthreads();
      if (wave < 4) { f32x16 acc = mm_tile<true, false>(lds, H_N2, tb, H_QT, cb, f32x16{}, lane);
#pragma unroll
          for (int r = 0; r < 16; ++r) if (32 * tb + crow(r, hi) == 32 * cb + (lane & 31)) acc[r] += 1.f;
          store_tr(lds, H_PT, tb, cb, acc, lane); }
      __syncthreads();
      if (wave < 4) { f32x16 acc = mm_tile<true, false>(lds, H_QT, tb, H_PT, cb, f32x16{}, lane); store_tr(lds, H_TT, tb, cb, acc, lane); }
    }
    }
    __syncthreads();
    {
    int lane = lane0; asm volatile("" : "+v"(lane)); const int hi = lane >> 5; (void)hi;
    { const int tb = (wave >> 1) & 1, cb = wave & 1;
      if (wave < 4) { f32x16 acc = mm_tile<true, false>(lds, H_TT, tb, H_AT, cb, f32x16{}, lane); store_tr(lds, H_PT, tb, cb, acc, lane); }
      else { f32x16 acc = mm_tile<true, false>(lds, H_TT, tb, H_XT, cb, f32x16{}, lane); store_tr(lds, H_QT, tb, cb, acc, lane); } }
    }
    __syncthreads();
    {
    int lane = lane0; asm volatile("" : "+v"(lane)); const int hi = lane >> 5; (void)hi;
#pragma unroll
    for (int k2 = 0; k2 < 2; ++k2) {
        const int id = 2 * wave + k2, prod = id >> 2, rb = (id >> 1) & 1, cb = id & 1;
        f32x16 acc = f32x16{};
        if (prod == 0) {
            acc = mm_tile<false, false>(lds, H_PT, rb, H_BT, cb, acc, lane);
            const float wc = WC[32 * cb + (lane & 31)];
#pragma unroll
            for (int r = 0; r < 16; ++r) { const int n = 32 * rb + crow(r, hi), m = 32 * cb + (lane & 31); acc[r] = (acc[r] + (n == m ? 1.f : 0.f)) * wc; }
            u32x4v* o = B.MF + ((size_t)ci * 8 + (cb * 2 + rb) * 2) * 64 + lane;
            o[0] = pack8(acc, 0); o[64] = pack8(acc, 1);
        } else if (prod == 1) {
            acc = mm_tile<false, false>(lds, H_BT, rb, H_QT, cb, acc, lane);
            acc = mm_tile<false, false>(lds, H_KT, rb, H_VT, cb, acc, lane);
#pragma unroll
            for (int g = 0; g < 4; ++g) { const f32x4a w4 = *(const LAS f32x4a*)(WC + 32 * rb + 8 * g + 4 * hi);
                f32x4a v = {acc[4 * g] * w4[0], acc[4 * g + 1] * w4[1], acc[4 * g + 2] * w4[2], acc[4 * g + 3] * w4[3]};
                *(f32x4a*)(B.NT + (((size_t)ci * 4 + rb * 2 + cb) * 64 + lane) * 16 + 4 * g) = v; }
        } else if (prod == 2) {
            acc = mm_tile<false, false>(lds, H_PT, rb, H_ARB, cb, acc, lane);
#pragma unroll
            for (int s = 0; s < 4; ++s) { bf16x8 idf;
#pragma unroll
                for (int e = 0; e < 8; ++e) idf[e] = (16 * s + 8 * hi + e == 32 * cb + (lane & 31)) ? (short)0x3f80 : (short)0;
                acc = __builtin_amdgcn_mfma_f32_32x32x16_bf16(frag_row(lds, H_RT, rb, s, lane), idf, acc, 0, 0, 0); }
            u32x4v* o = B.PF + ((size_t)ci * 8 + (cb * 2 + rb) * 2) * 64 + lane;
            o[0] = pack8(acc, 0); o[64] = pack8(acc, 1);
        } else {
            acc = mm_tile<false, false>(lds, H_ARB, rb, H_QT, cb, acc, lane);
            acc = mm_tile<false, false>(lds, H_ARK, rb, H_VT, cb, acc, lane);
#pragma unroll
            for (int g = 0; g < 4; ++g) *(f32x4a*)(B.QP + (((size_t)ci * 4 + rb * 2 + cb) * 64 + lane) * 16 + 4 * g) = (f32x4a){acc[4 * g], acc[4 * g + 1], acc[4 * g + 2], acc[4 * g + 3]};
        }
    }
    }
    __syncthreads();
}
__device__ __forceinline__ void r1_phase(const Ctx& C, const Bufs& B) {
    for (int u = blockIdx.x; u < NB * RH * NCH; u += C.G) { const int c = u & (NCH - 1), h = (u >> 5) & 7, b = u >> 8; r1_unit(C, B, b, h, c); }
}
__device__ __forceinline__ void r2_chain(const Ctx& C, const Bufs& B, int k) {
    const int lane = C.lane, hi = lane >> 5, ib = k & 1, bh = k >> 1;
    f32x16 z[2]; z[0] = f32x16{}; z[1] = f32x16{};
    typedef float f32x4a __attribute__((ext_vector_type(4)));
    for (int c = 0; c < NCH; ++c) {
        const size_t ci = (size_t)bh * NCH + c;
        u32x4v bf[2][2];
#pragma unroll
        for (int nb = 0; nb < 2; ++nb)
#pragma unroll
            for (int s = 0; s < 2; ++s) { bf[nb][s] = pack8(z[nb], s); B.ZF[((ci * 2 + ib) * 4 + nb * 2 + s) * 64 + lane] = bf[nb][s]; }
        f32x16 zn[2];
#pragma unroll
        for (int mb = 0; mb < 2; ++mb) {
            const float* np = B.NT + ((ci * 4 + mb * 2 + ib) * 64 + lane) * 16;
#pragma unroll
            for (int g = 0; g < 4; ++g) { const f32x4a v = *(const f32x4a*)(np + 4 * g); zn[mb][4 * g] = v[0]; zn[mb][4 * g + 1] = v[1]; zn[mb][4 * g + 2] = v[2]; zn[mb][4 * g + 3] = v[3]; }
#pragma unroll
            for (int nb = 0; nb < 2; ++nb)
#pragma unroll
                for (int s = 0; s < 2; ++s) { const u32x4v af = B.MF[(ci * 8 + (mb * 2 + nb) * 2 + s) * 64 + lane];
                    zn[mb] = __builtin_amdgcn_mfma_f32_32x32x16_bf16(__builtin_bit_cast(bf16x8, af), __builtin_bit_cast(bf16x8, bf[nb][s]), zn[mb], 0, 0, 0); }
        }
        z[0] = zn[0]; z[1] = zn[1];
    }
    float* so = C.out + OUT_WKVP + ((size_t)bh * RN + 32 * ib + (lane & 31)) * RN;
#pragma unroll
    for (int nb = 0; nb < 2; ++nb)
#pragma unroll
        for (int g = 0; g < 4; ++g) *(f32x4a*)(so + 32 * nb + 8 * g + 4 * hi) = (f32x4a){z[nb][4 * g], z[nb][4 * g + 1], z[nb][4 * g + 2], z[nb][4 * g + 3]};
}
__device__ __forceinline__ void r2_chain_wg(const Ctx& C, const Bufs& B, int k) {
    const int lane = C.lane, hi = lane >> 5, ib = k & 1, bh = k >> 1, wave = C.wave;
    LAS unsigned char* lds = C.lds;
    typedef float f32x4a __attribute__((ext_vector_type(4)));
    auto load_round = [&](int rd) {
        u32x4v tmp[10];
#pragma unroll
        for (int i = 0; i < 10; ++i) { const int pidx = (wave - 1) + 7 * i;
            if (pidx < 64) { const size_t ci = (size_t)bh * NCH + 4 * rd + (pidx >> 4); const int q = pidx & 15;
                tmp[i] = q < 8 ? B.MF[(ci * 8 + q) * 64 + lane] : *(const u32x4v*)(B.NT + ((ci * 4 + ((q - 8) >> 2) * 2 + ib) * 64 + lane) * 16 + 4 * ((q - 8) & 3)); } }
#pragma unroll
        for (int i = 0; i < 10; ++i) { const int pidx = (wave - 1) + 7 * i;
            if (pidx < 64) *(LAS u32x4v*)(lds + (rd & 1) * 65536 + (pidx >> 4) * 16384 + (pidx & 15) * 1024 + lane * 16) = tmp[i]; }
    };
    f32x16 z[2]; z[0] = f32x16{}; z[1] = f32x16{};
    if (wave > 0) load_round(0);
    __syncthreads();
    for (int rd = 0; rd < NCH / 4; ++rd) {
        if (wave > 0) { if (rd + 1 < NCH / 4) load_round(rd + 1); }
        else {
            for (int st = 0; st < 4; ++st) {
                const size_t ci = (size_t)bh * NCH + 4 * rd + st; LAS unsigned char* sl = lds + (rd & 1) * 65536 + st * 16384;
                u32x4v bf[2][2];
#pragma unroll
                for (int nb = 0; nb < 2; ++nb)
#pragma unroll
                    for (int s = 0; s < 2; ++s) { bf[nb][s] = pack8(z[nb], s); B.ZF[((ci * 2 + ib) * 4 + nb * 2 + s) * 64 + lane] = bf[nb][s]; }
                f32x16 zn[2];
#pragma unroll
                for (int mb = 0; mb < 2; ++mb) {
#pragma unroll
                    for (int g = 0; g < 4; ++g) { const f32x4a v = *(const LAS f32x4a*)(sl + (8 + mb * 4 + g) * 1024 + lane * 16); zn[mb][4 * g] = v[0]; zn[mb][4 * g + 1] = v[1]; zn[mb][4 * g + 2] = v[2]; zn[mb][4 * g + 3] = v[3]; }
#pragma unroll
                    for (int nb = 0; nb < 2; ++nb)
#pragma unroll
                        for (int s = 0; s < 2; ++s) { const u32x4v af = *(const LAS u32x4v*)(sl + ((mb * 2 + nb) * 2 + s) * 1024 + lane * 16);
                            zn[mb] = __builtin_amdgcn_mfma_f32_32x32x16_bf16(__builtin_bit_cast(bf16x8, af), __builtin_bit_cast(bf16x8, bf[nb][s]), zn[mb], 0, 0, 0); }
                }
                z[0] = zn[0]; z[1] = zn[1];
            }
        }
        __syncthreads();
    }
    if (wave == 0) {
        float* so = C.out + OUT_WKVP + ((size_t)bh * RN + 32 * ib + (lane & 31)) * RN;
#pragma unroll
        for (int nb = 0; nb < 2; ++nb)
#pragma unroll
            for (int g = 0; g < 4; ++g) *(f32x4a*)(so + 32 * nb + 8 * g + 4 * hi) = (f32x4a){z[nb][4 * g], z[nb][4 * g + 1], z[nb][4 * g + 2], z[nb][4 * g + 3]};
    }
}
__device__ __forceinline__ void r3_phase(const Ctx& C, const Bufs& B) {
    const int lane = C.lane, hi = lane >> 5;
    typedef float f32x4a __attribute__((ext_vector_type(4)));
    for (int wu = C.gw; wu < NB * RH * NCH * 2; wu += C.ngw) {
        const int tb = wu & 1; const size_t ci = (size_t)(wu >> 1); const int c = (int)(ci & (NCH - 1)), bh = (int)(ci >> 5), h = bh & 7, b = bh >> 3;
        u32x4v pf[2][2];
#pragma unroll
        for (int nb = 0; nb < 2; ++nb)
#pragma unroll
            for (int s = 0; s < 2; ++s) pf[nb][s] = B.PF[(ci * 8 + (tb * 2 + nb) * 2 + s) * 64 + lane];
        f32x16 y[2];
#pragma unroll
        for (int ib = 0; ib < 2; ++ib) {
            const float* qp = B.QP + ((ci * 4 + tb * 2 + ib) * 64 + lane) * 16;
#pragma unroll
            for (int g = 0; g < 4; ++g) { const f32x4a v = *(const f32x4a*)(qp + 4 * g); y[ib][4 * g] = v[0]; y[ib][4 * g + 1] = v[1]; y[ib][4 * g + 2] = v[2]; y[ib][4 * g + 3] = v[3]; }
#pragma unroll
            for (int nb = 0; nb < 2; ++nb)
#pragma unroll
                for (int s = 0; s < 2; ++s) { const u32x4v zf = B.ZF[((ci * 2 + ib) * 4 + nb * 2 + s) * 64 + lane];
                    y[ib] = __builtin_amdgcn_mfma_f32_32x32x16_bf16(__builtin_bit_cast(bf16x8, pf[nb][s]), __builtin_bit_cast(bf16x8, zf), y[ib], 0, 0, 0); }
        }
        const size_t rowb = (size_t)b * T + 64 * c + 32 * tb;
        float mean[16], rstd[16];
#pragma unroll
        for (int r = 0; r < 16; ++r) {
            float s1 = y[0][r] + y[1][r], s2 = y[0][r] * y[0][r] + y[1][r] * y[1][r];
#pragma unroll
            for (int o = 1; o < 32; o <<= 1) { s1 += __shfl_xor(s1, o); s2 += __shfl_xor(s2, o); }
            mean[r] = s1 * (1.f / 64.f); rstd[r] = 1.f / sqrtf(fmaxf(s2 * (1.f / 64.f) - mean[r] * mean[r], 0.f) + GN_EPS); }
#pragma unroll
        for (int ib = 0; ib < 2; ++ib) { const int i = 32 * ib + (lane & 31);
#pragma unroll
            for (int g = 0; g < 4; ++g) { const size_t o = ((size_t)ci * 64 + i) * 64 + 32 * tb + 8 * g + 4 * hi;
                const u32x2 a1 = *(const u32x2*)(B.G1 + o), a2 = *(const u32x2*)(B.G2 + o);
#pragma unroll
                for (int e = 0; e < 4; ++e) { const int r = 4 * g + e;
                    const float g1 = __builtin_bit_cast(float, (e & 1) ? ((e < 2 ? a1.x : a1.y) & 0xffff0000u) : ((e < 2 ? a1.x : a1.y) << 16));
                    const float g2 = __builtin_bit_cast(float, (e & 1) ? ((e < 2 ? a2.x : a2.y) & 0xffff0000u) : ((e < 2 ? a2.x : a2.y) << 16));
                    B.MIX[(rowb + crow(r, hi)) * D + ATT_W + h * 64 + i] = (bf16)f2bf((y[ib][r] - mean[r]) * rstd[r] * g1 + g2); } } }
    }
}
}
constexpr int N_PHASES = 11;
__global__ void __launch_bounds__(NTHREADS, 2) fwd(Args args) {
    extern __shared__ __attribute__((aligned(16))) unsigned char lds[];
    Ctx C;
    C.lds = (LAS unsigned char*)lds;
    C.tid = threadIdx.x; C.lane = C.tid & 63; C.wave = __builtin_amdgcn_readfirstlane(C.tid >> 6);
    C.G = gridDim.x; C.gw = blockIdx.x * NWAVES + C.wave; C.ngw = C.G * NWAVES;
    C.in = args.in; C.out = args.out; C.ws = args.ws;
    const int lo = args.ph_lo, hi = args.ph_hi;
    volatile LAS unsigned* MISC = (volatile LAS unsigned*)(C.lds + MISC_OFF);
    if (C.tid < 32) MISC[C.tid] = 0u;
    __syncthreads();
    XcdBarrier bar = xcd_barrier_post((unsigned*)(C.ws + WS_CTL) + CW_BAR, MISC + 8);
#define IN(k) (lo <= (k) && (k) < hi)
#define SEAM(k) do { if (IN(k) && IN((k) + 1)) xcd_barrier(bar); } while (0)
    if (IN(0)) { p0_mod(C); p0_weights(C); }
    SEAM(0);
    if (IN(1)) { p1_norm1(C); }
    SEAM(1);
    if (IN(2)) {
        pg8::Gemm g{(const pg8::bf16_t*)(C.ws + WS_A1), (const pg8::bf16_t*)(C.ws + WS_WIN), MPAD, NIN, D}; pg8::StaticOrder S; S.init(MPAD, NIN, C.G, (int)blockIdx.x);
        EpiIn E{C.ws, C.out, C.in[15], C.in[16]};
        pg8::gemm_phase<EpiIn, pg8::StaticOrder, true, true>(C.lds, g, S, E);
    }
    SEAM(2);
    rw::Bufs RB;
    RB.LIN = (bf16*)(C.ws + WS_LIN); RB.W2T = (bf16*)(C.ws + WS_W2T); RB.A2T = (bf16*)(C.ws + WS_A2T); RB.G2T = (bf16*)(C.ws + WS_G2T);
    RB.PRW = (const float*)(C.ws + WS_PRW); RB.G1 = (bf16*)(C.ws + WS_RWA); RB.G2 = (bf16*)(C.ws + WS_RWA + RWA_STRIDE); RB.MIX = (bf16*)(C.ws + WS_MIX);
    RB.MF = (rw::u32x4v*)(C.ws + WS_MF); RB.NT = (float*)(C.ws + WS_NT); RB.PF = (rw::u32x4v*)(C.ws + WS_PF); RB.QP = (float*)(C.ws + WS_QP); RB.ZF = (rw::u32x4v*)(C.ws + WS_ZF);
    if (IN(3)) { p3_lin(C); smp_rwkv(C); }
    SEAM(3);
    if (IN(4)) { idxsel::phase(C); rw::r1_phase(C, RB); p4_indexer<false, true>(C); }
    SEAM(4);
    if (IN(5)) {
        p5_select<false, true>(C);
        if (blockIdx.x < NB * RH * 2) rw::r2_chain_wg(C, RB, (int)blockIdx.x);
        __syncthreads();
        const attn_body::AttnTensors AT{(const attn_body::bf16*)(C.ws + WS_QB), (const attn_body::bf16*)(C.ws + WS_KB), (const attn_body::bf16*)(C.ws + WS_VB), (attn_body::bf16*)(C.ws + WS_MIX), (const unsigned long long*)(C.ws + WS_MASKT)};
        const attn_body::StaticOrder S((int)C.G, (int)blockIdx.x);
        attn_body::attn_phase<attn_body::StaticOrder>((char*)lds, AT, S);
    }
    SEAM(5);
    if (IN(6)) { smp_attn(C); rw::r3_phase(C, RB); }
    SEAM(6);
    if (IN(7)) {
        pg8::Gemm g{(const pg8::bf16_t*)(C.ws + WS_MIX), (const pg8::bf16_t*)(C.ws + WS_WOUT), MP, D, D}; pg8::StaticOrder S; S.init(MP, D, C.G, (int)blockIdx.x);
        EpiResGate E{C.in[0], (const float*)(C.ws + WS_MOD) + 2 * D, (float*)(C.ws + WS_X1)};
        pg8::gemm_phase<EpiResGate, pg8::StaticOrder, true, true>(C.lds, g, S, E);
        const float* xs = C.in[1]; const float* g1 = (const float*)(C.ws + WS_MOD) + (size_t)NB * MODW + 2 * D; float* x1s = (float*)(C.ws + WS_X1) + (size_t)MP * D;
        sample_gemm(C, (const bf16*)(C.ws + WS_MIX) + (size_t)MP * D, (const bf16*)(C.ws + WS_WOUT), D, [&](int row, int col, float v) { x1s[row * D + col] = xs[row * D + col] + g1[(size_t)row * MODW + col] * v; });
    }
    SEAM(7);
    if (IN(8)) { p8_res_norm2(C); }
    SEAM(8);
    if (IN(9)) {
        pg8::Gemm g{(const pg8::bf16_t*)(C.ws + WS_A2), (const pg8::bf16_t*)(C.ws + WS_WGU), MPAD, NGU, D}; pg8::StaticOrder S; S.init(MPAD, NGU, C.G, (int)blockIdx.x);
        EpiSwiGLU E{(bf16*)(C.ws + WS_HB)};
        pg8::gemm_phase<EpiSwiGLU, pg8::StaticOrder, true, true>(C.lds, g, S, E);
    }
    SEAM(9);
    if (IN(10)) {
        pg8::Gemm g{(const pg8::bf16_t*)(C.ws + WS_HB), (const pg8::bf16_t*)(C.ws + WS_WDN), MP, D, FFN}; pg8::StaticOrder S; S.init(MP, D, C.G, (int)blockIdx.x);
        EpiResGate E{(const float*)(C.ws + WS_X1), (const float*)(C.ws + WS_MOD) + 5 * D, C.out + OUT_Y};
        pg8::gemm_phase<EpiResGate, pg8::StaticOrder, true, true>(C.lds, g, S, E);
        const float* x1s = (const float*)(C.ws + WS_X1) + (size_t)MP * D; const float* g2 = (const float*)(C.ws + WS_MOD) + (size_t)NB * MODW + 5 * D; float* ys = C.out + OUT_YS;
        sample_gemm(C, (const bf16*)(C.ws + WS_HB) + (size_t)MP * FFN, (const bf16*)(C.ws + WS_WDN), FFN, [&](int row, int col, float v) { ys[row * D + col] = x1s[row * D + col] + g2[(size_t)row * MODW + col] * v; });
    }
#undef IN
#undef SEAM
}

extern "C" void kernel_launch(void* const* d_in, const int* in_sizes, int n_in, void* d_out, int out_size, void* d_ws, size_t ws_size, hipStream_t stream) {
    static int grid = 0;
    if (grid == 0) {
        if (n_in != 32 || (size_t)out_size != OUT_END || ws_size < WS_END) { fprintf(stderr, "kernel_launch: unexpected sizes n_in %d out %d ws %zu\n", n_in, out_size, ws_size); grid = -1; return; }
        int dev = 0, cus = 0;
        if (hipGetDevice(&dev) != hipSuccess || hipDeviceGetAttribute(&cus, hipDeviceAttributeMultiprocessorCount, dev) != hipSuccess) { grid = -1; return; }
        if (hipFuncSetAttribute((const void*)fwd, hipFuncAttributeMaxDynamicSharedMemorySize, LDS_BYTES) != hipSuccess) { fprintf(stderr, "kernel_launch: hipFuncSetAttribute failed\n"); grid = -1; return; }
        (void)hipGetLastError();
        grid = cus;
    }
    if (grid < 0) return;
    (void)hipMemsetAsync((char*)d_ws + WS_CTL, 0, CTL_ZERO_BYTES, stream);
    Args a{};
    for (int i = 0; i < 32; ++i) a.in[i] = (const float*)d_in[i];
    a.out = (float*)d_out; a.ws = (unsigned char*)d_ws;
    a.ph_lo = 0; a.ph_hi = N_PHASES;
    hipLaunchKernelGGL(fwd, dim3(grid), dim3(NTHREADS), LDS_BYTES, stream, a);
}
```

```cpp
#include <hip/hip_runtime.h>
#include <cstdio>
#include <cstdint>
#include <cmath>
#include <hip/hip_bf16.h>
#define LAS __attribute__((address_space(3)))
namespace pg8 {
#define PG8_LAS __attribute__((address_space(3)))
typedef unsigned short bf16_t;
typedef short bf16x8 __attribute__((ext_vector_type(8)));
typedef float f32x4 __attribute__((ext_vector_type(4)));
typedef unsigned u32x4 __attribute__((ext_vector_type(4)));
constexpr int BM = 256, BK = 64, HALF = 128, HTB = HALF * BK * 2  , STAGE_BYTES = 8 * HTB, NXCD = 8, WGM = 8;

__host__ __device__ __forceinline__ int lds_byte(int r, int c) { const int st = (r >> 4) * 2 + (c >> 5), rr = r & 15, cc = c & 31, ob = rr * 64 + cc * 2; return st * 1024 + (ob ^ (((ob >> 9) & 1) << 5)); }
__host__ __device__ __forceinline__ void stage_rc(int b, int& R, int& C) { const int st = b / 1024, sb = b % 1024, swz = sb ^ (((sb >> 9) & 1) << 5); R = (st >> 1) * 16 + swz / 64; C = (st & 1) * 32 + (swz % 64) / 2; }
__host__ __device__ __forceinline__ int perm32(int rho) { const int n = rho >> 4, i = rho & 15; return 8 * (i >> 2) + 4 * n + (i & 3); }

struct Unit { int pm, pn; };
struct Gemm { const bf16_t* A; const bf16_t* Bt; int M, N, K; };

struct StaticOrder {
    int nM, nN, nwg, G, c;
    __host__ __device__ void init(int M, int N, int G_, int c_) { nM = M / BM; nN = N / BM; nwg = nM * nN; G = G_; c = c_; }
    __host__ __device__ bool next(int i, Unit& u) const {
        const long L = (long)i * G + c; if (L >= nwg) return false;
        int wgid = (int)L; { const int q = nwg / NXCD, r = nwg % NXCD, xcd = wgid % NXCD, off = wgid / NXCD; wgid = (xcd < r ? xcd * (q + 1) : r * (q + 1) + (xcd - r) * q) + off; }
        const int nig = WGM * nN, gid = wgid / nig, fm = gid * WGM, gsz = (nM - fm) < WGM ? (nM - fm) : WGM;
        u.pm = fm + ((wgid % nig) % gsz); u.pn = (wgid % nig) / gsz; return true;
    }
    __device__ __forceinline__ void a_ready(const Unit&) const {}
    __device__ __forceinline__ void done(const Unit&) const {}
};

__device__ __forceinline__ unsigned cvt_pk_bf16(float lo, float hi) { unsigned r; asm volatile("v_cvt_pk_bf16_f32 %0, %1, %2" : "=v"(r) : "v"(lo), "v"(hi)); return r; }
typedef float f32x2 __attribute__((ext_vector_type(2)));
__device__ __forceinline__ f32x2 gelu_pk(f32x2 v) {
    const f32x2 av = __builtin_elementwise_abs(v), d = av * 0.2316418882f + 1.0f;
    f32x2 t; t.x = __builtin_amdgcn_rcpf(d.x); t.y = __builtin_amdgcn_rcpf(d.y);
    f32x2 q = t * 0.5307027145f + (-0.7265760135f); q = q * t + 0.7107068705f; q = q * t + (-0.142248368f); q = q * t + 0.127414796f; q = q * t;
    const f32x2 s = (v * v) * (-0.72134752044f);
    f32x2 e; e.x = __builtin_amdgcn_exp2f(s.x); e.y = __builtin_amdgcn_exp2f(s.y);
    const f32x2 m = v * (q * e), r = v - m;
    f32x2 o; o.x = v.x < 0.f ? m.x : r.x; o.y = v.y < 0.f ? m.y : r.y; return o;
}

template <int ACT  > struct EpiBf16 {
    static constexpr bool PERM = true, AFTER_DRAIN = false; static_assert(ACT == 0 || ACT == 1, "EpiBf16: ACT is 0 (none) or 1 (gelu_pk)");
    bf16_t* O; int ldc; const float* bias; int split_cols; size_t split_stride; float scale0;
    __device__ __forceinline__ void operator()(const f32x4 (&acc)[2][2][4][2], const Unit& u, int wr, int wc, int fr, int fq) const {
        const int row0 = u.pm * BM + wr * 64 + fr; int colt = u.pn * BM; bf16_t* base = O;
        float sc = 1.f; if (split_cols) { const int t = colt / split_cols; base += (size_t)t * split_stride; colt -= t * split_cols; if (t == 0) sc = scale0; }
        const int col0 = colt + wc * 32 + 8 * fq, bcol0 = u.pn * BM + wc * 32 + 8 * fq;
        f32x4 bv[2][2];
#pragma unroll
        for (int bj = 0; bj < 2; ++bj)
#pragma unroll
            for (int n = 0; n < 2; ++n) bv[bj][n] = bias ? *(const f32x4*)(bias + bcol0 + bj * HALF + 4 * n) : (f32x4){0.f, 0.f, 0.f, 0.f};
#pragma unroll
        for (int ai = 0; ai < 2; ++ai)
#pragma unroll
            for (int m = 0; m < 4; ++m) { bf16_t* rowp = base + (size_t)(row0 + ai * HALF + m * 16) * ldc + col0;
#pragma unroll
                for (int bj = 0; bj < 2; ++bj) { f32x4 v0 = acc[ai][bj][m][0] + bv[bj][0], v1 = acc[ai][bj][m][1] + bv[bj][1];
                    if (ACT == 1) { f32x2 a = gelu_pk((f32x2){v0[0], v0[1]}), b = gelu_pk((f32x2){v0[2], v0[3]}), c = gelu_pk((f32x2){v1[0], v1[1]}), d = gelu_pk((f32x2){v1[2], v1[3]});
                        v0 = (f32x4){a.x, a.y, b.x, b.y}; v1 = (f32x4){c.x, c.y, d.x, d.y}; }
                    v0 = v0 * sc; v1 = v1 * sc; u32x4 w; w.x = cvt_pk_bf16(v0[0], v0[1]); w.y = cvt_pk_bf16(v0[2], v0[3]); w.z = cvt_pk_bf16(v1[0], v1[1]); w.w = cvt_pk_bf16(v1[2], v1[3]);
                    *(u32x4*)(rowp + bj * HALF) = w; } }
    }
};


template <class Epi, class Sched, bool ALIGN_EPI = false, bool SP2 = false>
__device__ __forceinline__ void gemm_phase(PG8_LAS unsigned char* lds, const Gemm g, const Sched& S, const Epi& E) {
    const int tid = threadIdx.x, wid = __builtin_amdgcn_readfirstlane(tid >> 6), lane = tid & 63, wr = wid >> 2, wc = wid & 3, fr = lane & 15, fq = lane >> 4;
    const int K = g.K, nt = K / BK;
    unsigned voffA[2], voffB[2];
#pragma unroll
    for (int i = 0; i < 2; ++i) { int R, C; stage_rc(tid * 16 + i * 8192, R, C); const int Rb = Epi::PERM ? ((R & ~31) + perm32(R & 31)) : R;
        voffA[i] = (unsigned)(R * K + C) * 2u; voffB[i] = (unsigned)(Rb * K + C) * 2u; }
    const size_t kstep = (size_t)(BK * 2);
    const size_t hstep = (size_t)HALF * K * 2;
    const size_t tstep = 2 * hstep;
    const unsigned ldsw = (unsigned)wid * 1024u;
    const int aoff = lds_byte(wr * 64 + fr, fq * 8), boff = lds_byte(wc * 32 + fr, fq * 8);
#define PG8_SA(b, h) (((b) * 2 + (h)) * HTB)
#define PG8_SB(b, h) ((4 + (b) * 2 + (h)) * HTB)
#define PG8_STAGE(bufoff, gbase, voff) do { _Pragma("unroll") for (int _i = 0; _i < 2; ++_i) \
        __builtin_amdgcn_global_load_lds((const unsigned*)((const char*)(gbase) + (voff)[_i]), (PG8_LAS unsigned*)(lds + (bufoff) + ldsw + _i * 8192), 16, 0, 0); } while (0)
#define PG8_LDA(dst, b, h) do { _Pragma("unroll") for (int m = 0; m < 4; ++m) _Pragma("unroll") for (int k = 0; k < 2; ++k) dst[m][k] = *(const PG8_LAS bf16x8*)(lds + PG8_SA(b, h) + aoff + m * 2048 + k * 1024); } while (0)
#define PG8_LDB(dst, b, h) do { _Pragma("unroll") for (int n = 0; n < 2; ++n) _Pragma("unroll") for (int k = 0; k < 2; ++k) dst[n][k] = *(const PG8_LAS bf16x8*)(lds + PG8_SB(b, h) + boff + n * 2048 + k * 1024); } while (0)
#define PG8_MMA(ai, bj, At, Bt) do { __builtin_amdgcn_s_setprio(1); _Pragma("unroll") for (int m = 0; m < 4; ++m) _Pragma("unroll") for (int n = 0; n < 2; ++n) _Pragma("unroll") for (int k = 0; k < 2; ++k) \
        acc[ai][bj][m][n] = __builtin_amdgcn_mfma_f32_16x16x32_bf16(Bt[n][k], At[m][k], acc[ai][bj][m][n], 0, 0, 0); __builtin_amdgcn_s_setprio(0); } while (0)
#define PG8_WAIT_V(n) asm volatile("s_waitcnt vmcnt(" #n ")" ::: "memory")
#define PG8_WAIT_L(n) asm volatile("s_waitcnt lgkmcnt(" #n ")" ::: "memory")
#define PG8_BAR __builtin_amdgcn_s_barrier()
#define PG8_SCHED __builtin_amdgcn_sched_barrier(0)
    Unit cur, nxt; int ui = 0;
    if (!S.next(0, cur)) return;
    f32x4 acc[2][2][4][2];
#pragma unroll
    for (int a = 0; a < 2; ++a)
#pragma unroll
        for (int b = 0; b < 2; ++b)
#pragma unroll
            for (int m = 0; m < 4; ++m)
#pragma unroll
                for (int n = 0; n < 2; ++n) acc[a][b][m][n] = (f32x4){0.f, 0.f, 0.f, 0.f};
    bf16x8 At[4][2], B0[2][2], B1[2][2];
    const char* cA = (const char*)g.A + (size_t)cur.pm * tstep; const char* cB = (const char*)g.Bt + (size_t)cur.pn * tstep;
    S.a_ready(cur);
    if constexpr (SP2) {
        PG8_STAGE(PG8_SB(0, 0), cB, voffB); PG8_STAGE(PG8_SB(0, 1), cB + hstep, voffB); PG8_STAGE(PG8_SA(0, 0), cA, voffA); PG8_STAGE(PG8_SA(0, 1), cA + hstep, voffA);
        if (wr == 1) PG8_BAR;
        PG8_WAIT_V(2); PG8_BAR;
        PG8_STAGE(PG8_SB(1, 0), cB + kstep, voffB); PG8_STAGE(PG8_SA(1, 0), cA + kstep, voffA); PG8_STAGE(PG8_SB(1, 1), cB + hstep + kstep, voffB);
        PG8_WAIT_V(6); PG8_BAR;
    } else {
        PG8_STAGE(PG8_SB(0, 0), cB, voffB); PG8_STAGE(PG8_SA(0, 0), cA, voffA); PG8_STAGE(PG8_SB(0, 1), cB + hstep, voffB); PG8_STAGE(PG8_SA(0, 1), cA + hstep, voffA);
        if (wr == 1) PG8_BAR;
        PG8_WAIT_V(4); PG8_BAR;
        PG8_STAGE(PG8_SB(1, 0), cB + kstep, voffB); PG8_STAGE(PG8_SA(1, 0), cA + kstep, voffA); PG8_STAGE(PG8_SB(1, 1), cB + hstep + kstep, voffB);
        PG8_WAIT_V(6); PG8_BAR;
    }
    for (;;) {
        const bool has_next = S.next(ui + 1, nxt);
        const char* nA = has_next ? (const char*)g.A + (size_t)nxt.pm * tstep : cA; const char* nB = has_next ? (const char*)g.Bt + (size_t)nxt.pn * tstep : cB;
        for (int t = 0; t < nt; t += 2) {
            const bool last = (t == nt - 2);
            const char* a1 = cA + (size_t)(t + 1) * kstep;
            const char* a2 = last ? nA : cA + (size_t)(t + 2) * kstep; const char* b2 = last ? nB : cB + (size_t)(t + 2) * kstep;
            const char* a3 = a2 + kstep; const char* b3 = b2 + kstep;
            if (last && has_next) S.a_ready(nxt);
            if constexpr (SP2) {
            PG8_LDB(B0, 0, 0); PG8_LDB(B1, 0, 1); PG8_SCHED; PG8_LDA(At, 0, 0); PG8_STAGE(PG8_SA(1, 1), a1 + hstep, voffA);
            PG8_WAIT_V(8); PG8_WAIT_L(0); PG8_BAR; PG8_MMA(0, 0, At, B0); PG8_MMA(0, 1, At, B1); PG8_BAR; PG8_SCHED;
            PG8_LDA(At, 0, 1); PG8_STAGE(PG8_SB(0, 0), b2, voffB); PG8_STAGE(PG8_SB(0, 1), b2 + hstep, voffB); PG8_STAGE(PG8_SA(0, 0), a2, voffA);
            PG8_WAIT_V(8); PG8_WAIT_L(0); PG8_BAR; PG8_MMA(1, 0, At, B0); PG8_MMA(1, 1, At, B1); PG8_BAR; PG8_SCHED;
            PG8_LDB(B0, 1, 0); PG8_LDB(B1, 1, 1); PG8_SCHED; PG8_LDA(At, 1, 0); PG8_STAGE(PG8_SA(0, 1), a2 + hstep, voffA);
            PG8_WAIT_V(8); PG8_WAIT_L(0); PG8_BAR; PG8_MMA(0, 0, At, B0); PG8_MMA(0, 1, At, B1); PG8_BAR; PG8_SCHED;
            PG8_LDA(At, 1, 1); PG8_STAGE(PG8_SB(1, 0), b3, voffB); PG8_STAGE(PG8_SB(1, 1), b3 + hstep, voffB); PG8_STAGE(PG8_SA(1, 0), a3, voffA);
            PG8_WAIT_V(8); PG8_WAIT_L(0); PG8_BAR; PG8_MMA(1, 0, At, B0); PG8_MMA(1, 1, At, B1); PG8_BAR; PG8_SCHED;
            } else {
            PG8_LDB(B0, 0, 0); PG8_SCHED; PG8_LDA(At, 0, 0); PG8_STAGE(PG8_SA(1, 1), a1 + hstep, voffA);
            PG8_WAIT_L(8); PG8_BAR; PG8_WAIT_L(0); PG8_MMA(0, 0, At, B0); PG8_BAR; PG8_SCHED;
            PG8_LDB(B1, 0, 1); PG8_STAGE(PG8_SB(0, 0), b2, voffB);
            PG8_BAR; PG8_WAIT_L(0); PG8_MMA(0, 1, At, B1); PG8_BAR;
            PG8_LDA(At, 0, 1); PG8_STAGE(PG8_SA(0, 0), a2, voffA);
            PG8_BAR; PG8_WAIT_L(0); PG8_MMA(1, 0, At, B0); PG8_BAR; PG8_SCHED;
            PG8_STAGE(PG8_SB(0, 1), b2 + hstep, voffB);
            PG8_WAIT_V(6); PG8_BAR; PG8_MMA(1, 1, At, B1); PG8_BAR;
            PG8_LDB(B0, 1, 0); PG8_SCHED; PG8_LDA(At, 1, 0); PG8_STAGE(PG8_SA(0, 1), a2 + hstep, voffA);
            PG8_WAIT_L(8); PG8_BAR; PG8_WAIT_L(0); PG8_MMA(0, 0, At, B0); PG8_BAR; PG8_SCHED;
            PG8_LDB(B1, 1, 1); PG8_STAGE(PG8_SB(1, 0), b3, voffB);
            PG8_BAR; PG8_WAIT_L(0); PG8_MMA(0, 1, At, B1); PG8_BAR;
            PG8_LDA(At, 1, 1); PG8_STAGE(PG8_SA(1, 0), a3, voffA);
            PG8_BAR; PG8_WAIT_L(0); PG8_MMA(1, 0, At, B0); PG8_BAR; PG8_SCHED;
            PG8_STAGE(PG8_SB(1, 1), b3 + hstep, voffB);
            PG8_WAIT_V(6); PG8_BAR; PG8_MMA(1, 1, At, B1); PG8_BAR;
            }
        }
        if constexpr (ALIGN_EPI) { if (wr == 0) PG8_BAR; }
        if constexpr (!Epi::AFTER_DRAIN) { E(acc, cur, wr, wc, fr, fq); S.done(cur); }
        if (!has_next) break;
#pragma unroll
        for (int a = 0; a < 2; ++a)
#pragma unroll
            for (int b = 0; b < 2; ++b)
#pragma unroll
                for (int m = 0; m < 4; ++m)
#pragma unroll
                    for (int n = 0; n < 2; ++n) acc[a][b][m][n] = (f32x4){0.f, 0.f, 0.f, 0.f};
        cur = nxt; cA = nA; cB = nB; ++ui;
        if constexpr (ALIGN_EPI) { if (wr == 1) PG8_BAR; }
    }
    PG8_WAIT_V(0);
    if constexpr (!ALIGN_EPI) { if (wr == 0) PG8_BAR; }
    PG8_BAR;
    if constexpr (Epi::AFTER_DRAIN) { E.fused(acc, cur, wr, wc, fr, fq, lds, wid, lane); S.done(cur); }
#undef PG8_SA
#undef PG8_SB
#undef PG8_STAGE
#undef PG8_LDA
#undef PG8_LDB
#undef PG8_MMA
#undef PG8_WAIT_V
#undef PG8_WAIT_L
#undef PG8_BAR
#undef PG8_SCHED
}
}
namespace attn_body {
using bf16=__hip_bfloat16;
using bf16x8=__attribute__((ext_vector_type(8)))short;
using s16x4=__attribute__((ext_vector_type(4)))short;
using f32x16=__attribute__((ext_vector_type(16)))float;
using u32x4=__attribute__((ext_vector_type(4)))unsigned;
constexpr int BATCH=8,NHEAD=8,SEQ=2048,D=64,DM=NHEAD*D,DMO=1024;
constexpr int NW=8,QBLK=32,QB=QBLK*NW,KVBLK=64,NQB=SEQ/QB;
constexpr int ATTN_PITCH=DM, ATTN_UNIT_ROWS=QB;
__device__ __forceinline__ int crow(int r,int hi){return (r&3)+8*(r>>2)+4*hi;}
#define SBAR() __builtin_amdgcn_sched_barrier(0)
typedef unsigned u32x16 __attribute__((ext_vector_type(16)));
constexpr int NSLOT=3, SLOTB=8192;
constexpr int LDS_K=0, LDS_V=NSLOT*SLOTB, LDS_WS=2*NSLOT*SLOTB, LDS_OST=LDS_WS+NW*64*4, LDS_BYTES=LDS_OST+NW*4096;
constexpr float C2=0.125f*1.4426950408889634f;
__device__ __forceinline__ void glds16(const void*gsrc,unsigned lds_dst){unsigned keep;
  asm volatile("s_mov_b32 %0, m0\n\ts_mov_b32 m0, %2\n\ts_nop 0\n\tglobal_load_lds_dwordx4 %1, off\n\ts_mov_b32 m0, %0":"=&s"(keep):"v"(gsrc),"s"(lds_dst):"memory");}
__device__ __forceinline__ float max3f(float a,float b,float c){float r;asm("v_max3_f32 %0, %1, %2, %3":"=v"(r):"v"(a),"v"(b),"v"(c));return r;}
__device__ __forceinline__ float max2f(float a,float b){float r;asm("v_max_f32_e32 %0, %1, %2":"=v"(r):"v"(a),"v"(b));return r;}
__device__ __forceinline__ float fadd_s(float a,float b){float r;asm("v_add_f32_e32 %0, %1, %2":"=v"(r):"v"(a),"v"(b));return r;}
__device__ __forceinline__ float fsub_s(float a,float b){float r;asm("v_sub_f32_e32 %0, %1, %2":"=v"(r):"v"(a),"v"(b));return r;}
typedef float f32x2_t __attribute__((ext_vector_type(2))); typedef __bf16 bf16x2_t __attribute__((ext_vector_type(2)));
__device__ __forceinline__ unsigned cvtpk_s(float lo,float hi){f32x2_t v={lo,hi};bf16x2_t b=__builtin_convertvector(v,bf16x2_t);return __builtin_bit_cast(unsigned,b);}
#define WAIT_BAR(N) asm volatile("s_waitcnt vmcnt(" #N ") lgkmcnt(0)\n\ts_barrier":::"memory")

__device__ __forceinline__ void qkt(f32x16&p0,f32x16&p1,const char*Kslot,const bf16x8*qr,int r32,int hi){ const f32x16 negm=f32x16{};
  const char*kb=Kslot+hi*1024+r32*16;
  #pragma unroll
  for(int d0=0;d0<4;++d0){
    const bf16x8 b0=*reinterpret_cast<const bf16x8*>(kb+d0*2048);
    const bf16x8 b1=*reinterpret_cast<const bf16x8*>(kb+d0*2048+512);
    if(d0==0){p0=__builtin_amdgcn_mfma_f32_32x32x16_bf16(b0,qr[0],negm,0,0,0);p1=__builtin_amdgcn_mfma_f32_32x32x16_bf16(b1,qr[0],negm,0,0,0);}
    else{p0=__builtin_amdgcn_mfma_f32_32x32x16_bf16(b0,qr[d0],p0,0,0,0);p1=__builtin_amdgcn_mfma_f32_32x32x16_bf16(b1,qr[d0],p1,0,0,0);}}
}
typedef __attribute__((address_space(3))) const char* lds_cptr;
typedef short v4i16_t __attribute__((ext_vector_type(4)));
__device__ __forceinline__ void kload8(bf16x8*kf,lds_cptr kp){
  kf[0]=*(const __attribute__((address_space(3))) bf16x8*)(kp);      kf[1]=*(const __attribute__((address_space(3))) bf16x8*)(kp+512);
  kf[2]=*(const __attribute__((address_space(3))) bf16x8*)(kp+2048); kf[3]=*(const __attribute__((address_space(3))) bf16x8*)(kp+2560);
  kf[4]=*(const __attribute__((address_space(3))) bf16x8*)(kp+4096); kf[5]=*(const __attribute__((address_space(3))) bf16x8*)(kp+4608);
  kf[6]=*(const __attribute__((address_space(3))) bf16x8*)(kp+6144); kf[7]=*(const __attribute__((address_space(3))) bf16x8*)(kp+6656);
}
__device__ __forceinline__ void kload2(bf16x8*kf,lds_cptr kp,int j){ kf[2*j]=*(const __attribute__((address_space(3))) bf16x8*)(kp+j*2048); kf[2*j+1]=*(const __attribute__((address_space(3))) bf16x8*)(kp+j*2048+512); }
__device__ __forceinline__ s16x4 vtr(lds_cptr p){ return __builtin_bit_cast(s16x4,__builtin_amdgcn_ds_read_tr16_b64_v4i16((__attribute__((address_space(3))) v4i16_t*)p)); }
__device__ __forceinline__ float rowmax(const f32x16&p0,const f32x16&p1){
  float a=max3f(p0[0],p0[1],p1[0]),b=max3f(p0[2],p0[3],p1[1]);a=max3f(a,p1[2],p1[3]);
  #pragma unroll
  for(int r=4;r<16;r+=4){a=max3f(a,p0[r],p0[r+1]);b=max3f(b,p0[r+2],p0[r+3]);a=max3f(a,p1[r],p1[r+1]);b=max3f(b,p1[r+2],p1[r+3]);}
  const float m=max2f(a,b);
  auto rr=__builtin_amdgcn_permlane32_swap(__float_as_uint(m),__float_as_uint(m),false,false);
  return max2f(__uint_as_float(rr[0]),__uint_as_float(rr[1]));
}
__device__ __forceinline__ void pv(f32x16*o,int vb,bf16x8 pa0,bf16x8 pa1,bf16x8 pa2,bf16x8 pa3){
  #pragma unroll
  for(int d0=0;d0<2;++d0){s16x4 lo[4],hi[4];
    #pragma unroll
    for(int ks=0;ks<4;++ks){
      asm volatile("ds_read_b64_tr_b16 %0,%1 offset:%c2":"=&v"(lo[ks]):"v"(vb),"i"(d0*4096+ks*1024):"memory");
      asm volatile("ds_read_b64_tr_b16 %0,%1 offset:%c2":"=&v"(hi[ks]):"v"(vb),"i"(d0*4096+ks*1024+512):"memory");}
    asm volatile("s_waitcnt lgkmcnt(0)":::"memory");SBAR();
    #define PK(k) (bf16x8){lo[k][0],lo[k][1],lo[k][2],lo[k][3],hi[k][0],hi[k][1],hi[k][2],hi[k][3]}
    o[d0]=__builtin_amdgcn_mfma_f32_32x32x16_bf16(pa0,PK(0),o[d0],0,0,0);
    o[d0]=__builtin_amdgcn_mfma_f32_32x32x16_bf16(pa1,PK(1),o[d0],0,0,0);
    o[d0]=__builtin_amdgcn_mfma_f32_32x32x16_bf16(pa2,PK(2),o[d0],0,0,0);
    o[d0]=__builtin_amdgcn_mfma_f32_32x32x16_bf16(pa3,PK(3),o[d0],0,0,0);
    #undef PK
  }
}

#ifndef ATTN_STORE16
#define ATTN_STORE16(p,v) (*(u32x4*)(p)=(v))
#endif
template<int THRL> __device__ __forceinline__ void attn_unit(int b,int h,int qb,const bf16*Q,const bf16*__restrict__ K,const bf16*__restrict__ V,bf16*O,const unsigned long long*MT,char*shm){
  const int tid=threadIdx.x,lane=tid&63,r32=lane&31,hi=lane>>5; const int wid=__builtin_amdgcn_readfirstlane(tid>>6);
  const long rowbase=(long)b*SEQ; const int q0=qb*QB;
  const bf16*Qw=Q+(rowbase+q0+wid*QBLK)*DM+h*D;
  const bf16*Kh=K+rowbase*DM+h*D,*Vh=V+rowbase*DM+h*D;
  const unsigned lds0=(unsigned)(uintptr_t)shm;
  float*wsf=(float*)(shm+LDS_WS)+wid*64;
  const bf16*ksrc=Kh+(long)lane*DM+wid*8;
  const bf16*vsrc=Vh+(long)(16*(wid&3)+(lane>>2))*DM+(wid>>2)*32+(lane&3)*8;
  const unsigned kdst=lds0+LDS_K+wid*1024, vdst=lds0+LDS_V+wid*1024;
  #define DMA_K(t,slot) glds16(ksrc+(long)(t)*KVBLK*DM,(unsigned)__builtin_amdgcn_readfirstlane(kdst+(slot)))
  #define DMA_V(t,slot) glds16(vsrc+(long)(t)*KVBLK*DM,(unsigned)__builtin_amdgcn_readfirstlane(vdst+(slot)))
  const int vb0=(int)(lds0+LDS_V)+((lane>>4)&1)*32+(lane&3)*8+(4*hi+((lane&15)>>2))*64;
  const char*Kbase=shm+LDS_K; bf16x8 kf[8];
  const lds_cptr shm3=(lds_cptr)shm; const lds_cptr kp0=shm3+LDS_K+hi*1024+r32*16; const lds_cptr vp0=shm3+LDS_V+((lane>>4)&1)*32+(lane&3)*8+(4*hi+((lane&15)>>2))*64;
  const int NT=(q0+QB)/KVBLK;
  const unsigned long long*mbase=MT+((size_t)((b*(SEQ/32)+qb*NW+wid)*(SEQ/KVBLK)))*32;
  u32x16 mk0,mk1,mk2,mk3; const float NEGV=-INFINITY;
  #define MLOAD(t) do{ const unsigned long long*mp_=mbase+(size_t)(t)*32; \
    asm volatile("s_load_dwordx16 %0, %4, 0x0\n\ts_load_dwordx16 %1, %4, 0x40\n\ts_load_dwordx16 %2, %4, 0x80\n\ts_load_dwordx16 %3, %4, 0xc0":"=&s"(mk0),"=&s"(mk1),"=&s"(mk2),"=&s"(mk3):"s"(mp_):"memory"); }while(0)
  #define MK64(v,i) (((unsigned long long)(v)[2*(i)+1]<<32)|(unsigned long long)(v)[2*(i)])
  #define MAPPLY(P0,P1) do{ asm volatile("s_waitcnt lgkmcnt(0)":"+s"(mk0),"+s"(mk1),"+s"(mk2),"+s"(mk3)::"memory"); \
    _Pragma("unroll") for(int r=0;r<8;++r){ P0[r]=__builtin_amdgcn_inverse_ballot_w64(MK64(mk0,r))?P0[r]:NEGV; P0[r+8]=__builtin_amdgcn_inverse_ballot_w64(MK64(mk1,r))?P0[r+8]:NEGV; \
      P1[r]=__builtin_amdgcn_inverse_ballot_w64(MK64(mk2,r))?P1[r]:NEGV; P1[r+8]=__builtin_amdgcn_inverse_ballot_w64(MK64(mk3,r))?P1[r+8]:NEGV; } }while(0)
  DMA_K(0,0);DMA_V(0,0);DMA_K(1,SLOTB);
  bf16x8 qr[4];
  #pragma unroll
  for(int d0=0;d0<4;++d0)qr[d0]=*reinterpret_cast<const bf16x8*>(&Qw[(long)r32*DM+d0*16+hi*8]);
  float mhat=0.f,l_reg=0.f;f32x16 o[2];o[0]=f32x16{};o[1]=f32x16{};const f32x16 zc=f32x16{};
  bool resc=false;
  #define START(P0,P1) do{ const float rm=rowmax(P0,P1); resc=false; \
    { const float dl=max2f(rm,-30.f); mhat=fadd_s(mhat,dl); \
      _Pragma("unroll") for(int r=0;r<16;++r){P0[r]=fsub_s(P0[r],dl);P1[r]=fsub_s(P1[r],dl);} \
      } \
    _Pragma("unroll") for(int r=0;r<16;++r)P0[r]=__builtin_amdgcn_exp2f(P0[r]); }while(0)
  #define RESC() do{ if(resc){ asm volatile("s_waitcnt lgkmcnt(0)":::"memory"); \
      _Pragma("unroll") for(int d_=0;d_<2;++d_) _Pragma("unroll") for(int r=0;r<16;++r)o[d_][r]*=wsf[crow(r,hi)]; } }while(0)
  f32x16 pA0,pA1,pB0,pB1;
  int sl_prev=0,sl_cur=0,sl_next=SLOTB;
  #define ROT() do{sl_prev=sl_cur;sl_cur=sl_next;sl_next=(sl_next==(NSLOT-1)*SLOTB)?0:sl_next+SLOTB;}while(0)
  DMA_K(2,2*SLOTB);
  WAIT_BAR(3);
  MLOAD(0); qkt(pA0,pA1,Kbase,qr,r32,hi);asm volatile("s_nop 15\n\ts_nop 7":"+v"(pA0),"+v"(pA1));MAPPLY(pA0,pA1);asm volatile("s_nop 1":"+v"(pA0),"+v"(pA1));
  START(pA0,pA1);
  _Pragma("unroll") for(int r=0;r<16;++r)pA1[r]=__builtin_amdgcn_exp2f(pA1[r]);
  WAIT_BAR(0);
  DMA_K(3,0);DMA_V(1,SLOTB);
  ROT();
  kload8(kf,kp0+sl_cur);
  WAIT_BAR(2);
  s16x4 vlo[8],vhi[8]; u32x4 pw0,pw1,pw2,pw3;
  #define PKW(P,B) cvtpk_s(P[B],P[B+1])
  #define PAF(k) __builtin_bit_cast(bf16x8,pw##k)
  #define VFR(i) (bf16x8){vlo[i][0],vlo[i][1],vlo[i][2],vlo[i][3],vhi[i][0],vhi[i][1],vhi[i][2],vhi[i][3]}
  #define PIN(x) asm volatile("":"+v"(x))
  #define MX3(a,b,c) __builtin_fmaxf(__builtin_fmaxf((a),(b)),(c))
  #define GAPA(MF,A0,A1,A2,A3,W0,W1,PW) do{ MF; sacc+=A0; sacc+=A1; sacc+=A2; sacc+=A3; PIN(sacc); W0; W1; PIN(PW); SBAR(); }while(0)
  #define EX(v) __builtin_amdgcn_exp2f(v)
  #define GAPB(MF,X,B) do{ MF; X[B]=EX(X[B]); X[B+1]=EX(X[B+1]); X[B+2]=EX(X[B+2]); X[B+3]=EX(X[B+3]); PIN(X); SBAR(); }while(0)
  #define VRD(i) do{ vlo[i]=vtr(vp_+(((i)>>2)*4096+((i)&3)*1024)); vhi[i]=vtr(vp_+(((i)>>2)*4096+((i)&3)*1024+512)); }while(0)
  #define KRD(G,j) do{ if(G){ kload2(kf,kp0+sl_next,j); SBAR(); } }while(0)
  #define STEP(C0,C1,P0,P1,t,GK,GV,GL) do{ SBAR(); MLOAD(t); \
    const lds_cptr vp_=vp0+sl_prev; \
    VRD(0); SBAR(); float sacc=(P0[0]+P0[1]); \
    GAPA(C0=__builtin_amdgcn_mfma_f32_32x32x16_bf16(kf[0],qr[0],zc,0,0,0), P0[2],P0[3],P0[4],P0[5],     pw0[0]=PKW(P0,0), pw0[1]=PKW(P0,2), pw0); \
    VRD(4); SBAR(); GAPA(C1=__builtin_amdgcn_mfma_f32_32x32x16_bf16(kf[1],qr[0],zc,0,0,0), P0[6],P0[7],P0[8],P0[9],     pw0[2]=PKW(P0,4), pw0[3]=PKW(P0,6), pw0); \
    VRD(1); SBAR(); GAPA(C0=__builtin_amdgcn_mfma_f32_32x32x16_bf16(kf[2],qr[1],C0,0,0,0),   P0[10],P0[11],P0[12],P0[13], pw1[0]=PKW(P0,8), pw1[1]=PKW(P0,10), pw1); \
    VRD(5); SBAR(); GAPA(C1=__builtin_amdgcn_mfma_f32_32x32x16_bf16(kf[3],qr[1],C1,0,0,0),   P0[14],P0[15],P1[0],P1[1],   pw1[2]=PKW(P0,12),pw1[3]=PKW(P0,14), pw1); \
    VRD(2); SBAR(); GAPA(C0=__builtin_amdgcn_mfma_f32_32x32x16_bf16(kf[4],qr[2],C0,0,0,0),   P1[2],P1[3],P1[4],P1[5],     pw2[0]=PKW(P1,0), pw2[1]=PKW(P1,2), pw2); \
    VRD(6); SBAR(); GAPA(C1=__builtin_amdgcn_mfma_f32_32x32x16_bf16(kf[5],qr[2],C1,0,0,0),   P1[6],P1[7],P1[8],P1[9],     pw2[2]=PKW(P1,4), pw2[3]=PKW(P1,6), pw2); \
    VRD(3); SBAR(); GAPA(C0=__builtin_amdgcn_mfma_f32_32x32x16_bf16(kf[6],qr[3],C0,0,0,0),   P1[10],P1[11],P1[12],P1[13], pw3[0]=PKW(P1,8), pw3[1]=PKW(P1,10), pw3); \
    VRD(7); SBAR(); GAPA(C1=__builtin_amdgcn_mfma_f32_32x32x16_bf16(kf[7],qr[3],C1,0,0,0),   P1[14],P1[15],0.f,0.f,       pw3[2]=PKW(P1,12),pw3[3]=PKW(P1,14), pw3); \
    l_reg+=sacc; \
    if(GK){DMA_K((t)+3,sl_cur);} if(GV){DMA_V((t)+1,sl_next);} \
    MAPPLY(C0,C1); \
    { float a=MX3(C0[0],C0[1],C1[0]),b=MX3(C0[2],C0[3],C1[1]); a=MX3(a,C1[2],C1[3]); \
      _Pragma("unroll") for(int r=4;r<16;r+=4){a=MX3(a,C0[r],C0[r+1]);b=MX3(b,C0[r+2],C0[r+3]);a=MX3(a,C1[r],C1[r+1]);b=MX3(b,C1[r+2],C1[r+3]);} \
      float rm=__builtin_fmaxf(a,b); { auto rr=__builtin_amdgcn_permlane32_swap(__float_as_uint(rm),__float_as_uint(rm),false,false); rm=__builtin_fmaxf(__uint_as_float(rr[0]),__uint_as_float(rr[1])); } \
      resc=false; \
      const float rl=rm-mhat; \
      if(__builtin_expect(__any(rl>(float)THRL),0)){ const float dl=__builtin_fmaxf(rl,0.f); mhat+=dl; \
        const float f=__builtin_amdgcn_exp2f(-dl); l_reg*=f; if(hi==0)wsf[r32]=f; resc=true; } \
      _Pragma("unroll") for(int r=0;r<16;++r){C0[r]-=mhat;C1[r]-=mhat;} } \
    SBAR(); \
    GAPB(o[0]=__builtin_amdgcn_mfma_f32_32x32x16_bf16(PAF(0),VFR(0),o[0],0,0,0), C0,0); \
    GAPB(o[1]=__builtin_amdgcn_mfma_f32_32x32x16_bf16(PAF(0),VFR(4),o[1],0,0,0), C0,4); \
    KRD(GL,0); GAPB(o[0]=__builtin_amdgcn_mfma_f32_32x32x16_bf16(PAF(1),VFR(1),o[0],0,0,0), C0,8); \
    KRD(GL,1); GAPB(o[1]=__builtin_amdgcn_mfma_f32_32x32x16_bf16(PAF(1),VFR(5),o[1],0,0,0), C0,12); \
    KRD(GL,2); GAPB(o[0]=__builtin_amdgcn_mfma_f32_32x32x16_bf16(PAF(2),VFR(2),o[0],0,0,0), C1,0); \
    KRD(GL,3); GAPB(o[1]=__builtin_amdgcn_mfma_f32_32x32x16_bf16(PAF(2),VFR(6),o[1],0,0,0), C1,4); \
    GAPB(o[0]=__builtin_amdgcn_mfma_f32_32x32x16_bf16(PAF(3),VFR(3),o[0],0,0,0), C1,8); \
    GAPB(o[1]=__builtin_amdgcn_mfma_f32_32x32x16_bf16(PAF(3),VFR(7),o[1],0,0,0), C1,12); \
    }while(0)
  int t=1;
  for(;t+5<NT;t+=2){
    STEP(pB0,pB1,pA0,pA1,t,true,true,true);     WAIT_BAR(2); RESC(); ROT();
    STEP(pA0,pA1,pB0,pB1,t+1,true,true,true);   WAIT_BAR(2); RESC(); ROT();
  }
  #define ENDW(tt) do{ if((tt)+3<NT){WAIT_BAR(2);} else if((tt)+2<NT){WAIT_BAR(1);} else {WAIT_BAR(0);} }while(0)
  for(;t+1<NT;t+=2){
    STEP(pB0,pB1,pA0,pA1,t,(t+3<NT),(t+1<NT),(t+1<NT));       ENDW(t);   RESC(); ROT();
    STEP(pA0,pA1,pB0,pB1,t+1,(t+4<NT),(t+2<NT),(t+2<NT));     ENDW(t+1); RESC(); ROT();
  }
  STEP(pB0,pB1,pA0,pA1,NT-1,false,false,false); RESC();
  { float sacc=pB0[0]+pB0[1]; _Pragma("unroll") for(int r=2;r<16;++r)sacc+=pB0[r]; _Pragma("unroll") for(int r=0;r<16;++r)sacc+=pB1[r]; l_reg+=sacc;
    pw0=(u32x4){PKW(pB0,0),PKW(pB0,2),PKW(pB0,4),PKW(pB0,6)};pw1=(u32x4){PKW(pB0,8),PKW(pB0,10),PKW(pB0,12),PKW(pB0,14)};pw2=(u32x4){PKW(pB1,0),PKW(pB1,2),PKW(pB1,4),PKW(pB1,6)};pw3=(u32x4){PKW(pB1,8),PKW(pB1,10),PKW(pB1,12),PKW(pB1,14)};
    SBAR(); pv(o,vb0+sl_cur,PAF(0),PAF(1),PAF(2),PAF(3)); }
  #undef PKW
  #undef PAF
  #undef VFR
  #undef PIN
  #undef MX3
  #undef GAPA
  #undef GAPB
  #undef EX
  #undef VRD
  #undef KRD
  #undef STEP
  #undef ENDW
  {auto rr=__builtin_amdgcn_permlane32_swap(__float_as_uint(l_reg),__float_as_uint(l_reg),false,false);l_reg=__uint_as_float(rr[0])+__uint_as_float(rr[1]);}
  if(hi==0)wsf[32+r32]=l_reg;asm volatile("s_waitcnt lgkmcnt(0)":::"memory");
  float rli[16];
  #pragma unroll
  for(int r=0;r<16;++r)rli[r]=__builtin_amdgcn_rcpf(wsf[32+crow(r,hi)]);
  bf16*Ow=O+(rowbase+q0+wid*QBLK)*DMO+h*D;
  { bf16*stg=(bf16*)(shm+LDS_OST)+wid*2048;
    #pragma unroll
    for(int r=0;r<16;++r){const int orow=crow(r,hi);
      #pragma unroll
      for(int d0=0;d0<2;++d0)stg[orow*64+d0*32+r32]=__float2bfloat16(o[d0][r]*rli[r]);}
    asm volatile("s_waitcnt lgkmcnt(0)":::"memory");
    #pragma unroll
    for(int i=0;i<4;++i){const int row=i*8+(lane>>3),ch=lane&7; const u32x4 v=*(const u32x4*)(stg+row*64+ch*8); ATTN_STORE16(Ow+(long)row*DMO+ch*8,v);} }
  asm volatile("s_waitcnt lgkmcnt(0)\n\ts_barrier":::"memory");
  #undef DMA_K
  #undef DMA_V
  #undef MLOAD
  #undef MK64
  #undef MAPPLY
  #undef START
  #undef RESC
  #undef ROT
}
constexpr int ATTN_LDS_BYTES=LDS_BYTES;
struct AttnTensors { const bf16* Q; const bf16* K; const bf16* V; bf16* O; const unsigned long long* MT; };
struct AttnUnit { int bh; int qb; };
struct StaticOrder {
  int vcu;
  __device__ __forceinline__ explicit StaticOrder(int grid,int block):vcu((block%8)*(grid/8)+block/8){}
  __device__ __forceinline__ bool next(int i,AttnUnit&u)const{ if(i>=2)return false; const int s=vcu&3; u.bh=vcu>>2; u.qb=(i==0)?s:7-s; return true; }
  __device__ __forceinline__ void a_ready(const AttnUnit&)const{}
  __device__ __forceinline__ void done(const AttnUnit&)const{}
};
template<class Sched,int THRL=8> __device__ __forceinline__ void attn_phase(char*lds,const AttnTensors&T,const Sched&S){
  AttnUnit u;
  for(int i=0;S.next(i,u);++i){ S.a_ready(u); attn_unit<THRL>(u.bh/NHEAD,u.bh%NHEAD,u.qb,T.Q,T.K,T.V,T.O,T.MT,lds); S.done(u); }
}
#undef SBAR
#undef WAIT_BAR
}
#define XB_TMO      128
#define XB_XCNT(j)  (256  + 64 * (j))
#define XB_XSUB(j)  (1280 + 64 * (j))
#define XB_XGEN(j)  (2304 + 64 * (j))
#define XB_TOP      3328
#define XB_TOPGEN   3392
#define XCD_BAR_WORDS 3456
#define XB_SPIN_CAP (1u << 18)

__device__ __forceinline__ unsigned xb_ld(unsigned* p)              { return __hip_atomic_load(p, __ATOMIC_RELAXED, __HIP_MEMORY_SCOPE_AGENT); }
__device__ __forceinline__ unsigned xb_add(unsigned* p, unsigned v) { return __hip_atomic_fetch_add(p, v, __ATOMIC_RELAXED, __HIP_MEMORY_SCOPE_AGENT); }
__device__ __forceinline__ unsigned xb_xcc_id() { return (unsigned)__builtin_amdgcn_s_getreg((3 << 11) | 20) & 0xFu; }
#define XB_SPIN(cond, bar) do { unsigned _sp = 0; while (cond) { __builtin_amdgcn_s_sleep(1); \
    if ((++_sp & 255u) == 0u) { if (xb_ld(&(bar)[XB_TMO])) break; if (_sp > XB_SPIN_CAP) { atomicAdd(&(bar)[XB_TMO], 1u); break; } } } } while (0)

struct XcdBarrier {
    unsigned* bar; unsigned x;
    volatile LAS unsigned* st;
};

__device__ __forceinline__ XcdBarrier xcd_barrier_post(unsigned* bar, volatile LAS unsigned* st) {
    XcdBarrier b; b.bar = bar; b.x = xb_xcc_id(); b.st = st;
    if (threadIdx.x == 0) (void)xb_add(&bar[XB_XCNT(b.x)], 1u);
    return b;
}
__device__ __forceinline__ void xcd_barrier_complete(unsigned* bar, unsigned x, unsigned& nloc, unsigned& nx) {
    const unsigned G = gridDim.x * gridDim.y * gridDim.z;
    unsigned sum, cnt, mine, sp = 0u;
    for (;;) {
        sum = 0u; cnt = 0u; mine = 0u;
#pragma unroll
        for (unsigned j = 0; j < 16; ++j) { const unsigned c = xb_ld(&bar[XB_XCNT(j)]); sum += c; cnt += (c > 0u) ? 1u : 0u; mine = (j == x) ? c : mine; }
        if (sum == G) break;
        __builtin_amdgcn_s_sleep(1);
        if ((++sp & 255u) == 0u) { if (xb_ld(&bar[XB_TMO])) break; if (sp > XB_SPIN_CAP) { atomicAdd(&bar[XB_TMO], 1u); break; } }
    }
    nloc = mine > 0u ? mine : 1u; nx = cnt > 0u ? cnt : 1u;
}

__device__ __forceinline__ void xcd_barrier(const XcdBarrier& b) {
    asm volatile("s_waitcnt vmcnt(0)" ::: "memory");
    __syncthreads();
    if (threadIdx.x == 0) {
        unsigned* bar = b.bar;
        __builtin_amdgcn_s_waitcnt(0);
        unsigned nloc = b.st[0], nx = b.st[1];
        if (nloc == 0u) { xcd_barrier_complete(bar, b.x, nloc, nx); b.st[0] = nloc; b.st[1] = nx; }
        const unsigned old = xb_add(&bar[XB_XSUB(b.x)], 1u);
        const unsigned gen = old / nloc;
        if (old + 1u == (gen + 1u) * nloc) {
            __builtin_amdgcn_fence(__ATOMIC_RELEASE, "agent");
            asm volatile("s_waitcnt vmcnt(0)" ::: "memory");
            const unsigned og = xb_add(&bar[XB_TOP], 1u);
            const unsigned tg = og / nx;
            if (og + 1u == (tg + 1u) * nx) xb_add(&bar[XB_TOPGEN], 1u);
            else XB_SPIN(xb_ld(&bar[XB_TOPGEN]) == tg, bar);
            __builtin_amdgcn_fence(__ATOMIC_ACQUIRE, "agent");
            xb_add(&bar[XB_XGEN(b.x)], 1u);
            asm volatile("s_waitcnt vmcnt(0)" ::: "memory");
        } else {
            XB_SPIN(xb_ld(&bar[XB_XGEN(b.x)]) == gen, bar);
            __builtin_amdgcn_fence(__ATOMIC_ACQUIRE, "agent");
            asm volatile("s_waitcnt vmcnt(0)" ::: "memory");
        }
    }
    __syncthreads();
}
#define GAS __attribute__((address_space(1)))
#ifndef LAS
#define LAS __attribute__((address_space(3)))
#endif
typedef unsigned short bf16;
typedef unsigned v4u __attribute__((ext_vector_type(4)));
typedef float f32x4 __attribute__((ext_vector_type(4)));
#define LDS_WAIT() asm volatile("s_waitcnt lgkmcnt(0)" ::: "memory")
#define VM_WAIT() asm volatile("s_waitcnt vmcnt(0)" ::: "memory")

constexpr int D = 1024, NB = 8, T = 2048, MP = NB * T, NSMP = 32, MT = MP + NSMP, MPAD = 16640;
constexpr int ATT_W = 512, AH = 8, IH = 16, IDD = 64, TOPK = 256;
constexpr int RW_W = 512, RH = 8, RN = 64;
constexpr int RW_COLS = 1792, IN_COLS = 4432, NIN = 4608;
constexpr int FFN = 2816, NGU = 2 * FFN;
constexpr int NPAGES = 64, PAGE = 128, PAST = 8192, LS = PAST + 1, SCS_LD = 8704;
constexpr int O_Q = 0, O_K = 512, O_V = 1024, O_QI = 1536, O_KI = 2560, O_WI = 2624, O_RW = 2640;
constexpr float IDX_W_SCALE = 0.03125f;
constexpr float RMS_EPS = 1e-6f, GN_EPS = 64e-5f;
constexpr int MODW = 6 * D;

constexpr size_t OUT_Y = 0, OUT_YS = OUT_Y + (size_t)MP * D, OUT_KP = OUT_YS + (size_t)NSMP * D, OUT_VP = OUT_KP + (size_t)MP * ATT_W,
                 OUT_IKP = OUT_VP + (size_t)MP * ATT_W, OUT_WKVP = OUT_IKP + (size_t)MP * IDD, OUT_SHP = OUT_WKVP + (size_t)NB * RH * RN * RN,
                 OUT_KS = OUT_SHP + (size_t)NB * RW_COLS, OUT_VS = OUT_KS + (size_t)NSMP * ATT_W, OUT_IKS = OUT_VS + (size_t)NSMP * ATT_W,
                 OUT_WKVS = OUT_IKS + (size_t)NSMP * IDD, OUT_SHS = OUT_WKVS + (size_t)NSMP * RH * RN * RN, OUT_END = OUT_SHS + (size_t)NSMP * RW_COLS;
static_assert(OUT_END == 36052992, "output size");

constexpr size_t MiB = 1u << 20;
constexpr size_t WS_CTL = 0, CTL_ZERO_BYTES = 1 * MiB;
constexpr size_t WS_MOD = 1 * MiB;
constexpr size_t WS_WIN = 2 * MiB;
constexpr size_t WS_WOUT = 12 * MiB;
constexpr size_t WS_WGU = 14 * MiB;
constexpr size_t WS_WDN = 26 * MiB;
constexpr size_t WS_A1 = 32 * MiB;
constexpr size_t WS_A2 = 66 * MiB;
constexpr size_t WS_MIX = 100 * MiB;
constexpr size_t WS_HB = 134 * MiB;
constexpr size_t WS_X1 = 224 * MiB;
constexpr size_t WS_PROJ = 290 * MiB;
constexpr size_t WS_PRW = 290 * MiB;
constexpr size_t WS_RAW = 584 * MiB;
constexpr size_t WS_RAW2 = 650 * MiB;
constexpr size_t WS_QN = 1008 * MiB;
constexpr size_t WS_RWA = 1042 * MiB, RWA_STRIDE = 33 * MiB;
constexpr size_t WS_Y = 1273 * MiB;
constexpr size_t WS_SC = 1306 * MiB;
constexpr size_t WS_SCS = 1434 * MiB;
constexpr size_t WS_MASK = 1436 * MiB;
constexpr size_t WS_SLIST = 1440 * MiB;
constexpr size_t WS_QB = 1444 * MiB, WS_KB = 1461 * MiB, WS_VB = 1478 * MiB;
constexpr size_t WS_MASKT = 1495 * MiB;
constexpr size_t WS_QIB = 1500 * MiB;
constexpr size_t WS_KIB = 1536 * MiB;
constexpr size_t WS_WI = 1539 * MiB;
constexpr size_t WS_LIN = 1541 * MiB;
constexpr size_t WS_KX = 1550 * MiB;
constexpr size_t WS_W2T = 1583 * MiB, WS_A2T = 1584 * MiB, WS_G2T = 1585 * MiB;
constexpr size_t WS_MF = 1586 * MiB, WS_NT = 1603 * MiB, WS_PF = 1636 * MiB, WS_QP = 1653 * MiB, WS_ZF = 1686 * MiB;
constexpr size_t WS_Y2 = 1703 * MiB;
constexpr size_t WS_END = 1736 * MiB;
constexpr int QI_LD = 17 * 64;
constexpr int CW_BAR = 4096;

constexpr int NWAVES = 8, NTHREADS = 512;
constexpr int LDS_BYTES = 147456, MISC_OFF = 147200;

__device__ __forceinline__ unsigned f2bf(float f) { unsigned u = __builtin_bit_cast(unsigned, f); return (u + 0x7fffu + ((u >> 16) & 1u)) >> 16; }
__device__ __forceinline__ unsigned pk2(float lo, float hi) { return f2bf(lo) | (f2bf(hi) << 16); }
__device__ __forceinline__ float bf2f(bf16 v) { return __builtin_bit_cast(float, (unsigned)v << 16); }
__device__ __forceinline__ float wave_sum(float v) {
#pragma unroll
    for (int o = 1; o < 64; o <<= 1) v += __shfl_xor(v, o);
    return v;
}
__device__ __forceinline__ float wave_max(float v) {
#pragma unroll
    for (int o = 1; o < 64; o <<= 1) v = fmaxf(v, __shfl_xor(v, o));
    return v;
}
__device__ __forceinline__ int wave_sum_i(int v) {
#pragma unroll
    for (int o = 1; o < 64; o <<= 1) v += __shfl_xor(v, o);
    return v;
}
__device__ __forceinline__ float sigmoidf_(float x) { return 1.f / (1.f + expf(-x)); }
__device__ __forceinline__ unsigned sortable(float f) { const unsigned u = __builtin_bit_cast(unsigned, f); return (u & 0x80000000u) ? ~u : (u | 0x80000000u); }
__device__ __forceinline__ unsigned long long lanemask_lt(int lane) { return (1ull << lane) - 1ull; }
__device__ __forceinline__ float rdlane(float v, int l) { return __builtin_bit_cast(float, __builtin_amdgcn_readlane(__builtin_bit_cast(int, v), l)); }

struct Args { const float* in[32]; float* out; unsigned char* ws; int ph_lo, ph_hi; };

struct Ctx {
    LAS unsigned char* lds;
    int tid, lane, wave, G, gw, ngw;
    const float* const* in; float* out; unsigned char* ws;
};
__device__ __forceinline__ const float* x_row(const Ctx& C, int m) { return m < MP ? C.in[0] + (size_t)m * D : C.in[1] + (size_t)(m - MP) * D; }
__device__ __forceinline__ int mod_row(int m) { return m < MP ? (m >> 11) : NB + (m - MP); }

struct EpiRawF32 {
    static constexpr bool PERM = false, AFTER_DRAIN = false;
    float* O; int ldc;
    __device__ __forceinline__ void operator()(const pg8::f32x4 (&acc)[2][2][4][2], const pg8::Unit& u, int wr, int wc, int fr, int fq) const {
        const int row0 = u.pm * 256 + wr * 64 + fr, col0 = u.pn * 256 + wc * 32 + 4 * fq;
#pragma unroll
        for (int ai = 0; ai < 2; ++ai)
#pragma unroll
            for (int m = 0; m < 4; ++m) { float* rowp = O + (size_t)(row0 + ai * 128 + m * 16) * ldc + col0;
#pragma unroll
                for (int bj = 0; bj < 2; ++bj)
#pragma unroll
                    for (int n = 0; n < 2; ++n) *(pg8::f32x4*)(rowp + bj * 128 + n * 16) = acc[ai][bj][m][n]; }
    }
};

struct EpiResGate {
    static constexpr bool PERM = false, AFTER_DRAIN = false;
    const float* base; const float* gate; float* out;
    __device__ __forceinline__ void operator()(const pg8::f32x4 (&acc)[2][2][4][2], const pg8::Unit& u, int wr, int wc, int fr, int fq) const {
        const int row0 = u.pm * 256 + wr * 64 + fr, col0 = u.pn * 256 + wc * 32 + 4 * fq;
        const float* gp = gate + (size_t)((u.pm * 256) >> 11) * MODW + col0;
        pg8::f32x4 gv[2][2];
#pragma unroll
        for (int bj = 0; bj < 2; ++bj)
#pragma unroll
            for (int n = 0; n < 2; ++n) gv[bj][n] = *(const pg8::f32x4*)(gp + bj * 128 + n * 16);
#pragma unroll
        for (int ai = 0; ai < 2; ++ai)
#pragma unroll
            for (int m = 0; m < 4; ++m) { const size_t off = (size_t)(row0 + ai * 128 + m * 16) * D + col0;
#pragma unroll
                for (int bj = 0; bj < 2; ++bj)
#pragma unroll
                    for (int n = 0; n < 2; ++n) { const pg8::f32x4 bv = *(const pg8::f32x4*)(base + off + bj * 128 + n * 16);
                        *(pg8::f32x4*)(out + off + bj * 128 + n * 16) = bv + gv[bj][n] * acc[ai][bj][m][n]; } }
    }
};
struct EpiIn {
    static constexpr bool PERM = true, AFTER_DRAIN = false;
    unsigned char* ws; float* out; const float* qg; const float* kg;
    __device__ __forceinline__ void operator()(const pg8::f32x4 (&acc)[2][2][4][2], const pg8::Unit& u, int wr, int wc, int fr, int fq) const {
        const int pn = u.pn; const bool smp = u.pm == MP / 256;
        bf16* QB = (bf16*)(ws + WS_QB); bf16* KB = (bf16*)(ws + WS_KB); bf16* VB = (bf16*)(ws + WS_VB); bf16* QIb = (bf16*)(ws + WS_QIB); bf16* KIb = (bf16*)(ws + WS_KIB);
        float* QN = (float*)(ws + WS_QN); float* WI = (float*)(ws + WS_WI); bf16* PRW = (bf16*)(ws + WS_PRW);
        float gq[2][8];
        if (pn < 4) {
#pragma unroll
            for (int bj = 0; bj < 2; ++bj)
#pragma unroll
                for (int e = 0; e < 8; ++e) gq[bj][e] = (pn < 2 ? qg : kg)[32 * bj + 8 * fq + e] * (pn < 2 ? attn_body::C2 : 1.f);
        }
#pragma unroll
        for (int ai = 0; ai < 2; ++ai)
#pragma unroll
            for (int m = 0; m < 4; ++m) {
                const int r = u.pm * 256 + ai * 128 + wr * 64 + m * 16 + fr; const bool ok = r < MT;
                float v[2][8];
#pragma unroll
                for (int bj = 0; bj < 2; ++bj)
#pragma unroll
                    for (int n = 0; n < 2; ++n)
#pragma unroll
                        for (int i = 0; i < 4; ++i) v[bj][4 * n + i] = acc[ai][bj][m][n][i];
                float rstd = 1.f;
                if (pn < 4 || (pn == 10 && wc == 0)) { float ss = 0.f;
#pragma unroll
                    for (int bj = 0; bj < 2; ++bj)
#pragma unroll
                        for (int e = 0; e < 8; ++e) ss += v[bj][e] * v[bj][e];
                    ss += __shfl_xor(ss, 16); ss += __shfl_xor(ss, 32);
                    rstd = 1.f / sqrtf(ss * (1.f / 64.f) + RMS_EPS); }
                if (!ok) continue;
#pragma unroll
                for (int bj = 0; bj < 2; ++bj) {
                    const int cl = 32 * bj + 8 * fq;
                    float* x = v[bj]; int rwcol = -1;
                    if (pn < 2) {
                        const int col = (4 * pn + wc) * 64 + cl; pg8::u32x4 w;
                        w.x = pg8::cvt_pk_bf16(x[0] * rstd * gq[bj][0], x[1] * rstd * gq[bj][1]); w.y = pg8::cvt_pk_bf16(x[2] * rstd * gq[bj][2], x[3] * rstd * gq[bj][3]);
                        w.z = pg8::cvt_pk_bf16(x[4] * rstd * gq[bj][4], x[5] * rstd * gq[bj][5]); w.w = pg8::cvt_pk_bf16(x[6] * rstd * gq[bj][6], x[7] * rstd * gq[bj][7]);
                        *(pg8::u32x4*)(QB + (size_t)r * ATT_W + col) = w;
                        if (smp) { const float ic = 1.f / attn_body::C2; float* qn = QN + (size_t)r * ATT_W + col;
                            *(pg8::f32x4*)qn = (pg8::f32x4){x[0] * rstd * gq[bj][0] * ic, x[1] * rstd * gq[bj][1] * ic, x[2] * rstd * gq[bj][2] * ic, x[3] * rstd * gq[bj][3] * ic};
                            *(pg8::f32x4*)(qn + 4) = (pg8::f32x4){x[4] * rstd * gq[bj][4] * ic, x[5] * rstd * gq[bj][5] * ic, x[6] * rstd * gq[bj][6] * ic, x[7] * rstd * gq[bj][7] * ic}; }
                    } else if (pn < 6) {
                        const bool isk = pn < 4; const int col = (4 * (pn & 1) + wc) * 64 + cl; float y[8];
#pragma unroll
                        for (int e = 0; e < 8; ++e) y[e] = isk ? x[e] * rstd * gq[bj][e] : x[e];
                        float* o = out + (isk ? (smp ? OUT_KS : OUT_KP) : (smp ? OUT_VS : OUT_VP)) + (size_t)(smp ? r - MP : r) * ATT_W + col;
                        *(pg8::f32x4*)o = (pg8::f32x4){y[0], y[1], y[2], y[3]}; *(pg8::f32x4*)(o + 4) = (pg8::f32x4){y[4], y[5], y[6], y[7]};
                        pg8::u32x4 w; w.x = pg8::cvt_pk_bf16(y[0], y[1]); w.y = pg8::cvt_pk_bf16(y[2], y[3]); w.z = pg8::cvt_pk_bf16(y[4], y[5]); w.w = pg8::cvt_pk_bf16(y[6], y[7]);
                        *(pg8::u32x4*)((isk ? KB : VB) + (size_t)r * ATT_W + col) = w;
                    } else if (pn < 10) {
                        const int col = (4 * (pn - 6) + wc) * 64 + cl;
                        pg8::u32x4 w; w.x = pg8::cvt_pk_bf16(x[0], x[1]); w.y = pg8::cvt_pk_bf16(x[2], x[3]); w.z = pg8::cvt_pk_bf16(x[4], x[5]); w.w = pg8::cvt_pk_bf16(x[6], x[7]);
                        *(pg8::u32x4*)(QIb + (size_t)r * QI_LD + col) = w;
                    } else if (pn == 10) {
                        if (wc == 0) {
                            float* o = out + (smp ? OUT_IKS : OUT_IKP) + (size_t)(smp ? r - MP : r) * IDD + cl;
                            *(pg8::f32x4*)o = (pg8::f32x4){x[0] * rstd, x[1] * rstd, x[2] * rstd, x[3] * rstd}; *(pg8::f32x4*)(o + 4) = (pg8::f32x4){x[4] * rstd, x[5] * rstd, x[6] * rstd, x[7] * rstd};
                            pg8::u32x4 w; w.x = pg8::cvt_pk_bf16(x[0] * rstd, x[1] * rstd); w.y = pg8::cvt_pk_bf16(x[2] * rstd, x[3] * rstd); w.z = pg8::cvt_pk_bf16(x[4] * rstd, x[5] * rstd); w.w = pg8::cvt_pk_bf16(x[6] * rstd, x[7] * rstd);
                            *(pg8::u32x4*)(KIb + (size_t)r * IDD + cl) = w;
                        } else if (wc == 1) {
                            if (bj == 0 && fq < 2) { float* o = WI + (size_t)r * IH + 8 * fq; *(pg8::f32x4*)o = (pg8::f32x4){x[0], x[1], x[2], x[3]}; *(pg8::f32x4*)(o + 4) = (pg8::f32x4){x[4], x[5], x[6], x[7]}; }
                        } else rwcol = 1536 + 64 * (wc - 2) + cl;
                    } else if (pn < 17) rwcol = (pn - 11) * 256 + 64 * wc + cl;
                    else if (wc < 2) rwcol = 1664 + 64 * wc + cl;
                    if (rwcol >= 0) {
                        pg8::u32x4 w; w.x = pg8::cvt_pk_bf16(x[0], x[1]); w.y = pg8::cvt_pk_bf16(x[2], x[3]); w.z = pg8::cvt_pk_bf16(x[4], x[5]); w.w = pg8::cvt_pk_bf16(x[6], x[7]);
                        *(pg8::u32x4*)(PRW + (size_t)r * RW_COLS + rwcol) = w;
                        if (smp || (r & (T - 1)) == T - 1) { float* o = out + (smp ? OUT_SHS + (size_t)(r - MP) * RW_COLS : OUT_SHP + (size_t)(r >> 11) * RW_COLS) + rwcol;
                            *(pg8::f32x4*)o = (pg8::f32x4){x[0], x[1], x[2], x[3]}; *(pg8::f32x4*)(o + 4) = (pg8::f32x4){x[4], x[5], x[6], x[7]}; } }
                }
            }
    }
};
struct EpiSwiGLU {
    static constexpr bool PERM = true, AFTER_DRAIN = false;
    bf16* H;
    __device__ __forceinline__ void operator()(const pg8::f32x4 (&acc)[2][2][4][2], const pg8::Unit& u, int wr, int wc, int fr, int fq) const {
        const int row0 = u.pm * 256 + wr * 64 + fr, col0 = u.pn * 128 + wc * 32 + 8 * fq;
#pragma unroll
        for (int ai = 0; ai < 2; ++ai)
#pragma unroll
            for (int m = 0; m < 4; ++m) { float hv[8];
#pragma unroll
                for (int n = 0; n < 2; ++n)
#pragma unroll
                    for (int i = 0; i < 4; ++i) { const float g = acc[ai][0][m][n][i], up = acc[ai][1][m][n][i]; hv[4 * n + i] = g * __builtin_amdgcn_rcpf(1.f + __expf(-g)) * up; }
                pg8::u32x4 w; w.x = pg8::cvt_pk_bf16(hv[0], hv[1]); w.y = pg8::cvt_pk_bf16(hv[2], hv[3]); w.z = pg8::cvt_pk_bf16(hv[4], hv[5]); w.w = pg8::cvt_pk_bf16(hv[6], hv[7]);
                *(pg8::u32x4*)(H + (size_t)(row0 + ai * 128 + m * 16) * FFN + col0) = w; }
    }
};
template <class F> __device__ __forceinline__ void sample_gemm(const Ctx& C, const bf16* A, const bf16* Bt, int K, const F& f) {
    typedef short bf16x8 __attribute__((ext_vector_type(8))); typedef float f32x16 __attribute__((ext_vector_type(16)));
    LAS float* red = (LAS float*)C.lds;
    const int lane = C.lane, hi = lane >> 5, ksteps = K / 16 / NWAVES;
    for (int u = (int)blockIdx.x - 128; u >= 0 && u < D / 32; u += C.G) {
        const int n0 = 32 * u;
        const bf16* ap = A + (size_t)(lane & 31) * K + (size_t)C.wave * ksteps * 16 + 8 * hi; const bf16* bp = Bt + (size_t)(n0 + (lane & 31)) * K + (size_t)C.wave * ksteps * 16 + 8 * hi;
        f32x16 acc = f32x16{};
        for (int ks = 0; ks < ksteps; ++ks) acc = __builtin_amdgcn_mfma_f32_32x32x16_bf16(*(const bf16x8*)(ap + 16 * ks), *(const bf16x8*)(bp + 16 * ks), acc, 0, 0, 0);
        __syncthreads();
#pragma unroll
        for (int r = 0; r < 16; ++r) red[(C.wave * 64 + lane) * 16 + r] = acc[r];
        __syncthreads();
        for (int o = C.tid; o < 1024; o += NTHREADS) { const int ls = o & 63, r = o >> 6; float v = 0.f;
#pragma unroll
            for (int w = 0; w < 8; ++w) v += red[(w * 64 + ls) * 16 + r];
            f((r & 3) + 8 * (r >> 2) + 4 * (ls >> 5), n0 + (ls & 31), v); }
    }
    __syncthreads();
}

__device__ __forceinline__ void p0_mod(const Ctx& C) {
    LAS float* sc = (LAS float*)C.lds;
    const float* cp = C.in[8]; const float* cs = C.in[9]; const float* wada = C.in[12]; const float* bada = C.in[13];
    float* MOD = (float*)(C.ws + WS_MOD);
    const int cl = C.tid & 31, kc = C.tid >> 5;
    for (int u = blockIdx.x; u < MODW / 32; u += C.G) {
        const int c0 = 32 * u;
        float acc[40];
#pragma unroll
        for (int r = 0; r < 40; ++r) acc[r] = 0.f;
        for (int hh = 0; hh < 2; ++hh) {
            __syncthreads();
            for (int i = C.tid; i < 40 * 512; i += NTHREADS) { const int r = i >> 9, kk = i & 511; const float v = (r < NB) ? cp[r * D + 512 * hh + kk] : cs[(r - NB) * D + 512 * hh + kk]; sc[i] = v / (1.f + expf(-v)); }
            __syncthreads();
            const int kb = 512 * hh + 32 * kc;
            for (int k4 = 0; k4 < 8; ++k4) {
                const float* wp = wada + (size_t)(kb + 4 * k4) * MODW + c0 + cl;
                const float w0 = wp[0], w1 = wp[MODW], w2 = wp[2 * MODW], w3 = wp[3 * MODW];
#pragma unroll
                for (int r = 0; r < 40; ++r) { const f32x4 s = *(const LAS f32x4*)(sc + r * 512 + 32 * kc + 4 * k4); acc[r] += s.x * w0 + s.y * w1 + s.z * w2 + s.w * w3; }
            }
        }
        __syncthreads();
#pragma unroll
        for (int r = 0; r < 40; ++r) sc[(kc * 40 + r) * 32 + cl] = acc[r];
        __syncthreads();
        for (int i = C.tid; i < 40 * 32; i += NTHREADS) { const int r = i >> 5, c = i & 31; float s = 0.f;
            for (int k = 0; k < 16; ++k) s += sc[(k * 40 + r) * 32 + c];
            MOD[r * MODW + c0 + c] = s + bada[c0 + c]; }
    }
    __syncthreads();
}
template <int MODE = 0> __device__ __forceinline__ void transpose_item(const float* W, int K, int N, int NP, bf16* WT, int row_off, LAS float* scr, int item, int lane) {
    const int nblk = NP / 32, kb = item / nblk, nb = item % nblk, k0 = 64 * kb, n0 = 32 * nb;
    const int nsrc = n0 + (lane & 31);
#pragma unroll 8
    for (int i = 0; i < 32; ++i) { const int kk = 2 * i + (lane >> 5); scr[kk * 33 + (lane & 31)] = (nsrc < N) ? W[(size_t)(k0 + kk) * N + nsrc] : 0.f; }
    LDS_WAIT(); asm volatile("" ::: "memory");
    const int c = lane & 7;
#pragma unroll
    for (int j = 0; j < 4; ++j) { const int n = (lane >> 3) + 8 * j; const LAS float* s = scr + (8 * c) * 33 + n;
        v4u o; o.x = pk2(s[0 * 33], s[1 * 33]); o.y = pk2(s[2 * 33], s[3 * 33]); o.z = pk2(s[4 * 33], s[5 * 33]); o.w = pk2(s[6 * 33], s[7 * 33]);
        const int nn = n0 + n; int drow;
        if (MODE == 0) drow = row_off + nn;
        else if (MODE == 3) { int tile, L;
            if (nn < 2560) { tile = nn >> 8; L = nn & 255; } else if (nn < 2624) { tile = 10; L = nn - 2560; } else if (nn < 2640) { tile = 10; L = 64 + (nn - 2624); }
            else if (nn < 4176) { tile = 11 + ((nn - 2640) >> 8); L = (nn - 2640) & 255; } else if (nn < 4240) { tile = 10; L = 128 + (nn - 4176); } else if (nn < 4304) { tile = 10; L = 192 + (nn - 4240); }
            else { tile = 17; L = nn - 4304; }
            drow = 256 * tile + 128 * ((L >> 5) & 1) + 32 * (L >> 6) + (L & 31); }
        else drow = 256 * (nn >> 7) + (nn & 127) + (MODE == 2 ? 128 : 0);
        if (MODE != 3 || nn < N) *(GAS v4u*)(WT + (size_t)drow * K + k0 + 8 * c) = o; }
    LDS_WAIT(); asm volatile("" ::: "memory");
}
__device__ __forceinline__ void p0_weights(const Ctx& C) {
    LAS float* scr = (LAS float*)(C.lds + C.wave * 16384);
    constexpr int I_IN = (D / 64) * 139, I_OUT = (D / 64) * (D / 32), I_G = (D / 64) * (FFN / 32), I_DN = (FFN / 64) * (D / 32);
    constexpr int I_L = RW_W / 32, NITEMS = I_IN + I_OUT + 2 * I_G + I_DN + 4 * I_L;
    bf16* WIN = (bf16*)(C.ws + WS_WIN); bf16* WOUT = (bf16*)(C.ws + WS_WOUT); bf16* WGU = (bf16*)(C.ws + WS_WGU); bf16* WDN = (bf16*)(C.ws + WS_WDN);
    for (int it = C.gw; it < NITEMS; it += C.ngw) {
        int r = it;
        if (r < I_IN) { transpose_item<3>(C.in[14], D, IN_COLS, 139 * 32, WIN, 0, scr, r, C.lane); continue; } r -= I_IN;
        if (r < I_OUT) { transpose_item(C.in[28], D, D, D, WOUT, 0, scr, r, C.lane); continue; } r -= I_OUT;
        if (r < I_G) { transpose_item<1>(C.in[29], D, FFN, FFN, WGU, 0, scr, r, C.lane); continue; } r -= I_G;
        if (r < I_G) { transpose_item<2>(C.in[30], D, FFN, FFN, WGU, 0, scr, r, C.lane); continue; } r -= I_G;
        if (r < I_DN) { transpose_item(C.in[31], FFN, D, D, WDN, 0, scr, r, C.lane); continue; } r -= I_DN;
        if (r < I_L) { transpose_item(C.in[19], 64, RW_W, RW_W, (bf16*)(C.ws + WS_W2T), 0, scr, r, C.lane); continue; } r -= I_L;
        if (r < I_L) { transpose_item(C.in[21], 64, RW_W, RW_W, (bf16*)(C.ws + WS_A2T), 0, scr, r, C.lane); continue; } r -= I_L;
        transpose_item(C.in[22], 128, RW_W, RW_W, (bf16*)(C.ws + WS_G2T), 0, scr, r, C.lane);
    }
    for (int i = C.gw; i < 176; i += C.ngw) { const int L = i < 48 ? 80 + i : 128 + (i - 48), tile = i < 48 ? 10 : 17;
        GAS v4u* rowp = (GAS v4u*)(WIN + (size_t)(256 * tile + 128 * ((L >> 5) & 1) + 32 * (L >> 6) + (L & 31)) * D);
        rowp[C.lane] = (v4u){0u, 0u, 0u, 0u}; rowp[64 + C.lane] = (v4u){0u, 0u, 0u, 0u}; }
}
__device__ __forceinline__ void norm_mod_row(const Ctx& C, int m, const float* xr, const float* g, const float* shift, const float* scale, bf16* orow) {
    const GAS f32x4* xp = (const GAS f32x4*)xr + C.lane;
    f32x4 v[4]; float s = 0.f;
#pragma unroll
    for (int j = 0; j < 4; ++j) { v[j] = xp[64 * j]; s += (v[j].x * v[j].x + v[j].y * v[j].y) + (v[j].z * v[j].z + v[j].w * v[j].w); }
    const float rstd = 1.f / sqrtf(wave_sum(s) * (1.f / D) + RMS_EPS);
    GAS unsigned long long* o8 = (GAS unsigned long long*)orow + C.lane;
#pragma unroll
    for (int j = 0; j < 4; ++j) { const int c = 4 * (C.lane + 64 * j);
        const f32x4 gg = *(const f32x4*)(g + c), sh = *(const f32x4*)(shift + c), sc = *(const f32x4*)(scale + c);
        const f32x4 h = v[j] * rstd * gg * (1.f + sc) + sh;
        o8[64 * j] = (unsigned long long)pk2(h.x, h.y) | ((unsigned long long)pk2(h.z, h.w) << 32); }
}
__device__ __forceinline__ void p1_norm1(const Ctx& C) {
    bf16* A1 = (bf16*)(C.ws + WS_A1); const float* MOD = (const float*)(C.ws + WS_MOD);
    for (int m = C.gw; m < MPAD; m += C.ngw) {
        bf16* orow = A1 + (size_t)m * D;
        if (m >= MT) { GAS unsigned long long* o8 = (GAS unsigned long long*)orow + C.lane;
#pragma unroll
            for (int j = 0; j < 4; ++j) o8[64 * j] = 0ull;
            continue; }
        const float* md = MOD + mod_row(m) * MODW;
        norm_mod_row(C, m, x_row(C, m), C.in[10], md, md + D, orow);
    }
}
__device__ __forceinline__ void p3_post(const Ctx& C) {
    const float* PROJ = (const float*)(C.ws + WS_PROJ); float* QN = (float*)(C.ws + WS_QN);
    const int lane = C.lane;
    const float qg = C.in[15][lane], kg = C.in[16][lane];
    for (int m = C.gw; m < MT; m += C.ngw) {
        const float* p = PROJ + (size_t)m * NIN;
        const bool smp = m >= MP; const int j = m - MP;
        float* ko = C.out + (smp ? OUT_KS + (size_t)j * ATT_W : OUT_KP + (size_t)m * ATT_W);
        float* vo = C.out + (smp ? OUT_VS + (size_t)j * ATT_W : OUT_VP + (size_t)m * ATT_W);
        float* io = C.out + (smp ? OUT_IKS + (size_t)j * IDD : OUT_IKP + (size_t)m * IDD);
        float* qn = QN + (size_t)m * ATT_W;
        bf16* qb = (bf16*)(C.ws + WS_QB) + (size_t)m * ATT_W; bf16* kb = (bf16*)(C.ws + WS_KB) + (size_t)m * ATT_W; bf16* vb = (bf16*)(C.ws + WS_VB) + (size_t)m * ATT_W;
        for (int h = 0; h < AH; ++h) {
            const float q = p[O_Q + h * 64 + lane], k = p[O_K + h * 64 + lane];
            const float sq = wave_sum(q * q), sk = wave_sum(k * k);
            const float qv = q * (1.f / sqrtf(sq * (1.f / 64.f) + RMS_EPS)) * qg, kv = k * (1.f / sqrtf(sk * (1.f / 64.f) + RMS_EPS)) * kg, vv = p[O_V + h * 64 + lane];
            qn[h * 64 + lane] = qv; ko[h * 64 + lane] = kv; vo[h * 64 + lane] = vv;
            qb[h * 64 + lane] = (bf16)f2bf(qv * attn_body::C2); kb[h * 64 + lane] = (bf16)f2bf(kv); vb[h * 64 + lane] = (bf16)f2bf(vv);
        }
        const float ki = p[O_KI + lane];
        const float kin = ki * (1.f / sqrtf(wave_sum(ki * ki) * (1.f / 64.f) + RMS_EPS));
        io[lane] = kin;
        ((bf16*)(C.ws + WS_KIB))[(size_t)m * IDD + lane] = (bf16)f2bf(kin);
        { bf16* qi = (bf16*)(C.ws + WS_QIB) + (size_t)m * QI_LD; float ql = 0.f;
          for (int h = 0; h < IH; ++h) { const float v = p[O_QI + h * 64 + lane]; qi[h * 64 + lane] = (bf16)f2bf(v); ql += p[O_WI + h] * v; }
          qi[IH * 64 + lane] = (bf16)f2bf(ql);
          if (lane < IH) ((float*)(C.ws + WS_WI))[(size_t)m * IH + lane] = p[O_WI + lane]; }
        if (smp || (m & (T - 1)) == T - 1) {
            float* so = C.out + (smp ? OUT_SHS + (size_t)j * RW_COLS : OUT_SHP + (size_t)(m >> 11) * RW_COLS);
            for (int i = 0; i < RW_COLS / 64; ++i) so[i * 64 + lane] = p[O_RW + i * 64 + lane];
        }
    }
}
__device__ __forceinline__ void p3_lin(const Ctx& C) {
    const bf16* PRW = (const bf16*)(C.ws + WS_PRW); const float* mu = C.in[17];
    const int lane = C.lane;
    for (int m = C.gw; m < MP; m += C.ngw) {
        const bf16* p = PRW + (size_t)m * RW_COLS;
        const int t = m & (T - 1);
        float x[4];
#pragma unroll
        for (int i = 0; i < 4; ++i) { const int c = 1536 + 64 * i + lane; const float cur = bf2f(p[c]), prv = t == 0 ? 0.f : bf2f(p[c - RW_COLS]); x[i] = cur + (prv - cur) * mu[c]; }
        bf16* lin = (bf16*)(C.ws + WS_LIN) + (size_t)m * 256;
        lin[lane] = (bf16)f2bf(tanhf(x[0])); lin[64 + lane] = (bf16)f2bf(x[1]); lin[128 + lane] = (bf16)f2bf(sigmoidf_(x[2])); lin[192 + lane] = (bf16)f2bf(sigmoidf_(x[3]));
    }
}
__device__ __forceinline__ void smp_rwkv(const Ctx& C) {
    const bf16* PRW = (const bf16*)(C.ws + WS_PRW); bf16* MIX = (bf16*)(C.ws + WS_MIX);
    const float* mu = C.in[17]; const float* w0 = C.in[18]; const float* w2 = C.in[19]; const float* a0 = C.in[20]; const float* a2 = C.in[21]; const float* g2 = C.in[22];
    const float* k_k = C.in[23]; const float* k_a = C.in[24]; const float* r_k = C.in[25]; const float* ln_w = C.in[26]; const float* ln_b = C.in[27];
    LAS float* lw = (LAS float*)(C.lds + C.wave * 1024);
    const int lane = C.lane;
    for (int wu = C.gw; wu < NSMP * RH; wu += C.ngw) {
        const int j = wu / RH, h = wu % RH, c = h * 64 + lane;
        const bf16* p = PRW + (size_t)(MP + j) * RW_COLS; const float* pv = C.in[6] + (size_t)j * RW_COLS;
#define XM(cc) ({ const int c_ = (cc); const float cur_ = bf2f(p[c_]); cur_ + (pv[c_] - cur_) * mu[c_]; })
        lw[lane] = tanhf(XM(1536 + lane)); lw[64 + lane] = XM(1600 + lane); lw[128 + lane] = sigmoidf_(XM(1664 + lane)); lw[192 + lane] = sigmoidf_(XM(1728 + lane));
        LDS_WAIT(); asm volatile("" ::: "memory");
        float aw = w0[c], aa = a0[c], ag = 0.f;
#pragma unroll 8
        for (int jj = 0; jj < 64; ++jj) { aw += lw[jj] * w2[jj * RW_W + c]; aa += lw[64 + jj] * a2[jj * RW_W + c]; }
#pragma unroll 8
        for (int jj = 0; jj < 128; ++jj) ag += lw[128 + jj] * g2[jj * RW_W + c];
        const float w = expf(-0.6065306597126334f * sigmoidf_(aw)), a = sigmoidf_(aa);
        const float r = XM(c), k = XM(512 + c), v = XM(1024 + c);
#undef XM
        float kk = k * k_k[c]; kk *= 1.f / sqrtf(fmaxf(wave_sum(kk * kk), 1e-24f));
        const float kp = k * (1.f + (a - 1.f) * k_a[c]), bb = kk * a;
        float S[64];
        { const f32x4* sp = (const f32x4*)(C.in[5] + (((size_t)j * RH + h) * RN + lane) * RN);
#pragma unroll
          for (int i = 0; i < 16; ++i) { const f32x4 q4 = sp[i]; S[4 * i] = q4.x; S[4 * i + 1] = q4.y; S[4 * i + 2] = q4.z; S[4 * i + 3] = q4.w; } }
        float sa0 = 0.f, sa1 = 0.f;
#pragma unroll
        for (int jx = 0; jx < 64; jx += 2) { sa0 += S[jx] * rdlane(kk, jx); sa1 += S[jx + 1] * rdlane(kk, jx + 1); }
        const float sa = -(sa0 + sa1);
        float y0 = 0.f, y1 = 0.f;
#pragma unroll
        for (int jx = 0; jx < 64; jx += 2) {
            S[jx] = S[jx] * rdlane(w, jx) + sa * rdlane(bb, jx) + v * rdlane(kp, jx); y0 += S[jx] * rdlane(r, jx);
            S[jx + 1] = S[jx + 1] * rdlane(w, jx + 1) + sa * rdlane(bb, jx + 1) + v * rdlane(kp, jx + 1); y1 += S[jx + 1] * rdlane(r, jx + 1); }
        const float y = y0 + y1;
        f32x4* so = (f32x4*)(C.out + OUT_WKVS + (((size_t)j * RH + h) * RN + lane) * RN);
#pragma unroll
        for (int i = 0; i < 16; ++i) so[i] = (f32x4){S[4 * i], S[4 * i + 1], S[4 * i + 2], S[4 * i + 3]};
        const float mean = wave_sum(y) * (1.f / 64.f), dy = y - mean, var = wave_sum(dy * dy) * (1.f / 64.f);
        const float yn = dy * (1.f / sqrtf(var + GN_EPS)) * ln_w[c] + ln_b[c];
        const float bonus = wave_sum(r * kp * r_k[c]) * v;
        MIX[(size_t)(MP + j) * D + ATT_W + c] = (bf16)f2bf((yn + bonus) * ag);
        LDS_WAIT(); asm volatile("" ::: "memory");
    }
}
namespace idxsel {
typedef short bf16x8 __attribute__((ext_vector_type(8)));
typedef float f32x16 __attribute__((ext_vector_type(16)));
constexpr int QT_BYTES = 17 * 32 * 128, WT_OFF = QT_BYTES, CNT_OFF = WT_OFF + 32 * 17 * 4;
__device__ __forceinline__ int crow(int r, int hi) { return (r & 3) + 8 * (r >> 2) + 4 * hi; }
__device__ __forceinline__ void unit(const Ctx& C, int b, int qg) {
    const int lane = C.lane, r32 = lane & 31, hi = lane >> 5, wave = C.wave;
    LAS unsigned char* lds = C.lds;
    const bf16* QIb = (const bf16*)(C.ws + WS_QIB); const bf16* KIb = (const bf16*)(C.ws + WS_KIB); const float* WIr = (const float*)(C.ws + WS_WI);
    unsigned long long* MASKT = (unsigned long long*)(C.ws + WS_MASKT);
    LAS float* WT = (LAS float*)(lds + WT_OFF); LAS int* CNT = (LAS int*)(lds + CNT_OFF);
    const size_t row0 = (size_t)b * T + 32 * qg;
    __syncthreads();
    for (int i = C.tid; i < 32 * 128; i += NTHREADS) { const int q = i >> 7, hc = i & 127, h = hc >> 3, c = hc & 7;
        const v4u v = *(const v4u*)(QIb + (row0 + q) * QI_LD + hc * 8);
        *(LAS v4u*)(lds + ((h * 32 + q) * 8 + (c ^ (q & 7))) * 16) = v; }
    { const int q = C.tid >> 4, h = C.tid & 15; WT[q * 17 + h] = WIr[(row0 + q) * IH + h]; }
    __syncthreads();
    if (C.tid < 256) {
        const int q = C.tid >> 3, c = C.tid & 7; float a8[8];
#pragma unroll
        for (int e = 0; e < 8; ++e) a8[e] = 0.f;
        for (int h = 0; h < 16; ++h) { const v4u v = *(const LAS v4u*)(lds + ((h * 32 + q) * 8 + (c ^ (q & 7))) * 16); const float w = WT[q * 17 + h];
            a8[0] += w * __builtin_bit_cast(float, v.x << 16); a8[1] += w * __builtin_bit_cast(float, v.x & 0xffff0000u); a8[2] += w * __builtin_bit_cast(float, v.y << 16); a8[3] += w * __builtin_bit_cast(float, v.y & 0xffff0000u);
            a8[4] += w * __builtin_bit_cast(float, v.z << 16); a8[5] += w * __builtin_bit_cast(float, v.z & 0xffff0000u); a8[6] += w * __builtin_bit_cast(float, v.w << 16); a8[7] += w * __builtin_bit_cast(float, v.w & 0xffff0000u); }
        v4u o; o.x = pk2(a8[0], a8[1]); o.y = pk2(a8[2], a8[3]); o.z = pk2(a8[4], a8[5]); o.w = pk2(a8[6], a8[7]);
        *(LAS v4u*)(lds + ((16 * 32 + q) * 8 + (c ^ (q & 7))) * 16) = o; }
    __syncthreads();
    f32x16 sc[8];
#pragma unroll
    for (int j = 0; j < 8; ++j) sc[j] = f32x16{};
    bf16x8 ka[4];
    { const int kc = wave <= qg ? wave : qg; const bf16* kp0 = KIb + ((size_t)b * T + kc * 32 + r32) * IDD + 8 * hi;
#pragma unroll
      for (int s4 = 0; s4 < 4; ++s4) ka[s4] = *(const bf16x8*)(kp0 + 16 * s4); }
#pragma unroll
    for (int j = 0; j < 8; ++j) {
        const int kt0 = wave + 8 * j;
        asm volatile("" ::: "memory");
        if (kt0 <= qg) {
            bf16x8 kn[4];
            { const int kc = kt0 + 8 <= qg ? kt0 + 8 : qg; const bf16* kp1 = KIb + ((size_t)b * T + kc * 32 + r32) * IDD + 8 * hi;
#pragma unroll
              for (int s4 = 0; s4 < 4; ++s4) kn[s4] = *(const bf16x8*)(kp1 + 16 * s4); }
            bf16x8 qf[4];
#pragma unroll
            for (int s4 = 0; s4 < 4; ++s4) qf[s4] = *(const LAS bf16x8*)(lds + ((0 * 32 + r32) * 8 + ((2 * s4 + hi) ^ (r32 & 7))) * 16);
#pragma unroll 1
            for (int h = 0; h < 17; ++h) {
                bf16x8 qn[4];
                const int hn = h < 16 ? h + 1 : 16;
#pragma unroll
                for (int s4 = 0; s4 < 4; ++s4) qn[s4] = *(const LAS bf16x8*)(lds + ((hn * 32 + r32) * 8 + ((2 * s4 + hi) ^ (r32 & 7))) * 16);
                const float w = WT[r32 * 17 + h];
                f32x16 xa = f32x16{};
#pragma unroll
                for (int s4 = 0; s4 < 4; ++s4) xa = __builtin_amdgcn_mfma_f32_32x32x16_bf16(ka[s4], qf[s4], xa, 0, 0, 0);
                if (h < 16) {
#pragma unroll
                    for (int r = 0; r < 16; ++r) sc[j][r] = __builtin_fmaf(__builtin_fabsf(xa[r]), w, sc[j][r]); }
                else {
#pragma unroll
                    for (int r = 0; r < 16; ++r) sc[j][r] += xa[r]; }
#pragma unroll
                for (int s4 = 0; s4 < 4; ++s4) qf[s4] = qn[s4];
            }
#pragma unroll
            for (int s4 = 0; s4 < 4; ++s4) ka[s4] = kn[s4];
        }
    }
    unsigned key[8][16];
#pragma unroll
    for (int j = 0; j < 8; ++j) { const int kt = wave + 8 * j;
#pragma unroll
        for (int r = 0; r < 16; ++r) { const bool valid = (kt < qg) || (kt == qg && crow(r, hi) <= r32); key[j][r] = valid ? sortable(sc[j][r]) : 0u; } }
    unsigned Tk = 1u;
    if (qg >= 8) {
        Tk = 0u; int buf = 0; bool exact = false;
        for (int bit = 31; bit >= 0; --bit) {
            const unsigned cand = Tk | (1u << bit); int c = 0;
#pragma unroll
            for (int j = 0; j < 8; ++j) if (wave + 8 * j <= qg) {
#pragma unroll
                for (int r = 0; r < 16; ++r) c += (key[j][r] >= cand) ? 1 : 0; }
            c += __shfl_xor(c, 32);
            if (hi == 0) CNT[(buf * 8 + wave) * 32 + r32] = c;
            __syncthreads();
            int tot = 0;
#pragma unroll
            for (int w = 0; w < 8; ++w) tot += CNT[(buf * 8 + w) * 32 + r32];
            if (tot >= TOPK) { Tk = cand; exact = (tot == TOPK); }
            buf ^= 1;
            if (__all(exact)) break;
        }
    }
#pragma unroll
    for (int j = 0; j < 8; ++j) { const int kt = wave + 8 * j; unsigned long long mine = 0ull;
#pragma unroll
        for (int r = 0; r < 16; ++r) { const unsigned long long W = __ballot(key[j][r] >= Tk); if (lane == r) mine = W; }
        if (lane < 16) MASKT[(((size_t)(b * 64 + qg) * 32 + (kt >> 1)) * 32) + (kt & 1) * 16 + lane] = mine; }
}
__device__ __forceinline__ void phase(const Ctx& C) {
    const int v = (int)((blockIdx.x % 8) * (C.G / 8) + blockIdx.x / 8);
    for (int vv = v; vv < NB * 32; vv += C.G) { const int b = vv >> 5, i = vv & 31; unit(C, b, 63 - i); unit(C, b, i); }
    __syncthreads();
}
}
__device__ __forceinline__ float idx_score(const float (&kr)[64], const LAS float* ql, const LAS float* wl) {
    float score = 0.f;
    for (int h = 0; h < IH; ++h) {
        float d = 0.f;
#pragma unroll
        for (int dd = 0; dd < 64; dd += 4) { const f32x4 qv = *(const LAS f32x4*)(ql + h * 64 + dd); d += qv.x * kr[dd] + qv.y * kr[dd + 1] + qv.z * kr[dd + 2] + qv.w * kr[dd + 3]; }
        score += wl[h] * fmaxf(d, 0.f);
    }
    return score;
}
template <bool PROMPT, bool SAMPLE> __device__ __forceinline__ void p4_indexer(const Ctx& C) {
    const float* PROJ = (const float*)(C.ws + WS_PROJ); float* SC = (float*)(C.ws + WS_SC); float* SCS = (float*)(C.ws + WS_SCS);
    LAS float* ql = (LAS float*)C.lds;
    LAS float* wl = ql + 16 * 1024;
    const int lane = C.lane;
    if (PROMPT) for (int u = blockIdx.x; u < NB * 128 * 4; u += C.G) {
        const int b = u >> 9, tq = (u >> 2) & 127, scn = u & 3, t0 = tq * 16;
        if (scn * 512 > t0 + 15) continue;
        __syncthreads();
        for (int i = C.tid; i < 16 * 1024; i += NTHREADS) { const int q = i >> 10, e = i & 1023; ql[i] = PROJ[(size_t)(b * T + t0 + q) * NIN + O_QI + e]; }
        if (C.tid < 256) { const int q = C.tid >> 4, h = C.tid & 15; wl[C.tid] = PROJ[(size_t)(b * T + t0 + q) * NIN + O_WI + h] * IDX_W_SCALE; }
        __syncthreads();
        const int s = scn * 512 + C.wave * 64 + lane;
        if (scn * 512 + C.wave * 64 <= t0 + 15) {
            float kr[64];
            const f32x4* kp = (const f32x4*)(C.out + OUT_IKP + (size_t)(b * T + s) * IDD);
#pragma unroll
            for (int i = 0; i < 16; ++i) { const f32x4 v = kp[i]; kr[4 * i] = v.x; kr[4 * i + 1] = v.y; kr[4 * i + 2] = v.z; kr[4 * i + 3] = v.w; }
            for (int q = 0; q < 16; ++q) {
                const float score = idx_score(kr, ql + q * 1024, wl + q * 16);
                const int t = t0 + q;
                if (s <= t) SC[((size_t)b * T + t) * T + s] = score;
            }
        }
    }
    __syncthreads();
    const int* pt = (const int*)C.in[7];
    LAS float* qw = (LAS float*)(C.lds + C.wave * 8192); LAS float* ww = qw + 1024;
    if (SAMPLE) for (int wu = C.gw; wu < NSMP * 129; wu += C.ngw) {
        const int j = wu / 129, kb = wu % 129;
        const bf16* pq = (const bf16*)(C.ws + WS_QIB) + (size_t)(MP + j) * QI_LD;
        for (int i = 0; i < 16; ++i) qw[i * 64 + lane] = __builtin_bit_cast(float, (unsigned)pq[i * 64 + lane] << 16);
        if (lane < 16) ww[lane] = ((const float*)(C.ws + WS_WI))[(size_t)(MP + j) * IH + lane] * IDX_W_SCALE;
        LDS_WAIT(); asm volatile("" ::: "memory");
        const int s = kb * 64 + lane;
        const float* krow = nullptr;
        if (s < PAST) krow = C.in[4] + ((size_t)pt[j * NPAGES + (s >> 7)] * PAGE + (s & 127)) * IDD;
        else if (s == PAST) krow = C.out + OUT_IKS + (size_t)j * IDD;
        float score = -INFINITY;
        if (krow) { float kr[64]; const f32x4* kp = (const f32x4*)krow;
#pragma unroll
            for (int i = 0; i < 16; ++i) { const f32x4 v = kp[i]; kr[4 * i] = v.x; kr[4 * i + 1] = v.y; kr[4 * i + 2] = v.z; kr[4 * i + 3] = v.w; }
            score = idx_score(kr, qw, ww); }
        SCS[(size_t)j * SCS_LD + s] = score;
        LDS_WAIT(); asm volatile("" ::: "memory");
    }
}
template <bool PROBE> __device__ __forceinline__ void p4_scan(const Ctx& C, int u_begin) {
    const float* Rr = (const float*)(C.ws + WS_RWA), *Wd = (const float*)(C.ws + WS_RWA + RWA_STRIDE), *Kp = (const float*)(C.ws + WS_RWA + 2 * RWA_STRIDE), *Vv = (const float*)(C.ws + WS_RWA + 3 * RWA_STRIDE),
          *KK = (const float*)(C.ws + WS_RWA + 4 * RWA_STRIDE), *Bb = (const float*)(C.ws + WS_RWA + 5 * RWA_STRIDE);
    float* Y = (float*)(C.ws + (PROBE ? WS_Y2 : WS_Y));
    const int lane = C.lane;
    for (int u = u_begin + C.gw; u < (PROBE ? NB * RH : NB * RH + NSMP * RH); u += C.ngw) {
        const bool smp = u >= NB * RH; const int seq = smp ? (u - NB * RH) / RH : u / RH, h = u % RH;
        const int nsteps = smp ? 1 : T; const size_t base = smp ? (size_t)(MP + seq) : (size_t)seq * T;
        float S[64];
        if (smp) { const f32x4* sp = (const f32x4*)(C.in[5] + (((size_t)seq * RH + h) * RN + lane) * RN);
#pragma unroll
            for (int i = 0; i < 16; ++i) { const f32x4 v = sp[i]; S[4 * i] = v.x; S[4 * i + 1] = v.y; S[4 * i + 2] = v.z; S[4 * i + 3] = v.w; } }
        else {
#pragma unroll
            for (int i = 0; i < 64; ++i) S[i] = 0.f; }
        size_t o = base * RW_W + h * 64 + lane;
        float r = Rr[o], w = Wd[o], k = Kp[o], v = Vv[o], kk = KK[o], bb = Bb[o];
        for (int t = 0; t < nsteps; ++t) {
            float rn = 0.f, wn = 0.f, kn = 0.f, vn = 0.f, kkn = 0.f, bbn = 0.f;
            const size_t on = o + RW_W;
            if (t + 1 < nsteps) { rn = Rr[on]; wn = Wd[on]; kn = Kp[on]; vn = Vv[on]; kkn = KK[on]; bbn = Bb[on]; }
            float sa0 = 0.f, sa1 = 0.f;
#pragma unroll
            for (int jx = 0; jx < 64; jx += 2) { sa0 += S[jx] * rdlane(kk, jx); sa1 += S[jx + 1] * rdlane(kk, jx + 1); }
            const float sa = -(sa0 + sa1);
            float y0 = 0.f, y1 = 0.f;
#pragma unroll
            for (int jx = 0; jx < 64; jx += 2) {
                S[jx] = S[jx] * rdlane(w, jx) + sa * rdlane(bb, jx) + v * rdlane(k, jx); y0 += S[jx] * rdlane(r, jx);
                S[jx + 1] = S[jx + 1] * rdlane(w, jx + 1) + sa * rdlane(bb, jx + 1) + v * rdlane(k, jx + 1); y1 += S[jx + 1] * rdlane(r, jx + 1); }
            Y[o] = y0 + y1;
            o = on; r = rn; w = wn; k = kn; v = vn; kk = kkn; bb = bbn;
        }
        f32x4* so = (f32x4*)(C.out + (smp ? OUT_WKVS : OUT_WKVP) + (((size_t)seq * RH + h) * RN + lane) * RN);
        if (!PROBE)
#pragma unroll
        for (int i = 0; i < 16; ++i) so[i] = (f32x4){S[4 * i], S[4 * i + 1], S[4 * i + 2], S[4 * i + 3]};
    }
}
template <bool PROMPT, bool SAMPLE> __device__ __forceinline__ void p5_select(const Ctx& C) {
    const float* SC = (const float*)(C.ws + WS_SC); unsigned* MASK = (unsigned*)(C.ws + WS_MASK);
    const int lane = C.lane;
    if (PROMPT) for (int row = C.gw; row < MP; row += C.ngw) {
        const int t = row & (T - 1); const float* sp = SC + (size_t)row * T;
        unsigned key[32];
#pragma unroll
        for (int j = 0; j < 32; ++j) { const int s = 64 * j + lane; key[j] = (s <= t) ? sortable(sp[s]) : 0u; }
        unsigned Tk = 0u; int need = 0;
        const bool all = (t + 1 <= TOPK);
        if (!all) {
            for (int bit = 31; bit >= 0; --bit) { const unsigned cand = Tk | (1u << bit); int cnt = 0;
#pragma unroll
                for (int j = 0; j < 32; ++j) cnt += __builtin_popcountll(__ballot(key[j] >= cand));
                if (cnt >= TOPK) Tk = cand; }
            int cgt = 0;
#pragma unroll
            for (int j = 0; j < 32; ++j) cgt += __builtin_popcountll(__ballot(key[j] > Tk));
            need = TOPK - cgt;
        }
        int running = 0;
#pragma unroll
        for (int j = 0; j < 32; ++j) {
            const int s = 64 * j + lane; bool take;
            if (all) take = (s <= t);
            else { const bool gt = key[j] > Tk, eq = key[j] == Tk; const unsigned long long eqb = __ballot(eq);
                const int pre = __builtin_popcountll(eqb & lanemask_lt(lane)); take = gt || (eq && (running + pre < need)); running += __builtin_popcountll(eqb); }
            const unsigned long long mb = __ballot(take);
            if (lane == 0) { MASK[(size_t)row * 64 + 2 * j] = (unsigned)mb; MASK[(size_t)row * 64 + 2 * j + 1] = (unsigned)(mb >> 32); }
        }
    }
    const float* SCS = (const float*)(C.ws + WS_SCS); int* SLIST = (int*)(C.ws + WS_SLIST);
    LAS int* sh = (LAS int*)C.lds;
    if (SAMPLE) for (int j = (int)blockIdx.x - 128; j >= 0 && j < NSMP; j += C.G) {
        unsigned key[17];
#pragma unroll
        for (int i = 0; i < 17; ++i) { const int s = i * NTHREADS + C.tid; key[i] = (s < LS) ? sortable(SCS[(size_t)j * SCS_LD + s]) : 0u; }
        unsigned Tk = 0u;
        for (int bit = 31; bit >= 0; --bit) { const unsigned cand = Tk | (1u << bit); int c = 0;
#pragma unroll
            for (int i = 0; i < 17; ++i) c += (key[i] >= cand) ? 1 : 0;
            c = wave_sum_i(c);
            __syncthreads(); if (lane == 0) sh[C.wave] = c; __syncthreads();
            int cnt = 0;
#pragma unroll
            for (int w = 0; w < 8; ++w) cnt += sh[w];
            if (cnt >= TOPK) Tk = cand; }
        int cg = 0;
#pragma unroll
        for (int i = 0; i < 17; ++i) cg += (key[i] > Tk) ? 1 : 0;
        cg = wave_sum_i(cg);
        __syncthreads(); if (lane == 0) sh[C.wave] = cg; __syncthreads();
        int cgt = 0;
#pragma unroll
        for (int w = 0; w < 8; ++w) cgt += sh[w];
        const int need = TOPK - cgt;
        int run_eq = 0, run_sel = 0;
#pragma unroll
        for (int i = 0; i < 17; ++i) {
            const int s = i * NTHREADS + C.tid; const bool gt = key[i] > Tk, eq = key[i] == Tk;
            const unsigned long long eqb = __ballot(eq);
            __syncthreads(); if (lane == 0) sh[C.wave] = __builtin_popcountll(eqb); __syncthreads();
            int eq_before = 0, eq_tot = 0;
#pragma unroll
            for (int w = 0; w < 8; ++w) { const int x = sh[w]; eq_tot += x; if (w < C.wave) eq_before += x; }
            const bool take = gt || (eq && (run_eq + eq_before + __builtin_popcountll(eqb & lanemask_lt(lane)) < need));
            const unsigned long long tb = __ballot(take);
            __syncthreads(); if (lane == 0) sh[8 + C.wave] = __builtin_popcountll(tb); __syncthreads();
            int s_before = 0, s_tot = 0;
#pragma unroll
            for (int w = 0; w < 8; ++w) { const int x = sh[8 + w]; s_tot += x; if (w < C.wave) s_before += x; }
            const int pos = run_sel + s_before + __builtin_popcountll(tb & lanemask_lt(lane));
            if (take && pos < TOPK) SLIST[j * TOPK + pos] = s;
            run_eq += eq_tot; run_sel += s_tot;
        }
    }
    __syncthreads();
}
template <int DIFFK> __device__ __forceinline__ void p5_rwfinal(const Ctx& C, int m_begin) {
    const float* Rr = (const float*)(C.ws + WS_RWA), *Kp = (const float*)(C.ws + WS_RWA + 2 * RWA_STRIDE), *Vv = (const float*)(C.ws + WS_RWA + 3 * RWA_STRIDE), *Gg = (const float*)(C.ws + WS_RWA + 6 * RWA_STRIDE);
    const float* Y = (const float*)(C.ws + WS_Y); bf16* MIX = (bf16*)(C.ws + WS_MIX);
    const float* r_k = C.in[25]; const float* ln_w = C.in[26]; const float* ln_b = C.in[27];
    const int lane = C.lane;
    for (int m = m_begin + C.gw; m < MT; m += C.ngw) {
        for (int h = 0; h < RH; ++h) {
            const int c = h * 64 + lane; const size_t o = (size_t)m * RW_W + c;
            float y = Y[o];
            if (DIFFK != 0 && m < MP) y += (float)DIFFK * (y - ((const float*)(C.ws + WS_Y2))[o]);
            const float mu = wave_sum(y) * (1.f / 64.f); const float dy = y - mu; const float var = wave_sum(dy * dy) * (1.f / 64.f);
            const float yn = dy * (1.f / sqrtf(var + GN_EPS)) * ln_w[c] + ln_b[c];
            const float bonus = wave_sum(Rr[o] * Kp[o] * r_k[c]) * Vv[o];
            MIX[(size_t)m * D + ATT_W + c] = (bf16)f2bf((yn + bonus) * Gg[o]);
        }
    }
}
__device__ __forceinline__ void p6_masktr(const Ctx& C) {
    const unsigned* MASK = (const unsigned*)(C.ws + WS_MASK); unsigned long long* MASKT = (unsigned long long*)(C.ws + WS_MASKT);
    const int lane = C.lane, q = lane & 31, hi = lane >> 5;
    for (int wu = C.gw; wu < NB * 64 * 32; wu += C.ngw) {
        const int j = wu & 31, qg = (wu >> 5) & 63, b = wu >> 11;
        const size_t row = (size_t)b * T + 32 * qg + q;
        const unsigned w0 = MASK[row * 64 + 2 * j], w1 = MASK[row * 64 + 2 * j + 1];
        unsigned long long mine = 0ull;
#pragma unroll
        for (int r = 0; r < 16; ++r) { const int c = (r & 3) + 8 * (r >> 2) + 4 * hi;
            const unsigned long long W0 = __ballot((w0 >> c) & 1u), W1 = __ballot((w1 >> c) & 1u);
            if (lane == r) mine = W0; if (lane == 16 + r) mine = W1; }
        if (lane < 32) MASKT[((size_t)((b * 64 + qg) * 32 + j)) * 32 + lane] = mine;
    }
}
__device__ __forceinline__ void smp_attn(const Ctx& C) {
    const int* SLIST = (const int*)(C.ws + WS_SLIST); const float* QN = (const float*)(C.ws + WS_QN); bf16* MIX = (bf16*)(C.ws + WS_MIX); const int* pt = (const int*)C.in[7];
    LAS int* prow = (LAS int*)C.lds;
    LAS float* pb = (LAS float*)(C.lds + 1024);
    const int lane = C.lane, h = C.wave;
    for (int j = blockIdx.x; j < NSMP; j += C.G) {
        __syncthreads();
        if (C.tid < TOPK) { const int s = SLIST[j * TOPK + C.tid]; prow[C.tid] = (s < PAST) ? pt[j * NPAGES + (s >> 7)] * PAGE + (s & 127) : -1; }
        __syncthreads();
        const float* kn = C.out + OUT_KS + (size_t)j * ATT_W + h * 64; const float* vn = C.out + OUT_VS + (size_t)j * ATT_W + h * 64;
        float q[64];
        { const f32x4* qp = (const f32x4*)(QN + (size_t)(MP + j) * ATT_W + h * 64);
#pragma unroll
          for (int i = 0; i < 16; ++i) { const f32x4 v = qp[i]; q[4 * i] = v.x; q[4 * i + 1] = v.y; q[4 * i + 2] = v.z; q[4 * i + 3] = v.w; } }
        float sc[4]; float mx = -INFINITY;
#pragma unroll
        for (int i = 0; i < 4; ++i) { const int pr = prow[i * 64 + lane]; const float* kp = pr >= 0 ? C.in[2] + (size_t)pr * ATT_W + h * 64 : kn;
            float d = 0.f;
#pragma unroll
            for (int e = 0; e < 16; ++e) { const f32x4 kv = ((const f32x4*)kp)[e]; d += q[4 * e] * kv.x + q[4 * e + 1] * kv.y + q[4 * e + 2] * kv.z + q[4 * e + 3] * kv.w; }
            sc[i] = d * 0.125f; mx = fmaxf(mx, sc[i]); }
        mx = wave_max(mx); float l = 0.f;
#pragma unroll
        for (int i = 0; i < 4; ++i) { const float p = expf(sc[i] - mx); pb[h * 256 + i * 64 + lane] = p; l += p; }
        l = wave_sum(l);
        LDS_WAIT(); asm volatile("" ::: "memory");
        float o = 0.f;
        for (int kx = 0; kx < TOPK; kx += 32) { float vv[32];
#pragma unroll
            for (int e = 0; e < 32; ++e) { const int pr = prow[kx + e]; vv[e] = (pr >= 0 ? C.in[3] + (size_t)pr * ATT_W + h * 64 : vn)[lane]; }
#pragma unroll
            for (int e = 0; e < 32; ++e) o += pb[h * 256 + kx + e] * vv[e]; }
        MIX[(size_t)(MP + j) * D + h * 64 + lane] = (bf16)f2bf(o / l);
    }
    __syncthreads();
}
template <int DIFFK> __device__ __forceinline__ void p6_attn(const Ctx& C, int u_begin, int u_end) {
    const unsigned* MASK = (const unsigned*)(C.ws + WS_MASK); const int* SLIST = (const int*)(C.ws + WS_SLIST); const float* QN = (const float*)(C.ws + WS_QN);
    bf16* MIX = (bf16*)(C.ws + WS_MIX); const int* pt = (const int*)C.in[7];
    LAS int* list = (LAS int*)C.lds;
    LAS float* pb = (LAS float*)(C.lds + 1024);
    LAS int* cntp = (LAS int*)(C.lds + 1024 + 8192);
    const int lane = C.lane, h = C.wave;
    for (int u = u_begin + blockIdx.x; u < u_end; u += C.G) {
        const bool smp = u >= MP; const int j = u - MP, b = u >> 11;
        __syncthreads();
        if (C.wave == 0) {
            if (!smp) { const unsigned w = MASK[(size_t)u * 64 + lane]; const int c = __builtin_popcount(w);
                int incl = c;
#pragma unroll
                for (int o = 1; o < 64; o <<= 1) { const int x = __shfl_up(incl, o); if (lane >= o) incl += x; }
                int pos = incl - c; unsigned ww = w;
                while (ww) { const int bit = __builtin_ctz(ww); ww &= ww - 1u; list[pos++] = 32 * lane + bit; }
                if (lane == 63) *cntp = incl; }
            else { for (int i = 0; i < 4; ++i) list[i * 64 + lane] = SLIST[j * TOPK + i * 64 + lane]; if (lane == 0) *cntp = TOPK; }
        }
        __syncthreads();
        int cnt = *cntp; if (cnt > TOPK) cnt = TOPK;
        float q[64];
        { const f32x4* qp = (const f32x4*)(QN + (size_t)u * ATT_W + h * 64);
#pragma unroll
          for (int i = 0; i < 16; ++i) { const f32x4 v = qp[i]; q[4 * i] = v.x; q[4 * i + 1] = v.y; q[4 * i + 2] = v.z; q[4 * i + 3] = v.w; } }
        float sc[4]; float mx = -INFINITY;
#pragma unroll
        for (int i = 0; i < 4; ++i) { const int idx = i * 64 + lane; sc[i] = -INFINITY;
            if (idx < cnt) { const int s = list[idx]; const float* kp;
                if (!smp) kp = C.out + OUT_KP + ((size_t)(b * T + s)) * ATT_W + h * 64;
                else if (s < PAST) kp = C.in[2] + ((size_t)pt[j * NPAGES + (s >> 7)] * PAGE + (s & 127)) * ATT_W + h * 64;
                else kp = C.out + OUT_KS + (size_t)j * ATT_W + h * 64;
                float d = 0.f;
#pragma unroll
                for (int e = 0; e < 16; ++e) { const f32x4 kv = ((const f32x4*)kp)[e]; d += q[4 * e] * kv.x + q[4 * e + 1] * kv.y + q[4 * e + 2] * kv.z + q[4 * e + 3] * kv.w; }
                sc[i] = d * 0.125f; }
            mx = fmaxf(mx, sc[i]); }
        mx = wave_max(mx); float l = 0.f;
#pragma unroll
        for (int i = 0; i < 4; ++i) { const int idx = i * 64 + lane; const float p = (idx < cnt) ? expf(sc[i] - mx) : 0.f; pb[h * 256 + idx] = p; l += p; }
        l = wave_sum(l);
        LDS_WAIT(); asm volatile("" ::: "memory");
        float o = 0.f;
        for (int kx = 0; kx < cnt; ++kx) { const int s = list[kx]; const float* vp;
            if (!smp) vp = C.out + OUT_VP + ((size_t)(b * T + s)) * ATT_W + h * 64;
            else if (s < PAST) vp = C.in[3] + ((size_t)pt[j * NPAGES + (s >> 7)] * PAGE + (s & 127)) * ATT_W + h * 64;
            else vp = C.out + OUT_VS + (size_t)j * ATT_W + h * 64;
            o += pb[h * 256 + kx] * vp[lane]; }
        if (DIFFK == 0) MIX[(size_t)u * D + h * 64 + lane] = (bf16)f2bf(o / l);
        else { const float a = __builtin_bit_cast(float, (unsigned)MIX[(size_t)u * D + h * 64 + lane] << 16); MIX[(size_t)u * D + h * 64 + lane] = (bf16)f2bf(a + (float)DIFFK * (a - o / l)); }
    }
    __syncthreads();
}
__device__ __forceinline__ void p8_res_norm2(const Ctx& C) {
    const float* X1 = (const float*)(C.ws + WS_X1); bf16* A2 = (bf16*)(C.ws + WS_A2); const float* MOD = (const float*)(C.ws + WS_MOD);
    for (int m = C.gw; m < MPAD; m += C.ngw) {
        bf16* orow = A2 + (size_t)m * D;
        if (m >= MT) { GAS unsigned long long* o8 = (GAS unsigned long long*)orow + C.lane;
#pragma unroll
            for (int j = 0; j < 4; ++j) o8[64 * j] = 0ull;
            continue; }
        const float* md = MOD + mod_row(m) * MODW;
        norm_mod_row(C, m, X1 + (size_t)m * D, C.in[11], md + 3 * D, md + 4 * D, orow);
    }
}
__device__ __forceinline__ void p10_swiglu(const Ctx& C) {
    const float* RAW2 = (const float*)(C.ws + WS_RAW2); bf16* HB = (bf16*)(C.ws + WS_HB);
    const size_t total = (size_t)MPAD * (FFN / 4);
    for (size_t i = (size_t)blockIdx.x * NTHREADS + C.tid; i < total; i += (size_t)C.G * NTHREADS) {
        const size_t m = i / (FFN / 4); const int c = (int)(i % (FFN / 4)) * 4;
        const f32x4 g = *(const f32x4*)(RAW2 + m * NGU + c), u = *(const f32x4*)(RAW2 + m * NGU + FFN + c);
        const float h0 = g.x / (1.f + expf(-g.x)) * u.x, h1 = g.y / (1.f + expf(-g.y)) * u.y, h2 = g.z / (1.f + expf(-g.z)) * u.z, h3 = g.w / (1.f + expf(-g.w)) * u.w;
        *(unsigned long long*)(HB + m * FFN + c) = (unsigned long long)pk2(h0, h1) | ((unsigned long long)pk2(h2, h3) << 32);
    }
}
__device__ __forceinline__ void p12_final(const Ctx& C) {
    const float* RAW = (const float*)(C.ws + WS_RAW); const float* X1 = (const float*)(C.ws + WS_X1); const float* MOD = (const float*)(C.ws + WS_MOD);
    for (int m = C.gw; m < MT; m += C.ngw) {
        const float* md = MOD + mod_row(m) * MODW;
        float* yo = C.out + (m < MP ? OUT_Y + (size_t)m * D : OUT_YS + (size_t)(m - MP) * D);
#pragma unroll
        for (int j = 0; j < 4; ++j) { const int c = 4 * (C.lane + 64 * j);
            const f32x4 xv = *(const f32x4*)(X1 + (size_t)m * D + c), rv = *(const f32x4*)(RAW + (size_t)m * D + c), g2 = *(const f32x4*)(md + 5 * D + c);
            *(f32x4*)(yo + c) = xv + g2 * rv; }
    }
}

namespace rw {
typedef short bf16x8 __attribute__((ext_vector_type(8)));
typedef short s16x4 __attribute__((ext_vector_type(4)));
typedef float f32x16 __attribute__((ext_vector_type(16)));
typedef float f32x4v __attribute__((ext_vector_type(4)));
typedef unsigned u32x2 __attribute__((ext_vector_type(2)));
typedef unsigned u32x4v __attribute__((ext_vector_type(4)));
constexpr int NCH = T / 64;
constexpr int IMG = 16384;
constexpr int A32_OFF = 7 * IMG, WC_OFF = A32_OFF + 16384, RED_OFF = WC_OFF + 256;
enum { H_AT = 0, H_BT = 1, H_KT = 2, H_RT = 3, H_VT = 4, H_AAK = 5, H_ARB = 6, H_ARK = 7, H_XT = 8, H_TT = 9, H_QT = 10, H_PT = 11, H_N1 = 12, H_N2 = 13 };
__device__ __forceinline__ unsigned off_b(unsigned row, unsigned ch) { return 256u * row + 16u * (ch ^ (((row & 3) << 2) | ((row >> 2) & 3))); }
__device__ __forceinline__ int crow(int r, int hi) { return (r & 3) + 8 * (r >> 2) + 4 * hi; }
__device__ __forceinline__ unsigned cvt2(float lo, float hi) { typedef float f2 __attribute__((ext_vector_type(2))); typedef __bf16 b2 __attribute__((ext_vector_type(2))); f2 v = {lo, hi}; b2 b = __builtin_convertvector(v, b2); return __builtin_bit_cast(unsigned, b); }
__device__ __forceinline__ bf16x8 frag_row(LAS unsigned char* lds, int H, int blk, int s, int lane) {
    return *(const LAS bf16x8*)(lds + (H >> 1) * IMG + off_b(32 * blk + (lane & 31), 8 * (H & 1) + 2 * s + (lane >> 5)));
}
__device__ __forceinline__ bf16x8 frag_tr(LAS unsigned char* lds, int H, int blk, int ks, int lane) {
    const unsigned h = lane >> 5, b2 = (lane >> 4) & 1, q = (lane & 15) >> 2, p = lane & 3, c = 2 * (H & 1) + blk;
    typedef short v4i16_t __attribute__((ext_vector_type(4)));
    LAS unsigned char* base = lds + (H >> 1) * IMG;
    const s16x4 lo = __builtin_bit_cast(s16x4, __builtin_amdgcn_ds_read_tr16_b64_v4i16((LAS v4i16_t*)(base + off_b(16 * ks + 8 * h + q, 4 * c + 2 * b2 + (p >> 1)) + 8 * (p & 1))));
    const s16x4 hi = __builtin_bit_cast(s16x4, __builtin_amdgcn_ds_read_tr16_b64_v4i16((LAS v4i16_t*)(base + off_b(16 * ks + 8 * h + 4 + q, 4 * c + 2 * b2 + (p >> 1)) + 8 * (p & 1))));
    return (bf16x8){lo[0], lo[1], lo[2], lo[3], hi[0], hi[1], hi[2], hi[3]};
}
template <bool ATR, bool BTR> __device__ __forceinline__ f32x16 mm_tile(LAS unsigned char* lds, int HA, int ablk, int HB, int bblk, f32x16 acc, int lane) {
#pragma unroll
    for (int s = 0; s < 4; ++s) {
        const bf16x8 a = ATR ? frag_tr(lds, HA, ablk, s, lane) : frag_row(lds, HA, ablk, s, lane);
        const bf16x8 b = BTR ? frag_tr(lds, HB, bblk, s, lane) : frag_row(lds, HB, bblk, s, lane);
        acc = __builtin_amdgcn_mfma_f32_32x32x16_bf16(a, b, acc, 0, 0, 0);
    }
    return acc;
}
__device__ __forceinline__ void store_tr(LAS unsigned char* lds, int H, int rblk, int cblk, const f32x16& acc, int lane) {
    LAS unsigned char* base = lds + (H >> 1) * IMG; const int hi = lane >> 5, row = 32 * cblk + (lane & 31);
#pragma unroll
    for (int g = 0; g < 4; ++g) { u32x2 w; w.x = cvt2(acc[4 * g], acc[4 * g + 1]); w.y = cvt2(acc[4 * g + 2], acc[4 * g + 3]);
        *(LAS u32x2*)(base + off_b(row, 8 * (H & 1) + 4 * rblk + g) + 8 * hi) = w; }
}
__device__ __forceinline__ float row16_sum(float x) {
    x += __builtin_bit_cast(float, __builtin_amdgcn_update_dpp(0, __builtin_bit_cast(int, x), 0xB1, 0xF, 0xF, true));
    x += __builtin_bit_cast(float, __builtin_amdgcn_update_dpp(0, __builtin_bit_cast(int, x), 0x4E, 0xF, 0xF, true));
    x += __builtin_bit_cast(float, __builtin_amdgcn_update_dpp(0, __builtin_bit_cast(int, x), 0x141, 0xF, 0xF, true));
    x += __builtin_bit_cast(float, __builtin_amdgcn_update_dpp(0, __builtin_bit_cast(int, x), 0x140, 0xF, 0xF, true));
    return x;
}
__device__ __forceinline__ u32x4v pack8(const f32x16& a, int s) { u32x4v w; w.x = cvt2(a[8 * s], a[8 * s + 1]); w.y = cvt2(a[8 * s + 2], a[8 * s + 3]); w.z = cvt2(a[8 * s + 4], a[8 * s + 5]); w.w = cvt2(a[8 * s + 6], a[8 * s + 7]); return w; }

struct Bufs { bf16* LIN; bf16* W2T; bf16* A2T; bf16* G2T; const bf16* PRW; bf16* G1; bf16* G2; bf16* MIX;
              u32x4v* MF; float* NT; u32x4v* PF; float* QP; u32x4v* ZF; float* Y; };

__device__ __forceinline__ void r1_unit(const Ctx& C, const Bufs& B, int b, int h, int c) {
    LAS unsigned char* lds = C.lds; const int lane0 = C.lane, wave = C.wave;
    const size_t row0 = (size_t)b * T + 64 * c; const int ci = (b * RH + h) * NCH + c;
    LAS float* A32 = (LAS float*)(lds + A32_OFF); LAS float* WC = (LAS float*)(lds + WC_OFF);
    typedef float f32x4a __attribute__((ext_vector_type(4)));
    {
    int lane = lane0; asm volatile("" : "+v"(lane)); const int hi = lane >> 5; (void)hi;
    { const int nl = lane & 15, q = lane >> 4;
      typedef float f32x2a __attribute__((ext_vector_type(2)));
      LAS f32x2a* RED = (LAS f32x2a*)(lds + RED_OFF);
      const bool first = (c == 0);
      if (wave < 4) {
        const int n = 16 * wave + nl, col = h * 64 + n;
        f32x4a aw[4], aa[4];
#pragma unroll
        for (int tt = 0; tt < 4; ++tt) { aw[tt] = (f32x4a){0.f, 0.f, 0.f, 0.f}; aa[tt] = aw[tt]; }
#pragma unroll
        for (int s = 0; s < 2; ++s) {
            const bf16x8 bw = *(const bf16x8*)(B.W2T + (size_t)col * 64 + 32 * s + 8 * q), ba = *(const bf16x8*)(B.A2T + (size_t)col * 64 + 32 * s + 8 * q);
#pragma unroll
            for (int tt = 0; tt < 4; ++tt) { const bf16* lp = B.LIN + (row0 + 16 * tt + nl) * 256 + 32 * s + 8 * q;
                aw[tt] = __builtin_amdgcn_mfma_f32_16x16x32_bf16(*(const bf16x8*)lp, bw, aw[tt], 0, 0, 0);
                aa[tt] = __builtin_amdgcn_mfma_f32_16x16x32_bf16(*(const bf16x8*)(lp + 64), ba, aa[tt], 0, 0, 0); }
        }
        const float w0c = C.in[18][col], a0c = C.in[20][col], kac = C.in[24][col], kkc = C.in[23][col], rkc = C.in[25][col], mur = C.in[17][col], muk = C.in[17][512 + col];
        float lw[4][4], av[4][4], xr[4][4], kkr[4][4], kpv[4][4];
#pragma unroll
        for (int tt = 0; tt < 4; ++tt) {
            asm volatile("" ::: "memory");
            const int t0 = 16 * tt + 4 * q; const bf16* p = B.PRW + (row0 + t0) * RW_COLS + col;
            const bool z = first && t0 == 0;
            float rr[5], kr5[5];
            rr[0] = z ? 0.f : bf2f(p[-RW_COLS]); kr5[0] = z ? 0.f : bf2f(p[512 - RW_COLS]);
#pragma unroll
            for (int e = 0; e < 4; ++e) { rr[e + 1] = bf2f(p[e * RW_COLS]); kr5[e + 1] = bf2f(p[512 + e * RW_COLS]); }
#pragma unroll
            for (int e = 0; e < 4; ++e) { const int t = t0 + e;
                const float r_ = rr[e + 1] + (rr[e] - rr[e + 1]) * mur, k_ = kr5[e + 1] + (kr5[e] - kr5[e + 1]) * muk;
                lw[tt][e] = -0.6065306597126334f / (1.f + __expf(-(w0c + aw[tt][e]))); av[tt][e] = 1.f / (1.f + __expf(-(a0c + aa[tt][e])));
                xr[tt][e] = r_; kkr[tt][e] = k_ * kkc; kpv[tt][e] = k_ * (1.f + (av[tt][e] - 1.f) * kac);
                const float p1 = row16_sum(kkr[tt][e] * kkr[tt][e]), p2 = row16_sum(r_ * kpv[tt][e] * rkc);
                if (nl == 0) RED[wave * 64 + t] = (f32x2a){p1, p2}; }
        }
        __syncthreads();
        float tot[4], L[4][4];
#pragma unroll
        for (int tt = 0; tt < 4; ++tt) { L[tt][0] = lw[tt][0]; L[tt][1] = L[tt][0] + lw[tt][1]; L[tt][2] = L[tt][1] + lw[tt][2]; L[tt][3] = L[tt][2] + lw[tt][3]; tot[tt] = L[tt][3]; }
        float run = 0.f;
#pragma unroll
        for (int tt = 0; tt < 4; ++tt) { float basev = run;
#pragma unroll
            for (int qq = 0; qq < 4; ++qq) { const float o = __shfl(tot[tt], nl + 16 * qq); if (qq < q) basev += o; run += o; }
#pragma unroll
            for (int e = 0; e < 4; ++e) L[tt][e] += basev; }
        if (q == 3) WC[n] = __expf(L[3][3]);
#pragma unroll
        for (int tt = 0; tt < 4; ++tt) {
            float at[4], bt[4], kt[4], rt[4];
#pragma unroll
            for (int e = 0; e < 4; ++e) { const int t = 16 * tt + 4 * q + e;
                const float nrm = RED[t].x + RED[64 + t].x + RED[128 + t].x + RED[192 + t].x;
                const float kkn = kkr[tt][e] * (1.f / sqrtf(fmaxf(nrm, 1e-24f)));
                const float eL = __expf(L[tt][e]), eLm = __expf(-L[tt][e]), eLex = __expf(L[tt][e] - lw[tt][e]);
                at[e] = -kkn * eLex; bt[e] = kkn * av[tt][e] * eLm; kt[e] = kpv[tt][e] * eLm; rt[e] = xr[tt][e] * eL; }
            const unsigned ch = 2 * tt + (q >> 1), bo = 8 * (q & 1);
            u32x2 w;
            w.x = cvt2(at[0], at[1]); w.y = cvt2(at[2], at[3]); *(LAS u32x2*)(lds + 0 * IMG + off_b(n, ch) + bo) = w;
            w.x = cvt2(bt[0], bt[1]); w.y = cvt2(bt[2], bt[3]); *(LAS u32x2*)(lds + 0 * IMG + off_b(n, 8 + ch) + bo) = w;
            w.x = cvt2(kt[0], kt[1]); w.y = cvt2(kt[2], kt[3]); *(LAS u32x2*)(lds + 1 * IMG + off_b(n, ch) + bo) = w;
            w.x = cvt2(rt[0], rt[1]); w.y = cvt2(rt[2], rt[3]); *(LAS u32x2*)(lds + 1 * IMG + off_b(n, 8 + ch) + bo) = w;
        }
      } else {
        const int n = 16 * (wave - 4) + nl, col = h * 64 + n;
        f32x4a ag[4];
#pragma unroll
        for (int tt = 0; tt < 4; ++tt) ag[tt] = (f32x4a){0.f, 0.f, 0.f, 0.f};
#pragma unroll
        for (int s = 0; s < 4; ++s) { const bf16x8 bg = *(const bf16x8*)(B.G2T + (size_t)col * 128 + 32 * s + 8 * q);
#pragma unroll
            for (int tt = 0; tt < 4; ++tt) ag[tt] = __builtin_amdgcn_mfma_f32_16x16x32_bf16(*(const bf16x8*)(B.LIN + (row0 + 16 * tt + nl) * 256 + 128 + 32 * s + 8 * q), bg, ag[tt], 0, 0, 0); }
        const float muv = C.in[17][1024 + col], lnw = C.in[26][col], lnb = C.in[27][col];
        float xv[4][4];
#pragma unroll
        for (int tt = 0; tt < 4; ++tt) { const int t0 = 16 * tt + 4 * q; const bf16* p = B.PRW + (row0 + t0) * RW_COLS + 1024 + col;
            float vr[5]; vr[0] = (first && t0 == 0) ? 0.f : bf2f(p[-RW_COLS]);
#pragma unroll
            for (int e = 0; e < 4; ++e) vr[e + 1] = bf2f(p[e * RW_COLS]);
#pragma unroll
            for (int e = 0; e < 4; ++e) xv[tt][e] = vr[e + 1] + (vr[e] - vr[e + 1]) * muv; }
        __syncthreads();
#pragma unroll
        for (int tt = 0; tt < 4; ++tt) {
            float g1v[4], g2v[4];
#pragma unroll
            for (int e = 0; e < 4; ++e) { const int t = 16 * tt + 4 * q + e;
                const float bsc = RED[t].y + RED[64 + t].y + RED[128 + t].y + RED[192 + t].y, g = ag[tt][e];
                g1v[e] = lnw * g; g2v[e] = (lnb + bsc * xv[tt][e]) * g; }
            { u32x2 w; const size_t o = ((size_t)ci * 64 + n) * 64 + 16 * tt + 4 * q;
              w.x = cvt2(g1v[0], g1v[1]); w.y = cvt2(g1v[2], g1v[3]); *(u32x2*)(B.G1 + o) = w;
              w.x = cvt2(g2v[0], g2v[1]); w.y = cvt2(g2v[2], g2v[3]); *(u32x2*)(B.G2 + o) = w; }
            u32x2 w; w.x = cvt2(xv[tt][0], xv[tt][1]); w.y = cvt2(xv[tt][2], xv[tt][3]);
            *(LAS u32x2*)(lds + 2 * IMG + off_b(n, 2 * tt + (q >> 1)) + 8 * (q & 1)) = w; }
      }
    }
    }
    __syncthreads();
    {
    int lane = lane0; asm volatile("" : "+v"(lane)); const int hi = lane >> 5; (void)hi;
#pragma unroll
    for (int k2 = 0; k2 < 2; ++k2) {
        const int id = 2 * wave + k2, prod = id >> 2, tb = (id >> 1) & 1, jb = id & 1;
        f32x16 acc = f32x16{};
        if (prod == 0) acc = mm_tile<true, true>(lds, H_AT, tb, H_BT, jb, acc, lane);
        else if (prod == 1) acc = mm_tile<true, true>(lds, H_AT, tb, H_KT, jb, acc, lane);
        else if (prod == 2) acc = mm_tile<true, true>(lds, H_BT, jb, H_RT, tb, acc, lane);
        else acc = mm_tile<true, true>(lds, H_KT, jb, H_RT, tb, acc, lane);
        if (prod < 2) {
#pragma unroll
            for (int r = 0; r < 16; ++r) { const int t = 32 * tb + crow(r, hi), j = 32 * jb + (lane & 31); if (!(j < t)) acc[r] = 0.f; }
            if (prod == 0) {
#pragma unroll
                for (int r = 0; r < 16; ++r) A32[(32 * tb + crow(r, hi)) * 64 + 32 * jb + (lane & 31)] = acc[r];
                f32x16 n1 = acc, n2 = acc;
#pragma unroll
                for (int r = 0; r < 16; ++r) { if (!(tb == jb && crow(r, hi) >= 16 && (lane & 31) < 16)) n1[r] = 0.f; if (!(tb == 1 && jb == 0)) n2[r] = 0.f; }
                store_tr(lds, H_N1, tb, jb, n1, lane); store_tr(lds, H_N2, tb, jb, n2, lane); }
            else store_tr(lds, H_AAK, tb, jb, acc, lane);
        } else {
#pragma unroll
            for (int r = 0; r < 16; ++r) { const int j = 32 * jb + crow(r, hi), t = 32 * tb + (lane & 31); if (!(j <= t)) acc[r] = 0.f; }
            store_tr(lds, prod == 2 ? H_ARB : H_ARK, jb, tb, acc, lane);
        }
    }
    }
    __syncthreads();
    {
    int lane = lane0; asm volatile("" : "+v"(lane)); const int hi = lane >> 5; (void)hi;
    if (wave == 0) {
        const int blk = lane >> 4, cc = lane & 15; float Tb[16];
#pragma unroll
        for (int t = 0; t < 16; ++t) { float sacc = (t == cc) ? 1.f : 0.f;
#pragma unroll
            for (int j4 = 0; j4 < t; j4 += 4) { const f32x4a a4 = *(const LAS f32x4a*)(A32 + (16 * blk + t) * 64 + 16 * blk + j4);
                sacc += a4[0] * Tb[j4]; if (j4 + 1 < t) sacc += a4[1] * Tb[j4 + 1]; if (j4 + 2 < t) sacc += a4[2] * Tb[j4 + 2]; if (j4 + 3 < t) sacc += a4[3] * Tb[j4 + 3]; }
            Tb[t] = sacc; }
        u32x4v lo, hi4; lo.x = cvt2(Tb[0], Tb[1]); lo.y = cvt2(Tb[2], Tb[3]); lo.z = cvt2(Tb[4], Tb[5]); lo.w = cvt2(Tb[6], Tb[7]);
        hi4.x = cvt2(Tb[8], Tb[9]); hi4.y = cvt2(Tb[10], Tb[11]); hi4.z = cvt2(Tb[12], Tb[13]); hi4.w = cvt2(Tb[14], Tb[15]);
#pragma unroll
        for (int g = 0; g < 8; ++g) { u32x4v w = (u32x4v){0u, 0u, 0u, 0u}; if (g == 2 * blk) w = lo; if (g == 2 * blk + 1) w = hi4;
            *(LAS u32x4v*)(lds + (H_TT >> 1) * IMG + off_b(lane, 8 * (H_TT & 1) + g)) = w; }
    } else if (wave >= 4) {
        const int tb = (wave - 4) >> 1, ib = (wave - 4) & 1;
        f32x16 acc = mm_tile<true, false>(lds, H_AAK, tb, H_VT, ib, f32x16{}, lane);
        store_tr(lds, H_XT, tb, ib, acc, lane);
    }
    __syncthreads();
    { const int tb = (wave >> 1) & 1, cb = wave & 1;
      if (wave < 4) { f32x16 acc = mm_tile<true, false>(lds, H_N1, tb, H_TT, cb, f32x16{}, lane);
#pragma unroll
          for (int r = 0; r < 16; ++r) if (32 * tb + crow(r, hi) == 32 * cb + (lane & 31)) acc[r] += 1.f;
          store_tr(lds, H_PT, tb, cb, acc, lane); }
      __syncthreads();
      if (wave < 4) { f32x16 acc = mm_tile<true, false>(lds, H_TT, tb, H_PT, cb, f32x16{}, lane); store_tr(lds, H_QT, tb, cb, acc, lane); }
      __syncthreads();
      if (wave < 4) { f32x16 acc = mm_tile<true, false>(lds, H_N2, tb, H_QT, cb, f32x16{}, lane);
#pragma unroll
          for (int r = 0; r < 16; ++r) if (32 * tb + crow(r, hi) == 32 * cb + (lane & 31)) acc[r] += 1.f;
          store_tr(lds, H_PT, tb, cb, acc, lane); }
      __syncthreads();
      if (wave < 4) { f32x16 acc = mm_tile<true, false>(lds, H_QT, tb, H_PT, cb, f32x16{}, lane); store_tr(lds, H_TT, tb, cb, acc, lane); }
    }
    }
    __syncthreads();
    {
    int lane = lane0; asm volatile("" : "+v"(lane)); const int hi = lane >> 5; (void)hi;
    { const int tb = (wave >> 1) & 1, cb = wave & 1;
      if (wave < 4) { f32x16 acc = mm_tile<true, false>(lds, H_TT, tb, H_AT, cb, f32x16{}, lane); store_tr(lds, H_PT, tb, cb, acc, lane); }
      else { f32x16 acc = mm_tile<true, false>(lds, H_TT, tb, H_XT, cb, f32x16{}, lane); store_tr(lds, H_QT, tb, cb, acc, lane); } }
    }
    __syncthreads();
    {
    int lane = lane0; asm volatile("" : "+v"(lane)); const int hi = lane >> 5; (void)hi;
#pragma unroll
    for (int k2 = 0; k2 < 2; ++k2) {
        const int id = 2 * wave + k2, prod = id >> 2, rb = (id >> 1) & 1, cb = id & 1;
        f32x16 acc = f32x16{};
        if (prod == 0) {
            acc = mm_tile<false, false>(lds, H_PT, rb, H_BT, cb, acc, lane);
            const float wc = WC[32 * cb + (lane & 31)];
#pragma unroll
            for (int r = 0; r < 16; ++r) { const int n = 32 * rb + crow(r, hi), m = 32 * cb + (lane & 31); acc[r] = (acc[r] + (n == m ? 1.f : 0.f)) * wc; }
            u32x4v* o = B.MF + ((size_t)ci * 8 + (cb * 2 + rb) * 2) * 64 + lane;
            o[0] = pack8(acc, 0); o[64] = pack8(acc, 1);
        } else if (prod == 1) {
            acc = mm_tile<false, false>(lds, H_BT, rb, H_QT, cb, acc, lane);
            acc = mm_tile<false, false>(lds, H_KT, rb, H_VT, cb, acc, lane);
#pragma unroll
            for (int g = 0; g < 4; ++g) { const f32x4a w4 = *(const LAS f32x4a*)(WC + 32 * rb + 8 * g + 4 * hi);
                f32x4a v = {acc[4 * g] * w4[0], acc[4 * g + 1] * w4[1], acc[4 * g + 2] * w4[2], acc[4 * g + 3] * w4[3]};
                *(f32x4a*)(B.NT + (((size_t)ci * 4 + rb * 2 + cb) * 64 + lane) * 16 + 4 * g) = v; }
        } else if (prod == 2) {
            acc = mm_tile<false, false>(lds, H_PT, rb, H_ARB, cb, acc, lane);
#pragma unroll
            for (int s = 0; s < 4; ++s) { bf16x8 idf;
#pragma unroll
                for (int e = 0; e < 8; ++e) idf[e] = (16 * s + 8 * hi + e == 32 * cb + (lane & 31)) ? (short)0x3f80 : (short)0;
                acc = __builtin_amdgcn_mfma_f32_32x32x16_bf16(frag_row(lds, H_RT, rb, s, lane), idf, acc, 0, 0, 0); }
            u32x4v* o = B.PF + ((size_t)ci * 8 + (cb * 2 + rb) * 2) * 64 + lane;
            o[0] = pack8(acc, 0); o[64] = pack8(acc, 1);
        } else {
            acc = mm_tile<false, false>(lds, H_ARB, rb, H_QT, cb, acc, lane);
            acc = mm_tile<false, false>(lds, H_ARK, rb, H_VT, cb, acc, lane);
#pragma unroll
            for (int g = 0; g < 4; ++g) *(f32x4a*)(B.QP + (((size_t)ci * 4 + rb * 2 + cb) * 64 + lane) * 16 + 4 * g) = (f32x4a){acc[4 * g], acc[4 * g + 1], acc[4 * g + 2], acc[4 * g + 3]};
        }
    }
    }
    __syncthreads();
}
__device__ __forceinline__ void r1_phase(const Ctx& C, const Bufs& B) {
    for (int u = blockIdx.x; u < NB * RH * NCH; u += C.G) { const int c = u & (NCH - 1), h = (u >> 5) & 7, b = u >> 8; r1_unit(C, B, b, h, c); }
}
__device__ __forceinline__ void r2_chain(const Ctx& C, const Bufs& B, int k) {
    const int lane = C.lane, hi = lane >> 5, ib = k & 1, bh = k >> 1;
    f32x16 z[2]; z[0] = f32x16{}; z[1] = f32x16{};
    typedef float f32x4a __attribute__((ext_vector_type(4)));
    for (int c = 0; c < NCH; ++c) {
        const size_t ci = (size_t)bh * NCH + c;
        u32x4v bf[2][2];
#pragma unroll
        for (int nb = 0; nb < 2; ++nb)
#pragma unroll
            for (int s = 0; s < 2; ++s) { bf[nb][s] = pack8(z[nb], s); B.ZF[((ci * 2 + ib) * 4 + nb * 2 + s) * 64 + lane] = bf[nb][s]; }
        f32x16 zn[2];
#pragma unroll
        for (int mb = 0; mb < 2; ++mb) {
            const float* np = B.NT + ((ci * 4 + mb * 2 + ib) * 64 + lane) * 16;
#pragma unroll
            for (int g = 0; g < 4; ++g) { const f32x4a v = *(const f32x4a*)(np + 4 * g); zn[mb][4 * g] = v[0]; zn[mb][4 * g + 1] = v[1]; zn[mb][4 * g + 2] = v[2]; zn[mb][4 * g + 3] = v[3]; }
#pragma unroll
            for (int nb = 0; nb < 2; ++nb)
#pragma unroll
                for (int s = 0; s < 2; ++s) { const u32x4v af = B.MF[(ci * 8 + (mb * 2 + nb) * 2 + s) * 64 + lane];
                    zn[mb] = __builtin_amdgcn_mfma_f32_32x32x16_bf16(__builtin_bit_cast(bf16x8, af), __builtin_bit_cast(bf16x8, bf[nb][s]), zn[mb], 0, 0, 0); }
        }
        z[0] = zn[0]; z[1] = zn[1];
    }
    float* so = C.out + OUT_WKVP + ((size_t)bh * RN + 32 * ib + (lane & 31)) * RN;
#pragma unroll
    for (int nb = 0; nb < 2; ++nb)
#pragma unroll
        for (int g = 0; g < 4; ++g) *(f32x4a*)(so + 32 * nb + 8 * g + 4 * hi) = (f32x4a){z[nb][4 * g], z[nb][4 * g + 1], z[nb][4 * g + 2], z[nb][4 * g + 3]};
}
__device__ __forceinline__ void r2_chain_wg(const Ctx& C, const Bufs& B, int k) {
    const int lane = C.lane, hi = lane >> 5, ib = k & 1, bh = k >> 1, wave = C.wave;
    LAS unsigned char* lds = C.lds;
    typedef float f32x4a __attribute__((ext_vector_type(4)));
    auto load_round = [&](int rd) {
        u32x4v tmp[10];
#pragma unroll
        for (int i = 0; i < 10; ++i) { const int pidx = (wave - 1) + 7 * i;
            if (pidx < 64) { const size_t ci = (size_t)bh * NCH + 4 * rd + (pidx >> 4); const int q = pidx & 15;
                tmp[i] = q < 8 ? B.MF[(ci * 8 + q) * 64 + lane] : *(const u32x4v*)(B.NT + ((ci * 4 + ((q - 8) >> 2) * 2 + ib) * 64 + lane) * 16 + 4 * ((q - 8) & 3)); } }
#pragma unroll
        for (int i = 0; i < 10; ++i) { const int pidx = (wave - 1) + 7 * i;
            if (pidx < 64) *(LAS u32x4v*)(lds + (rd & 1) * 65536 + (pidx >> 4) * 16384 + (pidx & 15) * 1024 + lane * 16) = tmp[i]; }
    };
    f32x16 z[2]; z[0] = f32x16{}; z[1] = f32x16{};
    if (wave > 0) load_round(0);
    __syncthreads();
    for (int rd = 0; rd < NCH / 4; ++rd) {
        if (wave > 0) { if (rd + 1 < NCH / 4) load_round(rd + 1); }
        else {
            for (int st = 0; st < 4; ++st) {
                const size_t ci = (size_t)bh * NCH + 4 * rd + st; LAS unsigned char* sl = lds + (rd & 1) * 65536 + st * 16384;
                u32x4v bf[2][2];
#pragma unroll
                for (int nb = 0; nb < 2; ++nb)
#pragma unroll
                    for (int s = 0; s < 2; ++s) { bf[nb][s] = pack8(z[nb], s); B.ZF[((ci * 2 + ib) * 4 + nb * 2 + s) * 64 + lane] = bf[nb][s]; }
                f32x16 zn[2];
#pragma unroll
                for (int mb = 0; mb < 2; ++mb) {
#pragma unroll
                    for (int g = 0; g < 4; ++g) { const f32x4a v = *(const LAS f32x4a*)(sl + (8 + mb * 4 + g) * 1024 + lane * 16); zn[mb][4 * g] = v[0]; zn[mb][4 * g + 1] = v[1]; zn[mb][4 * g + 2] = v[2]; zn[mb][4 * g + 3] = v[3]; }
#pragma unroll
                    for (int nb = 0; nb < 2; ++nb)
#pragma unroll
                        for (int s = 0; s < 2; ++s) { const u32x4v af = *(const LAS u32x4v*)(sl + ((mb * 2 + nb) * 2 + s) * 1024 + lane * 16);
                            zn[mb] = __builtin_amdgcn_mfma_f32_32x32x16_bf16(__builtin_bit_cast(bf16x8, af), __builtin_bit_cast(bf16x8, bf[nb][s]), zn[mb], 0, 0, 0); }
                }
                z[0] = zn[0]; z[1] = zn[1];
            }
        }
        __syncthreads();
    }
    if (wave == 0) {
        float* so = C.out + OUT_WKVP + ((size_t)bh * RN + 32 * ib + (lane & 31)) * RN;
#pragma unroll
        for (int nb = 0; nb < 2; ++nb)
#pragma unroll
            for (int g = 0; g < 4; ++g) *(f32x4a*)(so + 32 * nb + 8 * g + 4 * hi) = (f32x4a){z[nb][4 * g], z[nb][4 * g + 1], z[nb][4 * g + 2], z[nb][4 * g + 3]};
    }
}
__device__ __forceinline__ void r3_phase(const Ctx& C, const Bufs& B) {
    const int lane = C.lane, hi = lane >> 5;
    typedef float f32x4a __attribute__((ext_vector_type(4)));
    for (int wu = C.gw; wu < NB * RH * NCH * 2; wu += C.ngw) {
        const int tb = wu & 1; const size_t ci = (size_t)(wu >> 1); const int c = (int)(ci & (NCH - 1)), bh = (int)(ci >> 5), h = bh & 7, b = bh >> 3;
        u32x4v pf[2][2];
#pragma unroll
        for (int nb = 0; nb < 2; ++nb)
#pragma unroll
            for (int s = 0; s < 2; ++s) pf[nb][s] = B.PF[(ci * 8 + (tb * 2 + nb) * 2 + s) * 64 + lane];
        f32x16 y[2];
#pragma unroll
        for (int ib = 0; ib < 2; ++ib) {
            const float* qp = B.QP + ((ci * 4 + tb * 2 + ib) * 64 + lane) * 16;
#pragma unroll
            for (int g = 0; g < 4; ++g) { const f32x4a v = *(const f32x4a*)(qp + 4 * g); y[ib][4 * g] = v[0]; y[ib][4 * g + 1] = v[1]; y[ib][4 * g + 2] = v[2]; y[ib][4 * g + 3] = v[3]; }
#pragma unroll
            for (int nb = 0; nb < 2; ++nb)
#pragma unroll
                for (int s = 0; s < 2; ++s) { const u32x4v zf = B.ZF[((ci * 2 + ib) * 4 + nb * 2 + s) * 64 + lane];
                    y[ib] = __builtin_amdgcn_mfma_f32_32x32x16_bf16(__builtin_bit_cast(bf16x8, pf[nb][s]), __builtin_bit_cast(bf16x8, zf), y[ib], 0, 0, 0); }
        }
        const size_t rowb = (size_t)b * T + 64 * c + 32 * tb;
        float mean[16], rstd[16];
#pragma unroll
        for (int r = 0; r < 16; ++r) {
            float s1 = y[0][r] + y[1][r], s2 = y[0][r] * y[0][r] + y[1][r] * y[1][r];
#pragma unroll
            for (int o = 1; o < 32; o <<= 1) { s1 += __shfl_xor(s1, o); s2 += __shfl_xor(s2, o); }
            mean[r] = s1 * (1.f / 64.f); rstd[r] = 1.f / sqrtf(fmaxf(s2 * (1.f / 64.f) - mean[r] * mean[r], 0.f) + GN_EPS); }
#pragma unroll
        for (int ib = 0; ib < 2; ++ib) { const int i = 32 * ib + (lane & 31);
#pragma unroll
            for (int g = 0; g < 4; ++g) { const size_t o = ((size_t)ci * 64 + i) * 64 + 32 * tb + 8 * g + 4 * hi;
                const u32x2 a1 = *(const u32x2*)(B.G1 + o), a2 = *(const u32x2*)(B.G2 + o);
#pragma unroll
                for (int e = 0; e < 4; ++e) { const int r = 4 * g + e;
                    const float g1 = __builtin_bit_cast(float, (e & 1) ? ((e < 2 ? a1.x : a1.y) & 0xffff0000u) : ((e < 2 ? a1.x : a1.y) << 16));
                    const float g2 = __builtin_bit_cast(float, (e & 1) ? ((e < 2 ? a2.x : a2.y) & 0xffff0000u) : ((e < 2 ? a2.x : a2.y) << 16));
                    B.MIX[(rowb + crow(r, hi)) * D + ATT_W + h * 64 + i] = (bf16)f2bf((y[ib][r] - mean[r]) * rstd[r] * g1 + g2); } } }
    }
}
}
constexpr int N_PHASES = 11;
__global__ void __launch_bounds__(NTHREADS, 2) fwd(Args args) {
    extern __shared__ __attribute__((aligned(16))) unsigned char lds[];
    Ctx C;
    C.lds = (LAS unsigned char*)lds;
    C.tid = threadIdx.x; C.lane = C.tid & 63; C.wave = __builtin_amdgcn_readfirstlane(C.tid >> 6);
    C.G = gridDim.x; C.gw = blockIdx.x * NWAVES + C.wave; C.ngw = C.G * NWAVES;
    C.in = args.in; C.out = args.out; C.ws = args.ws;
    const int lo = args.ph_lo, hi = args.ph_hi;
    volatile LAS unsigned* MISC = (volatile LAS unsigned*)(C.lds + MISC_OFF);
    if (C.tid < 32) MISC[C.tid] = 0u;
    __syncthreads();
    XcdBarrier bar = xcd_barrier_post((unsigned*)(C.ws + WS_CTL) + CW_BAR, MISC + 8);
#define IN(k) (lo <= (k) && (k) < hi)
#define SEAM(k) do { if (IN(k) && IN((k) + 1)) xcd_barrier(bar); } while (0)
    if (IN(0)) { p0_mod(C); p0_weights(C); }
    SEAM(0);
    if (IN(1)) { p1_norm1(C); }
    SEAM(1);
    if (IN(2)) {
        pg8::Gemm g{(const pg8::bf16_t*)(C.ws + WS_A1), (const pg8::bf16_t*)(C.ws + WS_WIN), MPAD, NIN, D}; pg8::StaticOrder S; S.init(MPAD, NIN, C.G, (int)blockIdx.x);
        EpiIn E{C.ws, C.out, C.in[15], C.in[16]};
        pg8::gemm_phase<EpiIn, pg8::StaticOrder, true, true>(C.lds, g, S, E);
    }
    SEAM(2);
    rw::Bufs RB;
    RB.LIN = (bf16*)(C.ws + WS_LIN); RB.W2T = (bf16*)(C.ws + WS_W2T); RB.A2T = (bf16*)(C.ws + WS_A2T); RB.G2T = (bf16*)(C.ws + WS_G2T);
    RB.PRW = (const bf16*)(C.ws + WS_PRW); RB.G1 = (bf16*)(C.ws + WS_RWA); RB.G2 = (bf16*)(C.ws + WS_RWA + RWA_STRIDE); RB.MIX = (bf16*)(C.ws + WS_MIX);
    RB.MF = (rw::u32x4v*)(C.ws + WS_MF); RB.NT = (float*)(C.ws + WS_NT); RB.PF = (rw::u32x4v*)(C.ws + WS_PF); RB.QP = (float*)(C.ws + WS_QP); RB.ZF = (rw::u32x4v*)(C.ws + WS_ZF);
    if (IN(3)) { p3_lin(C); smp_rwkv(C); }
    SEAM(3);
    if (IN(4)) { idxsel::phase(C); rw::r1_phase(C, RB); p4_indexer<false, true>(C); }
    SEAM(4);
    if (IN(5)) {
        p5_select<false, true>(C);
        if (blockIdx.x < NB * RH * 2) rw::r2_chain_wg(C, RB, (int)blockIdx.x);
        __syncthreads();
        const attn_body::AttnTensors AT{(const attn_body::bf16*)(C.ws + WS_QB), (const attn_body::bf16*)(C.ws + WS_KB), (const attn_body::bf16*)(C.ws + WS_VB), (attn_body::bf16*)(C.ws + WS_MIX), (const unsigned long long*)(C.ws + WS_MASKT)};
        const attn_body::StaticOrder S((int)C.G, (int)blockIdx.x);
        attn_body::attn_phase<attn_body::StaticOrder>((char*)lds, AT, S);
    }
    SEAM(5);
    if (IN(6)) { smp_attn(C); rw::r3_phase(C, RB); }
    SEAM(6);
    if (IN(7)) {
        pg8::Gemm g{(const pg8::bf16_t*)(C.ws + WS_MIX), (const pg8::bf16_t*)(C.ws + WS_WOUT), MP, D, D}; pg8::StaticOrder S; S.init(MP, D, C.G, (int)blockIdx.x);
        EpiResGate E{C.in[0], (const float*)(C.ws + WS_MOD) + 2 * D, (float*)(C.ws + WS_X1)};
        pg8::gemm_phase<EpiResGate, pg8::StaticOrder, true, true>(C.lds, g, S, E);
        const float* xs = C.in[1]; const float* g1 = (const float*)(C.ws + WS_MOD) + (size_t)NB * MODW + 2 * D; float* x1s = (float*)(C.ws + WS_X1) + (size_t)MP * D;
        sample_gemm(C, (const bf16*)(C.ws + WS_MIX) + (size_t)MP * D, (const bf16*)(C.ws + WS_WOUT), D, [&](int row, int col, float v) { x1s[row * D + col] = xs[row * D + col] + g1[(size_t)row * MODW + col] * v; });
    }
    SEAM(7);
    if (IN(8)) { p8_res_norm2(C); }
    SEAM(8);
    if (IN(9)) {
        pg8::Gemm g{(const pg8::bf16_t*)(C.ws + WS_A2), (const pg8::bf16_t*)(C.ws + WS_WGU), MPAD, NGU, D}; pg8::StaticOrder S; S.init(MPAD, NGU, C.G, (int)blockIdx.x);
        EpiSwiGLU E{(bf16*)(C.ws + WS_HB)};
        pg8::gemm_phase<EpiSwiGLU, pg8::StaticOrder, true, true>(C.lds, g, S, E);
    }
    SEAM(9);
    if (IN(10)) {
        pg8::Gemm g{(const pg8::bf16_t*)(C.ws + WS_HB), (const pg8::bf16_t*)(C.ws + WS_WDN), MP, D, FFN}; pg8::StaticOrder S; S.init(MP, D, C.G, (int)blockIdx.x);
        EpiResGate E{(const float*)(C.ws + WS_X1), (const float*)(C.ws + WS_MOD) + 5 * D, C.out + OUT_Y};
        pg8::gemm_phase<EpiResGate, pg8::StaticOrder, true, true>(C.lds, g, S, E);
        const float* x1s = (const float*)(C.ws + WS_X1) + (size_t)MP * D; const float* g2 = (const float*)(C.ws + WS_MOD) + (size_t)NB * MODW + 5 * D; float* ys = C.out + OUT_YS;
        sample_gemm(C, (const bf16*)(C.ws + WS_HB) + (size_t)MP * FFN, (const bf16*)(C.ws + WS_WDN), FFN, [&](int row, int col, float v) { ys[row * D + col] = x1s[row * D + col] + g2[(size_t)row * MODW + col] * v; });
    }
#undef IN
#undef SEAM
}

extern "C" void kernel_launch(void* const* d_in, const int* in_sizes, int n_in, void* d_out, int out_size, void* d_ws, size_t ws_size, hipStream_t stream) {
    static int grid = 0;
    if (grid == 0) {
        if (n_in != 32 || (size_t)out_size != OUT_END || ws_size < WS_END) { fprintf(stderr, "kernel_launch: unexpected sizes n_in %d out %d ws %zu\n", n_in, out_size, ws_size); grid = -1; return; }
        int dev = 0, cus = 0;
        if (hipGetDevice(&dev) != hipSuccess || hipDeviceGetAttribute(&cus, hipDeviceAttributeMultiprocessorCount, dev) != hipSuccess) { grid = -1; return; }
        if (hipFuncSetAttribute((const void*)fwd, hipFuncAttributeMaxDynamicSharedMemorySize, LDS_BYTES) != hipSuccess) { fprintf(stderr, "kernel_launch: hipFuncSetAttribute failed\n"); grid = -1; return; }
        (void)hipGetLastError();
        grid = cus;
    }
    if (grid < 0) return;
    (void)hipMemsetAsync((char*)d_ws + WS_CTL, 0, CTL_ZERO_BYTES, stream);
    Args a{};
    for (int i = 0; i < 32; ++i) a.in[i] = (const float*)d_in[i];
    a.out = (float*)d_out; a.ws = (unsigned char*)d_ws;
    a.ph_lo = 0; a.ph_hi = N_PHASES;
    hipLaunchKernelGGL(fwd, dim3(grid), dim3(NTHREADS), LDS_BYTES, stream, a);
}
```
